# Optimizing an MI355X kernel written in HIP

```python
import math
import jax, jax.numpy as jnp
from jax import lax
import numpy as np

D_MODEL = 1024
BATCH = 32
SEQ = 2048
DEPTH = 2

GRID_W = 64
CTX_LEN = 256
MIX_W = D_MODEL
D_FF = 4 * D_MODEL
N_EVEN = (DEPTH + 1) // 2
N_ODD = DEPTH // 2
DEEPNORM_ALPHA = (2.0 * DEPTH) ** 0.25
DEEPNORM_BETA = (8.0 * DEPTH) ** -0.25
LN_EPS = 1e-5
N_MOD = 6

HY_W = MIX_W // 2
HY_SHORT = 3
HY_BANDS = 16
HY_PE_DIM = 2 * HY_BANDS + 1
HY_FFN = 64
HY_DECAY_MIN = -math.log(1e-2) / 1.5
HY_DECAY_MAX = -math.log(1e-2) / 0.3

HEAD_DIM = 64
SWA_HEADS = (MIX_W - HY_W) // HEAD_DIM
SWA_KV_HEADS = 2
SWA_GROUP = SWA_HEADS // SWA_KV_HEADS
WINDOW = 128
SWA_BLOCK = 128
ROPE_BASE = 10000.0

E_HY_COLS = 3 * HY_W
E_Q_COLS = SWA_HEADS * HEAD_DIM
E_KV_COLS = SWA_KV_HEADS * HEAD_DIM
E_IN_COLS = E_HY_COLS + E_Q_COLS + 2 * E_KV_COLS

RW_HEAD = 64
RW_W = MIX_W // 2
RW_HEADS = RW_W // RW_HEAD
RW_DECAY_LORA = 64
RW_AAA_LORA = 64
RW_GATE_LORA = 128
RW_GN_EPS = 64e-5
RW_COLS = 3 * RW_W + 2 * RW_DECAY_LORA + 2 * RW_AAA_LORA + RW_GATE_LORA

DN_HEAD = 128
DN_W = MIX_W - RW_W
DN_HEADS = DN_W // DN_HEAD
DN_SHORT = 3
DN_CHUNK = 64
DN_COLS = 4 * DN_W + 4 * DN_HEADS
O_IN_COLS = RW_COLS + DN_COLS

kernel_name = "hybrid_hyena_swa_rwkv7_gdn_dit_block"

F32 = jnp.float32


def layer_norm(x, g, b):
    xf = x.astype(F32)
    mu = jnp.mean(xf, -1, keepdims=True)
    var = jnp.mean(jnp.square(xf - mu), -1, keepdims=True)
    return ((xf - mu) * lax.rsqrt(var + LN_EPS) * g + b).astype(x.dtype)


def l2_normalize(t, eps=1e-6):
    tf = t.astype(F32)
    return tf * lax.rsqrt(jnp.sum(tf * tf, -1, keepdims=True) + eps)


def centred_conv(u, w):
    width = w.shape[0]
    pad = width // 2
    L = u.shape[1]
    up = jnp.pad(u, ((0, 0), (pad, pad), (0, 0)))
    out = up[:, 0:L] * w[0]
    for j in range(1, width):
        out = out + up[:, j:j + L] * w[j]
    return out


def sq_relu_mlp(h, w1, w2):
    return jnp.square(jax.nn.relu(h @ w1)) @ w2


def hyena_filters(L, w1, b1, w2, b2, freq, w3, decay):
    t = jnp.arange(L, dtype=F32)
    t_norm = t / max(L - 1, 1)
    bands = jnp.linspace(1e-4, HY_BANDS - 1, HY_BANDS, dtype=F32)
    ang = 2.0 * math.pi * t[:, None] * bands[None, :] / L
    pe = jnp.concatenate([t_norm[:, None], jnp.cos(ang), -jnp.sin(ang)], axis=-1)
    h = jnp.sin(freq * (pe @ w1 + b1))
    h = jnp.sin(freq * (h @ w2 + b2))
    h = (h @ w3) * jnp.exp(-t_norm[:, None] * jnp.abs(decay))
    return h[:, :HY_W], h[:, HY_W:]


def bidir_long_conv(u, h_fwd, h_bwd, bias):
    L = u.shape[1]
    k = jnp.concatenate([h_fwd, jnp.zeros_like(h_fwd[:1]), h_bwd[:0:-1]], axis=0)
    uf = jnp.fft.rfft(u.astype(F32), n=2 * L, axis=1)
    kf = jnp.fft.rfft(k.astype(F32), n=2 * L, axis=0)
    y = jnp.fft.irfft(uf * kf[None], n=2 * L, axis=1)[:, :L]
    return (y + u.astype(F32) * bias).astype(u.dtype)


def hyena_mixer(p, conv_w, w1, b1, w2, b2, freq, w3, decay, bias):
    z = centred_conv(p, conv_w)
    x0, x1, v = jnp.split(z, 3, axis=-1)
    h_f, h_b = hyena_filters(p.shape[1], w1, b1, w2, b2, freq, w3, decay)
    return x0 * bidir_long_conv(x1 * v, h_f, h_b, bias)


def axial_rope(t):
    L = t.shape[1]
    pos = jnp.arange(L, dtype=jnp.int32)
    half = HEAD_DIM // 2
    quarter = half // 2
    inv_freq = ROPE_BASE ** (-jnp.arange(quarter, dtype=F32) / quarter)
    tf = t.astype(F32)

    def rot(u, p):
        ang = p.astype(F32)[:, None] * inv_freq[None, :]
        cos = jnp.cos(ang)[None, :, None, :]
        sin = jnp.sin(ang)[None, :, None, :]
        u1, u2 = u[..., :quarter], u[..., quarter:]
        return jnp.concatenate([u1 * cos - u2 * sin, u1 * sin + u2 * cos], axis=-1)

    out = jnp.concatenate([rot(tf[..., :half], pos // GRID_W), rot(tf[..., half:], pos % GRID_W)], axis=-1)
    return out.astype(t.dtype)


def sink_softmax(s, sink):
    sk = sink.astype(F32)[None, :, :, None, None]
    m = jnp.maximum(jnp.max(s, -1, keepdims=True), sk)
    p = jnp.exp(s - m)
    return p / (jnp.sum(p, -1, keepdims=True) + jnp.exp(sk - m))


def windowed_attention_latent(q, k, v, kc, vc, sink):
    bsz, L = q.shape[0], q.shape[1]
    n_blk = L // SWA_BLOCK
    span = SWA_BLOCK + 2 * WINDOW
    scale = HEAD_DIM ** -0.5
    kp = jnp.pad(k, ((0, 0), (WINDOW, WINDOW), (0, 0), (0, 0)))
    vp = jnp.pad(v, ((0, 0), (WINDOW, WINDOW), (0, 0), (0, 0)))

    def one_block(b):
        start = b * SWA_BLOCK
        qb = lax.dynamic_slice_in_dim(q, start, SWA_BLOCK, axis=1)
        kb = lax.dynamic_slice_in_dim(kp, start, span, axis=1)
        vb = lax.dynamic_slice_in_dim(vp, start, span, axis=1)
        qpos = start + jnp.arange(SWA_BLOCK)
        kpos = start - WINDOW + jnp.arange(span)
        ok = (jnp.abs(qpos[:, None] - kpos[None, :]) <= WINDOW) & (kpos[None, :] >= 0) & (kpos[None, :] < L)
        s_loc = jnp.einsum('bqhgd,bkhd->bhgqk', qb, kb).astype(F32) * scale
        s_loc = jnp.where(ok, s_loc, -jnp.inf)
        s_ctx = jnp.einsum('bqhgd,bchd->bhgqc', qb, kc).astype(F32) * scale
        p = sink_softmax(jnp.concatenate([s_loc, s_ctx], axis=-1), sink).astype(v.dtype)
        return (jnp.einsum('bhgqk,bkhd->bqhgd', p[..., :span], vb)
                + jnp.einsum('bhgqc,bchd->bqhgd', p[..., span:], vc))

    o = lax.map(one_block, jnp.arange(n_blk))
    return jnp.moveaxis(o, 0, 1).reshape(bsz, L, SWA_HEADS * HEAD_DIM)


def context_attention(qc, kc, vc, sink):
    bsz, Lc = qc.shape[0], qc.shape[1]
    s = jnp.einsum('bqhgd,bchd->bhgqc', qc, kc).astype(F32) * (HEAD_DIM ** -0.5)
    p = sink_softmax(s, sink).astype(vc.dtype)
    return jnp.einsum('bhgqc,bchd->bqhgd', p, vc).reshape(bsz, Lc, SWA_HEADS * HEAD_DIM)


def split_swa(p):
    bsz, L = p.shape[0], p.shape[1]
    o1 = E_HY_COLS
    o2 = o1 + E_Q_COLS
    o3 = o2 + E_KV_COLS
    q = p[..., o1:o2].reshape(bsz, L, SWA_HEADS, HEAD_DIM)
    k = p[..., o2:o3].reshape(bsz, L, SWA_KV_HEADS, HEAD_DIM)
    v = p[..., o3:].reshape(bsz, L, SWA_KV_HEADS, HEAD_DIM)
    return q, k, v


def even_mixer(h_lat, h_ctx, w_in, w_out, hy_conv, hy_w1, hy_b1, hy_w2, hy_b2, hy_freq, hy_w3,
               hy_decay, hy_bias, sink, ctx_out):
    bsz, L = h_lat.shape[0], h_lat.shape[1]
    Lc = h_ctx.shape[1]
    p_lat = h_lat @ w_in
    p_ctx = h_ctx @ w_in
    sink_g = sink.reshape(SWA_KV_HEADS, SWA_GROUP)
    q, k, v = split_swa(p_lat)
    qc, kc, vc = split_swa(p_ctx)
    q = axial_rope(q).reshape(bsz, L, SWA_KV_HEADS, SWA_GROUP, HEAD_DIM)
    k = axial_rope(k)
    y_a = hyena_mixer(p_lat[..., :E_HY_COLS], hy_conv, hy_w1, hy_b1, hy_w2, hy_b2, hy_freq, hy_w3,
                      hy_decay, hy_bias)
    y_b = windowed_attention_latent(q, k, v, kc, vc, sink_g)
    y_lat = jnp.concatenate([y_a, y_b], axis=-1) @ w_out
    if not ctx_out:
        return y_lat, None
    yc_a = hyena_mixer(p_ctx[..., :E_HY_COLS], hy_conv, hy_w1, hy_b1, hy_w2, hy_b2, hy_freq, hy_w3,
                       hy_decay, hy_bias)
    yc_b = context_attention(qc.reshape(bsz, Lc, SWA_KV_HEADS, SWA_GROUP, HEAD_DIM), kc, vc, sink_g)
    y_ctx = jnp.concatenate([yc_a, yc_b], axis=-1) @ w_out
    return y_lat, y_ctx


def _heads(t):
    return t.astype(F32).reshape(t.shape[0], t.shape[1], RW_HEADS, RW_HEAD)


def rwkv7_features(p, mu, w0, w2, a0, a2, g2, k_k, k_a):
    bsz, L = p.shape[0], p.shape[1]
    pp = jnp.pad(p, ((0, 0), (1, 1), (0, 0)))
    p = p + mu * (0.5 * (pp[:, :-2] + pp[:, 2:]) - p)
    o1, o2, o3 = RW_W, 2 * RW_W, 3 * RW_W
    o4 = o3 + 2 * RW_DECAY_LORA
    o5 = o4 + 2 * RW_AAA_LORA
    r, k, v = p[..., :o1], p[..., o1:o2], p[..., o2:o3]
    wd = p[..., o3:o4].reshape(bsz, L, 2, RW_DECAY_LORA)
    ad = p[..., o4:o5].reshape(bsz, L, 2, RW_AAA_LORA)
    gd = p[..., o5:]
    w_log = -jax.nn.softplus(-(w0 + jnp.einsum('bldr,drc->bldc', jnp.tanh(wd), w2))) - 0.5
    decay = jnp.exp(-jnp.exp(w_log.astype(F32)))
    a = jax.nn.sigmoid(a0 + jnp.einsum('bldr,drc->bldc', ad, a2))
    g = jax.nn.sigmoid(gd) @ g2
    kk = l2_normalize((k * k_k).reshape(bsz, L, RW_HEADS, RW_HEAD)).reshape(bsz, L, RW_W)
    k_dir = k[:, :, None] * (1.0 + (a - 1.0) * k_a)
    b_dir = kk[:, :, None] * a
    return r, v, g, kk, decay, k_dir, b_dir


def rwkv7_scan(r, decay, k, v, kk, b, s0, reverse):
    def step(S, inp):
        r_t, w_t, k_t, v_t, kk_t, b_t = inp
        sa = jnp.einsum('bhvk,bhk->bhv', S, kk_t)
        S = S * w_t[:, :, None, :] - sa[..., None] * b_t[:, :, None, :] + v_t[..., None] * k_t[:, :, None, :]
        return S, jnp.einsum('bhvk,bhk->bhv', S, r_t)

    xs = tuple(jnp.moveaxis(t, 1, 0) for t in (r, decay, k, v, kk, b))
    S, ys = lax.scan(step, s0, xs, reverse=reverse)
    return jnp.moveaxis(ys, 0, 1), S


def rwkv7_direction(f_lat, f_ctx, d, s0, r_k):
    reverse = d == 1

    def run(f, s_init):
        r, v, g, kk, decay, k_dir, b_dir = f
        rh, vh, kh = _heads(r), _heads(v), _heads(k_dir[:, :, d])
        y, s = rwkv7_scan(rh, _heads(decay[:, :, d]), kh, vh, _heads(kk), _heads(b_dir[:, :, d]), s_init, reverse)
        bonus = jnp.sum(rh * kh * r_k, -1, keepdims=True) * vh
        return y, bonus, s

    yc, bc, s_ctx = run(f_ctx, s0)
    yl, bl, _ = run(f_lat, s_ctx)
    return yl, bl, yc, bc


def rwkv7_output(y, bonus, g, gn_g, gn_b):
    bsz, L = y.shape[0], y.shape[1]
    mu = jnp.mean(y, -1, keepdims=True)
    var = jnp.mean(jnp.square(y - mu), -1, keepdims=True)
    yn = ((y - mu) * lax.rsqrt(var + RW_GN_EPS)).reshape(bsz, L, RW_W) * gn_g + gn_b
    return ((yn + bonus.reshape(bsz, L, RW_W)) * g).astype(g.dtype)


def rwkv7_mixer(p_lat, p_ctx, mu, w0, w2, a0, a2, g2, k_k, k_a, r_k, gn_g, gn_b, ctx_out):
    f_lat = rwkv7_features(p_lat, mu, w0, w2, a0, a2, g2, k_k, k_a)
    f_ctx = rwkv7_features(p_ctx, mu, w0, w2, a0, a2, g2, k_k, k_a)
    s_zero = jnp.zeros((p_lat.shape[0], RW_HEADS, RW_HEAD, RW_HEAD), F32)
    yl_f, bl_f, yc_f, bc_f = rwkv7_direction(f_lat, f_ctx, 0, s_zero, r_k)
    yl_b, bl_b, yc_b, bc_b = rwkv7_direction(f_lat, f_ctx, 1, s_zero, r_k)
    y_lat = rwkv7_output(yl_f + yl_b, bl_f + bl_b, f_lat[2], gn_g, gn_b)
    y_ctx = rwkv7_output(yc_f + yc_b, bc_f + bc_b, f_ctx[2], gn_g, gn_b) if ctx_out else None
    return y_lat, y_ctx


def gdn_features(p, conv_w, A_log, dt_bias):
    bsz, L = p.shape[0], p.shape[1]
    qkv = jax.nn.silu(centred_conv(p[..., :3 * DN_W], conv_w))
    q, k, v = jnp.split(qkv, 3, axis=-1)
    q = l2_normalize(q.reshape(bsz, L, DN_HEADS, DN_HEAD)) * (DN_HEAD ** -0.5)
    k = l2_normalize(k.reshape(bsz, L, DN_HEADS, DN_HEAD))
    v = v.reshape(bsz, L, DN_HEADS, DN_HEAD).astype(F32)
    z = p[..., 3 * DN_W:4 * DN_W]
    gates = p[..., 4 * DN_W:].astype(F32).reshape(bsz, L, 2, 2, DN_HEADS)
    g_log = -jnp.exp(A_log) * jax.nn.softplus(gates[:, :, 0] + dt_bias)
    beta = jax.nn.sigmoid(gates[:, :, 1])
    return q, k, v, z, g_log, beta


def gdn_chunked(q, k, v, g_log, beta, s0):
    bsz, L = q.shape[0], q.shape[1]
    C = DN_CHUNK
    n = L // C

    def chunks(t):
        return jnp.moveaxis(t.reshape(bsz, n, C, *t.shape[2:]), 2, 3)

    qc, kc, vc = chunks(q), chunks(k), chunks(v)
    G = jnp.cumsum(chunks(g_log), axis=-1)
    bc = chunks(beta)
    causal = jnp.tril(jnp.ones((C, C), bool))
    strict = jnp.tril(jnp.ones((C, C), bool), -1)
    diff = G[..., :, None] - G[..., None, :]
    decay_mat = jnp.where(causal, jnp.exp(jnp.where(causal, diff, 0.0)), 0.0)
    A = jnp.where(strict, bc[..., :, None] * jnp.einsum('bnhid,bnhjd->bnhij', kc, kc) * decay_mat, 0.0)
    T = A + jnp.eye(C, dtype=F32)
    u0 = lax.linalg.triangular_solve(T, bc[..., None] * vc, left_side=True, lower=True, unit_diagonal=True)
    w = lax.linalg.triangular_solve(T, (bc * jnp.exp(G))[..., None] * kc, left_side=True, lower=True,
                                    unit_diagonal=True)
    qk = jnp.einsum('bnhid,bnhjd->bnhij', qc, kc) * decay_mat
    q_dec = qc * jnp.exp(G)[..., None]
    k_dec = kc * jnp.exp(G[..., -1:] - G)[..., None]
    g_end = jnp.exp(G[..., -1])

    def step(S, inp):
        u0_c, w_c, qk_c, q_c, k_c, ge = inp
        u = u0_c - jnp.einsum('bhck,bhkv->bhcv', w_c, S)
        o = jnp.einsum('bhck,bhkv->bhcv', q_c, S) + jnp.einsum('bhij,bhjv->bhiv', qk_c, u)
        S = ge[..., None, None] * S + jnp.einsum('bhck,bhcv->bhkv', k_c, u)
        return S, o

    xs = tuple(jnp.moveaxis(t, 1, 0) for t in (u0, w, qk, q_dec, k_dec, g_end))
    S, o = lax.scan(step, s0, xs)
    o = jnp.moveaxis(jnp.moveaxis(o, 0, 1), 2, 3).reshape(bsz, L, DN_HEADS, DN_HEAD)
    return o, S


def gdn_run(f, d, s0):
    q, k, v, z, g_log, beta = f
    g_d, b_d = g_log[:, :, d], beta[:, :, d]
    if d == 0:
        return gdn_chunked(q, k, v, g_d, b_d, s0)
    flip = lambda t: jnp.flip(t, axis=1)
    o, S = gdn_chunked(flip(q), flip(k), flip(v), flip(g_d), flip(b_d), s0)
    return flip(o), S


def gdn_output(o, z, norm_g):
    bsz, L = o.shape[0], o.shape[1]
    on = o * lax.rsqrt(jnp.mean(o * o, -1, keepdims=True) + 1e-6) * norm_g
    return (on.reshape(bsz, L, DN_W) * jax.nn.silu(z.astype(F32))).astype(z.dtype)


def gdn_mixer(p_lat, p_ctx, conv_w, A_log, dt_bias, norm_g, ctx_out):
    f_lat = gdn_features(p_lat, conv_w, A_log, dt_bias)
    f_ctx = gdn_features(p_ctx, conv_w, A_log, dt_bias)
    s_zero = jnp.zeros((p_lat.shape[0], DN_HEADS, DN_HEAD, DN_HEAD), F32)
    oc_f, sc_f = gdn_run(f_ctx, 0, s_zero)
    ol_f, _ = gdn_run(f_lat, 0, sc_f)
    oc_b, sc_b = gdn_run(f_ctx, 1, s_zero)
    ol_b, _ = gdn_run(f_lat, 1, sc_b)
    y_lat = gdn_output(ol_f + ol_b, f_lat[3], norm_g)
    y_ctx = gdn_output(oc_f + oc_b, f_ctx[3], norm_g) if ctx_out else None
    return y_lat, y_ctx


def odd_mixer(h_lat, h_ctx, w_in, w_out, rw_mu, rw_w0, rw_w2, rw_a0, rw_a2, rw_g2, rw_kk, rw_ka, rw_rk,
              rw_lnx_g, rw_lnx_b, dn_conv, dn_A_log, dn_dt_bias, dn_norm_g, ctx_out):
    p_lat = h_lat @ w_in
    p_ctx = h_ctx @ w_in
    yc_l, yc_c = rwkv7_mixer(p_lat[..., :RW_COLS], p_ctx[..., :RW_COLS], rw_mu, rw_w0, rw_w2, rw_a0, rw_a2,
                             rw_g2, rw_kk, rw_ka, rw_rk, rw_lnx_g, rw_lnx_b, ctx_out)
    yd_l, yd_c = gdn_mixer(p_lat[..., RW_COLS:], p_ctx[..., RW_COLS:], dn_conv, dn_A_log, dn_dt_bias,
                           dn_norm_g, ctx_out)
    y_lat = jnp.concatenate([yc_l, yd_l], axis=-1) @ w_out
    y_ctx = jnp.concatenate([yc_c, yd_c], axis=-1) @ w_out if ctx_out else None
    return y_lat, y_ctx


def setup_inputs(seed: int = 0) -> dict:
    key = jax.random.key(seed)
    keys = iter(jax.random.split(key, 64))

    def normal(shape, std):
        return std * jax.random.normal(next(keys), shape, F32)

    def uniform(shape, lo, hi):
        return jax.random.uniform(next(keys), shape, F32, lo, hi)

    dt = jnp.exp(uniform((N_ODD, 2, DN_HEADS), math.log(1e-3), math.log(1e-1)))
    return {
        "x": normal((BATCH, SEQ, D_MODEL), 1.0),
        "c": normal((BATCH, D_MODEL), 1.0),
        "ctx": normal((BATCH, CTX_LEN, D_MODEL), 1.0),
        "c_ctx": normal((D_MODEL,), 1.0),
        "mod_w": normal((DEPTH, D_MODEL, N_MOD * D_MODEL), 0.5 * D_MODEL ** -0.5),
        "mod_b": normal((DEPTH, N_MOD * D_MODEL), 0.02),
        "ln_g": 1.0 + normal((DEPTH, 2, D_MODEL), 0.02),
        "ln_b": normal((DEPTH, 2, D_MODEL), 0.02),
        "mlp_w1": normal((DEPTH, D_MODEL, D_FF), D_MODEL ** -0.5),
        "mlp_w2": normal((DEPTH, D_FF, D_MODEL), DEEPNORM_BETA * D_FF ** -0.5),
        "e_w_in": normal((N_EVEN, D_MODEL, E_IN_COLS), D_MODEL ** -0.5),
        "e_w_out": normal((N_EVEN, MIX_W, D_MODEL), DEEPNORM_BETA * MIX_W ** -0.5),
        "hy_conv": normal((N_EVEN, HY_SHORT, E_HY_COLS), HY_SHORT ** -0.5),
        "hy_ffn_w1": normal((N_EVEN, HY_PE_DIM, HY_FFN), HY_PE_DIM ** -0.5),
        "hy_ffn_b1": normal((N_EVEN, HY_FFN), 0.1),
        "hy_ffn_w2": normal((N_EVEN, HY_FFN, HY_FFN), HY_FFN ** -0.5),
        "hy_ffn_b2": normal((N_EVEN, HY_FFN), 0.1),
        "hy_sin_freq": 1.0 + normal((N_EVEN, HY_FFN), 0.1),
        "hy_ffn_w3": normal((N_EVEN, HY_FFN, 2 * HY_W), HY_FFN ** -0.5),
        "hy_decay": jnp.linspace(HY_DECAY_MIN, HY_DECAY_MAX, 2 * HY_W, dtype=F32)
                    * (1.0 + normal((N_EVEN, 2 * HY_W), 0.05)),
        "hy_bias": normal((N_EVEN, HY_W), 1.0),
        "attn_sink": normal((N_EVEN, SWA_HEADS), 0.5),
        "o_w_in": normal((N_ODD, D_MODEL, O_IN_COLS), D_MODEL ** -0.5),
        "o_w_out": normal((N_ODD, MIX_W, D_MODEL), DEEPNORM_BETA * MIX_W ** -0.5),
        "rw_mu": 0.5 + normal((N_ODD, RW_COLS), 0.1),
        "rw_w0": jnp.linspace(-6.0, -1.0, RW_W, dtype=F32) + normal((N_ODD, 2, RW_W), 0.1),
        "rw_w2": normal((N_ODD, 2, RW_DECAY_LORA, RW_W), 0.5 * RW_DECAY_LORA ** -0.5),
        "rw_a0": normal((N_ODD, 2, RW_W), 0.1),
        "rw_a2": normal((N_ODD, 2, RW_AAA_LORA, RW_W), 0.5 * RW_AAA_LORA ** -0.5),
        "rw_g2": normal((N_ODD, RW_GATE_LORA, RW_W), RW_GATE_LORA ** -0.5),
        "rw_kk": 0.85 + normal((N_ODD, RW_W), 0.05),
        "rw_ka": 1.0 + normal((N_ODD, RW_W), 0.05),
        "rw_rk": normal((N_ODD, RW_HEADS, RW_HEAD), 0.1),
        "rw_lnx_g": 1.0 + normal((N_ODD, RW_W), 0.02),
        "rw_lnx_b": normal((N_ODD, RW_W), 0.02),
        "dn_conv": normal((N_ODD, DN_SHORT, 3 * DN_W), DN_SHORT ** -0.5),
        "dn_A_log": jnp.log(uniform((N_ODD, 2, DN_HEADS), 1.0, 16.0)),
        "dn_dt_bias": dt + jnp.log(-jnp.expm1(-dt)),
        "dn_norm_g": 1.0 + normal((N_ODD, DN_HEAD), 0.02),
    }


def reference(x, c, ctx, c_ctx, mod_w, mod_b, ln_g, ln_b, mlp_w1, mlp_w2, e_w_in, e_w_out, hy_conv,
              hy_ffn_w1, hy_ffn_b1, hy_ffn_w2, hy_ffn_b2, hy_sin_freq, hy_ffn_w3, hy_decay, hy_bias, attn_sink,
              o_w_in, o_w_out, rw_mu, rw_w0, rw_w2, rw_a0, rw_a2, rw_g2, rw_kk, rw_ka, rw_rk, rw_lnx_g,
              rw_lnx_b, dn_conv, dn_A_log, dn_dt_bias, dn_norm_g):
    alpha = DEEPNORM_ALPHA
    for i in range(DEPTH):
        ctx_out = i != DEPTH - 1
        m_lat = jax.nn.silu(c) @ mod_w[i] + mod_b[i]
        m_ctx = jax.nn.silu(c_ctx) @ mod_w[i] + mod_b[i]
        sh1, sc1, g1, sh2, sc2, g2 = jnp.split(m_lat[:, None, :], N_MOD, axis=-1)
        csh1, csc1, cg1, csh2, csc2, cg2 = jnp.split(m_ctx, N_MOD, axis=-1)
        h_lat = x * (1.0 + sc1) + sh1
        h_ctx = ctx * (1.0 + csc1) + csh1
        j = i // 2
        if i % 2 == 0:
            y_lat, y_ctx = even_mixer(h_lat, h_ctx, e_w_in[j], e_w_out[j], hy_conv[j], hy_ffn_w1[j], hy_ffn_b1[j],
                                      hy_ffn_w2[j], hy_ffn_b2[j], hy_sin_freq[j], hy_ffn_w3[j], hy_decay[j],
                                      hy_bias[j], attn_sink[j], ctx_out)
        else:
            y_lat, y_ctx = odd_mixer(h_lat, h_ctx, o_w_in[j], o_w_out[j], rw_mu[j], rw_w0[j], rw_w2[j], rw_a0[j],
                                     rw_a2[j], rw_g2[j], rw_kk[j], rw_ka[j], rw_rk[j], rw_lnx_g[j], rw_lnx_b[j],
                                     dn_conv[j], dn_A_log[j], dn_dt_bias[j], dn_norm_g[j], ctx_out)
        x = layer_norm(alpha * x + g1 * y_lat, ln_g[i, 0], ln_b[i, 0])
        x = layer_norm(alpha * x + g2 * sq_relu_mlp(x * (1.0 + sc2) + sh2, mlp_w1[i], mlp_w2[i]),
                       ln_g[i, 1], ln_b[i, 1])
        if ctx_out:
            ctx = layer_norm(alpha * ctx + cg1 * y_ctx, ln_g[i, 0], ln_b[i, 0])
            ctx = layer_norm(alpha * ctx + cg2 * sq_relu_mlp(ctx * (1.0 + csc2) + csh2, mlp_w1[i], mlp_w2[i]),
                             ln_g[i, 1], ln_b[i, 1])
    return x
```

```cpp
#include <hip/hip_runtime.h>
#include <hip/hip_cooperative_groups.h>
#include <cstdio>
#include <cstdint>
namespace cg = cooperative_groups;

typedef unsigned short u16;
typedef __attribute__((ext_vector_type(8))) short bf16x8;
typedef __attribute__((ext_vector_type(4))) float f32x4;
typedef __attribute__((ext_vector_type(16))) float f32x16;

#define DEV __device__ __forceinline__

constexpr int NLAT = 65536, NCTX = 8192, NTOK = 73728;
constexpr int PS0 = 2304;
constexpr int PS1 = 4096;
constexpr int DNO = 1920;
constexpr float ALPHA = 1.4142135623730951f;

constexpr size_t OFF_WIN0 = 0;
constexpr size_t OFF_WOUT0 = OFF_WIN0 + (size_t)2304 * 1024 * 2;
constexpr size_t OFF_W1_0 = OFF_WOUT0 + (size_t)1024 * 1024 * 2;
constexpr size_t OFF_W1_1 = OFF_W1_0 + (size_t)4096 * 1024 * 2;
constexpr size_t OFF_W2_0 = OFF_W1_1 + (size_t)4096 * 1024 * 2;
constexpr size_t OFF_W2_1 = OFF_W2_0 + (size_t)4096 * 1024 * 2;
constexpr size_t OFF_WIN1 = OFF_W2_1 + (size_t)4096 * 1024 * 2;
constexpr size_t OFF_WOUT1 = OFF_WIN1 + (size_t)4096 * 1024 * 2;
constexpr size_t OFF_MODV = OFF_WOUT1 + (size_t)1024 * 1024 * 2;
constexpr size_t OFF_KR2048 = OFF_MODV + (size_t)2 * 33 * 6144 * 4;
constexpr size_t OFF_KR256 = OFF_KR2048 + (size_t)512 * 4096 * 2;
constexpr size_t OFF_ROPE = OFF_KR256 + (size_t)512 * 512 * 2;
constexpr size_t OFF_BSUM = OFF_ROPE + 8192;
constexpr size_t OFF_X = (size_t)64 << 20;
constexpr size_t OFF_HY = OFF_X + (size_t)NTOK * 1024 * 2;
constexpr size_t OFF_BIG = OFF_HY + (size_t)NTOK * 1024 * 2;
constexpr size_t WS_NEED = OFF_BIG + (size_t)NTOK * 4096 * 2;
static_assert(OFF_BSUM + (size_t)65536 * 16 * 4 <= OFF_X, "ws map");
constexpr size_t SO_U = 0;
constexpr size_t SO_X0 = SO_U + (size_t)512 * 32 * 2048 * 2;
constexpr size_t SO_UC = SO_X0 + (size_t)512 * 32 * 2048 * 2;
constexpr size_t SO_X0C = SO_UC + (size_t)512 * 32 * 256 * 2;

struct Params {
  const float *x, *c, *ctx, *c_ctx, *mod_w, *mod_b, *ln_g, *ln_b, *mlp_w1, *mlp_w2, *e_w_in, *e_w_out, *hy_conv,
      *hy_w1, *hy_b1, *hy_w2, *hy_b2, *hy_freq, *hy_w3, *hy_decay, *hy_bias, *attn_sink, *o_w_in, *o_w_out,
      *rw_mu, *rw_w0, *rw_w2, *rw_a0, *rw_a2, *rw_g2, *rw_kk, *rw_ka, *rw_rk, *rw_lnx_g, *rw_lnx_b,
      *dn_conv, *dn_A_log, *dn_dt_bias, *dn_norm_g;
  float* out;
  char* ws;
};

DEV u16 f2bf(float f) { unsigned u = __float_as_uint(f); u += 0x7fffu + ((u >> 16) & 1u); return (u16)(u >> 16); }
DEV float bf2f(u16 h) { return __uint_as_float(((unsigned)h) << 16); }
DEV float bflo(unsigned u) { return __uint_as_float(u << 16); }
DEV float bfhi(unsigned u) { return __uint_as_float(u & 0xffff0000u); }
DEV unsigned pack2(float a, float b) { return (unsigned)f2bf(a) | ((unsigned)f2bf(b) << 16); }
DEV void unpack8(const uint4& v, float* f) {
  f[0] = bflo(v.x); f[1] = bfhi(v.x); f[2] = bflo(v.y); f[3] = bfhi(v.y);
  f[4] = bflo(v.z); f[5] = bfhi(v.z); f[6] = bflo(v.w); f[7] = bfhi(v.w);
}
DEV uint4 pack8(const float* f) {
  uint4 v; v.x = pack2(f[0], f[1]); v.y = pack2(f[2], f[3]); v.z = pack2(f[4], f[5]); v.w = pack2(f[6], f[7]); return v;
}
DEV int modrow(int r) { return r < NLAT ? (r >> 11) : 32; }
DEV float sigm(float x) { return 1.f / (1.f + __expf(-x)); }
DEV float silu(float x) { return x / (1.f + __expf(-x)); }
DEV float softplus(float x) { return fmaxf(x, 0.f) + __logf(1.f + __expf(-fabsf(x))); }
DEV float fast_tanh(float x) { return 1.f - 2.f / (1.f + __expf(2.f * x)); }
DEV float wave_sum(float v) {
#pragma unroll
  for (int o = 32; o > 0; o >>= 1) v += __shfl_xor(v, o, 64);
  return v;
}

DEV void transpose_tile(const float* __restrict__ src, int K, int N, int Npad, u16* __restrict__ dst, int tile,
                               u16* sm) {
  const int tid = threadIdx.x;
  const int ntn = Npad >> 6;
  const int tk = tile / ntn, tn = tile - tk * ntn;
  const int n = tid & 63, kq = tid >> 6;
  const int gn = tn * 64 + n;
#pragma unroll 4
  for (int i = 0; i < 16; ++i) {
    int k = kq + 4 * i;
    float v = (gn < N) ? src[(size_t)(tk * 64 + k) * N + gn] : 0.f;
    sm[n * 66 + k] = f2bf(v);
  }
  __syncthreads();
  const int n2 = tid >> 2, q = tid & 3;
  const unsigned* s32 = (const unsigned*)sm + (n2 * 66 + q * 16) / 2;
  uint4 a, b;
  a.x = s32[0]; a.y = s32[1]; a.z = s32[2]; a.w = s32[3];
  b.x = s32[4]; b.y = s32[5]; b.z = s32[6]; b.w = s32[7];
  u16* d = dst + (size_t)(tn * 64 + n2) * K + tk * 64 + q * 16;
  *(uint4*)d = a;
  *(uint4*)(d + 8) = b;
  __syncthreads();
}

DEV void modv_item(const Params& p, int it, float* sl) {
  const int tid = threadIdx.x;
  const int l = it / 288, rem = it % 288, cc = rem / 3, rg = rem % 3;
  for (int idx = tid; idx < 11 * 1024; idx += 256) {
    int r = rg * 11 + (idx >> 10), k = idx & 1023;
    float cv = (r < 32) ? p.c[r * 1024 + k] : p.c_ctx[k];
    sl[idx] = cv / (1.f + expf(-cv));
  }
  __syncthreads();
  const int cl = tid & 63, kg = tid >> 6;
  const int col = cc * 64 + cl;
  float acc[11];
#pragma unroll
  for (int r = 0; r < 11; ++r) acc[r] = 0.f;
  const float* w = p.mod_w + (size_t)l * 1024 * 6144 + (size_t)(kg * 256) * 6144 + col;
#pragma unroll 8
  for (int k = 0; k < 256; ++k) {
    float wv = w[(size_t)k * 6144];
#pragma unroll
    for (int r = 0; r < 11; ++r) acc[r] += sl[r * 1024 + kg * 256 + k] * wv;
  }
  __syncthreads();
  float* red = sl;
#pragma unroll
  for (int r = 0; r < 11; ++r) red[(kg * 11 + r) * 64 + cl] = acc[r];
  __syncthreads();
  for (int idx = tid; idx < 11 * 64; idx += 256) {
    int r = idx >> 6, c2 = idx & 63;
    float v = red[(0 * 11 + r) * 64 + c2] + red[(1 * 11 + r) * 64 + c2] + red[(2 * 11 + r) * 64 + c2] + red[(3 * 11 + r) * 64 + c2];
    int gcol = cc * 64 + c2;
    ((float*)(p.ws + OFF_MODV))[(size_t)(l * 33 + rg * 11 + r) * 6144 + gcol] = v + p.mod_b[l * 6144 + gcol];
  }
  __syncthreads();
}

DEV void filter_item(const Params& p, int it, float* sm) {
  const int L = it < 2048 ? 2048 : 256;
  const int t = it < 2048 ? it : it - 2048;
  u16* R = (u16*)(p.ws + (L == 2048 ? OFF_KR2048 : OFF_KR256));
  float* pe = sm; float* h1 = sm + 64; float* h2 = sm + 128;
  const int tid = threadIdx.x;
  const float tn = (float)t / (float)(L - 1);
  if (tid < 33) {
    float v;
    if (tid == 0) v = tn;
    else {
      int i = (tid - 1) & 15;
      double band = 1e-4 + (double)i * ((15.0 - 1e-4) / 15.0);
      double ang = 2.0 * 3.14159265358979323846 * (double)t * band / (double)L;
      v = (tid <= 16) ? (float)cos(ang) : (float)(-sin(ang));
    }
    pe[tid] = v;
  }
  __syncthreads();
  if (tid < 64) {
    float acc = p.hy_b1[tid];
#pragma unroll 11
    for (int i = 0; i < 33; ++i) acc += pe[i] * p.hy_w1[i * 64 + tid];
    h1[tid] = sinf(p.hy_freq[tid] * acc);
  }
  __syncthreads();
  if (tid < 64) {
    float acc = p.hy_b2[tid];
#pragma unroll 16
    for (int i = 0; i < 64; ++i) acc += h1[i] * p.hy_w2[i * 64 + tid];
    h2[tid] = sinf(p.hy_freq[tid] * acc);
  }
  __syncthreads();
#pragma unroll 1
  for (int q = 0; q < 4; ++q) {
    int o = tid + 256 * q;
    float acc = 0.f;
#pragma unroll 16
    for (int i = 0; i < 64; ++i) acc += h2[i] * p.hy_w3[i * 1024 + o];
    float val = acc * expf(-tn * fabsf(p.hy_decay[o]));
    if (o < 512) {
      if (t == 0) val += p.hy_bias[o];
      R[(size_t)o * 2 * L + L - t] = f2bf(val);
    } else {
      int c = o - 512;
      if (t >= 1) R[(size_t)c * 2 * L + L + t] = f2bf(val);
      else R[(size_t)c * 2 * L] = 0;
    }
  }
  __syncthreads();
}

DEV void phase_prep(const Params& p, char* smem) {
  constexpr int T_IN0 = 16 * 36, T_OUT = 16 * 16, T_W = 16 * 64;
  constexpr int E0 = T_IN0, E1 = E0 + T_OUT, E2 = E1 + T_W, E3 = E2 + T_W, E4 = E3 + T_W, E5 = E4 + T_W,
                E6 = E5 + T_W, E7 = E6 + T_OUT, E8 = E7 + 576, E9 = E8 + 2304, E10 = E9 + 1;
  for (int it = blockIdx.x; it < E10; it += gridDim.x) {
    if (it < E0) transpose_tile(p.e_w_in, 1024, 2304, 2304, (u16*)(p.ws + OFF_WIN0), it, (u16*)smem);
    else if (it < E1) transpose_tile(p.e_w_out, 1024, 1024, 1024, (u16*)(p.ws + OFF_WOUT0), it - E0, (u16*)smem);
    else if (it < E2) transpose_tile(p.mlp_w1, 1024, 4096, 4096, (u16*)(p.ws + OFF_W1_0), it - E1, (u16*)smem);
    else if (it < E3) transpose_tile(p.mlp_w1 + (size_t)1024 * 4096, 1024, 4096, 4096, (u16*)(p.ws + OFF_W1_1), it - E2, (u16*)smem);
    else if (it < E4) transpose_tile(p.mlp_w2, 4096, 1024, 1024, (u16*)(p.ws + OFF_W2_0), it - E3, (u16*)smem);
    else if (it < E5) transpose_tile(p.mlp_w2 + (size_t)1024 * 4096, 4096, 1024, 1024, (u16*)(p.ws + OFF_W2_1), it - E4, (u16*)smem);
    else if (it < E6) transpose_tile(p.o_w_in, 1024, 3984, 4096, (u16*)(p.ws + OFF_WIN1), it - E5, (u16*)smem);
    else if (it < E7) transpose_tile(p.o_w_out, 1024, 1024, 1024, (u16*)(p.ws + OFF_WOUT1), it - E6, (u16*)smem);
    else if (it < E8) modv_item(p, it - E7, (float*)smem);
    else if (it < E9) filter_item(p, it - E8, (float*)smem);
    else {
      float2* tab = (float2*)(p.ws + OFF_ROPE);
      for (int q = 0; q < 4; ++q) {
        int e = threadIdx.x * 4 + q;
        int pos = e >> 4, i = e & 15;
        float inv = powf(10000.f, -(float)i / 16.f);
        float ang = (float)pos * inv;
        tab[e] = make_float2(cosf(ang), sinf(ang));
      }
    }
  }
}

DEV void phase_init(const Params& p) {
  const float* mv = (const float*)(p.ws + OFF_MODV);
  u16* X = (u16*)(p.ws + OFF_X);
  u16* HM = (u16*)(p.ws + OFF_HY);
  const size_t total = (size_t)NTOK * 128;
  for (size_t i = (size_t)blockIdx.x * 256 + threadIdx.x; i < total; i += (size_t)gridDim.x * 256) {
    int r = (int)(i >> 7), c8 = (int)(i & 127) * 8;
    const float* src = r < NLAT ? p.x + (size_t)r * 1024 + c8 : p.ctx + (size_t)(r - NLAT) * 1024 + c8;
    float4 v0 = *(const float4*)src, v1 = *(const float4*)(src + 4);
    const float* m = mv + (size_t)modrow(r) * 6144 + c8;
    float4 h0 = *(const float4*)m, h1 = *(const float4*)(m + 4);
    float4 s0 = *(const float4*)(m + 1024), s1 = *(const float4*)(m + 1028);
    float f[8] = {v0.x, v0.y, v0.z, v0.w, v1.x, v1.y, v1.z, v1.w};
    float sh[8] = {h0.x, h0.y, h0.z, h0.w, h1.x, h1.y, h1.z, h1.w};
    float sc[8] = {s0.x, s0.y, s0.z, s0.w, s1.x, s1.y, s1.z, s1.w};
    float g[8];
#pragma unroll
    for (int j = 0; j < 8; ++j) g[j] = f[j] * (1.f + sc[j]) + sh[j];
    *(uint4*)(X + (size_t)r * 1024 + c8) = pack8(f);
    *(uint4*)(HM + (size_t)r * 1024 + c8) = pack8(g);
  }
}

template <int EPI>
DEV void gemm_phase(const u16* __restrict__ A, int lda, const u16* __restrict__ Bt, int K, int M, int N,
                           u16* __restrict__ C, int ldc, const float* __restrict__ gate, char* smem) {
  const int tid = threadIdx.x, lane = tid & 63, wave = tid >> 6;
  const int wm = wave >> 1, wn = wave & 1;
  const int fr = lane & 15, fq = lane >> 4;
  const int tn = N >> 7, tiles = (M >> 7) * tn;
  const int nk = K >> 6;
  const int drow = wave * 8 + (lane >> 3);
  const int dchunk = (lane & 7) ^ ((drow >> 1) & 7);
  const size_t lda32 = (size_t)lda * 32, ldb32 = (size_t)K * 32;
  const int sw = fr >> 1;
  const bool xcd_order = (gridDim.x & 7) == 0 && ((M >> 7) & 63) == 0;
  const int per_xcd = tiles >> 3;
  const int nloc = gridDim.x >> 3;
  for (int it = blockIdx.x; it < tiles; it += gridDim.x) {
    int tm_i, tn_i;
    if (xcd_order) {
      const int x = it & 7;
      const int local = it >> 3;
      const int mg = local / (8 * tn), r = local - mg * 8 * tn;
      tn_i = r >> 3;
      tm_i = x * (per_xcd / tn) + mg * 8 + (r & 7);
    } else { tm_i = it / tn; tn_i = it - tm_i * tn; }
    const int m0 = tm_i << 7, n0 = tn_i << 7;
    const u16* ag = A + (size_t)(m0 + drow) * lda + dchunk * 8;
    const u16* bg = Bt + (size_t)(n0 + drow) * K + dchunk * 8;
    f32x4 acc[4][4];
#pragma unroll
    for (int i = 0; i < 4; ++i)
#pragma unroll
      for (int j = 0; j < 4; ++j) acc[i][j] = (f32x4){0.f, 0.f, 0.f, 0.f};
#define G_ISSUE(KT, ST)                                                                                  \
  {                                                                                                      \
    const u16* a2 = ag + (KT)*64;                                                                        \
    const u16* b2 = bg + (KT)*64;                                                                        \
    char* la = smem + (ST)*32768 + wave * 1024;                                                          \
    _Pragma("unroll") for (int j = 0; j < 4; ++j) {                                                      \
      __builtin_amdgcn_global_load_lds((const unsigned*)(a2 + j * lda32), (unsigned*)(la + j * 4096), 16, 0, 0);          \
      __builtin_amdgcn_global_load_lds((const unsigned*)(b2 + j * ldb32), (unsigned*)(la + 16384 + j * 4096), 16, 0, 0);  \
    }                                                                                                    \
  }
    G_ISSUE(0, 0)
    for (int kt = 0; kt < nk; ++kt) {
      asm volatile("s_waitcnt vmcnt(0)" ::: "memory");
      __syncthreads();
      if (kt + 1 < nk) G_ISSUE(kt + 1, (kt + 1) & 1)
      const u16* As = (const u16*)(smem + (kt & 1) * 32768);
      const u16* Bs = As + 8192;
#pragma unroll
      for (int ks = 0; ks < 2; ++ks) {
        bf16x8 af[4], bfr[4];
        const int pos = ((ks * 4 + fq) ^ sw) * 8;
#pragma unroll
        for (int i = 0; i < 4; ++i) {
          af[i] = *(const bf16x8*)(As + (wm * 64 + i * 16 + fr) * 64 + pos);
          bfr[i] = *(const bf16x8*)(Bs + (wn * 64 + i * 16 + fr) * 64 + pos);
        }
        __builtin_amdgcn_s_setprio(1);
#pragma unroll
        for (int i = 0; i < 4; ++i)
#pragma unroll
          for (int j = 0; j < 4; ++j)
            acc[i][j] = __builtin_amdgcn_mfma_f32_16x16x32_bf16(af[i], bfr[j], acc[i][j], 0, 0, 0);
        __builtin_amdgcn_s_setprio(0);
      }
    }
#undef G_ISSUE
    __syncthreads();
    u16* Cs = (u16*)smem;
#pragma unroll
    for (int i = 0; i < 4; ++i)
#pragma unroll
      for (int j = 0; j < 4; ++j)
#pragma unroll
        for (int e = 0; e < 4; ++e) {
          float v = acc[i][j][e];
          if (EPI == 1) { v = fmaxf(v, 0.f); v = v * v; }
          Cs[(wm * 64 + i * 16 + fq * 4 + e) * 136 + wn * 64 + j * 16 + fr] = f2bf(v);
        }
    __syncthreads();
#pragma unroll 2
    for (int q = 0; q < 8; ++q) {
      const int chunk = tid + q * 256;
      const int row = chunk >> 4, cc = chunk & 15;
      uint4 cv = *(const uint4*)(Cs + row * 136 + cc * 8);
      u16* dst = C + (size_t)(m0 + row) * ldc + n0 + cc * 8;
      if (EPI == 2) {
        float a[8], xo[8], y[8];
        unpack8(cv, a);
        unpack8(*(const uint4*)dst, xo);
        const float* gr = gate + (size_t)modrow(m0 + row) * 6144 + n0 + cc * 8;
        float4 g0 = *(const float4*)gr, g1 = *(const float4*)(gr + 4);
        float gg[8] = {g0.x, g0.y, g0.z, g0.w, g1.x, g1.y, g1.z, g1.w};
#pragma unroll
        for (int j = 0; j < 8; ++j) y[j] = ALPHA * xo[j] + gg[j] * a[j];
        cv = pack8(y);
      }
      *(uint4*)dst = cv;
    }
    __syncthreads();
  }
}

template <bool FINAL>
DEV void ln_phase(const Params& p, int M, const float* __restrict__ g, const float* __restrict__ b,
                         const float* __restrict__ modl  , int shi, int sci) {
  u16* X = (u16*)(p.ws + OFF_X);
  u16* HM = (u16*)(p.ws + OFF_HY);
  const int lane = threadIdx.x & 63;
  const int gw = blockIdx.x * 4 + (threadIdx.x >> 6), nw = gridDim.x * 4;
#pragma unroll 2
  for (int row = gw; row < M; row += nw) {
    u16* xr = X + (size_t)row * 1024;
    float f[16];
    unpack8(*(const uint4*)(xr + lane * 8), f);
    unpack8(*(const uint4*)(xr + 512 + lane * 8), f + 8);
    float s = 0.f, q = 0.f;
#pragma unroll
    for (int j = 0; j < 16; ++j) { s += f[j]; q += f[j] * f[j]; }
#pragma unroll
    for (int o = 32; o > 0; o >>= 1) { s += __shfl_xor(s, o, 64); q += __shfl_xor(q, o, 64); }
    const float mu = s * (1.f / 1024.f);
    const float rs = rsqrtf(fmaxf(q * (1.f / 1024.f) - mu * mu, 0.f) + 1e-5f);
#pragma unroll
    for (int j = 0; j < 16; ++j) f[j] -= mu;
#pragma unroll
    for (int hh = 0; hh < 2; ++hh) {
      const int c0 = hh * 512 + lane * 8;
      float y[8];
#pragma unroll
      for (int j = 0; j < 8; ++j) y[j] = f[hh * 8 + j] * rs * g[c0 + j] + b[c0 + j];
      if (FINAL) {
        float* o = p.out + (size_t)row * 1024 + c0;
        *(float4*)o = make_float4(y[0], y[1], y[2], y[3]);
        *(float4*)(o + 4) = make_float4(y[4], y[5], y[6], y[7]);
      } else {
        *(uint4*)(xr + c0) = pack8(y);
        const float* m = modl + (size_t)modrow(row) * 6144;
        float h[8];
#pragma unroll
        for (int j = 0; j < 8; ++j) h[j] = y[j] * (1.f + m[sci * 1024 + c0 + j]) + m[shi * 1024 + c0 + j];
        *(uint4*)(HM + (size_t)row * 1024 + c0) = pack8(h);
      }
    }
  }
}

DEV void hyprep_item(const Params& p, int it, char* smem) {
  u16* su = (u16*)smem;
  u16* sx = su + 64 * 66;
  const u16* P = (const u16*)(p.ws + OFF_BIG);
  const int tid = threadIdx.x;
  const int ct = it & 7, st = it >> 3;
  int b, t0, L, rowbase;
  u16 *U, *X0;
  if (st < 1024) { b = st >> 5; t0 = (st & 31) * 64; L = 2048; rowbase = b * 2048;
    U = (u16*)((char*)p.out + SO_U); X0 = (u16*)((char*)p.out + SO_X0); }
  else { int s2 = st - 1024; b = s2 >> 2; t0 = (s2 & 3) * 64; L = 256; rowbase = NLAT + b * 256;
    U = (u16*)((char*)p.out + SO_UC); X0 = (u16*)((char*)p.out + SO_X0C); }
  const int c0 = ct * 64;
  {
    const int t = tid >> 2, cq = tid & 3;
    float z[3][16];
#pragma unroll
    for (int g = 0; g < 3; ++g)
#pragma unroll
      for (int j = 0; j < 16; ++j) z[g][j] = 0.f;
#pragma unroll
    for (int tap = 0; tap < 3; ++tap) {
      const int tt = t0 + t + tap - 1;
      if (tt >= 0 && tt < L) {
#pragma unroll
        for (int g = 0; g < 3; ++g) {
          const int col = g * 512 + c0 + cq * 16;
          const u16* src = P + (size_t)(rowbase + tt) * PS0 + col;
          float f[16];
          unpack8(*(const uint4*)src, f);
          unpack8(*(const uint4*)(src + 8), f + 8);
          const float* w = p.hy_conv + tap * 1536 + col;
#pragma unroll
          for (int j = 0; j < 16; ++j) z[g][j] += f[j] * w[j];
        }
      }
    }
#pragma unroll
    for (int j = 0; j < 16; ++j) {
      su[t * 66 + cq * 16 + j] = f2bf(z[1][j] * z[2][j]);
      sx[t * 66 + cq * 16 + j] = f2bf(z[0][j]);
    }
  }
  __syncthreads();
  {
    const int c = tid >> 2, tq = tid & 3;
    unsigned wu[8], wx[8];
#pragma unroll
    for (int j = 0; j < 8; ++j) {
      wu[j] = (unsigned)su[(tq * 16 + 2 * j) * 66 + c] | ((unsigned)su[(tq * 16 + 2 * j + 1) * 66 + c] << 16);
      wx[j] = (unsigned)sx[(tq * 16 + 2 * j) * 66 + c] | ((unsigned)sx[(tq * 16 + 2 * j + 1) * 66 + c] << 16);
    }
    const size_t o = ((size_t)(c0 + c) * 32 + b) * L + t0 + tq * 16;
    *(uint4*)(U + o) = make_uint4(wu[0], wu[1], wu[2], wu[3]);
    *(uint4*)(U + o + 8) = make_uint4(wu[4], wu[5], wu[6], wu[7]);
    *(uint4*)(X0 + o) = make_uint4(wx[0], wx[1], wx[2], wx[3]);
    *(uint4*)(X0 + o + 8) = make_uint4(wx[4], wx[5], wx[6], wx[7]);
  }
  __syncthreads();
}

DEV void rope_item(const Params& p, int it) {
  u16* P = (u16*)(p.ws + OFF_BIG);
  const float2* tab = (const float2*)(p.ws + OFF_ROPE);
  const int task = it * 256 + threadIdx.x;
  const int row = task / 40, rem = task - row * 40;
  const int head = rem >> 2, pr = rem & 3;
  const int d0 = (pr >> 1) * 32 + (pr & 1) * 8;
  const int t = row & 2047;
  const int posc = (pr >> 1) ? (t & 63) : (t >> 6);
  const int fi0 = (pr & 1) * 8;
  u16* ptr = P + (size_t)row * PS0 + 1536 + head * 64 + d0;
  float u1[8], u2[8], o1[8], o2[8];
  unpack8(*(const uint4*)ptr, u1);
  unpack8(*(const uint4*)(ptr + 16), u2);
#pragma unroll
  for (int j = 0; j < 8; ++j) {
    float2 cs = tab[posc * 16 + fi0 + j];
    o1[j] = u1[j] * cs.x - u2[j] * cs.y;
    o2[j] = u1[j] * cs.y + u2[j] * cs.x;
  }
  *(uint4*)ptr = pack8(o1);
  *(uint4*)(ptr + 16) = pack8(o2);
}

DEV void phase_hyprep_rope(const Params& p, char* smem) {
  constexpr int NH = 9216, NR = 10240;
  for (int it = blockIdx.x; it < NH + NR; it += gridDim.x) {
    if (it < NH) hyprep_item(p, it, smem);
    else rope_item(p, it - NH);
  }
}

template <int L, int NT>
DEV void conv_item(const Params& p, int c, int th, char* smem) {
  const u16* R = (const u16*)(p.ws + (L == 2048 ? OFF_KR2048 : OFF_KR256)) + (size_t)c * 2 * L;
  const u16* U = (const u16*)((const char*)p.out + (L == 2048 ? SO_U : SO_UC));
  const u16* X0 = (const u16*)((const char*)p.out + (L == 2048 ? SO_X0 : SO_X0C));
  u16* Y = (u16*)(p.ws + OFF_HY);
  u16* Rs0 = (u16*)smem;
  u16* Rs1 = Rs0 + 2 * L + 8;
  const int tid = threadIdx.x, lane = tid & 63, wave = tid >> 6;
  for (int i = tid; i < 2 * L; i += 256) {
    Rs0[i] = R[i];
    Rs1[i] = (i + 1 < 2 * L) ? R[i + 1] : (u16)0;
  }
  __syncthreads();
  const int r = lane & 31, h = lane >> 5;
  const char* lanebase = (r & 1) ? (const char*)Rs1 + 2 * (8 * h - r + L - 1) : (const char*)Rs0 + 2 * (8 * h - r + L);
  const u16* Ub = U + ((size_t)c * 32 + r) * L + 8 * h;
  const int tw0 = th * 1024 + wave * NT * 32;
  f32x16 acc[NT];
#pragma unroll
  for (int i = 0; i < NT; ++i)
#pragma unroll
    for (int e = 0; e < 16; ++e) acc[i][e] = 0.f;
  uint4 nb = *(const uint4*)Ub;
  for (int st = 0; st < L / 16; ++st) {
    uint4 cur = nb;
    if (st + 1 < L / 16) nb = *(const uint4*)(Ub + (st + 1) * 16);
    bf16x8 bfrag = *(bf16x8*)&cur;
#pragma unroll
    for (int i = 0; i < NT; ++i) {
      const unsigned* ap = (const unsigned*)(lanebase + 2 * (st * 16 - (tw0 + i * 32)));
      uint4 av = make_uint4(ap[0], ap[1], ap[2], ap[3]);
      acc[i] = __builtin_amdgcn_mfma_f32_32x32x16_bf16(*(bf16x8*)&av, bfrag, acc[i], 0, 0, 0);
    }
  }
  const int rowbase = (L == 2048) ? r * 2048 : NLAT + r * 256;
#pragma unroll
  for (int i = 0; i < NT; ++i) {
#pragma unroll
    for (int g4 = 0; g4 < 4; ++g4) {
      const int tt = tw0 + i * 32 + 8 * g4 + 4 * h;
      uint2 xv = *(const uint2*)(X0 + ((size_t)c * 32 + r) * L + tt);
      float x0[4] = {bflo(xv.x), bfhi(xv.x), bflo(xv.y), bfhi(xv.y)};
#pragma unroll
      for (int e = 0; e < 4; ++e) Y[(size_t)(rowbase + tt + e) * 1024 + c] = f2bf(acc[i][g4 * 4 + e] * x0[e]);
    }
  }
  __syncthreads();
}

DEV void attn_item(const Params& p, int b, int hq, int qb, bool isctx, char* smem) {
  const u16* P = (const u16*)(p.ws + OFF_BIG);
  u16* Y = (u16*)(p.ws + OFF_HY);
  u16* Ks = (u16*)smem;
  u16* Vt = Ks + 64 * 72;
  const int tid = threadIdx.x, lane = tid & 63, wave = tid >> 6;
  const int nq = lane & 15, quad = lane >> 4;
  const int qrow = (isctx ? NLAT + b * 256 : b * 2048) + qb * 64 + wave * 16 + nq;
  const int qpos = qb * 64 + wave * 16 + nq;
  const int hkv = hq >> 2;
  const int kcol = 2048 + hkv * 64, vcol = 2176 + hkv * 64;
  bf16x8 qf[2];
#pragma unroll
  for (int ks = 0; ks < 2; ++ks)
    qf[ks] = *(const bf16x8*)(P + (size_t)qrow * PS0 + 1536 + hq * 64 + ks * 32 + quad * 8);
  float m = p.attn_sink[hq];
  float lsum = (quad == 0) ? 1.f : 0.f;
  f32x4 oacc[4];
#pragma unroll
  for (int n = 0; n < 4; ++n) oacc[n] = (f32x4){0.f, 0.f, 0.f, 0.f};
  const int nloc = isctx ? 0 : 5;
  for (int ti = 0; ti < nloc + 4; ++ti) {
    int krow0, k0 = 0;
    bool masked;
    if (ti < nloc) {
      k0 = qb * 64 - 128 + ti * 64;
      if (k0 < 0 || k0 >= 2048) continue;
      krow0 = b * 2048 + k0; masked = true;
    } else { krow0 = NLAT + b * 256 + (ti - nloc) * 64; masked = false; }
    __syncthreads();
    {
      const int key = tid >> 2, part = tid & 3;
      const u16* kp = P + (size_t)(krow0 + key) * PS0 + kcol + part * 16;
      const u16* vp = P + (size_t)(krow0 + key) * PS0 + vcol + part * 16;
      uint4 k0v = *(const uint4*)kp, k1v = *(const uint4*)(kp + 8);
      uint4 v0v = *(const uint4*)vp, v1v = *(const uint4*)(vp + 8);
      *(uint4*)(Ks + key * 72 + part * 16) = k0v;
      *(uint4*)(Ks + key * 72 + part * 16 + 8) = k1v;
      unsigned vw[8] = {v0v.x, v0v.y, v0v.z, v0v.w, v1v.x, v1v.y, v1v.z, v1v.w};
#pragma unroll
      for (int j = 0; j < 8; ++j) {
        Vt[(part * 16 + 2 * j) * 72 + key] = (u16)(vw[j] & 0xffffu);
        Vt[(part * 16 + 2 * j + 1) * 72 + key] = (u16)(vw[j] >> 16);
      }
    }
    __syncthreads();
    f32x4 s[4];
#pragma unroll
    for (int n = 0; n < 4; ++n) {
      s[n] = (f32x4){0.f, 0.f, 0.f, 0.f};
#pragma unroll
      for (int ks = 0; ks < 2; ++ks) {
        bf16x8 kf = *(const bf16x8*)(Ks + (n * 16 + nq) * 72 + ks * 32 + quad * 8);
        s[n] = __builtin_amdgcn_mfma_f32_16x16x32_bf16(kf, qf[ks], s[n], 0, 0, 0);
      }
    }
    float mx = -1e30f;
#pragma unroll
    for (int n = 0; n < 4; ++n)
#pragma unroll
      for (int e = 0; e < 4; ++e) {
        float v = s[n][e] * 0.125f;
        if (masked) {
          int kpos = k0 + n * 16 + quad * 4 + e;
          int d = qpos - kpos;
          if (d > 128 || d < -128) v = -1e30f;
        }
        s[n][e] = v;
        mx = fmaxf(mx, v);
      }
    mx = fmaxf(mx, __shfl_xor(mx, 16, 64));
    mx = fmaxf(mx, __shfl_xor(mx, 32, 64));
    const float mn = fmaxf(m, mx);
    const float al = __expf(m - mn);
    m = mn;
    float ps = 0.f;
#pragma unroll
    for (int n = 0; n < 4; ++n)
#pragma unroll
      for (int e = 0; e < 4; ++e) { float pv = __expf(s[n][e] - mn); s[n][e] = pv; ps += pv; }
    lsum = lsum * al + ps;
#pragma unroll
    for (int n = 0; n < 4; ++n)
#pragma unroll
      for (int e = 0; e < 4; ++e) oacc[n][e] *= al;
#pragma unroll
    for (int hh = 0; hh < 2; ++hh) {
      uint4 pw;
      pw.x = pack2(s[2 * hh][0], s[2 * hh][1]); pw.y = pack2(s[2 * hh][2], s[2 * hh][3]);
      pw.z = pack2(s[2 * hh + 1][0], s[2 * hh + 1][1]); pw.w = pack2(s[2 * hh + 1][2], s[2 * hh + 1][3]);
      bf16x8 pb = *(bf16x8*)&pw;
#pragma unroll
      for (int n = 0; n < 4; ++n) {
        const u16* vr = Vt + (n * 16 + nq) * 72 + quad * 4;
        uint2 va = *(const uint2*)(vr + (2 * hh) * 16);
        uint2 vb = *(const uint2*)(vr + (2 * hh + 1) * 16);
        uint4 vv = make_uint4(va.x, va.y, vb.x, vb.y);
        oacc[n] = __builtin_amdgcn_mfma_f32_16x16x32_bf16(*(bf16x8*)&vv, pb, oacc[n], 0, 0, 0);
      }
    }
  }
  lsum += __shfl_xor(lsum, 16, 64);
  lsum += __shfl_xor(lsum, 32, 64);
  const float inv = 1.f / lsum;
  u16* yo = Y + (size_t)qrow * 1024 + 512 + hq * 64 + quad * 4;
#pragma unroll
  for (int n = 0; n < 4; ++n) {
    uint2 w;
    w.x = pack2(oacc[n][0] * inv, oacc[n][1] * inv);
    w.y = pack2(oacc[n][2] * inv, oacc[n][3] * inv);
    *(uint2*)(yo + n * 16) = w;
  }
  __syncthreads();
}

DEV void phase_conv_attn(const Params& p, char* smem) {
  constexpr int N0 = 1024, N1 = N0 + 512, N2 = N1 + 8192, N3 = N2 + 1024;
  for (int it = blockIdx.x; it < N3; it += gridDim.x) {
    if (it < N0) conv_item<2048, 8>(p, it >> 1, it & 1, smem);
    else if (it < N1) conv_item<256, 2>(p, it - N0, 0, smem);
    else if (it < N2) { int a = it - N1; attn_item(p, a >> 8, (a >> 5) & 7, a & 31, false, smem); }
    else { int a = it - N2; attn_item(p, a >> 5, (a >> 2) & 7, a & 3, true, smem); }
  }
}

DEV void lds_wave_sync() {
  asm volatile("s_waitcnt lgkmcnt(0)" ::: "memory");
  __builtin_amdgcn_wave_barrier();
}

DEV void rwkv_item(const Params& p, int ri, char* smem) {
  const u16* P = (const u16*)(p.ws + OFF_BIG);
  u16* O4 = (u16*)p.out;
  float* BS = (float*)(p.ws + OFF_BSUM);
  const int tid0 = threadIdx.x;
  const int wp0 = tid0 >> 7;
  const int cid = ri * 2 + wp0;
  const int b = cid >> 4, d = (cid >> 3) & 1, h = cid & 7;
  f32x4 S[4][2];
#pragma unroll
  for (int i = 0; i < 4; ++i)
#pragma unroll
    for (int j = 0; j < 2; ++j) S[i][j] = (f32x4){0.f, 0.f, 0.f, 0.f};
  uint4 bw[2][4];
  float l0[4];
  {
    const int lane = tid0 & 63, wi = (tid0 >> 6) & 1, fr = lane & 15, fq = lane >> 4;
    const float* wsrc = (wi == 0 ? p.rw_w2 : p.rw_a2) + (size_t)d * 64 * 512 + h * 64;
    const float* bsrc = (wi == 0 ? p.rw_w0 : p.rw_a0) + d * 512 + h * 64;
#pragma unroll
    for (int nt = 0; nt < 4; ++nt) {
      l0[nt] = bsrc[nt * 16 + fr];
#pragma unroll
      for (int ks = 0; ks < 2; ++ks) {
        __builtin_amdgcn_sched_barrier(0);
        float f[8];
        const float* wp_ = wsrc + (size_t)(ks * 32 + fq * 8) * 512 + nt * 16 + fr;
#pragma unroll
        for (int j = 0; j < 8; ++j) f[j] = wp_[j * 512];
        bw[ks][nt] = pack8(f);
      }
    }
  }
  uint4 pre[5][3];
#define RW_LOAD(CI)                                                                                 \
  {                                                                                                 \
    const int seg_ = (CI) < 16 ? 0 : 1;                                                             \
    const int ch_ = seg_ ? (CI)-16 : (CI);                                                          \
    const int Ls_ = seg_ ? 2048 : 256;                                                              \
    const int rb_ = seg_ ? b * 2048 : NLAT + b * 256;                                               \
    const int sidx_ = ch_ * 16 + stt;                                                               \
    const int t_ = d == 0 ? sidx_ : Ls_ - 1 - sidx_;                                                \
    const u16* prow_ = P + (size_t)(rb_ + t_) * PS1 + spart * 8;                                    \
    _Pragma("unroll") for (int g = 0; g < 5; ++g) {                                                 \
      const int col_ = g < 3 ? g * 512 + h * 64 : (g == 3 ? 1536 + d * 64 : 1664 + d * 64);         \
      _Pragma("unroll") for (int tap = 0; tap < 3; ++tap) {                                         \
        const int tt_ = t_ + tap - 1;                                                               \
        if (tt_ >= 0 && tt_ < Ls_) pre[g][tap] = *(const uint4*)(prow_ + (ptrdiff_t)(tap - 1) * PS1 + col_); \
        else pre[g][tap] = make_uint4(0u, 0u, 0u, 0u);                                              \
      }                                                                                             \
    }                                                                                               \
  }
  {
    const int pt = tid0 & 127, stt = pt >> 3, spart = pt & 7;
    RW_LOAD(0)
  }
  for (int cidx = 0; cidx < 144; ++cidx) {
    asm volatile("" ::: "memory");
    int tid = tid0;
    asm volatile("" : "+v"(tid));
    const int lane = tid & 63, wave = tid >> 6, wp = wave >> 1, wi = wave & 1, pt = tid & 127;
    const int fr = lane & 15, fq = lane >> 4, stt = pt >> 3, spart = pt & 7;
    const int seg = cidx < 16 ? 0 : 1;
    const int ch = seg ? cidx - 16 : cidx;
    const int Ls = seg ? 2048 : 256;
    char* base = smem + wp * 32768;
    u16* RK = (u16*)base;
    u16* KD = RK + 1152;
    u16* KK = KD + 1152;
    u16* AB = KK + 1152;
    u16* VT = AB + 1152;
    float* LW = (float*)(base + 11264);
    u16* TW = (u16*)(base + 15360);
    u16* AD = TW + 1152;
    u16* BgCT = (u16*)(base + 19968);
    u16* KgCT = BgCT + 1024;
    float* gC = (float*)(base + 24064);
    float* Amat = (float*)(base + 24320) + wi * 256;
    u16* Tinv = (u16*)(base + 26368) + wi * 256;
    u16* BG = (u16*)(base + 27392);
    {
      const int o = stt * 72 + spart * 8;
#pragma unroll
      for (int g = 0; g < 5; ++g) {
        __builtin_amdgcn_sched_barrier(0);
        const int col = g < 3 ? g * 512 + h * 64 : (g == 3 ? 1536 + d * 64 : 1664 + d * 64);
        float pc[8], pp[8], pn[8], v[8];
        unpack8(pre[g][1], pc); unpack8(pre[g][0], pp); unpack8(pre[g][2], pn);
        const float* mu = p.rw_mu + col + spart * 8;
        float4 m0 = *(const float4*)mu, m1 = *(const float4*)(mu + 4);
        const float mm[8] = {m0.x, m0.y, m0.z, m0.w, m1.x, m1.y, m1.z, m1.w};
#pragma unroll
        for (int j = 0; j < 8; ++j) v[j] = pc[j] + mm[j] * (0.5f * (pp[j] + pn[j]) - pc[j]);
        if (g == 0) *(uint4*)(RK + o) = pack8(v);
        else if (g == 1) {
          *(uint4*)(KD + o) = pack8(v);
          const float* kkw = p.rw_kk + h * 64 + spart * 8;
          float kkv[8];
          float ss = 0.f;
#pragma unroll
          for (int j = 0; j < 8; ++j) { kkv[j] = v[j] * kkw[j]; ss += kkv[j] * kkv[j]; }
          ss += __shfl_xor(ss, 1, 64); ss += __shfl_xor(ss, 2, 64); ss += __shfl_xor(ss, 4, 64);
          const float inv = rsqrtf(ss + 1e-6f);
#pragma unroll
          for (int j = 0; j < 8; ++j) kkv[j] *= inv;
          *(uint4*)(KK + o) = pack8(kkv);
        } else if (g == 2) {
#pragma unroll
          for (int j = 0; j < 8; ++j) VT[(spart * 8 + j) * 16 + stt] = f2bf(v[j]);
        } else if (g == 3) {
#pragma unroll
          for (int j = 0; j < 8; ++j) v[j] = fast_tanh(v[j]);
          *(uint4*)(TW + o) = pack8(v);
        } else *(uint4*)(AD + o) = pack8(v);
      }
    }
    __syncthreads();
    if (cidx + 1 < 144) RW_LOAD(cidx + 1)
    {
      const u16* IN = wi == 0 ? TW : AD;
      bf16x8 af0 = *(const bf16x8*)(IN + fr * 72 + fq * 8);
      bf16x8 af1 = *(const bf16x8*)(IN + fr * 72 + 32 + fq * 8);
#pragma unroll
      for (int nt = 0; nt < 4; ++nt) {
        f32x4 o4 = (f32x4){0.f, 0.f, 0.f, 0.f};
        o4 = __builtin_amdgcn_mfma_f32_16x16x32_bf16(af0, *(bf16x8*)&bw[0][nt], o4, 0, 0, 0);
        o4 = __builtin_amdgcn_mfma_f32_16x16x32_bf16(af1, *(bf16x8*)&bw[1][nt], o4, 0, 0, 0);
#pragma unroll
        for (int e = 0; e < 4; ++e) {
          const float prev = l0[nt] + o4[e];
          const int t = fq * 4 + e, c = nt * 16 + fr;
          if (wi == 0) LW[t * 64 + c] = -__expf(-softplus(-prev) - 0.5f);
          else AB[t * 72 + c] = f2bf(sigm(prev));
        }
      }
    }
    __syncthreads();
    {
      const int c = lane;
      float cum = 0.f;
      if (wi == 0) {
#pragma unroll 4
        for (int t = 0; t < 16; ++t) {
          const float lw = LW[t * 64 + c];
          const float gp = __expf(cum);
          cum += lw;
          const float gi = __expf(-cum);
          const float kk = bf2f(KK[t * 72 + c]);
          const float a = bf2f(AB[t * 72 + c]);
          KK[t * 72 + c] = f2bf(kk * gp);
          BG[t * 72 + c] = f2bf(kk * a * gi);
        }
        const float gCv = __expf(cum);
        gC[c] = gCv;
#pragma unroll 4
        for (int t = 0; t < 16; ++t) BgCT[c * 16 + t] = f2bf(-bf2f(BG[t * 72 + c]) * gCv);
      } else {
        float* PR = (float*)TW;
        const float kac = p.rw_ka[h * 64 + c], rkc = p.rw_rk[h * 64 + c];
#pragma unroll 4
        for (int t = 0; t < 16; ++t) {
          const float lw = LW[t * 64 + c];
          cum += lw;
          const float g = __expf(cum), gi = __expf(-cum);
          const float r = bf2f(RK[t * 72 + c]);
          const float k = bf2f(KD[t * 72 + c]);
          const float a = bf2f(AB[t * 72 + c]);
          const float kd = k * (1.f + (a - 1.f) * kac);
          RK[t * 72 + c] = f2bf(r * g);
          KD[t * 72 + c] = f2bf(kd * gi);
          PR[t * 64 + c] = r * kd * rkc;
        }
        const float gCv = __expf(cum);
#pragma unroll 4
        for (int t = 0; t < 16; ++t) KgCT[c * 16 + t] = f2bf(bf2f(KD[t * 72 + c]) * gCv);
        lds_wave_sync();
        {
          const int t = lane >> 2, sg = lane & 3;
          const float4 q0 = *(const float4*)(PR + t * 64 + sg * 16), q1 = *(const float4*)(PR + t * 64 + sg * 16 + 4);
          const float4 q2 = *(const float4*)(PR + t * 64 + sg * 16 + 8), q3 = *(const float4*)(PR + t * 64 + sg * 16 + 12);
          float bsum = (q0.x + q0.y + q0.z + q0.w) + (q1.x + q1.y + q1.z + q1.w) + (q2.x + q2.y + q2.z + q2.w) + (q3.x + q3.y + q3.z + q3.w);
          bsum += __shfl_xor(bsum, 1, 64);
          bsum += __shfl_xor(bsum, 2, 64);
          if (seg == 1 && sg == 0) {
            const int sidx = ch * 16 + t;
            const int tpos = d == 0 ? sidx : 2047 - sidx;
            BS[(size_t)(b * 2048 + tpos) * 16 + h * 2 + d] = bsum;
          }
        }
      }
    }
    __syncthreads();
    __builtin_amdgcn_sched_barrier(0);
    {
      f32x4 XabT = (f32x4){0.f, 0.f, 0.f, 0.f}, XakT = XabT, XrbT = XabT, XrkT = XabT;
#pragma unroll
      for (int ks = 0; ks < 2; ++ks) {
        bf16x8 kkf = *(const bf16x8*)(KK + fr * 72 + ks * 32 + fq * 8);
        bf16x8 rgf = *(const bf16x8*)(RK + fr * 72 + ks * 32 + fq * 8);
        bf16x8 bgf = *(const bf16x8*)(BG + fr * 72 + ks * 32 + fq * 8);
        bf16x8 kgf = *(const bf16x8*)(KD + fr * 72 + ks * 32 + fq * 8);
        XabT = __builtin_amdgcn_mfma_f32_16x16x32_bf16(bgf, kkf, XabT, 0, 0, 0);
        XakT = __builtin_amdgcn_mfma_f32_16x16x32_bf16(kgf, kkf, XakT, 0, 0, 0);
        XrbT = __builtin_amdgcn_mfma_f32_16x16x32_bf16(bgf, rgf, XrbT, 0, 0, 0);
        XrkT = __builtin_amdgcn_mfma_f32_16x16x32_bf16(kgf, rgf, XrkT, 0, 0, 0);
      }
      {
        float am[4];
#pragma unroll
        for (int e = 0; e < 4; ++e) am[e] = (fq * 4 + e < fr) ? XabT[e] : 0.f;
        *(float4*)(Amat + fr * 16 + fq * 4) = make_float4(am[0], am[1], am[2], am[3]);
      }
      lds_wave_sync();
      if (lane < 16) {
        float x[16];
        x[0] = (lane == 0) ? 1.f : 0.f;
        float4 cur[4], nxt[4];
        cur[0] = *(const float4*)(Amat + 16);
        cur[1] = cur[0]; cur[2] = cur[0]; cur[3] = cur[0];
#pragma unroll
        for (int i = 1; i < 16; ++i) {
          __builtin_amdgcn_sched_barrier(0);
          if (i + 1 < 16) {
#pragma unroll
            for (int q = 0; q < (i + 4) / 4; ++q) nxt[q] = *(const float4*)(Amat + (i + 1) * 16 + q * 4);
          }
          float acc = (i == lane) ? 1.f : 0.f;
#pragma unroll
          for (int j = 0; j < i; ++j) {
            const float4 rv = cur[j >> 2];
            const float av = (j & 3) == 0 ? rv.x : ((j & 3) == 1 ? rv.y : ((j & 3) == 2 ? rv.z : rv.w));
            acc -= av * x[j];
          }
          x[i] = acc;
#pragma unroll
          for (int q = 0; q < 4; ++q) cur[q] = nxt[q];
        }
#pragma unroll
        for (int i = 0; i < 16; ++i) Tinv[i * 16 + lane] = f2bf(x[i]);
      }
      lds_wave_sync();
      f32x4 sa0[2], y0[2];
#pragma unroll
      for (int nt = 0; nt < 2; ++nt) { sa0[nt] = (f32x4){0.f, 0.f, 0.f, 0.f}; y0[nt] = (f32x4){0.f, 0.f, 0.f, 0.f}; }
#pragma unroll
      for (int x = 0; x < 2; ++x) {
        __builtin_amdgcn_sched_barrier(0);
        uint2 k0 = *(const uint2*)(KK + fr * 72 + 32 * x + fq * 4);
        uint2 k1 = *(const uint2*)(KK + fr * 72 + 32 * x + 16 + fq * 4);
        uint2 r0 = *(const uint2*)(RK + fr * 72 + 32 * x + fq * 4);
        uint2 r1 = *(const uint2*)(RK + fr * 72 + 32 * x + 16 + fq * 4);
        uint4 kw = make_uint4(k0.x, k0.y, k1.x, k1.y);
        uint4 rw = make_uint4(r0.x, r0.y, r1.x, r1.y);
#pragma unroll
        for (int nt = 0; nt < 2; ++nt) {
          uint4 sw;
          sw.x = pack2(S[2 * x][nt][0], S[2 * x][nt][1]); sw.y = pack2(S[2 * x][nt][2], S[2 * x][nt][3]);
          sw.z = pack2(S[2 * x + 1][nt][0], S[2 * x + 1][nt][1]); sw.w = pack2(S[2 * x + 1][nt][2], S[2 * x + 1][nt][3]);
          sa0[nt] = __builtin_amdgcn_mfma_f32_16x16x32_bf16(*(bf16x8*)&kw, *(bf16x8*)&sw, sa0[nt], 0, 0, 0);
          y0[nt] = __builtin_amdgcn_mfma_f32_16x16x32_bf16(*(bf16x8*)&rw, *(bf16x8*)&sw, y0[nt], 0, 0, 0);
        }
      }
      float ak[4], rb[4], rk[4];
#pragma unroll
      for (int e = 0; e < 4; ++e) {
        const int j = fq * 4 + e;
        ak[e] = (j < fr) ? XakT[e] : 0.f;
        rb[e] = (j <= fr) ? -XrbT[e] : 0.f;
        rk[e] = (j <= fr) ? XrkT[e] : 0.f;
      }
      const uint4 akw = make_uint4(pack2(ak[0], ak[1]), pack2(ak[2], ak[3]), 0u, 0u);
      const uint4 ybw = make_uint4(pack2(rb[0], rb[1]), pack2(rb[2], rb[3]), pack2(rk[0], rk[1]), pack2(rk[2], rk[3]));
      const uint2 tv = *(const uint2*)(Tinv + fr * 16 + fq * 4);
      const uint4 tw = make_uint4(tv.x, tv.y, 0u, 0u);
      uint4 sv[2];
#pragma unroll
      for (int nt = 0; nt < 2; ++nt) {
        const int vc = wi * 32 + nt * 16 + fr;
        const uint2 vt = *(const uint2*)(VT + vc * 16 + fq * 4);
        const uint4 vb = make_uint4(vt.x, vt.y, 0u, 0u);
        f32x4 rhs = __builtin_amdgcn_mfma_f32_16x16x32_bf16(*(bf16x8*)&akw, *(bf16x8*)&vb, sa0[nt], 0, 0, 0);
        const uint4 rw = make_uint4(pack2(rhs[0], rhs[1]), pack2(rhs[2], rhs[3]), 0u, 0u);
        f32x4 sa = __builtin_amdgcn_mfma_f32_16x16x32_bf16(*(bf16x8*)&tw, *(bf16x8*)&rw, (f32x4){0.f, 0.f, 0.f, 0.f}, 0, 0, 0);
        sv[nt] = make_uint4(pack2(sa[0], sa[1]), pack2(sa[2], sa[3]), vt.x, vt.y);
        f32x4 y = __builtin_amdgcn_mfma_f32_16x16x32_bf16(*(bf16x8*)&ybw, *(bf16x8*)&sv[nt], y0[nt], 0, 0, 0);
        if (seg == 1) {
#pragma unroll
          for (int e = 0; e < 4; ++e) {
            const int sidx = ch * 16 + fq * 4 + e;
            const int tpos = d == 0 ? sidx : 2047 - sidx;
            O4[((size_t)d * NLAT + b * 2048 + tpos) * 512 + h * 64 + vc] = f2bf(y[e]);
          }
        }
      }
#pragma unroll
      for (int mt = 0; mt < 4; ++mt) {
        __builtin_amdgcn_sched_barrier(0);
        const float4 g4 = *(const float4*)(gC + mt * 16 + fq * 4);
        const uint2 bv = *(const uint2*)(BgCT + (mt * 16 + fr) * 16 + fq * 4);
        const uint2 kv = *(const uint2*)(KgCT + (mt * 16 + fr) * 16 + fq * 4);
        const uint4 aw = make_uint4(bv.x, bv.y, kv.x, kv.y);
#pragma unroll
        for (int nt = 0; nt < 2; ++nt) {
          S[mt][nt][0] *= g4.x; S[mt][nt][1] *= g4.y; S[mt][nt][2] *= g4.z; S[mt][nt][3] *= g4.w;
          S[mt][nt] = __builtin_amdgcn_mfma_f32_16x16x32_bf16(*(bf16x8*)&aw, *(bf16x8*)&sv[nt], S[mt][nt], 0, 0, 0);
        }
      }
    }
    __syncthreads();
  }
#undef RW_LOAD
}

DEV void gdn_item(const Params& p, int gi, char* smem) {
  const u16* P = (const u16*)(p.ws + OFF_BIG);
  u16* O4 = (u16*)p.out;
  const int tid0 = threadIdx.x;
  const int b = gi >> 3, d = (gi >> 2) & 1, h = gi & 3;
  constexpr int BUFB = 23424;
  f32x4 S[8][2];
#pragma unroll
  for (int i = 0; i < 8; ++i)
#pragma unroll
    for (int j = 0; j < 2; ++j) S[i][j] = (f32x4){0.f, 0.f, 0.f, 0.f};
  const float negA = -__expf(p.dn_A_log[d * 4 + h]);
  const float dtb = p.dn_dt_bias[d * 4 + h];
  uint4 pre[3][3];
  float gpre0 = 0.f, gpre1 = 0.f;
#define GDN_LOAD(CI)                                                                               \
  {                                                                                                \
    const int seg_ = (CI) < 16 ? 0 : 1;                                                            \
    const int ch_ = seg_ ? (CI)-16 : (CI);                                                         \
    const int Ls_ = seg_ ? 2048 : 256;                                                             \
    const int rb_ = seg_ ? b * 2048 : NLAT + b * 256;                                              \
    const int sidx_ = ch_ * 16 + stt;                                                              \
    const int t_ = d == 0 ? sidx_ : Ls_ - 1 - sidx_;                                               \
    const u16* prow_ = P + (size_t)(rb_ + t_) * PS1 + DNO;                                         \
    _Pragma("unroll") for (int g = 0; g < 3; ++g) {                                                \
      const int col_ = g * 512 + h * 128 + spart * 8;                                              \
      _Pragma("unroll") for (int tap = 0; tap < 3; ++tap) {                                        \
        const int tt_ = t_ + tap - 1;                                                              \
        if (tt_ >= 0 && tt_ < Ls_) pre[g][tap] = *(const uint4*)(prow_ + (ptrdiff_t)(tap - 1) * PS1 + col_); \
        else pre[g][tap] = make_uint4(0u, 0u, 0u, 0u);                                             \
      }                                                                                            \
    }                                                                                              \
    if (wave == 0) {                                                                               \
      const int s2_ = ch_ * 16 + fr;                                                               \
      const int t2_ = d == 0 ? s2_ : Ls_ - 1 - s2_;                                                \
      const u16* gr_ = P + (size_t)(rb_ + t2_) * PS1 + DNO + 2048;                                 \
      gpre0 = bf2f(gr_[d * 4 + h]);                                                                \
      gpre1 = bf2f(gr_[8 + d * 4 + h]);                                                            \
    }                                                                                              \
  }
  {
    const int tid = tid0, lane = tid & 63, wave = tid >> 6, fr = lane & 15, stt = tid >> 4, spart = tid & 15;
    GDN_LOAD(0)
  }
  for (int cidx = 0; cidx < 144; ++cidx) {
    asm volatile("" ::: "memory");
    int tid = tid0;
    asm volatile("" : "+v"(tid));
    const int lane = tid & 63, wave = tid >> 6, fr = lane & 15, fq = lane >> 4, stt = tid >> 4, spart = tid & 15;
    char* buf = smem;
    u16* Kb = (u16*)buf;
    u16* Qb = Kb + 16 * 136;
    float* Vf = (float*)(buf + 8704);
    u16* KdT = (u16*)(buf + 17152);
    u16* Tinv = (u16*)(buf + 21248);
    u16* Pm = (u16*)(buf + 21760);
    float* Amat = (float*)(buf + 22272);
    float* Gs = (float*)(buf + 23296);
    float* Bs = Gs + 16;
#pragma unroll
    for (int g = 0; g < 3; ++g) {
      __builtin_amdgcn_sched_barrier(0);
      const int col = g * 512 + h * 128 + spart * 8;
      float z[8];
#pragma unroll
      for (int j = 0; j < 8; ++j) z[j] = 0.f;
#pragma unroll
      for (int tap = 0; tap < 3; ++tap) {
        __builtin_amdgcn_sched_barrier(0);
        float f[8];
        unpack8(pre[g][tap], f);
        const float* w = p.dn_conv + tap * 1536 + col;
        float4 w0 = *(const float4*)w, w1 = *(const float4*)(w + 4);
        z[0] += f[0] * w0.x; z[1] += f[1] * w0.y; z[2] += f[2] * w0.z; z[3] += f[3] * w0.w;
        z[4] += f[4] * w1.x; z[5] += f[5] * w1.y; z[6] += f[6] * w1.z; z[7] += f[7] * w1.w;
      }
      float ss = 0.f;
#pragma unroll
      for (int j = 0; j < 8; ++j) { z[j] = silu(z[j]); ss += z[j] * z[j]; }
      if (g < 2) {
        ss += __shfl_xor(ss, 1, 64); ss += __shfl_xor(ss, 2, 64); ss += __shfl_xor(ss, 4, 64); ss += __shfl_xor(ss, 8, 64);
        float sc = rsqrtf(ss + 1e-6f);
        if (g == 0) sc *= 0.08838834764831845f;
#pragma unroll
        for (int j = 0; j < 8; ++j) z[j] *= sc;
        *(uint4*)((g == 0 ? Qb : Kb) + stt * 136 + spart * 8) = pack8(z);
      } else {
        float* dst = Vf + stt * 132 + spart * 8;
        *(float4*)dst = make_float4(z[0], z[1], z[2], z[3]);
        *(float4*)(dst + 4) = make_float4(z[4], z[5], z[6], z[7]);
      }
    }
    if (wave == 0) {
      float g = negA * softplus(gpre0 + dtb);
#pragma unroll
      for (int o = 1; o < 16; o <<= 1) { float n = __shfl_up(g, o, 16); if (fr >= o) g += n; }
      if (lane < 16) { Gs[lane] = g; Bs[lane] = sigm(gpre1); }
    }
    __syncthreads();
    if (wave == 0) {
      f32x4 kk = (f32x4){0.f, 0.f, 0.f, 0.f};
#pragma unroll
      for (int ks = 0; ks < 4; ++ks) {
        bf16x8 kf = *(const bf16x8*)(Kb + fr * 136 + ks * 32 + fq * 8);
        kk = __builtin_amdgcn_mfma_f32_16x16x32_bf16(kf, kf, kk, 0, 0, 0);
      }
      const float Gj = Gs[fr];
#pragma unroll
      for (int e = 0; e < 4; ++e) {
        const int i = fq * 4 + e;
        const float a = (fr < i) ? Bs[i] * kk[e] * __expf(Gs[i] - Gj) : 0.f;
        Amat[i * 16 + fr] = a;
      }
      lds_wave_sync();
      if (lane < 16) {
        float x[16];
        x[0] = (lane == 0) ? 1.f : 0.f;
        float4 cur[4], nxt[4];
        cur[0] = *(const float4*)(Amat + 16);
        cur[1] = cur[0]; cur[2] = cur[0]; cur[3] = cur[0];
#pragma unroll
        for (int i = 1; i < 16; ++i) {
          __builtin_amdgcn_sched_barrier(0);
          if (i + 1 < 16) {
#pragma unroll
            for (int q = 0; q < (i + 4) / 4; ++q) nxt[q] = *(const float4*)(Amat + (i + 1) * 16 + q * 4);
          }
          float acc = (i == lane) ? 1.f : 0.f;
#pragma unroll
          for (int j = 0; j < i; ++j) {
            const float4 rv = cur[j >> 2];
            const float av = (j & 3) == 0 ? rv.x : ((j & 3) == 1 ? rv.y : ((j & 3) == 2 ? rv.z : rv.w));
            acc -= av * x[j];
          }
          x[i] = acc;
#pragma unroll
          for (int q = 0; q < 4; ++q) cur[q] = nxt[q];
        }
#pragma unroll
        for (int i = 0; i < 16; ++i) Tinv[i * 16 + lane] = f2bf(x[i]);
      }
    } else if (wave == 1) {
      f32x4 qk = (f32x4){0.f, 0.f, 0.f, 0.f};
#pragma unroll
      for (int ks = 0; ks < 4; ++ks) {
        bf16x8 qf = *(const bf16x8*)(Qb + fr * 136 + ks * 32 + fq * 8);
        bf16x8 kf = *(const bf16x8*)(Kb + fr * 136 + ks * 32 + fq * 8);
        qk = __builtin_amdgcn_mfma_f32_16x16x32_bf16(qf, kf, qk, 0, 0, 0);
      }
      const float Gj = Gs[fr];
#pragma unroll
      for (int e = 0; e < 4; ++e) {
        const int t = fq * 4 + e;
        const float v = (fr <= t) ? qk[e] * __expf(Gs[t] - Gj) : 0.f;
        Pm[t * 16 + fr] = f2bf(v);
      }
    } else {
      const int k = tid - 128;
      const float GC = Gs[15];
      unsigned w[8];
#pragma unroll
      for (int j = 0; j < 8; ++j) {
        __builtin_amdgcn_sched_barrier(0);
        float v0 = bf2f(Kb[(2 * j) * 136 + k]) * __expf(GC - Gs[2 * j]);
        float v1 = bf2f(Kb[(2 * j + 1) * 136 + k]) * __expf(GC - Gs[2 * j + 1]);
        w[j] = pack2(v0, v1);
      }
      *(uint4*)(KdT + k * 16) = make_uint4(w[0], w[1], w[2], w[3]);
      *(uint4*)(KdT + k * 16 + 8) = make_uint4(w[4], w[5], w[6], w[7]);
    }
    __builtin_amdgcn_sched_barrier(0);
    f32x4 ksv[2], qsv[2];
#pragma unroll
    for (int nt = 0; nt < 2; ++nt) { ksv[nt] = (f32x4){0.f, 0.f, 0.f, 0.f}; qsv[nt] = (f32x4){0.f, 0.f, 0.f, 0.f}; }
#pragma unroll
    for (int x = 0; x < 4; ++x) {
      __builtin_amdgcn_sched_barrier(0);
      uint2 k0 = *(const uint2*)(Kb + fr * 136 + 32 * x + fq * 4);
      uint2 k1 = *(const uint2*)(Kb + fr * 136 + 32 * x + 16 + fq * 4);
      uint2 q0 = *(const uint2*)(Qb + fr * 136 + 32 * x + fq * 4);
      uint2 q1 = *(const uint2*)(Qb + fr * 136 + 32 * x + 16 + fq * 4);
      uint4 kw = make_uint4(k0.x, k0.y, k1.x, k1.y);
      uint4 qw = make_uint4(q0.x, q0.y, q1.x, q1.y);
#pragma unroll
      for (int nt = 0; nt < 2; ++nt) {
        uint4 sw;
        sw.x = pack2(S[2 * x][nt][0], S[2 * x][nt][1]); sw.y = pack2(S[2 * x][nt][2], S[2 * x][nt][3]);
        sw.z = pack2(S[2 * x + 1][nt][0], S[2 * x + 1][nt][1]); sw.w = pack2(S[2 * x + 1][nt][2], S[2 * x + 1][nt][3]);
        ksv[nt] = __builtin_amdgcn_mfma_f32_16x16x32_bf16(*(bf16x8*)&kw, *(bf16x8*)&sw, ksv[nt], 0, 0, 0);
        qsv[nt] = __builtin_amdgcn_mfma_f32_16x16x32_bf16(*(bf16x8*)&qw, *(bf16x8*)&sw, qsv[nt], 0, 0, 0);
      }
    }
    __syncthreads();
    if (cidx + 1 < 144) GDN_LOAD(cidx + 1)
    __builtin_amdgcn_sched_barrier(0);
    {
      const int seg = cidx < 16 ? 0 : 1;
      const int ch = seg ? cidx - 16 : cidx;
      float eG[4], bt[4];
#pragma unroll
      for (int e = 0; e < 4; ++e) { eG[e] = __expf(Gs[fq * 4 + e]); bt[e] = Bs[fq * 4 + e]; }
      const float eGC = __expf(Gs[15]);
      uint2 tv = *(const uint2*)(Tinv + fr * 16 + fq * 4);
      uint2 pv = *(const uint2*)(Pm + fr * 16 + fq * 4);
      uint4 tw = make_uint4(tv.x, tv.y, 0u, 0u);
      uint4 pw = make_uint4(pv.x, pv.y, 0u, 0u);
      uint4 ub[2];
#pragma unroll
      for (int nt = 0; nt < 2; ++nt) {
        const int vc = wave * 32 + nt * 16 + fr;
        float rhs[4];
#pragma unroll
        for (int e = 0; e < 4; ++e) rhs[e] = bt[e] * (Vf[(fq * 4 + e) * 132 + vc] - eG[e] * ksv[nt][e]);
        uint4 rw = make_uint4(pack2(rhs[0], rhs[1]), pack2(rhs[2], rhs[3]), 0u, 0u);
        f32x4 u = __builtin_amdgcn_mfma_f32_16x16x32_bf16(*(bf16x8*)&tw, *(bf16x8*)&rw, (f32x4){0.f, 0.f, 0.f, 0.f}, 0, 0, 0);
        ub[nt] = make_uint4(pack2(u[0], u[1]), pack2(u[2], u[3]), 0u, 0u);
        f32x4 oa;
#pragma unroll
        for (int e = 0; e < 4; ++e) oa[e] = eG[e] * qsv[nt][e];
        oa = __builtin_amdgcn_mfma_f32_16x16x32_bf16(*(bf16x8*)&pw, *(bf16x8*)&ub[nt], oa, 0, 0, 0);
        if (seg == 1) {
#pragma unroll
          for (int e = 0; e < 4; ++e) {
            const int sidx = ch * 16 + fq * 4 + e;
            const int t = d == 0 ? sidx : 2047 - sidx;
            O4[((size_t)(2 + d) * NLAT + b * 2048 + t) * 512 + h * 128 + vc] = f2bf(oa[e]);
          }
        }
      }
#pragma unroll
      for (int mt = 0; mt < 8; ++mt) {
        __builtin_amdgcn_sched_barrier(0);
        uint2 kv = *(const uint2*)(KdT + (mt * 16 + fr) * 16 + fq * 4);
        uint4 kw = make_uint4(kv.x, kv.y, 0u, 0u);
#pragma unroll
        for (int nt = 0; nt < 2; ++nt) {
#pragma unroll
          for (int e = 0; e < 4; ++e) S[mt][nt][e] *= eGC;
          S[mt][nt] = __builtin_amdgcn_mfma_f32_16x16x32_bf16(*(bf16x8*)&kw, *(bf16x8*)&ub[nt], S[mt][nt], 0, 0, 0);
        }
      }
    }
    __syncthreads();
  }
#undef GDN_LOAD
}

DEV void phase_scans(const Params& p, char* smem) {
#pragma unroll 1
  for (int it = blockIdx.x; it < 512; it += gridDim.x)
    if (it & 1) rwkv_item(p, it >> 1, smem);
  __builtin_amdgcn_sched_barrier(0);
#pragma unroll 1
  for (int it = blockIdx.x; it < 512; it += gridDim.x)
    if (!(it & 1)) gdn_item(p, it >> 1, smem);
}

DEV void mixout_item(const Params& p, int it, char* smem) {
  const u16* P = (const u16*)(p.ws + OFF_BIG);
  const u16* O4 = (const u16*)p.out;
  const float* BS = (const float*)(p.ws + OFF_BSUM);
  u16* Y = (u16*)(p.ws + OFF_HY);
  float* sg = (float*)smem;
  const int tid = threadIdx.x, lane = tid & 63, wave = tid >> 6;
  const int tok0 = it * 32;
  const int tl0 = tok0 & 2047;
#pragma unroll 8
  for (int idx = tid; idx < 32 * 128; idx += 256) {
    const int tk = idx >> 7, r = idx & 127;
    const int t = tl0 + tk;
    const u16* src = P + (size_t)(tok0 + tk) * PS1 + 1792 + r;
    float pc = bf2f(src[0]);
    float pp = t > 0 ? bf2f(src[-PS1]) : 0.f;
    float pn = t + 1 < 2048 ? bf2f(src[PS1]) : 0.f;
    float v = pc + p.rw_mu[1792 + r] * (0.5f * (pp + pn) - pc);
    sg[idx] = sigm(v);
  }
  __syncthreads();
#pragma unroll 1
  for (int half = 0; half < 2; ++half) {
    const int c = tid + half * 256;
    const int hd = c >> 6;
    float gacc[32];
#pragma unroll
    for (int k = 0; k < 32; ++k) gacc[k] = 0.f;
#pragma unroll 8
    for (int r = 0; r < 128; r += 4) {
      const float w0 = p.rw_g2[(r + 0) * 512 + c], w1 = p.rw_g2[(r + 1) * 512 + c];
      const float w2 = p.rw_g2[(r + 2) * 512 + c], w3 = p.rw_g2[(r + 3) * 512 + c];
#pragma unroll
      for (int k = 0; k < 32; ++k) {
        float4 s4 = *(const float4*)(sg + k * 128 + r);
        gacc[k] += s4.x * w0 + s4.y * w1 + s4.z * w2 + s4.w * w3;
      }
    }
    const float gng = p.rw_lnx_g[c], gnb = p.rw_lnx_b[c], muv = p.rw_mu[1024 + c];
#pragma unroll
    for (int k = 0; k < 32; ++k) {
      const int row = tok0 + k, t = tl0 + k;
      float y = bf2f(O4[(size_t)row * 512 + c]) + bf2f(O4[((size_t)NLAT + row) * 512 + c]);
      float s1 = y, s2 = y * y;
#pragma unroll
      for (int o = 32; o > 0; o >>= 1) { s1 += __shfl_xor(s1, o, 64); s2 += __shfl_xor(s2, o, 64); }
      const float mean = s1 * (1.f / 64.f);
      const float dy = y - mean;
      const float var = fmaxf(s2 * (1.f / 64.f) - mean * mean, 0.f);
      const float yn = dy * rsqrtf(var + 64e-5f) * gng + gnb;
      const u16* vs = P + (size_t)row * PS1 + 1024 + c;
      float pc = bf2f(vs[0]);
      float pp = t > 0 ? bf2f(vs[-PS1]) : 0.f;
      float pn = t + 1 < 2048 ? bf2f(vs[PS1]) : 0.f;
      const float vsh = pc + muv * (0.5f * (pp + pn) - pc);
      const float bsum = BS[(size_t)row * 16 + hd * 2] + BS[(size_t)row * 16 + hd * 2 + 1];
      Y[(size_t)row * 1024 + c] = f2bf((yn + bsum * vsh) * gacc[k]);
    }
  }
  {
    const int c0 = wave * 128 + lane, c1 = c0 + 64;
    const float ng0 = p.dn_norm_g[lane], ng1 = p.dn_norm_g[lane + 64];
#pragma unroll 8
    for (int k = 0; k < 32; ++k) {
      const int row = tok0 + k;
      const u16* of = O4 + ((size_t)2 * NLAT + row) * 512;
      const u16* ob = O4 + ((size_t)3 * NLAT + row) * 512;
      const float o0 = bf2f(of[c0]) + bf2f(ob[c0]);
      const float o1 = bf2f(of[c1]) + bf2f(ob[c1]);
      const float ms = wave_sum(o0 * o0 + o1 * o1) * (1.f / 128.f);
      const float rs = rsqrtf(ms + 1e-6f);
      const u16* zr = P + (size_t)row * PS1 + DNO + 1536;
      const float z0 = bf2f(zr[c0]), z1 = bf2f(zr[c1]);
      Y[(size_t)row * 1024 + 512 + c0] = f2bf(o0 * rs * ng0 * silu(z0));
      Y[(size_t)row * 1024 + 512 + c1] = f2bf(o1 * rs * ng1 * silu(z1));
    }
  }
  __syncthreads();
}

constexpr int NPHASE = 18;

__global__ void __launch_bounds__(256, 2) mega(Params p, int ph_lo, int ph_hi) {
  __shared__ __attribute__((aligned(16))) char smem[65536];
  cg::grid_group grid = cg::this_grid();
  const float* mv0 = (const float*)(p.ws + OFF_MODV);
  const float* mv1 = mv0 + 33 * 6144;
  u16* X = (u16*)(p.ws + OFF_X);
  u16* HY = (u16*)(p.ws + OFF_HY);
  u16* BIG = (u16*)(p.ws + OFF_BIG);
#define PHASE(n, BODY) if (ph_lo <= (n) && (n) < ph_hi) { BODY; if ((n) + 1 < ph_hi) grid.sync(); }
  PHASE(0, phase_prep(p, smem))
  PHASE(1, phase_init(p))
  PHASE(2, gemm_phase<0>(HY, 1024, (const u16*)(p.ws + OFF_WIN0), 1024, NTOK, 2304, BIG, PS0, nullptr, smem))
  PHASE(3, phase_hyprep_rope(p, smem))
  PHASE(4, phase_conv_attn(p, smem))
  PHASE(5, gemm_phase<2>(HY, 1024, (const u16*)(p.ws + OFF_WOUT0), 1024, NTOK, 1024, X, 1024, mv0 + 2 * 1024, smem))
  PHASE(6, ln_phase<false>(p, NTOK, p.ln_g, p.ln_b, mv0, 3, 4))
  PHASE(7, gemm_phase<1>(HY, 1024, (const u16*)(p.ws + OFF_W1_0), 1024, NTOK, 4096, BIG, 4096, nullptr, smem))
  PHASE(8, gemm_phase<2>(BIG, 4096, (const u16*)(p.ws + OFF_W2_0), 4096, NTOK, 1024, X, 1024, mv0 + 5 * 1024, smem))
  PHASE(9, ln_phase<false>(p, NTOK, p.ln_g + 1024, p.ln_b + 1024, mv1, 0, 1))
  PHASE(10, gemm_phase<0>(HY, 1024, (const u16*)(p.ws + OFF_WIN1), 1024, NTOK, 4096, BIG, PS1, nullptr, smem))
  PHASE(11, phase_scans(p, smem))
  PHASE(12, for (int it = blockIdx.x; it < 2048; it += gridDim.x) mixout_item(p, it, smem))
  PHASE(13, gemm_phase<2>(HY, 1024, (const u16*)(p.ws + OFF_WOUT1), 1024, NLAT, 1024, X, 1024, mv1 + 2 * 1024, smem))
  PHASE(14, ln_phase<false>(p, NLAT, p.ln_g + 2048, p.ln_b + 2048, mv1, 3, 4))
  PHASE(15, gemm_phase<1>(HY, 1024, (const u16*)(p.ws + OFF_W1_1), 1024, NLAT, 4096, BIG, 4096, nullptr, smem))
  PHASE(16, gemm_phase<2>(BIG, 4096, (const u16*)(p.ws + OFF_W2_1), 4096, NLAT, 1024, X, 1024, mv1 + 5 * 1024, smem))
  PHASE(17, ln_phase<true>(p, NLAT, p.ln_g + 3072, p.ln_b + 3072, mv1, 0, 1))
}

extern "C" void kernel_launch(void* const* d_in, const int* in_sizes, int n_in, void* d_out, int out_size, void* d_ws,
                              size_t ws_size, hipStream_t stream) {
  static int grid_blocks = 0;
  if (!grid_blocks) {
    int dev = 0, cus = 0, per_cu = 0;
    hipGetDevice(&dev);
    hipDeviceGetAttribute(&cus, hipDeviceAttributeMultiprocessorCount, dev);
    hipOccupancyMaxActiveBlocksPerMultiprocessor(&per_cu, mega, 256, 0);
    if (per_cu > 2) per_cu = 2;
    if (per_cu < 1) per_cu = 1;
    grid_blocks = cus * per_cu;
  }
  if (ws_size < WS_NEED) fprintf(stderr, "workspace too small: %zu < %zu\n", ws_size, (size_t)WS_NEED);
  Params p{};
  const float** pp = (const float**)&p;
  for (int i = 0; i < 39; ++i) pp[i] = (const float*)d_in[i];
  p.out = (float*)d_out;
  p.ws = (char*)d_ws;
  int lo = 0, hi = NPHASE;
  void* args[] = {&p, &lo, &hi};
  hipError_t e = hipLaunchCooperativeKernel((void*)mega, dim3(grid_blocks), dim3(256), args, 0, stream);
  if (e != hipSuccess) fprintf(stderr, "cooperative launch failed: %s (grid %d)\n", hipGetErrorString(e), grid_blocks);
}
```

```cpp
#include <hip/hip_runtime.h>
#include <hip/hip_cooperative_groups.h>
#include <cstdio>
#include <cstdint>
namespace cg = cooperative_groups;

typedef unsigned short u16;
typedef __attribute__((ext_vector_type(8))) short bf16x8;
typedef __attribute__((ext_vector_type(4))) float f32x4;
typedef __attribute__((ext_vector_type(16))) float f32x16;

#define DEV __device__ __forceinline__

constexpr int NLAT = 65536, NCTX = 8192, NTOK = 73728;
constexpr int PS0 = 2304;
constexpr int PS1 = 4096;
constexpr int DNO = 1920;
constexpr float ALPHA = 1.4142135623730951f;

constexpr size_t OFF_WIN0 = 0;
constexpr size_t OFF_WOUT0 = OFF_WIN0 + (size_t)2304 * 1024 * 2;
constexpr size_t OFF_W1_0 = OFF_WOUT0 + (size_t)1024 * 1024 * 2;
constexpr size_t OFF_W1_1 = OFF_W1_0 + (size_t)4096 * 1024 * 2;
constexpr size_t OFF_W2_0 = OFF_W1_1 + (size_t)4096 * 1024 * 2;
constexpr size_t OFF_W2_1 = OFF_W2_0 + (size_t)4096 * 1024 * 2;
constexpr size_t OFF_WIN1 = OFF_W2_1 + (size_t)4096 * 1024 * 2;
constexpr size_t OFF_WOUT1 = OFF_WIN1 + (size_t)4096 * 1024 * 2;
constexpr size_t OFF_MODV = OFF_WOUT1 + (size_t)1024 * 1024 * 2;
constexpr size_t OFF_KR2048 = OFF_MODV + (size_t)2 * 33 * 6144 * 4;
constexpr size_t OFF_KR256 = OFF_KR2048 + (size_t)512 * 4096 * 2;
constexpr size_t OFF_ROPE = OFF_KR256 + (size_t)512 * 512 * 2;
constexpr size_t OFF_BSUM = OFF_ROPE + 8192;
constexpr size_t OFF_G2T = OFF_BSUM + (size_t)65536 * 16 * 4;
constexpr size_t OFF_X = (size_t)64 << 20;
constexpr size_t OFF_HY = OFF_X + (size_t)NTOK * 1024 * 2;
constexpr size_t OFF_BIG = OFF_HY + (size_t)NTOK * 1024 * 2;
constexpr size_t WS_NEED = OFF_BIG + (size_t)NTOK * 4096 * 2;
static_assert(OFF_G2T + (size_t)512 * 128 * 2 <= OFF_X, "ws map");
constexpr size_t SO_U = 0;
constexpr size_t SO_X0 = SO_U + (size_t)512 * 32 * 2048 * 2;
constexpr size_t SO_UC = SO_X0 + (size_t)512 * 32 * 2048 * 2;
constexpr size_t SO_X0C = SO_UC + (size_t)512 * 32 * 256 * 2;

struct Params {
  const float *x, *c, *ctx, *c_ctx, *mod_w, *mod_b, *ln_g, *ln_b, *mlp_w1, *mlp_w2, *e_w_in, *e_w_out, *hy_conv,
      *hy_w1, *hy_b1, *hy_w2, *hy_b2, *hy_freq, *hy_w3, *hy_decay, *hy_bias, *attn_sink, *o_w_in, *o_w_out,
      *rw_mu, *rw_w0, *rw_w2, *rw_a0, *rw_a2, *rw_g2, *rw_kk, *rw_ka, *rw_rk, *rw_lnx_g, *rw_lnx_b,
      *dn_conv, *dn_A_log, *dn_dt_bias, *dn_norm_g;
  float* out;
  char* ws;
};

DEV u16 f2bf(float f) { unsigned u = __float_as_uint(f); u += 0x7fffu + ((u >> 16) & 1u); return (u16)(u >> 16); }
DEV float bf2f(u16 h) { return __uint_as_float(((unsigned)h) << 16); }
DEV float bflo(unsigned u) { return __uint_as_float(u << 16); }
DEV float bfhi(unsigned u) { return __uint_as_float(u & 0xffff0000u); }
DEV unsigned pack2(float a, float b) { return (unsigned)f2bf(a) | ((unsigned)f2bf(b) << 16); }
DEV void unpack8(const uint4& v, float* f) {
  f[0] = bflo(v.x); f[1] = bfhi(v.x); f[2] = bflo(v.y); f[3] = bfhi(v.y);
  f[4] = bflo(v.z); f[5] = bfhi(v.z); f[6] = bflo(v.w); f[7] = bfhi(v.w);
}
DEV uint4 pack8(const float* f) {
  uint4 v; v.x = pack2(f[0], f[1]); v.y = pack2(f[2], f[3]); v.z = pack2(f[4], f[5]); v.w = pack2(f[6], f[7]); return v;
}
DEV int modrow(int r) { return r < NLAT ? (r >> 11) : 32; }
DEV float sigm(float x) { return 1.f / (1.f + __expf(-x)); }
DEV float silu(float x) { return x / (1.f + __expf(-x)); }
DEV float softplus(float x) { return fmaxf(x, 0.f) + __logf(1.f + __expf(-fabsf(x))); }
DEV float fast_tanh(float x) { return 1.f - 2.f / (1.f + __expf(2.f * x)); }
DEV float wave_sum(float v) {
#pragma unroll
  for (int o = 32; o > 0; o >>= 1) v += __shfl_xor(v, o, 64);
  return v;
}

DEV void transpose_tile(const float* __restrict__ src, int K, int N, int Npad, u16* __restrict__ dst, int tile,
                               u16* sm) {
  const int tid = threadIdx.x;
  const int ntn = Npad >> 6;
  const int tk = tile / ntn, tn = tile - tk * ntn;
  const int n = tid & 63, kq = tid >> 6;
  const int gn = tn * 64 + n;
#pragma unroll 4
  for (int i = 0; i < 16; ++i) {
    int k = kq + 4 * i;
    float v = (gn < N) ? src[(size_t)(tk * 64 + k) * N + gn] : 0.f;
    sm[n * 66 + k] = f2bf(v);
  }
  __syncthreads();
  const int n2 = tid >> 2, q = tid & 3;
  const unsigned* s32 = (const unsigned*)sm + (n2 * 66 + q * 16) / 2;
  uint4 a, b;
  a.x = s32[0]; a.y = s32[1]; a.z = s32[2]; a.w = s32[3];
  b.x = s32[4]; b.y = s32[5]; b.z = s32[6]; b.w = s32[7];
  u16* d = dst + (size_t)(tn * 64 + n2) * K + tk * 64 + q * 16;
  *(uint4*)d = a;
  *(uint4*)(d + 8) = b;
  __syncthreads();
}

DEV void modv_item(const Params& p, int it, float* sl) {
  const int tid = threadIdx.x;
  const int l = it / 288, rem = it % 288, cc = rem / 3, rg = rem % 3;
  for (int idx = tid; idx < 11 * 1024; idx += 256) {
    int r = rg * 11 + (idx >> 10), k = idx & 1023;
    float cv = (r < 32) ? p.c[r * 1024 + k] : p.c_ctx[k];
    sl[idx] = cv / (1.f + expf(-cv));
  }
  __syncthreads();
  const int cl = tid & 63, kg = tid >> 6;
  const int col = cc * 64 + cl;
  float acc[11];
#pragma unroll
  for (int r = 0; r < 11; ++r) acc[r] = 0.f;
  const float* w = p.mod_w + (size_t)l * 1024 * 6144 + (size_t)(kg * 256) * 6144 + col;
#pragma unroll 8
  for (int k = 0; k < 256; ++k) {
    float wv = w[(size_t)k * 6144];
#pragma unroll
    for (int r = 0; r < 11; ++r) acc[r] += sl[r * 1024 + kg * 256 + k] * wv;
  }
  __syncthreads();
  float* red = sl;
#pragma unroll
  for (int r = 0; r < 11; ++r) red[(kg * 11 + r) * 64 + cl] = acc[r];
  __syncthreads();
  for (int idx = tid; idx < 11 * 64; idx += 256) {
    int r = idx >> 6, c2 = idx & 63;
    float v = red[(0 * 11 + r) * 64 + c2] + red[(1 * 11 + r) * 64 + c2] + red[(2 * 11 + r) * 64 + c2] + red[(3 * 11 + r) * 64 + c2];
    int gcol = cc * 64 + c2;
    ((float*)(p.ws + OFF_MODV))[(size_t)(l * 33 + rg * 11 + r) * 6144 + gcol] = v + p.mod_b[l * 6144 + gcol];
  }
  __syncthreads();
}

DEV void filter_item(const Params& p, int it, float* sm) {
  const int L = it < 2048 ? 2048 : 256;
  const int t = it < 2048 ? it : it - 2048;
  u16* R = (u16*)(p.ws + (L == 2048 ? OFF_KR2048 : OFF_KR256));
  float* pe = sm; float* h1 = sm + 64; float* h2 = sm + 128;
  const int tid = threadIdx.x;
  const float tn = (float)t / (float)(L - 1);
  if (tid < 33) {
    float v;
    if (tid == 0) v = tn;
    else {
      int i = (tid - 1) & 15;
      double band = 1e-4 + (double)i * ((15.0 - 1e-4) / 15.0);
      double ang = 2.0 * 3.14159265358979323846 * (double)t * band / (double)L;
      v = (tid <= 16) ? (float)cos(ang) : (float)(-sin(ang));
    }
    pe[tid] = v;
  }
  __syncthreads();
  if (tid < 64) {
    float acc = p.hy_b1[tid];
#pragma unroll 11
    for (int i = 0; i < 33; ++i) acc += pe[i] * p.hy_w1[i * 64 + tid];
    h1[tid] = sinf(p.hy_freq[tid] * acc);
  }
  __syncthreads();
  if (tid < 64) {
    float acc = p.hy_b2[tid];
#pragma unroll 16
    for (int i = 0; i < 64; ++i) acc += h1[i] * p.hy_w2[i * 64 + tid];
    h2[tid] = sinf(p.hy_freq[tid] * acc);
  }
  __syncthreads();
#pragma unroll 1
  for (int q = 0; q < 4; ++q) {
    int o = tid + 256 * q;
    float acc = 0.f;
#pragma unroll 16
    for (int i = 0; i < 64; ++i) acc += h2[i] * p.hy_w3[i * 1024 + o];
    float val = acc * expf(-tn * fabsf(p.hy_decay[o]));
    if (o < 512) {
      if (t == 0) val += p.hy_bias[o];
      R[(size_t)o * 2 * L + L - t] = f2bf(val);
    } else {
      int c = o - 512;
      if (t >= 1) R[(size_t)c * 2 * L + L + t] = f2bf(val);
      else R[(size_t)c * 2 * L] = 0;
    }
  }
  __syncthreads();
}

DEV void phase_prep(const Params& p, char* smem) {
  constexpr int T_IN0 = 16 * 36, T_OUT = 16 * 16, T_W = 16 * 64;
  constexpr int E0 = T_IN0, E1 = E0 + T_OUT, E2 = E1 + T_W, E3 = E2 + T_W, E4 = E3 + T_W, E5 = E4 + T_W,
                E6 = E5 + T_W, E7 = E6 + T_OUT, E8 = E7 + 576, E9 = E8 + 2304, E10 = E9 + 1, E11 = E10 + 16;
  for (int it = blockIdx.x; it < E11; it += gridDim.x) {
    if (it >= E10) transpose_tile(p.rw_g2, 128, 512, 512, (u16*)(p.ws + OFF_G2T), it - E10, (u16*)smem);
    else if (it < E0) transpose_tile(p.e_w_in, 1024, 2304, 2304, (u16*)(p.ws + OFF_WIN0), it, (u16*)smem);
    else if (it < E1) transpose_tile(p.e_w_out, 1024, 1024, 1024, (u16*)(p.ws + OFF_WOUT0), it - E0, (u16*)smem);
    else if (it < E2) transpose_tile(p.mlp_w1, 1024, 4096, 4096, (u16*)(p.ws + OFF_W1_0), it - E1, (u16*)smem);
    else if (it < E3) transpose_tile(p.mlp_w1 + (size_t)1024 * 4096, 1024, 4096, 4096, (u16*)(p.ws + OFF_W1_1), it - E2, (u16*)smem);
    else if (it < E4) transpose_tile(p.mlp_w2, 4096, 1024, 1024, (u16*)(p.ws + OFF_W2_0), it - E3, (u16*)smem);
    else if (it < E5) transpose_tile(p.mlp_w2 + (size_t)1024 * 4096, 4096, 1024, 1024, (u16*)(p.ws + OFF_W2_1), it - E4, (u16*)smem);
    else if (it < E6) transpose_tile(p.o_w_in, 1024, 3984, 4096, (u16*)(p.ws + OFF_WIN1), it - E5, (u16*)smem);
    else if (it < E7) transpose_tile(p.o_w_out, 1024, 1024, 1024, (u16*)(p.ws + OFF_WOUT1), it - E6, (u16*)smem);
    else if (it < E8) modv_item(p, it - E7, (float*)smem);
    else if (it < E9) filter_item(p, it - E8, (float*)smem);
    else {
      float2* tab = (float2*)(p.ws + OFF_ROPE);
      for (int q = 0; q < 4; ++q) {
        int e = threadIdx.x * 4 + q;
        int pos = e >> 4, i = e & 15;
        float inv = powf(10000.f, -(float)i / 16.f);
        float ang = (float)pos * inv;
        tab[e] = make_float2(cosf(ang), sinf(ang));
      }
    }
  }
}

DEV void phase_init(const Params& p) {
  const float* mv = (const float*)(p.ws + OFF_MODV);
  u16* X = (u16*)(p.ws + OFF_X);
  u16* HM = (u16*)(p.ws + OFF_HY);
  const size_t total = (size_t)NTOK * 128;
  for (size_t i = (size_t)blockIdx.x * 256 + threadIdx.x; i < total; i += (size_t)gridDim.x * 256) {
    int r = (int)(i >> 7), c8 = (int)(i & 127) * 8;
    const float* src = r < NLAT ? p.x + (size_t)r * 1024 + c8 : p.ctx + (size_t)(r - NLAT) * 1024 + c8;
    float4 v0 = *(const float4*)src, v1 = *(const float4*)(src + 4);
    const float* m = mv + (size_t)modrow(r) * 6144 + c8;
    float4 h0 = *(const float4*)m, h1 = *(const float4*)(m + 4);
    float4 s0 = *(const float4*)(m + 1024), s1 = *(const float4*)(m + 1028);
    float f[8] = {v0.x, v0.y, v0.z, v0.w, v1.x, v1.y, v1.z, v1.w};
    float sh[8] = {h0.x, h0.y, h0.z, h0.w, h1.x, h1.y, h1.z, h1.w};
    float sc[8] = {s0.x, s0.y, s0.z, s0.w, s1.x, s1.y, s1.z, s1.w};
    float g[8];
#pragma unroll
    for (int j = 0; j < 8; ++j) g[j] = f[j] * (1.f + sc[j]) + sh[j];
    *(uint4*)(X + (size_t)r * 1024 + c8) = pack8(f);
    *(uint4*)(HM + (size_t)r * 1024 + c8) = pack8(g);
  }
}

template <int EPI>
DEV void gemm_phase(const u16* __restrict__ A, int lda, const u16* __restrict__ Bt, int K, int M, int N,
                           u16* __restrict__ C, int ldc, const float* __restrict__ gate, char* smem) {
  const int tid = threadIdx.x, lane = tid & 63, wave = tid >> 6;
  const int wm = wave >> 1, wn = wave & 1;
  const int fr = lane & 15, fq = lane >> 4;
  const int tn = N >> 7, tiles = (M >> 7) * tn;
  const int nk = K >> 6;
  const int drow = wave * 8 + (lane >> 3);
  const int dchunk = (lane & 7) ^ ((drow >> 1) & 7);
  const size_t lda32 = (size_t)lda * 32, ldb32 = (size_t)K * 32;
  const int sw = fr >> 1;
  const bool xcd_order = (gridDim.x & 7) == 0 && ((M >> 7) & 63) == 0;
  const int per_xcd = tiles >> 3;
  const int nloc = gridDim.x >> 3;
  for (int it = blockIdx.x; it < tiles; it += gridDim.x) {
    int tm_i, tn_i;
    if (xcd_order) {
      const int x = it & 7;
      const int local = it >> 3;
      const int mg = local / (8 * tn), r = local - mg * 8 * tn;
      tn_i = r >> 3;
      tm_i = x * (per_xcd / tn) + mg * 8 + (r & 7);
    } else { tm_i = it / tn; tn_i = it - tm_i * tn; }
    const int m0 = tm_i << 7, n0 = tn_i << 7;
    const u16* ag = A + (size_t)(m0 + drow) * lda + dchunk * 8;
    const u16* bg = Bt + (size_t)(n0 + drow) * K + dchunk * 8;
    f32x4 acc[4][4];
#pragma unroll
    for (int i = 0; i < 4; ++i)
#pragma unroll
      for (int j = 0; j < 4; ++j) acc[i][j] = (f32x4){0.f, 0.f, 0.f, 0.f};
#define G_ISSUE(KT, ST)                                                                                  \
  {                                                                                                      \
    const u16* a2 = ag + (KT)*64;                                                                        \
    const u16* b2 = bg + (KT)*64;                                                                        \
    char* la = smem + (ST)*32768 + wave * 1024;                                                          \
    _Pragma("unroll") for (int j = 0; j < 4; ++j) {                                                      \
      __builtin_amdgcn_global_load_lds((const unsigned*)(a2 + j * lda32), (unsigned*)(la + j * 4096), 16, 0, 0);          \
      __builtin_amdgcn_global_load_lds((const unsigned*)(b2 + j * ldb32), (unsigned*)(la + 16384 + j * 4096), 16, 0, 0);  \
    }                                                                                                    \
  }
    G_ISSUE(0, 0)
    for (int kt = 0; kt < nk; ++kt) {
      asm volatile("s_waitcnt vmcnt(0)" ::: "memory");
      __syncthreads();
      if (kt + 1 < nk) G_ISSUE(kt + 1, (kt + 1) & 1)
      const u16* As = (const u16*)(smem + (kt & 1) * 32768);
      const u16* Bs = As + 8192;
#pragma unroll
      for (int ks = 0; ks < 2; ++ks) {
        bf16x8 af[4], bfr[4];
        const int pos = ((ks * 4 + fq) ^ sw) * 8;
#pragma unroll
        for (int i = 0; i < 4; ++i) {
          af[i] = *(const bf16x8*)(As + (wm * 64 + i * 16 + fr) * 64 + pos);
          bfr[i] = *(const bf16x8*)(Bs + (wn * 64 + i * 16 + fr) * 64 + pos);
        }
        __builtin_amdgcn_s_setprio(1);
#pragma unroll
        for (int i = 0; i < 4; ++i)
#pragma unroll
          for (int j = 0; j < 4; ++j)
            acc[i][j] = __builtin_amdgcn_mfma_f32_16x16x32_bf16(af[i], bfr[j], acc[i][j], 0, 0, 0);
        __builtin_amdgcn_s_setprio(0);
      }
    }
#undef G_ISSUE
    __syncthreads();
    u16* Cs = (u16*)smem;
#pragma unroll
    for (int i = 0; i < 4; ++i)
#pragma unroll
      for (int j = 0; j < 4; ++j)
#pragma unroll
        for (int e = 0; e < 4; ++e) {
          float v = acc[i][j][e];
          if (EPI == 1) { v = fmaxf(v, 0.f); v = v * v; }
          Cs[(wm * 64 + i * 16 + fq * 4 + e) * 136 + wn * 64 + j * 16 + fr] = f2bf(v);
        }
    __syncthreads();
#pragma unroll 2
    for (int q = 0; q < 8; ++q) {
      const int chunk = tid + q * 256;
      const int row = chunk >> 4, cc = chunk & 15;
      uint4 cv = *(const uint4*)(Cs + row * 136 + cc * 8);
      u16* dst = C + (size_t)(m0 + row) * ldc + n0 + cc * 8;
      if (EPI == 2) {
        float a[8], xo[8], y[8];
        unpack8(cv, a);
        unpack8(*(const uint4*)dst, xo);
        const float* gr = gate + (size_t)modrow(m0 + row) * 6144 + n0 + cc * 8;
        float4 g0 = *(const float4*)gr, g1 = *(const float4*)(gr + 4);
        float gg[8] = {g0.x, g0.y, g0.z, g0.w, g1.x, g1.y, g1.z, g1.w};
#pragma unroll
        for (int j = 0; j < 8; ++j) y[j] = ALPHA * xo[j] + gg[j] * a[j];
        cv = pack8(y);
      }
      *(uint4*)dst = cv;
    }
    __syncthreads();
  }
}

template <bool FINAL>
DEV void ln_phase(const Params& p, int M, const float* __restrict__ g, const float* __restrict__ b,
                         const float* __restrict__ modl  , int shi, int sci) {
  u16* X = (u16*)(p.ws + OFF_X);
  u16* HM = (u16*)(p.ws + OFF_HY);
  const int lane = threadIdx.x & 63;
  const int gw = blockIdx.x * 4 + (threadIdx.x >> 6), nw = gridDim.x * 4;
#pragma unroll 2
  for (int row = gw; row < M; row += nw) {
    u16* xr = X + (size_t)row * 1024;
    float f[16];
    unpack8(*(const uint4*)(xr + lane * 8), f);
    unpack8(*(const uint4*)(xr + 512 + lane * 8), f + 8);
    float s = 0.f, q = 0.f;
#pragma unroll
    for (int j = 0; j < 16; ++j) { s += f[j]; q += f[j] * f[j]; }
#pragma unroll
    for (int o = 32; o > 0; o >>= 1) { s += __shfl_xor(s, o, 64); q += __shfl_xor(q, o, 64); }
    const float mu = s * (1.f / 1024.f);
    const float rs = rsqrtf(fmaxf(q * (1.f / 1024.f) - mu * mu, 0.f) + 1e-5f);
#pragma unroll
    for (int j = 0; j < 16; ++j) f[j] -= mu;
#pragma unroll
    for (int hh = 0; hh < 2; ++hh) {
      const int c0 = hh * 512 + lane * 8;
      float y[8];
#pragma unroll
      for (int j = 0; j < 8; ++j) y[j] = f[hh * 8 + j] * rs * g[c0 + j] + b[c0 + j];
      if (FINAL) {
        float* o = p.out + (size_t)row * 1024 + c0;
        *(float4*)o = make_float4(y[0], y[1], y[2], y[3]);
        *(float4*)(o + 4) = make_float4(y[4], y[5], y[6], y[7]);
      } else {
        *(uint4*)(xr + c0) = pack8(y);
        const float* m = modl + (size_t)modrow(row) * 6144;
        float h[8];
#pragma unroll
        for (int j = 0; j < 8; ++j) h[j] = y[j] * (1.f + m[sci * 1024 + c0 + j]) + m[shi * 1024 + c0 + j];
        *(uint4*)(HM + (size_t)row * 1024 + c0) = pack8(h);
      }
    }
  }
}

DEV void hyprep_item(const Params& p, int it, char* smem) {
  u16* su = (u16*)smem;
  u16* sx = su + 64 * 66;
  const u16* P = (const u16*)(p.ws + OFF_BIG);
  const int tid = threadIdx.x;
  const int ct = it & 7, st = it >> 3;
  int b, t0, L, rowbase;
  u16 *U, *X0;
  if (st < 1024) { b = st >> 5; t0 = (st & 31) * 64; L = 2048; rowbase = b * 2048;
    U = (u16*)((char*)p.out + SO_U); X0 = (u16*)((char*)p.out + SO_X0); }
  else { int s2 = st - 1024; b = s2 >> 2; t0 = (s2 & 3) * 64; L = 256; rowbase = NLAT + b * 256;
    U = (u16*)((char*)p.out + SO_UC); X0 = (u16*)((char*)p.out + SO_X0C); }
  const int c0 = ct * 64;
  {
    const int t = tid >> 2, cq = tid & 3;
    float z[3][16];
#pragma unroll
    for (int g = 0; g < 3; ++g)
#pragma unroll
      for (int j = 0; j < 16; ++j) z[g][j] = 0.f;
#pragma unroll
    for (int tap = 0; tap < 3; ++tap) {
      const int tt = t0 + t + tap - 1;
      if (tt >= 0 && tt < L) {
#pragma unroll
        for (int g = 0; g < 3; ++g) {
          const int col = g * 512 + c0 + cq * 16;
          const u16* src = P + (size_t)(rowbase + tt) * PS0 + col;
          float f[16];
          unpack8(*(const uint4*)src, f);
          unpack8(*(const uint4*)(src + 8), f + 8);
          const float* w = p.hy_conv + tap * 1536 + col;
#pragma unroll
          for (int j = 0; j < 16; ++j) z[g][j] += f[j] * w[j];
        }
      }
    }
#pragma unroll
    for (int j = 0; j < 16; ++j) {
      su[t * 66 + cq * 16 + j] = f2bf(z[1][j] * z[2][j]);
      sx[t * 66 + cq * 16 + j] = f2bf(z[0][j]);
    }
  }
  __syncthreads();
  {
    const int c = tid >> 2, tq = tid & 3;
    unsigned wu[8], wx[8];
#pragma unroll
    for (int j = 0; j < 8; ++j) {
      wu[j] = (unsigned)su[(tq * 16 + 2 * j) * 66 + c] | ((unsigned)su[(tq * 16 + 2 * j + 1) * 66 + c] << 16);
      wx[j] = (unsigned)sx[(tq * 16 + 2 * j) * 66 + c] | ((unsigned)sx[(tq * 16 + 2 * j + 1) * 66 + c] << 16);
    }
    const size_t o = ((size_t)(c0 + c) * 32 + b) * L + t0 + tq * 16;
    *(uint4*)(U + o) = make_uint4(wu[0], wu[1], wu[2], wu[3]);
    *(uint4*)(U + o + 8) = make_uint4(wu[4], wu[5], wu[6], wu[7]);
    *(uint4*)(X0 + o) = make_uint4(wx[0], wx[1], wx[2], wx[3]);
    *(uint4*)(X0 + o + 8) = make_uint4(wx[4], wx[5], wx[6], wx[7]);
  }
  __syncthreads();
}

DEV void rope_item(const Params& p, int it) {
  u16* P = (u16*)(p.ws + OFF_BIG);
  const float2* tab = (const float2*)(p.ws + OFF_ROPE);
  const int task = it * 256 + threadIdx.x;
  const int row = task / 40, rem = task - row * 40;
  const int head = rem >> 2, pr = rem & 3;
  const int d0 = (pr >> 1) * 32 + (pr & 1) * 8;
  const int t = row & 2047;
  const int posc = (pr >> 1) ? (t & 63) : (t >> 6);
  const int fi0 = (pr & 1) * 8;
  u16* ptr = P + (size_t)row * PS0 + 1536 + head * 64 + d0;
  float u1[8], u2[8], o1[8], o2[8];
  unpack8(*(const uint4*)ptr, u1);
  unpack8(*(const uint4*)(ptr + 16), u2);
#pragma unroll
  for (int j = 0; j < 8; ++j) {
    float2 cs = tab[posc * 16 + fi0 + j];
    o1[j] = u1[j] * cs.x - u2[j] * cs.y;
    o2[j] = u1[j] * cs.y + u2[j] * cs.x;
  }
  *(uint4*)ptr = pack8(o1);
  *(uint4*)(ptr + 16) = pack8(o2);
}

DEV void phase_hyprep_rope(const Params& p, char* smem) {
  constexpr int NH = 9216, NR = 10240;
  for (int it = blockIdx.x; it < NH + NR; it += gridDim.x) {
    if (it < NH) hyprep_item(p, it, smem);
    else rope_item(p, it - NH);
  }
}

template <int L, int NT>
DEV void conv_item(const Params& p, int c, int th, char* smem) {
  const u16* R = (const u16*)(p.ws + (L == 2048 ? OFF_KR2048 : OFF_KR256)) + (size_t)c * 2 * L;
  const u16* U = (const u16*)((const char*)p.out + (L == 2048 ? SO_U : SO_UC));
  const u16* X0 = (const u16*)((const char*)p.out + (L == 2048 ? SO_X0 : SO_X0C));
  u16* Y = (u16*)(p.ws + OFF_HY);
  u16* Rs0 = (u16*)smem;
  u16* Rs1 = Rs0 + 2 * L + 8;
  const int tid = threadIdx.x, lane = tid & 63, wave = tid >> 6;
  for (int i = tid; i < 2 * L; i += 256) {
    Rs0[i] = R[i];
    Rs1[i] = (i + 1 < 2 * L) ? R[i + 1] : (u16)0;
  }
  __syncthreads();
  const int r = lane & 31, h = lane >> 5;
  const char* lanebase = (r & 1) ? (const char*)Rs1 + 2 * (8 * h - r + L - 1) : (const char*)Rs0 + 2 * (8 * h - r + L);
  const u16* Ub = U + ((size_t)c * 32 + r) * L + 8 * h;
  const int tw0 = th * 1024 + wave * NT * 32;
  f32x16 acc[NT];
#pragma unroll
  for (int i = 0; i < NT; ++i)
#pragma unroll
    for (int e = 0; e < 16; ++e) acc[i][e] = 0.f;
  uint4 nb = *(const uint4*)Ub;
  for (int st = 0; st < L / 16; ++st) {
    uint4 cur = nb;
    if (st + 1 < L / 16) nb = *(const uint4*)(Ub + (st + 1) * 16);
    bf16x8 bfrag = *(bf16x8*)&cur;
#pragma unroll
    for (int i = 0; i < NT; ++i) {
      const unsigned* ap = (const unsigned*)(lanebase + 2 * (st * 16 - (tw0 + i * 32)));
      uint4 av = make_uint4(ap[0], ap[1], ap[2], ap[3]);
      acc[i] = __builtin_amdgcn_mfma_f32_32x32x16_bf16(*(bf16x8*)&av, bfrag, acc[i], 0, 0, 0);
    }
  }
  const int rowbase = (L == 2048) ? r * 2048 : NLAT + r * 256;
#pragma unroll
  for (int i = 0; i < NT; ++i) {
#pragma unroll
    for (int g4 = 0; g4 < 4; ++g4) {
      const int tt = tw0 + i * 32 + 8 * g4 + 4 * h;
      uint2 xv = *(const uint2*)(X0 + ((size_t)c * 32 + r) * L + tt);
      float x0[4] = {bflo(xv.x), bfhi(xv.x), bflo(xv.y), bfhi(xv.y)};
#pragma unroll
      for (int e = 0; e < 4; ++e) Y[(size_t)(rowbase + tt + e) * 1024 + c] = f2bf(acc[i][g4 * 4 + e] * x0[e]);
    }
  }
  __syncthreads();
}

DEV void attn_item(const Params& p, int b, int hq, int qb, bool isctx, char* smem) {
  const u16* P = (const u16*)(p.ws + OFF_BIG);
  u16* Y = (u16*)(p.ws + OFF_HY);
  u16* Ks = (u16*)smem;
  u16* Vt = Ks + 64 * 72;
  const int tid = threadIdx.x, lane = tid & 63, wave = tid >> 6;
  const int nq = lane & 15, quad = lane >> 4;
  const int qrow = (isctx ? NLAT + b * 256 : b * 2048) + qb * 64 + wave * 16 + nq;
  const int qpos = qb * 64 + wave * 16 + nq;
  const int hkv = hq >> 2;
  const int kcol = 2048 + hkv * 64, vcol = 2176 + hkv * 64;
  bf16x8 qf[2];
#pragma unroll
  for (int ks = 0; ks < 2; ++ks)
    qf[ks] = *(const bf16x8*)(P + (size_t)qrow * PS0 + 1536 + hq * 64 + ks * 32 + quad * 8);
  float m = p.attn_sink[hq];
  float lsum = (quad == 0) ? 1.f : 0.f;
  f32x4 oacc[4];
#pragma unroll
  for (int n = 0; n < 4; ++n) oacc[n] = (f32x4){0.f, 0.f, 0.f, 0.f};
  const int nloc = isctx ? 0 : 5;
  for (int ti = 0; ti < nloc + 4; ++ti) {
    int krow0, k0 = 0;
    bool masked;
    if (ti < nloc) {
      k0 = qb * 64 - 128 + ti * 64;
      if (k0 < 0 || k0 >= 2048) continue;
      krow0 = b * 2048 + k0; masked = true;
    } else { krow0 = NLAT + b * 256 + (ti - nloc) * 64; masked = false; }
    __syncthreads();
    {
      const int key = tid >> 2, part = tid & 3;
      const u16* kp = P + (size_t)(krow0 + key) * PS0 + kcol + part * 16;
      const u16* vp = P + (size_t)(krow0 + key) * PS0 + vcol + part * 16;
      uint4 k0v = *(const uint4*)kp, k1v = *(const uint4*)(kp + 8);
      uint4 v0v = *(const uint4*)vp, v1v = *(const uint4*)(vp + 8);
      *(uint4*)(Ks + key * 72 + part * 16) = k0v;
      *(uint4*)(Ks + key * 72 + part * 16 + 8) = k1v;
      unsigned vw[8] = {v0v.x, v0v.y, v0v.z, v0v.w, v1v.x, v1v.y, v1v.z, v1v.w};
#pragma unroll
      for (int j = 0; j < 8; ++j) {
        Vt[(part * 16 + 2 * j) * 72 + key] = (u16)(vw[j] & 0xffffu);
        Vt[(part * 16 + 2 * j + 1) * 72 + key] = (u16)(vw[j] >> 16);
      }
    }
    __syncthreads();
    f32x4 s[4];
#pragma unroll
    for (int n = 0; n < 4; ++n) {
      s[n] = (f32x4){0.f, 0.f, 0.f, 0.f};
#pragma unroll
      for (int ks = 0; ks < 2; ++ks) {
        bf16x8 kf = *(const bf16x8*)(Ks + (n * 16 + nq) * 72 + ks * 32 + quad * 8);
        s[n] = __builtin_amdgcn_mfma_f32_16x16x32_bf16(kf, qf[ks], s[n], 0, 0, 0);
      }
    }
    float mx = -1e30f;
#pragma unroll
    for (int n = 0; n < 4; ++n)
#pragma unroll
      for (int e = 0; e < 4; ++e) {
        float v = s[n][e] * 0.125f;
        if (masked) {
          int kpos = k0 + n * 16 + quad * 4 + e;
          int d = qpos - kpos;
          if (d > 128 || d < -128) v = -1e30f;
        }
        s[n][e] = v;
        mx = fmaxf(mx, v);
      }
    mx = fmaxf(mx, __shfl_xor(mx, 16, 64));
    mx = fmaxf(mx, __shfl_xor(mx, 32, 64));
    const float mn = fmaxf(m, mx);
    const float al = __expf(m - mn);
    m = mn;
    float ps = 0.f;
#pragma unroll
    for (int n = 0; n < 4; ++n)
#pragma unroll
      for (int e = 0; e < 4; ++e) { float pv = __expf(s[n][e] - mn); s[n][e] = pv; ps += pv; }
    lsum = lsum * al + ps;
#pragma unroll
    for (int n = 0; n < 4; ++n)
#pragma unroll
      for (int e = 0; e < 4; ++e) oacc[n][e] *= al;
#pragma unroll
    for (int hh = 0; hh < 2; ++hh) {
      uint4 pw;
      pw.x = pack2(s[2 * hh][0], s[2 * hh][1]); pw.y = pack2(s[2 * hh][2], s[2 * hh][3]);
      pw.z = pack2(s[2 * hh + 1][0], s[2 * hh + 1][1]); pw.w = pack2(s[2 * hh + 1][2], s[2 * hh + 1][3]);
      bf16x8 pb = *(bf16x8*)&pw;
#pragma unroll
      for (int n = 0; n < 4; ++n) {
        const u16* vr = Vt + (n * 16 + nq) * 72 + quad * 4;
        uint2 va = *(const uint2*)(vr + (2 * hh) * 16);
        uint2 vb = *(const uint2*)(vr + (2 * hh + 1) * 16);
        uint4 vv = make_uint4(va.x, va.y, vb.x, vb.y);
        oacc[n] = __builtin_amdgcn_mfma_f32_16x16x32_bf16(*(bf16x8*)&vv, pb, oacc[n], 0, 0, 0);
      }
    }
  }
  lsum += __shfl_xor(lsum, 16, 64);
  lsum += __shfl_xor(lsum, 32, 64);
  const float inv = 1.f / lsum;
  u16* yo = Y + (size_t)qrow * 1024 + 512 + hq * 64 + quad * 4;
#pragma unroll
  for (int n = 0; n < 4; ++n) {
    uint2 w;
    w.x = pack2(oacc[n][0] * inv, oacc[n][1] * inv);
    w.y = pack2(oacc[n][2] * inv, oacc[n][3] * inv);
    *(uint2*)(yo + n * 16) = w;
  }
  __syncthreads();
}

DEV void phase_conv_attn(const Params& p, char* smem) {
  constexpr int N0 = 1024, N1 = N0 + 512, N2 = N1 + 8192, N3 = N2 + 1024;
  for (int it = blockIdx.x; it < N3; it += gridDim.x) {
    if (it < N0) conv_item<2048, 8>(p, it >> 1, it & 1, smem);
    else if (it < N1) conv_item<256, 2>(p, it - N0, 0, smem);
    else if (it < N2) { int a = it - N1; attn_item(p, a >> 8, (a >> 5) & 7, a & 31, false, smem); }
    else { int a = it - N2; attn_item(p, a >> 5, (a >> 2) & 7, a & 3, true, smem); }
  }
}

DEV void lds_wave_sync() {
  asm volatile("s_waitcnt lgkmcnt(0)" ::: "memory");
  __builtin_amdgcn_wave_barrier();
}

DEV void rwkv_item(const Params& p, int ri, char* smem) {
  const u16* P = (const u16*)(p.ws + OFF_BIG);
  u16* O4 = (u16*)p.out;
  float* BS = (float*)(p.ws + OFF_BSUM);
  const int tid0 = threadIdx.x;
  const int wp0 = tid0 >> 7;
  const int cid = ri * 2 + wp0;
  const int b = cid >> 4, d = (cid >> 3) & 1, h = cid & 7;
  f32x4 S[4][2];
#pragma unroll
  for (int i = 0; i < 4; ++i)
#pragma unroll
    for (int j = 0; j < 2; ++j) S[i][j] = (f32x4){0.f, 0.f, 0.f, 0.f};
  uint4 bw[2][4];
  float l0[4];
  {
    const int lane = tid0 & 63, wi = (tid0 >> 6) & 1, fr = lane & 15, fq = lane >> 4;
    const float* wsrc = (wi == 0 ? p.rw_w2 : p.rw_a2) + (size_t)d * 64 * 512 + h * 64;
    const float* bsrc = (wi == 0 ? p.rw_w0 : p.rw_a0) + d * 512 + h * 64;
#pragma unroll
    for (int nt = 0; nt < 4; ++nt) {
      l0[nt] = bsrc[nt * 16 + fr];
#pragma unroll
      for (int ks = 0; ks < 2; ++ks) {
        __builtin_amdgcn_sched_barrier(0);
        float f[8];
        const float* wp_ = wsrc + (size_t)(ks * 32 + fq * 8) * 512 + nt * 16 + fr;
#pragma unroll
        for (int j = 0; j < 8; ++j) f[j] = wp_[j * 512];
        bw[ks][nt] = pack8(f);
      }
    }
  }
  uint4 pre[5][3];
#define RW_LOAD(CI)                                                                                 \
  {                                                                                                 \
    const int seg_ = (CI) < 16 ? 0 : 1;                                                             \
    const int ch_ = seg_ ? (CI)-16 : (CI);                                                          \
    const int Ls_ = seg_ ? 2048 : 256;                                                              \
    const int rb_ = seg_ ? b * 2048 : NLAT + b * 256;                                               \
    const int sidx_ = ch_ * 16 + stt;                                                               \
    const int t_ = d == 0 ? sidx_ : Ls_ - 1 - sidx_;                                                \
    const u16* prow_ = P + (size_t)(rb_ + t_) * PS1 + spart * 8;                                    \
    _Pragma("unroll") for (int g = 0; g < 5; ++g) {                                                 \
      const int col_ = g < 3 ? g * 512 + h * 64 : (g == 3 ? 1536 + d * 64 : 1664 + d * 64);         \
      _Pragma("unroll") for (int tap = 0; tap < 3; ++tap) {                                         \
        const int tt_ = t_ + tap - 1;                                                               \
        if (tt_ >= 0 && tt_ < Ls_) pre[g][tap] = *(const uint4*)(prow_ + (ptrdiff_t)(tap - 1) * PS1 + col_); \
        else pre[g][tap] = make_uint4(0u, 0u, 0u, 0u);                                              \
      }                                                                                             \
    }                                                                                               \
  }
  {
    const int pt = tid0 & 127, stt = pt >> 3, spart = pt & 7;
    RW_LOAD(0)
  }
  for (int cidx = 0; cidx < 144; ++cidx) {
    asm volatile("" ::: "memory");
    int tid = tid0;
    asm volatile("" : "+v"(tid));
    const int lane = tid & 63, wave = tid >> 6, wp = wave >> 1, wi = wave & 1, pt = tid & 127;
    const int fr = lane & 15, fq = lane >> 4, stt = pt >> 3, spart = pt & 7;
    const int seg = cidx < 16 ? 0 : 1;
    const int ch = seg ? cidx - 16 : cidx;
    const int Ls = seg ? 2048 : 256;
    char* base = smem + wp * 32768;
    u16* RK = (u16*)base;
    u16* KD = RK + 1152;
    u16* KK = KD + 1152;
    u16* AB = KK + 1152;
    u16* VT = AB + 1152;
    float* LW = (float*)(base + 11264);
    u16* TW = (u16*)(base + 15360);
    u16* AD = TW + 1152;
    u16* BgCT = (u16*)(base + 19968);
    u16* KgCT = BgCT + 1024;
    float* gC = (float*)(base + 24064);
    float* Amat = (float*)(base + 24320) + wi * 256;
    u16* Tinv = (u16*)(base + 26368) + wi * 256;
    u16* BG = (u16*)(base + 27392);
    {
      const int o = stt * 72 + spart * 8;
#pragma unroll
      for (int g = 0; g < 5; ++g) {
        __builtin_amdgcn_sched_barrier(0);
        const int col = g < 3 ? g * 512 + h * 64 : (g == 3 ? 1536 + d * 64 : 1664 + d * 64);
        float pc[8], pp[8], pn[8], v[8];
        unpack8(pre[g][1], pc); unpack8(pre[g][0], pp); unpack8(pre[g][2], pn);
        const float* mu = p.rw_mu + col + spart * 8;
        float4 m0 = *(const float4*)mu, m1 = *(const float4*)(mu + 4);
        const float mm[8] = {m0.x, m0.y, m0.z, m0.w, m1.x, m1.y, m1.z, m1.w};
#pragma unroll
        for (int j = 0; j < 8; ++j) v[j] = pc[j] + mm[j] * (0.5f * (pp[j] + pn[j]) - pc[j]);
        if (g == 0) *(uint4*)(RK + o) = pack8(v);
        else if (g == 1) {
          *(uint4*)(KD + o) = pack8(v);
          const float* kkw = p.rw_kk + h * 64 + spart * 8;
          float kkv[8];
          float ss = 0.f;
#pragma unroll
          for (int j = 0; j < 8; ++j) { kkv[j] = v[j] * kkw[j]; ss += kkv[j] * kkv[j]; }
          ss += __shfl_xor(ss, 1, 64); ss += __shfl_xor(ss, 2, 64); ss += __shfl_xor(ss, 4, 64);
          const float inv = rsqrtf(ss + 1e-6f);
#pragma unroll
          for (int j = 0; j < 8; ++j) kkv[j] *= inv;
          *(uint4*)(KK + o) = pack8(kkv);
        } else if (g == 2) {
#pragma unroll
          for (int j = 0; j < 8; ++j) VT[(spart * 8 + j) * 16 + stt] = f2bf(v[j]);
        } else if (g == 3) {
#pragma unroll
          for (int j = 0; j < 8; ++j) v[j] = fast_tanh(v[j]);
          *(uint4*)(TW + o) = pack8(v);
        } else *(uint4*)(AD + o) = pack8(v);
      }
    }
    __syncthreads();
    if (cidx + 1 < 144) RW_LOAD(cidx + 1)
    {
      const u16* IN = wi == 0 ? TW : AD;
      bf16x8 af0 = *(const bf16x8*)(IN + fr * 72 + fq * 8);
      bf16x8 af1 = *(const bf16x8*)(IN + fr * 72 + 32 + fq * 8);
#pragma unroll
      for (int nt = 0; nt < 4; ++nt) {
        f32x4 o4 = (f32x4){0.f, 0.f, 0.f, 0.f};
        o4 = __builtin_amdgcn_mfma_f32_16x16x32_bf16(af0, *(bf16x8*)&bw[0][nt], o4, 0, 0, 0);
        o4 = __builtin_amdgcn_mfma_f32_16x16x32_bf16(af1, *(bf16x8*)&bw[1][nt], o4, 0, 0, 0);
#pragma unroll
        for (int e = 0; e < 4; ++e) {
          const float prev = l0[nt] + o4[e];
          const int t = fq * 4 + e, c = nt * 16 + fr;
          if (wi == 0) LW[t * 64 + c] = -__expf(-softplus(-prev) - 0.5f);
          else AB[t * 72 + c] = f2bf(sigm(prev));
        }
      }
    }
    __syncthreads();
    {
      const int c = lane;
      float cum = 0.f;
      if (wi == 0) {
#pragma unroll 4
        for (int t = 0; t < 16; ++t) {
          const float lw = LW[t * 64 + c];
          const float gp = __expf(cum);
          cum += lw;
          const float gi = __expf(-cum);
          const float kk = bf2f(KK[t * 72 + c]);
          const float a = bf2f(AB[t * 72 + c]);
          KK[t * 72 + c] = f2bf(kk * gp);
          BG[t * 72 + c] = f2bf(kk * a * gi);
        }
        const float gCv = __expf(cum);
        gC[c] = gCv;
#pragma unroll 4
        for (int t = 0; t < 16; ++t) BgCT[c * 16 + t] = f2bf(-bf2f(BG[t * 72 + c]) * gCv);
      } else {
        float* PR = (float*)TW;
        const float kac = p.rw_ka[h * 64 + c], rkc = p.rw_rk[h * 64 + c];
#pragma unroll 4
        for (int t = 0; t < 16; ++t) {
          const float lw = LW[t * 64 + c];
          cum += lw;
          const float g = __expf(cum), gi = __expf(-cum);
          const float r = bf2f(RK[t * 72 + c]);
          const float k = bf2f(KD[t * 72 + c]);
          const float a = bf2f(AB[t * 72 + c]);
          const float kd = k * (1.f + (a - 1.f) * kac);
          RK[t * 72 + c] = f2bf(r * g);
          KD[t * 72 + c] = f2bf(kd * gi);
          PR[t * 64 + c] = r * kd * rkc;
        }
        const float gCv = __expf(cum);
#pragma unroll 4
        for (int t = 0; t < 16; ++t) KgCT[c * 16 + t] = f2bf(bf2f(KD[t * 72 + c]) * gCv);
        lds_wave_sync();
        {
          const int t = lane >> 2, sg = lane & 3;
          const float4 q0 = *(const float4*)(PR + t * 64 + sg * 16), q1 = *(const float4*)(PR + t * 64 + sg * 16 + 4);
          const float4 q2 = *(const float4*)(PR + t * 64 + sg * 16 + 8), q3 = *(const float4*)(PR + t * 64 + sg * 16 + 12);
          float bsum = (q0.x + q0.y + q0.z + q0.w) + (q1.x + q1.y + q1.z + q1.w) + (q2.x + q2.y + q2.z + q2.w) + (q3.x + q3.y + q3.z + q3.w);
          bsum += __shfl_xor(bsum, 1, 64);
          bsum += __shfl_xor(bsum, 2, 64);
          if (seg == 1 && sg == 0) {
            const int sidx = ch * 16 + t;
            const int tpos = d == 0 ? sidx : 2047 - sidx;
            BS[(size_t)(b * 2048 + tpos) * 16 + h * 2 + d] = bsum;
          }
        }
      }
    }
    __syncthreads();
    __builtin_amdgcn_sched_barrier(0);
    {
      f32x4 XabT = (f32x4){0.f, 0.f, 0.f, 0.f}, XakT = XabT, XrbT = XabT, XrkT = XabT;
#pragma unroll
      for (int ks = 0; ks < 2; ++ks) {
        bf16x8 kkf = *(const bf16x8*)(KK + fr * 72 + ks * 32 + fq * 8);
        bf16x8 rgf = *(const bf16x8*)(RK + fr * 72 + ks * 32 + fq * 8);
        bf16x8 bgf = *(const bf16x8*)(BG + fr * 72 + ks * 32 + fq * 8);
        bf16x8 kgf = *(const bf16x8*)(KD + fr * 72 + ks * 32 + fq * 8);
        XabT = __builtin_amdgcn_mfma_f32_16x16x32_bf16(bgf, kkf, XabT, 0, 0, 0);
        XakT = __builtin_amdgcn_mfma_f32_16x16x32_bf16(kgf, kkf, XakT, 0, 0, 0);
        XrbT = __builtin_amdgcn_mfma_f32_16x16x32_bf16(bgf, rgf, XrbT, 0, 0, 0);
        XrkT = __builtin_amdgcn_mfma_f32_16x16x32_bf16(kgf, rgf, XrkT, 0, 0, 0);
      }
      {
        float am[4];
#pragma unroll
        for (int e = 0; e < 4; ++e) am[e] = (fq * 4 + e < fr) ? XabT[e] : 0.f;
        *(float4*)(Amat + fr * 16 + fq * 4) = make_float4(am[0], am[1], am[2], am[3]);
      }
      lds_wave_sync();
      if (lane < 16) {
        float x[16];
        x[0] = (lane == 0) ? 1.f : 0.f;
        float4 cur[4], nxt[4];
        cur[0] = *(const float4*)(Amat + 16);
        cur[1] = cur[0]; cur[2] = cur[0]; cur[3] = cur[0];
#pragma unroll
        for (int i = 1; i < 16; ++i) {
          __builtin_amdgcn_sched_barrier(0);
          if (i + 1 < 16) {
#pragma unroll
            for (int q = 0; q < (i + 4) / 4; ++q) nxt[q] = *(const float4*)(Amat + (i + 1) * 16 + q * 4);
          }
          float acc = (i == lane) ? 1.f : 0.f;
#pragma unroll
          for (int j = 0; j < i; ++j) {
            const float4 rv = cur[j >> 2];
            const float av = (j & 3) == 0 ? rv.x : ((j & 3) == 1 ? rv.y : ((j & 3) == 2 ? rv.z : rv.w));
            acc -= av * x[j];
          }
          x[i] = acc;
#pragma unroll
          for (int q = 0; q < 4; ++q) cur[q] = nxt[q];
        }
#pragma unroll
        for (int i = 0; i < 16; ++i) Tinv[i * 16 + lane] = f2bf(x[i]);
      }
      lds_wave_sync();
      f32x4 sa0[2], y0[2];
#pragma unroll
      for (int nt = 0; nt < 2; ++nt) { sa0[nt] = (f32x4){0.f, 0.f, 0.f, 0.f}; y0[nt] = (f32x4){0.f, 0.f, 0.f, 0.f}; }
#pragma unroll
      for (int x = 0; x < 2; ++x) {
        __builtin_amdgcn_sched_barrier(0);
        uint2 k0 = *(const uint2*)(KK + fr * 72 + 32 * x + fq * 4);
        uint2 k1 = *(const uint2*)(KK + fr * 72 + 32 * x + 16 + fq * 4);
        uint2 r0 = *(const uint2*)(RK + fr * 72 + 32 * x + fq * 4);
        uint2 r1 = *(const uint2*)(RK + fr * 72 + 32 * x + 16 + fq * 4);
        uint4 kw = make_uint4(k0.x, k0.y, k1.x, k1.y);
        uint4 rw = make_uint4(r0.x, r0.y, r1.x, r1.y);
#pragma unroll
        for (int nt = 0; nt < 2; ++nt) {
          uint4 sw;
          sw.x = pack2(S[2 * x][nt][0], S[2 * x][nt][1]); sw.y = pack2(S[2 * x][nt][2], S[2 * x][nt][3]);
          sw.z = pack2(S[2 * x + 1][nt][0], S[2 * x + 1][nt][1]); sw.w = pack2(S[2 * x + 1][nt][2], S[2 * x + 1][nt][3]);
          sa0[nt] = __builtin_amdgcn_mfma_f32_16x16x32_bf16(*(bf16x8*)&kw, *(bf16x8*)&sw, sa0[nt], 0, 0, 0);
          y0[nt] = __builtin_amdgcn_mfma_f32_16x16x32_bf16(*(bf16x8*)&rw, *(bf16x8*)&sw, y0[nt], 0, 0, 0);
        }
      }
      float ak[4], rb[4], rk[4];
#pragma unroll
      for (int e = 0; e < 4; ++e) {
        const int j = fq * 4 + e;
        ak[e] = (j < fr) ? XakT[e] : 0.f;
        rb[e] = (j <= fr) ? -XrbT[e] : 0.f;
        rk[e] = (j <= fr) ? XrkT[e] : 0.f;
      }
      const uint4 akw = make_uint4(pack2(ak[0], ak[1]), pack2(ak[2], ak[3]), 0u, 0u);
      const uint4 ybw = make_uint4(pack2(rb[0], rb[1]), pack2(rb[2], rb[3]), pack2(rk[0], rk[1]), pack2(rk[2], rk[3]));
      const uint2 tv = *(const uint2*)(Tinv + fr * 16 + fq * 4);
      const uint4 tw = make_uint4(tv.x, tv.y, 0u, 0u);
      uint4 sv[2];
#pragma unroll
      for (int nt = 0; nt < 2; ++nt) {
        const int vc = wi * 32 + nt * 16 + fr;
        const uint2 vt = *(const uint2*)(VT + vc * 16 + fq * 4);
        const uint4 vb = make_uint4(vt.x, vt.y, 0u, 0u);
        f32x4 rhs = __builtin_amdgcn_mfma_f32_16x16x32_bf16(*(bf16x8*)&akw, *(bf16x8*)&vb, sa0[nt], 0, 0, 0);
        const uint4 rw = make_uint4(pack2(rhs[0], rhs[1]), pack2(rhs[2], rhs[3]), 0u, 0u);
        f32x4 sa = __builtin_amdgcn_mfma_f32_16x16x32_bf16(*(bf16x8*)&tw, *(bf16x8*)&rw, (f32x4){0.f, 0.f, 0.f, 0.f}, 0, 0, 0);
        sv[nt] = make_uint4(pack2(sa[0], sa[1]), pack2(sa[2], sa[3]), vt.x, vt.y);
        f32x4 y = __builtin_amdgcn_mfma_f32_16x16x32_bf16(*(bf16x8*)&ybw, *(bf16x8*)&sv[nt], y0[nt], 0, 0, 0);
        if (seg == 1) {
#pragma unroll
          for (int e = 0; e < 4; ++e) {
            const int sidx = ch * 16 + fq * 4 + e;
            const int tpos = d == 0 ? sidx : 2047 - sidx;
            O4[((size_t)d * NLAT + b * 2048 + tpos) * 512 + h * 64 + vc] = f2bf(y[e]);
          }
        }
      }
#pragma unroll
      for (int mt = 0; mt < 4; ++mt) {
        __builtin_amdgcn_sched_barrier(0);
        const float4 g4 = *(const float4*)(gC + mt * 16 + fq * 4);
        const uint2 bv = *(const uint2*)(BgCT + (mt * 16 + fr) * 16 + fq * 4);
        const uint2 kv = *(const uint2*)(KgCT + (mt * 16 + fr) * 16 + fq * 4);
        const uint4 aw = make_uint4(bv.x, bv.y, kv.x, kv.y);
#pragma unroll
        for (int nt = 0; nt < 2; ++nt) {
          S[mt][nt][0] *= g4.x; S[mt][nt][1] *= g4.y; S[mt][nt][2] *= g4.z; S[mt][nt][3] *= g4.w;
          S[mt][nt] = __builtin_amdgcn_mfma_f32_16x16x32_bf16(*(bf16x8*)&aw, *(bf16x8*)&sv[nt], S[mt][nt], 0, 0, 0);
        }
      }
    }
    __syncthreads();
  }
#undef RW_LOAD
}

DEV void gdn_item(const Params& p, int gi, char* smem) {
  const u16* P = (const u16*)(p.ws + OFF_BIG);
  u16* O4 = (u16*)p.out;
  const int tid0 = threadIdx.x;
  const int b = gi >> 3, d = (gi >> 2) & 1, h = gi & 3;
  constexpr int BUFB = 23424;
  f32x4 S[8][2];
#pragma unroll
  for (int i = 0; i < 8; ++i)
#pragma unroll
    for (int j = 0; j < 2; ++j) S[i][j] = (f32x4){0.f, 0.f, 0.f, 0.f};
  const float negA = -__expf(p.dn_A_log[d * 4 + h]);
  const float dtb = p.dn_dt_bias[d * 4 + h];
  uint4 pre[3][3];
  float gpre0 = 0.f, gpre1 = 0.f;
#define GDN_LOAD(CI)                                                                               \
  {                                                                                                \
    const int seg_ = (CI) < 16 ? 0 : 1;                                                            \
    const int ch_ = seg_ ? (CI)-16 : (CI);                                                         \
    const int Ls_ = seg_ ? 2048 : 256;                                                             \
    const int rb_ = seg_ ? b * 2048 : NLAT + b * 256;                                              \
    const int sidx_ = ch_ * 16 + stt;                                                              \
    const int t_ = d == 0 ? sidx_ : Ls_ - 1 - sidx_;                                               \
    const u16* prow_ = P + (size_t)(rb_ + t_) * PS1 + DNO;                                         \
    _Pragma("unroll") for (int g = 0; g < 3; ++g) {                                                \
      const int col_ = g * 512 + h * 128 + spart * 8;                                              \
      _Pragma("unroll") for (int tap = 0; tap < 3; ++tap) {                                        \
        const int tt_ = t_ + tap - 1;                                                              \
        if (tt_ >= 0 && tt_ < Ls_) pre[g][tap] = *(const uint4*)(prow_ + (ptrdiff_t)(tap - 1) * PS1 + col_); \
        else pre[g][tap] = make_uint4(0u, 0u, 0u, 0u);                                             \
      }                                                                                            \
    }                                                                                              \
    if (wave == 0) {                                                                               \
      const int s2_ = ch_ * 16 + fr;                                                               \
      const int t2_ = d == 0 ? s2_ : Ls_ - 1 - s2_;                                                \
      const u16* gr_ = P + (size_t)(rb_ + t2_) * PS1 + DNO + 2048;                                 \
      gpre0 = bf2f(gr_[d * 4 + h]);                                                                \
      gpre1 = bf2f(gr_[8 + d * 4 + h]);                                                            \
    }                                                                                              \
  }
  {
    const int tid = tid0, lane = tid & 63, wave = tid >> 6, fr = lane & 15, stt = tid >> 4, spart = tid & 15;
    GDN_LOAD(0)
  }
  for (int cidx = 0; cidx < 144; ++cidx) {
    asm volatile("" ::: "memory");
    int tid = tid0;
    asm volatile("" : "+v"(tid));
    const int lane = tid & 63, wave = tid >> 6, fr = lane & 15, fq = lane >> 4, stt = tid >> 4, spart = tid & 15;
    char* buf = smem;
    u16* Kb = (u16*)buf;
    u16* Qb = Kb + 16 * 136;
    float* Vf = (float*)(buf + 8704);
    u16* KdT = (u16*)(buf + 17152);
    u16* Tinv = (u16*)(buf + 21248);
    u16* Pm = (u16*)(buf + 21760);
    float* Amat = (float*)(buf + 22272);
    float* Gs = (float*)(buf + 23296);
    float* Bs = Gs + 16;
#pragma unroll
    for (int g = 0; g < 3; ++g) {
      __builtin_amdgcn_sched_barrier(0);
      const int col = g * 512 + h * 128 + spart * 8;
      float z[8];
#pragma unroll
      for (int j = 0; j < 8; ++j) z[j] = 0.f;
#pragma unroll
      for (int tap = 0; tap < 3; ++tap) {
        __builtin_amdgcn_sched_barrier(0);
        float f[8];
        unpack8(pre[g][tap], f);
        const float* w = p.dn_conv + tap * 1536 + col;
        float4 w0 = *(const float4*)w, w1 = *(const float4*)(w + 4);
        z[0] += f[0] * w0.x; z[1] += f[1] * w0.y; z[2] += f[2] * w0.z; z[3] += f[3] * w0.w;
        z[4] += f[4] * w1.x; z[5] += f[5] * w1.y; z[6] += f[6] * w1.z; z[7] += f[7] * w1.w;
      }
      float ss = 0.f;
#pragma unroll
      for (int j = 0; j < 8; ++j) { z[j] = silu(z[j]); ss += z[j] * z[j]; }
      if (g < 2) {
        ss += __shfl_xor(ss, 1, 64); ss += __shfl_xor(ss, 2, 64); ss += __shfl_xor(ss, 4, 64); ss += __shfl_xor(ss, 8, 64);
        float sc = rsqrtf(ss + 1e-6f);
        if (g == 0) sc *= 0.08838834764831845f;
#pragma unroll
        for (int j = 0; j < 8; ++j) z[j] *= sc;
        *(uint4*)((g == 0 ? Qb : Kb) + stt * 136 + spart * 8) = pack8(z);
      } else {
        float* dst = Vf + stt * 132 + spart * 8;
        *(float4*)dst = make_float4(z[0], z[1], z[2], z[3]);
        *(float4*)(dst + 4) = make_float4(z[4], z[5], z[6], z[7]);
      }
    }
    if (wave == 0) {
      float g = negA * softplus(gpre0 + dtb);
#pragma unroll
      for (int o = 1; o < 16; o <<= 1) { float n = __shfl_up(g, o, 16); if (fr >= o) g += n; }
      if (lane < 16) { Gs[lane] = g; Bs[lane] = sigm(gpre1); }
    }
    __syncthreads();
    if (wave == 0) {
      f32x4 kk = (f32x4){0.f, 0.f, 0.f, 0.f};
#pragma unroll
      for (int ks = 0; ks < 4; ++ks) {
        bf16x8 kf = *(const bf16x8*)(Kb + fr * 136 + ks * 32 + fq * 8);
        kk = __builtin_amdgcn_mfma_f32_16x16x32_bf16(kf, kf, kk, 0, 0, 0);
      }
      const float Gj = Gs[fr];
#pragma unroll
      for (int e = 0; e < 4; ++e) {
        const int i = fq * 4 + e;
        const float a = (fr < i) ? Bs[i] * kk[e] * __expf(Gs[i] - Gj) : 0.f;
        Amat[i * 16 + fr] = a;
      }
      lds_wave_sync();
      if (lane < 16) {
        float x[16];
        x[0] = (lane == 0) ? 1.f : 0.f;
        float4 cur[4], nxt[4];
        cur[0] = *(const float4*)(Amat + 16);
        cur[1] = cur[0]; cur[2] = cur[0]; cur[3] = cur[0];
#pragma unroll
        for (int i = 1; i < 16; ++i) {
          __builtin_amdgcn_sched_barrier(0);
          if (i + 1 < 16) {
#pragma unroll
            for (int q = 0; q < (i + 4) / 4; ++q) nxt[q] = *(const float4*)(Amat + (i + 1) * 16 + q * 4);
          }
          float acc = (i == lane) ? 1.f : 0.f;
#pragma unroll
          for (int j = 0; j < i; ++j) {
            const float4 rv = cur[j >> 2];
            const float av = (j & 3) == 0 ? rv.x : ((j & 3) == 1 ? rv.y : ((j & 3) == 2 ? rv.z : rv.w));
            acc -= av * x[j];
          }
          x[i] = acc;
#pragma unroll
          for (int q = 0; q < 4; ++q) cur[q] = nxt[q];
        }
#pragma unroll
        for (int i = 0; i < 16; ++i) Tinv[i * 16 + lane] = f2bf(x[i]);
      }
    } else if (wave == 1) {
      f32x4 qk = (f32x4){0.f, 0.f, 0.f, 0.f};
#pragma unroll
      for (int ks = 0; ks < 4; ++ks) {
        bf16x8 qf = *(const bf16x8*)(Qb + fr * 136 + ks * 32 + fq * 8);
        bf16x8 kf = *(const bf16x8*)(Kb + fr * 136 + ks * 32 + fq * 8);
        qk = __builtin_amdgcn_mfma_f32_16x16x32_bf16(qf, kf, qk, 0, 0, 0);
      }
      const float Gj = Gs[fr];
#pragma unroll
      for (int e = 0; e < 4; ++e) {
        const int t = fq * 4 + e;
        const float v = (fr <= t) ? qk[e] * __expf(Gs[t] - Gj) : 0.f;
        Pm[t * 16 + fr] = f2bf(v);
      }
    } else {
      const int k = tid - 128;
      const float GC = Gs[15];
      unsigned w[8];
#pragma unroll
      for (int j = 0; j < 8; ++j) {
        __builtin_amdgcn_sched_barrier(0);
        float v0 = bf2f(Kb[(2 * j) * 136 + k]) * __expf(GC - Gs[2 * j]);
        float v1 = bf2f(Kb[(2 * j + 1) * 136 + k]) * __expf(GC - Gs[2 * j + 1]);
        w[j] = pack2(v0, v1);
      }
      *(uint4*)(KdT + k * 16) = make_uint4(w[0], w[1], w[2], w[3]);
      *(uint4*)(KdT + k * 16 + 8) = make_uint4(w[4], w[5], w[6], w[7]);
    }
    __builtin_amdgcn_sched_barrier(0);
    f32x4 ksv[2], qsv[2];
#pragma unroll
    for (int nt = 0; nt < 2; ++nt) { ksv[nt] = (f32x4){0.f, 0.f, 0.f, 0.f}; qsv[nt] = (f32x4){0.f, 0.f, 0.f, 0.f}; }
#pragma unroll
    for (int x = 0; x < 4; ++x) {
      __builtin_amdgcn_sched_barrier(0);
      uint2 k0 = *(const uint2*)(Kb + fr * 136 + 32 * x + fq * 4);
      uint2 k1 = *(const uint2*)(Kb + fr * 136 + 32 * x + 16 + fq * 4);
      uint2 q0 = *(const uint2*)(Qb + fr * 136 + 32 * x + fq * 4);
      uint2 q1 = *(const uint2*)(Qb + fr * 136 + 32 * x + 16 + fq * 4);
      uint4 kw = make_uint4(k0.x, k0.y, k1.x, k1.y);
      uint4 qw = make_uint4(q0.x, q0.y, q1.x, q1.y);
#pragma unroll
      for (int nt = 0; nt < 2; ++nt) {
        uint4 sw;
        sw.x = pack2(S[2 * x][nt][0], S[2 * x][nt][1]); sw.y = pack2(S[2 * x][nt][2], S[2 * x][nt][3]);
        sw.z = pack2(S[2 * x + 1][nt][0], S[2 * x + 1][nt][1]); sw.w = pack2(S[2 * x + 1][nt][2], S[2 * x + 1][nt][3]);
        ksv[nt] = __builtin_amdgcn_mfma_f32_16x16x32_bf16(*(bf16x8*)&kw, *(bf16x8*)&sw, ksv[nt], 0, 0, 0);
        qsv[nt] = __builtin_amdgcn_mfma_f32_16x16x32_bf16(*(bf16x8*)&qw, *(bf16x8*)&sw, qsv[nt], 0, 0, 0);
      }
    }
    __syncthreads();
    if (cidx + 1 < 144) GDN_LOAD(cidx + 1)
    __builtin_amdgcn_sched_barrier(0);
    {
      const int seg = cidx < 16 ? 0 : 1;
      const int ch = seg ? cidx - 16 : cidx;
      float eG[4], bt[4];
#pragma unroll
      for (int e = 0; e < 4; ++e) { eG[e] = __expf(Gs[fq * 4 + e]); bt[e] = Bs[fq * 4 + e]; }
      const float eGC = __expf(Gs[15]);
      uint2 tv = *(const uint2*)(Tinv + fr * 16 + fq * 4);
      uint2 pv = *(const uint2*)(Pm + fr * 16 + fq * 4);
      uint4 tw = make_uint4(tv.x, tv.y, 0u, 0u);
      uint4 pw = make_uint4(pv.x, pv.y, 0u, 0u);
      uint4 ub[2];
#pragma unroll
      for (int nt = 0; nt < 2; ++nt) {
        const int vc = wave * 32 + nt * 16 + fr;
        float rhs[4];
#pragma unroll
        for (int e = 0; e < 4; ++e) rhs[e] = bt[e] * (Vf[(fq * 4 + e) * 132 + vc] - eG[e] * ksv[nt][e]);
        uint4 rw = make_uint4(pack2(rhs[0], rhs[1]), pack2(rhs[2], rhs[3]), 0u, 0u);
        f32x4 u = __builtin_amdgcn_mfma_f32_16x16x32_bf16(*(bf16x8*)&tw, *(bf16x8*)&rw, (f32x4){0.f, 0.f, 0.f, 0.f}, 0, 0, 0);
        ub[nt] = make_uint4(pack2(u[0], u[1]), pack2(u[2], u[3]), 0u, 0u);
        f32x4 oa;
#pragma unroll
        for (int e = 0; e < 4; ++e) oa[e] = eG[e] * qsv[nt][e];
        oa = __builtin_amdgcn_mfma_f32_16x16x32_bf16(*(bf16x8*)&pw, *(bf16x8*)&ub[nt], oa, 0, 0, 0);
        if (seg == 1) {
#pragma unroll
          for (int e = 0; e < 4; ++e) {
            const int sidx = ch * 16 + fq * 4 + e;
            const int t = d == 0 ? sidx : 2047 - sidx;
            O4[((size_t)(2 + d) * NLAT + b * 2048 + t) * 512 + h * 128 + vc] = f2bf(oa[e]);
          }
        }
      }
#pragma unroll
      for (int mt = 0; mt < 8; ++mt) {
        __builtin_amdgcn_sched_barrier(0);
        uint2 kv = *(const uint2*)(KdT + (mt * 16 + fr) * 16 + fq * 4);
        uint4 kw = make_uint4(kv.x, kv.y, 0u, 0u);
#pragma unroll
        for (int nt = 0; nt < 2; ++nt) {
#pragma unroll
          for (int e = 0; e < 4; ++e) S[mt][nt][e] *= eGC;
          S[mt][nt] = __builtin_amdgcn_mfma_f32_16x16x32_bf16(*(bf16x8*)&kw, *(bf16x8*)&ub[nt], S[mt][nt], 0, 0, 0);
        }
      }
    }
    __syncthreads();
  }
#undef GDN_LOAD
}

DEV void phase_scans(const Params& p, char* smem) {
#pragma unroll 1
  for (int it = blockIdx.x; it < 512; it += gridDim.x)
    if (it & 1) rwkv_item(p, it >> 1, smem);
  __builtin_amdgcn_sched_barrier(0);
#pragma unroll 1
  for (int it = blockIdx.x; it < 512; it += gridDim.x)
    if (!(it & 1)) gdn_item(p, it >> 1, smem);
}

DEV void mixout_item(const Params& p, int it, char* smem) {
  const u16* P = (const u16*)(p.ws + OFF_BIG);
  const u16* O4 = (const u16*)p.out;
  const float* BS = (const float*)(p.ws + OFF_BSUM);
  const u16* G2T = (const u16*)(p.ws + OFF_G2T);
  u16* Y = (u16*)(p.ws + OFF_HY);
  u16* sg = (u16*)smem;
  u16* G = sg + 32 * 136;
  const int tid = threadIdx.x, lane = tid & 63, wave = tid >> 6;
  const int fr = lane & 15, fq = lane >> 4;
  const int tok0 = it * 32, tl0 = tok0 & 2047;
  const int tk = tid >> 3, part = tid & 7;
  const int row = tok0 + tk, t = tl0 + tk;
  const bool hasp = t > 0, hasn = t + 1 < 2048;
  const u16* prow = P + (size_t)row * PS1;
  {
#pragma unroll
    for (int q = 0; q < 2; ++q) {
      const int col = 1792 + part * 16 + q * 8;
      float pc[8], pp[8], pn[8], v[8];
      unpack8(*(const uint4*)(prow + col), pc);
      if (hasp) unpack8(*(const uint4*)(prow - PS1 + col), pp);
      else {
#pragma unroll
        for (int j = 0; j < 8; ++j) pp[j] = 0.f;
      }
      if (hasn) unpack8(*(const uint4*)(prow + PS1 + col), pn);
      else {
#pragma unroll
        for (int j = 0; j < 8; ++j) pn[j] = 0.f;
      }
      const float* mu = p.rw_mu + col;
#pragma unroll
      for (int j = 0; j < 8; ++j) v[j] = sigm(pc[j] + mu[j] * (0.5f * (pp[j] + pn[j]) - pc[j]));
      *(uint4*)(sg + tk * 136 + part * 16 + q * 8) = pack8(v);
    }
  }
  __syncthreads();
  {
    bf16x8 af[2][4];
#pragma unroll
    for (int mt = 0; mt < 2; ++mt)
#pragma unroll
      for (int ks = 0; ks < 4; ++ks) af[mt][ks] = *(const bf16x8*)(sg + (mt * 16 + fr) * 136 + ks * 32 + fq * 8);
#pragma unroll
    for (int nt = 0; nt < 8; ++nt) {
      const u16* bp = G2T + (size_t)(wave * 128 + nt * 16 + fr) * 128 + fq * 8;
      bf16x8 bf0 = *(const bf16x8*)(bp), bf1 = *(const bf16x8*)(bp + 32), bf2 = *(const bf16x8*)(bp + 64), bf3 = *(const bf16x8*)(bp + 96);
#pragma unroll
      for (int mt = 0; mt < 2; ++mt) {
        f32x4 a = (f32x4){0.f, 0.f, 0.f, 0.f};
        a = __builtin_amdgcn_mfma_f32_16x16x32_bf16(af[mt][0], bf0, a, 0, 0, 0);
        a = __builtin_amdgcn_mfma_f32_16x16x32_bf16(af[mt][1], bf1, a, 0, 0, 0);
        a = __builtin_amdgcn_mfma_f32_16x16x32_bf16(af[mt][2], bf2, a, 0, 0, 0);
        a = __builtin_amdgcn_mfma_f32_16x16x32_bf16(af[mt][3], bf3, a, 0, 0, 0);
#pragma unroll
        for (int e = 0; e < 4; ++e) G[(mt * 16 + fq * 4 + e) * 520 + wave * 128 + nt * 16 + fr] = f2bf(a[e]);
      }
    }
  }
  __syncthreads();
  {
    const int hd = part, c0 = hd * 64;
    const u16* of = O4 + (size_t)row * 512 + c0;
    const u16* ob = O4 + ((size_t)NLAT + row) * 512 + c0;
    const float bsum = BS[(size_t)row * 16 + hd * 2] + BS[(size_t)row * 16 + hd * 2 + 1];
    float s1 = 0.f, s2 = 0.f;
#pragma unroll
    for (int q = 0; q < 8; ++q) {
      float a[8], b8[8];
      unpack8(*(const uint4*)(of + q * 8), a);
      unpack8(*(const uint4*)(ob + q * 8), b8);
#pragma unroll
      for (int j = 0; j < 8; ++j) { const float v = a[j] + b8[j]; s1 += v; s2 += v * v; }
    }
    const float mean = s1 * (1.f / 64.f);
    const float var = fmaxf(s2 * (1.f / 64.f) - mean * mean, 0.f);
    const float rs = rsqrtf(var + 64e-5f);
#pragma unroll
    for (int q = 0; q < 8; ++q) {
      __builtin_amdgcn_sched_barrier(0);
      const int c = c0 + q * 8;
      float pc[8], pp[8], pn[8], gv[8], o[8], ya[8], yb[8];
      unpack8(*(const uint4*)(of + q * 8), ya);
      unpack8(*(const uint4*)(ob + q * 8), yb);
      unpack8(*(const uint4*)(prow + 1024 + c), pc);
      if (hasp) unpack8(*(const uint4*)(prow - PS1 + 1024 + c), pp);
      else {
#pragma unroll
        for (int j = 0; j < 8; ++j) pp[j] = 0.f;
      }
      if (hasn) unpack8(*(const uint4*)(prow + PS1 + 1024 + c), pn);
      else {
#pragma unroll
        for (int j = 0; j < 8; ++j) pn[j] = 0.f;
      }
      unpack8(*(const uint4*)(G + tk * 520 + c), gv);
      const float* mu = p.rw_mu + 1024 + c;
      const float* gg = p.rw_lnx_g + c;
      const float* gb = p.rw_lnx_b + c;
#pragma unroll
      for (int j = 0; j < 8; ++j) {
        const float vsh = pc[j] + mu[j] * (0.5f * (pp[j] + pn[j]) - pc[j]);
        const float yn = (ya[j] + yb[j] - mean) * rs * gg[j] + gb[j];
        o[j] = (yn + bsum * vsh) * gv[j];
      }
      *(uint4*)(Y + (size_t)row * 1024 + c) = pack8(o);
    }
  }
  {
    const int c0 = part * 64;
    const u16* of = O4 + ((size_t)2 * NLAT + row) * 512 + c0;
    const u16* ob = O4 + ((size_t)3 * NLAT + row) * 512 + c0;
    float s2 = 0.f;
#pragma unroll
    for (int q = 0; q < 8; ++q) {
      float a[8], b8[8];
      unpack8(*(const uint4*)(of + q * 8), a);
      unpack8(*(const uint4*)(ob + q * 8), b8);
#pragma unroll
      for (int j = 0; j < 8; ++j) { const float v = a[j] + b8[j]; s2 += v * v; }
    }
    s2 += __shfl_xor(s2, 1, 64);
    const float rs = rsqrtf(s2 * (1.f / 128.f) + 1e-6f);
    const u16* zr = prow + DNO + 1536 + c0;
    const float* ng = p.dn_norm_g + (part & 1) * 64;
#pragma unroll
    for (int q = 0; q < 8; ++q) {
      __builtin_amdgcn_sched_barrier(0);
      float z[8], r8[8], a[8], b8[8];
      unpack8(*(const uint4*)(of + q * 8), a);
      unpack8(*(const uint4*)(ob + q * 8), b8);
      unpack8(*(const uint4*)(zr + q * 8), z);
#pragma unroll
      for (int j = 0; j < 8; ++j) r8[j] = (a[j] + b8[j]) * rs * ng[q * 8 + j] * silu(z[j]);
      *(uint4*)(Y + (size_t)row * 1024 + 512 + c0 + q * 8) = pack8(r8);
    }
  }
  __syncthreads();
}

constexpr int NPHASE = 18;

__global__ void __launch_bounds__(256, 2) mega(Params p, int ph_lo, int ph_hi) {
  __shared__ __attribute__((aligned(16))) char smem[65536];
  cg::grid_group grid = cg::this_grid();
  const float* mv0 = (const float*)(p.ws + OFF_MODV);
  const float* mv1 = mv0 + 33 * 6144;
  u16* X = (u16*)(p.ws + OFF_X);
  u16* HY = (u16*)(p.ws + OFF_HY);
  u16* BIG = (u16*)(p.ws + OFF_BIG);
#define PHASE(n, BODY) if (ph_lo <= (n) && (n) < ph_hi) { BODY; if ((n) + 1 < ph_hi) grid.sync(); }
  PHASE(0, phase_prep(p, smem))
  PHASE(1, phase_init(p))
  PHASE(2, gemm_phase<0>(HY, 1024, (const u16*)(p.ws + OFF_WIN0), 1024, NTOK, 2304, BIG, PS0, nullptr, smem))
  PHASE(3, phase_hyprep_rope(p, smem))
  PHASE(4, phase_conv_attn(p, smem))
  PHASE(5, gemm_phase<2>(HY, 1024, (const u16*)(p.ws + OFF_WOUT0), 1024, NTOK, 1024, X, 1024, mv0 + 2 * 1024, smem))
  PHASE(6, ln_phase<false>(p, NTOK, p.ln_g, p.ln_b, mv0, 3, 4))
  PHASE(7, gemm_phase<1>(HY, 1024, (const u16*)(p.ws + OFF_W1_0), 1024, NTOK, 4096, BIG, 4096, nullptr, smem))
  PHASE(8, gemm_phase<2>(BIG, 4096, (const u16*)(p.ws + OFF_W2_0), 4096, NTOK, 1024, X, 1024, mv0 + 5 * 1024, smem))
  PHASE(9, ln_phase<false>(p, NTOK, p.ln_g + 1024, p.ln_b + 1024, mv1, 0, 1))
  PHASE(10, gemm_phase<0>(HY, 1024, (const u16*)(p.ws + OFF_WIN1), 1024, NTOK, 4096, BIG, PS1, nullptr, smem))
  PHASE(11, phase_scans(p, smem))
  PHASE(12, for (int it = blockIdx.x; it < 2048; it += gridDim.x) mixout_item(p, it, smem))
  PHASE(13, gemm_phase<2>(HY, 1024, (const u16*)(p.ws + OFF_WOUT1), 1024, NLAT, 1024, X, 1024, mv1 + 2 * 1024, smem))
  PHASE(14, ln_phase<false>(p, NLAT, p.ln_g + 2048, p.ln_b + 2048, mv1, 3, 4))
  PHASE(15, gemm_phase<1>(HY, 1024, (const u16*)(p.ws + OFF_W1_1), 1024, NLAT, 4096, BIG, 4096, nullptr, smem))
  PHASE(16, gemm_phase<2>(BIG, 4096, (const u16*)(p.ws + OFF_W2_1), 4096, NLAT, 1024, X, 1024, mv1 + 5 * 1024, smem))
  PHASE(17, ln_phase<true>(p, NLAT, p.ln_g + 3072, p.ln_b + 3072, mv1, 0, 1))
}

extern "C" void kernel_launch(void* const* d_in, const int* in_sizes, int n_in, void* d_out, int out_size, void* d_ws,
                              size_t ws_size, hipStream_t stream) {
  static int grid_blocks = 0;
  if (!grid_blocks) {
    int dev = 0, cus = 0, per_cu = 0;
    hipGetDevice(&dev);
    hipDeviceGetAttribute(&cus, hipDeviceAttributeMultiprocessorCount, dev);
    hipOccupancyMaxActiveBlocksPerMultiprocessor(&per_cu, mega, 256, 0);
    if (per_cu > 2) per_cu = 2;
    if (per_cu < 1) per_cu = 1;
    grid_blocks = cus * per_cu;
  }
  if (ws_size < WS_NEED) fprintf(stderr, "workspace too small: %zu < %zu\n", ws_size, (size_t)WS_NEED);
  Params p{};
  const float** pp = (const float**)&p;
  for (int i = 0; i < 39; ++i) pp[i] = (const float*)d_in[i];
  p.out = (float*)d_out;
  p.ws = (char*)d_ws;
  int lo = 0, hi = NPHASE;
  void* args[] = {&p, &lo, &hi};
  hipError_t e = hipLaunchCooperativeKernel((void*)mega, dim3(grid_blocks), dim3(256), args, 0, stream);
  if (e != hipSuccess) fprintf(stderr, "cooperative launch failed: %s (grid %d)\n", hipGetErrorString(e), grid_blocks);
}
```

```cpp
#include <hip/hip_runtime.h>
#include <hip/hip_cooperative_groups.h>
#include <cstdio>
#include <cstdint>
namespace cg = cooperative_groups;

typedef unsigned short u16;
typedef __attribute__((ext_vector_type(8))) short bf16x8;
typedef __attribute__((ext_vector_type(4))) float f32x4;
typedef __attribute__((ext_vector_type(16))) float f32x16;

#define DEV __device__ __forceinline__

constexpr int NLAT = 65536, NCTX = 8192, NTOK = 73728;
constexpr int PS0 = 2304;
constexpr int PS1 = 4096;
constexpr int DNO = 1920;
constexpr float ALPHA = 1.4142135623730951f;

constexpr size_t OFF_WIN0 = 0;
constexpr size_t OFF_WOUT0 = OFF_WIN0 + (size_t)2304 * 1024 * 2;
constexpr size_t OFF_W1_0 = OFF_WOUT0 + (size_t)1024 * 1024 * 2;
constexpr size_t OFF_W1_1 = OFF_W1_0 + (size_t)4096 * 1024 * 2;
constexpr size_t OFF_W2_0 = OFF_W1_1 + (size_t)4096 * 1024 * 2;
constexpr size_t OFF_W2_1 = OFF_W2_0 + (size_t)4096 * 1024 * 2;
constexpr size_t OFF_WIN1 = OFF_W2_1 + (size_t)4096 * 1024 * 2;
constexpr size_t OFF_WOUT1 = OFF_WIN1 + (size_t)4096 * 1024 * 2;
constexpr size_t OFF_MODV = OFF_WOUT1 + (size_t)1024 * 1024 * 2;
constexpr size_t OFF_KR2048 = OFF_MODV + (size_t)2 * 33 * 6144 * 4;
constexpr size_t OFF_KR256 = OFF_KR2048 + (size_t)512 * 4096 * 2;
constexpr size_t OFF_ROPE = OFF_KR256 + (size_t)512 * 512 * 2;
constexpr size_t OFF_BSUM = OFF_ROPE + 8192;
constexpr size_t OFF_G2T = OFF_BSUM + (size_t)65536 * 16 * 4;
constexpr size_t OFF_BAR = OFF_G2T + (size_t)512 * 128 * 2;
constexpr size_t OFF_X = (size_t)64 << 20;
constexpr size_t OFF_HY = OFF_X + (size_t)NTOK * 1024 * 2;
constexpr size_t OFF_BIG = OFF_HY + (size_t)NTOK * 1024 * 2;
constexpr size_t WS_NEED = OFF_BIG + (size_t)NTOK * 4096 * 2;
static_assert(OFF_BAR + 16384 <= OFF_X, "ws map");
constexpr size_t SO_U = 0;
constexpr size_t SO_X0 = SO_U + (size_t)512 * 32 * 2048 * 2;
constexpr size_t SO_UC = SO_X0 + (size_t)512 * 32 * 2048 * 2;
constexpr size_t SO_X0C = SO_UC + (size_t)512 * 32 * 256 * 2;

struct Params {
  const float *x, *c, *ctx, *c_ctx, *mod_w, *mod_b, *ln_g, *ln_b, *mlp_w1, *mlp_w2, *e_w_in, *e_w_out, *hy_conv,
      *hy_w1, *hy_b1, *hy_w2, *hy_b2, *hy_freq, *hy_w3, *hy_decay, *hy_bias, *attn_sink, *o_w_in, *o_w_out,
      *rw_mu, *rw_w0, *rw_w2, *rw_a0, *rw_a2, *rw_g2, *rw_kk, *rw_ka, *rw_rk, *rw_lnx_g, *rw_lnx_b,
      *dn_conv, *dn_A_log, *dn_dt_bias, *dn_norm_g;
  float* out;
  char* ws;
};

DEV u16 f2bf(float f) { unsigned u = __float_as_uint(f); u += 0x7fffu + ((u >> 16) & 1u); return (u16)(u >> 16); }
DEV float bf2f(u16 h) { return __uint_as_float(((unsigned)h) << 16); }
DEV float bflo(unsigned u) { return __uint_as_float(u << 16); }
DEV float bfhi(unsigned u) { return __uint_as_float(u & 0xffff0000u); }
DEV unsigned pack2(float a, float b) { return (unsigned)f2bf(a) | ((unsigned)f2bf(b) << 16); }
DEV void unpack8(const uint4& v, float* f) {
  f[0] = bflo(v.x); f[1] = bfhi(v.x); f[2] = bflo(v.y); f[3] = bfhi(v.y);
  f[4] = bflo(v.z); f[5] = bfhi(v.z); f[6] = bflo(v.w); f[7] = bfhi(v.w);
}
DEV uint4 pack8(const float* f) {
  uint4 v; v.x = pack2(f[0], f[1]); v.y = pack2(f[2], f[3]); v.z = pack2(f[4], f[5]); v.w = pack2(f[6], f[7]); return v;
}
DEV int modrow(int r) { return r < NLAT ? (r >> 11) : 32; }
DEV float sigm(float x) { return 1.f / (1.f + __expf(-x)); }
DEV float silu(float x) { return x / (1.f + __expf(-x)); }
DEV float softplus(float x) { return fmaxf(x, 0.f) + __logf(1.f + __expf(-fabsf(x))); }
DEV float fast_tanh(float x) { return 1.f - 2.f / (1.f + __expf(2.f * x)); }
DEV float wave_sum(float v) {
#pragma unroll
  for (int o = 32; o > 0; o >>= 1) v += __shfl_xor(v, o, 64);
  return v;
}

DEV void transpose_tile(const float* __restrict__ src, int K, int N, int Npad, u16* __restrict__ dst, int tile,
                               u16* sm) {
  const int tid = threadIdx.x;
  const int ntn = Npad >> 6;
  const int tk = tile / ntn, tn = tile - tk * ntn;
  const int n = tid & 63, kq = tid >> 6;
  const int gn = tn * 64 + n;
#pragma unroll 4
  for (int i = 0; i < 16; ++i) {
    int k = kq + 4 * i;
    float v = (gn < N) ? src[(size_t)(tk * 64 + k) * N + gn] : 0.f;
    sm[n * 66 + k] = f2bf(v);
  }
  __syncthreads();
  const int n2 = tid >> 2, q = tid & 3;
  const unsigned* s32 = (const unsigned*)sm + (n2 * 66 + q * 16) / 2;
  uint4 a, b;
  a.x = s32[0]; a.y = s32[1]; a.z = s32[2]; a.w = s32[3];
  b.x = s32[4]; b.y = s32[5]; b.z = s32[6]; b.w = s32[7];
  u16* d = dst + (size_t)(tn * 64 + n2) * K + tk * 64 + q * 16;
  *(uint4*)d = a;
  *(uint4*)(d + 8) = b;
  __syncthreads();
}

DEV void modv_item(const Params& p, int it, float* sl) {
  const int tid = threadIdx.x;
  const int l = it / 288, rem = it % 288, cc = rem / 3, rg = rem % 3;
  for (int idx = tid; idx < 11 * 1024; idx += 256) {
    int r = rg * 11 + (idx >> 10), k = idx & 1023;
    float cv = (r < 32) ? p.c[r * 1024 + k] : p.c_ctx[k];
    sl[idx] = cv / (1.f + expf(-cv));
  }
  __syncthreads();
  const int cl = tid & 63, kg = tid >> 6;
  const int col = cc * 64 + cl;
  float acc[11];
#pragma unroll
  for (int r = 0; r < 11; ++r) acc[r] = 0.f;
  const float* w = p.mod_w + (size_t)l * 1024 * 6144 + (size_t)(kg * 256) * 6144 + col;
#pragma unroll 8
  for (int k = 0; k < 256; ++k) {
    float wv = w[(size_t)k * 6144];
#pragma unroll
    for (int r = 0; r < 11; ++r) acc[r] += sl[r * 1024 + kg * 256 + k] * wv;
  }
  __syncthreads();
  float* red = sl;
#pragma unroll
  for (int r = 0; r < 11; ++r) red[(kg * 11 + r) * 64 + cl] = acc[r];
  __syncthreads();
  for (int idx = tid; idx < 11 * 64; idx += 256) {
    int r = idx >> 6, c2 = idx & 63;
    float v = red[(0 * 11 + r) * 64 + c2] + red[(1 * 11 + r) * 64 + c2] + red[(2 * 11 + r) * 64 + c2] + red[(3 * 11 + r) * 64 + c2];
    int gcol = cc * 64 + c2;
    ((float*)(p.ws + OFF_MODV))[(size_t)(l * 33 + rg * 11 + r) * 6144 + gcol] = v + p.mod_b[l * 6144 + gcol];
  }
  __syncthreads();
}

DEV void filter_item(const Params& p, int it, float* sm) {
  const int L = it < 2048 ? 2048 : 256;
  const int t = it < 2048 ? it : it - 2048;
  u16* R = (u16*)(p.ws + (L == 2048 ? OFF_KR2048 : OFF_KR256));
  float* pe = sm; float* h1 = sm + 64; float* h2 = sm + 128;
  const int tid = threadIdx.x;
  const float tn = (float)t / (float)(L - 1);
  if (tid < 33) {
    float v;
    if (tid == 0) v = tn;
    else {
      int i = (tid - 1) & 15;
      double band = 1e-4 + (double)i * ((15.0 - 1e-4) / 15.0);
      double ang = 2.0 * 3.14159265358979323846 * (double)t * band / (double)L;
      v = (tid <= 16) ? (float)cos(ang) : (float)(-sin(ang));
    }
    pe[tid] = v;
  }
  __syncthreads();
  if (tid < 64) {
    float acc = p.hy_b1[tid];
#pragma unroll 11
    for (int i = 0; i < 33; ++i) acc += pe[i] * p.hy_w1[i * 64 + tid];
    h1[tid] = sinf(p.hy_freq[tid] * acc);
  }
  __syncthreads();
  if (tid < 64) {
    float acc = p.hy_b2[tid];
#pragma unroll 16
    for (int i = 0; i < 64; ++i) acc += h1[i] * p.hy_w2[i * 64 + tid];
    h2[tid] = sinf(p.hy_freq[tid] * acc);
  }
  __syncthreads();
#pragma unroll 1
  for (int q = 0; q < 4; ++q) {
    int o = tid + 256 * q;
    float acc = 0.f;
#pragma unroll 16
    for (int i = 0; i < 64; ++i) acc += h2[i] * p.hy_w3[i * 1024 + o];
    float val = acc * expf(-tn * fabsf(p.hy_decay[o]));
    if (o < 512) {
      if (t == 0) val += p.hy_bias[o];
      R[(size_t)o * 2 * L + L - t] = f2bf(val);
    } else {
      int c = o - 512;
      if (t >= 1) R[(size_t)c * 2 * L + L + t] = f2bf(val);
      else R[(size_t)c * 2 * L] = 0;
    }
  }
  __syncthreads();
}

DEV void phase_prep(const Params& p, char* smem) {
  constexpr int T_IN0 = 16 * 36, T_OUT = 16 * 16, T_W = 16 * 64;
  constexpr int E0 = T_IN0, E1 = E0 + T_OUT, E2 = E1 + T_W, E3 = E2 + T_W, E4 = E3 + T_W, E5 = E4 + T_W,
                E6 = E5 + T_W, E7 = E6 + T_OUT, E8 = E7 + 576, E9 = E8 + 2304, E10 = E9 + 1, E11 = E10 + 16;
  for (int it = blockIdx.x; it < E11; it += gridDim.x) {
    if (it >= E10) transpose_tile(p.rw_g2, 128, 512, 512, (u16*)(p.ws + OFF_G2T), it - E10, (u16*)smem);
    else if (it < E0) transpose_tile(p.e_w_in, 1024, 2304, 2304, (u16*)(p.ws + OFF_WIN0), it, (u16*)smem);
    else if (it < E1) transpose_tile(p.e_w_out, 1024, 1024, 1024, (u16*)(p.ws + OFF_WOUT0), it - E0, (u16*)smem);
    else if (it < E2) transpose_tile(p.mlp_w1, 1024, 4096, 4096, (u16*)(p.ws + OFF_W1_0), it - E1, (u16*)smem);
    else if (it < E3) transpose_tile(p.mlp_w1 + (size_t)1024 * 4096, 1024, 4096, 4096, (u16*)(p.ws + OFF_W1_1), it - E2, (u16*)smem);
    else if (it < E4) transpose_tile(p.mlp_w2, 4096, 1024, 1024, (u16*)(p.ws + OFF_W2_0), it - E3, (u16*)smem);
    else if (it < E5) transpose_tile(p.mlp_w2 + (size_t)1024 * 4096, 4096, 1024, 1024, (u16*)(p.ws + OFF_W2_1), it - E4, (u16*)smem);
    else if (it < E6) transpose_tile(p.o_w_in, 1024, 3984, 4096, (u16*)(p.ws + OFF_WIN1), it - E5, (u16*)smem);
    else if (it < E7) transpose_tile(p.o_w_out, 1024, 1024, 1024, (u16*)(p.ws + OFF_WOUT1), it - E6, (u16*)smem);
    else if (it < E8) modv_item(p, it - E7, (float*)smem);
    else if (it < E9) filter_item(p, it - E8, (float*)smem);
    else {
      float2* tab = (float2*)(p.ws + OFF_ROPE);
      for (int q = 0; q < 4; ++q) {
        int e = threadIdx.x * 4 + q;
        int pos = e >> 4, i = e & 15;
        float inv = powf(10000.f, -(float)i / 16.f);
        float ang = (float)pos * inv;
        tab[e] = make_float2(cosf(ang), sinf(ang));
      }
    }
  }
}

DEV void phase_init(const Params& p) {
  const float* mv = (const float*)(p.ws + OFF_MODV);
  u16* X = (u16*)(p.ws + OFF_X);
  u16* HM = (u16*)(p.ws + OFF_HY);
  const size_t total = (size_t)NTOK * 128;
  for (size_t i = (size_t)blockIdx.x * 256 + threadIdx.x; i < total; i += (size_t)gridDim.x * 256) {
    int r = (int)(i >> 7), c8 = (int)(i & 127) * 8;
    const float* src = r < NLAT ? p.x + (size_t)r * 1024 + c8 : p.ctx + (size_t)(r - NLAT) * 1024 + c8;
    float4 v0 = *(const float4*)src, v1 = *(const float4*)(src + 4);
    const float* m = mv + (size_t)modrow(r) * 6144 + c8;
    float4 h0 = *(const float4*)m, h1 = *(const float4*)(m + 4);
    float4 s0 = *(const float4*)(m + 1024), s1 = *(const float4*)(m + 1028);
    float f[8] = {v0.x, v0.y, v0.z, v0.w, v1.x, v1.y, v1.z, v1.w};
    float sh[8] = {h0.x, h0.y, h0.z, h0.w, h1.x, h1.y, h1.z, h1.w};
    float sc[8] = {s0.x, s0.y, s0.z, s0.w, s1.x, s1.y, s1.z, s1.w};
    float g[8];
#pragma unroll
    for (int j = 0; j < 8; ++j) g[j] = f[j] * (1.f + sc[j]) + sh[j];
    *(uint4*)(X + (size_t)r * 1024 + c8) = pack8(f);
    *(uint4*)(HM + (size_t)r * 1024 + c8) = pack8(g);
  }
}

template <int EPI>
DEV void gemm_phase(const u16* __restrict__ A, int lda, const u16* __restrict__ Bt, int K, int M, int N,
                           u16* __restrict__ C, int ldc, const float* __restrict__ gate, char* smem) {
  const int tid = threadIdx.x, lane = tid & 63, wave = tid >> 6;
  const int wm = wave >> 1, wn = wave & 1;
  const int fr = lane & 15, fq = lane >> 4;
  const int tn = N >> 7, tiles = (M >> 7) * tn;
  const int nk = K >> 6;
  const int drow = wave * 8 + (lane >> 3);
  const int dchunk = (lane & 7) ^ ((drow >> 1) & 7);
  const size_t lda32 = (size_t)lda * 32, ldb32 = (size_t)K * 32;
  const int sw = fr >> 1;
  const bool xcd_order = (gridDim.x & 7) == 0 && ((M >> 7) & 63) == 0;
  const int per_xcd = tiles >> 3;
  const int nloc = gridDim.x >> 3;
  for (int it = blockIdx.x; it < tiles; it += gridDim.x) {
    int tm_i, tn_i;
    if (xcd_order) {
      const int x = it & 7;
      const int local = it >> 3;
      const int mg = local / (8 * tn), r = local - mg * 8 * tn;
      tn_i = r >> 3;
      tm_i = x * (per_xcd / tn) + mg * 8 + (r & 7);
    } else { tm_i = it / tn; tn_i = it - tm_i * tn; }
    const int m0 = tm_i << 7, n0 = tn_i << 7;
    const u16* ag = A + (size_t)(m0 + drow) * lda + dchunk * 8;
    const u16* bg = Bt + (size_t)(n0 + drow) * K + dchunk * 8;
    f32x4 acc[4][4];
#pragma unroll
    for (int i = 0; i < 4; ++i)
#pragma unroll
      for (int j = 0; j < 4; ++j) acc[i][j] = (f32x4){0.f, 0.f, 0.f, 0.f};
#define G_ISSUE(KT, ST)                                                                                  \
  {                                                                                                      \
    const u16* a2 = ag + (KT)*64;                                                                        \
    const u16* b2 = bg + (KT)*64;                                                                        \
    char* la = smem + (ST)*32768 + wave * 1024;                                                          \
    _Pragma("unroll") for (int j = 0; j < 4; ++j) {                                                      \
      __builtin_amdgcn_global_load_lds((const unsigned*)(a2 + j * lda32), (unsigned*)(la + j * 4096), 16, 0, 0);          \
      __builtin_amdgcn_global_load_lds((const unsigned*)(b2 + j * ldb32), (unsigned*)(la + 16384 + j * 4096), 16, 0, 0);  \
    }                                                                                                    \
  }
    G_ISSUE(0, 0)
    for (int kt = 0; kt < nk; ++kt) {
      asm volatile("s_waitcnt vmcnt(0)" ::: "memory");
      __syncthreads();
      if (kt + 1 < nk) G_ISSUE(kt + 1, (kt + 1) & 1)
      const u16* As = (const u16*)(smem + (kt & 1) * 32768);
      const u16* Bs = As + 8192;
#pragma unroll
      for (int ks = 0; ks < 2; ++ks) {
        bf16x8 af[4], bfr[4];
        const int pos = ((ks * 4 + fq) ^ sw) * 8;
#pragma unroll
        for (int i = 0; i < 4; ++i) {
          af[i] = *(const bf16x8*)(As + (wm * 64 + i * 16 + fr) * 64 + pos);
          bfr[i] = *(const bf16x8*)(Bs + (wn * 64 + i * 16 + fr) * 64 + pos);
        }
        __builtin_amdgcn_s_setprio(1);
#pragma unroll
        for (int i = 0; i < 4; ++i)
#pragma unroll
          for (int j = 0; j < 4; ++j)
            acc[i][j] = __builtin_amdgcn_mfma_f32_16x16x32_bf16(af[i], bfr[j], acc[i][j], 0, 0, 0);
        __builtin_amdgcn_s_setprio(0);
      }
    }
#undef G_ISSUE
    __syncthreads();
    u16* Cs = (u16*)smem;
#pragma unroll
    for (int i = 0; i < 4; ++i)
#pragma unroll
      for (int j = 0; j < 4; ++j)
#pragma unroll
        for (int e = 0; e < 4; ++e) {
          float v = acc[i][j][e];
          if (EPI == 1) { v = fmaxf(v, 0.f); v = v * v; }
          Cs[(wm * 64 + i * 16 + fq * 4 + e) * 136 + wn * 64 + j * 16 + fr] = f2bf(v);
        }
    __syncthreads();
#pragma unroll 2
    for (int q = 0; q < 8; ++q) {
      const int chunk = tid + q * 256;
      const int row = chunk >> 4, cc = chunk & 15;
      uint4 cv = *(const uint4*)(Cs + row * 136 + cc * 8);
      u16* dst = C + (size_t)(m0 + row) * ldc + n0 + cc * 8;
      if (EPI == 2) {
        float a[8], xo[8], y[8];
        unpack8(cv, a);
        unpack8(*(const uint4*)dst, xo);
        const float* gr = gate + (size_t)modrow(m0 + row) * 6144 + n0 + cc * 8;
        float4 g0 = *(const float4*)gr, g1 = *(const float4*)(gr + 4);
        float gg[8] = {g0.x, g0.y, g0.z, g0.w, g1.x, g1.y, g1.z, g1.w};
#pragma unroll
        for (int j = 0; j < 8; ++j) y[j] = ALPHA * xo[j] + gg[j] * a[j];
        cv = pack8(y);
      }
      *(uint4*)dst = cv;
    }
    __syncthreads();
  }
}

template <bool FINAL>
DEV void ln_phase(const Params& p, int M, const float* __restrict__ g, const float* __restrict__ b,
                         const float* __restrict__ modl  , int shi, int sci) {
  u16* X = (u16*)(p.ws + OFF_X);
  u16* HM = (u16*)(p.ws + OFF_HY);
  const int lane = threadIdx.x & 63;
  const int gw = blockIdx.x * 4 + (threadIdx.x >> 6), nw = gridDim.x * 4;
#pragma unroll 2
  for (int row = gw; row < M; row += nw) {
    u16* xr = X + (size_t)row * 1024;
    float f[16];
    unpack8(*(const uint4*)(xr + lane * 8), f);
    unpack8(*(const uint4*)(xr + 512 + lane * 8), f + 8);
    float s = 0.f, q = 0.f;
#pragma unroll
    for (int j = 0; j < 16; ++j) { s += f[j]; q += f[j] * f[j]; }
#pragma unroll
    for (int o = 32; o > 0; o >>= 1) { s += __shfl_xor(s, o, 64); q += __shfl_xor(q, o, 64); }
    const float mu = s * (1.f / 1024.f);
    const float rs = rsqrtf(fmaxf(q * (1.f / 1024.f) - mu * mu, 0.f) + 1e-5f);
#pragma unroll
    for (int j = 0; j < 16; ++j) f[j] -= mu;
#pragma unroll
    for (int hh = 0; hh < 2; ++hh) {
      const int c0 = hh * 512 + lane * 8;
      float y[8];
#pragma unroll
      for (int j = 0; j < 8; ++j) y[j] = f[hh * 8 + j] * rs * g[c0 + j] + b[c0 + j];
      if (FINAL) {
        float* o = p.out + (size_t)row * 1024 + c0;
        *(float4*)o = make_float4(y[0], y[1], y[2], y[3]);
        *(float4*)(o + 4) = make_float4(y[4], y[5], y[6], y[7]);
      } else {
        *(uint4*)(xr + c0) = pack8(y);
        const float* m = modl + (size_t)modrow(row) * 6144;
        float h[8];
#pragma unroll
        for (int j = 0; j < 8; ++j) h[j] = y[j] * (1.f + m[sci * 1024 + c0 + j]) + m[shi * 1024 + c0 + j];
        *(uint4*)(HM + (size_t)row * 1024 + c0) = pack8(h);
      }
    }
  }
}

DEV void hyprep_item(const Params& p, int it, char* smem) {
  u16* su = (u16*)smem;
  u16* sx = su + 64 * 66;
  const u16* P = (const u16*)(p.ws + OFF_BIG);
  const int tid = threadIdx.x;
  const int ct = it & 7, st = it >> 3;
  int b, t0, L, rowbase;
  u16 *U, *X0;
  if (st < 1024) { b = st >> 5; t0 = (st & 31) * 64; L = 2048; rowbase = b * 2048;
    U = (u16*)((char*)p.out + SO_U); X0 = (u16*)((char*)p.out + SO_X0); }
  else { int s2 = st - 1024; b = s2 >> 2; t0 = (s2 & 3) * 64; L = 256; rowbase = NLAT + b * 256;
    U = (u16*)((char*)p.out + SO_UC); X0 = (u16*)((char*)p.out + SO_X0C); }
  const int c0 = ct * 64;
  {
    const int t = tid >> 2, cq = tid & 3;
    float z[3][16];
#pragma unroll
    for (int g = 0; g < 3; ++g)
#pragma unroll
      for (int j = 0; j < 16; ++j) z[g][j] = 0.f;
#pragma unroll
    for (int tap = 0; tap < 3; ++tap) {
      const int tt = t0 + t + tap - 1;
      if (tt >= 0 && tt < L) {
#pragma unroll
        for (int g = 0; g < 3; ++g) {
          const int col = g * 512 + c0 + cq * 16;
          const u16* src = P + (size_t)(rowbase + tt) * PS0 + col;
          float f[16];
          unpack8(*(const uint4*)src, f);
          unpack8(*(const uint4*)(src + 8), f + 8);
          const float* w = p.hy_conv + tap * 1536 + col;
#pragma unroll
          for (int j = 0; j < 16; ++j) z[g][j] += f[j] * w[j];
        }
      }
    }
#pragma unroll
    for (int j = 0; j < 16; ++j) {
      su[t * 66 + cq * 16 + j] = f2bf(z[1][j] * z[2][j]);
      sx[t * 66 + cq * 16 + j] = f2bf(z[0][j]);
    }
  }
  __syncthreads();
  {
    const int c = tid >> 2, tq = tid & 3;
    unsigned wu[8], wx[8];
#pragma unroll
    for (int j = 0; j < 8; ++j) {
      wu[j] = (unsigned)su[(tq * 16 + 2 * j) * 66 + c] | ((unsigned)su[(tq * 16 + 2 * j + 1) * 66 + c] << 16);
      wx[j] = (unsigned)sx[(tq * 16 + 2 * j) * 66 + c] | ((unsigned)sx[(tq * 16 + 2 * j + 1) * 66 + c] << 16);
    }
    const size_t o = ((size_t)(c0 + c) * 32 + b) * L + t0 + tq * 16;
    *(uint4*)(U + o) = make_uint4(wu[0], wu[1], wu[2], wu[3]);
    *(uint4*)(U + o + 8) = make_uint4(wu[4], wu[5], wu[6], wu[7]);
    *(uint4*)(X0 + o) = make_uint4(wx[0], wx[1], wx[2], wx[3]);
    *(uint4*)(X0 + o + 8) = make_uint4(wx[4], wx[5], wx[6], wx[7]);
  }
  __syncthreads();
}

DEV void rope_item(const Params& p, int it) {
  u16* P = (u16*)(p.ws + OFF_BIG);
  const float2* tab = (const float2*)(p.ws + OFF_ROPE);
  const int task = it * 256 + threadIdx.x;
  const int row = task / 40, rem = task - row * 40;
  const int head = rem >> 2, pr = rem & 3;
  const int d0 = (pr >> 1) * 32 + (pr & 1) * 8;
  const int t = row & 2047;
  const int posc = (pr >> 1) ? (t & 63) : (t >> 6);
  const int fi0 = (pr & 1) * 8;
  u16* ptr = P + (size_t)row * PS0 + 1536 + head * 64 + d0;
  float u1[8], u2[8], o1[8], o2[8];
  unpack8(*(const uint4*)ptr, u1);
  unpack8(*(const uint4*)(ptr + 16), u2);
#pragma unroll
  for (int j = 0; j < 8; ++j) {
    float2 cs = tab[posc * 16 + fi0 + j];
    o1[j] = u1[j] * cs.x - u2[j] * cs.y;
    o2[j] = u1[j] * cs.y + u2[j] * cs.x;
  }
  *(uint4*)ptr = pack8(o1);
  *(uint4*)(ptr + 16) = pack8(o2);
}

DEV void phase_hyprep_rope(const Params& p, char* smem) {
  constexpr int NH = 9216, NR = 10240;
  for (int it = blockIdx.x; it < NH + NR; it += gridDim.x) {
    if (it < NH) hyprep_item(p, it, smem);
    else rope_item(p, it - NH);
  }
}

template <int L, int NT>
DEV void conv_item(const Params& p, int c, int th, char* smem) {
  const u16* R = (const u16*)(p.ws + (L == 2048 ? OFF_KR2048 : OFF_KR256)) + (size_t)c * 2 * L;
  const u16* U = (const u16*)((const char*)p.out + (L == 2048 ? SO_U : SO_UC));
  const u16* X0 = (const u16*)((const char*)p.out + (L == 2048 ? SO_X0 : SO_X0C));
  u16* Y = (u16*)(p.ws + OFF_HY);
  u16* Rs0 = (u16*)smem;
  u16* Rs1 = Rs0 + 2 * L + 8;
  const int tid = threadIdx.x, lane = tid & 63, wave = tid >> 6;
  for (int i = tid; i < 2 * L; i += 256) {
    Rs0[i] = R[i];
    Rs1[i] = (i + 1 < 2 * L) ? R[i + 1] : (u16)0;
  }
  __syncthreads();
  const int r = lane & 31, h = lane >> 5;
  const char* lanebase = (r & 1) ? (const char*)Rs1 + 2 * (8 * h - r + L - 1) : (const char*)Rs0 + 2 * (8 * h - r + L);
  const u16* Ub = U + ((size_t)c * 32 + r) * L + 8 * h;
  const int tw0 = th * 1024 + wave * NT * 32;
  f32x16 acc[NT];
#pragma unroll
  for (int i = 0; i < NT; ++i)
#pragma unroll
    for (int e = 0; e < 16; ++e) acc[i][e] = 0.f;
  uint4 nb = *(const uint4*)Ub;
  for (int st = 0; st < L / 16; ++st) {
    uint4 cur = nb;
    if (st + 1 < L / 16) nb = *(const uint4*)(Ub + (st + 1) * 16);
    bf16x8 bfrag = *(bf16x8*)&cur;
#pragma unroll
    for (int i = 0; i < NT; ++i) {
      const unsigned* ap = (const unsigned*)(lanebase + 2 * (st * 16 - (tw0 + i * 32)));
      uint4 av = make_uint4(ap[0], ap[1], ap[2], ap[3]);
      acc[i] = __builtin_amdgcn_mfma_f32_32x32x16_bf16(*(bf16x8*)&av, bfrag, acc[i], 0, 0, 0);
    }
  }
  const int rowbase = (L == 2048) ? r * 2048 : NLAT + r * 256;
#pragma unroll
  for (int i = 0; i < NT; ++i) {
#pragma unroll
    for (int g4 = 0; g4 < 4; ++g4) {
      const int tt = tw0 + i * 32 + 8 * g4 + 4 * h;
      uint2 xv = *(const uint2*)(X0 + ((size_t)c * 32 + r) * L + tt);
      float x0[4] = {bflo(xv.x), bfhi(xv.x), bflo(xv.y), bfhi(xv.y)};
#pragma unroll
      for (int e = 0; e < 4; ++e) Y[(size_t)(rowbase + tt + e) * 1024 + c] = f2bf(acc[i][g4 * 4 + e] * x0[e]);
    }
  }
  __syncthreads();
}

DEV void attn_item(const Params& p, int b, int hq, int qb, bool isctx, char* smem) {
  const u16* P = (const u16*)(p.ws + OFF_BIG);
  u16* Y = (u16*)(p.ws + OFF_HY);
  u16* Ks = (u16*)smem;
  u16* Vt = Ks + 64 * 72;
  const int tid = threadIdx.x, lane = tid & 63, wave = tid >> 6;
  const int nq = lane & 15, quad = lane >> 4;
  const int qrow = (isctx ? NLAT + b * 256 : b * 2048) + qb * 64 + wave * 16 + nq;
  const int qpos = qb * 64 + wave * 16 + nq;
  const int hkv = hq >> 2;
  const int kcol = 2048 + hkv * 64, vcol = 2176 + hkv * 64;
  bf16x8 qf[2];
#pragma unroll
  for (int ks = 0; ks < 2; ++ks)
    qf[ks] = *(const bf16x8*)(P + (size_t)qrow * PS0 + 1536 + hq * 64 + ks * 32 + quad * 8);
  float m = p.attn_sink[hq];
  float lsum = (quad == 0) ? 1.f : 0.f;
  f32x4 oacc[4];
#pragma unroll
  for (int n = 0; n < 4; ++n) oacc[n] = (f32x4){0.f, 0.f, 0.f, 0.f};
  const int nloc = isctx ? 0 : 5;
  for (int ti = 0; ti < nloc + 4; ++ti) {
    int krow0, k0 = 0;
    bool masked;
    if (ti < nloc) {
      k0 = qb * 64 - 128 + ti * 64;
      if (k0 < 0 || k0 >= 2048) continue;
      krow0 = b * 2048 + k0; masked = true;
    } else { krow0 = NLAT + b * 256 + (ti - nloc) * 64; masked = false; }
    __syncthreads();
    {
      const int key = tid >> 2, part = tid & 3;
      const u16* kp = P + (size_t)(krow0 + key) * PS0 + kcol + part * 16;
      const u16* vp = P + (size_t)(krow0 + key) * PS0 + vcol + part * 16;
      uint4 k0v = *(const uint4*)kp, k1v = *(const uint4*)(kp + 8);
      uint4 v0v = *(const uint4*)vp, v1v = *(const uint4*)(vp + 8);
      *(uint4*)(Ks + key * 72 + part * 16) = k0v;
      *(uint4*)(Ks + key * 72 + part * 16 + 8) = k1v;
      unsigned vw[8] = {v0v.x, v0v.y, v0v.z, v0v.w, v1v.x, v1v.y, v1v.z, v1v.w};
#pragma unroll
      for (int j = 0; j < 8; ++j) {
        Vt[(part * 16 + 2 * j) * 72 + key] = (u16)(vw[j] & 0xffffu);
        Vt[(part * 16 + 2 * j + 1) * 72 + key] = (u16)(vw[j] >> 16);
      }
    }
    __syncthreads();
    f32x4 s[4];
#pragma unroll
    for (int n = 0; n < 4; ++n) {
      s[n] = (f32x4){0.f, 0.f, 0.f, 0.f};
#pragma unroll
      for (int ks = 0; ks < 2; ++ks) {
        bf16x8 kf = *(const bf16x8*)(Ks + (n * 16 + nq) * 72 + ks * 32 + quad * 8);
        s[n] = __builtin_amdgcn_mfma_f32_16x16x32_bf16(kf, qf[ks], s[n], 0, 0, 0);
      }
    }
    float mx = -1e30f;
#pragma unroll
    for (int n = 0; n < 4; ++n)
#pragma unroll
      for (int e = 0; e < 4; ++e) {
        float v = s[n][e] * 0.125f;
        if (masked) {
          int kpos = k0 + n * 16 + quad * 4 + e;
          int d = qpos - kpos;
          if (d > 128 || d < -128) v = -1e30f;
        }
        s[n][e] = v;
        mx = fmaxf(mx, v);
      }
    mx = fmaxf(mx, __shfl_xor(mx, 16, 64));
    mx = fmaxf(mx, __shfl_xor(mx, 32, 64));
    const float mn = fmaxf(m, mx);
    const float al = __expf(m - mn);
    m = mn;
    float ps = 0.f;
#pragma unroll
    for (int n = 0; n < 4; ++n)
#pragma unroll
      for (int e = 0; e < 4; ++e) { float pv = __expf(s[n][e] - mn); s[n][e] = pv; ps += pv; }
    lsum = lsum * al + ps;
#pragma unroll
    for (int n = 0; n < 4; ++n)
#pragma unroll
      for (int e = 0; e < 4; ++e) oacc[n][e] *= al;
#pragma unroll
    for (int hh = 0; hh < 2; ++hh) {
      uint4 pw;
      pw.x = pack2(s[2 * hh][0], s[2 * hh][1]); pw.y = pack2(s[2 * hh][2], s[2 * hh][3]);
      pw.z = pack2(s[2 * hh + 1][0], s[2 * hh + 1][1]); pw.w = pack2(s[2 * hh + 1][2], s[2 * hh + 1][3]);
      bf16x8 pb = *(bf16x8*)&pw;
#pragma unroll
      for (int n = 0; n < 4; ++n) {
        const u16* vr = Vt + (n * 16 + nq) * 72 + quad * 4;
        uint2 va = *(const uint2*)(vr + (2 * hh) * 16);
        uint2 vb = *(const uint2*)(vr + (2 * hh + 1) * 16);
        uint4 vv = make_uint4(va.x, va.y, vb.x, vb.y);
        oacc[n] = __builtin_amdgcn_mfma_f32_16x16x32_bf16(*(bf16x8*)&vv, pb, oacc[n], 0, 0, 0);
      }
    }
  }
  lsum += __shfl_xor(lsum, 16, 64);
  lsum += __shfl_xor(lsum, 32, 64);
  const float inv = 1.f / lsum;
  u16* yo = Y + (size_t)qrow * 1024 + 512 + hq * 64 + quad * 4;
#pragma unroll
  for (int n = 0; n < 4; ++n) {
    uint2 w;
    w.x = pack2(oacc[n][0] * inv, oacc[n][1] * inv);
    w.y = pack2(oacc[n][2] * inv, oacc[n][3] * inv);
    *(uint2*)(yo + n * 16) = w;
  }
  __syncthreads();
}

DEV void phase_conv_attn(const Params& p, char* smem) {
  constexpr int N0 = 1024, N1 = N0 + 512, N2 = N1 + 8192, N3 = N2 + 1024;
  for (int it = blockIdx.x; it < N3; it += gridDim.x) {
    if (it < N0) conv_item<2048, 8>(p, it >> 1, it & 1, smem);
    else if (it < N1) conv_item<256, 2>(p, it - N0, 0, smem);
    else if (it < N2) { int a = it - N1; attn_item(p, a >> 8, (a >> 5) & 7, a & 31, false, smem); }
    else { int a = it - N2; attn_item(p, a >> 5, (a >> 2) & 7, a & 3, true, smem); }
  }
}

DEV void lds_wave_sync() {
  asm volatile("s_waitcnt lgkmcnt(0)" ::: "memory");
  __builtin_amdgcn_wave_barrier();
}

DEV void rwkv_item(const Params& p, int ri, char* smem) {
  const u16* P = (const u16*)(p.ws + OFF_BIG);
  u16* O4 = (u16*)p.out;
  float* BS = (float*)(p.ws + OFF_BSUM);
  const int tid0 = threadIdx.x;
  const int wp0 = tid0 >> 7;
  const int cid = ri * 2 + wp0;
  const int b = cid >> 4, d = (cid >> 3) & 1, h = cid & 7;
  f32x4 S[4][2];
#pragma unroll
  for (int i = 0; i < 4; ++i)
#pragma unroll
    for (int j = 0; j < 2; ++j) S[i][j] = (f32x4){0.f, 0.f, 0.f, 0.f};
  uint4 bw[2][4];
  float l0[4];
  {
    const int lane = tid0 & 63, wi = (tid0 >> 6) & 1, fr = lane & 15, fq = lane >> 4;
    const float* wsrc = (wi == 0 ? p.rw_w2 : p.rw_a2) + (size_t)d * 64 * 512 + h * 64;
    const float* bsrc = (wi == 0 ? p.rw_w0 : p.rw_a0) + d * 512 + h * 64;
#pragma unroll
    for (int nt = 0; nt < 4; ++nt) {
      l0[nt] = bsrc[nt * 16 + fr];
#pragma unroll
      for (int ks = 0; ks < 2; ++ks) {
        __builtin_amdgcn_sched_barrier(0);
        float f[8];
        const float* wp_ = wsrc + (size_t)(ks * 32 + fq * 8) * 512 + nt * 16 + fr;
#pragma unroll
        for (int j = 0; j < 8; ++j) f[j] = wp_[j * 512];
        bw[ks][nt] = pack8(f);
      }
    }
  }
  uint4 pre[5][3];
#define RW_LOAD(CI)                                                                                 \
  {                                                                                                 \
    const int seg_ = (CI) < 16 ? 0 : 1;                                                             \
    const int ch_ = seg_ ? (CI)-16 : (CI);                                                          \
    const int Ls_ = seg_ ? 2048 : 256;                                                              \
    const int rb_ = seg_ ? b * 2048 : NLAT + b * 256;                                               \
    const int sidx_ = ch_ * 16 + stt;                                                               \
    const int t_ = d == 0 ? sidx_ : Ls_ - 1 - sidx_;                                                \
    const u16* prow_ = P + (size_t)(rb_ + t_) * PS1 + spart * 8;                                    \
    _Pragma("unroll") for (int g = 0; g < 5; ++g) {                                                 \
      const int col_ = g < 3 ? g * 512 + h * 64 : (g == 3 ? 1536 + d * 64 : 1664 + d * 64);         \
      _Pragma("unroll") for (int tap = 0; tap < 3; ++tap) {                                         \
        const int tt_ = t_ + tap - 1;                                                               \
        if (tt_ >= 0 && tt_ < Ls_) pre[g][tap] = *(const uint4*)(prow_ + (ptrdiff_t)(tap - 1) * PS1 + col_); \
        else pre[g][tap] = make_uint4(0u, 0u, 0u, 0u);                                              \
      }                                                                                             \
    }                                                                                               \
  }
  {
    const int pt = tid0 & 127, stt = pt >> 3, spart = pt & 7;
    RW_LOAD(0)
  }
  for (int cidx = 0; cidx < 144; ++cidx) {
    asm volatile("" ::: "memory");
    int tid = tid0;
    asm volatile("" : "+v"(tid));
    const int lane = tid & 63, wave = tid >> 6, wp = wave >> 1, wi = wave & 1, pt = tid & 127;
    const int fr = lane & 15, fq = lane >> 4, stt = pt >> 3, spart = pt & 7;
    const int seg = cidx < 16 ? 0 : 1;
    const int ch = seg ? cidx - 16 : cidx;
    const int Ls = seg ? 2048 : 256;
    char* base = smem + wp * 32768;
    u16* RK = (u16*)base;
    u16* KD = RK + 1152;
    u16* KK = KD + 1152;
    u16* AB = KK + 1152;
    u16* VT = AB + 1152;
    float* LW = (float*)(base + 11264);
    u16* TW = (u16*)(base + 15360);
    u16* AD = TW + 1152;
    u16* BgCT = (u16*)(base + 19968);
    u16* KgCT = BgCT + 1024;
    float* gC = (float*)(base + 24064);
    float* Amat = (float*)(base + 24320) + wi * 256;
    u16* Tinv = (u16*)(base + 26368) + wi * 256;
    u16* BG = (u16*)(base + 27392);
    {
      const int o = stt * 72 + spart * 8;
#pragma unroll
      for (int g = 0; g < 5; ++g) {
        __builtin_amdgcn_sched_barrier(0);
        const int col = g < 3 ? g * 512 + h * 64 : (g == 3 ? 1536 + d * 64 : 1664 + d * 64);
        float pc[8], pp[8], pn[8], v[8];
        unpack8(pre[g][1], pc); unpack8(pre[g][0], pp); unpack8(pre[g][2], pn);
        const float* mu = p.rw_mu + col + spart * 8;
        float4 m0 = *(const float4*)mu, m1 = *(const float4*)(mu + 4);
        const float mm[8] = {m0.x, m0.y, m0.z, m0.w, m1.x, m1.y, m1.z, m1.w};
#pragma unroll
        for (int j = 0; j < 8; ++j) v[j] = pc[j] + mm[j] * (0.5f * (pp[j] + pn[j]) - pc[j]);
        if (g == 0) *(uint4*)(RK + o) = pack8(v);
        else if (g == 1) {
          *(uint4*)(KD + o) = pack8(v);
          const float* kkw = p.rw_kk + h * 64 + spart * 8;
          float kkv[8];
          float ss = 0.f;
#pragma unroll
          for (int j = 0; j < 8; ++j) { kkv[j] = v[j] * kkw[j]; ss += kkv[j] * kkv[j]; }
          ss += __shfl_xor(ss, 1, 64); ss += __shfl_xor(ss, 2, 64); ss += __shfl_xor(ss, 4, 64);
          const float inv = rsqrtf(ss + 1e-6f);
#pragma unroll
          for (int j = 0; j < 8; ++j) kkv[j] *= inv;
          *(uint4*)(KK + o) = pack8(kkv);
        } else if (g == 2) {
#pragma unroll
          for (int j = 0; j < 8; ++j) VT[(spart * 8 + j) * 16 + stt] = f2bf(v[j]);
        } else if (g == 3) {
#pragma unroll
          for (int j = 0; j < 8; ++j) v[j] = fast_tanh(v[j]);
          *(uint4*)(TW + o) = pack8(v);
        } else *(uint4*)(AD + o) = pack8(v);
      }
    }
    __syncthreads();
    if (cidx + 1 < 144) RW_LOAD(cidx + 1)
    {
      const u16* IN = wi == 0 ? TW : AD;
      bf16x8 af0 = *(const bf16x8*)(IN + fr * 72 + fq * 8);
      bf16x8 af1 = *(const bf16x8*)(IN + fr * 72 + 32 + fq * 8);
#pragma unroll
      for (int nt = 0; nt < 4; ++nt) {
        f32x4 o4 = (f32x4){0.f, 0.f, 0.f, 0.f};
        o4 = __builtin_amdgcn_mfma_f32_16x16x32_bf16(af0, *(bf16x8*)&bw[0][nt], o4, 0, 0, 0);
        o4 = __builtin_amdgcn_mfma_f32_16x16x32_bf16(af1, *(bf16x8*)&bw[1][nt], o4, 0, 0, 0);
#pragma unroll
        for (int e = 0; e < 4; ++e) {
          const float prev = l0[nt] + o4[e];
          const int t = fq * 4 + e, c = nt * 16 + fr;
          if (wi == 0) LW[t * 64 + c] = -__expf(-softplus(-prev) - 0.5f);
          else AB[t * 72 + c] = f2bf(sigm(prev));
        }
      }
    }
    __syncthreads();
    {
      const int c = lane;
      float cum = 0.f;
      if (wi == 0) {
#pragma unroll 4
        for (int t = 0; t < 16; ++t) {
          const float lw = LW[t * 64 + c];
          const float gp = __expf(cum);
          cum += lw;
          const float gi = __expf(-cum);
          const float kk = bf2f(KK[t * 72 + c]);
          const float a = bf2f(AB[t * 72 + c]);
          KK[t * 72 + c] = f2bf(kk * gp);
          BG[t * 72 + c] = f2bf(kk * a * gi);
        }
        const float gCv = __expf(cum);
        gC[c] = gCv;
#pragma unroll 4
        for (int t = 0; t < 16; ++t) BgCT[c * 16 + t] = f2bf(-bf2f(BG[t * 72 + c]) * gCv);
      } else {
        float* PR = (float*)TW;
        const float kac = p.rw_ka[h * 64 + c], rkc = p.rw_rk[h * 64 + c];
#pragma unroll 4
        for (int t = 0; t < 16; ++t) {
          const float lw = LW[t * 64 + c];
          cum += lw;
          const float g = __expf(cum), gi = __expf(-cum);
          const float r = bf2f(RK[t * 72 + c]);
          const float k = bf2f(KD[t * 72 + c]);
          const float a = bf2f(AB[t * 72 + c]);
          const float kd = k * (1.f + (a - 1.f) * kac);
          RK[t * 72 + c] = f2bf(r * g);
          KD[t * 72 + c] = f2bf(kd * gi);
          PR[t * 64 + c] = r * kd * rkc;
        }
        const float gCv = __expf(cum);
#pragma unroll 4
        for (int t = 0; t < 16; ++t) KgCT[c * 16 + t] = f2bf(bf2f(KD[t * 72 + c]) * gCv);
        lds_wave_sync();
        {
          const int t = lane >> 2, sg = lane & 3;
          const float4 q0 = *(const float4*)(PR + t * 64 + sg * 16), q1 = *(const float4*)(PR + t * 64 + sg * 16 + 4);
          const float4 q2 = *(const float4*)(PR + t * 64 + sg * 16 + 8), q3 = *(const float4*)(PR + t * 64 + sg * 16 + 12);
          float bsum = (q0.x + q0.y + q0.z + q0.w) + (q1.x + q1.y + q1.z + q1.w) + (q2.x + q2.y + q2.z + q2.w) + (q3.x + q3.y + q3.z + q3.w);
          bsum += __shfl_xor(bsum, 1, 64);
          bsum += __shfl_xor(bsum, 2, 64);
          if (seg == 1 && sg == 0) {
            const int sidx = ch * 16 + t;
            const int tpos = d == 0 ? sidx : 2047 - sidx;
            BS[(size_t)(b * 2048 + tpos) * 16 + h * 2 + d] = bsum;
          }
        }
      }
    }
    __syncthreads();
    __builtin_amdgcn_sched_barrier(0);
    {
      f32x4 XabT = (f32x4){0.f, 0.f, 0.f, 0.f}, XakT = XabT, XrbT = XabT, XrkT = XabT;
#pragma unroll
      for (int ks = 0; ks < 2; ++ks) {
        bf16x8 kkf = *(const bf16x8*)(KK + fr * 72 + ks * 32 + fq * 8);
        bf16x8 rgf = *(const bf16x8*)(RK + fr * 72 + ks * 32 + fq * 8);
        bf16x8 bgf = *(const bf16x8*)(BG + fr * 72 + ks * 32 + fq * 8);
        bf16x8 kgf = *(const bf16x8*)(KD + fr * 72 + ks * 32 + fq * 8);
        XabT = __builtin_amdgcn_mfma_f32_16x16x32_bf16(bgf, kkf, XabT, 0, 0, 0);
        XakT = __builtin_amdgcn_mfma_f32_16x16x32_bf16(kgf, kkf, XakT, 0, 0, 0);
        XrbT = __builtin_amdgcn_mfma_f32_16x16x32_bf16(bgf, rgf, XrbT, 0, 0, 0);
        XrkT = __builtin_amdgcn_mfma_f32_16x16x32_bf16(kgf, rgf, XrkT, 0, 0, 0);
      }
      {
        float am[4];
#pragma unroll
        for (int e = 0; e < 4; ++e) am[e] = (fq * 4 + e < fr) ? XabT[e] : 0.f;
        *(float4*)(Amat + fr * 16 + fq * 4) = make_float4(am[0], am[1], am[2], am[3]);
      }
      lds_wave_sync();
      if (lane < 16) {
        float x[16];
        x[0] = (lane == 0) ? 1.f : 0.f;
        float4 cur[4], nxt[4];
        cur[0] = *(const float4*)(Amat + 16);
        cur[1] = cur[0]; cur[2] = cur[0]; cur[3] = cur[0];
#pragma unroll
        for (int i = 1; i < 16; ++i) {
          __builtin_amdgcn_sched_barrier(0);
          if (i + 1 < 16) {
#pragma unroll
            for (int q = 0; q < (i + 4) / 4; ++q) nxt[q] = *(const float4*)(Amat + (i + 1) * 16 + q * 4);
          }
          float acc = (i == lane) ? 1.f : 0.f;
#pragma unroll
          for (int j = 0; j < i; ++j) {
            const float4 rv = cur[j >> 2];
            const float av = (j & 3) == 0 ? rv.x : ((j & 3) == 1 ? rv.y : ((j & 3) == 2 ? rv.z : rv.w));
            acc -= av * x[j];
          }
          x[i] = acc;
#pragma unroll
          for (int q = 0; q < 4; ++q) cur[q] = nxt[q];
        }
#pragma unroll
        for (int i = 0; i < 16; ++i) Tinv[i * 16 + lane] = f2bf(x[i]);
      }
      lds_wave_sync();
      f32x4 sa0[2], y0[2];
#pragma unroll
      for (int nt = 0; nt < 2; ++nt) { sa0[nt] = (f32x4){0.f, 0.f, 0.f, 0.f}; y0[nt] = (f32x4){0.f, 0.f, 0.f, 0.f}; }
#pragma unroll
      for (int x = 0; x < 2; ++x) {
        __builtin_amdgcn_sched_barrier(0);
        uint2 k0 = *(const uint2*)(KK + fr * 72 + 32 * x + fq * 4);
        uint2 k1 = *(const uint2*)(KK + fr * 72 + 32 * x + 16 + fq * 4);
        uint2 r0 = *(const uint2*)(RK + fr * 72 + 32 * x + fq * 4);
        uint2 r1 = *(const uint2*)(RK + fr * 72 + 32 * x + 16 + fq * 4);
        uint4 kw = make_uint4(k0.x, k0.y, k1.x, k1.y);
        uint4 rw = make_uint4(r0.x, r0.y, r1.x, r1.y);
#pragma unroll
        for (int nt = 0; nt < 2; ++nt) {
          uint4 sw;
          sw.x = pack2(S[2 * x][nt][0], S[2 * x][nt][1]); sw.y = pack2(S[2 * x][nt][2], S[2 * x][nt][3]);
          sw.z = pack2(S[2 * x + 1][nt][0], S[2 * x + 1][nt][1]); sw.w = pack2(S[2 * x + 1][nt][2], S[2 * x + 1][nt][3]);
          sa0[nt] = __builtin_amdgcn_mfma_f32_16x16x32_bf16(*(bf16x8*)&kw, *(bf16x8*)&sw, sa0[nt], 0, 0, 0);
          y0[nt] = __builtin_amdgcn_mfma_f32_16x16x32_bf16(*(bf16x8*)&rw, *(bf16x8*)&sw, y0[nt], 0, 0, 0);
        }
      }
      float ak[4], rb[4], rk[4];
#pragma unroll
      for (int e = 0; e < 4; ++e) {
        const int j = fq * 4 + e;
        ak[e] = (j < fr) ? XakT[e] : 0.f;
        rb[e] = (j <= fr) ? -XrbT[e] : 0.f;
        rk[e] = (j <= fr) ? XrkT[e] : 0.f;
      }
      const uint4 akw = make_uint4(pack2(ak[0], ak[1]), pack2(ak[2], ak[3]), 0u, 0u);
      const uint4 ybw = make_uint4(pack2(rb[0], rb[1]), pack2(rb[2], rb[3]), pack2(rk[0], rk[1]), pack2(rk[2], rk[3]));
      const uint2 tv = *(const uint2*)(Tinv + fr * 16 + fq * 4);
      const uint4 tw = make_uint4(tv.x, tv.y, 0u, 0u);
      uint4 sv[2];
#pragma unroll
      for (int nt = 0; nt < 2; ++nt) {
        const int vc = wi * 32 + nt * 16 + fr;
        const uint2 vt = *(const uint2*)(VT + vc * 16 + fq * 4);
        const uint4 vb = make_uint4(vt.x, vt.y, 0u, 0u);
        f32x4 rhs = __builtin_amdgcn_mfma_f32_16x16x32_bf16(*(bf16x8*)&akw, *(bf16x8*)&vb, sa0[nt], 0, 0, 0);
        const uint4 rw = make_uint4(pack2(rhs[0], rhs[1]), pack2(rhs[2], rhs[3]), 0u, 0u);
        f32x4 sa = __builtin_amdgcn_mfma_f32_16x16x32_bf16(*(bf16x8*)&tw, *(bf16x8*)&rw, (f32x4){0.f, 0.f, 0.f, 0.f}, 0, 0, 0);
        sv[nt] = make_uint4(pack2(sa[0], sa[1]), pack2(sa[2], sa[3]), vt.x, vt.y);
        f32x4 y = __builtin_amdgcn_mfma_f32_16x16x32_bf16(*(bf16x8*)&ybw, *(bf16x8*)&sv[nt], y0[nt], 0, 0, 0);
        if (seg == 1) {
#pragma unroll
          for (int e = 0; e < 4; ++e) {
            const int sidx = ch * 16 + fq * 4 + e;
            const int tpos = d == 0 ? sidx : 2047 - sidx;
            O4[((size_t)d * NLAT + b * 2048 + tpos) * 512 + h * 64 + vc] = f2bf(y[e]);
          }
        }
      }
#pragma unroll
      for (int mt = 0; mt < 4; ++mt) {
        __builtin_amdgcn_sched_barrier(0);
        const float4 g4 = *(const float4*)(gC + mt * 16 + fq * 4);
        const uint2 bv = *(const uint2*)(BgCT + (mt * 16 + fr) * 16 + fq * 4);
        const uint2 kv = *(const uint2*)(KgCT + (mt * 16 + fr) * 16 + fq * 4);
        const uint4 aw = make_uint4(bv.x, bv.y, kv.x, kv.y);
#pragma unroll
        for (int nt = 0; nt < 2; ++nt) {
          S[mt][nt][0] *= g4.x; S[mt][nt][1] *= g4.y; S[mt][nt][2] *= g4.z; S[mt][nt][3] *= g4.w;
          S[mt][nt] = __builtin_amdgcn_mfma_f32_16x16x32_bf16(*(bf16x8*)&aw, *(bf16x8*)&sv[nt], S[mt][nt], 0, 0, 0);
        }
      }
    }
    __syncthreads();
  }
#undef RW_LOAD
}

DEV void gdn_item(const Params& p, int gi, char* smem) {
  const u16* P = (const u16*)(p.ws + OFF_BIG);
  u16* O4 = (u16*)p.out;
  const int tid0 = threadIdx.x;
  const int b = gi >> 3, d = (gi >> 2) & 1, h = gi & 3;
  constexpr int BUFB = 23424;
  f32x4 S[8][2];
#pragma unroll
  for (int i = 0; i < 8; ++i)
#pragma unroll
    for (int j = 0; j < 2; ++j) S[i][j] = (f32x4){0.f, 0.f, 0.f, 0.f};
  const float negA = -__expf(p.dn_A_log[d * 4 + h]);
  const float dtb = p.dn_dt_bias[d * 4 + h];
  uint4 pre[3][3];
  float gpre0 = 0.f, gpre1 = 0.f;
#define GDN_LOAD(CI)                                                                               \
  {                                                                                                \
    const int seg_ = (CI) < 16 ? 0 : 1;                                                            \
    const int ch_ = seg_ ? (CI)-16 : (CI);                                                         \
    const int Ls_ = seg_ ? 2048 : 256;                                                             \
    const int rb_ = seg_ ? b * 2048 : NLAT + b * 256;                                              \
    const int sidx_ = ch_ * 16 + stt;                                                              \
    const int t_ = d == 0 ? sidx_ : Ls_ - 1 - sidx_;                                               \
    const u16* prow_ = P + (size_t)(rb_ + t_) * PS1 + DNO;                                         \
    _Pragma("unroll") for (int g = 0; g < 3; ++g) {                                                \
      const int col_ = g * 512 + h * 128 + spart * 8;                                              \
      _Pragma("unroll") for (int tap = 0; tap < 3; ++tap) {                                        \
        const int tt_ = t_ + tap - 1;                                                              \
        if (tt_ >= 0 && tt_ < Ls_) pre[g][tap] = *(const uint4*)(prow_ + (ptrdiff_t)(tap - 1) * PS1 + col_); \
        else pre[g][tap] = make_uint4(0u, 0u, 0u, 0u);                                             \
      }                                                                                            \
    }                                                                                              \
    if (wave == 0) {                                                                               \
      const int s2_ = ch_ * 16 + fr;                                                               \
      const int t2_ = d == 0 ? s2_ : Ls_ - 1 - s2_;                                                \
      const u16* gr_ = P + (size_t)(rb_ + t2_) * PS1 + DNO + 2048;                                 \
      gpre0 = bf2f(gr_[d * 4 + h]);                                                                \
      gpre1 = bf2f(gr_[8 + d * 4 + h]);                                                            \
    }                                                                                              \
  }
  {
    const int tid = tid0, lane = tid & 63, wave = tid >> 6, fr = lane & 15, stt = tid >> 4, spart = tid & 15;
    GDN_LOAD(0)
  }
  for (int cidx = 0; cidx < 144; ++cidx) {
    asm volatile("" ::: "memory");
    int tid = tid0;
    asm volatile("" : "+v"(tid));
    const int lane = tid & 63, wave = tid >> 6, fr = lane & 15, fq = lane >> 4, stt = tid >> 4, spart = tid & 15;
    char* buf = smem;
    u16* Kb = (u16*)buf;
    u16* Qb = Kb + 16 * 136;
    float* Vf = (float*)(buf + 8704);
    u16* KdT = (u16*)(buf + 17152);
    u16* Tinv = (u16*)(buf + 21248);
    u16* Pm = (u16*)(buf + 21760);
    float* Amat = (float*)(buf + 22272);
    float* Gs = (float*)(buf + 23296);
    float* Bs = Gs + 16;
#pragma unroll
    for (int g = 0; g < 3; ++g) {
      __builtin_amdgcn_sched_barrier(0);
      const int col = g * 512 + h * 128 + spart * 8;
      float z[8];
#pragma unroll
      for (int j = 0; j < 8; ++j) z[j] = 0.f;
#pragma unroll
      for (int tap = 0; tap < 3; ++tap) {
        __builtin_amdgcn_sched_barrier(0);
        float f[8];
        unpack8(pre[g][tap], f);
        const float* w = p.dn_conv + tap * 1536 + col;
        float4 w0 = *(const float4*)w, w1 = *(const float4*)(w + 4);
        z[0] += f[0] * w0.x; z[1] += f[1] * w0.y; z[2] += f[2] * w0.z; z[3] += f[3] * w0.w;
        z[4] += f[4] * w1.x; z[5] += f[5] * w1.y; z[6] += f[6] * w1.z; z[7] += f[7] * w1.w;
      }
      float ss = 0.f;
#pragma unroll
      for (int j = 0; j < 8; ++j) { z[j] = silu(z[j]); ss += z[j] * z[j]; }
      if (g < 2) {
        ss += __shfl_xor(ss, 1, 64); ss += __shfl_xor(ss, 2, 64); ss += __shfl_xor(ss, 4, 64); ss += __shfl_xor(ss, 8, 64);
        float sc = rsqrtf(ss + 1e-6f);
        if (g == 0) sc *= 0.08838834764831845f;
#pragma unroll
        for (int j = 0; j < 8; ++j) z[j] *= sc;
        *(uint4*)((g == 0 ? Qb : Kb) + stt * 136 + spart * 8) = pack8(z);
      } else {
        float* dst = Vf + stt * 132 + spart * 8;
        *(float4*)dst = make_float4(z[0], z[1], z[2], z[3]);
        *(float4*)(dst + 4) = make_float4(z[4], z[5], z[6], z[7]);
      }
    }
    if (wave == 0) {
      float g = negA * softplus(gpre0 + dtb);
#pragma unroll
      for (int o = 1; o < 16; o <<= 1) { float n = __shfl_up(g, o, 16); if (fr >= o) g += n; }
      if (lane < 16) { Gs[lane] = g; Bs[lane] = sigm(gpre1); }
    }
    __syncthreads();
    if (wave == 0) {
      f32x4 kk = (f32x4){0.f, 0.f, 0.f, 0.f};
#pragma unroll
      for (int ks = 0; ks < 4; ++ks) {
        bf16x8 kf = *(const bf16x8*)(Kb + fr * 136 + ks * 32 + fq * 8);
        kk = __builtin_amdgcn_mfma_f32_16x16x32_bf16(kf, kf, kk, 0, 0, 0);
      }
      const float Gj = Gs[fr];
#pragma unroll
      for (int e = 0; e < 4; ++e) {
        const int i = fq * 4 + e;
        const float a = (fr < i) ? Bs[i] * kk[e] * __expf(Gs[i] - Gj) : 0.f;
        Amat[i * 16 + fr] = a;
      }
      lds_wave_sync();
      if (lane < 16) {
        float x[16];
        x[0] = (lane == 0) ? 1.f : 0.f;
        float4 cur[4], nxt[4];
        cur[0] = *(const float4*)(Amat + 16);
        cur[1] = cur[0]; cur[2] = cur[0]; cur[3] = cur[0];
#pragma unroll
        for (int i = 1; i < 16; ++i) {
          __builtin_amdgcn_sched_barrier(0);
          if (i + 1 < 16) {
#pragma unroll
            for (int q = 0; q < (i + 4) / 4; ++q) nxt[q] = *(const float4*)(Amat + (i + 1) * 16 + q * 4);
          }
          float acc = (i == lane) ? 1.f : 0.f;
#pragma unroll
          for (int j = 0; j < i; ++j) {
            const float4 rv = cur[j >> 2];
            const float av = (j & 3) == 0 ? rv.x : ((j & 3) == 1 ? rv.y : ((j & 3) == 2 ? rv.z : rv.w));
            acc -= av * x[j];
          }
          x[i] = acc;
#pragma unroll
          for (int q = 0; q < 4; ++q) cur[q] = nxt[q];
        }
#pragma unroll
        for (int i = 0; i < 16; ++i) Tinv[i * 16 + lane] = f2bf(x[i]);
      }
    } else if (wave == 1) {
      f32x4 qk = (f32x4){0.f, 0.f, 0.f, 0.f};
#pragma unroll
      for (int ks = 0; ks < 4; ++ks) {
        bf16x8 qf = *(const bf16x8*)(Qb + fr * 136 + ks * 32 + fq * 8);
        bf16x8 kf = *(const bf16x8*)(Kb + fr * 136 + ks * 32 + fq * 8);
        qk = __builtin_amdgcn_mfma_f32_16x16x32_bf16(qf, kf, qk, 0, 0, 0);
      }
      const float Gj = Gs[fr];
#pragma unroll
      for (int e = 0; e < 4; ++e) {
        const int t = fq * 4 + e;
        const float v = (fr <= t) ? qk[e] * __expf(Gs[t] - Gj) : 0.f;
        Pm[t * 16 + fr] = f2bf(v);
      }
    } else {
      const int k = tid - 128;
      const float GC = Gs[15];
      unsigned w[8];
#pragma unroll
      for (int j = 0; j < 8; ++j) {
        __builtin_amdgcn_sched_barrier(0);
        float v0 = bf2f(Kb[(2 * j) * 136 + k]) * __expf(GC - Gs[2 * j]);
        float v1 = bf2f(Kb[(2 * j + 1) * 136 + k]) * __expf(GC - Gs[2 * j + 1]);
        w[j] = pack2(v0, v1);
      }
      *(uint4*)(KdT + k * 16) = make_uint4(w[0], w[1], w[2], w[3]);
      *(uint4*)(KdT + k * 16 + 8) = make_uint4(w[4], w[5], w[6], w[7]);
    }
    __builtin_amdgcn_sched_barrier(0);
    f32x4 ksv[2], qsv[2];
#pragma unroll
    for (int nt = 0; nt < 2; ++nt) { ksv[nt] = (f32x4){0.f, 0.f, 0.f, 0.f}; qsv[nt] = (f32x4){0.f, 0.f, 0.f, 0.f}; }
#pragma unroll
    for (int x = 0; x < 4; ++x) {
      __builtin_amdgcn_sched_barrier(0);
      uint2 k0 = *(const uint2*)(Kb + fr * 136 + 32 * x + fq * 4);
      uint2 k1 = *(const uint2*)(Kb + fr * 136 + 32 * x + 16 + fq * 4);
      uint2 q0 = *(const uint2*)(Qb + fr * 136 + 32 * x + fq * 4);
      uint2 q1 = *(const uint2*)(Qb + fr * 136 + 32 * x + 16 + fq * 4);
      uint4 kw = make_uint4(k0.x, k0.y, k1.x, k1.y);
      uint4 qw = make_uint4(q0.x, q0.y, q1.x, q1.y);
#pragma unroll
      for (int nt = 0; nt < 2; ++nt) {
        uint4 sw;
        sw.x = pack2(S[2 * x][nt][0], S[2 * x][nt][1]); sw.y = pack2(S[2 * x][nt][2], S[2 * x][nt][3]);
        sw.z = pack2(S[2 * x + 1][nt][0], S[2 * x + 1][nt][1]); sw.w = pack2(S[2 * x + 1][nt][2], S[2 * x + 1][nt][3]);
        ksv[nt] = __builtin_amdgcn_mfma_f32_16x16x32_bf16(*(bf16x8*)&kw, *(bf16x8*)&sw, ksv[nt], 0, 0, 0);
        qsv[nt] = __builtin_amdgcn_mfma_f32_16x16x32_bf16(*(bf16x8*)&qw, *(bf16x8*)&sw, qsv[nt], 0, 0, 0);
      }
    }
    __syncthreads();
    if (cidx + 1 < 144) GDN_LOAD(cidx + 1)
    __builtin_amdgcn_sched_barrier(0);
    {
      const int seg = cidx < 16 ? 0 : 1;
      const int ch = seg ? cidx - 16 : cidx;
      float eG[4], bt[4];
#pragma unroll
      for (int e = 0; e < 4; ++e) { eG[e] = __expf(Gs[fq * 4 + e]); bt[e] = Bs[fq * 4 + e]; }
      const float eGC = __expf(Gs[15]);
      uint2 tv = *(const uint2*)(Tinv + fr * 16 + fq * 4);
      uint2 pv = *(const uint2*)(Pm + fr * 16 + fq * 4);
      uint4 tw = make_uint4(tv.x, tv.y, 0u, 0u);
      uint4 pw = make_uint4(pv.x, pv.y, 0u, 0u);
      uint4 ub[2];
#pragma unroll
      for (int nt = 0; nt < 2; ++nt) {
        const int vc = wave * 32 + nt * 16 + fr;
        float rhs[4];
#pragma unroll
        for (int e = 0; e < 4; ++e) rhs[e] = bt[e] * (Vf[(fq * 4 + e) * 132 + vc] - eG[e] * ksv[nt][e]);
        uint4 rw = make_uint4(pack2(rhs[0], rhs[1]), pack2(rhs[2], rhs[3]), 0u, 0u);
        f32x4 u = __builtin_amdgcn_mfma_f32_16x16x32_bf16(*(bf16x8*)&tw, *(bf16x8*)&rw, (f32x4){0.f, 0.f, 0.f, 0.f}, 0, 0, 0);
        ub[nt] = make_uint4(pack2(u[0], u[1]), pack2(u[2], u[3]), 0u, 0u);
        f32x4 oa;
#pragma unroll
        for (int e = 0; e < 4; ++e) oa[e] = eG[e] * qsv[nt][e];
        oa = __builtin_amdgcn_mfma_f32_16x16x32_bf16(*(bf16x8*)&pw, *(bf16x8*)&ub[nt], oa, 0, 0, 0);
        if (seg == 1) {
#pragma unroll
          for (int e = 0; e < 4; ++e) {
            const int sidx = ch * 16 + fq * 4 + e;
            const int t = d == 0 ? sidx : 2047 - sidx;
            O4[((size_t)(2 + d) * NLAT + b * 2048 + t) * 512 + h * 128 + vc] = f2bf(oa[e]);
          }
        }
      }
#pragma unroll
      for (int mt = 0; mt < 8; ++mt) {
        __builtin_amdgcn_sched_barrier(0);
        uint2 kv = *(const uint2*)(KdT + (mt * 16 + fr) * 16 + fq * 4);
        uint4 kw = make_uint4(kv.x, kv.y, 0u, 0u);
#pragma unroll
        for (int nt = 0; nt < 2; ++nt) {
#pragma unroll
          for (int e = 0; e < 4; ++e) S[mt][nt][e] *= eGC;
          S[mt][nt] = __builtin_amdgcn_mfma_f32_16x16x32_bf16(*(bf16x8*)&kw, *(bf16x8*)&ub[nt], S[mt][nt], 0, 0, 0);
        }
      }
    }
    __syncthreads();
  }
#undef GDN_LOAD
}

DEV void phase_scans(const Params& p, char* smem) {
#pragma unroll 1
  for (int it = blockIdx.x; it < 512; it += gridDim.x)
    if (it & 1) rwkv_item(p, it >> 1, smem);
  __builtin_amdgcn_sched_barrier(0);
#pragma unroll 1
  for (int it = blockIdx.x; it < 512; it += gridDim.x)
    if (!(it & 1)) gdn_item(p, it >> 1, smem);
}

DEV void mixout_item(const Params& p, int it, char* smem) {
  const u16* P = (const u16*)(p.ws + OFF_BIG);
  const u16* O4 = (const u16*)p.out;
  const float* BS = (const float*)(p.ws + OFF_BSUM);
  const u16* G2T = (const u16*)(p.ws + OFF_G2T);
  u16* Y = (u16*)(p.ws + OFF_HY);
  u16* sg = (u16*)smem;
  u16* G = sg + 32 * 136;
  const int tid = threadIdx.x, lane = tid & 63, wave = tid >> 6;
  const int fr = lane & 15, fq = lane >> 4;
  const int tok0 = it * 32, tl0 = tok0 & 2047;
  const int tk = tid >> 3, part = tid & 7;
  const int row = tok0 + tk, t = tl0 + tk;
  const bool hasp = t > 0, hasn = t + 1 < 2048;
  const u16* prow = P + (size_t)row * PS1;
  {
#pragma unroll
    for (int q = 0; q < 2; ++q) {
      const int col = 1792 + part * 16 + q * 8;
      float pc[8], pp[8], pn[8], v[8];
      unpack8(*(const uint4*)(prow + col), pc);
      if (hasp) unpack8(*(const uint4*)(prow - PS1 + col), pp);
      else {
#pragma unroll
        for (int j = 0; j < 8; ++j) pp[j] = 0.f;
      }
      if (hasn) unpack8(*(const uint4*)(prow + PS1 + col), pn);
      else {
#pragma unroll
        for (int j = 0; j < 8; ++j) pn[j] = 0.f;
      }
      const float* mu = p.rw_mu + col;
#pragma unroll
      for (int j = 0; j < 8; ++j) v[j] = sigm(pc[j] + mu[j] * (0.5f * (pp[j] + pn[j]) - pc[j]));
      *(uint4*)(sg + tk * 136 + part * 16 + q * 8) = pack8(v);
    }
  }
  __syncthreads();
  {
    bf16x8 af[2][4];
#pragma unroll
    for (int mt = 0; mt < 2; ++mt)
#pragma unroll
      for (int ks = 0; ks < 4; ++ks) af[mt][ks] = *(const bf16x8*)(sg + (mt * 16 + fr) * 136 + ks * 32 + fq * 8);
#pragma unroll
    for (int nt = 0; nt < 8; ++nt) {
      const u16* bp = G2T + (size_t)(wave * 128 + nt * 16 + fr) * 128 + fq * 8;
      bf16x8 bf0 = *(const bf16x8*)(bp), bf1 = *(const bf16x8*)(bp + 32), bf2 = *(const bf16x8*)(bp + 64), bf3 = *(const bf16x8*)(bp + 96);
#pragma unroll
      for (int mt = 0; mt < 2; ++mt) {
        f32x4 a = (f32x4){0.f, 0.f, 0.f, 0.f};
        a = __builtin_amdgcn_mfma_f32_16x16x32_bf16(af[mt][0], bf0, a, 0, 0, 0);
        a = __builtin_amdgcn_mfma_f32_16x16x32_bf16(af[mt][1], bf1, a, 0, 0, 0);
        a = __builtin_amdgcn_mfma_f32_16x16x32_bf16(af[mt][2], bf2, a, 0, 0, 0);
        a = __builtin_amdgcn_mfma_f32_16x16x32_bf16(af[mt][3], bf3, a, 0, 0, 0);
#pragma unroll
        for (int e = 0; e < 4; ++e) G[(mt * 16 + fq * 4 + e) * 520 + wave * 128 + nt * 16 + fr] = f2bf(a[e]);
      }
    }
  }
  __syncthreads();
  {
    const int hd = part, c0 = hd * 64;
    const u16* of = O4 + (size_t)row * 512 + c0;
    const u16* ob = O4 + ((size_t)NLAT + row) * 512 + c0;
    const float bsum = BS[(size_t)row * 16 + hd * 2] + BS[(size_t)row * 16 + hd * 2 + 1];
    float s1 = 0.f, s2 = 0.f;
#pragma unroll
    for (int q = 0; q < 8; ++q) {
      float a[8], b8[8];
      unpack8(*(const uint4*)(of + q * 8), a);
      unpack8(*(const uint4*)(ob + q * 8), b8);
#pragma unroll
      for (int j = 0; j < 8; ++j) { const float v = a[j] + b8[j]; s1 += v; s2 += v * v; }
    }
    const float mean = s1 * (1.f / 64.f);
    const float var = fmaxf(s2 * (1.f / 64.f) - mean * mean, 0.f);
    const float rs = rsqrtf(var + 64e-5f);
#pragma unroll
    for (int q = 0; q < 8; ++q) {
      __builtin_amdgcn_sched_barrier(0);
      const int c = c0 + q * 8;
      float pc[8], pp[8], pn[8], gv[8], o[8], ya[8], yb[8];
      unpack8(*(const uint4*)(of + q * 8), ya);
      unpack8(*(const uint4*)(ob + q * 8), yb);
      unpack8(*(const uint4*)(prow + 1024 + c), pc);
      if (hasp) unpack8(*(const uint4*)(prow - PS1 + 1024 + c), pp);
      else {
#pragma unroll
        for (int j = 0; j < 8; ++j) pp[j] = 0.f;
      }
      if (hasn) unpack8(*(const uint4*)(prow + PS1 + 1024 + c), pn);
      else {
#pragma unroll
        for (int j = 0; j < 8; ++j) pn[j] = 0.f;
      }
      unpack8(*(const uint4*)(G + tk * 520 + c), gv);
      const float* mu = p.rw_mu + 1024 + c;
      const float* gg = p.rw_lnx_g + c;
      const float* gb = p.rw_lnx_b + c;
#pragma unroll
      for (int j = 0; j < 8; ++j) {
        const float vsh = pc[j] + mu[j] * (0.5f * (pp[j] + pn[j]) - pc[j]);
        const float yn = (ya[j] + yb[j] - mean) * rs * gg[j] + gb[j];
        o[j] = (yn + bsum * vsh) * gv[j];
      }
      *(uint4*)(Y + (size_t)row * 1024 + c) = pack8(o);
    }
  }
  {
    const int c0 = part * 64;
    const u16* of = O4 + ((size_t)2 * NLAT + row) * 512 + c0;
    const u16* ob = O4 + ((size_t)3 * NLAT + row) * 512 + c0;
    float s2 = 0.f;
#pragma unroll
    for (int q = 0; q < 8; ++q) {
      float a[8], b8[8];
      unpack8(*(const uint4*)(of + q * 8), a);
      unpack8(*(const uint4*)(ob + q * 8), b8);
#pragma unroll
      for (int j = 0; j < 8; ++j) { const float v = a[j] + b8[j]; s2 += v * v; }
    }
    s2 += __shfl_xor(s2, 1, 64);
    const float rs = rsqrtf(s2 * (1.f / 128.f) + 1e-6f);
    const u16* zr = prow + DNO + 1536 + c0;
    const float* ng = p.dn_norm_g + (part & 1) * 64;
#pragma unroll
    for (int q = 0; q < 8; ++q) {
      __builtin_amdgcn_sched_barrier(0);
      float z[8], r8[8], a[8], b8[8];
      unpack8(*(const uint4*)(of + q * 8), a);
      unpack8(*(const uint4*)(ob + q * 8), b8);
      unpack8(*(const uint4*)(zr + q * 8), z);
#pragma unroll
      for (int j = 0; j < 8; ++j) r8[j] = (a[j] + b8[j]) * rs * ng[q * 8 + j] * silu(z[j]);
      *(uint4*)(Y + (size_t)row * 1024 + 512 + c0 + q * 8) = pack8(r8);
    }
  }
  __syncthreads();
}

#define XB_TMO      128
#define XB_XCNT(j)  (256  + 64 * (j))
#define XB_XSUB(j)  (1280 + 64 * (j))
#define XB_XGEN(j)  (2304 + 64 * (j))
#define XB_TOP      3328
#define XB_TOPGEN   3392
#define XCD_BAR_WORDS 3456
#define XB_SPIN_CAP (1u << 20)
DEV unsigned xb_ld(unsigned* p) { return __hip_atomic_load(p, __ATOMIC_RELAXED, __HIP_MEMORY_SCOPE_AGENT); }
DEV unsigned xb_add(unsigned* p, unsigned v) { return __hip_atomic_fetch_add(p, v, __ATOMIC_RELAXED, __HIP_MEMORY_SCOPE_AGENT); }
DEV unsigned xb_xcc_id() { return (unsigned)__builtin_amdgcn_s_getreg((3 << 11) | 20) & 0xFu; }
#define XB_SPIN(cond, bar) do { unsigned _sp = 0; while (cond) { __builtin_amdgcn_s_sleep(1); \
    if ((++_sp & 255u) == 0u) { if (xb_ld(&(bar)[XB_TMO])) break; if (_sp > XB_SPIN_CAP) { atomicAdd(&(bar)[XB_TMO], 1u); break; } } } } while (0)
DEV void xcd_barrier_complete(unsigned* bar, unsigned x, unsigned& nloc, unsigned& nx) {
  const unsigned G = gridDim.x;
  unsigned sum, cnt, mine, sp = 0u;
  for (;;) {
    sum = 0u; cnt = 0u; mine = 0u;
#pragma unroll
    for (unsigned j = 0; j < 16; ++j) { const unsigned c = xb_ld(&bar[XB_XCNT(j)]); sum += c; cnt += (c > 0u) ? 1u : 0u; mine = (j == x) ? c : mine; }
    if (sum == G) break;
    __builtin_amdgcn_s_sleep(1);
    if ((++sp & 255u) == 0u) { if (xb_ld(&bar[XB_TMO])) break; if (sp > XB_SPIN_CAP) { atomicAdd(&bar[XB_TMO], 1u); break; } }
  }
  nloc = mine > 0u ? mine : 1u; nx = cnt > 0u ? cnt : 1u;
}
DEV void xcd_barrier(unsigned* bar, unsigned x, unsigned& nloc, unsigned& nx) {
  asm volatile("s_waitcnt vmcnt(0)" ::: "memory");
  __syncthreads();
  if (threadIdx.x == 0) {
    __builtin_amdgcn_s_waitcnt(0);
    if (nloc == 0u) xcd_barrier_complete(bar, x, nloc, nx);
    const unsigned old = xb_add(&bar[XB_XSUB(x)], 1u);
    const unsigned gen = old / nloc;
    if (old + 1u == (gen + 1u) * nloc) {
      __builtin_amdgcn_fence(__ATOMIC_RELEASE, "agent");
      asm volatile("s_waitcnt vmcnt(0)" ::: "memory");
      const unsigned og = xb_add(&bar[XB_TOP], 1u);
      const unsigned tg = og / nx;
      if (og + 1u == (tg + 1u) * nx) xb_add(&bar[XB_TOPGEN], 1u);
      else XB_SPIN(xb_ld(&bar[XB_TOPGEN]) == tg, bar);
      __builtin_amdgcn_fence(__ATOMIC_ACQUIRE, "agent");
      xb_add(&bar[XB_XGEN(x)], 1u);
      asm volatile("s_waitcnt vmcnt(0)" ::: "memory");
    } else {
      XB_SPIN(xb_ld(&bar[XB_XGEN(x)]) == gen, bar);
      __builtin_amdgcn_fence(__ATOMIC_ACQUIRE, "agent");
      asm volatile("s_waitcnt vmcnt(0)" ::: "memory");
    }
  }
  __syncthreads();
}

constexpr int NPHASE = 18;

__global__ void __launch_bounds__(256, 2) mega(Params p, int ph_lo, int ph_hi) {
  __shared__ __attribute__((aligned(16))) char smem[65536];
  cg::grid_group grid = cg::this_grid();
  const float* mv0 = (const float*)(p.ws + OFF_MODV);
  const float* mv1 = mv0 + 33 * 6144;
  u16* X = (u16*)(p.ws + OFF_X);
  u16* HY = (u16*)(p.ws + OFF_HY);
  u16* BIG = (u16*)(p.ws + OFF_BIG);
  unsigned* bar = (unsigned*)(p.ws + OFF_BAR);
  const unsigned xid = xb_xcc_id();
  unsigned nloc = 0u, nx = 0u;
  if (threadIdx.x == 0) (void)xb_add(&bar[XB_XCNT(xid)], 1u);
  if (ph_hi < 0) grid.sync();
#define PHASE(n, BODY) if (ph_lo <= (n) && (n) < ph_hi) { BODY; if ((n) + 1 < ph_hi) xcd_barrier(bar, xid, nloc, nx); }
  PHASE(0, phase_prep(p, smem))
  PHASE(1, phase_init(p))
  PHASE(2, gemm_phase<0>(HY, 1024, (const u16*)(p.ws + OFF_WIN0), 1024, NTOK, 2304, BIG, PS0, nullptr, smem))
  PHASE(3, phase_hyprep_rope(p, smem))
  PHASE(4, phase_conv_attn(p, smem))
  PHASE(5, gemm_phase<2>(HY, 1024, (const u16*)(p.ws + OFF_WOUT0), 1024, NTOK, 1024, X, 1024, mv0 + 2 * 1024, smem))
  PHASE(6, ln_phase<false>(p, NTOK, p.ln_g, p.ln_b, mv0, 3, 4))
  PHASE(7, gemm_phase<1>(HY, 1024, (const u16*)(p.ws + OFF_W1_0), 1024, NTOK, 4096, BIG, 4096, nullptr, smem))
  PHASE(8, gemm_phase<2>(BIG, 4096, (const u16*)(p.ws + OFF_W2_0), 4096, NTOK, 1024, X, 1024, mv0 + 5 * 1024, smem))
  PHASE(9, ln_phase<false>(p, NTOK, p.ln_g + 1024, p.ln_b + 1024, mv1, 0, 1))
  PHASE(10, gemm_phase<0>(HY, 1024, (const u16*)(p.ws + OFF_WIN1), 1024, NTOK, 4096, BIG, PS1, nullptr, smem))
  PHASE(11, phase_scans(p, smem))
  PHASE(12, for (int it = blockIdx.x; it < 2048; it += gridDim.x) mixout_item(p, it, smem))
  PHASE(13, gemm_phase<2>(HY, 1024, (const u16*)(p.ws + OFF_WOUT1), 1024, NLAT, 1024, X, 1024, mv1 + 2 * 1024, smem))
  PHASE(14, ln_phase<false>(p, NLAT, p.ln_g + 2048, p.ln_b + 2048, mv1, 3, 4))
  PHASE(15, gemm_phase<1>(HY, 1024, (const u16*)(p.ws + OFF_W1_1), 1024, NLAT, 4096, BIG, 4096, nullptr, smem))
  PHASE(16, gemm_phase<2>(BIG, 4096, (const u16*)(p.ws + OFF_W2_1), 4096, NLAT, 1024, X, 1024, mv1 + 5 * 1024, smem))
  PHASE(17, ln_phase<true>(p, NLAT, p.ln_g + 3072, p.ln_b + 3072, mv1, 0, 1))
}

extern "C" void kernel_launch(void* const* d_in, const int* in_sizes, int n_in, void* d_out, int out_size, void* d_ws,
                              size_t ws_size, hipStream_t stream) {
  static int grid_blocks = 0;
  if (!grid_blocks) {
    int dev = 0, cus = 0, per_cu = 0;
    hipGetDevice(&dev);
    hipDeviceGetAttribute(&cus, hipDeviceAttributeMultiprocessorCount, dev);
    hipOccupancyMaxActiveBlocksPerMultiprocessor(&per_cu, mega, 256, 0);
    if (per_cu > 2) per_cu = 2;
    if (per_cu < 1) per_cu = 1;
    grid_blocks = cus * per_cu;
  }
  if (ws_size < WS_NEED) fprintf(stderr, "workspace too small: %zu < %zu\n", ws_size, (size_t)WS_NEED);
  Params p{};
  const float** pp = (const float**)&p;
  for (int i = 0; i < 39; ++i) pp[i] = (const float*)d_in[i];
  p.out = (float*)d_out;
  p.ws = (char*)d_ws;
  int lo = 0, hi = NPHASE;
  void* args[] = {&p, &lo, &hi};
  hipMemsetAsync((char*)d_ws + OFF_BAR, 0, XCD_BAR_WORDS * sizeof(unsigned), stream);
  hipError_t e = hipLaunchCooperativeKernel((void*)mega, dim3(grid_blocks), dim3(256), args, 0, stream);
  if (e != hipSuccess) fprintf(stderr, "cooperative launch failed: %s (grid %d)\n", hipGetErrorString(e), grid_blocks);
}
```

```cpp
#include <hip/hip_runtime.h>
#include <hip/hip_cooperative_groups.h>
#include <cstdio>
#include <cstdint>
namespace cg = cooperative_groups;

typedef unsigned short u16;
typedef __attribute__((ext_vector_type(8))) short bf16x8;
typedef __attribute__((ext_vector_type(4))) float f32x4;
typedef __attribute__((ext_vector_type(16))) float f32x16;

#define DEV __device__ __forceinline__

constexpr int NLAT = 65536, NCTX = 8192, NTOK = 73728;
constexpr int PS0 = 2304;
constexpr int PS1 = 4096;
constexpr int DNO = 1920;
constexpr float ALPHA = 1.4142135623730951f;

constexpr size_t OFF_WIN0 = 0;
constexpr size_t OFF_WOUT0 = OFF_WIN0 + (size_t)2304 * 1024 * 2;
constexpr size_t OFF_W1_0 = OFF_WOUT0 + (size_t)1024 * 1024 * 2;
constexpr size_t OFF_W1_1 = OFF_W1_0 + (size_t)4096 * 1024 * 2;
constexpr size_t OFF_W2_0 = OFF_W1_1 + (size_t)4096 * 1024 * 2;
constexpr size_t OFF_W2_1 = OFF_W2_0 + (size_t)4096 * 1024 * 2;
constexpr size_t OFF_WIN1 = OFF_W2_1 + (size_t)4096 * 1024 * 2;
constexpr size_t OFF_WOUT1 = OFF_WIN1 + (size_t)4096 * 1024 * 2;
constexpr size_t OFF_MODV = OFF_WOUT1 + (size_t)1024 * 1024 * 2;
constexpr size_t OFF_KR2048 = OFF_MODV + (size_t)2 * 33 * 6144 * 4;
constexpr size_t OFF_KR256 = OFF_KR2048 + (size_t)512 * 4096 * 2;
constexpr size_t OFF_ROPE = OFF_KR256 + (size_t)512 * 512 * 2;
constexpr size_t OFF_BSUM = OFF_ROPE + 8192;
constexpr size_t OFF_G2T = OFF_BSUM + (size_t)65536 * 16 * 4;
constexpr size_t OFF_BAR = OFF_G2T + (size_t)512 * 128 * 2;
constexpr size_t OFF_X = (size_t)64 << 20;
constexpr size_t OFF_HY = OFF_X + (size_t)NTOK * 1024 * 2;
constexpr size_t OFF_BIG = OFF_HY + (size_t)NTOK * 1024 * 2;
constexpr size_t WS_NEED = OFF_BIG + (size_t)NTOK * 4096 * 2;
static_assert(OFF_BAR + 16384 <= OFF_X, "ws map");
constexpr size_t SO_U = 0;
constexpr size_t SO_X0 = SO_U + (size_t)512 * 32 * 2048 * 2;
constexpr size_t SO_UC = SO_X0 + (size_t)512 * 32 * 2048 * 2;
constexpr size_t SO_X0C = SO_UC + (size_t)512 * 32 * 256 * 2;

struct Params {
  const float *x, *c, *ctx, *c_ctx, *mod_w, *mod_b, *ln_g, *ln_b, *mlp_w1, *mlp_w2, *e_w_in, *e_w_out, *hy_conv,
      *hy_w1, *hy_b1, *hy_w2, *hy_b2, *hy_freq, *hy_w3, *hy_decay, *hy_bias, *attn_sink, *o_w_in, *o_w_out,
      *rw_mu, *rw_w0, *rw_w2, *rw_a0, *rw_a2, *rw_g2, *rw_kk, *rw_ka, *rw_rk, *rw_lnx_g, *rw_lnx_b,
      *dn_conv, *dn_A_log, *dn_dt_bias, *dn_norm_g;
  float* out;
  char* ws;
};

DEV u16 f2bf(float f) { unsigned u = __float_as_uint(f); u += 0x7fffu + ((u >> 16) & 1u); return (u16)(u >> 16); }
DEV float bf2f(u16 h) { return __uint_as_float(((unsigned)h) << 16); }
DEV float bflo(unsigned u) { return __uint_as_float(u << 16); }
DEV float bfhi(unsigned u) { return __uint_as_float(u & 0xffff0000u); }
DEV unsigned pack2(float a, float b) { return (unsigned)f2bf(a) | ((unsigned)f2bf(b) << 16); }
DEV void unpack8(const uint4& v, float* f) {
  f[0] = bflo(v.x); f[1] = bfhi(v.x); f[2] = bflo(v.y); f[3] = bfhi(v.y);
  f[4] = bflo(v.z); f[5] = bfhi(v.z); f[6] = bflo(v.w); f[7] = bfhi(v.w);
}
DEV uint4 pack8(const float* f) {
  uint4 v; v.x = pack2(f[0], f[1]); v.y = pack2(f[2], f[3]); v.z = pack2(f[4], f[5]); v.w = pack2(f[6], f[7]); return v;
}
DEV int modrow(int r) { return r < NLAT ? (r >> 11) : 32; }
DEV float sigm(float x) { return 1.f / (1.f + __expf(-x)); }
DEV float silu(float x) { return x / (1.f + __expf(-x)); }
DEV float softplus(float x) { return fmaxf(x, 0.f) + __logf(1.f + __expf(-fabsf(x))); }
DEV float fast_tanh(float x) { return 1.f - 2.f / (1.f + __expf(2.f * x)); }
DEV float wave_sum(float v) {
#pragma unroll
  for (int o = 32; o > 0; o >>= 1) v += __shfl_xor(v, o, 64);
  return v;
}

DEV void transpose_tile(const float* __restrict__ src, int K, int N, int Npad, u16* __restrict__ dst, int tile,
                               u16* sm) {
  const int tid = threadIdx.x;
  const int ntn = Npad >> 6;
  const int tk = tile / ntn, tn = tile - tk * ntn;
  const int n = tid & 63, kq = tid >> 6;
  const int gn = tn * 64 + n;
#pragma unroll 4
  for (int i = 0; i < 16; ++i) {
    int k = kq + 4 * i;
    float v = (gn < N) ? src[(size_t)(tk * 64 + k) * N + gn] : 0.f;
    sm[n * 66 + k] = f2bf(v);
  }
  __syncthreads();
  const int n2 = tid >> 2, q = tid & 3;
  const unsigned* s32 = (const unsigned*)sm + (n2 * 66 + q * 16) / 2;
  uint4 a, b;
  a.x = s32[0]; a.y = s32[1]; a.z = s32[2]; a.w = s32[3];
  b.x = s32[4]; b.y = s32[5]; b.z = s32[6]; b.w = s32[7];
  u16* d = dst + (size_t)(tn * 64 + n2) * K + tk * 64 + q * 16;
  *(uint4*)d = a;
  *(uint4*)(d + 8) = b;
  __syncthreads();
}

DEV void modv_item(const Params& p, int it, float* sl) {
  const int tid = threadIdx.x;
  const int l = it / 288, rem = it % 288, cc = rem / 3, rg = rem % 3;
  for (int idx = tid; idx < 11 * 1024; idx += 256) {
    int r = rg * 11 + (idx >> 10), k = idx & 1023;
    float cv = (r < 32) ? p.c[r * 1024 + k] : p.c_ctx[k];
    sl[idx] = cv / (1.f + expf(-cv));
  }
  __syncthreads();
  const int cl = tid & 63, kg = tid >> 6;
  const int col = cc * 64 + cl;
  float acc[11];
#pragma unroll
  for (int r = 0; r < 11; ++r) acc[r] = 0.f;
  const float* w = p.mod_w + (size_t)l * 1024 * 6144 + (size_t)(kg * 256) * 6144 + col;
#pragma unroll 8
  for (int k = 0; k < 256; ++k) {
    float wv = w[(size_t)k * 6144];
#pragma unroll
    for (int r = 0; r < 11; ++r) acc[r] += sl[r * 1024 + kg * 256 + k] * wv;
  }
  __syncthreads();
  float* red = sl;
#pragma unroll
  for (int r = 0; r < 11; ++r) red[(kg * 11 + r) * 64 + cl] = acc[r];
  __syncthreads();
  for (int idx = tid; idx < 11 * 64; idx += 256) {
    int r = idx >> 6, c2 = idx & 63;
    float v = red[(0 * 11 + r) * 64 + c2] + red[(1 * 11 + r) * 64 + c2] + red[(2 * 11 + r) * 64 + c2] + red[(3 * 11 + r) * 64 + c2];
    int gcol = cc * 64 + c2;
    ((float*)(p.ws + OFF_MODV))[(size_t)(l * 33 + rg * 11 + r) * 6144 + gcol] = v + p.mod_b[l * 6144 + gcol];
  }
  __syncthreads();
}

DEV void filter_item(const Params& p, int it, float* sm) {
  const int L = it < 2048 ? 2048 : 256;
  const int t = it < 2048 ? it : it - 2048;
  u16* R = (u16*)(p.ws + (L == 2048 ? OFF_KR2048 : OFF_KR256));
  float* pe = sm; float* h1 = sm + 64; float* h2 = sm + 128;
  const int tid = threadIdx.x;
  const float tn = (float)t / (float)(L - 1);
  if (tid < 33) {
    float v;
    if (tid == 0) v = tn;
    else {
      int i = (tid - 1) & 15;
      double band = 1e-4 + (double)i * ((15.0 - 1e-4) / 15.0);
      double ang = 2.0 * 3.14159265358979323846 * (double)t * band / (double)L;
      v = (tid <= 16) ? (float)cos(ang) : (float)(-sin(ang));
    }
    pe[tid] = v;
  }
  __syncthreads();
  if (tid < 64) {
    float acc = p.hy_b1[tid];
#pragma unroll 11
    for (int i = 0; i < 33; ++i) acc += pe[i] * p.hy_w1[i * 64 + tid];
    h1[tid] = sinf(p.hy_freq[tid] * acc);
  }
  __syncthreads();
  if (tid < 64) {
    float acc = p.hy_b2[tid];
#pragma unroll 16
    for (int i = 0; i < 64; ++i) acc += h1[i] * p.hy_w2[i * 64 + tid];
    h2[tid] = sinf(p.hy_freq[tid] * acc);
  }
  __syncthreads();
#pragma unroll 1
  for (int q = 0; q < 4; ++q) {
    int o = tid + 256 * q;
    float acc = 0.f;
#pragma unroll 16
    for (int i = 0; i < 64; ++i) acc += h2[i] * p.hy_w3[i * 1024 + o];
    float val = acc * expf(-tn * fabsf(p.hy_decay[o]));
    if (o < 512) {
      if (t == 0) val += p.hy_bias[o];
      R[(size_t)o * 2 * L + L - t] = f2bf(val);
    } else {
      int c = o - 512;
      if (t >= 1) R[(size_t)c * 2 * L + L + t] = f2bf(val);
      else R[(size_t)c * 2 * L] = 0;
    }
  }
  __syncthreads();
}

DEV void phase_prep(const Params& p, char* smem) {
  constexpr int T_IN0 = 16 * 36, T_OUT = 16 * 16, T_W = 16 * 64;
  constexpr int E0 = T_IN0, E1 = E0 + T_OUT, E2 = E1 + T_W, E3 = E2 + T_W, E4 = E3 + T_W, E5 = E4 + T_W,
                E6 = E5 + T_W, E7 = E6 + T_OUT, E8 = E7 + 576, E9 = E8 + 2304, E10 = E9 + 1, E11 = E10 + 16;
  for (int it = blockIdx.x; it < E11; it += gridDim.x) {
    if (it >= E10) transpose_tile(p.rw_g2, 128, 512, 512, (u16*)(p.ws + OFF_G2T), it - E10, (u16*)smem);
    else if (it < E0) transpose_tile(p.e_w_in, 1024, 2304, 2304, (u16*)(p.ws + OFF_WIN0), it, (u16*)smem);
    else if (it < E1) transpose_tile(p.e_w_out, 1024, 1024, 1024, (u16*)(p.ws + OFF_WOUT0), it - E0, (u16*)smem);
    else if (it < E2) transpose_tile(p.mlp_w1, 1024, 4096, 4096, (u16*)(p.ws + OFF_W1_0), it - E1, (u16*)smem);
    else if (it < E3) transpose_tile(p.mlp_w1 + (size_t)1024 * 4096, 1024, 4096, 4096, (u16*)(p.ws + OFF_W1_1), it - E2, (u16*)smem);
    else if (it < E4) transpose_tile(p.mlp_w2, 4096, 1024, 1024, (u16*)(p.ws + OFF_W2_0), it - E3, (u16*)smem);
    else if (it < E5) transpose_tile(p.mlp_w2 + (size_t)1024 * 4096, 4096, 1024, 1024, (u16*)(p.ws + OFF_W2_1), it - E4, (u16*)smem);
    else if (it < E6) transpose_tile(p.o_w_in, 1024, 3984, 4096, (u16*)(p.ws + OFF_WIN1), it - E5, (u16*)smem);
    else if (it < E7) transpose_tile(p.o_w_out, 1024, 1024, 1024, (u16*)(p.ws + OFF_WOUT1), it - E6, (u16*)smem);
    else if (it < E8) modv_item(p, it - E7, (float*)smem);
    else if (it < E9) filter_item(p, it - E8, (float*)smem);
    else {
      float2* tab = (float2*)(p.ws + OFF_ROPE);
      for (int q = 0; q < 4; ++q) {
        int e = threadIdx.x * 4 + q;
        int pos = e >> 4, i = e & 15;
        float inv = powf(10000.f, -(float)i / 16.f);
        float ang = (float)pos * inv;
        tab[e] = make_float2(cosf(ang), sinf(ang));
      }
    }
  }
}

DEV void phase_init(const Params& p) {
  const float* mv = (const float*)(p.ws + OFF_MODV);
  u16* X = (u16*)(p.ws + OFF_X);
  u16* HM = (u16*)(p.ws + OFF_HY);
  const size_t total = (size_t)NTOK * 128;
  for (size_t i = (size_t)blockIdx.x * 256 + threadIdx.x; i < total; i += (size_t)gridDim.x * 256) {
    int r = (int)(i >> 7), c8 = (int)(i & 127) * 8;
    const float* src = r < NLAT ? p.x + (size_t)r * 1024 + c8 : p.ctx + (size_t)(r - NLAT) * 1024 + c8;
    float4 v0 = *(const float4*)src, v1 = *(const float4*)(src + 4);
    const float* m = mv + (size_t)modrow(r) * 6144 + c8;
    float4 h0 = *(const float4*)m, h1 = *(const float4*)(m + 4);
    float4 s0 = *(const float4*)(m + 1024), s1 = *(const float4*)(m + 1028);
    float f[8] = {v0.x, v0.y, v0.z, v0.w, v1.x, v1.y, v1.z, v1.w};
    float sh[8] = {h0.x, h0.y, h0.z, h0.w, h1.x, h1.y, h1.z, h1.w};
    float sc[8] = {s0.x, s0.y, s0.z, s0.w, s1.x, s1.y, s1.z, s1.w};
    float g[8];
#pragma unroll
    for (int j = 0; j < 8; ++j) g[j] = f[j] * (1.f + sc[j]) + sh[j];
    *(uint4*)(X + (size_t)r * 1024 + c8) = pack8(f);
    *(uint4*)(HM + (size_t)r * 1024 + c8) = pack8(g);
  }
}

template <int EPI>
DEV void gemm_phase(const u16* __restrict__ A, int lda, const u16* __restrict__ Bt, int K, int M, int N,
                           u16* __restrict__ C, int ldc, const float* __restrict__ gate, char* smem) {
  const int tid = threadIdx.x, lane = tid & 63, wave = tid >> 6;
  const int wm = wave >> 1, wn = wave & 1;
  const int fr = lane & 15, fq = lane >> 4;
  const int tn = N >> 7, tiles = (M >> 7) * tn;
  const int nk = K >> 6;
  const int drow = wave * 8 + (lane >> 3);
  const int dchunk = (lane & 7) ^ ((drow >> 1) & 7);
  const size_t lda32 = (size_t)lda * 32, ldb32 = (size_t)K * 32;
  const int sw = fr >> 1;
  const bool xcd_order = (gridDim.x & 7) == 0 && ((M >> 7) & 63) == 0;
  const int per_xcd = tiles >> 3;
  const int nloc = gridDim.x >> 3;
  for (int it = blockIdx.x; it < tiles; it += gridDim.x) {
    int tm_i, tn_i;
    if (xcd_order) {
      const int x = it & 7;
      const int local = it >> 3;
      const int mg = local / (8 * tn), r = local - mg * 8 * tn;
      tn_i = r >> 3;
      tm_i = x * (per_xcd / tn) + mg * 8 + (r & 7);
    } else { tm_i = it / tn; tn_i = it - tm_i * tn; }
    const int m0 = tm_i << 7, n0 = tn_i << 7;
    const u16* ag = A + (size_t)(m0 + drow) * lda + dchunk * 8;
    const u16* bg = Bt + (size_t)(n0 + drow) * K + dchunk * 8;
    f32x4 acc[4][4];
#pragma unroll
    for (int i = 0; i < 4; ++i)
#pragma unroll
      for (int j = 0; j < 4; ++j) acc[i][j] = (f32x4){0.f, 0.f, 0.f, 0.f};
#define G_ISSUE(KT, ST)                                                                                  \
  {                                                                                                      \
    const u16* a2 = ag + (KT)*64;                                                                        \
    const u16* b2 = bg + (KT)*64;                                                                        \
    char* la = smem + (ST)*32768 + wave * 1024;                                                          \
    _Pragma("unroll") for (int j = 0; j < 4; ++j) {                                                      \
      __builtin_amdgcn_global_load_lds((const unsigned*)(a2 + j * lda32), (unsigned*)(la + j * 4096), 16, 0, 0);          \
      __builtin_amdgcn_global_load_lds((const unsigned*)(b2 + j * ldb32), (unsigned*)(la + 16384 + j * 4096), 16, 0, 0);  \
    }                                                                                                    \
  }
    G_ISSUE(0, 0)
    for (int kt = 0; kt < nk; ++kt) {
      asm volatile("s_waitcnt vmcnt(0)" ::: "memory");
      __syncthreads();
      if (kt + 1 < nk) G_ISSUE(kt + 1, (kt + 1) & 1)
      const u16* As = (const u16*)(smem + (kt & 1) * 32768);
      const u16* Bs = As + 8192;
#pragma unroll
      for (int ks = 0; ks < 2; ++ks) {
        bf16x8 af[4], bfr[4];
        const int pos = ((ks * 4 + fq) ^ sw) * 8;
#pragma unroll
        for (int i = 0; i < 4; ++i) {
          af[i] = *(const bf16x8*)(As + (wm * 64 + i * 16 + fr) * 64 + pos);
          bfr[i] = *(const bf16x8*)(Bs + (wn * 64 + i * 16 + fr) * 64 + pos);
        }
        __builtin_amdgcn_s_setprio(1);
#pragma unroll
        for (int i = 0; i < 4; ++i)
#pragma unroll
          for (int j = 0; j < 4; ++j)
            acc[i][j] = __builtin_amdgcn_mfma_f32_16x16x32_bf16(af[i], bfr[j], acc[i][j], 0, 0, 0);
        __builtin_amdgcn_s_setprio(0);
      }
    }
#undef G_ISSUE
    __syncthreads();
    u16* Cs = (u16*)smem;
#pragma unroll
    for (int i = 0; i < 4; ++i)
#pragma unroll
      for (int j = 0; j < 4; ++j)
#pragma unroll
        for (int e = 0; e < 4; ++e) {
          float v = acc[i][j][e];
          if (EPI == 1) { v = fmaxf(v, 0.f); v = v * v; }
          Cs[(wm * 64 + i * 16 + fq * 4 + e) * 136 + wn * 64 + j * 16 + fr] = f2bf(v);
        }
    __syncthreads();
#pragma unroll 2
    for (int q = 0; q < 8; ++q) {
      const int chunk = tid + q * 256;
      const int row = chunk >> 4, cc = chunk & 15;
      uint4 cv = *(const uint4*)(Cs + row * 136 + cc * 8);
      u16* dst = C + (size_t)(m0 + row) * ldc + n0 + cc * 8;
      if (EPI == 2) {
        float a[8], xo[8], y[8];
        unpack8(cv, a);
        unpack8(*(const uint4*)dst, xo);
        const float* gr = gate + (size_t)modrow(m0 + row) * 6144 + n0 + cc * 8;
        float4 g0 = *(const float4*)gr, g1 = *(const float4*)(gr + 4);
        float gg[8] = {g0.x, g0.y, g0.z, g0.w, g1.x, g1.y, g1.z, g1.w};
#pragma unroll
        for (int j = 0; j < 8; ++j) y[j] = ALPHA * xo[j] + gg[j] * a[j];
        cv = pack8(y);
      }
      *(uint4*)dst = cv;
    }
    __syncthreads();
  }
}

template <bool FINAL>
DEV void ln_phase(const Params& p, int M, const float* __restrict__ g, const float* __restrict__ b,
                         const float* __restrict__ modl  , int shi, int sci) {
  u16* X = (u16*)(p.ws + OFF_X);
  u16* HM = (u16*)(p.ws + OFF_HY);
  const int lane = threadIdx.x & 63;
  const int gw = blockIdx.x * 4 + (threadIdx.x >> 6), nw = gridDim.x * 4;
  uint4 nx0 = make_uint4(0u, 0u, 0u, 0u), nx1 = nx0;
  if (gw < M) {
    nx0 = *(const uint4*)(X + (size_t)gw * 1024 + lane * 8);
    nx1 = *(const uint4*)(X + (size_t)gw * 1024 + 512 + lane * 8);
  }
  for (int row = gw; row < M; row += nw) {
    u16* xr = X + (size_t)row * 1024;
    float f[16];
    unpack8(nx0, f);
    unpack8(nx1, f + 8);
    if (row + nw < M) {
      nx0 = *(const uint4*)(xr + (size_t)nw * 1024 + lane * 8);
      nx1 = *(const uint4*)(xr + (size_t)nw * 1024 + 512 + lane * 8);
    }
    float s = 0.f, q = 0.f;
#pragma unroll
    for (int j = 0; j < 16; ++j) { s += f[j]; q += f[j] * f[j]; }
#pragma unroll
    for (int o = 32; o > 0; o >>= 1) { s += __shfl_xor(s, o, 64); q += __shfl_xor(q, o, 64); }
    const float mu = s * (1.f / 1024.f);
    const float rs = rsqrtf(fmaxf(q * (1.f / 1024.f) - mu * mu, 0.f) + 1e-5f);
#pragma unroll
    for (int j = 0; j < 16; ++j) f[j] -= mu;
#pragma unroll
    for (int hh = 0; hh < 2; ++hh) {
      const int c0 = hh * 512 + lane * 8;
      float y[8];
#pragma unroll
      for (int j = 0; j < 8; ++j) y[j] = f[hh * 8 + j] * rs * g[c0 + j] + b[c0 + j];
      if (FINAL) {
        float* o = p.out + (size_t)row * 1024 + c0;
        *(float4*)o = make_float4(y[0], y[1], y[2], y[3]);
        *(float4*)(o + 4) = make_float4(y[4], y[5], y[6], y[7]);
      } else {
        *(uint4*)(xr + c0) = pack8(y);
        const float* m = modl + (size_t)modrow(row) * 6144;
        float h[8];
#pragma unroll
        for (int j = 0; j < 8; ++j) h[j] = y[j] * (1.f + m[sci * 1024 + c0 + j]) + m[shi * 1024 + c0 + j];
        *(uint4*)(HM + (size_t)row * 1024 + c0) = pack8(h);
      }
    }
  }
}

DEV void hyprep_item(const Params& p, int it, char* smem) {
  u16* su = (u16*)smem;
  u16* sx = su + 64 * 66;
  const u16* P = (const u16*)(p.ws + OFF_BIG);
  const int tid = threadIdx.x;
  const int ct = it & 7, st = it >> 3;
  int b, t0, L, rowbase;
  u16 *U, *X0;
  if (st < 1024) { b = st >> 5; t0 = (st & 31) * 64; L = 2048; rowbase = b * 2048;
    U = (u16*)((char*)p.out + SO_U); X0 = (u16*)((char*)p.out + SO_X0); }
  else { int s2 = st - 1024; b = s2 >> 2; t0 = (s2 & 3) * 64; L = 256; rowbase = NLAT + b * 256;
    U = (u16*)((char*)p.out + SO_UC); X0 = (u16*)((char*)p.out + SO_X0C); }
  const int c0 = ct * 64;
  {
    const int t = tid >> 2, cq = tid & 3;
    float z[3][16];
#pragma unroll
    for (int g = 0; g < 3; ++g)
#pragma unroll
      for (int j = 0; j < 16; ++j) z[g][j] = 0.f;
#pragma unroll
    for (int tap = 0; tap < 3; ++tap) {
      const int tt = t0 + t + tap - 1;
      if (tt >= 0 && tt < L) {
#pragma unroll
        for (int g = 0; g < 3; ++g) {
          const int col = g * 512 + c0 + cq * 16;
          const u16* src = P + (size_t)(rowbase + tt) * PS0 + col;
          float f[16];
          unpack8(*(const uint4*)src, f);
          unpack8(*(const uint4*)(src + 8), f + 8);
          const float* w = p.hy_conv + tap * 1536 + col;
#pragma unroll
          for (int j = 0; j < 16; ++j) z[g][j] += f[j] * w[j];
        }
      }
    }
#pragma unroll
    for (int j = 0; j < 16; ++j) {
      su[t * 66 + cq * 16 + j] = f2bf(z[1][j] * z[2][j]);
      sx[t * 66 + cq * 16 + j] = f2bf(z[0][j]);
    }
  }
  __syncthreads();
  {
    const int c = tid >> 2, tq = tid & 3;
    unsigned wu[8], wx[8];
#pragma unroll
    for (int j = 0; j < 8; ++j) {
      wu[j] = (unsigned)su[(tq * 16 + 2 * j) * 66 + c] | ((unsigned)su[(tq * 16 + 2 * j + 1) * 66 + c] << 16);
      wx[j] = (unsigned)sx[(tq * 16 + 2 * j) * 66 + c] | ((unsigned)sx[(tq * 16 + 2 * j + 1) * 66 + c] << 16);
    }
    const size_t o = ((size_t)(c0 + c) * 32 + b) * L + t0 + tq * 16;
    *(uint4*)(U + o) = make_uint4(wu[0], wu[1], wu[2], wu[3]);
    *(uint4*)(U + o + 8) = make_uint4(wu[4], wu[5], wu[6], wu[7]);
    *(uint4*)(X0 + o) = make_uint4(wx[0], wx[1], wx[2], wx[3]);
    *(uint4*)(X0 + o + 8) = make_uint4(wx[4], wx[5], wx[6], wx[7]);
  }
  __syncthreads();
}

DEV void rope_item(const Params& p, int it) {
  u16* P = (u16*)(p.ws + OFF_BIG);
  const float2* tab = (const float2*)(p.ws + OFF_ROPE);
  const int task = it * 256 + threadIdx.x;
  const int row = task / 40, rem = task - row * 40;
  const int head = rem >> 2, pr = rem & 3;
  const int d0 = (pr >> 1) * 32 + (pr & 1) * 8;
  const int t = row & 2047;
  const int posc = (pr >> 1) ? (t & 63) : (t >> 6);
  const int fi0 = (pr & 1) * 8;
  u16* ptr = P + (size_t)row * PS0 + 1536 + head * 64 + d0;
  float u1[8], u2[8], o1[8], o2[8];
  unpack8(*(const uint4*)ptr, u1);
  unpack8(*(const uint4*)(ptr + 16), u2);
#pragma unroll
  for (int j = 0; j < 8; ++j) {
    float2 cs = tab[posc * 16 + fi0 + j];
    o1[j] = u1[j] * cs.x - u2[j] * cs.y;
    o2[j] = u1[j] * cs.y + u2[j] * cs.x;
  }
  *(uint4*)ptr = pack8(o1);
  *(uint4*)(ptr + 16) = pack8(o2);
}

DEV void phase_hyprep_rope(const Params& p, char* smem) {
  constexpr int NH = 9216, NR = 10240;
  for (int it = blockIdx.x; it < NH + NR; it += gridDim.x) {
    if (it < NH) hyprep_item(p, it, smem);
    else rope_item(p, it - NH);
  }
}

template <int L, int NT>
DEV void conv_item(const Params& p, int c, int th, char* smem) {
  const u16* R = (const u16*)(p.ws + (L == 2048 ? OFF_KR2048 : OFF_KR256)) + (size_t)c * 2 * L;
  const u16* U = (const u16*)((const char*)p.out + (L == 2048 ? SO_U : SO_UC));
  const u16* X0 = (const u16*)((const char*)p.out + (L == 2048 ? SO_X0 : SO_X0C));
  u16* Y = (u16*)(p.ws + OFF_HY);
  u16* Rs0 = (u16*)smem;
  u16* Rs1 = Rs0 + 2 * L + 8;
  const int tid = threadIdx.x, lane = tid & 63, wave = tid >> 6;
  for (int i = tid; i < 2 * L; i += 256) {
    Rs0[i] = R[i];
    Rs1[i] = (i + 1 < 2 * L) ? R[i + 1] : (u16)0;
  }
  __syncthreads();
  const int r = lane & 31, h = lane >> 5;
  const char* lanebase = (r & 1) ? (const char*)Rs1 + 2 * (8 * h - r + L - 1) : (const char*)Rs0 + 2 * (8 * h - r + L);
  const u16* Ub = U + ((size_t)c * 32 + r) * L + 8 * h;
  const int tw0 = th * 1024 + wave * NT * 32;
  f32x16 acc[NT];
#pragma unroll
  for (int i = 0; i < NT; ++i)
#pragma unroll
    for (int e = 0; e < 16; ++e) acc[i][e] = 0.f;
  uint4 nb = *(const uint4*)Ub;
  for (int st = 0; st < L / 16; ++st) {
    uint4 cur = nb;
    if (st + 1 < L / 16) nb = *(const uint4*)(Ub + (st + 1) * 16);
    bf16x8 bfrag = *(bf16x8*)&cur;
#pragma unroll
    for (int i = 0; i < NT; ++i) {
      const unsigned* ap = (const unsigned*)(lanebase + 2 * (st * 16 - (tw0 + i * 32)));
      uint4 av = make_uint4(ap[0], ap[1], ap[2], ap[3]);
      acc[i] = __builtin_amdgcn_mfma_f32_32x32x16_bf16(*(bf16x8*)&av, bfrag, acc[i], 0, 0, 0);
    }
  }
  const int rowbase = (L == 2048) ? r * 2048 : NLAT + r * 256;
#pragma unroll
  for (int i = 0; i < NT; ++i) {
#pragma unroll
    for (int g4 = 0; g4 < 4; ++g4) {
      const int tt = tw0 + i * 32 + 8 * g4 + 4 * h;
      uint2 xv = *(const uint2*)(X0 + ((size_t)c * 32 + r) * L + tt);
      float x0[4] = {bflo(xv.x), bfhi(xv.x), bflo(xv.y), bfhi(xv.y)};
#pragma unroll
      for (int e = 0; e < 4; ++e) Y[(size_t)(rowbase + tt + e) * 1024 + c] = f2bf(acc[i][g4 * 4 + e] * x0[e]);
    }
  }
  __syncthreads();
}

DEV void attn_item(const Params& p, int b, int hq, int qb, bool isctx, char* smem) {
  const u16* P = (const u16*)(p.ws + OFF_BIG);
  u16* Y = (u16*)(p.ws + OFF_HY);
  u16* Ks = (u16*)smem;
  u16* Vt = Ks + 64 * 72;
  const int tid = threadIdx.x, lane = tid & 63, wave = tid >> 6;
  const int nq = lane & 15, quad = lane >> 4;
  const int qrow = (isctx ? NLAT + b * 256 : b * 2048) + qb * 64 + wave * 16 + nq;
  const int qpos = qb * 64 + wave * 16 + nq;
  const int hkv = hq >> 2;
  const int kcol = 2048 + hkv * 64, vcol = 2176 + hkv * 64;
  bf16x8 qf[2];
#pragma unroll
  for (int ks = 0; ks < 2; ++ks)
    qf[ks] = *(const bf16x8*)(P + (size_t)qrow * PS0 + 1536 + hq * 64 + ks * 32 + quad * 8);
  float m = p.attn_sink[hq];
  float lsum = (quad == 0) ? 1.f : 0.f;
  f32x4 oacc[4];
#pragma unroll
  for (int n = 0; n < 4; ++n) oacc[n] = (f32x4){0.f, 0.f, 0.f, 0.f};
  const int nloc = isctx ? 0 : 5;
  for (int ti = 0; ti < nloc + 4; ++ti) {
    int krow0, k0 = 0;
    bool masked;
    if (ti < nloc) {
      k0 = qb * 64 - 128 + ti * 64;
      if (k0 < 0 || k0 >= 2048) continue;
      krow0 = b * 2048 + k0; masked = true;
    } else { krow0 = NLAT + b * 256 + (ti - nloc) * 64; masked = false; }
    __syncthreads();
    {
      const int key = tid >> 2, part = tid & 3;
      const u16* kp = P + (size_t)(krow0 + key) * PS0 + kcol + part * 16;
      const u16* vp = P + (size_t)(krow0 + key) * PS0 + vcol + part * 16;
      uint4 k0v = *(const uint4*)kp, k1v = *(const uint4*)(kp + 8);
      uint4 v0v = *(const uint4*)vp, v1v = *(const uint4*)(vp + 8);
      *(uint4*)(Ks + key * 72 + part * 16) = k0v;
      *(uint4*)(Ks + key * 72 + part * 16 + 8) = k1v;
      unsigned vw[8] = {v0v.x, v0v.y, v0v.z, v0v.w, v1v.x, v1v.y, v1v.z, v1v.w};
#pragma unroll
      for (int j = 0; j < 8; ++j) {
        Vt[(part * 16 + 2 * j) * 72 + key] = (u16)(vw[j] & 0xffffu);
        Vt[(part * 16 + 2 * j + 1) * 72 + key] = (u16)(vw[j] >> 16);
      }
    }
    __syncthreads();
    f32x4 s[4];
#pragma unroll
    for (int n = 0; n < 4; ++n) {
      s[n] = (f32x4){0.f, 0.f, 0.f, 0.f};
#pragma unroll
      for (int ks = 0; ks < 2; ++ks) {
        bf16x8 kf = *(const bf16x8*)(Ks + (n * 16 + nq) * 72 + ks * 32 + quad * 8);
        s[n] = __builtin_amdgcn_mfma_f32_16x16x32_bf16(kf, qf[ks], s[n], 0, 0, 0);
      }
    }
    float mx = -1e30f;
#pragma unroll
    for (int n = 0; n < 4; ++n)
#pragma unroll
      for (int e = 0; e < 4; ++e) {
        float v = s[n][e] * 0.125f;
        if (masked) {
          int kpos = k0 + n * 16 + quad * 4 + e;
          int d = qpos - kpos;
          if (d > 128 || d < -128) v = -1e30f;
        }
        s[n][e] = v;
        mx = fmaxf(mx, v);
      }
    mx = fmaxf(mx, __shfl_xor(mx, 16, 64));
    mx = fmaxf(mx, __shfl_xor(mx, 32, 64));
    const float mn = fmaxf(m, mx);
    const float al = __expf(m - mn);
    m = mn;
    float ps = 0.f;
#pragma unroll
    for (int n = 0; n < 4; ++n)
#pragma unroll
      for (int e = 0; e < 4; ++e) { float pv = __expf(s[n][e] - mn); s[n][e] = pv; ps += pv; }
    lsum = lsum * al + ps;
#pragma unroll
    for (int n = 0; n < 4; ++n)
#pragma unroll
      for (int e = 0; e < 4; ++e) oacc[n][e] *= al;
#pragma unroll
    for (int hh = 0; hh < 2; ++hh) {
      uint4 pw;
      pw.x = pack2(s[2 * hh][0], s[2 * hh][1]); pw.y = pack2(s[2 * hh][2], s[2 * hh][3]);
      pw.z = pack2(s[2 * hh + 1][0], s[2 * hh + 1][1]); pw.w = pack2(s[2 * hh + 1][2], s[2 * hh + 1][3]);
      bf16x8 pb = *(bf16x8*)&pw;
#pragma unroll
      for (int n = 0; n < 4; ++n) {
        const u16* vr = Vt + (n * 16 + nq) * 72 + quad * 4;
        uint2 va = *(const uint2*)(vr + (2 * hh) * 16);
        uint2 vb = *(const uint2*)(vr + (2 * hh + 1) * 16);
        uint4 vv = make_uint4(va.x, va.y, vb.x, vb.y);
        oacc[n] = __builtin_amdgcn_mfma_f32_16x16x32_bf16(*(bf16x8*)&vv, pb, oacc[n], 0, 0, 0);
      }
    }
  }
  lsum += __shfl_xor(lsum, 16, 64);
  lsum += __shfl_xor(lsum, 32, 64);
  const float inv = 1.f / lsum;
  u16* yo = Y + (size_t)qrow * 1024 + 512 + hq * 64 + quad * 4;
#pragma unroll
  for (int n = 0; n < 4; ++n) {
    uint2 w;
    w.x = pack2(oacc[n][0] * inv, oacc[n][1] * inv);
    w.y = pack2(oacc[n][2] * inv, oacc[n][3] * inv);
    *(uint2*)(yo + n * 16) = w;
  }
  __syncthreads();
}

DEV void phase_conv_attn(const Params& p, char* smem) {
  constexpr int N0 = 1024, N1 = N0 + 512, N2 = N1 + 8192, N3 = N2 + 1024;
  for (int it = blockIdx.x; it < N3; it += gridDim.x) {
    if (it < N0) conv_item<2048, 8>(p, it >> 1, it & 1, smem);
    else if (it < N1) conv_item<256, 2>(p, it - N0, 0, smem);
    else if (it < N2) { int a = it - N1; attn_item(p, a >> 8, (a >> 5) & 7, a & 31, false, smem); }
    else { int a = it - N2; attn_item(p, a >> 5, (a >> 2) & 7, a & 3, true, smem); }
  }
}

DEV void lds_wave_sync() {
  asm volatile("s_waitcnt lgkmcnt(0)" ::: "memory");
  __builtin_amdgcn_wave_barrier();
}

DEV void rwkv_item(const Params& p, int ri, char* smem) {
  const u16* P = (const u16*)(p.ws + OFF_BIG);
  u16* O4 = (u16*)p.out;
  float* BS = (float*)(p.ws + OFF_BSUM);
  const int tid0 = threadIdx.x;
  const int wp0 = tid0 >> 7;
  const int cid = ri * 2 + wp0;
  const int b = cid >> 4, d = (cid >> 3) & 1, h = cid & 7;
  f32x4 S[4][2];
#pragma unroll
  for (int i = 0; i < 4; ++i)
#pragma unroll
    for (int j = 0; j < 2; ++j) S[i][j] = (f32x4){0.f, 0.f, 0.f, 0.f};
  uint4 bw[2][4];
  float l0[4];
  {
    const int lane = tid0 & 63, wi = (tid0 >> 6) & 1, fr = lane & 15, fq = lane >> 4;
    const float* wsrc = (wi == 0 ? p.rw_w2 : p.rw_a2) + (size_t)d * 64 * 512 + h * 64;
    const float* bsrc = (wi == 0 ? p.rw_w0 : p.rw_a0) + d * 512 + h * 64;
#pragma unroll
    for (int nt = 0; nt < 4; ++nt) {
      l0[nt] = bsrc[nt * 16 + fr];
#pragma unroll
      for (int ks = 0; ks < 2; ++ks) {
        __builtin_amdgcn_sched_barrier(0);
        float f[8];
        const float* wp_ = wsrc + (size_t)(ks * 32 + fq * 8) * 512 + nt * 16 + fr;
#pragma unroll
        for (int j = 0; j < 8; ++j) f[j] = wp_[j * 512];
        bw[ks][nt] = pack8(f);
      }
    }
  }
  uint4 pre[5][3];
#define RW_LOAD(CI)                                                                                 \
  {                                                                                                 \
    const int seg_ = (CI) < 16 ? 0 : 1;                                                             \
    const int ch_ = seg_ ? (CI)-16 : (CI);                                                          \
    const int Ls_ = seg_ ? 2048 : 256;                                                              \
    const int rb_ = seg_ ? b * 2048 : NLAT + b * 256;                                               \
    const int sidx_ = ch_ * 16 + stt;                                                               \
    const int t_ = d == 0 ? sidx_ : Ls_ - 1 - sidx_;                                                \
    const u16* prow_ = P + (size_t)(rb_ + t_) * PS1 + spart * 8;                                    \
    _Pragma("unroll") for (int g = 0; g < 5; ++g) {                                                 \
      const int col_ = g < 3 ? g * 512 + h * 64 : (g == 3 ? 1536 + d * 64 : 1664 + d * 64);         \
      _Pragma("unroll") for (int tap = 0; tap < 3; ++tap) {                                         \
        const int tt_ = t_ + tap - 1;                                                               \
        if (tt_ >= 0 && tt_ < Ls_) pre[g][tap] = *(const uint4*)(prow_ + (ptrdiff_t)(tap - 1) * PS1 + col_); \
        else pre[g][tap] = make_uint4(0u, 0u, 0u, 0u);                                              \
      }                                                                                             \
    }                                                                                               \
  }
  {
    const int pt = tid0 & 127, stt = pt >> 3, spart = pt & 7;
    RW_LOAD(0)
  }
  for (int cidx = 0; cidx < 144; ++cidx) {
    asm volatile("" ::: "memory");
    int tid = tid0;
    asm volatile("" : "+v"(tid));
    const int lane = tid & 63, wave = tid >> 6, wp = wave >> 1, wi = wave & 1, pt = tid & 127;
    const int fr = lane & 15, fq = lane >> 4, stt = pt >> 3, spart = pt & 7;
    const int seg = cidx < 16 ? 0 : 1;
    const int ch = seg ? cidx - 16 : cidx;
    const int Ls = seg ? 2048 : 256;
    char* base = smem + wp * 32768;
    u16* RK = (u16*)base;
    u16* KD = RK + 1152;
    u16* KK = KD + 1152;
    u16* AB = KK + 1152;
    u16* VT = AB + 1152;
    float* LW = (float*)(base + 11264);
    u16* TW = (u16*)(base + 15360);
    u16* AD = TW + 1152;
    u16* BgCT = (u16*)(base + 19968);
    u16* KgCT = BgCT + 1024;
    float* gC = (float*)(base + 24064);
    float* Amat = (float*)(base + 24320) + wi * 256;
    u16* Tinv = (u16*)(base + 26368) + wi * 256;
    u16* BG = (u16*)(base + 27392);
    {
      const int o = stt * 72 + spart * 8;
#pragma unroll
      for (int g = 0; g < 5; ++g) {
        __builtin_amdgcn_sched_barrier(0);
        const int col = g < 3 ? g * 512 + h * 64 : (g == 3 ? 1536 + d * 64 : 1664 + d * 64);
        float pc[8], pp[8], pn[8], v[8];
        unpack8(pre[g][1], pc); unpack8(pre[g][0], pp); unpack8(pre[g][2], pn);
        const float* mu = p.rw_mu + col + spart * 8;
        float4 m0 = *(const float4*)mu, m1 = *(const float4*)(mu + 4);
        const float mm[8] = {m0.x, m0.y, m0.z, m0.w, m1.x, m1.y, m1.z, m1.w};
#pragma unroll
        for (int j = 0; j < 8; ++j) v[j] = pc[j] + mm[j] * (0.5f * (pp[j] + pn[j]) - pc[j]);
        if (g == 0) *(uint4*)(RK + o) = pack8(v);
        else if (g == 1) {
          *(uint4*)(KD + o) = pack8(v);
          const float* kkw = p.rw_kk + h * 64 + spart * 8;
          float kkv[8];
          float ss = 0.f;
#pragma unroll
          for (int j = 0; j < 8; ++j) { kkv[j] = v[j] * kkw[j]; ss += kkv[j] * kkv[j]; }
          ss += __shfl_xor(ss, 1, 64); ss += __shfl_xor(ss, 2, 64); ss += __shfl_xor(ss, 4, 64);
          const float inv = rsqrtf(ss + 1e-6f);
#pragma unroll
          for (int j = 0; j < 8; ++j) kkv[j] *= inv;
          *(uint4*)(KK + o) = pack8(kkv);
        } else if (g == 2) {
#pragma unroll
          for (int j = 0; j < 8; ++j) VT[(spart * 8 + j) * 16 + stt] = f2bf(v[j]);
        } else if (g == 3) {
#pragma unroll
          for (int j = 0; j < 8; ++j) v[j] = fast_tanh(v[j]);
          *(uint4*)(TW + o) = pack8(v);
        } else *(uint4*)(AD + o) = pack8(v);
      }
    }
    __syncthreads();
    if (cidx + 1 < 144) RW_LOAD(cidx + 1)
    {
      const u16* IN = wi == 0 ? TW : AD;
      bf16x8 af0 = *(const bf16x8*)(IN + fr * 72 + fq * 8);
      bf16x8 af1 = *(const bf16x8*)(IN + fr * 72 + 32 + fq * 8);
#pragma unroll
      for (int nt = 0; nt < 4; ++nt) {
        f32x4 o4 = (f32x4){0.f, 0.f, 0.f, 0.f};
        o4 = __builtin_amdgcn_mfma_f32_16x16x32_bf16(af0, *(bf16x8*)&bw[0][nt], o4, 0, 0, 0);
        o4 = __builtin_amdgcn_mfma_f32_16x16x32_bf16(af1, *(bf16x8*)&bw[1][nt], o4, 0, 0, 0);
#pragma unroll
        for (int e = 0; e < 4; ++e) {
          const float prev = l0[nt] + o4[e];
          const int t = fq * 4 + e, c = nt * 16 + fr;
          if (wi == 0) LW[t * 64 + c] = -__expf(-softplus(-prev) - 0.5f);
          else AB[t * 72 + c] = f2bf(sigm(prev));
        }
      }
    }
    __syncthreads();
    {
      const int c = lane;
      float cum = 0.f;
      if (wi == 0) {
#pragma unroll 4
        for (int t = 0; t < 16; ++t) {
          const float lw = LW[t * 64 + c];
          const float gp = __expf(cum);
          cum += lw;
          const float gi = __expf(-cum);
          const float kk = bf2f(KK[t * 72 + c]);
          const float a = bf2f(AB[t * 72 + c]);
          KK[t * 72 + c] = f2bf(kk * gp);
          BG[t * 72 + c] = f2bf(kk * a * gi);
        }
        const float gCv = __expf(cum);
        gC[c] = gCv;
#pragma unroll 4
        for (int t = 0; t < 16; ++t) BgCT[c * 16 + t] = f2bf(-bf2f(BG[t * 72 + c]) * gCv);
      } else {
        float* PR = (float*)TW;
        const float kac = p.rw_ka[h * 64 + c], rkc = p.rw_rk[h * 64 + c];
#pragma unroll 4
        for (int t = 0; t < 16; ++t) {
          const float lw = LW[t * 64 + c];
          cum += lw;
          const float g = __expf(cum), gi = __expf(-cum);
          const float r = bf2f(RK[t * 72 + c]);
          const float k = bf2f(KD[t * 72 + c]);
          const float a = bf2f(AB[t * 72 + c]);
          const float kd = k * (1.f + (a - 1.f) * kac);
          RK[t * 72 + c] = f2bf(r * g);
          KD[t * 72 + c] = f2bf(kd * gi);
          PR[t * 64 + c] = r * kd * rkc;
        }
        const float gCv = __expf(cum);
#pragma unroll 4
        for (int t = 0; t < 16; ++t) KgCT[c * 16 + t] = f2bf(bf2f(KD[t * 72 + c]) * gCv);
        lds_wave_sync();
        {
          const int t = lane >> 2, sg = lane & 3;
          const float4 q0 = *(const float4*)(PR + t * 64 + sg * 16), q1 = *(const float4*)(PR + t * 64 + sg * 16 + 4);
          const float4 q2 = *(const float4*)(PR + t * 64 + sg * 16 + 8), q3 = *(const float4*)(PR + t * 64 + sg * 16 + 12);
          float bsum = (q0.x + q0.y + q0.z + q0.w) + (q1.x + q1.y + q1.z + q1.w) + (q2.x + q2.y + q2.z + q2.w) + (q3.x + q3.y + q3.z + q3.w);
          bsum += __shfl_xor(bsum, 1, 64);
          bsum += __shfl_xor(bsum, 2, 64);
          if (seg == 1 && sg == 0) {
            const int sidx = ch * 16 + t;
            const int tpos = d == 0 ? sidx : 2047 - sidx;
            BS[(size_t)(b * 2048 + tpos) * 16 + h * 2 + d] = bsum;
          }
        }
      }
    }
    __syncthreads();
    __builtin_amdgcn_sched_barrier(0);
    {
      f32x4 XabT = (f32x4){0.f, 0.f, 0.f, 0.f}, XakT = XabT, XrbT = XabT, XrkT = XabT;
#pragma unroll
      for (int ks = 0; ks < 2; ++ks) {
        bf16x8 kkf = *(const bf16x8*)(KK + fr * 72 + ks * 32 + fq * 8);
        bf16x8 rgf = *(const bf16x8*)(RK + fr * 72 + ks * 32 + fq * 8);
        bf16x8 bgf = *(const bf16x8*)(BG + fr * 72 + ks * 32 + fq * 8);
        bf16x8 kgf = *(const bf16x8*)(KD + fr * 72 + ks * 32 + fq * 8);
        XabT = __builtin_amdgcn_mfma_f32_16x16x32_bf16(bgf, kkf, XabT, 0, 0, 0);
        XakT = __builtin_amdgcn_mfma_f32_16x16x32_bf16(kgf, kkf, XakT, 0, 0, 0);
        XrbT = __builtin_amdgcn_mfma_f32_16x16x32_bf16(bgf, rgf, XrbT, 0, 0, 0);
        XrkT = __builtin_amdgcn_mfma_f32_16x16x32_bf16(kgf, rgf, XrkT, 0, 0, 0);
      }
      {
        float am[4];
#pragma unroll
        for (int e = 0; e < 4; ++e) am[e] = (fq * 4 + e < fr) ? XabT[e] : 0.f;
        *(float4*)(Amat + fr * 16 + fq * 4) = make_float4(am[0], am[1], am[2], am[3]);
      }
      lds_wave_sync();
      if (lane < 16) {
        float x[16];
        x[0] = (lane == 0) ? 1.f : 0.f;
        float4 cur[4], nxt[4];
        cur[0] = *(const float4*)(Amat + 16);
        cur[1] = cur[0]; cur[2] = cur[0]; cur[3] = cur[0];
#pragma unroll
        for (int i = 1; i < 16; ++i) {
          __builtin_amdgcn_sched_barrier(0);
          if (i + 1 < 16) {
#pragma unroll
            for (int q = 0; q < (i + 4) / 4; ++q) nxt[q] = *(const float4*)(Amat + (i + 1) * 16 + q * 4);
          }
          float acc = (i == lane) ? 1.f : 0.f;
#pragma unroll
          for (int j = 0; j < i; ++j) {
            const float4 rv = cur[j >> 2];
            const float av = (j & 3) == 0 ? rv.x : ((j & 3) == 1 ? rv.y : ((j & 3) == 2 ? rv.z : rv.w));
            acc -= av * x[j];
          }
          x[i] = acc;
#pragma unroll
          for (int q = 0; q < 4; ++q) cur[q] = nxt[q];
        }
#pragma unroll
        for (int i = 0; i < 16; ++i) Tinv[i * 16 + lane] = f2bf(x[i]);
      }
      lds_wave_sync();
      f32x4 sa0[2], y0[2];
#pragma unroll
      for (int nt = 0; nt < 2; ++nt) { sa0[nt] = (f32x4){0.f, 0.f, 0.f, 0.f}; y0[nt] = (f32x4){0.f, 0.f, 0.f, 0.f}; }
#pragma unroll
      for (int x = 0; x < 2; ++x) {
        __builtin_amdgcn_sched_barrier(0);
        uint2 k0 = *(const uint2*)(KK + fr * 72 + 32 * x + fq * 4);
        uint2 k1 = *(const uint2*)(KK + fr * 72 + 32 * x + 16 + fq * 4);
        uint2 r0 = *(const uint2*)(RK + fr * 72 + 32 * x + fq * 4);
        uint2 r1 = *(const uint2*)(RK + fr * 72 + 32 * x + 16 + fq * 4);
        uint4 kw = make_uint4(k0.x, k0.y, k1.x, k1.y);
        uint4 rw = make_uint4(r0.x, r0.y, r1.x, r1.y);
#pragma unroll
        for (int nt = 0; nt < 2; ++nt) {
          uint4 sw;
          sw.x = pack2(S[2 * x][nt][0], S[2 * x][nt][1]); sw.y = pack2(S[2 * x][nt][2], S[2 * x][nt][3]);
          sw.z = pack2(S[2 * x + 1][nt][0], S[2 * x + 1][nt][1]); sw.w = pack2(S[2 * x + 1][nt][2], S[2 * x + 1][nt][3]);
          sa0[nt] = __builtin_amdgcn_mfma_f32_16x16x32_bf16(*(bf16x8*)&kw, *(bf16x8*)&sw, sa0[nt], 0, 0, 0);
          y0[nt] = __builtin_amdgcn_mfma_f32_16x16x32_bf16(*(bf16x8*)&rw, *(bf16x8*)&sw, y0[nt], 0, 0, 0);
        }
      }
      float ak[4], rb[4], rk[4];
#pragma unroll
      for (int e = 0; e < 4; ++e) {
        const int j = fq * 4 + e;
        ak[e] = (j < fr) ? XakT[e] : 0.f;
        rb[e] = (j <= fr) ? -XrbT[e] : 0.f;
        rk[e] = (j <= fr) ? XrkT[e] : 0.f;
      }
      const uint4 akw = make_uint4(pack2(ak[0], ak[1]), pack2(ak[2], ak[3]), 0u, 0u);
      const uint4 ybw = make_uint4(pack2(rb[0], rb[1]), pack2(rb[2], rb[3]), pack2(rk[0], rk[1]), pack2(rk[2], rk[3]));
      const uint2 tv = *(const uint2*)(Tinv + fr * 16 + fq * 4);
      const uint4 tw = make_uint4(tv.x, tv.y, 0u, 0u);
      uint4 sv[2];
#pragma unroll
      for (int nt = 0; nt < 2; ++nt) {
        const int vc = wi * 32 + nt * 16 + fr;
        const uint2 vt = *(const uint2*)(VT + vc * 16 + fq * 4);
        const uint4 vb = make_uint4(vt.x, vt.y, 0u, 0u);
        f32x4 rhs = __builtin_amdgcn_mfma_f32_16x16x32_bf16(*(bf16x8*)&akw, *(bf16x8*)&vb, sa0[nt], 0, 0, 0);
        const uint4 rw = make_uint4(pack2(rhs[0], rhs[1]), pack2(rhs[2], rhs[3]), 0u, 0u);
        f32x4 sa = __builtin_amdgcn_mfma_f32_16x16x32_bf16(*(bf16x8*)&tw, *(bf16x8*)&rw, (f32x4){0.f, 0.f, 0.f, 0.f}, 0, 0, 0);
        sv[nt] = make_uint4(pack2(sa[0], sa[1]), pack2(sa[2], sa[3]), vt.x, vt.y);
        f32x4 y = __builtin_amdgcn_mfma_f32_16x16x32_bf16(*(bf16x8*)&ybw, *(bf16x8*)&sv[nt], y0[nt], 0, 0, 0);
        if (seg == 1) {
#pragma unroll
          for (int e = 0; e < 4; ++e) {
            const int sidx = ch * 16 + fq * 4 + e;
            const int tpos = d == 0 ? sidx : 2047 - sidx;
            O4[((size_t)d * NLAT + b * 2048 + tpos) * 512 + h * 64 + vc] = f2bf(y[e]);
          }
        }
      }
#pragma unroll
      for (int mt = 0; mt < 4; ++mt) {
        __builtin_amdgcn_sched_barrier(0);
        const float4 g4 = *(const float4*)(gC + mt * 16 + fq * 4);
        const uint2 bv = *(const uint2*)(BgCT + (mt * 16 + fr) * 16 + fq * 4);
        const uint2 kv = *(const uint2*)(KgCT + (mt * 16 + fr) * 16 + fq * 4);
        const uint4 aw = make_uint4(bv.x, bv.y, kv.x, kv.y);
#pragma unroll
        for (int nt = 0; nt < 2; ++nt) {
          S[mt][nt][0] *= g4.x; S[mt][nt][1] *= g4.y; S[mt][nt][2] *= g4.z; S[mt][nt][3] *= g4.w;
          S[mt][nt] = __builtin_amdgcn_mfma_f32_16x16x32_bf16(*(bf16x8*)&aw, *(bf16x8*)&sv[nt], S[mt][nt], 0, 0, 0);
        }
      }
    }
    __syncthreads();
  }
#undef RW_LOAD
}

DEV void gdn_item(const Params& p, int gi, char* smem) {
  const u16* P = (const u16*)(p.ws + OFF_BIG);
  u16* O4 = (u16*)p.out;
  const int tid0 = threadIdx.x;
  const int b = gi >> 3, d = (gi >> 2) & 1, h = gi & 3;
  constexpr int BUFB = 23424;
  f32x4 S[8][2];
#pragma unroll
  for (int i = 0; i < 8; ++i)
#pragma unroll
    for (int j = 0; j < 2; ++j) S[i][j] = (f32x4){0.f, 0.f, 0.f, 0.f};
  const float negA = -__expf(p.dn_A_log[d * 4 + h]);
  const float dtb = p.dn_dt_bias[d * 4 + h];
  uint4 pre[3][3];
  float gpre0 = 0.f, gpre1 = 0.f;
#define GDN_LOAD(CI)                                                                               \
  {                                                                                                \
    const int seg_ = (CI) < 16 ? 0 : 1;                                                            \
    const int ch_ = seg_ ? (CI)-16 : (CI);                                                         \
    const int Ls_ = seg_ ? 2048 : 256;                                                             \
    const int rb_ = seg_ ? b * 2048 : NLAT + b * 256;                                              \
    const int sidx_ = ch_ * 16 + stt;                                                              \
    const int t_ = d == 0 ? sidx_ : Ls_ - 1 - sidx_;                                               \
    const u16* prow_ = P + (size_t)(rb_ + t_) * PS1 + DNO;                                         \
    _Pragma("unroll") for (int g = 0; g < 3; ++g) {                                                \
      const int col_ = g * 512 + h * 128 + spart * 8;                                              \
      _Pragma("unroll") for (int tap = 0; tap < 3; ++tap) {                                        \
        const int tt_ = t_ + tap - 1;                                                              \
        if (tt_ >= 0 && tt_ < Ls_) pre[g][tap] = *(const uint4*)(prow_ + (ptrdiff_t)(tap - 1) * PS1 + col_); \
        else pre[g][tap] = make_uint4(0u, 0u, 0u, 0u);                                             \
      }                                                                                            \
    }                                                                                              \
    if (wave == 0) {                                                                               \
      const int s2_ = ch_ * 16 + fr;                                                               \
      const int t2_ = d == 0 ? s2_ : Ls_ - 1 - s2_;                                                \
      const u16* gr_ = P + (size_t)(rb_ + t2_) * PS1 + DNO + 2048;                                 \
      gpre0 = bf2f(gr_[d * 4 + h]);                                                                \
      gpre1 = bf2f(gr_[8 + d * 4 + h]);                                                            \
    }                                                                                              \
  }
  {
    const int tid = tid0, lane = tid & 63, wave = tid >> 6, fr = lane & 15, stt = tid >> 4, spart = tid & 15;
    GDN_LOAD(0)
  }
  for (int cidx = 0; cidx < 144; ++cidx) {
    asm volatile("" ::: "memory");
    int tid = tid0;
    asm volatile("" : "+v"(tid));
    const int lane = tid & 63, wave = tid >> 6, fr = lane & 15, fq = lane >> 4, stt = tid >> 4, spart = tid & 15;
    char* buf = smem;
    u16* Kb = (u16*)buf;
    u16* Qb = Kb + 16 * 136;
    float* Vf = (float*)(buf + 8704);
    u16* KdT = (u16*)(buf + 17152);
    u16* Tinv = (u16*)(buf + 21248);
    u16* Pm = (u16*)(buf + 21760);
    float* Amat = (float*)(buf + 22272);
    float* Gs = (float*)(buf + 23296);
    float* Bs = Gs + 16;
#pragma unroll
    for (int g = 0; g < 3; ++g) {
      __builtin_amdgcn_sched_barrier(0);
      const int col = g * 512 + h * 128 + spart * 8;
      float z[8];
#pragma unroll
      for (int j = 0; j < 8; ++j) z[j] = 0.f;
#pragma unroll
      for (int tap = 0; tap < 3; ++tap) {
        __builtin_amdgcn_sched_barrier(0);
        float f[8];
        unpack8(pre[g][tap], f);
        const float* w = p.dn_conv + tap * 1536 + col;
        float4 w0 = *(const float4*)w, w1 = *(const float4*)(w + 4);
        z[0] += f[0] * w0.x; z[1] += f[1] * w0.y; z[2] += f[2] * w0.z; z[3] += f[3] * w0.w;
        z[4] += f[4] * w1.x; z[5] += f[5] * w1.y; z[6] += f[6] * w1.z; z[7] += f[7] * w1.w;
      }
      float ss = 0.f;
#pragma unroll
      for (int j = 0; j < 8; ++j) { z[j] = silu(z[j]); ss += z[j] * z[j]; }
      if (g < 2) {
        ss += __shfl_xor(ss, 1, 64); ss += __shfl_xor(ss, 2, 64); ss += __shfl_xor(ss, 4, 64); ss += __shfl_xor(ss, 8, 64);
        float sc = rsqrtf(ss + 1e-6f);
        if (g == 0) sc *= 0.08838834764831845f;
#pragma unroll
        for (int j = 0; j < 8; ++j) z[j] *= sc;
        *(uint4*)((g == 0 ? Qb : Kb) + stt * 136 + spart * 8) = pack8(z);
      } else {
        float* dst = Vf + stt * 132 + spart * 8;
        *(float4*)dst = make_float4(z[0], z[1], z[2], z[3]);
        *(float4*)(dst + 4) = make_float4(z[4], z[5], z[6], z[7]);
      }
    }
    if (wave == 0) {
      float g = negA * softplus(gpre0 + dtb);
#pragma unroll
      for (int o = 1; o < 16; o <<= 1) { float n = __shfl_up(g, o, 16); if (fr >= o) g += n; }
      if (lane < 16) { Gs[lane] = g; Bs[lane] = sigm(gpre1); }
    }
    __syncthreads();
    if (wave == 0) {
      f32x4 kk = (f32x4){0.f, 0.f, 0.f, 0.f};
#pragma unroll
      for (int ks = 0; ks < 4; ++ks) {
        bf16x8 kf = *(const bf16x8*)(Kb + fr * 136 + ks * 32 + fq * 8);
        kk = __builtin_amdgcn_mfma_f32_16x16x32_bf16(kf, kf, kk, 0, 0, 0);
      }
      const float Gj = Gs[fr];
#pragma unroll
      for (int e = 0; e < 4; ++e) {
        const int i = fq * 4 + e;
        const float a = (fr < i) ? Bs[i] * kk[e] * __expf(Gs[i] - Gj) : 0.f;
        Amat[i * 16 + fr] = a;
      }
      lds_wave_sync();
      if (lane < 16) {
        float x[16];
        x[0] = (lane == 0) ? 1.f : 0.f;
        float4 cur[4], nxt[4];
        cur[0] = *(const float4*)(Amat + 16);
        cur[1] = cur[0]; cur[2] = cur[0]; cur[3] = cur[0];
#pragma unroll
        for (int i = 1; i < 16; ++i) {
          __builtin_amdgcn_sched_barrier(0);
          if (i + 1 < 16) {
#pragma unroll
            for (int q = 0; q < (i + 4) / 4; ++q) nxt[q] = *(const float4*)(Amat + (i + 1) * 16 + q * 4);
          }
          float acc = (i == lane) ? 1.f : 0.f;
#pragma unroll
          for (int j = 0; j < i; ++j) {
            const float4 rv = cur[j >> 2];
            const float av = (j & 3) == 0 ? rv.x : ((j & 3) == 1 ? rv.y : ((j & 3) == 2 ? rv.z : rv.w));
            acc -= av * x[j];
          }
          x[i] = acc;
#pragma unroll
          for (int q = 0; q < 4; ++q) cur[q] = nxt[q];
        }
#pragma unroll
        for (int i = 0; i < 16; ++i) Tinv[i * 16 + lane] = f2bf(x[i]);
      }
    } else if (wave == 1) {
      f32x4 qk = (f32x4){0.f, 0.f, 0.f, 0.f};
#pragma unroll
      for (int ks = 0; ks < 4; ++ks) {
        bf16x8 qf = *(const bf16x8*)(Qb + fr * 136 + ks * 32 + fq * 8);
        bf16x8 kf = *(const bf16x8*)(Kb + fr * 136 + ks * 32 + fq * 8);
        qk = __builtin_amdgcn_mfma_f32_16x16x32_bf16(qf, kf, qk, 0, 0, 0);
      }
      const float Gj = Gs[fr];
#pragma unroll
      for (int e = 0; e < 4; ++e) {
        const int t = fq * 4 + e;
        const float v = (fr <= t) ? qk[e] * __expf(Gs[t] - Gj) : 0.f;
        Pm[t * 16 + fr] = f2bf(v);
      }
    } else {
      const int k = tid - 128;
      const float GC = Gs[15];
      unsigned w[8];
#pragma unroll
      for (int j = 0; j < 8; ++j) {
        __builtin_amdgcn_sched_barrier(0);
        float v0 = bf2f(Kb[(2 * j) * 136 + k]) * __expf(GC - Gs[2 * j]);
        float v1 = bf2f(Kb[(2 * j + 1) * 136 + k]) * __expf(GC - Gs[2 * j + 1]);
        w[j] = pack2(v0, v1);
      }
      *(uint4*)(KdT + k * 16) = make_uint4(w[0], w[1], w[2], w[3]);
      *(uint4*)(KdT + k * 16 + 8) = make_uint4(w[4], w[5], w[6], w[7]);
    }
    __builtin_amdgcn_sched_barrier(0);
    f32x4 ksv[2], qsv[2];
#pragma unroll
    for (int nt = 0; nt < 2; ++nt) { ksv[nt] = (f32x4){0.f, 0.f, 0.f, 0.f}; qsv[nt] = (f32x4){0.f, 0.f, 0.f, 0.f}; }
#pragma unroll
    for (int x = 0; x < 4; ++x) {
      __builtin_amdgcn_sched_barrier(0);
      uint2 k0 = *(const uint2*)(Kb + fr * 136 + 32 * x + fq * 4);
      uint2 k1 = *(const uint2*)(Kb + fr * 136 + 32 * x + 16 + fq * 4);
      uint2 q0 = *(const uint2*)(Qb + fr * 136 + 32 * x + fq * 4);
      uint2 q1 = *(const uint2*)(Qb + fr * 136 + 32 * x + 16 + fq * 4);
      uint4 kw = make_uint4(k0.x, k0.y, k1.x, k1.y);
      uint4 qw = make_uint4(q0.x, q0.y, q1.x, q1.y);
#pragma unroll
      for (int nt = 0; nt < 2; ++nt) {
        uint4 sw;
        sw.x = pack2(S[2 * x][nt][0], S[2 * x][nt][1]); sw.y = pack2(S[2 * x][nt][2], S[2 * x][nt][3]);
        sw.z = pack2(S[2 * x + 1][nt][0], S[2 * x + 1][nt][1]); sw.w = pack2(S[2 * x + 1][nt][2], S[2 * x + 1][nt][3]);
        ksv[nt] = __builtin_amdgcn_mfma_f32_16x16x32_bf16(*(bf16x8*)&kw, *(bf16x8*)&sw, ksv[nt], 0, 0, 0);
        qsv[nt] = __builtin_amdgcn_mfma_f32_16x16x32_bf16(*(bf16x8*)&qw, *(bf16x8*)&sw, qsv[nt], 0, 0, 0);
      }
    }
    __syncthreads();
    if (cidx + 1 < 144) GDN_LOAD(cidx + 1)
    __builtin_amdgcn_sched_barrier(0);
    {
      const int seg = cidx < 16 ? 0 : 1;
      const int ch = seg ? cidx - 16 : cidx;
      float eG[4], bt[4];
#pragma unroll
      for (int e = 0; e < 4; ++e) { eG[e] = __expf(Gs[fq * 4 + e]); bt[e] = Bs[fq * 4 + e]; }
      const float eGC = __expf(Gs[15]);
      uint2 tv = *(const uint2*)(Tinv + fr * 16 + fq * 4);
      uint2 pv = *(const uint2*)(Pm + fr * 16 + fq * 4);
      uint4 tw = make_uint4(tv.x, tv.y, 0u, 0u);
      uint4 pw = make_uint4(pv.x, pv.y, 0u, 0u);
      uint4 ub[2];
#pragma unroll
      for (int nt = 0; nt < 2; ++nt) {
        const int vc = wave * 32 + nt * 16 + fr;
        float rhs[4];
#pragma unroll
        for (int e = 0; e < 4; ++e) rhs[e] = bt[e] * (Vf[(fq * 4 + e) * 132 + vc] - eG[e] * ksv[nt][e]);
        uint4 rw = make_uint4(pack2(rhs[0], rhs[1]), pack2(rhs[2], rhs[3]), 0u, 0u);
        f32x4 u = __builtin_amdgcn_mfma_f32_16x16x32_bf16(*(bf16x8*)&tw, *(bf16x8*)&rw, (f32x4){0.f, 0.f, 0.f, 0.f}, 0, 0, 0);
        ub[nt] = make_uint4(pack2(u[0], u[1]), pack2(u[2], u[3]), 0u, 0u);
        f32x4 oa;
#pragma unroll
        for (int e = 0; e < 4; ++e) oa[e] = eG[e] * qsv[nt][e];
        oa = __builtin_amdgcn_mfma_f32_16x16x32_bf16(*(bf16x8*)&pw, *(bf16x8*)&ub[nt], oa, 0, 0, 0);
        if (seg == 1) {
#pragma unroll
          for (int e = 0; e < 4; ++e) {
            const int sidx = ch * 16 + fq * 4 + e;
            const int t = d == 0 ? sidx : 2047 - sidx;
            O4[((size_t)(2 + d) * NLAT + b * 2048 + t) * 512 + h * 128 + vc] = f2bf(oa[e]);
          }
        }
      }
#pragma unroll
      for (int mt = 0; mt < 8; ++mt) {
        __builtin_amdgcn_sched_barrier(0);
        uint2 kv = *(const uint2*)(KdT + (mt * 16 + fr) * 16 + fq * 4);
        uint4 kw = make_uint4(kv.x, kv.y, 0u, 0u);
#pragma unroll
        for (int nt = 0; nt < 2; ++nt) {
#pragma unroll
          for (int e = 0; e < 4; ++e) S[mt][nt][e] *= eGC;
          S[mt][nt] = __builtin_amdgcn_mfma_f32_16x16x32_bf16(*(bf16x8*)&kw, *(bf16x8*)&ub[nt], S[mt][nt], 0, 0, 0);
        }
      }
    }
    __syncthreads();
  }
#undef GDN_LOAD
}

DEV void phase_scans(const Params& p, char* smem) {
#pragma unroll 1
  for (int it = blockIdx.x; it < 512; it += gridDim.x)
    if (it & 1) rwkv_item(p, it >> 1, smem);
  __builtin_amdgcn_sched_barrier(0);
#pragma unroll 1
  for (int it = blockIdx.x; it < 512; it += gridDim.x)
    if (!(it & 1)) gdn_item(p, it >> 1, smem);
}

DEV void mixout_item(const Params& p, int it, char* smem) {
  const u16* P = (const u16*)(p.ws + OFF_BIG);
  const u16* O4 = (const u16*)p.out;
  const float* BS = (const float*)(p.ws + OFF_BSUM);
  const u16* G2T = (const u16*)(p.ws + OFF_G2T);
  u16* Y = (u16*)(p.ws + OFF_HY);
  u16* sg = (u16*)smem;
  u16* G = sg + 32 * 136;
  const int tid = threadIdx.x, lane = tid & 63, wave = tid >> 6;
  const int fr = lane & 15, fq = lane >> 4;
  const int tok0 = it * 32, tl0 = tok0 & 2047;
  const int tk = tid >> 3, part = tid & 7;
  const int row = tok0 + tk, t = tl0 + tk;
  const bool hasp = t > 0, hasn = t + 1 < 2048;
  const u16* prow = P + (size_t)row * PS1;
  {
#pragma unroll
    for (int q = 0; q < 2; ++q) {
      const int col = 1792 + part * 16 + q * 8;
      float pc[8], pp[8], pn[8], v[8];
      unpack8(*(const uint4*)(prow + col), pc);
      if (hasp) unpack8(*(const uint4*)(prow - PS1 + col), pp);
      else {
#pragma unroll
        for (int j = 0; j < 8; ++j) pp[j] = 0.f;
      }
      if (hasn) unpack8(*(const uint4*)(prow + PS1 + col), pn);
      else {
#pragma unroll
        for (int j = 0; j < 8; ++j) pn[j] = 0.f;
      }
      const float* mu = p.rw_mu + col;
#pragma unroll
      for (int j = 0; j < 8; ++j) v[j] = sigm(pc[j] + mu[j] * (0.5f * (pp[j] + pn[j]) - pc[j]));
      *(uint4*)(sg + tk * 136 + part * 16 + q * 8) = pack8(v);
    }
  }
  __syncthreads();
  {
    bf16x8 af[2][4];
#pragma unroll
    for (int mt = 0; mt < 2; ++mt)
#pragma unroll
      for (int ks = 0; ks < 4; ++ks) af[mt][ks] = *(const bf16x8*)(sg + (mt * 16 + fr) * 136 + ks * 32 + fq * 8);
#pragma unroll
    for (int nt = 0; nt < 8; ++nt) {
      const u16* bp = G2T + (size_t)(wave * 128 + nt * 16 + fr) * 128 + fq * 8;
      bf16x8 bf0 = *(const bf16x8*)(bp), bf1 = *(const bf16x8*)(bp + 32), bf2 = *(const bf16x8*)(bp + 64), bf3 = *(const bf16x8*)(bp + 96);
#pragma unroll
      for (int mt = 0; mt < 2; ++mt) {
        f32x4 a = (f32x4){0.f, 0.f, 0.f, 0.f};
        a = __builtin_amdgcn_mfma_f32_16x16x32_bf16(af[mt][0], bf0, a, 0, 0, 0);
        a = __builtin_amdgcn_mfma_f32_16x16x32_bf16(af[mt][1], bf1, a, 0, 0, 0);
        a = __builtin_amdgcn_mfma_f32_16x16x32_bf16(af[mt][2], bf2, a, 0, 0, 0);
        a = __builtin_amdgcn_mfma_f32_16x16x32_bf16(af[mt][3], bf3, a, 0, 0, 0);
#pragma unroll
        for (int e = 0; e < 4; ++e) G[(mt * 16 + fq * 4 + e) * 520 + wave * 128 + nt * 16 + fr] = f2bf(a[e]);
      }
    }
  }
  __syncthreads();
  {
    const int hd = part, c0 = hd * 64;
    const u16* of = O4 + (size_t)row * 512 + c0;
    const u16* ob = O4 + ((size_t)NLAT + row) * 512 + c0;
    const float bsum = BS[(size_t)row * 16 + hd * 2] + BS[(size_t)row * 16 + hd * 2 + 1];
    float s1 = 0.f, s2 = 0.f;
#pragma unroll
    for (int q = 0; q < 8; ++q) {
      float a[8], b8[8];
      unpack8(*(const uint4*)(of + q * 8), a);
      unpack8(*(const uint4*)(ob + q * 8), b8);
#pragma unroll
      for (int j = 0; j < 8; ++j) { const float v = a[j] + b8[j]; s1 += v; s2 += v * v; }
    }
    const float mean = s1 * (1.f / 64.f);
    const float var = fmaxf(s2 * (1.f / 64.f) - mean * mean, 0.f);
    const float rs = rsqrtf(var + 64e-5f);
#pragma unroll
    for (int q = 0; q < 8; ++q) {
      const int c = c0 + q * 8;
      float pc[8], pp[8], pn[8], gv[8], o[8], ya[8], yb[8];
      unpack8(*(const uint4*)(of + q * 8), ya);
      unpack8(*(const uint4*)(ob + q * 8), yb);
      unpack8(*(const uint4*)(prow + 1024 + c), pc);
      if (hasp) unpack8(*(const uint4*)(prow - PS1 + 1024 + c), pp);
      else {
#pragma unroll
        for (int j = 0; j < 8; ++j) pp[j] = 0.f;
      }
      if (hasn) unpack8(*(const uint4*)(prow + PS1 + 1024 + c), pn);
      else {
#pragma unroll
        for (int j = 0; j < 8; ++j) pn[j] = 0.f;
      }
      unpack8(*(const uint4*)(G + tk * 520 + c), gv);
      const float* mu = p.rw_mu + 1024 + c;
      const float* gg = p.rw_lnx_g + c;
      const float* gb = p.rw_lnx_b + c;
#pragma unroll
      for (int j = 0; j < 8; ++j) {
        const float vsh = pc[j] + mu[j] * (0.5f * (pp[j] + pn[j]) - pc[j]);
        const float yn = (ya[j] + yb[j] - mean) * rs * gg[j] + gb[j];
        o[j] = (yn + bsum * vsh) * gv[j];
      }
      *(uint4*)(Y + (size_t)row * 1024 + c) = pack8(o);
    }
  }
  {
    const int c0 = part * 64;
    const u16* of = O4 + ((size_t)2 * NLAT + row) * 512 + c0;
    const u16* ob = O4 + ((size_t)3 * NLAT + row) * 512 + c0;
    float s2 = 0.f;
#pragma unroll
    for (int q = 0; q < 8; ++q) {
      float a[8], b8[8];
      unpack8(*(const uint4*)(of + q * 8), a);
      unpack8(*(const uint4*)(ob + q * 8), b8);
#pragma unroll
      for (int j = 0; j < 8; ++j) { const float v = a[j] + b8[j]; s2 += v * v; }
    }
    s2 += __shfl_xor(s2, 1, 64);
    const float rs = rsqrtf(s2 * (1.f / 128.f) + 1e-6f);
    const u16* zr = prow + DNO + 1536 + c0;
    const float* ng = p.dn_norm_g + (part & 1) * 64;
#pragma unroll
    for (int q = 0; q < 8; ++q) {
      float z[8], r8[8], a[8], b8[8];
      unpack8(*(const uint4*)(of + q * 8), a);
      unpack8(*(const uint4*)(ob + q * 8), b8);
      unpack8(*(const uint4*)(zr + q * 8), z);
#pragma unroll
      for (int j = 0; j < 8; ++j) r8[j] = (a[j] + b8[j]) * rs * ng[q * 8 + j] * silu(z[j]);
      *(uint4*)(Y + (size_t)row * 1024 + 512 + c0 + q * 8) = pack8(r8);
    }
  }
  __syncthreads();
}

#define XB_TMO      128
#define XB_XCNT(j)  (256  + 64 * (j))
#define XB_XSUB(j)  (1280 + 64 * (j))
#define XB_XGEN(j)  (2304 + 64 * (j))
#define XB_TOP      3328
#define XB_TOPGEN   3392
#define XCD_BAR_WORDS 3456
#define XB_SPIN_CAP (1u << 20)
DEV unsigned xb_ld(unsigned* p) { return __hip_atomic_load(p, __ATOMIC_RELAXED, __HIP_MEMORY_SCOPE_AGENT); }
DEV unsigned xb_add(unsigned* p, unsigned v) { return __hip_atomic_fetch_add(p, v, __ATOMIC_RELAXED, __HIP_MEMORY_SCOPE_AGENT); }
DEV unsigned xb_xcc_id() { return (unsigned)__builtin_amdgcn_s_getreg((3 << 11) | 20) & 0xFu; }
#define XB_SPIN(cond, bar) do { unsigned _sp = 0; while (cond) { __builtin_amdgcn_s_sleep(1); \
    if ((++_sp & 255u) == 0u) { if (xb_ld(&(bar)[XB_TMO])) break; if (_sp > XB_SPIN_CAP) { atomicAdd(&(bar)[XB_TMO], 1u); break; } } } } while (0)
DEV void xcd_barrier_complete(unsigned* bar, unsigned x, unsigned& nloc, unsigned& nx) {
  const unsigned G = gridDim.x;
  unsigned sum, cnt, mine, sp = 0u;
  for (;;) {
    sum = 0u; cnt = 0u; mine = 0u;
#pragma unroll
    for (unsigned j = 0; j < 16; ++j) { const unsigned c = xb_ld(&bar[XB_XCNT(j)]); sum += c; cnt += (c > 0u) ? 1u : 0u; mine = (j == x) ? c : mine; }
    if (sum == G) break;
    __builtin_amdgcn_s_sleep(1);
    if ((++sp & 255u) == 0u) { if (xb_ld(&bar[XB_TMO])) break; if (sp > XB_SPIN_CAP) { atomicAdd(&bar[XB_TMO], 1u); break; } }
  }
  nloc = mine > 0u ? mine : 1u; nx = cnt > 0u ? cnt : 1u;
}
DEV void xcd_barrier(unsigned* bar, unsigned x, unsigned& nloc, unsigned& nx) {
  asm volatile("s_waitcnt vmcnt(0)" ::: "memory");
  __syncthreads();
  if (threadIdx.x == 0) {
    __builtin_amdgcn_s_waitcnt(0);
    if (nloc == 0u) xcd_barrier_complete(bar, x, nloc, nx);
    const unsigned old = xb_add(&bar[XB_XSUB(x)], 1u);
    const unsigned gen = old / nloc;
    if (old + 1u == (gen + 1u) * nloc) {
      __builtin_amdgcn_fence(__ATOMIC_RELEASE, "agent");
      asm volatile("s_waitcnt vmcnt(0)" ::: "memory");
      const unsigned og = xb_add(&bar[XB_TOP], 1u);
      const unsigned tg = og / nx;
      if (og + 1u == (tg + 1u) * nx) xb_add(&bar[XB_TOPGEN], 1u);
      else XB_SPIN(xb_ld(&bar[XB_TOPGEN]) == tg, bar);
      __builtin_amdgcn_fence(__ATOMIC_ACQUIRE, "agent");
      xb_add(&bar[XB_XGEN(x)], 1u);
      asm volatile("s_waitcnt vmcnt(0)" ::: "memory");
    } else {
      XB_SPIN(xb_ld(&bar[XB_XGEN(x)]) == gen, bar);
      __builtin_amdgcn_fence(__ATOMIC_ACQUIRE, "agent");
      asm volatile("s_waitcnt vmcnt(0)" ::: "memory");
    }
  }
  __syncthreads();
}

constexpr int NPHASE = 18;

__global__ void __launch_bounds__(256, 2) mega(Params p, int ph_lo, int ph_hi) {
  __shared__ __attribute__((aligned(16))) char smem[65536];
  cg::grid_group grid = cg::this_grid();
  const float* mv0 = (const float*)(p.ws + OFF_MODV);
  const float* mv1 = mv0 + 33 * 6144;
  u16* X = (u16*)(p.ws + OFF_X);
  u16* HY = (u16*)(p.ws + OFF_HY);
  u16* BIG = (u16*)(p.ws + OFF_BIG);
  unsigned* bar = (unsigned*)(p.ws + OFF_BAR);
  const unsigned xid = xb_xcc_id();
  unsigned nloc = 0u, nx = 0u;
  if (threadIdx.x == 0) (void)xb_add(&bar[XB_XCNT(xid)], 1u);
  if (ph_hi < 0) grid.sync();
#define PHASE(n, BODY) if (ph_lo <= (n) && (n) < ph_hi) { BODY; if ((n) + 1 < ph_hi) xcd_barrier(bar, xid, nloc, nx); }
  PHASE(0, phase_prep(p, smem))
  PHASE(1, phase_init(p))
  PHASE(2, gemm_phase<0>(HY, 1024, (const u16*)(p.ws + OFF_WIN0), 1024, NTOK, 2304, BIG, PS0, nullptr, smem))
  PHASE(3, phase_hyprep_rope(p, smem))
  PHASE(4, phase_conv_attn(p, smem))
  PHASE(5, gemm_phase<2>(HY, 1024, (const u16*)(p.ws + OFF_WOUT0), 1024, NTOK, 1024, X, 1024, mv0 + 2 * 1024, smem))
  PHASE(6, ln_phase<false>(p, NTOK, p.ln_g, p.ln_b, mv0, 3, 4))
  PHASE(7, gemm_phase<1>(HY, 1024, (const u16*)(p.ws + OFF_W1_0), 1024, NTOK, 4096, BIG, 4096, nullptr, smem))
  PHASE(8, gemm_phase<2>(BIG, 4096, (const u16*)(p.ws + OFF_W2_0), 4096, NTOK, 1024, X, 1024, mv0 + 5 * 1024, smem))
  PHASE(9, ln_phase<false>(p, NTOK, p.ln_g + 1024, p.ln_b + 1024, mv1, 0, 1))
  PHASE(10, gemm_phase<0>(HY, 1024, (const u16*)(p.ws + OFF_WIN1), 1024, NTOK, 4096, BIG, PS1, nullptr, smem))
  PHASE(11, phase_scans(p, smem))
  PHASE(12, for (int it = blockIdx.x; it < 2048; it += gridDim.x) mixout_item(p, it, smem))
  PHASE(13, gemm_phase<2>(HY, 1024, (const u16*)(p.ws + OFF_WOUT1), 1024, NLAT, 1024, X, 1024, mv1 + 2 * 1024, smem))
  PHASE(14, ln_phase<false>(p, NLAT, p.ln_g + 2048, p.ln_b + 2048, mv1, 3, 4))
  PHASE(15, gemm_phase<1>(HY, 1024, (const u16*)(p.ws + OFF_W1_1), 1024, NLAT, 4096, BIG, 4096, nullptr, smem))
  PHASE(16, gemm_phase<2>(BIG, 4096, (const u16*)(p.ws + OFF_W2_1), 4096, NLAT, 1024, X, 1024, mv1 + 5 * 1024, smem))
  PHASE(17, ln_phase<true>(p, NLAT, p.ln_g + 3072, p.ln_b + 3072, mv1, 0, 1))
}

extern "C" void kernel_launch(void* const* d_in, const int* in_sizes, int n_in, void* d_out, int out_size, void* d_ws,
                              size_t ws_size, hipStream_t stream) {
  static int grid_blocks = 0;
  if (!grid_blocks) {
    int dev = 0, cus = 0, per_cu = 0;
    hipGetDevice(&dev);
    hipDeviceGetAttribute(&cus, hipDeviceAttributeMultiprocessorCount, dev);
    hipOccupancyMaxActiveBlocksPerMultiprocessor(&per_cu, mega, 256, 0);
    if (per_cu > 2) per_cu = 2;
    if (per_cu < 1) per_cu = 1;
    grid_blocks = cus * per_cu;
  }
  if (ws_size < WS_NEED) fprintf(stderr, "workspace too small: %zu < %zu\n", ws_size, (size_t)WS_NEED);
  Params p{};
  const float** pp = (const float**)&p;
  for (int i = 0; i < 39; ++i) pp[i] = (const float*)d_in[i];
  p.out = (float*)d_out;
  p.ws = (char*)d_ws;
  int lo = 0, hi = NPHASE;
  void* args[] = {&p, &lo, &hi};
  hipMemsetAsync((char*)d_ws + OFF_BAR, 0, XCD_BAR_WORDS * sizeof(unsigned), stream);
  hipError_t e = hipLaunchCooperativeKernel((void*)mega, dim3(grid_blocks), dim3(256), args, 0, stream);
  if (e != hipSuccess) fprintf(stderr, "cooperative launch failed: %s (grid %d)\n", hipGetErrorString(e), grid_blocks);
}
```

```cpp
#include <hip/hip_runtime.h>
#include <hip/hip_cooperative_groups.h>
#include <cstdio>
#include <cstdint>
namespace cg = cooperative_groups;

typedef unsigned short u16;
typedef __attribute__((ext_vector_type(8))) short bf16x8;
typedef __attribute__((ext_vector_type(4))) float f32x4;
typedef __attribute__((ext_vector_type(16))) float f32x16;

#define DEV __device__ __forceinline__

constexpr int NLAT = 65536, NCTX = 8192, NTOK = 73728;
constexpr int PS0 = 2304;
constexpr int PS1 = 4096;
constexpr int DNO = 1920;
constexpr float ALPHA = 1.4142135623730951f;

constexpr size_t OFF_WIN0 = 0;
constexpr size_t OFF_WOUT0 = OFF_WIN0 + (size_t)2304 * 1024 * 2;
constexpr size_t OFF_W1_0 = OFF_WOUT0 + (size_t)1024 * 1024 * 2;
constexpr size_t OFF_W1_1 = OFF_W1_0 + (size_t)4096 * 1024 * 2;
constexpr size_t OFF_W2_0 = OFF_W1_1 + (size_t)4096 * 1024 * 2;
constexpr size_t OFF_W2_1 = OFF_W2_0 + (size_t)4096 * 1024 * 2;
constexpr size_t OFF_WIN1 = OFF_W2_1 + (size_t)4096 * 1024 * 2;
constexpr size_t OFF_WOUT1 = OFF_WIN1 + (size_t)4096 * 1024 * 2;
constexpr size_t OFF_MODV = OFF_WOUT1 + (size_t)1024 * 1024 * 2;
constexpr size_t OFF_KR2048 = OFF_MODV + (size_t)2 * 33 * 6144 * 4;
constexpr size_t OFF_KR256 = OFF_KR2048 + (size_t)512 * 4096 * 2;
constexpr size_t OFF_ROPE = OFF_KR256 + (size_t)512 * 512 * 2;
constexpr size_t OFF_BSUM = OFF_ROPE + 8192;
constexpr size_t OFF_G2T = OFF_BSUM + (size_t)65536 * 16 * 4;
constexpr size_t OFF_BAR = OFF_G2T + (size_t)512 * 128 * 2;
constexpr size_t OFF_X = (size_t)64 << 20;
constexpr size_t OFF_HY = OFF_X + (size_t)NTOK * 1024 * 2;
constexpr size_t OFF_BIG = OFF_HY + (size_t)NTOK * 1024 * 2;
constexpr size_t WS_NEED = OFF_BIG + (size_t)NTOK * 4096 * 2;
static_assert(OFF_BAR + 16384 <= OFF_X, "ws map");
constexpr size_t SO_U = 0;
constexpr size_t SO_X0 = SO_U + (size_t)512 * 32 * 2048 * 2;
constexpr size_t SO_UC = SO_X0 + (size_t)512 * 32 * 2048 * 2;
constexpr size_t SO_X0C = SO_UC + (size_t)512 * 32 * 256 * 2;

struct Params {
  const float *x, *c, *ctx, *c_ctx, *mod_w, *mod_b, *ln_g, *ln_b, *mlp_w1, *mlp_w2, *e_w_in, *e_w_out, *hy_conv,
      *hy_w1, *hy_b1, *hy_w2, *hy_b2, *hy_freq, *hy_w3, *hy_decay, *hy_bias, *attn_sink, *o_w_in, *o_w_out,
      *rw_mu, *rw_w0, *rw_w2, *rw_a0, *rw_a2, *rw_g2, *rw_kk, *rw_ka, *rw_rk, *rw_lnx_g, *rw_lnx_b,
      *dn_conv, *dn_A_log, *dn_dt_bias, *dn_norm_g;
  float* out;
  char* ws;
};

DEV u16 f2bf(float f) { unsigned u = __float_as_uint(f); u += 0x7fffu + ((u >> 16) & 1u); return (u16)(u >> 16); }
DEV float bf2f(u16 h) { return __uint_as_float(((unsigned)h) << 16); }
DEV float bflo(unsigned u) { return __uint_as_float(u << 16); }
DEV float bfhi(unsigned u) { return __uint_as_float(u & 0xffff0000u); }
DEV unsigned pack2(float a, float b) { return (unsigned)f2bf(a) | ((unsigned)f2bf(b) << 16); }
DEV void unpack8(const uint4& v, float* f) {
  f[0] = bflo(v.x); f[1] = bfhi(v.x); f[2] = bflo(v.y); f[3] = bfhi(v.y);
  f[4] = bflo(v.z); f[5] = bfhi(v.z); f[6] = bflo(v.w); f[7] = bfhi(v.w);
}
DEV uint4 pack8(const float* f) {
  uint4 v; v.x = pack2(f[0], f[1]); v.y = pack2(f[2], f[3]); v.z = pack2(f[4], f[5]); v.w = pack2(f[6], f[7]); return v;
}
DEV int modrow(int r) { return r < NLAT ? (r >> 11) : 32; }
DEV float sigm(float x) { return 1.f / (1.f + __expf(-x)); }
DEV float silu(float x) { return x / (1.f + __expf(-x)); }
DEV float softplus(float x) { return fmaxf(x, 0.f) + __logf(1.f + __expf(-fabsf(x))); }
DEV float fast_tanh(float x) { return 1.f - 2.f / (1.f + __expf(2.f * x)); }
DEV float wave_sum(float v) {
#pragma unroll
  for (int o = 32; o > 0; o >>= 1) v += __shfl_xor(v, o, 64);
  return v;
}

extern __shared__ __attribute__((aligned(16))) char dyn_smem[];
#define LAS __attribute__((address_space(3)))
constexpr int HALF_LDS = 65536;
constexpr int HS_OFF = 2 * HALF_LDS;
constexpr int LDS_BYTES = HS_OFF + 256;
#define VTID ((int)(threadIdx.x & 255))
#define VHALF ((int)__builtin_amdgcn_readfirstlane((int)(threadIdx.x >> 8)))
#define VBID ((int)(blockIdx.x * 2 + VHALF))
#define VNB ((int)(gridDim.x * 2))
DEV void hsync() {
  LAS unsigned* cnt = (LAS unsigned*)(dyn_smem + HS_OFF) + VHALF * 16;
  asm volatile("s_waitcnt vmcnt(0) lgkmcnt(0)" ::: "memory");
  unsigned tgt = 0u;
  if ((threadIdx.x & 63) == 0) {
    const unsigned old = __hip_atomic_fetch_add(cnt, 1u, __ATOMIC_RELAXED, __HIP_MEMORY_SCOPE_WORKGROUP);
    tgt = (old & ~3u) + 4u;
  }
  tgt = __builtin_amdgcn_readfirstlane(tgt);
  while (__hip_atomic_load(cnt, __ATOMIC_RELAXED, __HIP_MEMORY_SCOPE_WORKGROUP) < tgt) __builtin_amdgcn_s_sleep(0);
  asm volatile("s_waitcnt lgkmcnt(0)" ::: "memory");
}
#define HSYNC() hsync()

DEV void transpose_tile(const float* __restrict__ src, int K, int N, int Npad, u16* __restrict__ dst, int tile,
                               u16* sm) {
  const int tid = VTID;
  const int ntn = Npad >> 6;
  const int tk = tile / ntn, tn = tile - tk * ntn;
  const int n = tid & 63, kq = tid >> 6;
  const int gn = tn * 64 + n;
#pragma unroll 4
  for (int i = 0; i < 16; ++i) {
    int k = kq + 4 * i;
    float v = (gn < N) ? src[(size_t)(tk * 64 + k) * N + gn] : 0.f;
    sm[n * 66 + k] = f2bf(v);
  }
  HSYNC();
  const int n2 = tid >> 2, q = tid & 3;
  const unsigned* s32 = (const unsigned*)sm + (n2 * 66 + q * 16) / 2;
  uint4 a, b;
  a.x = s32[0]; a.y = s32[1]; a.z = s32[2]; a.w = s32[3];
  b.x = s32[4]; b.y = s32[5]; b.z = s32[6]; b.w = s32[7];
  u16* d = dst + (size_t)(tn * 64 + n2) * K + tk * 64 + q * 16;
  *(uint4*)d = a;
  *(uint4*)(d + 8) = b;
  HSYNC();
}

DEV void modv_item(const Params& p, int it, float* sl) {
  const int tid = VTID;
  const int l = it / 288, rem = it % 288, cc = rem / 3, rg = rem % 3;
  for (int idx = tid; idx < 11 * 1024; idx += 256) {
    int r = rg * 11 + (idx >> 10), k = idx & 1023;
    float cv = (r < 32) ? p.c[r * 1024 + k] : p.c_ctx[k];
    sl[idx] = cv / (1.f + expf(-cv));
  }
  HSYNC();
  const int cl = tid & 63, kg = tid >> 6;
  const int col = cc * 64 + cl;
  float acc[11];
#pragma unroll
  for (int r = 0; r < 11; ++r) acc[r] = 0.f;
  const float* w = p.mod_w + (size_t)l * 1024 * 6144 + (size_t)(kg * 256) * 6144 + col;
#pragma unroll 8
  for (int k = 0; k < 256; ++k) {
    float wv = w[(size_t)k * 6144];
#pragma unroll
    for (int r = 0; r < 11; ++r) acc[r] += sl[r * 1024 + kg * 256 + k] * wv;
  }
  HSYNC();
  float* red = sl;
#pragma unroll
  for (int r = 0; r < 11; ++r) red[(kg * 11 + r) * 64 + cl] = acc[r];
  HSYNC();
  for (int idx = tid; idx < 11 * 64; idx += 256) {
    int r = idx >> 6, c2 = idx & 63;
    float v = red[(0 * 11 + r) * 64 + c2] + red[(1 * 11 + r) * 64 + c2] + red[(2 * 11 + r) * 64 + c2] + red[(3 * 11 + r) * 64 + c2];
    int gcol = cc * 64 + c2;
    ((float*)(p.ws + OFF_MODV))[(size_t)(l * 33 + rg * 11 + r) * 6144 + gcol] = v + p.mod_b[l * 6144 + gcol];
  }
  HSYNC();
}

DEV void filter_item(const Params& p, int it, float* sm) {
  const int L = it < 2048 ? 2048 : 256;
  const int t = it < 2048 ? it : it - 2048;
  u16* R = (u16*)(p.ws + (L == 2048 ? OFF_KR2048 : OFF_KR256));
  float* pe = sm; float* h1 = sm + 64; float* h2 = sm + 128;
  const int tid = VTID;
  const float tn = (float)t / (float)(L - 1);
  if (tid < 33) {
    float v;
    if (tid == 0) v = tn;
    else {
      int i = (tid - 1) & 15;
      double band = 1e-4 + (double)i * ((15.0 - 1e-4) / 15.0);
      double ang = 2.0 * 3.14159265358979323846 * (double)t * band / (double)L;
      v = (tid <= 16) ? (float)cos(ang) : (float)(-sin(ang));
    }
    pe[tid] = v;
  }
  HSYNC();
  if (tid < 64) {
    float acc = p.hy_b1[tid];
#pragma unroll 11
    for (int i = 0; i < 33; ++i) acc += pe[i] * p.hy_w1[i * 64 + tid];
    h1[tid] = sinf(p.hy_freq[tid] * acc);
  }
  HSYNC();
  if (tid < 64) {
    float acc = p.hy_b2[tid];
#pragma unroll 16
    for (int i = 0; i < 64; ++i) acc += h1[i] * p.hy_w2[i * 64 + tid];
    h2[tid] = sinf(p.hy_freq[tid] * acc);
  }
  HSYNC();
#pragma unroll 1
  for (int q = 0; q < 4; ++q) {
    int o = tid + 256 * q;
    float acc = 0.f;
#pragma unroll 16
    for (int i = 0; i < 64; ++i) acc += h2[i] * p.hy_w3[i * 1024 + o];
    float val = acc * expf(-tn * fabsf(p.hy_decay[o]));
    if (o < 512) {
      if (t == 0) val += p.hy_bias[o];
      R[(size_t)o * 2 * L + L - t] = f2bf(val);
    } else {
      int c = o - 512;
      if (t >= 1) R[(size_t)c * 2 * L + L + t] = f2bf(val);
      else R[(size_t)c * 2 * L] = 0;
    }
  }
  HSYNC();
}

DEV void phase_prep(const Params& p, char* smem) {
  constexpr int T_IN0 = 16 * 36, T_OUT = 16 * 16, T_W = 16 * 64;
  constexpr int E0 = T_IN0, E1 = E0 + T_OUT, E2 = E1 + T_W, E3 = E2 + T_W, E4 = E3 + T_W, E5 = E4 + T_W,
                E6 = E5 + T_W, E7 = E6 + T_OUT, E8 = E7 + 576, E9 = E8 + 2304, E10 = E9 + 1, E11 = E10 + 16;
  for (int it = VBID; it < E11; it += VNB) {
    if (it >= E10) transpose_tile(p.rw_g2, 128, 512, 512, (u16*)(p.ws + OFF_G2T), it - E10, (u16*)smem);
    else if (it < E0) transpose_tile(p.e_w_in, 1024, 2304, 2304, (u16*)(p.ws + OFF_WIN0), it, (u16*)smem);
    else if (it < E1) transpose_tile(p.e_w_out, 1024, 1024, 1024, (u16*)(p.ws + OFF_WOUT0), it - E0, (u16*)smem);
    else if (it < E2) transpose_tile(p.mlp_w1, 1024, 4096, 4096, (u16*)(p.ws + OFF_W1_0), it - E1, (u16*)smem);
    else if (it < E3) transpose_tile(p.mlp_w1 + (size_t)1024 * 4096, 1024, 4096, 4096, (u16*)(p.ws + OFF_W1_1), it - E2, (u16*)smem);
    else if (it < E4) transpose_tile(p.mlp_w2, 4096, 1024, 1024, (u16*)(p.ws + OFF_W2_0), it - E3, (u16*)smem);
    else if (it < E5) transpose_tile(p.mlp_w2 + (size_t)1024 * 4096, 4096, 1024, 1024, (u16*)(p.ws + OFF_W2_1), it - E4, (u16*)smem);
    else if (it < E6) transpose_tile(p.o_w_in, 1024, 3984, 4096, (u16*)(p.ws + OFF_WIN1), it - E5, (u16*)smem);
    else if (it < E7) transpose_tile(p.o_w_out, 1024, 1024, 1024, (u16*)(p.ws + OFF_WOUT1), it - E6, (u16*)smem);
    else if (it < E8) modv_item(p, it - E7, (float*)smem);
    else if (it < E9) filter_item(p, it - E8, (float*)smem);
    else {
      float2* tab = (float2*)(p.ws + OFF_ROPE);
      for (int q = 0; q < 4; ++q) {
        int e = VTID * 4 + q;
        int pos = e >> 4, i = e & 15;
        float inv = powf(10000.f, -(float)i / 16.f);
        float ang = (float)pos * inv;
        tab[e] = make_float2(cosf(ang), sinf(ang));
      }
    }
  }
}

DEV void phase_init(const Params& p) {
  const float* mv = (const float*)(p.ws + OFF_MODV);
  u16* X = (u16*)(p.ws + OFF_X);
  u16* HM = (u16*)(p.ws + OFF_HY);
  const size_t total = (size_t)NTOK * 128;
  for (size_t i = (size_t)VBID * 256 + VTID; i < total; i += (size_t)VNB * 256) {
    int r = (int)(i >> 7), c8 = (int)(i & 127) * 8;
    const float* src = r < NLAT ? p.x + (size_t)r * 1024 + c8 : p.ctx + (size_t)(r - NLAT) * 1024 + c8;
    float4 v0 = *(const float4*)src, v1 = *(const float4*)(src + 4);
    const float* m = mv + (size_t)modrow(r) * 6144 + c8;
    float4 h0 = *(const float4*)m, h1 = *(const float4*)(m + 4);
    float4 s0 = *(const float4*)(m + 1024), s1 = *(const float4*)(m + 1028);
    float f[8] = {v0.x, v0.y, v0.z, v0.w, v1.x, v1.y, v1.z, v1.w};
    float sh[8] = {h0.x, h0.y, h0.z, h0.w, h1.x, h1.y, h1.z, h1.w};
    float sc[8] = {s0.x, s0.y, s0.z, s0.w, s1.x, s1.y, s1.z, s1.w};
    float g[8];
#pragma unroll
    for (int j = 0; j < 8; ++j) g[j] = f[j] * (1.f + sc[j]) + sh[j];
    *(uint4*)(X + (size_t)r * 1024 + c8) = pack8(f);
    *(uint4*)(HM + (size_t)r * 1024 + c8) = pack8(g);
  }
}

template <int EPI>
DEV void gemm_phase(const u16* __restrict__ A, int lda, const u16* __restrict__ Bt, int K, int M, int N,
                    u16* __restrict__ C, int ldc, const float* __restrict__ gate, char* smem) {
  const int tid = threadIdx.x, lane = tid & 63, wave = tid >> 6;
  const int wm = wave >> 2, wn = wave & 3;
  const int fr = lane & 15, fq = lane >> 4;
  const int tn = N >> 8, tm = M >> 8, tiles = tm * tn;
  const int nk = K >> 6;
  const int drow = wave * 8 + (lane >> 3);
  const int dchunk = (lane & 7) ^ ((drow >> 1) & 7);
  const size_t lda64 = (size_t)lda * 64, ldb64 = (size_t)K * 64;
  const int sw = fr >> 1;
  const bool xcd_order = (gridDim.x & 7) == 0 && (tm & 31) == 0;
  const int mx = tm >> 3;
  for (int it = blockIdx.x; it < tiles; it += gridDim.x) {
    int tm_i, tn_i;
    if (xcd_order) {
      const int x = it & 7, local = it >> 3;
      const int mg = local / (4 * tn), r = local - mg * 4 * tn;
      tn_i = r >> 2;
      tm_i = x * mx + mg * 4 + (r & 3);
    } else { tm_i = it / tn; tn_i = it - tm_i * tn; }
    const int m0 = tm_i << 8, n0 = tn_i << 8;
    const u16* ag = A + (size_t)(m0 + drow) * lda + dchunk * 8;
    const u16* bg = Bt + (size_t)(n0 + drow) * K + dchunk * 8;
    f32x4 acc[8][4];
#pragma unroll
    for (int i = 0; i < 8; ++i)
#pragma unroll
      for (int j = 0; j < 4; ++j) acc[i][j] = (f32x4){0.f, 0.f, 0.f, 0.f};
#define G_ISSUE(KT, ST)                                                                                  \
  {                                                                                                      \
    const u16* a2 = ag + (KT)*64;                                                                        \
    const u16* b2 = bg + (KT)*64;                                                                        \
    char* la = smem + (ST)*65536 + wave * 1024;                                                          \
    _Pragma("unroll") for (int j = 0; j < 4; ++j) {                                                      \
      __builtin_amdgcn_global_load_lds((const unsigned*)(a2 + j * lda64), (unsigned*)(la + j * 8192), 16, 0, 0);          \
      __builtin_amdgcn_global_load_lds((const unsigned*)(b2 + j * ldb64), (unsigned*)(la + 32768 + j * 8192), 16, 0, 0);  \
    }                                                                                                    \
  }
    G_ISSUE(0, 0)
    for (int kt = 0; kt < nk; ++kt) {
      asm volatile("s_waitcnt vmcnt(0)" ::: "memory");
      __syncthreads();
      if (kt + 1 < nk) G_ISSUE(kt + 1, (kt + 1) & 1)
      const u16* As = (const u16*)(smem + (kt & 1) * 65536);
      const u16* Bs = As + 16384;
#pragma unroll
      for (int ks = 0; ks < 2; ++ks) {
        bf16x8 af[8], bfr[4];
        const int pos = ((ks * 4 + fq) ^ sw) * 8;
#pragma unroll
        for (int i = 0; i < 8; ++i) af[i] = *(const bf16x8*)(As + (wm * 128 + i * 16 + fr) * 64 + pos);
#pragma unroll
        for (int j = 0; j < 4; ++j) bfr[j] = *(const bf16x8*)(Bs + (wn * 64 + j * 16 + fr) * 64 + pos);
        __builtin_amdgcn_s_setprio(1);
#pragma unroll
        for (int i = 0; i < 8; ++i)
#pragma unroll
          for (int j = 0; j < 4; ++j)
            acc[i][j] = __builtin_amdgcn_mfma_f32_16x16x32_bf16(af[i], bfr[j], acc[i][j], 0, 0, 0);
        __builtin_amdgcn_s_setprio(0);
      }
    }
#undef G_ISSUE
    u16* Cs = (u16*)smem;
#pragma unroll 1
    for (int hp = 0; hp < 2; ++hp) {
      __syncthreads();
      if (wm == hp) {
#pragma unroll
        for (int i = 0; i < 8; ++i)
#pragma unroll
          for (int j = 0; j < 4; ++j)
#pragma unroll
            for (int e = 0; e < 4; ++e) {
              float v = acc[i][j][e];
              if (EPI == 1) { v = fmaxf(v, 0.f); v = v * v; }
              Cs[(i * 16 + fq * 4 + e) * 264 + wn * 64 + j * 16 + fr] = f2bf(v);
            }
      }
      __syncthreads();
#pragma unroll 2
      for (int q = 0; q < 8; ++q) {
        const int chunk = tid + q * 512;
        const int row = chunk >> 5, cc = chunk & 31;
        uint4 cv = *(const uint4*)(Cs + row * 264 + cc * 8);
        const int grow = m0 + hp * 128 + row;
        u16* dst = C + (size_t)grow * ldc + n0 + cc * 8;
        if (EPI == 2) {
          float a[8], xo[8], y[8];
          unpack8(cv, a);
          unpack8(*(const uint4*)dst, xo);
          const float* gr = gate + (size_t)modrow(grow) * 6144 + n0 + cc * 8;
          float4 g0 = *(const float4*)gr, g1 = *(const float4*)(gr + 4);
          float gg[8] = {g0.x, g0.y, g0.z, g0.w, g1.x, g1.y, g1.z, g1.w};
#pragma unroll
          for (int j = 0; j < 8; ++j) y[j] = ALPHA * xo[j] + gg[j] * a[j];
          cv = pack8(y);
        }
        *(uint4*)dst = cv;
      }
    }
    __syncthreads();
  }
}

template <bool FINAL>
DEV void ln_phase(const Params& p, int M, const float* __restrict__ g, const float* __restrict__ b,
                         const float* __restrict__ modl  , int shi, int sci) {
  u16* X = (u16*)(p.ws + OFF_X);
  u16* HM = (u16*)(p.ws + OFF_HY);
  const int lane = VTID & 63;
  const int gw = VBID * 4 + (VTID >> 6), nw = VNB * 4;
  uint4 nx0 = make_uint4(0u, 0u, 0u, 0u), nx1 = nx0;
  if (gw < M) {
    nx0 = *(const uint4*)(X + (size_t)gw * 1024 + lane * 8);
    nx1 = *(const uint4*)(X + (size_t)gw * 1024 + 512 + lane * 8);
  }
  for (int row = gw; row < M; row += nw) {
    u16* xr = X + (size_t)row * 1024;
    float f[16];
    unpack8(nx0, f);
    unpack8(nx1, f + 8);
    if (row + nw < M) {
      nx0 = *(const uint4*)(xr + (size_t)nw * 1024 + lane * 8);
      nx1 = *(const uint4*)(xr + (size_t)nw * 1024 + 512 + lane * 8);
    }
    float s = 0.f, q = 0.f;
#pragma unroll
    for (int j = 0; j < 16; ++j) { s += f[j]; q += f[j] * f[j]; }
#pragma unroll
    for (int o = 32; o > 0; o >>= 1) { s += __shfl_xor(s, o, 64); q += __shfl_xor(q, o, 64); }
    const float mu = s * (1.f / 1024.f);
    const float rs = rsqrtf(fmaxf(q * (1.f / 1024.f) - mu * mu, 0.f) + 1e-5f);
#pragma unroll
    for (int j = 0; j < 16; ++j) f[j] -= mu;
#pragma unroll
    for (int hh = 0; hh < 2; ++hh) {
      const int c0 = hh * 512 + lane * 8;
      float y[8];
#pragma unroll
      for (int j = 0; j < 8; ++j) y[j] = f[hh * 8 + j] * rs * g[c0 + j] + b[c0 + j];
      if (FINAL) {
        float* o = p.out + (size_t)row * 1024 + c0;
        *(float4*)o = make_float4(y[0], y[1], y[2], y[3]);
        *(float4*)(o + 4) = make_float4(y[4], y[5], y[6], y[7]);
      } else {
        *(uint4*)(xr + c0) = pack8(y);
        const float* m = modl + (size_t)modrow(row) * 6144;
        float h[8];
#pragma unroll
        for (int j = 0; j < 8; ++j) h[j] = y[j] * (1.f + m[sci * 1024 + c0 + j]) + m[shi * 1024 + c0 + j];
        *(uint4*)(HM + (size_t)row * 1024 + c0) = pack8(h);
      }
    }
  }
}

DEV void hyprep_item(const Params& p, int it, char* smem) {
  u16* su = (u16*)smem;
  u16* sx = su + 64 * 66;
  const u16* P = (const u16*)(p.ws + OFF_BIG);
  const int tid = VTID;
  const int ct = it & 7, st = it >> 3;
  int b, t0, L, rowbase;
  u16 *U, *X0;
  if (st < 1024) { b = st >> 5; t0 = (st & 31) * 64; L = 2048; rowbase = b * 2048;
    U = (u16*)((char*)p.out + SO_U); X0 = (u16*)((char*)p.out + SO_X0); }
  else { int s2 = st - 1024; b = s2 >> 2; t0 = (s2 & 3) * 64; L = 256; rowbase = NLAT + b * 256;
    U = (u16*)((char*)p.out + SO_UC); X0 = (u16*)((char*)p.out + SO_X0C); }
  const int c0 = ct * 64;
  {
    const int t = tid >> 2, cq = tid & 3;
    float z[3][16];
#pragma unroll
    for (int g = 0; g < 3; ++g)
#pragma unroll
      for (int j = 0; j < 16; ++j) z[g][j] = 0.f;
#pragma unroll
    for (int tap = 0; tap < 3; ++tap) {
      const int tt = t0 + t + tap - 1;
      if (tt >= 0 && tt < L) {
#pragma unroll
        for (int g = 0; g < 3; ++g) {
          const int col = g * 512 + c0 + cq * 16;
          const u16* src = P + (size_t)(rowbase + tt) * PS0 + col;
          float f[16];
          unpack8(*(const uint4*)src, f);
          unpack8(*(const uint4*)(src + 8), f + 8);
          const float* w = p.hy_conv + tap * 1536 + col;
#pragma unroll
          for (int j = 0; j < 16; ++j) z[g][j] += f[j] * w[j];
        }
      }
    }
#pragma unroll
    for (int j = 0; j < 16; ++j) {
      su[t * 66 + cq * 16 + j] = f2bf(z[1][j] * z[2][j]);
      sx[t * 66 + cq * 16 + j] = f2bf(z[0][j]);
    }
  }
  HSYNC();
  {
    const int c = tid >> 2, tq = tid & 3;
    unsigned wu[8], wx[8];
#pragma unroll
    for (int j = 0; j < 8; ++j) {
      wu[j] = (unsigned)su[(tq * 16 + 2 * j) * 66 + c] | ((unsigned)su[(tq * 16 + 2 * j + 1) * 66 + c] << 16);
      wx[j] = (unsigned)sx[(tq * 16 + 2 * j) * 66 + c] | ((unsigned)sx[(tq * 16 + 2 * j + 1) * 66 + c] << 16);
    }
    const size_t o = ((size_t)(c0 + c) * 32 + b) * L + t0 + tq * 16;
    *(uint4*)(U + o) = make_uint4(wu[0], wu[1], wu[2], wu[3]);
    *(uint4*)(U + o + 8) = make_uint4(wu[4], wu[5], wu[6], wu[7]);
    *(uint4*)(X0 + o) = make_uint4(wx[0], wx[1], wx[2], wx[3]);
    *(uint4*)(X0 + o + 8) = make_uint4(wx[4], wx[5], wx[6], wx[7]);
  }
  HSYNC();
}

DEV void rope_item(const Params& p, int it) {
  u16* P = (u16*)(p.ws + OFF_BIG);
  const float2* tab = (const float2*)(p.ws + OFF_ROPE);
  const int task = it * 256 + VTID;
  const int row = task / 40, rem = task - row * 40;
  const int head = rem >> 2, pr = rem & 3;
  const int d0 = (pr >> 1) * 32 + (pr & 1) * 8;
  const int t = row & 2047;
  const int posc = (pr >> 1) ? (t & 63) : (t >> 6);
  const int fi0 = (pr & 1) * 8;
  u16* ptr = P + (size_t)row * PS0 + 1536 + head * 64 + d0;
  float u1[8], u2[8], o1[8], o2[8];
  unpack8(*(const uint4*)ptr, u1);
  unpack8(*(const uint4*)(ptr + 16), u2);
#pragma unroll
  for (int j = 0; j < 8; ++j) {
    float2 cs = tab[posc * 16 + fi0 + j];
    o1[j] = u1[j] * cs.x - u2[j] * cs.y;
    o2[j] = u1[j] * cs.y + u2[j] * cs.x;
  }
  *(uint4*)ptr = pack8(o1);
  *(uint4*)(ptr + 16) = pack8(o2);
}

DEV void phase_hyprep_rope(const Params& p, char* smem) {
  constexpr int NH = 9216, NR = 10240;
  for (int it = VBID; it < NH + NR; it += VNB) {
    if (it < NH) hyprep_item(p, it, smem);
    else rope_item(p, it - NH);
  }
}

template <int L, int NT>
DEV void conv_item(const Params& p, int c, int th, char* smem) {
  const u16* R = (const u16*)(p.ws + (L == 2048 ? OFF_KR2048 : OFF_KR256)) + (size_t)c * 2 * L;
  const u16* U = (const u16*)((const char*)p.out + (L == 2048 ? SO_U : SO_UC));
  const u16* X0 = (const u16*)((const char*)p.out + (L == 2048 ? SO_X0 : SO_X0C));
  u16* Y = (u16*)(p.ws + OFF_HY);
  u16* Rs0 = (u16*)smem;
  u16* Rs1 = Rs0 + 2 * L + 8;
  const int tid = VTID, lane = tid & 63, wave = tid >> 6;
  for (int i = tid; i < 2 * L; i += 256) {
    Rs0[i] = R[i];
    Rs1[i] = (i + 1 < 2 * L) ? R[i + 1] : (u16)0;
  }
  HSYNC();
  const int r = lane & 31, h = lane >> 5;
  const char* lanebase = (r & 1) ? (const char*)Rs1 + 2 * (8 * h - r + L - 1) : (const char*)Rs0 + 2 * (8 * h - r + L);
  const u16* Ub = U + ((size_t)c * 32 + r) * L + 8 * h;
  const int tw0 = th * 1024 + wave * NT * 32;
  f32x16 acc[NT];
#pragma unroll
  for (int i = 0; i < NT; ++i)
#pragma unroll
    for (int e = 0; e < 16; ++e) acc[i][e] = 0.f;
  uint4 nb = *(const uint4*)Ub;
  for (int st = 0; st < L / 16; ++st) {
    uint4 cur = nb;
    if (st + 1 < L / 16) nb = *(const uint4*)(Ub + (st + 1) * 16);
    bf16x8 bfrag = *(bf16x8*)&cur;
#pragma unroll
    for (int i = 0; i < NT; ++i) {
      const unsigned* ap = (const unsigned*)(lanebase + 2 * (st * 16 - (tw0 + i * 32)));
      uint4 av = make_uint4(ap[0], ap[1], ap[2], ap[3]);
      acc[i] = __builtin_amdgcn_mfma_f32_32x32x16_bf16(*(bf16x8*)&av, bfrag, acc[i], 0, 0, 0);
    }
  }
  const int rowbase = (L == 2048) ? r * 2048 : NLAT + r * 256;
#pragma unroll
  for (int i = 0; i < NT; ++i) {
#pragma unroll
    for (int g4 = 0; g4 < 4; ++g4) {
      const int tt = tw0 + i * 32 + 8 * g4 + 4 * h;
      uint2 xv = *(const uint2*)(X0 + ((size_t)c * 32 + r) * L + tt);
      float x0[4] = {bflo(xv.x), bfhi(xv.x), bflo(xv.y), bfhi(xv.y)};
#pragma unroll
      for (int e = 0; e < 4; ++e) Y[(size_t)(rowbase + tt + e) * 1024 + c] = f2bf(acc[i][g4 * 4 + e] * x0[e]);
    }
  }
  HSYNC();
}

DEV void attn_item(const Params& p, int b, int hq, int qb, bool isctx, char* smem) {
  const u16* P = (const u16*)(p.ws + OFF_BIG);
  u16* Y = (u16*)(p.ws + OFF_HY);
  u16* Ks = (u16*)smem;
  u16* Vt = Ks + 64 * 72;
  const int tid = VTID, lane = tid & 63, wave = tid >> 6;
  const int nq = lane & 15, quad = lane >> 4;
  const int qrow = (isctx ? NLAT + b * 256 : b * 2048) + qb * 64 + wave * 16 + nq;
  const int qpos = qb * 64 + wave * 16 + nq;
  const int hkv = hq >> 2;
  const int kcol = 2048 + hkv * 64, vcol = 2176 + hkv * 64;
  bf16x8 qf[2];
#pragma unroll
  for (int ks = 0; ks < 2; ++ks)
    qf[ks] = *(const bf16x8*)(P + (size_t)qrow * PS0 + 1536 + hq * 64 + ks * 32 + quad * 8);
  float m = p.attn_sink[hq];
  float lsum = (quad == 0) ? 1.f : 0.f;
  f32x4 oacc[4];
#pragma unroll
  for (int n = 0; n < 4; ++n) oacc[n] = (f32x4){0.f, 0.f, 0.f, 0.f};
  const int nloc = isctx ? 0 : 5;
  for (int ti = 0; ti < nloc + 4; ++ti) {
    int krow0, k0 = 0;
    bool masked;
    if (ti < nloc) {
      k0 = qb * 64 - 128 + ti * 64;
      if (k0 < 0 || k0 >= 2048) continue;
      krow0 = b * 2048 + k0; masked = true;
    } else { krow0 = NLAT + b * 256 + (ti - nloc) * 64; masked = false; }
    HSYNC();
    {
      const int key = tid >> 2, part = tid & 3;
      const u16* kp = P + (size_t)(krow0 + key) * PS0 + kcol + part * 16;
      const u16* vp = P + (size_t)(krow0 + key) * PS0 + vcol + part * 16;
      uint4 k0v = *(const uint4*)kp, k1v = *(const uint4*)(kp + 8);
      uint4 v0v = *(const uint4*)vp, v1v = *(const uint4*)(vp + 8);
      *(uint4*)(Ks + key * 72 + part * 16) = k0v;
      *(uint4*)(Ks + key * 72 + part * 16 + 8) = k1v;
      unsigned vw[8] = {v0v.x, v0v.y, v0v.z, v0v.w, v1v.x, v1v.y, v1v.z, v1v.w};
#pragma unroll
      for (int j = 0; j < 8; ++j) {
        Vt[(part * 16 + 2 * j) * 72 + key] = (u16)(vw[j] & 0xffffu);
        Vt[(part * 16 + 2 * j + 1) * 72 + key] = (u16)(vw[j] >> 16);
      }
    }
    HSYNC();
    f32x4 s[4];
#pragma unroll
    for (int n = 0; n < 4; ++n) {
      s[n] = (f32x4){0.f, 0.f, 0.f, 0.f};
#pragma unroll
      for (int ks = 0; ks < 2; ++ks) {
        bf16x8 kf = *(const bf16x8*)(Ks + (n * 16 + nq) * 72 + ks * 32 + quad * 8);
        s[n] = __builtin_amdgcn_mfma_f32_16x16x32_bf16(kf, qf[ks], s[n], 0, 0, 0);
      }
    }
    float mx = -1e30f;
#pragma unroll
    for (int n = 0; n < 4; ++n)
#pragma unroll
      for (int e = 0; e < 4; ++e) {
        float v = s[n][e] * 0.125f;
        if (masked) {
          int kpos = k0 + n * 16 + quad * 4 + e;
          int d = qpos - kpos;
          if (d > 128 || d < -128) v = -1e30f;
        }
        s[n][e] = v;
        mx = fmaxf(mx, v);
      }
    mx = fmaxf(mx, __shfl_xor(mx, 16, 64));
    mx = fmaxf(mx, __shfl_xor(mx, 32, 64));
    const float mn = fmaxf(m, mx);
    const float al = __expf(m - mn);
    m = mn;
    float ps = 0.f;
#pragma unroll
    for (int n = 0; n < 4; ++n)
#pragma unroll
      for (int e = 0; e < 4; ++e) { float pv = __expf(s[n][e] - mn); s[n][e] = pv; ps += pv; }
    lsum = lsum * al + ps;
#pragma unroll
    for (int n = 0; n < 4; ++n)
#pragma unroll
      for (int e = 0; e < 4; ++e) oacc[n][e] *= al;
#pragma unroll
    for (int hh = 0; hh < 2; ++hh) {
      uint4 pw;
      pw.x = pack2(s[2 * hh][0], s[2 * hh][1]); pw.y = pack2(s[2 * hh][2], s[2 * hh][3]);
      pw.z = pack2(s[2 * hh + 1][0], s[2 * hh + 1][1]); pw.w = pack2(s[2 * hh + 1][2], s[2 * hh + 1][3]);
      bf16x8 pb = *(bf16x8*)&pw;
#pragma unroll
      for (int n = 0; n < 4; ++n) {
        const u16* vr = Vt + (n * 16 + nq) * 72 + quad * 4;
        uint2 va = *(const uint2*)(vr + (2 * hh) * 16);
        uint2 vb = *(const uint2*)(vr + (2 * hh + 1) * 16);
        uint4 vv = make_uint4(va.x, va.y, vb.x, vb.y);
        oacc[n] = __builtin_amdgcn_mfma_f32_16x16x32_bf16(*(bf16x8*)&vv, pb, oacc[n], 0, 0, 0);
      }
    }
  }
  lsum += __shfl_xor(lsum, 16, 64);
  lsum += __shfl_xor(lsum, 32, 64);
  const float inv = 1.f / lsum;
  u16* yo = Y + (size_t)qrow * 1024 + 512 + hq * 64 + quad * 4;
#pragma unroll
  for (int n = 0; n < 4; ++n) {
    uint2 w;
    w.x = pack2(oacc[n][0] * inv, oacc[n][1] * inv);
    w.y = pack2(oacc[n][2] * inv, oacc[n][3] * inv);
    *(uint2*)(yo + n * 16) = w;
  }
  HSYNC();
}

DEV void phase_conv_attn(const Params& p, char* smem) {
  constexpr int N0 = 1024, N1 = N0 + 512, N2 = N1 + 8192, N3 = N2 + 1024;
#pragma unroll 1
  for (int it = VBID; it < N0; it += VNB) conv_item<2048, 8>(p, it >> 1, it & 1, smem);
  __builtin_amdgcn_sched_barrier(0);
#pragma unroll 1
  for (int it = VBID; it < N3; it += VNB) {
    if (it < N0) continue;
    if (it < N1) conv_item<256, 2>(p, it - N0, 0, smem);
  }
  __builtin_amdgcn_sched_barrier(0);
#pragma unroll 1
  for (int it = VBID; it < N3; it += VNB) {
    if (it < N1) continue;
    if (it < N2) { int a = it - N1; attn_item(p, a >> 8, (a >> 5) & 7, a & 31, false, smem); }
    else { int a = it - N2; attn_item(p, a >> 5, (a >> 2) & 7, a & 3, true, smem); }
  }
}

DEV void lds_wave_sync() {
  asm volatile("s_waitcnt lgkmcnt(0)" ::: "memory");
  __builtin_amdgcn_wave_barrier();
}

DEV void rwkv_item(const Params& p, int ri, char* smem) {
  const u16* P = (const u16*)(p.ws + OFF_BIG);
  u16* O4 = (u16*)p.out;
  float* BS = (float*)(p.ws + OFF_BSUM);
  const int tid0 = VTID;
  const int wp0 = tid0 >> 7;
  const int cid = ri * 2 + wp0;
  const int b = cid >> 4, d = (cid >> 3) & 1, h = cid & 7;
  f32x4 S[4][2];
#pragma unroll
  for (int i = 0; i < 4; ++i)
#pragma unroll
    for (int j = 0; j < 2; ++j) S[i][j] = (f32x4){0.f, 0.f, 0.f, 0.f};
  uint4 bw[2][4];
  float l0[4];
  {
    const int lane = tid0 & 63, wi = (tid0 >> 6) & 1, fr = lane & 15, fq = lane >> 4;
    const float* wsrc = (wi == 0 ? p.rw_w2 : p.rw_a2) + (size_t)d * 64 * 512 + h * 64;
    const float* bsrc = (wi == 0 ? p.rw_w0 : p.rw_a0) + d * 512 + h * 64;
#pragma unroll
    for (int nt = 0; nt < 4; ++nt) {
      l0[nt] = bsrc[nt * 16 + fr];
#pragma unroll
      for (int ks = 0; ks < 2; ++ks) {
        __builtin_amdgcn_sched_barrier(0);
        float f[8];
        const float* wp_ = wsrc + (size_t)(ks * 32 + fq * 8) * 512 + nt * 16 + fr;
#pragma unroll
        for (int j = 0; j < 8; ++j) f[j] = wp_[j * 512];
        bw[ks][nt] = pack8(f);
      }
    }
  }
  uint4 pre[5][3];
#define RW_LOAD(CI)                                                                                 \
  {                                                                                                 \
    const int seg_ = (CI) < 16 ? 0 : 1;                                                             \
    const int ch_ = seg_ ? (CI)-16 : (CI);                                                          \
    const int Ls_ = seg_ ? 2048 : 256;                                                              \
    const int rb_ = seg_ ? b * 2048 : NLAT + b * 256;                                               \
    const int sidx_ = ch_ * 16 + stt;                                                               \
    const int t_ = d == 0 ? sidx_ : Ls_ - 1 - sidx_;                                                \
    const u16* prow_ = P + (size_t)(rb_ + t_) * PS1 + spart * 8;                                    \
    _Pragma("unroll") for (int g = 0; g < 5; ++g) {                                                 \
      const int col_ = g < 3 ? g * 512 + h * 64 : (g == 3 ? 1536 + d * 64 : 1664 + d * 64);         \
      _Pragma("unroll") for (int tap = 0; tap < 3; ++tap) {                                         \
        const int tt_ = t_ + tap - 1;                                                               \
        if (tt_ >= 0 && tt_ < Ls_) pre[g][tap] = *(const uint4*)(prow_ + (ptrdiff_t)(tap - 1) * PS1 + col_); \
        else pre[g][tap] = make_uint4(0u, 0u, 0u, 0u);                                              \
      }                                                                                             \
    }                                                                                               \
  }
  {
    const int pt = tid0 & 127, stt = pt >> 3, spart = pt & 7;
    RW_LOAD(0)
  }
  for (int cidx = 0; cidx < 144; ++cidx) {
    asm volatile("" ::: "memory");
    int tid = tid0;
    asm volatile("" : "+v"(tid));
    const int lane = tid & 63, wave = tid >> 6, wp = wave >> 1, wi = wave & 1, pt = tid & 127;
    const int fr = lane & 15, fq = lane >> 4, stt = pt >> 3, spart = pt & 7;
    const int seg = cidx < 16 ? 0 : 1;
    const int ch = seg ? cidx - 16 : cidx;
    const int Ls = seg ? 2048 : 256;
    char* base = smem + wp * 32768;
    u16* RK = (u16*)base;
    u16* KD = RK + 1152;
    u16* KK = KD + 1152;
    u16* AB = KK + 1152;
    u16* VT = AB + 1152;
    float* LW = (float*)(base + 11264);
    u16* TW = (u16*)(base + 15360);
    u16* AD = TW + 1152;
    u16* BgCT = (u16*)(base + 19968);
    u16* KgCT = BgCT + 1024;
    float* gC = (float*)(base + 24064);
    float* Amat = (float*)(base + 24320) + wi * 256;
    u16* Tinv = (u16*)(base + 26368) + wi * 256;
    u16* BG = (u16*)(base + 27392);
    {
      const int o = stt * 72 + spart * 8;
#pragma unroll
      for (int g = 0; g < 5; ++g) {
        __builtin_amdgcn_sched_barrier(0);
        const int col = g < 3 ? g * 512 + h * 64 : (g == 3 ? 1536 + d * 64 : 1664 + d * 64);
        float pc[8], pp[8], pn[8], v[8];
        unpack8(pre[g][1], pc); unpack8(pre[g][0], pp); unpack8(pre[g][2], pn);
        const float* mu = p.rw_mu + col + spart * 8;
        float4 m0 = *(const float4*)mu, m1 = *(const float4*)(mu + 4);
        const float mm[8] = {m0.x, m0.y, m0.z, m0.w, m1.x, m1.y, m1.z, m1.w};
#pragma unroll
        for (int j = 0; j < 8; ++j) v[j] = pc[j] + mm[j] * (0.5f * (pp[j] + pn[j]) - pc[j]);
        if (g == 0) *(uint4*)(RK + o) = pack8(v);
        else if (g == 1) {
          *(uint4*)(KD + o) = pack8(v);
          const float* kkw = p.rw_kk + h * 64 + spart * 8;
          float kkv[8];
          float ss = 0.f;
#pragma unroll
          for (int j = 0; j < 8; ++j) { kkv[j] = v[j] * kkw[j]; ss += kkv[j] * kkv[j]; }
          ss += __shfl_xor(ss, 1, 64); ss += __shfl_xor(ss, 2, 64); ss += __shfl_xor(ss, 4, 64);
          const float inv = rsqrtf(ss + 1e-6f);
#pragma unroll
          for (int j = 0; j < 8; ++j) kkv[j] *= inv;
          *(uint4*)(KK + o) = pack8(kkv);
        } else if (g == 2) {
#pragma unroll
          for (int j = 0; j < 8; ++j) VT[(spart * 8 + j) * 16 + stt] = f2bf(v[j]);
        } else if (g == 3) {
#pragma unroll
          for (int j = 0; j < 8; ++j) v[j] = fast_tanh(v[j]);
          *(uint4*)(TW + o) = pack8(v);
        } else *(uint4*)(AD + o) = pack8(v);
      }
    }
    HSYNC();
    if (cidx + 1 < 144) RW_LOAD(cidx + 1)
    {
      const u16* IN = wi == 0 ? TW : AD;
      bf16x8 af0 = *(const bf16x8*)(IN + fr * 72 + fq * 8);
      bf16x8 af1 = *(const bf16x8*)(IN + fr * 72 + 32 + fq * 8);
#pragma unroll
      for (int nt = 0; nt < 4; ++nt) {
        f32x4 o4 = (f32x4){0.f, 0.f, 0.f, 0.f};
        o4 = __builtin_amdgcn_mfma_f32_16x16x32_bf16(af0, *(bf16x8*)&bw[0][nt], o4, 0, 0, 0);
        o4 = __builtin_amdgcn_mfma_f32_16x16x32_bf16(af1, *(bf16x8*)&bw[1][nt], o4, 0, 0, 0);
#pragma unroll
        for (int e = 0; e < 4; ++e) {
          const float prev = l0[nt] + o4[e];
          const int t = fq * 4 + e, c = nt * 16 + fr;
          if (wi == 0) LW[t * 64 + c] = -__expf(-softplus(-prev) - 0.5f);
          else AB[t * 72 + c] = f2bf(sigm(prev));
        }
      }
    }
    HSYNC();
    {
      const int c = lane;
      float cum = 0.f;
      if (wi == 0) {
#pragma unroll 4
        for (int t = 0; t < 16; ++t) {
          const float lw = LW[t * 64 + c];
          const float gp = __expf(cum);
          cum += lw;
          const float gi = __expf(-cum);
          const float kk = bf2f(KK[t * 72 + c]);
          const float a = bf2f(AB[t * 72 + c]);
          KK[t * 72 + c] = f2bf(kk * gp);
          BG[t * 72 + c] = f2bf(kk * a * gi);
        }
        const float gCv = __expf(cum);
        gC[c] = gCv;
#pragma unroll 4
        for (int t = 0; t < 16; ++t) BgCT[c * 16 + t] = f2bf(-bf2f(BG[t * 72 + c]) * gCv);
      } else {
        float* PR = (float*)TW;
        const float kac = p.rw_ka[h * 64 + c], rkc = p.rw_rk[h * 64 + c];
#pragma unroll 4
        for (int t = 0; t < 16; ++t) {
          const float lw = LW[t * 64 + c];
          cum += lw;
          const float g = __expf(cum), gi = __expf(-cum);
          const float r = bf2f(RK[t * 72 + c]);
          const float k = bf2f(KD[t * 72 + c]);
          const float a = bf2f(AB[t * 72 + c]);
          const float kd = k * (1.f + (a - 1.f) * kac);
          RK[t * 72 + c] = f2bf(r * g);
          KD[t * 72 + c] = f2bf(kd * gi);
          PR[t * 64 + c] = r * kd * rkc;
        }
        const float gCv = __expf(cum);
#pragma unroll 4
        for (int t = 0; t < 16; ++t) KgCT[c * 16 + t] = f2bf(bf2f(KD[t * 72 + c]) * gCv);
        lds_wave_sync();
        {
          const int t = lane >> 2, sg = lane & 3;
          const float4 q0 = *(const float4*)(PR + t * 64 + sg * 16), q1 = *(const float4*)(PR + t * 64 + sg * 16 + 4);
          const float4 q2 = *(const float4*)(PR + t * 64 + sg * 16 + 8), q3 = *(const float4*)(PR + t * 64 + sg * 16 + 12);
          float bsum = (q0.x + q0.y + q0.z + q0.w) + (q1.x + q1.y + q1.z + q1.w) + (q2.x + q2.y + q2.z + q2.w) + (q3.x + q3.y + q3.z + q3.w);
          bsum += __shfl_xor(bsum, 1, 64);
          bsum += __shfl_xor(bsum, 2, 64);
          if (seg == 1 && sg == 0) {
            const int sidx = ch * 16 + t;
            const int tpos = d == 0 ? sidx : 2047 - sidx;
            BS[(size_t)(b * 2048 + tpos) * 16 + h * 2 + d] = bsum;
          }
        }
      }
    }
    HSYNC();
    __builtin_amdgcn_sched_barrier(0);
    {
      f32x4 XabT = (f32x4){0.f, 0.f, 0.f, 0.f}, XakT = XabT, XrbT = XabT, XrkT = XabT;
#pragma unroll
      for (int ks = 0; ks < 2; ++ks) {
        bf16x8 kkf = *(const bf16x8*)(KK + fr * 72 + ks * 32 + fq * 8);
        bf16x8 rgf = *(const bf16x8*)(RK + fr * 72 + ks * 32 + fq * 8);
        bf16x8 bgf = *(const bf16x8*)(BG + fr * 72 + ks * 32 + fq * 8);
        bf16x8 kgf = *(const bf16x8*)(KD + fr * 72 + ks * 32 + fq * 8);
        XabT = __builtin_amdgcn_mfma_f32_16x16x32_bf16(bgf, kkf, XabT, 0, 0, 0);
        XakT = __builtin_amdgcn_mfma_f32_16x16x32_bf16(kgf, kkf, XakT, 0, 0, 0);
        XrbT = __builtin_amdgcn_mfma_f32_16x16x32_bf16(bgf, rgf, XrbT, 0, 0, 0);
        XrkT = __builtin_amdgcn_mfma_f32_16x16x32_bf16(kgf, rgf, XrkT, 0, 0, 0);
      }
      {
        float am[4];
#pragma unroll
        for (int e = 0; e < 4; ++e) am[e] = (fq * 4 + e < fr) ? XabT[e] : 0.f;
        *(float4*)(Amat + fr * 16 + fq * 4) = make_float4(am[0], am[1], am[2], am[3]);
      }
      lds_wave_sync();
      if (lane < 16) {
        float x[16];
        x[0] = (lane == 0) ? 1.f : 0.f;
        float4 cur[4], nxt[4];
        cur[0] = *(const float4*)(Amat + 16);
        cur[1] = cur[0]; cur[2] = cur[0]; cur[3] = cur[0];
#pragma unroll
        for (int i = 1; i < 16; ++i) {
          __builtin_amdgcn_sched_barrier(0);
          if (i + 1 < 16) {
#pragma unroll
            for (int q = 0; q < (i + 4) / 4; ++q) nxt[q] = *(const float4*)(Amat + (i + 1) * 16 + q * 4);
          }
          float acc = (i == lane) ? 1.f : 0.f;
#pragma unroll
          for (int j = 0; j < i; ++j) {
            const float4 rv = cur[j >> 2];
            const float av = (j & 3) == 0 ? rv.x : ((j & 3) == 1 ? rv.y : ((j & 3) == 2 ? rv.z : rv.w));
            acc -= av * x[j];
          }
          x[i] = acc;
#pragma unroll
          for (int q = 0; q < 4; ++q) cur[q] = nxt[q];
        }
#pragma unroll
        for (int i = 0; i < 16; ++i) Tinv[i * 16 + lane] = f2bf(x[i]);
      }
      lds_wave_sync();
      f32x4 sa0[2], y0[2];
#pragma unroll
      for (int nt = 0; nt < 2; ++nt) { sa0[nt] = (f32x4){0.f, 0.f, 0.f, 0.f}; y0[nt] = (f32x4){0.f, 0.f, 0.f, 0.f}; }
#pragma unroll
      for (int x = 0; x < 2; ++x) {
        __builtin_amdgcn_sched_barrier(0);
        uint2 k0 = *(const uint2*)(KK + fr * 72 + 32 * x + fq * 4);
        uint2 k1 = *(const uint2*)(KK + fr * 72 + 32 * x + 16 + fq * 4);
        uint2 r0 = *(const uint2*)(RK + fr * 72 + 32 * x + fq * 4);
        uint2 r1 = *(const uint2*)(RK + fr * 72 + 32 * x + 16 + fq * 4);
        uint4 kw = make_uint4(k0.x, k0.y, k1.x, k1.y);
        uint4 rw = make_uint4(r0.x, r0.y, r1.x, r1.y);
#pragma unroll
        for (int nt = 0; nt < 2; ++nt) {
          uint4 sw;
          sw.x = pack2(S[2 * x][nt][0], S[2 * x][nt][1]); sw.y = pack2(S[2 * x][nt][2], S[2 * x][nt][3]);
          sw.z = pack2(S[2 * x + 1][nt][0], S[2 * x + 1][nt][1]); sw.w = pack2(S[2 * x + 1][nt][2], S[2 * x + 1][nt][3]);
          sa0[nt] = __builtin_amdgcn_mfma_f32_16x16x32_bf16(*(bf16x8*)&kw, *(bf16x8*)&sw, sa0[nt], 0, 0, 0);
          y0[nt] = __builtin_amdgcn_mfma_f32_16x16x32_bf16(*(bf16x8*)&rw, *(bf16x8*)&sw, y0[nt], 0, 0, 0);
        }
      }
      float ak[4], rb[4], rk[4];
#pragma unroll
      for (int e = 0; e < 4; ++e) {
        const int j = fq * 4 + e;
        ak[e] = (j < fr) ? XakT[e] : 0.f;
        rb[e] = (j <= fr) ? -XrbT[e] : 0.f;
        rk[e] = (j <= fr) ? XrkT[e] : 0.f;
      }
      const uint4 akw = make_uint4(pack2(ak[0], ak[1]), pack2(ak[2], ak[3]), 0u, 0u);
      const uint4 ybw = make_uint4(pack2(rb[0], rb[1]), pack2(rb[2], rb[3]), pack2(rk[0], rk[1]), pack2(rk[2], rk[3]));
      const uint2 tv = *(const uint2*)(Tinv + fr * 16 + fq * 4);
      const uint4 tw = make_uint4(tv.x, tv.y, 0u, 0u);
      uint4 sv[2];
#pragma unroll
      for (int nt = 0; nt < 2; ++nt) {
        const int vc = wi * 32 + nt * 16 + fr;
        const uint2 vt = *(const uint2*)(VT + vc * 16 + fq * 4);
        const uint4 vb = make_uint4(vt.x, vt.y, 0u, 0u);
        f32x4 rhs = __builtin_amdgcn_mfma_f32_16x16x32_bf16(*(bf16x8*)&akw, *(bf16x8*)&vb, sa0[nt], 0, 0, 0);
        const uint4 rw = make_uint4(pack2(rhs[0], rhs[1]), pack2(rhs[2], rhs[3]), 0u, 0u);
        f32x4 sa = __builtin_amdgcn_mfma_f32_16x16x32_bf16(*(bf16x8*)&tw, *(bf16x8*)&rw, (f32x4){0.f, 0.f, 0.f, 0.f}, 0, 0, 0);
        sv[nt] = make_uint4(pack2(sa[0], sa[1]), pack2(sa[2], sa[3]), vt.x, vt.y);
        f32x4 y = __builtin_amdgcn_mfma_f32_16x16x32_bf16(*(bf16x8*)&ybw, *(bf16x8*)&sv[nt], y0[nt], 0, 0, 0);
        if (seg == 1) {
#pragma unroll
          for (int e = 0; e < 4; ++e) {
            const int sidx = ch * 16 + fq * 4 + e;
            const int tpos = d == 0 ? sidx : 2047 - sidx;
            O4[((size_t)d * NLAT + b * 2048 + tpos) * 512 + h * 64 + vc] = f2bf(y[e]);
          }
        }
      }
#pragma unroll
      for (int mt = 0; mt < 4; ++mt) {
        __builtin_amdgcn_sched_barrier(0);
        const float4 g4 = *(const float4*)(gC + mt * 16 + fq * 4);
        const uint2 bv = *(const uint2*)(BgCT + (mt * 16 + fr) * 16 + fq * 4);
        const uint2 kv = *(const uint2*)(KgCT + (mt * 16 + fr) * 16 + fq * 4);
        const uint4 aw = make_uint4(bv.x, bv.y, kv.x, kv.y);
#pragma unroll
        for (int nt = 0; nt < 2; ++nt) {
          S[mt][nt][0] *= g4.x; S[mt][nt][1] *= g4.y; S[mt][nt][2] *= g4.z; S[mt][nt][3] *= g4.w;
          S[mt][nt] = __builtin_amdgcn_mfma_f32_16x16x32_bf16(*(bf16x8*)&aw, *(bf16x8*)&sv[nt], S[mt][nt], 0, 0, 0);
        }
      }
    }
    HSYNC();
  }
#undef RW_LOAD
}

DEV void gdn_item(const Params& p, int gi, char* smem) {
  const u16* P = (const u16*)(p.ws + OFF_BIG);
  u16* O4 = (u16*)p.out;
  const int tid0 = VTID;
  const int b = gi >> 3, d = (gi >> 2) & 1, h = gi & 3;
  constexpr int BUFB = 23424;
  f32x4 S[8][2];
#pragma unroll
  for (int i = 0; i < 8; ++i)
#pragma unroll
    for (int j = 0; j < 2; ++j) S[i][j] = (f32x4){0.f, 0.f, 0.f, 0.f};
  const float negA = -__expf(p.dn_A_log[d * 4 + h]);
  const float dtb = p.dn_dt_bias[d * 4 + h];
  uint4 pre[3][3];
  float gpre0 = 0.f, gpre1 = 0.f;
#define GDN_LOAD(CI)                                                                               \
  {                                                                                                \
    const int seg_ = (CI) < 16 ? 0 : 1;                                                            \
    const int ch_ = seg_ ? (CI)-16 : (CI);                                                         \
    const int Ls_ = seg_ ? 2048 : 256;                                                             \
    const int rb_ = seg_ ? b * 2048 : NLAT + b * 256;                                              \
    const int sidx_ = ch_ * 16 + stt;                                                              \
    const int t_ = d == 0 ? sidx_ : Ls_ - 1 - sidx_;                                               \
    const u16* prow_ = P + (size_t)(rb_ + t_) * PS1 + DNO;                                         \
    _Pragma("unroll") for (int g = 0; g < 3; ++g) {                                                \
      const int col_ = g * 512 + h * 128 + spart * 8;                                              \
      _Pragma("unroll") for (int tap = 0; tap < 3; ++tap) {                                        \
        const int tt_ = t_ + tap - 1;                                                              \
        if (tt_ >= 0 && tt_ < Ls_) pre[g][tap] = *(const uint4*)(prow_ + (ptrdiff_t)(tap - 1) * PS1 + col_); \
        else pre[g][tap] = make_uint4(0u, 0u, 0u, 0u);                                             \
      }                                                                                            \
    }                                                                                              \
    if (wave == 0) {                                                                               \
      const int s2_ = ch_ * 16 + fr;                                                               \
      const int t2_ = d == 0 ? s2_ : Ls_ - 1 - s2_;                                                \
      const u16* gr_ = P + (size_t)(rb_ + t2_) * PS1 + DNO + 2048;                                 \
      gpre0 = bf2f(gr_[d * 4 + h]);                                                                \
      gpre1 = bf2f(gr_[8 + d * 4 + h]);                                                            \
    }                                                                                              \
  }
  {
    const int tid = tid0, lane = tid & 63, wave = tid >> 6, fr = lane & 15, stt = tid >> 4, spart = tid & 15;
    GDN_LOAD(0)
  }
  for (int cidx = 0; cidx < 144; ++cidx) {
    asm volatile("" ::: "memory");
    int tid = tid0;
    asm volatile("" : "+v"(tid));
    const int lane = tid & 63, wave = tid >> 6, fr = lane & 15, fq = lane >> 4, stt = tid >> 4, spart = tid & 15;
    char* buf = smem;
    u16* Kb = (u16*)buf;
    u16* Qb = Kb + 16 * 136;
    float* Vf = (float*)(buf + 8704);
    u16* KdT = (u16*)(buf + 17152);
    u16* Tinv = (u16*)(buf + 21248);
    u16* Pm = (u16*)(buf + 21760);
    float* Amat = (float*)(buf + 22272);
    float* Gs = (float*)(buf + 23296);
    float* Bs = Gs + 16;
#pragma unroll
    for (int g = 0; g < 3; ++g) {
      __builtin_amdgcn_sched_barrier(0);
      const int col = g * 512 + h * 128 + spart * 8;
      float z[8];
#pragma unroll
      for (int j = 0; j < 8; ++j) z[j] = 0.f;
#pragma unroll
      for (int tap = 0; tap < 3; ++tap) {
        __builtin_amdgcn_sched_barrier(0);
        float f[8];
        unpack8(pre[g][tap], f);
        const float* w = p.dn_conv + tap * 1536 + col;
        float4 w0 = *(const float4*)w, w1 = *(const float4*)(w + 4);
        z[0] += f[0] * w0.x; z[1] += f[1] * w0.y; z[2] += f[2] * w0.z; z[3] += f[3] * w0.w;
        z[4] += f[4] * w1.x; z[5] += f[5] * w1.y; z[6] += f[6] * w1.z; z[7] += f[7] * w1.w;
      }
      float ss = 0.f;
#pragma unroll
      for (int j = 0; j < 8; ++j) { z[j] = silu(z[j]); ss += z[j] * z[j]; }
      if (g < 2) {
        ss += __shfl_xor(ss, 1, 64); ss += __shfl_xor(ss, 2, 64); ss += __shfl_xor(ss, 4, 64); ss += __shfl_xor(ss, 8, 64);
        float sc = rsqrtf(ss + 1e-6f);
        if (g == 0) sc *= 0.08838834764831845f;
#pragma unroll
        for (int j = 0; j < 8; ++j) z[j] *= sc;
        *(uint4*)((g == 0 ? Qb : Kb) + stt * 136 + spart * 8) = pack8(z);
      } else {
        float* dst = Vf + stt * 132 + spart * 8;
        *(float4*)dst = make_float4(z[0], z[1], z[2], z[3]);
        *(float4*)(dst + 4) = make_float4(z[4], z[5], z[6], z[7]);
      }
    }
    if (wave == 0) {
      float g = negA * softplus(gpre0 + dtb);
#pragma unroll
      for (int o = 1; o < 16; o <<= 1) { float n = __shfl_up(g, o, 16); if (fr >= o) g += n; }
      if (lane < 16) { Gs[lane] = g; Bs[lane] = sigm(gpre1); }
    }
    HSYNC();
    if (wave == 0) {
      f32x4 kk = (f32x4){0.f, 0.f, 0.f, 0.f};
#pragma unroll
      for (int ks = 0; ks < 4; ++ks) {
        bf16x8 kf = *(const bf16x8*)(Kb + fr * 136 + ks * 32 + fq * 8);
        kk = __builtin_amdgcn_mfma_f32_16x16x32_bf16(kf, kf, kk, 0, 0, 0);
      }
      const float Gj = Gs[fr];
#pragma unroll
      for (int e = 0; e < 4; ++e) {
        const int i = fq * 4 + e;
        const float a = (fr < i) ? Bs[i] * kk[e] * __expf(Gs[i] - Gj) : 0.f;
        Amat[i * 16 + fr] = a;
      }
      lds_wave_sync();
      if (lane < 16) {
        float x[16];
        x[0] = (lane == 0) ? 1.f : 0.f;
        float4 cur[4], nxt[4];
        cur[0] = *(const float4*)(Amat + 16);
        cur[1] = cur[0]; cur[2] = cur[0]; cur[3] = cur[0];
#pragma unroll
        for (int i = 1; i < 16; ++i) {
          __builtin_amdgcn_sched_barrier(0);
          if (i + 1 < 16) {
#pragma unroll
            for (int q = 0; q < (i + 4) / 4; ++q) nxt[q] = *(const float4*)(Amat + (i + 1) * 16 + q * 4);
          }
          float acc = (i == lane) ? 1.f : 0.f;
#pragma unroll
          for (int j = 0; j < i; ++j) {
            const float4 rv = cur[j >> 2];
            const float av = (j & 3) == 0 ? rv.x : ((j & 3) == 1 ? rv.y : ((j & 3) == 2 ? rv.z : rv.w));
            acc -= av * x[j];
          }
          x[i] = acc;
#pragma unroll
          for (int q = 0; q < 4; ++q) cur[q] = nxt[q];
        }
#pragma unroll
        for (int i = 0; i < 16; ++i) Tinv[i * 16 + lane] = f2bf(x[i]);
      }
    } else if (wave == 1) {
      f32x4 qk = (f32x4){0.f, 0.f, 0.f, 0.f};
#pragma unroll
      for (int ks = 0; ks < 4; ++ks) {
        bf16x8 qf = *(const bf16x8*)(Qb + fr * 136 + ks * 32 + fq * 8);
        bf16x8 kf = *(const bf16x8*)(Kb + fr * 136 + ks * 32 + fq * 8);
        qk = __builtin_amdgcn_mfma_f32_16x16x32_bf16(qf, kf, qk, 0, 0, 0);
      }
      const float Gj = Gs[fr];
#pragma unroll
      for (int e = 0; e < 4; ++e) {
        const int t = fq * 4 + e;
        const float v = (fr <= t) ? qk[e] * __expf(Gs[t] - Gj) : 0.f;
        Pm[t * 16 + fr] = f2bf(v);
      }
    } else {
      const int k = tid - 128;
      const float GC = Gs[15];
      unsigned w[8];
#pragma unroll
      for (int j = 0; j < 8; ++j) {
        __builtin_amdgcn_sched_barrier(0);
        float v0 = bf2f(Kb[(2 * j) * 136 + k]) * __expf(GC - Gs[2 * j]);
        float v1 = bf2f(Kb[(2 * j + 1) * 136 + k]) * __expf(GC - Gs[2 * j + 1]);
        w[j] = pack2(v0, v1);
      }
      *(uint4*)(KdT + k * 16) = make_uint4(w[0], w[1], w[2], w[3]);
      *(uint4*)(KdT + k * 16 + 8) = make_uint4(w[4], w[5], w[6], w[7]);
    }
    __builtin_amdgcn_sched_barrier(0);
    f32x4 ksv[2], qsv[2];
#pragma unroll
    for (int nt = 0; nt < 2; ++nt) { ksv[nt] = (f32x4){0.f, 0.f, 0.f, 0.f}; qsv[nt] = (f32x4){0.f, 0.f, 0.f, 0.f}; }
#pragma unroll
    for (int x = 0; x < 4; ++x) {
      __builtin_amdgcn_sched_barrier(0);
      uint2 k0 = *(const uint2*)(Kb + fr * 136 + 32 * x + fq * 4);
      uint2 k1 = *(const uint2*)(Kb + fr * 136 + 32 * x + 16 + fq * 4);
      uint2 q0 = *(const uint2*)(Qb + fr * 136 + 32 * x + fq * 4);
      uint2 q1 = *(const uint2*)(Qb + fr * 136 + 32 * x + 16 + fq * 4);
      uint4 kw = make_uint4(k0.x, k0.y, k1.x, k1.y);
      uint4 qw = make_uint4(q0.x, q0.y, q1.x, q1.y);
#pragma unroll
      for (int nt = 0; nt < 2; ++nt) {
        uint4 sw;
        sw.x = pack2(S[2 * x][nt][0], S[2 * x][nt][1]); sw.y = pack2(S[2 * x][nt][2], S[2 * x][nt][3]);
        sw.z = pack2(S[2 * x + 1][nt][0], S[2 * x + 1][nt][1]); sw.w = pack2(S[2 * x + 1][nt][2], S[2 * x + 1][nt][3]);
        ksv[nt] = __builtin_amdgcn_mfma_f32_16x16x32_bf16(*(bf16x8*)&kw, *(bf16x8*)&sw, ksv[nt], 0, 0, 0);
        qsv[nt] = __builtin_amdgcn_mfma_f32_16x16x32_bf16(*(bf16x8*)&qw, *(bf16x8*)&sw, qsv[nt], 0, 0, 0);
      }
    }
    HSYNC();
    if (cidx + 1 < 144) GDN_LOAD(cidx + 1)
    __builtin_amdgcn_sched_barrier(0);
    {
      const int seg = cidx < 16 ? 0 : 1;
      const int ch = seg ? cidx - 16 : cidx;
      float eG[4], bt[4];
#pragma unroll
      for (int e = 0; e < 4; ++e) { eG[e] = __expf(Gs[fq * 4 + e]); bt[e] = Bs[fq * 4 + e]; }
      const float eGC = __expf(Gs[15]);
      uint2 tv = *(const uint2*)(Tinv + fr * 16 + fq * 4);
      uint2 pv = *(const uint2*)(Pm + fr * 16 + fq * 4);
      uint4 tw = make_uint4(tv.x, tv.y, 0u, 0u);
      uint4 pw = make_uint4(pv.x, pv.y, 0u, 0u);
      uint4 ub[2];
#pragma unroll
      for (int nt = 0; nt < 2; ++nt) {
        const int vc = wave * 32 + nt * 16 + fr;
        float rhs[4];
#pragma unroll
        for (int e = 0; e < 4; ++e) rhs[e] = bt[e] * (Vf[(fq * 4 + e) * 132 + vc] - eG[e] * ksv[nt][e]);
        uint4 rw = make_uint4(pack2(rhs[0], rhs[1]), pack2(rhs[2], rhs[3]), 0u, 0u);
        f32x4 u = __builtin_amdgcn_mfma_f32_16x16x32_bf16(*(bf16x8*)&tw, *(bf16x8*)&rw, (f32x4){0.f, 0.f, 0.f, 0.f}, 0, 0, 0);
        ub[nt] = make_uint4(pack2(u[0], u[1]), pack2(u[2], u[3]), 0u, 0u);
        f32x4 oa;
#pragma unroll
        for (int e = 0; e < 4; ++e) oa[e] = eG[e] * qsv[nt][e];
        oa = __builtin_amdgcn_mfma_f32_16x16x32_bf16(*(bf16x8*)&pw, *(bf16x8*)&ub[nt], oa, 0, 0, 0);
        if (seg == 1) {
#pragma unroll
          for (int e = 0; e < 4; ++e) {
            const int sidx = ch * 16 + fq * 4 + e;
            const int t = d == 0 ? sidx : 2047 - sidx;
            O4[((size_t)(2 + d) * NLAT + b * 2048 + t) * 512 + h * 128 + vc] = f2bf(oa[e]);
          }
        }
      }
#pragma unroll
      for (int mt = 0; mt < 8; ++mt) {
        __builtin_amdgcn_sched_barrier(0);
        uint2 kv = *(const uint2*)(KdT + (mt * 16 + fr) * 16 + fq * 4);
        uint4 kw = make_uint4(kv.x, kv.y, 0u, 0u);
#pragma unroll
        for (int nt = 0; nt < 2; ++nt) {
#pragma unroll
          for (int e = 0; e < 4; ++e) S[mt][nt][e] *= eGC;
          S[mt][nt] = __builtin_amdgcn_mfma_f32_16x16x32_bf16(*(bf16x8*)&kw, *(bf16x8*)&ub[nt], S[mt][nt], 0, 0, 0);
        }
      }
    }
    HSYNC();
  }
#undef GDN_LOAD
}

DEV void phase_scans(const Params& p, char* smem) {
#pragma unroll 1
  for (int it = VBID; it < 512; it += VNB)
    if (it & 1) rwkv_item(p, it >> 1, smem);
  __builtin_amdgcn_sched_barrier(0);
#pragma unroll 1
  for (int it = VBID; it < 512; it += VNB)
    if (!(it & 1)) gdn_item(p, it >> 1, smem);
}

DEV void mixout_item(const Params& p, int it, char* smem) {
  const u16* P = (const u16*)(p.ws + OFF_BIG);
  const u16* O4 = (const u16*)p.out;
  const float* BS = (const float*)(p.ws + OFF_BSUM);
  const u16* G2T = (const u16*)(p.ws + OFF_G2T);
  u16* Y = (u16*)(p.ws + OFF_HY);
  u16* sg = (u16*)smem;
  u16* G = sg + 32 * 136;
  const int tid = VTID, lane = tid & 63, wave = tid >> 6;
  const int fr = lane & 15, fq = lane >> 4;
  const int tok0 = it * 32, tl0 = tok0 & 2047;
  const int tk = tid >> 3, part = tid & 7;
  const int row = tok0 + tk, t = tl0 + tk;
  const bool hasp = t > 0, hasn = t + 1 < 2048;
  const u16* prow = P + (size_t)row * PS1;
  {
#pragma unroll
    for (int q = 0; q < 2; ++q) {
      const int col = 1792 + part * 16 + q * 8;
      float pc[8], pp[8], pn[8], v[8];
      unpack8(*(const uint4*)(prow + col), pc);
      if (hasp) unpack8(*(const uint4*)(prow - PS1 + col), pp);
      else {
#pragma unroll
        for (int j = 0; j < 8; ++j) pp[j] = 0.f;
      }
      if (hasn) unpack8(*(const uint4*)(prow + PS1 + col), pn);
      else {
#pragma unroll
        for (int j = 0; j < 8; ++j) pn[j] = 0.f;
      }
      const float* mu = p.rw_mu + col;
#pragma unroll
      for (int j = 0; j < 8; ++j) v[j] = sigm(pc[j] + mu[j] * (0.5f * (pp[j] + pn[j]) - pc[j]));
      *(uint4*)(sg + tk * 136 + part * 16 + q * 8) = pack8(v);
    }
  }
  HSYNC();
  {
    bf16x8 af[2][4];
#pragma unroll
    for (int mt = 0; mt < 2; ++mt)
#pragma unroll
      for (int ks = 0; ks < 4; ++ks) af[mt][ks] = *(const bf16x8*)(sg + (mt * 16 + fr) * 136 + ks * 32 + fq * 8);
#pragma unroll
    for (int nt = 0; nt < 8; ++nt) {
      const u16* bp = G2T + (size_t)(wave * 128 + nt * 16 + fr) * 128 + fq * 8;
      bf16x8 bf0 = *(const bf16x8*)(bp), bf1 = *(const bf16x8*)(bp + 32), bf2 = *(const bf16x8*)(bp + 64), bf3 = *(const bf16x8*)(bp + 96);
#pragma unroll
      for (int mt = 0; mt < 2; ++mt) {
        f32x4 a = (f32x4){0.f, 0.f, 0.f, 0.f};
        a = __builtin_amdgcn_mfma_f32_16x16x32_bf16(af[mt][0], bf0, a, 0, 0, 0);
        a = __builtin_amdgcn_mfma_f32_16x16x32_bf16(af[mt][1], bf1, a, 0, 0, 0);
        a = __builtin_amdgcn_mfma_f32_16x16x32_bf16(af[mt][2], bf2, a, 0, 0, 0);
        a = __builtin_amdgcn_mfma_f32_16x16x32_bf16(af[mt][3], bf3, a, 0, 0, 0);
#pragma unroll
        for (int e = 0; e < 4; ++e) G[(mt * 16 + fq * 4 + e) * 520 + wave * 128 + nt * 16 + fr] = f2bf(a[e]);
      }
    }
  }
  HSYNC();
  {
    const int hd = part, c0 = hd * 64;
    const u16* of = O4 + (size_t)row * 512 + c0;
    const u16* ob = O4 + ((size_t)NLAT + row) * 512 + c0;
    const float bsum = BS[(size_t)row * 16 + hd * 2] + BS[(size_t)row * 16 + hd * 2 + 1];
    float s1 = 0.f, s2 = 0.f;
#pragma unroll
    for (int q = 0; q < 8; ++q) {
      float a[8], b8[8];
      unpack8(*(const uint4*)(of + q * 8), a);
      unpack8(*(const uint4*)(ob + q * 8), b8);
#pragma unroll
      for (int j = 0; j < 8; ++j) { const float v = a[j] + b8[j]; s1 += v; s2 += v * v; }
    }
    const float mean = s1 * (1.f / 64.f);
    const float var = fmaxf(s2 * (1.f / 64.f) - mean * mean, 0.f);
    const float rs = rsqrtf(var + 64e-5f);
#pragma unroll
    for (int q = 0; q < 8; ++q) {
      const int c = c0 + q * 8;
      float pc[8], pp[8], pn[8], gv[8], o[8], ya[8], yb[8];
      unpack8(*(const uint4*)(of + q * 8), ya);
      unpack8(*(const uint4*)(ob + q * 8), yb);
      unpack8(*(const uint4*)(prow + 1024 + c), pc);
      if (hasp) unpack8(*(const uint4*)(prow - PS1 + 1024 + c), pp);
      else {
#pragma unroll
        for (int j = 0; j < 8; ++j) pp[j] = 0.f;
      }
      if (hasn) unpack8(*(const uint4*)(prow + PS1 + 1024 + c), pn);
      else {
#pragma unroll
        for (int j = 0; j < 8; ++j) pn[j] = 0.f;
      }
      unpack8(*(const uint4*)(G + tk * 520 + c), gv);
      const float* mu = p.rw_mu + 1024 + c;
      const float* gg = p.rw_lnx_g + c;
      const float* gb = p.rw_lnx_b + c;
#pragma unroll
      for (int j = 0; j < 8; ++j) {
        const float vsh = pc[j] + mu[j] * (0.5f * (pp[j] + pn[j]) - pc[j]);
        const float yn = (ya[j] + yb[j] - mean) * rs * gg[j] + gb[j];
        o[j] = (yn + bsum * vsh) * gv[j];
      }
      *(uint4*)(Y + (size_t)row * 1024 + c) = pack8(o);
    }
  }
  {
    const int c0 = part * 64;
    const u16* of = O4 + ((size_t)2 * NLAT + row) * 512 + c0;
    const u16* ob = O4 + ((size_t)3 * NLAT + row) * 512 + c0;
    float s2 = 0.f;
#pragma unroll
    for (int q = 0; q < 8; ++q) {
      float a[8], b8[8];
      unpack8(*(const uint4*)(of + q * 8), a);
      unpack8(*(const uint4*)(ob + q * 8), b8);
#pragma unroll
      for (int j = 0; j < 8; ++j) { const float v = a[j] + b8[j]; s2 += v * v; }
    }
    s2 += __shfl_xor(s2, 1, 64);
    const float rs = rsqrtf(s2 * (1.f / 128.f) + 1e-6f);
    const u16* zr = prow + DNO + 1536 + c0;
    const float* ng = p.dn_norm_g + (part & 1) * 64;
#pragma unroll
    for (int q = 0; q < 8; ++q) {
      float z[8], r8[8], a[8], b8[8];
      unpack8(*(const uint4*)(of + q * 8), a);
      unpack8(*(const uint4*)(ob + q * 8), b8);
      unpack8(*(const uint4*)(zr + q * 8), z);
#pragma unroll
      for (int j = 0; j < 8; ++j) r8[j] = (a[j] + b8[j]) * rs * ng[q * 8 + j] * silu(z[j]);
      *(uint4*)(Y + (size_t)row * 1024 + 512 + c0 + q * 8) = pack8(r8);
    }
  }
  HSYNC();
}

#define XB_TMO      128
#define XB_XCNT(j)  (256  + 64 * (j))
#define XB_XSUB(j)  (1280 + 64 * (j))
#define XB_XGEN(j)  (2304 + 64 * (j))
#define XB_TOP      3328
#define XB_TOPGEN   3392
#define XCD_BAR_WORDS 3456
#define XB_SPIN_CAP (1u << 20)
DEV unsigned xb_ld(unsigned* p) { return __hip_atomic_load(p, __ATOMIC_RELAXED, __HIP_MEMORY_SCOPE_AGENT); }
DEV unsigned xb_add(unsigned* p, unsigned v) { return __hip_atomic_fetch_add(p, v, __ATOMIC_RELAXED, __HIP_MEMORY_SCOPE_AGENT); }
DEV unsigned xb_xcc_id() { return (unsigned)__builtin_amdgcn_s_getreg((3 << 11) | 20) & 0xFu; }
#define XB_SPIN(cond, bar) do { unsigned _sp = 0; while (cond) { __builtin_amdgcn_s_sleep(1); \
    if ((++_sp & 255u) == 0u) { if (xb_ld(&(bar)[XB_TMO])) break; if (_sp > XB_SPIN_CAP) { atomicAdd(&(bar)[XB_TMO], 1u); break; } } } } while (0)
DEV void xcd_barrier_complete(unsigned* bar, unsigned x, unsigned& nloc, unsigned& nx) {
  const unsigned G = gridDim.x;
  unsigned sum, cnt, mine, sp = 0u;
  for (;;) {
    sum = 0u; cnt = 0u; mine = 0u;
#pragma unroll
    for (unsigned j = 0; j < 16; ++j) { const unsigned c = xb_ld(&bar[XB_XCNT(j)]); sum += c; cnt += (c > 0u) ? 1u : 0u; mine = (j == x) ? c : mine; }
    if (sum == G) break;
    __builtin_amdgcn_s_sleep(1);
    if ((++sp & 255u) == 0u) { if (xb_ld(&bar[XB_TMO])) break; if (sp > XB_SPIN_CAP) { atomicAdd(&bar[XB_TMO], 1u); break; } }
  }
  nloc = mine > 0u ? mine : 1u; nx = cnt > 0u ? cnt : 1u;
}
DEV void xcd_barrier(unsigned* bar) {
  asm volatile("s_waitcnt vmcnt(0)" ::: "memory");
  __syncthreads();
  if (threadIdx.x == 0) {
    __builtin_amdgcn_s_waitcnt(0);
    const unsigned x = xb_xcc_id();
    volatile LAS unsigned* st = (volatile LAS unsigned*)(dyn_smem + HS_OFF + 128);
    unsigned nloc = st[0], nx = st[1];
    if (nloc == 0u) { xcd_barrier_complete(bar, x, nloc, nx); st[0] = nloc; st[1] = nx; }
    const unsigned old = xb_add(&bar[XB_XSUB(x)], 1u);
    const unsigned gen = old / nloc;
    if (old + 1u == (gen + 1u) * nloc) {
      __builtin_amdgcn_fence(__ATOMIC_RELEASE, "agent");
      asm volatile("s_waitcnt vmcnt(0)" ::: "memory");
      const unsigned og = xb_add(&bar[XB_TOP], 1u);
      const unsigned tg = og / nx;
      if (og + 1u == (tg + 1u) * nx) xb_add(&bar[XB_TOPGEN], 1u);
      else XB_SPIN(xb_ld(&bar[XB_TOPGEN]) == tg, bar);
      __builtin_amdgcn_fence(__ATOMIC_ACQUIRE, "agent");
      xb_add(&bar[XB_XGEN(x)], 1u);
      asm volatile("s_waitcnt vmcnt(0)" ::: "memory");
    } else {
      XB_SPIN(xb_ld(&bar[XB_XGEN(x)]) == gen, bar);
      __builtin_amdgcn_fence(__ATOMIC_ACQUIRE, "agent");
      asm volatile("s_waitcnt vmcnt(0)" ::: "memory");
    }
  }
  __syncthreads();
}

constexpr int NPHASE = 18;

__global__ void __launch_bounds__(512, 2) mega(Params p, int ph_lo, int ph_hi) {
  char* smem = dyn_smem + VHALF * HALF_LDS;
  if ((threadIdx.x & 255) == 0) *((LAS unsigned*)(dyn_smem + HS_OFF) + (threadIdx.x >> 8) * 16) = 0u;
  __syncthreads();
  cg::grid_group grid = cg::this_grid();
  const float* mv0 = (const float*)(p.ws + OFF_MODV);
  const float* mv1 = mv0 + 33 * 6144;
  u16* X = (u16*)(p.ws + OFF_X);
  u16* HY = (u16*)(p.ws + OFF_HY);
  u16* BIG = (u16*)(p.ws + OFF_BIG);
  unsigned* bar = (unsigned*)(p.ws + OFF_BAR);
  if (threadIdx.x == 0) {
    volatile LAS unsigned* st = (volatile LAS unsigned*)(dyn_smem + HS_OFF + 128);
    st[0] = 0u; st[1] = 0u;
    (void)xb_add(&bar[XB_XCNT(xb_xcc_id())], 1u);
  }
  if (ph_hi < 0) grid.sync();
#define PHASE(n, BODY) if (ph_lo <= (n) && (n) < ph_hi) { BODY; if ((n) + 1 < ph_hi) xcd_barrier(bar); }
  PHASE(0, phase_prep(p, smem))
  PHASE(1, phase_init(p))
  PHASE(2, gemm_phase<0>(HY, 1024, (const u16*)(p.ws + OFF_WIN0), 1024, NTOK, 2304, BIG, PS0, nullptr, dyn_smem))
  PHASE(3, phase_hyprep_rope(p, smem))
  PHASE(4, phase_conv_attn(p, smem))
  PHASE(5, gemm_phase<2>(HY, 1024, (const u16*)(p.ws + OFF_WOUT0), 1024, NTOK, 1024, X, 1024, mv0 + 2 * 1024, dyn_smem))
  PHASE(6, ln_phase<false>(p, NTOK, p.ln_g, p.ln_b, mv0, 3, 4))
  PHASE(7, gemm_phase<1>(HY, 1024, (const u16*)(p.ws + OFF_W1_0), 1024, NTOK, 4096, BIG, 4096, nullptr, dyn_smem))
  PHASE(8, gemm_phase<2>(BIG, 4096, (const u16*)(p.ws + OFF_W2_0), 4096, NTOK, 1024, X, 1024, mv0 + 5 * 1024, dyn_smem))
  PHASE(9, ln_phase<false>(p, NTOK, p.ln_g + 1024, p.ln_b + 1024, mv1, 0, 1))
  PHASE(10, gemm_phase<0>(HY, 1024, (const u16*)(p.ws + OFF_WIN1), 1024, NTOK, 4096, BIG, PS1, nullptr, dyn_smem))
  PHASE(11, phase_scans(p, smem))
  PHASE(12, for (int it = VBID; it < 2048; it += VNB) mixout_item(p, it, smem))
  PHASE(13, gemm_phase<2>(HY, 1024, (const u16*)(p.ws + OFF_WOUT1), 1024, NLAT, 1024, X, 1024, mv1 + 2 * 1024, dyn_smem))
  PHASE(14, ln_phase<false>(p, NLAT, p.ln_g + 2048, p.ln_b + 2048, mv1, 3, 4))
  PHASE(15, gemm_phase<1>(HY, 1024, (const u16*)(p.ws + OFF_W1_1), 1024, NLAT, 4096, BIG, 4096, nullptr, dyn_smem))
  PHASE(16, gemm_phase<2>(BIG, 4096, (const u16*)(p.ws + OFF_W2_1), 4096, NLAT, 1024, X, 1024, mv1 + 5 * 1024, dyn_smem))
  PHASE(17, ln_phase<true>(p, NLAT, p.ln_g + 3072, p.ln_b + 3072, mv1, 0, 1))
}

extern "C" void kernel_launch(void* const* d_in, const int* in_sizes, int n_in, void* d_out, int out_size, void* d_ws,
                              size_t ws_size, hipStream_t stream) {
  static int grid_blocks = 0;
  if (!grid_blocks) {
    int dev = 0, cus = 0, per_cu = 0;
    hipGetDevice(&dev);
    hipDeviceGetAttribute(&cus, hipDeviceAttributeMultiprocessorCount, dev);
    hipFuncSetAttribute((const void*)mega, hipFuncAttributeMaxDynamicSharedMemorySize, LDS_BYTES);
    hipOccupancyMaxActiveBlocksPerMultiprocessor(&per_cu, mega, 512, LDS_BYTES);
    if (per_cu > 1) per_cu = 1;
    if (per_cu < 1) per_cu = 1;
    grid_blocks = cus * per_cu;
  }
  if (ws_size < WS_NEED) fprintf(stderr, "workspace too small: %zu < %zu\n", ws_size, (size_t)WS_NEED);
  Params p{};
  const float** pp = (const float**)&p;
  for (int i = 0; i < 39; ++i) pp[i] = (const float*)d_in[i];
  p.out = (float*)d_out;
  p.ws = (char*)d_ws;
  int lo = 0, hi = NPHASE;
  void* args[] = {&p, &lo, &hi};
  hipMemsetAsync((char*)d_ws + OFF_BAR, 0, XCD_BAR_WORDS * sizeof(unsigned), stream);
  hipError_t e = hipLaunchCooperativeKernel((void*)mega, dim3(grid_blocks), dim3(512), args, LDS_BYTES, stream);
  if (e != hipSuccess) fprintf(stderr, "cooperative launch failed: %s (grid %d)\n", hipGetErrorString(e), grid_blocks);
}
```

```cpp
#include <hip/hip_runtime.h>
#include <hip/hip_cooperative_groups.h>
#include <cstdio>
#include <cstdint>
namespace cg = cooperative_groups;

typedef unsigned short u16;
typedef __attribute__((ext_vector_type(8))) short bf16x8;
typedef __attribute__((ext_vector_type(4))) float f32x4;
typedef __attribute__((ext_vector_type(16))) float f32x16;

#define DEV __device__ __forceinline__

constexpr int NLAT = 65536, NCTX = 8192, NTOK = 73728;
constexpr int PS0 = 2304;
constexpr int PS1 = 4096;
constexpr int DNO = 1920;
constexpr float ALPHA = 1.4142135623730951f;

constexpr size_t OFF_WIN0 = 0;
constexpr size_t OFF_WOUT0 = OFF_WIN0 + (size_t)2304 * 1024 * 2;
constexpr size_t OFF_W1_0 = OFF_WOUT0 + (size_t)1024 * 1024 * 2;
constexpr size_t OFF_W1_1 = OFF_W1_0 + (size_t)4096 * 1024 * 2;
constexpr size_t OFF_W2_0 = OFF_W1_1 + (size_t)4096 * 1024 * 2;
constexpr size_t OFF_W2_1 = OFF_W2_0 + (size_t)4096 * 1024 * 2;
constexpr size_t OFF_WIN1 = OFF_W2_1 + (size_t)4096 * 1024 * 2;
constexpr size_t OFF_WOUT1 = OFF_WIN1 + (size_t)4096 * 1024 * 2;
constexpr size_t OFF_MODV = OFF_WOUT1 + (size_t)1024 * 1024 * 2;
constexpr size_t OFF_KR2048 = OFF_MODV + (size_t)2 * 33 * 6144 * 4;
constexpr size_t OFF_KR256 = OFF_KR2048 + (size_t)512 * 4096 * 2;
constexpr size_t OFF_ROPE = OFF_KR256 + (size_t)512 * 512 * 2;
constexpr size_t OFF_BSUM = OFF_ROPE + 8192;
constexpr size_t OFF_G2T = OFF_BSUM + (size_t)65536 * 16 * 4;
constexpr size_t OFF_BAR = OFF_G2T + (size_t)512 * 128 * 2;
constexpr size_t OFF_X = (size_t)64 << 20;
constexpr size_t OFF_HY = OFF_X + (size_t)NTOK * 1024 * 2;
constexpr size_t OFF_BIG = OFF_HY + (size_t)NTOK * 1024 * 2;
constexpr size_t WS_NEED = OFF_BIG + (size_t)NTOK * 4096 * 2;
static_assert(OFF_BAR + 16384 <= OFF_X, "ws map");
constexpr size_t SO_U = 0;
constexpr size_t SO_X0 = SO_U + (size_t)512 * 32 * 2048 * 2;
constexpr size_t SO_UC = SO_X0 + (size_t)512 * 32 * 2048 * 2;
constexpr size_t SO_X0C = SO_UC + (size_t)512 * 32 * 256 * 2;

struct Params {
  const float *x, *c, *ctx, *c_ctx, *mod_w, *mod_b, *ln_g, *ln_b, *mlp_w1, *mlp_w2, *e_w_in, *e_w_out, *hy_conv,
      *hy_w1, *hy_b1, *hy_w2, *hy_b2, *hy_freq, *hy_w3, *hy_decay, *hy_bias, *attn_sink, *o_w_in, *o_w_out,
      *rw_mu, *rw_w0, *rw_w2, *rw_a0, *rw_a2, *rw_g2, *rw_kk, *rw_ka, *rw_rk, *rw_lnx_g, *rw_lnx_b,
      *dn_conv, *dn_A_log, *dn_dt_bias, *dn_norm_g;
  float* out;
  char* ws;
};

DEV u16 f2bf(float f) { unsigned u = __float_as_uint(f); u += 0x7fffu + ((u >> 16) & 1u); return (u16)(u >> 16); }
DEV float bf2f(u16 h) { return __uint_as_float(((unsigned)h) << 16); }
DEV float bflo(unsigned u) { return __uint_as_float(u << 16); }
DEV float bfhi(unsigned u) { return __uint_as_float(u & 0xffff0000u); }
DEV unsigned pack2(float a, float b) { return (unsigned)f2bf(a) | ((unsigned)f2bf(b) << 16); }
DEV void unpack8(const uint4& v, float* f) {
  f[0] = bflo(v.x); f[1] = bfhi(v.x); f[2] = bflo(v.y); f[3] = bfhi(v.y);
  f[4] = bflo(v.z); f[5] = bfhi(v.z); f[6] = bflo(v.w); f[7] = bfhi(v.w);
}
DEV uint4 pack8(const float* f) {
  uint4 v; v.x = pack2(f[0], f[1]); v.y = pack2(f[2], f[3]); v.z = pack2(f[4], f[5]); v.w = pack2(f[6], f[7]); return v;
}
DEV int modrow(int r) { return r < NLAT ? (r >> 11) : 32; }
DEV float sigm(float x) { return 1.f / (1.f + __expf(-x)); }
DEV float silu(float x) { return x / (1.f + __expf(-x)); }
DEV float softplus(float x) { return fmaxf(x, 0.f) + __logf(1.f + __expf(-fabsf(x))); }
DEV float fast_tanh(float x) { return 1.f - 2.f / (1.f + __expf(2.f * x)); }
DEV float wave_sum(float v) {
#pragma unroll
  for (int o = 32; o > 0; o >>= 1) v += __shfl_xor(v, o, 64);
  return v;
}

extern __shared__ __attribute__((aligned(16))) char dyn_smem[];
#define LAS __attribute__((address_space(3)))
constexpr int HALF_LDS = 65536;
constexpr int HS_OFF = 2 * HALF_LDS;
constexpr int LDS_BYTES = HS_OFF + 256;
#define VTID ((int)(threadIdx.x & 255))
#define VHALF ((int)__builtin_amdgcn_readfirstlane((int)(threadIdx.x >> 8)))
#define VBID ((int)(blockIdx.x * 2 + VHALF))
#define VNB ((int)(gridDim.x * 2))
DEV void hsync() {
  LAS unsigned* cnt = (LAS unsigned*)(dyn_smem + HS_OFF) + VHALF * 16;
  asm volatile("s_waitcnt vmcnt(0) lgkmcnt(0)" ::: "memory");
  unsigned tgt = 0u;
  if ((threadIdx.x & 63) == 0) {
    const unsigned old = __hip_atomic_fetch_add(cnt, 1u, __ATOMIC_RELAXED, __HIP_MEMORY_SCOPE_WORKGROUP);
    tgt = (old & ~3u) + 4u;
  }
  tgt = __builtin_amdgcn_readfirstlane(tgt);
  while (__hip_atomic_load(cnt, __ATOMIC_RELAXED, __HIP_MEMORY_SCOPE_WORKGROUP) < tgt) __builtin_amdgcn_s_sleep(0);
  asm volatile("s_waitcnt lgkmcnt(0)" ::: "memory");
}
#define HSYNC() hsync()

DEV void transpose_tile(const float* __restrict__ src, int K, int N, int Npad, u16* __restrict__ dst, int tile,
                               u16* sm) {
  const int tid = VTID;
  const int ntn = Npad >> 6;
  const int tk = tile / ntn, tn = tile - tk * ntn;
  const int n = tid & 63, kq = tid >> 6;
  const int gn = tn * 64 + n;
#pragma unroll 4
  for (int i = 0; i < 16; ++i) {
    int k = kq + 4 * i;
    float v = (gn < N) ? src[(size_t)(tk * 64 + k) * N + gn] : 0.f;
    sm[n * 66 + k] = f2bf(v);
  }
  HSYNC();
  const int n2 = tid >> 2, q = tid & 3;
  const unsigned* s32 = (const unsigned*)sm + (n2 * 66 + q * 16) / 2;
  uint4 a, b;
  a.x = s32[0]; a.y = s32[1]; a.z = s32[2]; a.w = s32[3];
  b.x = s32[4]; b.y = s32[5]; b.z = s32[6]; b.w = s32[7];
  u16* d = dst + (size_t)(tn * 64 + n2) * K + tk * 64 + q * 16;
  *(uint4*)d = a;
  *(uint4*)(d + 8) = b;
  HSYNC();
}

DEV void modv_item(const Params& p, int it, float* sl) {
  const int tid = VTID;
  const int l = it / 288, rem = it % 288, cc = rem / 3, rg = rem % 3;
  for (int idx = tid; idx < 11 * 1024; idx += 256) {
    int r = rg * 11 + (idx >> 10), k = idx & 1023;
    float cv = (r < 32) ? p.c[r * 1024 + k] : p.c_ctx[k];
    sl[idx] = cv / (1.f + expf(-cv));
  }
  HSYNC();
  const int cl = tid & 63, kg = tid >> 6;
  const int col = cc * 64 + cl;
  float acc[11];
#pragma unroll
  for (int r = 0; r < 11; ++r) acc[r] = 0.f;
  const float* w = p.mod_w + (size_t)l * 1024 * 6144 + (size_t)(kg * 256) * 6144 + col;
#pragma unroll 8
  for (int k = 0; k < 256; ++k) {
    float wv = w[(size_t)k * 6144];
#pragma unroll
    for (int r = 0; r < 11; ++r) acc[r] += sl[r * 1024 + kg * 256 + k] * wv;
  }
  HSYNC();
  float* red = sl;
#pragma unroll
  for (int r = 0; r < 11; ++r) red[(kg * 11 + r) * 64 + cl] = acc[r];
  HSYNC();
  for (int idx = tid; idx < 11 * 64; idx += 256) {
    int r = idx >> 6, c2 = idx & 63;
    float v = red[(0 * 11 + r) * 64 + c2] + red[(1 * 11 + r) * 64 + c2] + red[(2 * 11 + r) * 64 + c2] + red[(3 * 11 + r) * 64 + c2];
    int gcol = cc * 64 + c2;
    ((float*)(p.ws + OFF_MODV))[(size_t)(l * 33 + rg * 11 + r) * 6144 + gcol] = v + p.mod_b[l * 6144 + gcol];
  }
  HSYNC();
}

DEV void filter_item(const Params& p, int it, float* sm) {
  const int L = it < 2048 ? 2048 : 256;
  const int t = it < 2048 ? it : it - 2048;
  u16* R = (u16*)(p.ws + (L == 2048 ? OFF_KR2048 : OFF_KR256));
  float* pe = sm; float* h1 = sm + 64; float* h2 = sm + 128;
  const int tid = VTID;
  const float tn = (float)t / (float)(L - 1);
  if (tid < 33) {
    float v;
    if (tid == 0) v = tn;
    else {
      int i = (tid - 1) & 15;
      double band = 1e-4 + (double)i * ((15.0 - 1e-4) / 15.0);
      double ang = 2.0 * 3.14159265358979323846 * (double)t * band / (double)L;
      v = (tid <= 16) ? (float)cos(ang) : (float)(-sin(ang));
    }
    pe[tid] = v;
  }
  HSYNC();
  if (tid < 64) {
    float acc = p.hy_b1[tid];
#pragma unroll 11
    for (int i = 0; i < 33; ++i) acc += pe[i] * p.hy_w1[i * 64 + tid];
    h1[tid] = sinf(p.hy_freq[tid] * acc);
  }
  HSYNC();
  if (tid < 64) {
    float acc = p.hy_b2[tid];
#pragma unroll 16
    for (int i = 0; i < 64; ++i) acc += h1[i] * p.hy_w2[i * 64 + tid];
    h2[tid] = sinf(p.hy_freq[tid] * acc);
  }
  HSYNC();
#pragma unroll 1
  for (int q = 0; q < 4; ++q) {
    int o = tid + 256 * q;
    float acc = 0.f;
#pragma unroll 16
    for (int i = 0; i < 64; ++i) acc += h2[i] * p.hy_w3[i * 1024 + o];
    float val = acc * expf(-tn * fabsf(p.hy_decay[o]));
    if (o < 512) {
      if (t == 0) val += p.hy_bias[o];
      R[(size_t)o * 2 * L + L - t] = f2bf(val);
    } else {
      int c = o - 512;
      if (t >= 1) R[(size_t)c * 2 * L + L + t] = f2bf(val);
      else R[(size_t)c * 2 * L] = 0;
    }
  }
  HSYNC();
}

DEV void phase_prep(const Params& p, char* smem) {
  constexpr int T_IN0 = 16 * 36, T_OUT = 16 * 16, T_W = 16 * 64;
  constexpr int E0 = T_IN0, E1 = E0 + T_OUT, E2 = E1 + T_W, E3 = E2 + T_W, E4 = E3 + T_W, E5 = E4 + T_W,
                E6 = E5 + T_W, E7 = E6 + T_OUT, E8 = E7 + 576, E9 = E8 + 2304, E10 = E9 + 1, E11 = E10 + 16;
  for (int it = VBID; it < E11; it += VNB) {
    if (it >= E10) transpose_tile(p.rw_g2, 128, 512, 512, (u16*)(p.ws + OFF_G2T), it - E10, (u16*)smem);
    else if (it < E0) transpose_tile(p.e_w_in, 1024, 2304, 2304, (u16*)(p.ws + OFF_WIN0), it, (u16*)smem);
    else if (it < E1) transpose_tile(p.e_w_out, 1024, 1024, 1024, (u16*)(p.ws + OFF_WOUT0), it - E0, (u16*)smem);
    else if (it < E2) transpose_tile(p.mlp_w1, 1024, 4096, 4096, (u16*)(p.ws + OFF_W1_0), it - E1, (u16*)smem);
    else if (it < E3) transpose_tile(p.mlp_w1 + (size_t)1024 * 4096, 1024, 4096, 4096, (u16*)(p.ws + OFF_W1_1), it - E2, (u16*)smem);
    else if (it < E4) transpose_tile(p.mlp_w2, 4096, 1024, 1024, (u16*)(p.ws + OFF_W2_0), it - E3, (u16*)smem);
    else if (it < E5) transpose_tile(p.mlp_w2 + (size_t)1024 * 4096, 4096, 1024, 1024, (u16*)(p.ws + OFF_W2_1), it - E4, (u16*)smem);
    else if (it < E6) transpose_tile(p.o_w_in, 1024, 3984, 4096, (u16*)(p.ws + OFF_WIN1), it - E5, (u16*)smem);
    else if (it < E7) transpose_tile(p.o_w_out, 1024, 1024, 1024, (u16*)(p.ws + OFF_WOUT1), it - E6, (u16*)smem);
    else if (it < E8) modv_item(p, it - E7, (float*)smem);
    else if (it < E9) filter_item(p, it - E8, (float*)smem);
    else {
      float2* tab = (float2*)(p.ws + OFF_ROPE);
      for (int q = 0; q < 4; ++q) {
        int e = VTID * 4 + q;
        int pos = e >> 4, i = e & 15;
        float inv = powf(10000.f, -(float)i / 16.f);
        float ang = (float)pos * inv;
        tab[e] = make_float2(cosf(ang), sinf(ang));
      }
    }
  }
}

DEV void phase_init(const Params& p) {
  const float* mv = (const float*)(p.ws + OFF_MODV);
  u16* X = (u16*)(p.ws + OFF_X);
  u16* HM = (u16*)(p.ws + OFF_HY);
  const size_t total = (size_t)NTOK * 128;
  for (size_t i = (size_t)VBID * 256 + VTID; i < total; i += (size_t)VNB * 256) {
    int r = (int)(i >> 7), c8 = (int)(i & 127) * 8;
    const float* src = r < NLAT ? p.x + (size_t)r * 1024 + c8 : p.ctx + (size_t)(r - NLAT) * 1024 + c8;
    float4 v0 = *(const float4*)src, v1 = *(const float4*)(src + 4);
    const float* m = mv + (size_t)modrow(r) * 6144 + c8;
    float4 h0 = *(const float4*)m, h1 = *(const float4*)(m + 4);
    float4 s0 = *(const float4*)(m + 1024), s1 = *(const float4*)(m + 1028);
    float f[8] = {v0.x, v0.y, v0.z, v0.w, v1.x, v1.y, v1.z, v1.w};
    float sh[8] = {h0.x, h0.y, h0.z, h0.w, h1.x, h1.y, h1.z, h1.w};
    float sc[8] = {s0.x, s0.y, s0.z, s0.w, s1.x, s1.y, s1.z, s1.w};
    float g[8];
#pragma unroll
    for (int j = 0; j < 8; ++j) g[j] = f[j] * (1.f + sc[j]) + sh[j];
    *(uint4*)(X + (size_t)r * 1024 + c8) = pack8(f);
    *(uint4*)(HM + (size_t)r * 1024 + c8) = pack8(g);
  }
}

template <int EPI>
DEV void gemm_phase(const u16* __restrict__ A, int lda, const u16* __restrict__ Bt, int K, int M, int N,
                    u16* __restrict__ C, int ldc, const float* __restrict__ gate, char* smem) {
  const int tid = threadIdx.x, lane = tid & 63, wave = tid >> 6;
  const int wm = wave >> 2, wn = wave & 3;
  const int fr = lane & 15, fq = lane >> 4;
  const int tn = N >> 8, tm = M >> 8, tiles = tm * tn;
  const int nk = K >> 6;
  const int drow = wave * 8 + (lane >> 3);
  const int dchunk = (lane & 7) ^ ((drow >> 1) & 7);
  const size_t lda64 = (size_t)lda * 64, ldb64 = (size_t)K * 64;
  const int sw = fr >> 1;
  const bool xcd_order = (gridDim.x & 7) == 0 && (tm & 31) == 0;
  const int mx = tm >> 3;
  for (int it = blockIdx.x; it < tiles; it += gridDim.x) {
    int tm_i, tn_i;
    if (xcd_order) {
      const int x = it & 7, local = it >> 3;
      const int mg = local / (4 * tn), r = local - mg * 4 * tn;
      tn_i = r >> 2;
      tm_i = x * mx + mg * 4 + (r & 3);
    } else { tm_i = it / tn; tn_i = it - tm_i * tn; }
    const int m0 = tm_i << 8, n0 = tn_i << 8;
    const u16* ag = A + (size_t)(m0 + drow) * lda + dchunk * 8;
    const u16* bg = Bt + (size_t)(n0 + drow) * K + dchunk * 8;
    f32x4 acc[8][4];
#pragma unroll
    for (int i = 0; i < 8; ++i)
#pragma unroll
      for (int j = 0; j < 4; ++j) acc[i][j] = (f32x4){0.f, 0.f, 0.f, 0.f};
#define G_ISSUE(KT, ST)                                                                                  \
  {                                                                                                      \
    const u16* a2 = ag + (KT)*64;                                                                        \
    const u16* b2 = bg + (KT)*64;                                                                        \
    char* la = smem + (ST)*65536 + wave * 1024;                                                          \
    _Pragma("unroll") for (int j = 0; j < 4; ++j) {                                                      \
      __builtin_amdgcn_global_load_lds((const unsigned*)(a2 + j * lda64), (unsigned*)(la + j * 8192), 16, 0, 0);          \
      __builtin_amdgcn_global_load_lds((const unsigned*)(b2 + j * ldb64), (unsigned*)(la + 32768 + j * 8192), 16, 0, 0);  \
    }                                                                                                    \
  }
    G_ISSUE(0, 0)
    for (int kt = 0; kt < nk; ++kt) {
      asm volatile("s_waitcnt vmcnt(0)" ::: "memory");
      __syncthreads();
      if (kt + 1 < nk) G_ISSUE(kt + 1, (kt + 1) & 1)
      const u16* As = (const u16*)(smem + (kt & 1) * 65536);
      const u16* Bs = As + 16384;
#define LDA(i, ks) (*(const bf16x8*)(As + (wm * 128 + (i) * 16 + fr) * 64 + ((((ks) * 4 + fq) ^ sw) * 8)))
#define LDB(j, ks) (*(const bf16x8*)(Bs + (wn * 64 + (j) * 16 + fr) * 64 + ((((ks) * 4 + fq) ^ sw) * 8)))
#define SB __builtin_amdgcn_sched_barrier(0)
#define MFMA_H(R, X0, Y0) acc[R][0] = __builtin_amdgcn_mfma_f32_16x16x32_bf16(X0, Y0, acc[R][0], 0, 0, 0);
#define MFMA_T(R, X0, X1, Y0, Y1, Y2, Y3)                                                  \
  acc[R][1] = __builtin_amdgcn_mfma_f32_16x16x32_bf16(X0, Y1, acc[R][1], 0, 0, 0);         \
  acc[R][2] = __builtin_amdgcn_mfma_f32_16x16x32_bf16(X0, Y2, acc[R][2], 0, 0, 0);         \
  acc[R][3] = __builtin_amdgcn_mfma_f32_16x16x32_bf16(X0, Y3, acc[R][3], 0, 0, 0);         \
  acc[R + 1][0] = __builtin_amdgcn_mfma_f32_16x16x32_bf16(X1, Y0, acc[R + 1][0], 0, 0, 0); \
  acc[R + 1][1] = __builtin_amdgcn_mfma_f32_16x16x32_bf16(X1, Y1, acc[R + 1][1], 0, 0, 0); \
  acc[R + 1][2] = __builtin_amdgcn_mfma_f32_16x16x32_bf16(X1, Y2, acc[R + 1][2], 0, 0, 0); \
  acc[R + 1][3] = __builtin_amdgcn_mfma_f32_16x16x32_bf16(X1, Y3, acc[R + 1][3], 0, 0, 0);
      {
        bf16x8 b0 = LDB(0, 0), b1 = LDB(1, 0), b2 = LDB(2, 0), b3 = LDB(3, 0);
        bf16x8 a0 = LDA(0, 0), a1 = LDA(1, 0);
        bf16x8 n0, n1, c0, c1, c2, c3;
        SB; MFMA_H(0, a0, b0) SB; n0 = LDA(2, 0); n1 = LDA(3, 0); SB; MFMA_T(0, a0, a1, b0, b1, b2, b3) SB;
        MFMA_H(2, n0, b0) SB; a0 = LDA(4, 0); a1 = LDA(5, 0); SB; MFMA_T(2, n0, n1, b0, b1, b2, b3) SB;
        MFMA_H(4, a0, b0) SB; n0 = LDA(6, 0); n1 = LDA(7, 0); SB; MFMA_T(4, a0, a1, b0, b1, b2, b3) SB;
        MFMA_H(6, n0, b0) SB;
        c0 = LDB(0, 1); c1 = LDB(1, 1); c2 = LDB(2, 1); c3 = LDB(3, 1); a0 = LDA(0, 1); a1 = LDA(1, 1);
        SB; MFMA_T(6, n0, n1, b0, b1, b2, b3) SB;
        MFMA_H(0, a0, c0) SB; n0 = LDA(2, 1); n1 = LDA(3, 1); SB; MFMA_T(0, a0, a1, c0, c1, c2, c3) SB;
        MFMA_H(2, n0, c0) SB; a0 = LDA(4, 1); a1 = LDA(5, 1); SB; MFMA_T(2, n0, n1, c0, c1, c2, c3) SB;
        MFMA_H(4, a0, c0) SB; n0 = LDA(6, 1); n1 = LDA(7, 1); SB; MFMA_T(4, a0, a1, c0, c1, c2, c3) SB;
        MFMA_H(6, n0, c0) MFMA_T(6, n0, n1, c0, c1, c2, c3) SB;
      }
#undef LDA
#undef LDB
#undef SB
#undef MFMA_H
#undef MFMA_T
    }
#undef G_ISSUE
    u16* Cs = (u16*)smem;
#pragma unroll 1
    for (int hp = 0; hp < 2; ++hp) {
      __syncthreads();
      if (wm == hp) {
#pragma unroll
        for (int i = 0; i < 8; ++i)
#pragma unroll
          for (int j = 0; j < 4; ++j)
#pragma unroll
            for (int e = 0; e < 4; ++e) {
              float v = acc[i][j][e];
              if (EPI == 1) { v = fmaxf(v, 0.f); v = v * v; }
              Cs[(i * 16 + fq * 4 + e) * 264 + wn * 64 + j * 16 + fr] = f2bf(v);
            }
      }
      __syncthreads();
#pragma unroll 2
      for (int q = 0; q < 8; ++q) {
        const int chunk = tid + q * 512;
        const int row = chunk >> 5, cc = chunk & 31;
        uint4 cv = *(const uint4*)(Cs + row * 264 + cc * 8);
        const int grow = m0 + hp * 128 + row;
        u16* dst = C + (size_t)grow * ldc + n0 + cc * 8;
        if (EPI == 2) {
          float a[8], xo[8], y[8];
          unpack8(cv, a);
          unpack8(*(const uint4*)dst, xo);
          const float* gr = gate + (size_t)modrow(grow) * 6144 + n0 + cc * 8;
          float4 g0 = *(const float4*)gr, g1 = *(const float4*)(gr + 4);
          float gg[8] = {g0.x, g0.y, g0.z, g0.w, g1.x, g1.y, g1.z, g1.w};
#pragma unroll
          for (int j = 0; j < 8; ++j) y[j] = ALPHA * xo[j] + gg[j] * a[j];
          cv = pack8(y);
        }
        *(uint4*)dst = cv;
      }
    }
    __syncthreads();
  }
}

template <bool FINAL>
DEV void ln_phase(const Params& p, int M, const float* __restrict__ g, const float* __restrict__ b,
                         const float* __restrict__ modl  , int shi, int sci) {
  u16* X = (u16*)(p.ws + OFF_X);
  u16* HM = (u16*)(p.ws + OFF_HY);
  const int lane = VTID & 63;
  const int gw = VBID * 4 + (VTID >> 6), nw = VNB * 4;
  uint4 nx0 = make_uint4(0u, 0u, 0u, 0u), nx1 = nx0;
  if (gw < M) {
    nx0 = *(const uint4*)(X + (size_t)gw * 1024 + lane * 8);
    nx1 = *(const uint4*)(X + (size_t)gw * 1024 + 512 + lane * 8);
  }
  for (int row = gw; row < M; row += nw) {
    u16* xr = X + (size_t)row * 1024;
    float f[16];
    unpack8(nx0, f);
    unpack8(nx1, f + 8);
    if (row + nw < M) {
      nx0 = *(const uint4*)(xr + (size_t)nw * 1024 + lane * 8);
      nx1 = *(const uint4*)(xr + (size_t)nw * 1024 + 512 + lane * 8);
    }
    float s = 0.f, q = 0.f;
#pragma unroll
    for (int j = 0; j < 16; ++j) { s += f[j]; q += f[j] * f[j]; }
#pragma unroll
    for (int o = 32; o > 0; o >>= 1) { s += __shfl_xor(s, o, 64); q += __shfl_xor(q, o, 64); }
    const float mu = s * (1.f / 1024.f);
    const float rs = rsqrtf(fmaxf(q * (1.f / 1024.f) - mu * mu, 0.f) + 1e-5f);
#pragma unroll
    for (int j = 0; j < 16; ++j) f[j] -= mu;
#pragma unroll
    for (int hh = 0; hh < 2; ++hh) {
      const int c0 = hh * 512 + lane * 8;
      float y[8];
#pragma unroll
      for (int j = 0; j < 8; ++j) y[j] = f[hh * 8 + j] * rs * g[c0 + j] + b[c0 + j];
      if (FINAL) {
        float* o = p.out + (size_t)row * 1024 + c0;
        *(float4*)o = make_float4(y[0], y[1], y[2], y[3]);
        *(float4*)(o + 4) = make_float4(y[4], y[5], y[6], y[7]);
      } else {
        *(uint4*)(xr + c0) = pack8(y);
        const float* m = modl + (size_t)modrow(row) * 6144;
        float h[8];
#pragma unroll
        for (int j = 0; j < 8; ++j) h[j] = y[j] * (1.f + m[sci * 1024 + c0 + j]) + m[shi * 1024 + c0 + j];
        *(uint4*)(HM + (size_t)row * 1024 + c0) = pack8(h);
      }
    }
  }
}

DEV void hyprep_item(const Params& p, int it, char* smem) {
  u16* su = (u16*)smem;
  u16* sx = su + 64 * 66;
  const u16* P = (const u16*)(p.ws + OFF_BIG);
  const int tid = VTID;
  const int ct = it & 7, st = it >> 3;
  int b, t0, L, rowbase;
  u16 *U, *X0;
  if (st < 1024) { b = st >> 5; t0 = (st & 31) * 64; L = 2048; rowbase = b * 2048;
    U = (u16*)((char*)p.out + SO_U); X0 = (u16*)((char*)p.out + SO_X0); }
  else { int s2 = st - 1024; b = s2 >> 2; t0 = (s2 & 3) * 64; L = 256; rowbase = NLAT + b * 256;
    U = (u16*)((char*)p.out + SO_UC); X0 = (u16*)((char*)p.out + SO_X0C); }
  const int c0 = ct * 64;
  {
    const int t = tid >> 2, cq = tid & 3;
    float z[3][16];
#pragma unroll
    for (int g = 0; g < 3; ++g)
#pragma unroll
      for (int j = 0; j < 16; ++j) z[g][j] = 0.f;
#pragma unroll
    for (int tap = 0; tap < 3; ++tap) {
      const int tt = t0 + t + tap - 1;
      if (tt >= 0 && tt < L) {
#pragma unroll
        for (int g = 0; g < 3; ++g) {
          const int col = g * 512 + c0 + cq * 16;
          const u16* src = P + (size_t)(rowbase + tt) * PS0 + col;
          float f[16];
          unpack8(*(const uint4*)src, f);
          unpack8(*(const uint4*)(src + 8), f + 8);
          const float* w = p.hy_conv + tap * 1536 + col;
#pragma unroll
          for (int j = 0; j < 16; ++j) z[g][j] += f[j] * w[j];
        }
      }
    }
#pragma unroll
    for (int j = 0; j < 16; ++j) {
      su[t * 66 + cq * 16 + j] = f2bf(z[1][j] * z[2][j]);
      sx[t * 66 + cq * 16 + j] = f2bf(z[0][j]);
    }
  }
  HSYNC();
  {
    const int c = tid >> 2, tq = tid & 3;
    unsigned wu[8], wx[8];
#pragma unroll
    for (int j = 0; j < 8; ++j) {
      wu[j] = (unsigned)su[(tq * 16 + 2 * j) * 66 + c] | ((unsigned)su[(tq * 16 + 2 * j + 1) * 66 + c] << 16);
      wx[j] = (unsigned)sx[(tq * 16 + 2 * j) * 66 + c] | ((unsigned)sx[(tq * 16 + 2 * j + 1) * 66 + c] << 16);
    }
    const size_t o = ((size_t)(c0 + c) * 32 + b) * L + t0 + tq * 16;
    *(uint4*)(U + o) = make_uint4(wu[0], wu[1], wu[2], wu[3]);
    *(uint4*)(U + o + 8) = make_uint4(wu[4], wu[5], wu[6], wu[7]);
    *(uint4*)(X0 + o) = make_uint4(wx[0], wx[1], wx[2], wx[3]);
    *(uint4*)(X0 + o + 8) = make_uint4(wx[4], wx[5], wx[6], wx[7]);
  }
  HSYNC();
}

DEV void rope_item(const Params& p, int it) {
  u16* P = (u16*)(p.ws + OFF_BIG);
  const float2* tab = (const float2*)(p.ws + OFF_ROPE);
  const int task = it * 256 + VTID;
  const int row = task / 40, rem = task - row * 40;
  const int head = rem >> 2, pr = rem & 3;
  const int d0 = (pr >> 1) * 32 + (pr & 1) * 8;
  const int t = row & 2047;
  const int posc = (pr >> 1) ? (t & 63) : (t >> 6);
  const int fi0 = (pr & 1) * 8;
  u16* ptr = P + (size_t)row * PS0 + 1536 + head * 64 + d0;
  float u1[8], u2[8], o1[8], o2[8];
  unpack8(*(const uint4*)ptr, u1);
  unpack8(*(const uint4*)(ptr + 16), u2);
#pragma unroll
  for (int j = 0; j < 8; ++j) {
    float2 cs = tab[posc * 16 + fi0 + j];
    o1[j] = u1[j] * cs.x - u2[j] * cs.y;
    o2[j] = u1[j] * cs.y + u2[j] * cs.x;
  }
  *(uint4*)ptr = pack8(o1);
  *(uint4*)(ptr + 16) = pack8(o2);
}

DEV void phase_hyprep_rope(const Params& p, char* smem) {
  constexpr int NH = 9216, NR = 10240;
  for (int it = VBID; it < NH + NR; it += VNB) {
    if (it < NH) hyprep_item(p, it, smem);
    else rope_item(p, it - NH);
  }
}

template <int L, int NT>
DEV void conv_item(const Params& p, int c, int th, char* smem) {
  const u16* R = (const u16*)(p.ws + (L == 2048 ? OFF_KR2048 : OFF_KR256)) + (size_t)c * 2 * L;
  const u16* U = (const u16*)((const char*)p.out + (L == 2048 ? SO_U : SO_UC));
  const u16* X0 = (const u16*)((const char*)p.out + (L == 2048 ? SO_X0 : SO_X0C));
  u16* Y = (u16*)(p.ws + OFF_HY);
  u16* Rs0 = (u16*)smem;
  u16* Rs1 = Rs0 + 2 * L + 8;
  const int tid = VTID, lane = tid & 63, wave = tid >> 6;
  for (int i = tid; i < 2 * L; i += 256) {
    Rs0[i] = R[i];
    Rs1[i] = (i + 1 < 2 * L) ? R[i + 1] : (u16)0;
  }
  HSYNC();
  const int r = lane & 31, h = lane >> 5;
  const char* lanebase = (r & 1) ? (const char*)Rs1 + 2 * (8 * h - r + L - 1) : (const char*)Rs0 + 2 * (8 * h - r + L);
  const u16* Ub = U + ((size_t)c * 32 + r) * L + 8 * h;
  const int tw0 = th * 1024 + wave * NT * 32;
  f32x16 acc[NT];
#pragma unroll
  for (int i = 0; i < NT; ++i)
#pragma unroll
    for (int e = 0; e < 16; ++e) acc[i][e] = 0.f;
  uint4 nb = *(const uint4*)Ub;
  for (int st = 0; st < L / 16; ++st) {
    uint4 cur = nb;
    if (st + 1 < L / 16) nb = *(const uint4*)(Ub + (st + 1) * 16);
    bf16x8 bfrag = *(bf16x8*)&cur;
#pragma unroll
    for (int i = 0; i < NT; ++i) {
      const unsigned* ap = (const unsigned*)(lanebase + 2 * (st * 16 - (tw0 + i * 32)));
      uint4 av = make_uint4(ap[0], ap[1], ap[2], ap[3]);
      acc[i] = __builtin_amdgcn_mfma_f32_32x32x16_bf16(*(bf16x8*)&av, bfrag, acc[i], 0, 0, 0);
    }
  }
  const int rowbase = (L == 2048) ? r * 2048 : NLAT + r * 256;
#pragma unroll
  for (int i = 0; i < NT; ++i) {
#pragma unroll
    for (int g4 = 0; g4 < 4; ++g4) {
      const int tt = tw0 + i * 32 + 8 * g4 + 4 * h;
      uint2 xv = *(const uint2*)(X0 + ((size_t)c * 32 + r) * L + tt);
      float x0[4] = {bflo(xv.x), bfhi(xv.x), bflo(xv.y), bfhi(xv.y)};
#pragma unroll
      for (int e = 0; e < 4; ++e) Y[(size_t)(rowbase + tt + e) * 1024 + c] = f2bf(acc[i][g4 * 4 + e] * x0[e]);
    }
  }
  HSYNC();
}

DEV void attn_item(const Params& p, int b, int hq, int qb, bool isctx, char* smem) {
  const u16* P = (const u16*)(p.ws + OFF_BIG);
  u16* Y = (u16*)(p.ws + OFF_HY);
  u16* Ks = (u16*)smem;
  u16* Vt = Ks + 64 * 72;
  const int tid = VTID, lane = tid & 63, wave = tid >> 6;
  const int nq = lane & 15, quad = lane >> 4;
  const int qrow = (isctx ? NLAT + b * 256 : b * 2048) + qb * 64 + wave * 16 + nq;
  const int qpos = qb * 64 + wave * 16 + nq;
  const int hkv = hq >> 2;
  const int kcol = 2048 + hkv * 64, vcol = 2176 + hkv * 64;
  bf16x8 qf[2];
#pragma unroll
  for (int ks = 0; ks < 2; ++ks)
    qf[ks] = *(const bf16x8*)(P + (size_t)qrow * PS0 + 1536 + hq * 64 + ks * 32 + quad * 8);
  float m = p.attn_sink[hq];
  float lsum = (quad == 0) ? 1.f : 0.f;
  f32x4 oacc[4];
#pragma unroll
  for (int n = 0; n < 4; ++n) oacc[n] = (f32x4){0.f, 0.f, 0.f, 0.f};
  const int nloc = isctx ? 0 : 5;
  for (int ti = 0; ti < nloc + 4; ++ti) {
    int krow0, k0 = 0;
    bool masked;
    if (ti < nloc) {
      k0 = qb * 64 - 128 + ti * 64;
      if (k0 < 0 || k0 >= 2048) continue;
      krow0 = b * 2048 + k0; masked = true;
    } else { krow0 = NLAT + b * 256 + (ti - nloc) * 64; masked = false; }
    HSYNC();
    {
      const int key = tid >> 2, part = tid & 3;
      const u16* kp = P + (size_t)(krow0 + key) * PS0 + kcol + part * 16;
      const u16* vp = P + (size_t)(krow0 + key) * PS0 + vcol + part * 16;
      uint4 k0v = *(const uint4*)kp, k1v = *(const uint4*)(kp + 8);
      uint4 v0v = *(const uint4*)vp, v1v = *(const uint4*)(vp + 8);
      *(uint4*)(Ks + key * 72 + part * 16) = k0v;
      *(uint4*)(Ks + key * 72 + part * 16 + 8) = k1v;
      unsigned vw[8] = {v0v.x, v0v.y, v0v.z, v0v.w, v1v.x, v1v.y, v1v.z, v1v.w};
#pragma unroll
      for (int j = 0; j < 8; ++j) {
        Vt[(part * 16 + 2 * j) * 72 + key] = (u16)(vw[j] & 0xffffu);
        Vt[(part * 16 + 2 * j + 1) * 72 + key] = (u16)(vw[j] >> 16);
      }
    }
    HSYNC();
    f32x4 s[4];
#pragma unroll
    for (int n = 0; n < 4; ++n) {
      s[n] = (f32x4){0.f, 0.f, 0.f, 0.f};
#pragma unroll
      for (int ks = 0; ks < 2; ++ks) {
        bf16x8 kf = *(const bf16x8*)(Ks + (n * 16 + nq) * 72 + ks * 32 + quad * 8);
        s[n] = __builtin_amdgcn_mfma_f32_16x16x32_bf16(kf, qf[ks], s[n], 0, 0, 0);
      }
    }
    float mx = -1e30f;
#pragma unroll
    for (int n = 0; n < 4; ++n)
#pragma unroll
      for (int e = 0; e < 4; ++e) {
        float v = s[n][e] * 0.125f;
        if (masked) {
          int kpos = k0 + n * 16 + quad * 4 + e;
          int d = qpos - kpos;
          if (d > 128 || d < -128) v = -1e30f;
        }
        s[n][e] = v;
        mx = fmaxf(mx, v);
      }
    mx = fmaxf(mx, __shfl_xor(mx, 16, 64));
    mx = fmaxf(mx, __shfl_xor(mx, 32, 64));
    const float mn = fmaxf(m, mx);
    const float al = __expf(m - mn);
    m = mn;
    float ps = 0.f;
#pragma unroll
    for (int n = 0; n < 4; ++n)
#pragma unroll
      for (int e = 0; e < 4; ++e) { float pv = __expf(s[n][e] - mn); s[n][e] = pv; ps += pv; }
    lsum = lsum * al + ps;
#pragma unroll
    for (int n = 0; n < 4; ++n)
#pragma unroll
      for (int e = 0; e < 4; ++e) oacc[n][e] *= al;
#pragma unroll
    for (int hh = 0; hh < 2; ++hh) {
      uint4 pw;
      pw.x = pack2(s[2 * hh][0], s[2 * hh][1]); pw.y = pack2(s[2 * hh][2], s[2 * hh][3]);
      pw.z = pack2(s[2 * hh + 1][0], s[2 * hh + 1][1]); pw.w = pack2(s[2 * hh + 1][2], s[2 * hh + 1][3]);
      bf16x8 pb = *(bf16x8*)&pw;
#pragma unroll
      for (int n = 0; n < 4; ++n) {
        const u16* vr = Vt + (n * 16 + nq) * 72 + quad * 4;
        uint2 va = *(const uint2*)(vr + (2 * hh) * 16);
        uint2 vb = *(const uint2*)(vr + (2 * hh + 1) * 16);
        uint4 vv = make_uint4(va.x, va.y, vb.x, vb.y);
        oacc[n] = __builtin_amdgcn_mfma_f32_16x16x32_bf16(*(bf16x8*)&vv, pb, oacc[n], 0, 0, 0);
      }
    }
  }
  lsum += __shfl_xor(lsum, 16, 64);
  lsum += __shfl_xor(lsum, 32, 64);
  const float inv = 1.f / lsum;
  u16* yo = Y + (size_t)qrow * 1024 + 512 + hq * 64 + quad * 4;
#pragma unroll
  for (int n = 0; n < 4; ++n) {
    uint2 w;
    w.x = pack2(oacc[n][0] * inv, oacc[n][1] * inv);
    w.y = pack2(oacc[n][2] * inv, oacc[n][3] * inv);
    *(uint2*)(yo + n * 16) = w;
  }
  HSYNC();
}

DEV void phase_conv_attn(const Params& p, char* smem) {
  constexpr int N0 = 1024, N1 = N0 + 512, N2 = N1 + 8192, N3 = N2 + 1024;
#pragma unroll 1
  for (int it = VBID; it < N0; it += VNB) conv_item<2048, 8>(p, it >> 1, it & 1, smem);
  __builtin_amdgcn_sched_barrier(0);
#pragma unroll 1
  for (int it = VBID; it < N3; it += VNB) {
    if (it < N0) continue;
    if (it < N1) conv_item<256, 2>(p, it - N0, 0, smem);
  }
  __builtin_amdgcn_sched_barrier(0);
#pragma unroll 1
  for (int it = VBID; it < N3; it += VNB) {
    if (it < N1) continue;
    if (it < N2) { int a = it - N1; attn_item(p, a >> 8, (a >> 5) & 7, a & 31, false, smem); }
    else { int a = it - N2; attn_item(p, a >> 5, (a >> 2) & 7, a & 3, true, smem); }
  }
}

DEV void lds_wave_sync() {
  asm volatile("s_waitcnt lgkmcnt(0)" ::: "memory");
  __builtin_amdgcn_wave_barrier();
}

DEV void rwkv_item(const Params& p, int ri, char* smem) {
  const u16* P = (const u16*)(p.ws + OFF_BIG);
  u16* O4 = (u16*)p.out;
  float* BS = (float*)(p.ws + OFF_BSUM);
  const int tid0 = VTID;
  const int wp0 = tid0 >> 7;
  const int cid = ri * 2 + wp0;
  const int b = cid >> 4, d = (cid >> 3) & 1, h = cid & 7;
  f32x4 S[4][2];
#pragma unroll
  for (int i = 0; i < 4; ++i)
#pragma unroll
    for (int j = 0; j < 2; ++j) S[i][j] = (f32x4){0.f, 0.f, 0.f, 0.f};
  uint4 bw[2][4];
  float l0[4];
  {
    const int lane = tid0 & 63, wi = (tid0 >> 6) & 1, fr = lane & 15, fq = lane >> 4;
    const float* wsrc = (wi == 0 ? p.rw_w2 : p.rw_a2) + (size_t)d * 64 * 512 + h * 64;
    const float* bsrc = (wi == 0 ? p.rw_w0 : p.rw_a0) + d * 512 + h * 64;
#pragma unroll
    for (int nt = 0; nt < 4; ++nt) {
      l0[nt] = bsrc[nt * 16 + fr];
#pragma unroll
      for (int ks = 0; ks < 2; ++ks) {
        __builtin_amdgcn_sched_barrier(0);
        float f[8];
        const float* wp_ = wsrc + (size_t)(ks * 32 + fq * 8) * 512 + nt * 16 + fr;
#pragma unroll
        for (int j = 0; j < 8; ++j) f[j] = wp_[j * 512];
        bw[ks][nt] = pack8(f);
      }
    }
  }
  uint4 pre[5][3];
#define RW_LOAD(CI)                                                                                 \
  {                                                                                                 \
    const int seg_ = (CI) < 16 ? 0 : 1;                                                             \
    const int ch_ = seg_ ? (CI)-16 : (CI);                                                          \
    const int Ls_ = seg_ ? 2048 : 256;                                                              \
    const int rb_ = seg_ ? b * 2048 : NLAT + b * 256;                                               \
    const int sidx_ = ch_ * 16 + stt;                                                               \
    const int t_ = d == 0 ? sidx_ : Ls_ - 1 - sidx_;                                                \
    const u16* prow_ = P + (size_t)(rb_ + t_) * PS1 + spart * 8;                                    \
    _Pragma("unroll") for (int g = 0; g < 5; ++g) {                                                 \
      const int col_ = g < 3 ? g * 512 + h * 64 : (g == 3 ? 1536 + d * 64 : 1664 + d * 64);         \
      _Pragma("unroll") for (int tap = 0; tap < 3; ++tap) {                                         \
        const int tt_ = t_ + tap - 1;                                                               \
        if (tt_ >= 0 && tt_ < Ls_) pre[g][tap] = *(const uint4*)(prow_ + (ptrdiff_t)(tap - 1) * PS1 + col_); \
        else pre[g][tap] = make_uint4(0u, 0u, 0u, 0u);                                              \
      }                                                                                             \
    }                                                                                               \
  }
  {
    const int pt = tid0 & 127, stt = pt >> 3, spart = pt & 7;
    RW_LOAD(0)
  }
  for (int cidx = 0; cidx < 144; ++cidx) {
    asm volatile("" ::: "memory");
    int tid = tid0;
    asm volatile("" : "+v"(tid));
    const int lane = tid & 63, wave = tid >> 6, wp = wave >> 1, wi = wave & 1, pt = tid & 127;
    const int fr = lane & 15, fq = lane >> 4, stt = pt >> 3, spart = pt & 7;
    const int seg = cidx < 16 ? 0 : 1;
    const int ch = seg ? cidx - 16 : cidx;
    const int Ls = seg ? 2048 : 256;
    char* base = smem + wp * 32768;
    u16* RK = (u16*)base;
    u16* KD = RK + 1152;
    u16* KK = KD + 1152;
    u16* AB = KK + 1152;
    u16* VT = AB + 1152;
    float* LW = (float*)(base + 11264);
    u16* TW = (u16*)(base + 15360);
    u16* AD = TW + 1152;
    u16* BgCT = (u16*)(base + 19968);
    u16* KgCT = BgCT + 1024;
    float* gC = (float*)(base + 24064);
    float* Amat = (float*)(base + 24320) + wi * 256;
    u16* Tinv = (u16*)(base + 26368) + wi * 256;
    u16* BG = (u16*)(base + 27392);
    {
      const int o = stt * 72 + spart * 8;
#pragma unroll
      for (int g = 0; g < 5; ++g) {
        __builtin_amdgcn_sched_barrier(0);
        const int col = g < 3 ? g * 512 + h * 64 : (g == 3 ? 1536 + d * 64 : 1664 + d * 64);
        float pc[8], pp[8], pn[8], v[8];
        unpack8(pre[g][1], pc); unpack8(pre[g][0], pp); unpack8(pre[g][2], pn);
        const float* mu = p.rw_mu + col + spart * 8;
        float4 m0 = *(const float4*)mu, m1 = *(const float4*)(mu + 4);
        const float mm[8] = {m0.x, m0.y, m0.z, m0.w, m1.x, m1.y, m1.z, m1.w};
#pragma unroll
        for (int j = 0; j < 8; ++j) v[j] = pc[j] + mm[j] * (0.5f * (pp[j] + pn[j]) - pc[j]);
        if (g == 0) *(uint4*)(RK + o) = pack8(v);
        else if (g == 1) {
          *(uint4*)(KD + o) = pack8(v);
          const float* kkw = p.rw_kk + h * 64 + spart * 8;
          float kkv[8];
          float ss = 0.f;
#pragma unroll
          for (int j = 0; j < 8; ++j) { kkv[j] = v[j] * kkw[j]; ss += kkv[j] * kkv[j]; }
          ss += __shfl_xor(ss, 1, 64); ss += __shfl_xor(ss, 2, 64); ss += __shfl_xor(ss, 4, 64);
          const float inv = rsqrtf(ss + 1e-6f);
#pragma unroll
          for (int j = 0; j < 8; ++j) kkv[j] *= inv;
          *(uint4*)(KK + o) = pack8(kkv);
        } else if (g == 2) {
#pragma unroll
          for (int j = 0; j < 8; ++j) VT[(spart * 8 + j) * 16 + stt] = f2bf(v[j]);
        } else if (g == 3) {
#pragma unroll
          for (int j = 0; j < 8; ++j) v[j] = fast_tanh(v[j]);
          *(uint4*)(TW + o) = pack8(v);
        } else *(uint4*)(AD + o) = pack8(v);
      }
    }
    HSYNC();
    if (cidx + 1 < 144) RW_LOAD(cidx + 1)
    {
      const u16* IN = wi == 0 ? TW : AD;
      bf16x8 af0 = *(const bf16x8*)(IN + fr * 72 + fq * 8);
      bf16x8 af1 = *(const bf16x8*)(IN + fr * 72 + 32 + fq * 8);
#pragma unroll
      for (int nt = 0; nt < 4; ++nt) {
        f32x4 o4 = (f32x4){0.f, 0.f, 0.f, 0.f};
        o4 = __builtin_amdgcn_mfma_f32_16x16x32_bf16(af0, *(bf16x8*)&bw[0][nt], o4, 0, 0, 0);
        o4 = __builtin_amdgcn_mfma_f32_16x16x32_bf16(af1, *(bf16x8*)&bw[1][nt], o4, 0, 0, 0);
#pragma unroll
        for (int e = 0; e < 4; ++e) {
          const float prev = l0[nt] + o4[e];
          const int t = fq * 4 + e, c = nt * 16 + fr;
          if (wi == 0) LW[t * 64 + c] = -__expf(-softplus(-prev) - 0.5f);
          else AB[t * 72 + c] = f2bf(sigm(prev));
        }
      }
    }
    HSYNC();
    {
      const int c = lane;
      float cum = 0.f;
      if (wi == 0) {
#pragma unroll 4
        for (int t = 0; t < 16; ++t) {
          const float lw = LW[t * 64 + c];
          const float gp = __expf(cum);
          cum += lw;
          const float gi = __expf(-cum);
          const float kk = bf2f(KK[t * 72 + c]);
          const float a = bf2f(AB[t * 72 + c]);
          KK[t * 72 + c] = f2bf(kk * gp);
          BG[t * 72 + c] = f2bf(kk * a * gi);
        }
        const float gCv = __expf(cum);
        gC[c] = gCv;
#pragma unroll 4
        for (int t = 0; t < 16; ++t) BgCT[c * 16 + t] = f2bf(-bf2f(BG[t * 72 + c]) * gCv);
      } else {
        float* PR = (float*)TW;
        const float kac = p.rw_ka[h * 64 + c], rkc = p.rw_rk[h * 64 + c];
#pragma unroll 4
        for (int t = 0; t < 16; ++t) {
          const float lw = LW[t * 64 + c];
          cum += lw;
          const float g = __expf(cum), gi = __expf(-cum);
          const float r = bf2f(RK[t * 72 + c]);
          const float k = bf2f(KD[t * 72 + c]);
          const float a = bf2f(AB[t * 72 + c]);
          const float kd = k * (1.f + (a - 1.f) * kac);
          RK[t * 72 + c] = f2bf(r * g);
          KD[t * 72 + c] = f2bf(kd * gi);
          PR[t * 64 + c] = r * kd * rkc;
        }
        const float gCv = __expf(cum);
#pragma unroll 4
        for (int t = 0; t < 16; ++t) KgCT[c * 16 + t] = f2bf(bf2f(KD[t * 72 + c]) * gCv);
        lds_wave_sync();
        {
          const int t = lane >> 2, sg = lane & 3;
          const float4 q0 = *(const float4*)(PR + t * 64 + sg * 16), q1 = *(const float4*)(PR + t * 64 + sg * 16 + 4);
          const float4 q2 = *(const float4*)(PR + t * 64 + sg * 16 + 8), q3 = *(const float4*)(PR + t * 64 + sg * 16 + 12);
          float bsum = (q0.x + q0.y + q0.z + q0.w) + (q1.x + q1.y + q1.z + q1.w) + (q2.x + q2.y + q2.z + q2.w) + (q3.x + q3.y + q3.z + q3.w);
          bsum += __shfl_xor(bsum, 1, 64);
          bsum += __shfl_xor(bsum, 2, 64);
          if (seg == 1 && sg == 0) {
            const int sidx = ch * 16 + t;
            const int tpos = d == 0 ? sidx : 2047 - sidx;
            BS[(size_t)(b * 2048 + tpos) * 16 + h * 2 + d] = bsum;
          }
        }
      }
    }
    HSYNC();
    __builtin_amdgcn_sched_barrier(0);
    {
      f32x4 XabT = (f32x4){0.f, 0.f, 0.f, 0.f}, XakT = XabT, XrbT = XabT, XrkT = XabT;
#pragma unroll
      for (int ks = 0; ks < 2; ++ks) {
        bf16x8 kkf = *(const bf16x8*)(KK + fr * 72 + ks * 32 + fq * 8);
        bf16x8 rgf = *(const bf16x8*)(RK + fr * 72 + ks * 32 + fq * 8);
        bf16x8 bgf = *(const bf16x8*)(BG + fr * 72 + ks * 32 + fq * 8);
        bf16x8 kgf = *(const bf16x8*)(KD + fr * 72 + ks * 32 + fq * 8);
        XabT = __builtin_amdgcn_mfma_f32_16x16x32_bf16(bgf, kkf, XabT, 0, 0, 0);
        XakT = __builtin_amdgcn_mfma_f32_16x16x32_bf16(kgf, kkf, XakT, 0, 0, 0);
        XrbT = __builtin_amdgcn_mfma_f32_16x16x32_bf16(bgf, rgf, XrbT, 0, 0, 0);
        XrkT = __builtin_amdgcn_mfma_f32_16x16x32_bf16(kgf, rgf, XrkT, 0, 0, 0);
      }
      {
        float am[4];
#pragma unroll
        for (int e = 0; e < 4; ++e) am[e] = (fq * 4 + e < fr) ? XabT[e] : 0.f;
        *(float4*)(Amat + fr * 16 + fq * 4) = make_float4(am[0], am[1], am[2], am[3]);
      }
      lds_wave_sync();
      if (lane < 16) {
        float x[16];
        x[0] = (lane == 0) ? 1.f : 0.f;
        float4 cur[4], nxt[4];
        cur[0] = *(const float4*)(Amat + 16);
        cur[1] = cur[0]; cur[2] = cur[0]; cur[3] = cur[0];
#pragma unroll
        for (int i = 1; i < 16; ++i) {
          __builtin_amdgcn_sched_barrier(0);
          if (i + 1 < 16) {
#pragma unroll
            for (int q = 0; q < (i + 4) / 4; ++q) nxt[q] = *(const float4*)(Amat + (i + 1) * 16 + q * 4);
          }
          float acc = (i == lane) ? 1.f : 0.f;
#pragma unroll
          for (int j = 0; j < i; ++j) {
            const float4 rv = cur[j >> 2];
            const float av = (j & 3) == 0 ? rv.x : ((j & 3) == 1 ? rv.y : ((j & 3) == 2 ? rv.z : rv.w));
            acc -= av * x[j];
          }
          x[i] = acc;
#pragma unroll
          for (int q = 0; q < 4; ++q) cur[q] = nxt[q];
        }
#pragma unroll
        for (int i = 0; i < 16; ++i) Tinv[i * 16 + lane] = f2bf(x[i]);
      }
      lds_wave_sync();
      f32x4 sa0[2], y0[2];
#pragma unroll
      for (int nt = 0; nt < 2; ++nt) { sa0[nt] = (f32x4){0.f, 0.f, 0.f, 0.f}; y0[nt] = (f32x4){0.f, 0.f, 0.f, 0.f}; }
#pragma unroll
      for (int x = 0; x < 2; ++x) {
        __builtin_amdgcn_sched_barrier(0);
        uint2 k0 = *(const uint2*)(KK + fr * 72 + 32 * x + fq * 4);
        uint2 k1 = *(const uint2*)(KK + fr * 72 + 32 * x + 16 + fq * 4);
        uint2 r0 = *(const uint2*)(RK + fr * 72 + 32 * x + fq * 4);
        uint2 r1 = *(const uint2*)(RK + fr * 72 + 32 * x + 16 + fq * 4);
        uint4 kw = make_uint4(k0.x, k0.y, k1.x, k1.y);
        uint4 rw = make_uint4(r0.x, r0.y, r1.x, r1.y);
#pragma unroll
        for (int nt = 0; nt < 2; ++nt) {
          uint4 sw;
          sw.x = pack2(S[2 * x][nt][0], S[2 * x][nt][1]); sw.y = pack2(S[2 * x][nt][2], S[2 * x][nt][3]);
          sw.z = pack2(S[2 * x + 1][nt][0], S[2 * x + 1][nt][1]); sw.w = pack2(S[2 * x + 1][nt][2], S[2 * x + 1][nt][3]);
          sa0[nt] = __builtin_amdgcn_mfma_f32_16x16x32_bf16(*(bf16x8*)&kw, *(bf16x8*)&sw, sa0[nt], 0, 0, 0);
          y0[nt] = __builtin_amdgcn_mfma_f32_16x16x32_bf16(*(bf16x8*)&rw, *(bf16x8*)&sw, y0[nt], 0, 0, 0);
        }
      }
      float ak[4], rb[4], rk[4];
#pragma unroll
      for (int e = 0; e < 4; ++e) {
        const int j = fq * 4 + e;
        ak[e] = (j < fr) ? XakT[e] : 0.f;
        rb[e] = (j <= fr) ? -XrbT[e] : 0.f;
        rk[e] = (j <= fr) ? XrkT[e] : 0.f;
      }
      const uint4 akw = make_uint4(pack2(ak[0], ak[1]), pack2(ak[2], ak[3]), 0u, 0u);
      const uint4 ybw = make_uint4(pack2(rb[0], rb[1]), pack2(rb[2], rb[3]), pack2(rk[0], rk[1]), pack2(rk[2], rk[3]));
      const uint2 tv = *(const uint2*)(Tinv + fr * 16 + fq * 4);
      const uint4 tw = make_uint4(tv.x, tv.y, 0u, 0u);
      uint4 sv[2];
#pragma unroll
      for (int nt = 0; nt < 2; ++nt) {
        const int vc = wi * 32 + nt * 16 + fr;
        const uint2 vt = *(const uint2*)(VT + vc * 16 + fq * 4);
        const uint4 vb = make_uint4(vt.x, vt.y, 0u, 0u);
        f32x4 rhs = __builtin_amdgcn_mfma_f32_16x16x32_bf16(*(bf16x8*)&akw, *(bf16x8*)&vb, sa0[nt], 0, 0, 0);
        const uint4 rw = make_uint4(pack2(rhs[0], rhs[1]), pack2(rhs[2], rhs[3]), 0u, 0u);
        f32x4 sa = __builtin_amdgcn_mfma_f32_16x16x32_bf16(*(bf16x8*)&tw, *(bf16x8*)&rw, (f32x4){0.f, 0.f, 0.f, 0.f}, 0, 0, 0);
        sv[nt] = make_uint4(pack2(sa[0], sa[1]), pack2(sa[2], sa[3]), vt.x, vt.y);
        f32x4 y = __builtin_amdgcn_mfma_f32_16x16x32_bf16(*(bf16x8*)&ybw, *(bf16x8*)&sv[nt], y0[nt], 0, 0, 0);
        if (seg == 1) {
#pragma unroll
          for (int e = 0; e < 4; ++e) {
            const int sidx = ch * 16 + fq * 4 + e;
            const int tpos = d == 0 ? sidx : 2047 - sidx;
            O4[((size_t)d * NLAT + b * 2048 + tpos) * 512 + h * 64 + vc] = f2bf(y[e]);
          }
        }
      }
#pragma unroll
      for (int mt = 0; mt < 4; ++mt) {
        __builtin_amdgcn_sched_barrier(0);
        const float4 g4 = *(const float4*)(gC + mt * 16 + fq * 4);
        const uint2 bv = *(const uint2*)(BgCT + (mt * 16 + fr) * 16 + fq * 4);
        const uint2 kv = *(const uint2*)(KgCT + (mt * 16 + fr) * 16 + fq * 4);
        const uint4 aw = make_uint4(bv.x, bv.y, kv.x, kv.y);
#pragma unroll
        for (int nt = 0; nt < 2; ++nt) {
          S[mt][nt][0] *= g4.x; S[mt][nt][1] *= g4.y; S[mt][nt][2] *= g4.z; S[mt][nt][3] *= g4.w;
          S[mt][nt] = __builtin_amdgcn_mfma_f32_16x16x32_bf16(*(bf16x8*)&aw, *(bf16x8*)&sv[nt], S[mt][nt], 0, 0, 0);
        }
      }
    }
    HSYNC();
  }
#undef RW_LOAD
}

DEV void gdn_item(const Params& p, int gi, char* smem) {
  const u16* P = (const u16*)(p.ws + OFF_BIG);
  u16* O4 = (u16*)p.out;
  const int tid0 = VTID;
  const int b = gi >> 3, d = (gi >> 2) & 1, h = gi & 3;
  constexpr int BUFB = 23424;
  f32x4 S[8][2];
#pragma unroll
  for (int i = 0; i < 8; ++i)
#pragma unroll
    for (int j = 0; j < 2; ++j) S[i][j] = (f32x4){0.f, 0.f, 0.f, 0.f};
  const float negA = -__expf(p.dn_A_log[d * 4 + h]);
  const float dtb = p.dn_dt_bias[d * 4 + h];
  uint4 pre[3][3];
  float gpre0 = 0.f, gpre1 = 0.f;
#define GDN_LOAD(CI)                                                                               \
  {                                                                                                \
    const int seg_ = (CI) < 16 ? 0 : 1;                                                            \
    const int ch_ = seg_ ? (CI)-16 : (CI);                                                         \
    const int Ls_ = seg_ ? 2048 : 256;                                                             \
    const int rb_ = seg_ ? b * 2048 : NLAT + b * 256;                                              \
    const int sidx_ = ch_ * 16 + stt;                                                              \
    const int t_ = d == 0 ? sidx_ : Ls_ - 1 - sidx_;                                               \
    const u16* prow_ = P + (size_t)(rb_ + t_) * PS1 + DNO;                                         \
    _Pragma("unroll") for (int g = 0; g < 3; ++g) {                                                \
      const int col_ = g * 512 + h * 128 + spart * 8;                                              \
      _Pragma("unroll") for (int tap = 0; tap < 3; ++tap) {                                        \
        const int tt_ = t_ + tap - 1;                                                              \
        if (tt_ >= 0 && tt_ < Ls_) pre[g][tap] = *(const uint4*)(prow_ + (ptrdiff_t)(tap - 1) * PS1 + col_); \
        else pre[g][tap] = make_uint4(0u, 0u, 0u, 0u);                                             \
      }                                                                                            \
    }                                                                                              \
    if (wave == 0) {                                                                               \
      const int s2_ = ch_ * 16 + fr;                                                               \
      const int t2_ = d == 0 ? s2_ : Ls_ - 1 - s2_;                                                \
      const u16* gr_ = P + (size_t)(rb_ + t2_) * PS1 + DNO + 2048;                                 \
      gpre0 = bf2f(gr_[d * 4 + h]);                                                                \
      gpre1 = bf2f(gr_[8 + d * 4 + h]);                                                            \
    }                                                                                              \
  }
  {
    const int tid = tid0, lane = tid & 63, wave = tid >> 6, fr = lane & 15, stt = tid >> 4, spart = tid & 15;
    GDN_LOAD(0)
  }
  for (int cidx = 0; cidx < 144; ++cidx) {
    asm volatile("" ::: "memory");
    int tid = tid0;
    asm volatile("" : "+v"(tid));
    const int lane = tid & 63, wave = tid >> 6, fr = lane & 15, fq = lane >> 4, stt = tid >> 4, spart = tid & 15;
    char* buf = smem;
    u16* Kb = (u16*)buf;
    u16* Qb = Kb + 16 * 136;
    float* Vf = (float*)(buf + 8704);
    u16* KdT = (u16*)(buf + 17152);
    u16* Tinv = (u16*)(buf + 21248);
    u16* Pm = (u16*)(buf + 21760);
    float* Amat = (float*)(buf + 22272);
    float* Gs = (float*)(buf + 23296);
    float* Bs = Gs + 16;
#pragma unroll
    for (int g = 0; g < 3; ++g) {
      __builtin_amdgcn_sched_barrier(0);
      const int col = g * 512 + h * 128 + spart * 8;
      float z[8];
#pragma unroll
      for (int j = 0; j < 8; ++j) z[j] = 0.f;
#pragma unroll
      for (int tap = 0; tap < 3; ++tap) {
        __builtin_amdgcn_sched_barrier(0);
        float f[8];
        unpack8(pre[g][tap], f);
        const float* w = p.dn_conv + tap * 1536 + col;
        float4 w0 = *(const float4*)w, w1 = *(const float4*)(w + 4);
        z[0] += f[0] * w0.x; z[1] += f[1] * w0.y; z[2] += f[2] * w0.z; z[3] += f[3] * w0.w;
        z[4] += f[4] * w1.x; z[5] += f[5] * w1.y; z[6] += f[6] * w1.z; z[7] += f[7] * w1.w;
      }
      float ss = 0.f;
#pragma unroll
      for (int j = 0; j < 8; ++j) { z[j] = silu(z[j]); ss += z[j] * z[j]; }
      if (g < 2) {
        ss += __shfl_xor(ss, 1, 64); ss += __shfl_xor(ss, 2, 64); ss += __shfl_xor(ss, 4, 64); ss += __shfl_xor(ss, 8, 64);
        float sc = rsqrtf(ss + 1e-6f);
        if (g == 0) sc *= 0.08838834764831845f;
#pragma unroll
        for (int j = 0; j < 8; ++j) z[j] *= sc;
        *(uint4*)((g == 0 ? Qb : Kb) + stt * 136 + spart * 8) = pack8(z);
      } else {
        float* dst = Vf + stt * 132 + spart * 8;
        *(float4*)dst = make_float4(z[0], z[1], z[2], z[3]);
        *(float4*)(dst + 4) = make_float4(z[4], z[5], z[6], z[7]);
      }
    }
    if (wave == 0) {
      float g = negA * softplus(gpre0 + dtb);
#pragma unroll
      for (int o = 1; o < 16; o <<= 1) { float n = __shfl_up(g, o, 16); if (fr >= o) g += n; }
      if (lane < 16) { Gs[lane] = g; Bs[lane] = sigm(gpre1); }
    }
    HSYNC();
    if (wave == 0) {
      f32x4 kk = (f32x4){0.f, 0.f, 0.f, 0.f};
#pragma unroll
      for (int ks = 0; ks < 4; ++ks) {
        bf16x8 kf = *(const bf16x8*)(Kb + fr * 136 + ks * 32 + fq * 8);
        kk = __builtin_amdgcn_mfma_f32_16x16x32_bf16(kf, kf, kk, 0, 0, 0);
      }
      const float Gj = Gs[fr];
#pragma unroll
      for (int e = 0; e < 4; ++e) {
        const int i = fq * 4 + e;
        const float a = (fr < i) ? Bs[i] * kk[e] * __expf(Gs[i] - Gj) : 0.f;
        Amat[i * 16 + fr] = a;
      }
      lds_wave_sync();
      if (lane < 16) {
        float x[16];
        x[0] = (lane == 0) ? 1.f : 0.f;
        float4 cur[4], nxt[4];
        cur[0] = *(const float4*)(Amat + 16);
        cur[1] = cur[0]; cur[2] = cur[0]; cur[3] = cur[0];
#pragma unroll
        for (int i = 1; i < 16; ++i) {
          __builtin_amdgcn_sched_barrier(0);
          if (i + 1 < 16) {
#pragma unroll
            for (int q = 0; q < (i + 4) / 4; ++q) nxt[q] = *(const float4*)(Amat + (i + 1) * 16 + q * 4);
          }
          float acc = (i == lane) ? 1.f : 0.f;
#pragma unroll
          for (int j = 0; j < i; ++j) {
            const float4 rv = cur[j >> 2];
            const float av = (j & 3) == 0 ? rv.x : ((j & 3) == 1 ? rv.y : ((j & 3) == 2 ? rv.z : rv.w));
            acc -= av * x[j];
          }
          x[i] = acc;
#pragma unroll
          for (int q = 0; q < 4; ++q) cur[q] = nxt[q];
        }
#pragma unroll
        for (int i = 0; i < 16; ++i) Tinv[i * 16 + lane] = f2bf(x[i]);
      }
    } else if (wave == 1) {
      f32x4 qk = (f32x4){0.f, 0.f, 0.f, 0.f};
#pragma unroll
      for (int ks = 0; ks < 4; ++ks) {
        bf16x8 qf = *(const bf16x8*)(Qb + fr * 136 + ks * 32 + fq * 8);
        bf16x8 kf = *(const bf16x8*)(Kb + fr * 136 + ks * 32 + fq * 8);
        qk = __builtin_amdgcn_mfma_f32_16x16x32_bf16(qf, kf, qk, 0, 0, 0);
      }
      const float Gj = Gs[fr];
#pragma unroll
      for (int e = 0; e < 4; ++e) {
        const int t = fq * 4 + e;
        const float v = (fr <= t) ? qk[e] * __expf(Gs[t] - Gj) : 0.f;
        Pm[t * 16 + fr] = f2bf(v);
      }
    } else {
      const int k = tid - 128;
      const float GC = Gs[15];
      unsigned w[8];
#pragma unroll
      for (int j = 0; j < 8; ++j) {
        __builtin_amdgcn_sched_barrier(0);
        float v0 = bf2f(Kb[(2 * j) * 136 + k]) * __expf(GC - Gs[2 * j]);
        float v1 = bf2f(Kb[(2 * j + 1) * 136 + k]) * __expf(GC - Gs[2 * j + 1]);
        w[j] = pack2(v0, v1);
      }
      *(uint4*)(KdT + k * 16) = make_uint4(w[0], w[1], w[2], w[3]);
      *(uint4*)(KdT + k * 16 + 8) = make_uint4(w[4], w[5], w[6], w[7]);
    }
    __builtin_amdgcn_sched_barrier(0);
    f32x4 ksv[2], qsv[2];
#pragma unroll
    for (int nt = 0; nt < 2; ++nt) { ksv[nt] = (f32x4){0.f, 0.f, 0.f, 0.f}; qsv[nt] = (f32x4){0.f, 0.f, 0.f, 0.f}; }
#pragma unroll
    for (int x = 0; x < 4; ++x) {
      __builtin_amdgcn_sched_barrier(0);
      uint2 k0 = *(const uint2*)(Kb + fr * 136 + 32 * x + fq * 4);
      uint2 k1 = *(const uint2*)(Kb + fr * 136 + 32 * x + 16 + fq * 4);
      uint2 q0 = *(const uint2*)(Qb + fr * 136 + 32 * x + fq * 4);
      uint2 q1 = *(const uint2*)(Qb + fr * 136 + 32 * x + 16 + fq * 4);
      uint4 kw = make_uint4(k0.x, k0.y, k1.x, k1.y);
      uint4 qw = make_uint4(q0.x, q0.y, q1.x, q1.y);
#pragma unroll
      for (int nt = 0; nt < 2; ++nt) {
        uint4 sw;
        sw.x = pack2(S[2 * x][nt][0], S[2 * x][nt][1]); sw.y = pack2(S[2 * x][nt][2], S[2 * x][nt][3]);
        sw.z = pack2(S[2 * x + 1][nt][0], S[2 * x + 1][nt][1]); sw.w = pack2(S[2 * x + 1][nt][2], S[2 * x + 1][nt][3]);
        ksv[nt] = __builtin_amdgcn_mfma_f32_16x16x32_bf16(*(bf16x8*)&kw, *(bf16x8*)&sw, ksv[nt], 0, 0, 0);
        qsv[nt] = __builtin_amdgcn_mfma_f32_16x16x32_bf16(*(bf16x8*)&qw, *(bf16x8*)&sw, qsv[nt], 0, 0, 0);
      }
    }
    HSYNC();
    if (cidx + 1 < 144) GDN_LOAD(cidx + 1)
    __builtin_amdgcn_sched_barrier(0);
    {
      const int seg = cidx < 16 ? 0 : 1;
      const int ch = seg ? cidx - 16 : cidx;
      float eG[4], bt[4];
#pragma unroll
      for (int e = 0; e < 4; ++e) { eG[e] = __expf(Gs[fq * 4 + e]); bt[e] = Bs[fq * 4 + e]; }
      const float eGC = __expf(Gs[15]);
      uint2 tv = *(const uint2*)(Tinv + fr * 16 + fq * 4);
      uint2 pv = *(const uint2*)(Pm + fr * 16 + fq * 4);
      uint4 tw = make_uint4(tv.x, tv.y, 0u, 0u);
      uint4 pw = make_uint4(pv.x, pv.y, 0u, 0u);
      uint4 ub[2];
#pragma unroll
      for (int nt = 0; nt < 2; ++nt) {
        const int vc = wave * 32 + nt * 16 + fr;
        float rhs[4];
#pragma unroll
        for (int e = 0; e < 4; ++e) rhs[e] = bt[e] * (Vf[(fq * 4 + e) * 132 + vc] - eG[e] * ksv[nt][e]);
        uint4 rw = make_uint4(pack2(rhs[0], rhs[1]), pack2(rhs[2], rhs[3]), 0u, 0u);
        f32x4 u = __builtin_amdgcn_mfma_f32_16x16x32_bf16(*(bf16x8*)&tw, *(bf16x8*)&rw, (f32x4){0.f, 0.f, 0.f, 0.f}, 0, 0, 0);
        ub[nt] = make_uint4(pack2(u[0], u[1]), pack2(u[2], u[3]), 0u, 0u);
        f32x4 oa;
#pragma unroll
        for (int e = 0; e < 4; ++e) oa[e] = eG[e] * qsv[nt][e];
        oa = __builtin_amdgcn_mfma_f32_16x16x32_bf16(*(bf16x8*)&pw, *(bf16x8*)&ub[nt], oa, 0, 0, 0);
        if (seg == 1) {
#pragma unroll
          for (int e = 0; e < 4; ++e) {
            const int sidx = ch * 16 + fq * 4 + e;
            const int t = d == 0 ? sidx : 2047 - sidx;
            O4[((size_t)(2 + d) * NLAT + b * 2048 + t) * 512 + h * 128 + vc] = f2bf(oa[e]);
          }
        }
      }
#pragma unroll
      for (int mt = 0; mt < 8; ++mt) {
        __builtin_amdgcn_sched_barrier(0);
        uint2 kv = *(const uint2*)(KdT + (mt * 16 + fr) * 16 + fq * 4);
        uint4 kw = make_uint4(kv.x, kv.y, 0u, 0u);
#pragma unroll
        for (int nt = 0; nt < 2; ++nt) {
#pragma unroll
          for (int e = 0; e < 4; ++e) S[mt][nt][e] *= eGC;
          S[mt][nt] = __builtin_amdgcn_mfma_f32_16x16x32_bf16(*(bf16x8*)&kw, *(bf16x8*)&ub[nt], S[mt][nt], 0, 0, 0);
        }
      }
    }
    HSYNC();
  }
#undef GDN_LOAD
}

DEV void phase_scans(const Params& p, char* smem) {
#pragma unroll 1
  for (int it = VBID; it < 512; it += VNB)
    if (it & 1) rwkv_item(p, it >> 1, smem);
  __builtin_amdgcn_sched_barrier(0);
#pragma unroll 1
  for (int it = VBID; it < 512; it += VNB)
    if (!(it & 1)) gdn_item(p, it >> 1, smem);
}

DEV void mixout_item(const Params& p, int it, char* smem) {
  const u16* P = (const u16*)(p.ws + OFF_BIG);
  const u16* O4 = (const u16*)p.out;
  const float* BS = (const float*)(p.ws + OFF_BSUM);
  const u16* G2T = (const u16*)(p.ws + OFF_G2T);
  u16* Y = (u16*)(p.ws + OFF_HY);
  u16* sg = (u16*)smem;
  u16* G = sg + 32 * 136;
  const int tid = VTID, lane = tid & 63, wave = tid >> 6;
  const int fr = lane & 15, fq = lane >> 4;
  const int tok0 = it * 32, tl0 = tok0 & 2047;
  const int tk = tid >> 3, part = tid & 7;
  const int row = tok0 + tk, t = tl0 + tk;
  const bool hasp = t > 0, hasn = t + 1 < 2048;
  const u16* prow = P + (size_t)row * PS1;
  {
#pragma unroll
    for (int q = 0; q < 2; ++q) {
      const int col = 1792 + part * 16 + q * 8;
      float pc[8], pp[8], pn[8], v[8];
      unpack8(*(const uint4*)(prow + col), pc);
      if (hasp) unpack8(*(const uint4*)(prow - PS1 + col), pp);
      else {
#pragma unroll
        for (int j = 0; j < 8; ++j) pp[j] = 0.f;
      }
      if (hasn) unpack8(*(const uint4*)(prow + PS1 + col), pn);
      else {
#pragma unroll
        for (int j = 0; j < 8; ++j) pn[j] = 0.f;
      }
      const float* mu = p.rw_mu + col;
#pragma unroll
      for (int j = 0; j < 8; ++j) v[j] = sigm(pc[j] + mu[j] * (0.5f * (pp[j] + pn[j]) - pc[j]));
      *(uint4*)(sg + tk * 136 + part * 16 + q * 8) = pack8(v);
    }
  }
  HSYNC();
  {
    bf16x8 af[2][4];
#pragma unroll
    for (int mt = 0; mt < 2; ++mt)
#pragma unroll
      for (int ks = 0; ks < 4; ++ks) af[mt][ks] = *(const bf16x8*)(sg + (mt * 16 + fr) * 136 + ks * 32 + fq * 8);
#pragma unroll
    for (int nt = 0; nt < 8; ++nt) {
      const u16* bp = G2T + (size_t)(wave * 128 + nt * 16 + fr) * 128 + fq * 8;
      bf16x8 bf0 = *(const bf16x8*)(bp), bf1 = *(const bf16x8*)(bp + 32), bf2 = *(const bf16x8*)(bp + 64), bf3 = *(const bf16x8*)(bp + 96);
#pragma unroll
      for (int mt = 0; mt < 2; ++mt) {
        f32x4 a = (f32x4){0.f, 0.f, 0.f, 0.f};
        a = __builtin_amdgcn_mfma_f32_16x16x32_bf16(af[mt][0], bf0, a, 0, 0, 0);
        a = __builtin_amdgcn_mfma_f32_16x16x32_bf16(af[mt][1], bf1, a, 0, 0, 0);
        a = __builtin_amdgcn_mfma_f32_16x16x32_bf16(af[mt][2], bf2, a, 0, 0, 0);
        a = __builtin_amdgcn_mfma_f32_16x16x32_bf16(af[mt][3], bf3, a, 0, 0, 0);
#pragma unroll
        for (int e = 0; e < 4; ++e) G[(mt * 16 + fq * 4 + e) * 520 + wave * 128 + nt * 16 + fr] = f2bf(a[e]);
      }
    }
  }
  HSYNC();
  {
    const int hd = part, c0 = hd * 64;
    const u16* of = O4 + (size_t)row * 512 + c0;
    const u16* ob = O4 + ((size_t)NLAT + row) * 512 + c0;
    const float bsum = BS[(size_t)row * 16 + hd * 2] + BS[(size_t)row * 16 + hd * 2 + 1];
    float s1 = 0.f, s2 = 0.f;
#pragma unroll
    for (int q = 0; q < 8; ++q) {
      float a[8], b8[8];
      unpack8(*(const uint4*)(of + q * 8), a);
      unpack8(*(const uint4*)(ob + q * 8), b8);
#pragma unroll
      for (int j = 0; j < 8; ++j) { const float v = a[j] + b8[j]; s1 += v; s2 += v * v; }
    }
    const float mean = s1 * (1.f / 64.f);
    const float var = fmaxf(s2 * (1.f / 64.f) - mean * mean, 0.f);
    const float rs = rsqrtf(var + 64e-5f);
#pragma unroll
    for (int q = 0; q < 8; ++q) {
      const int c = c0 + q * 8;
      float pc[8], pp[8], pn[8], gv[8], o[8], ya[8], yb[8];
      unpack8(*(const uint4*)(of + q * 8), ya);
      unpack8(*(const uint4*)(ob + q * 8), yb);
      unpack8(*(const uint4*)(prow + 1024 + c), pc);
      if (hasp) unpack8(*(const uint4*)(prow - PS1 + 1024 + c), pp);
      else {
#pragma unroll
        for (int j = 0; j < 8; ++j) pp[j] = 0.f;
      }
      if (hasn) unpack8(*(const uint4*)(prow + PS1 + 1024 + c), pn);
      else {
#pragma unroll
        for (int j = 0; j < 8; ++j) pn[j] = 0.f;
      }
      unpack8(*(const uint4*)(G + tk * 520 + c), gv);
      const float* mu = p.rw_mu + 1024 + c;
      const float* gg = p.rw_lnx_g + c;
      const float* gb = p.rw_lnx_b + c;
#pragma unroll
      for (int j = 0; j < 8; ++j) {
        const float vsh = pc[j] + mu[j] * (0.5f * (pp[j] + pn[j]) - pc[j]);
        const float yn = (ya[j] + yb[j] - mean) * rs * gg[j] + gb[j];
        o[j] = (yn + bsum * vsh) * gv[j];
      }
      *(uint4*)(Y + (size_t)row * 1024 + c) = pack8(o);
    }
  }
  {
    const int c0 = part * 64;
    const u16* of = O4 + ((size_t)2 * NLAT + row) * 512 + c0;
    const u16* ob = O4 + ((size_t)3 * NLAT + row) * 512 + c0;
    float s2 = 0.f;
#pragma unroll
    for (int q = 0; q < 8; ++q) {
      float a[8], b8[8];
      unpack8(*(const uint4*)(of + q * 8), a);
      unpack8(*(const uint4*)(ob + q * 8), b8);
#pragma unroll
      for (int j = 0; j < 8; ++j) { const float v = a[j] + b8[j]; s2 += v * v; }
    }
    s2 += __shfl_xor(s2, 1, 64);
    const float rs = rsqrtf(s2 * (1.f / 128.f) + 1e-6f);
    const u16* zr = prow + DNO + 1536 + c0;
    const float* ng = p.dn_norm_g + (part & 1) * 64;
#pragma unroll
    for (int q = 0; q < 8; ++q) {
      float z[8], r8[8], a[8], b8[8];
      unpack8(*(const uint4*)(of + q * 8), a);
      unpack8(*(const uint4*)(ob + q * 8), b8);
      unpack8(*(const uint4*)(zr + q * 8), z);
#pragma unroll
      for (int j = 0; j < 8; ++j) r8[j] = (a[j] + b8[j]) * rs * ng[q * 8 + j] * silu(z[j]);
      *(uint4*)(Y + (size_t)row * 1024 + 512 + c0 + q * 8) = pack8(r8);
    }
  }
  HSYNC();
}

#define XB_TMO      128
#define XB_XCNT(j)  (256  + 64 * (j))
#define XB_XSUB(j)  (1280 + 64 * (j))
#define XB_XGEN(j)  (2304 + 64 * (j))
#define XB_TOP      3328
#define XB_TOPGEN   3392
#define XCD_BAR_WORDS 3456
#define XB_SPIN_CAP (1u << 20)
DEV unsigned xb_ld(unsigned* p) { return __hip_atomic_load(p, __ATOMIC_RELAXED, __HIP_MEMORY_SCOPE_AGENT); }
DEV unsigned xb_add(unsigned* p, unsigned v) { return __hip_atomic_fetch_add(p, v, __ATOMIC_RELAXED, __HIP_MEMORY_SCOPE_AGENT); }
DEV unsigned xb_xcc_id() { return (unsigned)__builtin_amdgcn_s_getreg((3 << 11) | 20) & 0xFu; }
#define XB_SPIN(cond, bar) do { unsigned _sp = 0; while (cond) { __builtin_amdgcn_s_sleep(1); \
    if ((++_sp & 255u) == 0u) { if (xb_ld(&(bar)[XB_TMO])) break; if (_sp > XB_SPIN_CAP) { atomicAdd(&(bar)[XB_TMO], 1u); break; } } } } while (0)
DEV void xcd_barrier_complete(unsigned* bar, unsigned x, unsigned& nloc, unsigned& nx) {
  const unsigned G = gridDim.x;
  unsigned sum, cnt, mine, sp = 0u;
  for (;;) {
    sum = 0u; cnt = 0u; mine = 0u;
#pragma unroll
    for (unsigned j = 0; j < 16; ++j) { const unsigned c = xb_ld(&bar[XB_XCNT(j)]); sum += c; cnt += (c > 0u) ? 1u : 0u; mine = (j == x) ? c : mine; }
    if (sum == G) break;
    __builtin_amdgcn_s_sleep(1);
    if ((++sp & 255u) == 0u) { if (xb_ld(&bar[XB_TMO])) break; if (sp > XB_SPIN_CAP) { atomicAdd(&bar[XB_TMO], 1u); break; } }
  }
  nloc = mine > 0u ? mine : 1u; nx = cnt > 0u ? cnt : 1u;
}
DEV void xcd_barrier(unsigned* bar) {
  asm volatile("s_waitcnt vmcnt(0)" ::: "memory");
  __syncthreads();
  if (threadIdx.x == 0) {
    __builtin_amdgcn_s_waitcnt(0);
    const unsigned x = xb_xcc_id();
    volatile LAS unsigned* st = (volatile LAS unsigned*)(dyn_smem + HS_OFF + 128);
    unsigned nloc = st[0], nx = st[1];
    if (nloc == 0u) { xcd_barrier_complete(bar, x, nloc, nx); st[0] = nloc; st[1] = nx; }
    const unsigned old = xb_add(&bar[XB_XSUB(x)], 1u);
    const unsigned gen = old / nloc;
    if (old + 1u == (gen + 1u) * nloc) {
      __builtin_amdgcn_fence(__ATOMIC_RELEASE, "agent");
      asm volatile("s_waitcnt vmcnt(0)" ::: "memory");
      const unsigned og = xb_add(&bar[XB_TOP], 1u);
      const unsigned tg = og / nx;
      if (og + 1u == (tg + 1u) * nx) xb_add(&bar[XB_TOPGEN], 1u);
      else XB_SPIN(xb_ld(&bar[XB_TOPGEN]) == tg, bar);
      __builtin_amdgcn_fence(__ATOMIC_ACQUIRE, "agent");
      xb_add(&bar[XB_XGEN(x)], 1u);
      asm volatile("s_waitcnt vmcnt(0)" ::: "memory");
    } else {
      XB_SPIN(xb_ld(&bar[XB_XGEN(x)]) == gen, bar);
      __builtin_amdgcn_fence(__ATOMIC_ACQUIRE, "agent");
      asm volatile("s_waitcnt vmcnt(0)" ::: "memory");
    }
  }
  __syncthreads();
}

constexpr int NPHASE = 18;

__global__ void __launch_bounds__(512, 2) mega(Params p, int ph_lo, int ph_hi) {
  char* smem = dyn_smem + VHALF * HALF_LDS;
  if ((threadIdx.x & 255) == 0) *((LAS unsigned*)(dyn_smem + HS_OFF) + (threadIdx.x >> 8) * 16) = 0u;
  __syncthreads();
  cg::grid_group grid = cg::this_grid();
  const float* mv0 = (const float*)(p.ws + OFF_MODV);
  const float* mv1 = mv0 + 33 * 6144;
  u16* X = (u16*)(p.ws + OFF_X);
  u16* HY = (u16*)(p.ws + OFF_HY);
  u16* BIG = (u16*)(p.ws + OFF_BIG);
  unsigned* bar = (unsigned*)(p.ws + OFF_BAR);
  if (threadIdx.x == 0) {
    volatile LAS unsigned* st = (volatile LAS unsigned*)(dyn_smem + HS_OFF + 128);
    st[0] = 0u; st[1] = 0u;
    (void)xb_add(&bar[XB_XCNT(xb_xcc_id())], 1u);
  }
  if (ph_hi < 0) grid.sync();
#define PHASE(n, BODY) if (ph_lo <= (n) && (n) < ph_hi) { BODY; if ((n) + 1 < ph_hi) xcd_barrier(bar); }
  PHASE(0, phase_prep(p, smem))
  PHASE(1, phase_init(p))
  PHASE(2, gemm_phase<0>(HY, 1024, (const u16*)(p.ws + OFF_WIN0), 1024, NTOK, 2304, BIG, PS0, nullptr, dyn_smem))
  PHASE(3, phase_hyprep_rope(p, smem))
  PHASE(4, phase_conv_attn(p, smem))
  PHASE(5, gemm_phase<2>(HY, 1024, (const u16*)(p.ws + OFF_WOUT0), 1024, NTOK, 1024, X, 1024, mv0 + 2 * 1024, dyn_smem))
  PHASE(6, ln_phase<false>(p, NTOK, p.ln_g, p.ln_b, mv0, 3, 4))
  PHASE(7, gemm_phase<1>(HY, 1024, (const u16*)(p.ws + OFF_W1_0), 1024, NTOK, 4096, BIG, 4096, nullptr, dyn_smem))
  PHASE(8, gemm_phase<2>(BIG, 4096, (const u16*)(p.ws + OFF_W2_0), 4096, NTOK, 1024, X, 1024, mv0 + 5 * 1024, dyn_smem))
  PHASE(9, ln_phase<false>(p, NTOK, p.ln_g + 1024, p.ln_b + 1024, mv1, 0, 1))
  PHASE(10, gemm_phase<0>(HY, 1024, (const u16*)(p.ws + OFF_WIN1), 1024, NTOK, 4096, BIG, PS1, nullptr, dyn_smem))
  PHASE(11, phase_scans(p, smem))
  PHASE(12, for (int it = VBID; it < 2048; it += VNB) mixout_item(p, it, smem))
  PHASE(13, gemm_phase<2>(HY, 1024, (const u16*)(p.ws + OFF_WOUT1), 1024, NLAT, 1024, X, 1024, mv1 + 2 * 1024, dyn_smem))
  PHASE(14, ln_phase<false>(p, NLAT, p.ln_g + 2048, p.ln_b + 2048, mv1, 3, 4))
  PHASE(15, gemm_phase<1>(HY, 1024, (const u16*)(p.ws + OFF_W1_1), 1024, NLAT, 4096, BIG, 4096, nullptr, dyn_smem))
  PHASE(16, gemm_phase<2>(BIG, 4096, (const u16*)(p.ws + OFF_W2_1), 4096, NLAT, 1024, X, 1024, mv1 + 5 * 1024, dyn_smem))
  PHASE(17, ln_phase<true>(p, NLAT, p.ln_g + 3072, p.ln_b + 3072, mv1, 0, 1))
}

extern "C" void kernel_launch(void* const* d_in, const int* in_sizes, int n_in, void* d_out, int out_size, void* d_ws,
                              size_t ws_size, hipStream_t stream) {
  static int grid_blocks = 0;
  if (!grid_blocks) {
    int dev = 0, cus = 0, per_cu = 0;
    hipGetDevice(&dev);
    hipDeviceGetAttribute(&cus, hipDeviceAttributeMultiprocessorCount, dev);
    hipFuncSetAttribute((const void*)mega, hipFuncAttributeMaxDynamicSharedMemorySize, LDS_BYTES);
    hipOccupancyMaxActiveBlocksPerMultiprocessor(&per_cu, mega, 512, LDS_BYTES);
    if (per_cu > 1) per_cu = 1;
    if (per_cu < 1) per_cu = 1;
    grid_blocks = cus * per_cu;
  }
  if (ws_size < WS_NEED) fprintf(stderr, "workspace too small: %zu < %zu\n", ws_size, (size_t)WS_NEED);
  Params p{};
  const float** pp = (const float**)&p;
  for (int i = 0; i < 39; ++i) pp[i] = (const float*)d_in[i];
  p.out = (float*)d_out;
  p.ws = (char*)d_ws;
  int lo = 0, hi = NPHASE;
  void* args[] = {&p, &lo, &hi};
  hipMemsetAsync((char*)d_ws + OFF_BAR, 0, XCD_BAR_WORDS * sizeof(unsigned), stream);
  hipError_t e = hipLaunchCooperativeKernel((void*)mega, dim3(grid_blocks), dim3(512), args, LDS_BYTES, stream);
  if (e != hipSuccess) fprintf(stderr, "cooperative launch failed: %s (grid %d)\n", hipGetErrorString(e), grid_blocks);
}
```

```cpp
#include <hip/hip_runtime.h>
#include <hip/hip_cooperative_groups.h>
#include <cstdio>
#include <cstdint>
namespace cg = cooperative_groups;

typedef unsigned short u16;
typedef __attribute__((ext_vector_type(8))) short bf16x8;
typedef __attribute__((ext_vector_type(4))) float f32x4;
typedef __attribute__((ext_vector_type(16))) float f32x16;

#define DEV __device__ __forceinline__

constexpr int NLAT = 65536, NCTX = 8192, NTOK = 73728;
constexpr int PS0 = 2304;
constexpr int PS1 = 4096;
constexpr int DNO = 1920;
constexpr float ALPHA = 1.4142135623730951f;

constexpr size_t OFF_WIN0 = 0;
constexpr size_t OFF_WOUT0 = OFF_WIN0 + (size_t)2304 * 1024 * 2;
constexpr size_t OFF_W1_0 = OFF_WOUT0 + (size_t)1024 * 1024 * 2;
constexpr size_t OFF_W1_1 = OFF_W1_0 + (size_t)4096 * 1024 * 2;
constexpr size_t OFF_W2_0 = OFF_W1_1 + (size_t)4096 * 1024 * 2;
constexpr size_t OFF_W2_1 = OFF_W2_0 + (size_t)4096 * 1024 * 2;
constexpr size_t OFF_WIN1 = OFF_W2_1 + (size_t)4096 * 1024 * 2;
constexpr size_t OFF_WOUT1 = OFF_WIN1 + (size_t)4096 * 1024 * 2;
constexpr size_t OFF_MODV = OFF_WOUT1 + (size_t)1024 * 1024 * 2;
constexpr size_t OFF_KR2048 = OFF_MODV + (size_t)2 * 33 * 6144 * 4;
constexpr size_t OFF_KR256 = OFF_KR2048 + (size_t)512 * 4096 * 2;
constexpr size_t OFF_ROPE = OFF_KR256 + (size_t)512 * 512 * 2;
constexpr size_t OFF_BSUM = OFF_ROPE + 8192;
constexpr size_t OFF_G2T = OFF_BSUM + (size_t)65536 * 16 * 4;
constexpr size_t OFF_BAR = OFF_G2T + (size_t)512 * 128 * 2;
constexpr size_t OFF_X = (size_t)64 << 20;
constexpr size_t OFF_HY = OFF_X + (size_t)NTOK * 1024 * 2;
constexpr size_t OFF_BIG = OFF_HY + (size_t)NTOK * 1024 * 2;
constexpr size_t WS_NEED = OFF_BIG + (size_t)NTOK * 4096 * 2;
static_assert(OFF_BAR + 16384 <= OFF_X, "ws map");
constexpr size_t SO_U = 0;
constexpr size_t SO_X0 = SO_U + (size_t)512 * 32 * 2048 * 2;
constexpr size_t SO_UC = SO_X0 + (size_t)512 * 32 * 2048 * 2;
constexpr size_t SO_X0C = SO_UC + (size_t)512 * 32 * 256 * 2;

struct Params {
  const float *x, *c, *ctx, *c_ctx, *mod_w, *mod_b, *ln_g, *ln_b, *mlp_w1, *mlp_w2, *e_w_in, *e_w_out, *hy_conv,
      *hy_w1, *hy_b1, *hy_w2, *hy_b2, *hy_freq, *hy_w3, *hy_decay, *hy_bias, *attn_sink, *o_w_in, *o_w_out,
      *rw_mu, *rw_w0, *rw_w2, *rw_a0, *rw_a2, *rw_g2, *rw_kk, *rw_ka, *rw_rk, *rw_lnx_g, *rw_lnx_b,
      *dn_conv, *dn_A_log, *dn_dt_bias, *dn_norm_g;
  float* out;
  char* ws;
};

DEV u16 f2bf(float f) { unsigned u = __float_as_uint(f); u += 0x7fffu + ((u >> 16) & 1u); return (u16)(u >> 16); }
DEV float bf2f(u16 h) { return __uint_as_float(((unsigned)h) << 16); }
DEV float bflo(unsigned u) { return __uint_as_float(u << 16); }
DEV float bfhi(unsigned u) { return __uint_as_float(u & 0xffff0000u); }
DEV unsigned pack2(float a, float b) { return (unsigned)f2bf(a) | ((unsigned)f2bf(b) << 16); }
DEV void unpack8(const uint4& v, float* f) {
  f[0] = bflo(v.x); f[1] = bfhi(v.x); f[2] = bflo(v.y); f[3] = bfhi(v.y);
  f[4] = bflo(v.z); f[5] = bfhi(v.z); f[6] = bflo(v.w); f[7] = bfhi(v.w);
}
DEV uint4 pack8(const float* f) {
  uint4 v; v.x = pack2(f[0], f[1]); v.y = pack2(f[2], f[3]); v.z = pack2(f[4], f[5]); v.w = pack2(f[6], f[7]); return v;
}
DEV int modrow(int r) { return r < NLAT ? (r >> 11) : 32; }
DEV float sigm(float x) { return 1.f / (1.f + __expf(-x)); }
DEV float silu(float x) { return x / (1.f + __expf(-x)); }
DEV float softplus(float x) { return fmaxf(x, 0.f) + __logf(1.f + __expf(-fabsf(x))); }
DEV float fast_tanh(float x) { return 1.f - 2.f / (1.f + __expf(2.f * x)); }
DEV float wave_sum(float v) {
#pragma unroll
  for (int o = 32; o > 0; o >>= 1) v += __shfl_xor(v, o, 64);
  return v;
}

extern __shared__ __attribute__((aligned(16))) char dyn_smem[];
#define LAS __attribute__((address_space(3)))
constexpr int HALF_LDS = 65536;
constexpr int HS_OFF = 2 * HALF_LDS + 2048;
constexpr int LDS_BYTES = HS_OFF + 256;
#define VTID ((int)(threadIdx.x & 255))
#define VHALF ((int)__builtin_amdgcn_readfirstlane((int)(threadIdx.x >> 8)))
#define VBID ((int)(blockIdx.x * 2 + VHALF))
#define VNB ((int)(gridDim.x * 2))
DEV void hsync() {
  LAS unsigned* cnt = (LAS unsigned*)(dyn_smem + HS_OFF) + VHALF * 16;
  asm volatile("s_waitcnt vmcnt(0) lgkmcnt(0)" ::: "memory");
  unsigned tgt = 0u;
  if ((threadIdx.x & 63) == 0) {
    const unsigned old = __hip_atomic_fetch_add(cnt, 1u, __ATOMIC_RELAXED, __HIP_MEMORY_SCOPE_WORKGROUP);
    tgt = (old & ~3u) + 4u;
  }
  tgt = __builtin_amdgcn_readfirstlane(tgt);
  while (__hip_atomic_load(cnt, __ATOMIC_RELAXED, __HIP_MEMORY_SCOPE_WORKGROUP) < tgt) __builtin_amdgcn_s_sleep(0);
  asm volatile("s_waitcnt lgkmcnt(0)" ::: "memory");
}
#define HSYNC() hsync()

DEV void transpose_tile(const float* __restrict__ src, int K, int N, int Npad, u16* __restrict__ dst, int tile,
                               u16* sm) {
  const int tid = VTID;
  const int ntn = Npad >> 6;
  const int tk = tile / ntn, tn = tile - tk * ntn;
  const int n = tid & 63, kq = tid >> 6;
  const int gn = tn * 64 + n;
#pragma unroll 4
  for (int i = 0; i < 16; ++i) {
    int k = kq + 4 * i;
    float v = (gn < N) ? src[(size_t)(tk * 64 + k) * N + gn] : 0.f;
    sm[n * 66 + k] = f2bf(v);
  }
  HSYNC();
  const int n2 = tid >> 2, q = tid & 3;
  const unsigned* s32 = (const unsigned*)sm + (n2 * 66 + q * 16) / 2;
  uint4 a, b;
  a.x = s32[0]; a.y = s32[1]; a.z = s32[2]; a.w = s32[3];
  b.x = s32[4]; b.y = s32[5]; b.z = s32[6]; b.w = s32[7];
  u16* d = dst + (size_t)(tn * 64 + n2) * K + tk * 64 + q * 16;
  *(uint4*)d = a;
  *(uint4*)(d + 8) = b;
  HSYNC();
}

DEV void modv_item(const Params& p, int it, float* sl) {
  const int tid = VTID;
  const int l = it / 288, rem = it % 288, cc = rem / 3, rg = rem % 3;
  for (int idx = tid; idx < 11 * 1024; idx += 256) {
    int r = rg * 11 + (idx >> 10), k = idx & 1023;
    float cv = (r < 32) ? p.c[r * 1024 + k] : p.c_ctx[k];
    sl[idx] = cv / (1.f + expf(-cv));
  }
  HSYNC();
  const int cl = tid & 63, kg = tid >> 6;
  const int col = cc * 64 + cl;
  float acc[11];
#pragma unroll
  for (int r = 0; r < 11; ++r) acc[r] = 0.f;
  const float* w = p.mod_w + (size_t)l * 1024 * 6144 + (size_t)(kg * 256) * 6144 + col;
#pragma unroll 8
  for (int k = 0; k < 256; ++k) {
    float wv = w[(size_t)k * 6144];
#pragma unroll
    for (int r = 0; r < 11; ++r) acc[r] += sl[r * 1024 + kg * 256 + k] * wv;
  }
  HSYNC();
  float* red = sl;
#pragma unroll
  for (int r = 0; r < 11; ++r) red[(kg * 11 + r) * 64 + cl] = acc[r];
  HSYNC();
  for (int idx = tid; idx < 11 * 64; idx += 256) {
    int r = idx >> 6, c2 = idx & 63;
    float v = red[(0 * 11 + r) * 64 + c2] + red[(1 * 11 + r) * 64 + c2] + red[(2 * 11 + r) * 64 + c2] + red[(3 * 11 + r) * 64 + c2];
    int gcol = cc * 64 + c2;
    ((float*)(p.ws + OFF_MODV))[(size_t)(l * 33 + rg * 11 + r) * 6144 + gcol] = v + p.mod_b[l * 6144 + gcol];
  }
  HSYNC();
}

DEV void filter_item(const Params& p, int it, float* sm) {
  const int L = it < 2048 ? 2048 : 256;
  const int t = it < 2048 ? it : it - 2048;
  u16* R = (u16*)(p.ws + (L == 2048 ? OFF_KR2048 : OFF_KR256));
  float* pe = sm; float* h1 = sm + 64; float* h2 = sm + 128;
  const int tid = VTID;
  const float tn = (float)t / (float)(L - 1);
  if (tid < 33) {
    float v;
    if (tid == 0) v = tn;
    else {
      int i = (tid - 1) & 15;
      double band = 1e-4 + (double)i * ((15.0 - 1e-4) / 15.0);
      double ang = 2.0 * 3.14159265358979323846 * (double)t * band / (double)L;
      v = (tid <= 16) ? (float)cos(ang) : (float)(-sin(ang));
    }
    pe[tid] = v;
  }
  HSYNC();
  if (tid < 64) {
    float acc = p.hy_b1[tid];
#pragma unroll 11
    for (int i = 0; i < 33; ++i) acc += pe[i] * p.hy_w1[i * 64 + tid];
    h1[tid] = sinf(p.hy_freq[tid] * acc);
  }
  HSYNC();
  if (tid < 64) {
    float acc = p.hy_b2[tid];
#pragma unroll 16
    for (int i = 0; i < 64; ++i) acc += h1[i] * p.hy_w2[i * 64 + tid];
    h2[tid] = sinf(p.hy_freq[tid] * acc);
  }
  HSYNC();
#pragma unroll 1
  for (int q = 0; q < 4; ++q) {
    int o = tid + 256 * q;
    float acc = 0.f;
#pragma unroll 16
    for (int i = 0; i < 64; ++i) acc += h2[i] * p.hy_w3[i * 1024 + o];
    float val = acc * expf(-tn * fabsf(p.hy_decay[o]));
    if (o < 512) {
      if (t == 0) val += p.hy_bias[o];
      R[(size_t)o * 2 * L + L - t] = f2bf(val);
    } else {
      int c = o - 512;
      if (t >= 1) R[(size_t)c * 2 * L + L + t] = f2bf(val);
      else R[(size_t)c * 2 * L] = 0;
    }
  }
  HSYNC();
}

DEV void phase_prep(const Params& p, char* smem) {
  constexpr int T_IN0 = 16 * 36, T_OUT = 16 * 16, T_W = 16 * 64;
  constexpr int E0 = T_IN0, E1 = E0 + T_OUT, E2 = E1 + T_W, E3 = E2 + T_W, E4 = E3 + T_W, E5 = E4 + T_W,
                E6 = E5 + T_W, E7 = E6 + T_OUT, E8 = E7 + 576, E9 = E8 + 2304, E10 = E9 + 1, E11 = E10 + 16;
  for (int it = VBID; it < E11; it += VNB) {
    if (it >= E10) transpose_tile(p.rw_g2, 128, 512, 512, (u16*)(p.ws + OFF_G2T), it - E10, (u16*)smem);
    else if (it < E0) transpose_tile(p.e_w_in, 1024, 2304, 2304, (u16*)(p.ws + OFF_WIN0), it, (u16*)smem);
    else if (it < E1) transpose_tile(p.e_w_out, 1024, 1024, 1024, (u16*)(p.ws + OFF_WOUT0), it - E0, (u16*)smem);
    else if (it < E2) transpose_tile(p.mlp_w1, 1024, 4096, 4096, (u16*)(p.ws + OFF_W1_0), it - E1, (u16*)smem);
    else if (it < E3) transpose_tile(p.mlp_w1 + (size_t)1024 * 4096, 1024, 4096, 4096, (u16*)(p.ws + OFF_W1_1), it - E2, (u16*)smem);
    else if (it < E4) transpose_tile(p.mlp_w2, 4096, 1024, 1024, (u16*)(p.ws + OFF_W2_0), it - E3, (u16*)smem);
    else if (it < E5) transpose_tile(p.mlp_w2 + (size_t)1024 * 4096, 4096, 1024, 1024, (u16*)(p.ws + OFF_W2_1), it - E4, (u16*)smem);
    else if (it < E6) transpose_tile(p.o_w_in, 1024, 3984, 4096, (u16*)(p.ws + OFF_WIN1), it - E5, (u16*)smem);
    else if (it < E7) transpose_tile(p.o_w_out, 1024, 1024, 1024, (u16*)(p.ws + OFF_WOUT1), it - E6, (u16*)smem);
    else if (it < E8) modv_item(p, it - E7, (float*)smem);
    else if (it < E9) filter_item(p, it - E8, (float*)smem);
    else {
      float2* tab = (float2*)(p.ws + OFF_ROPE);
      for (int q = 0; q < 4; ++q) {
        int e = VTID * 4 + q;
        int pos = e >> 4, i = e & 15;
        float inv = powf(10000.f, -(float)i / 16.f);
        float ang = (float)pos * inv;
        tab[e] = make_float2(cosf(ang), sinf(ang));
      }
    }
  }
}

DEV void phase_init(const Params& p) {
  const float* mv = (const float*)(p.ws + OFF_MODV);
  u16* X = (u16*)(p.ws + OFF_X);
  u16* HM = (u16*)(p.ws + OFF_HY);
  const size_t total = (size_t)NTOK * 128;
  for (size_t i = (size_t)VBID * 256 + VTID; i < total; i += (size_t)VNB * 256) {
    int r = (int)(i >> 7), c8 = (int)(i & 127) * 8;
    const float* src = r < NLAT ? p.x + (size_t)r * 1024 + c8 : p.ctx + (size_t)(r - NLAT) * 1024 + c8;
    float4 v0 = *(const float4*)src, v1 = *(const float4*)(src + 4);
    const float* m = mv + (size_t)modrow(r) * 6144 + c8;
    float4 h0 = *(const float4*)m, h1 = *(const float4*)(m + 4);
    float4 s0 = *(const float4*)(m + 1024), s1 = *(const float4*)(m + 1028);
    float f[8] = {v0.x, v0.y, v0.z, v0.w, v1.x, v1.y, v1.z, v1.w};
    float sh[8] = {h0.x, h0.y, h0.z, h0.w, h1.x, h1.y, h1.z, h1.w};
    float sc[8] = {s0.x, s0.y, s0.z, s0.w, s1.x, s1.y, s1.z, s1.w};
    float g[8];
#pragma unroll
    for (int j = 0; j < 8; ++j) g[j] = f[j] * (1.f + sc[j]) + sh[j];
    *(uint4*)(X + (size_t)r * 1024 + c8) = pack8(f);
    *(uint4*)(HM + (size_t)r * 1024 + c8) = pack8(g);
  }
}

template <int EPI>
DEV void gemm_phase(const u16* __restrict__ A, int lda, const u16* __restrict__ Bt, int K, int M, int N,
                    u16* __restrict__ C, int ldc, const float* __restrict__ gate, char* smem) {
  const int tid = threadIdx.x, lane = tid & 63, wave = tid >> 6;
  const int wm = wave >> 2, wn = wave & 3;
  const int fr = lane & 15, fq = lane >> 4;
  const int tn = N >> 8, tm = M >> 8, tiles = tm * tn;
  const int nk = K >> 6;
  const int drow = wave * 8 + (lane >> 3);
  const int dchunk = (lane & 7) ^ ((drow >> 1) & 7);
  const size_t lda64 = (size_t)lda * 64, ldb64 = (size_t)K * 64;
  const int sw = fr >> 1;
  const bool xcd_order = (gridDim.x & 7) == 0 && (tm & 31) == 0;
  const int mx = tm >> 3;
#define G_COORDS(IT, M0, N0)                                                   \
  {                                                                            \
    int tm_i, tn_i;                                                            \
    if (xcd_order) {                                                           \
      const int x = (IT) & 7, local = (IT) >> 3;                               \
      const int mg = local / (4 * tn), r = local - mg * 4 * tn;                \
      tn_i = r >> 2;                                                           \
      tm_i = x * mx + mg * 4 + (r & 3);                                        \
    } else { tm_i = (IT) / tn; tn_i = (IT) - tm_i * tn; }                      \
    M0 = tm_i << 8; N0 = tn_i << 8;                                            \
  }
  int m0 = 0, n0 = 0;
  const u16* ag = A;
  const u16* bg = Bt;
  bool primed = false;
  for (int it = blockIdx.x; it < tiles; it += gridDim.x) {
    if (!primed) {
      G_COORDS(it, m0, n0)
      ag = A + (size_t)(m0 + drow) * lda + dchunk * 8;
      bg = Bt + (size_t)(n0 + drow) * K + dchunk * 8;
    }
    f32x4 acc[8][4];
#pragma unroll
    for (int i = 0; i < 8; ++i)
#pragma unroll
      for (int j = 0; j < 4; ++j) acc[i][j] = (f32x4){0.f, 0.f, 0.f, 0.f};
#define G_ISSUE(KT, ST)                                                                                  \
  {                                                                                                      \
    const u16* a2 = ag + (KT)*64;                                                                        \
    const u16* b2 = bg + (KT)*64;                                                                        \
    char* la = smem + (ST)*65536 + wave * 1024;                                                          \
    _Pragma("unroll") for (int j = 0; j < 4; ++j) {                                                      \
      __builtin_amdgcn_global_load_lds((const unsigned*)(a2 + j * lda64), (unsigned*)(la + j * 8192), 16, 0, 0);          \
      __builtin_amdgcn_global_load_lds((const unsigned*)(b2 + j * ldb64), (unsigned*)(la + 32768 + j * 8192), 16, 0, 0);  \
    }                                                                                                    \
  }
    if (!primed) G_ISSUE(0, 0)
    for (int kt = 0; kt < nk; ++kt) {
      asm volatile("s_waitcnt vmcnt(0)" ::: "memory");
      __syncthreads();
      if (kt + 1 < nk) G_ISSUE(kt + 1, (kt + 1) & 1)
      const u16* As = (const u16*)(smem + (kt & 1) * 65536);
      const u16* Bs = As + 16384;
#define LDA(i, ks) (*(const bf16x8*)(As + (wm * 128 + (i) * 16 + fr) * 64 + ((((ks) * 4 + fq) ^ sw) * 8)))
#define LDB(j, ks) (*(const bf16x8*)(Bs + (wn * 64 + (j) * 16 + fr) * 64 + ((((ks) * 4 + fq) ^ sw) * 8)))
#define SB __builtin_amdgcn_sched_barrier(0)
#define MFMA_H(R, X0, Y0) acc[R][0] = __builtin_amdgcn_mfma_f32_16x16x32_bf16(X0, Y0, acc[R][0], 0, 0, 0);
#define MFMA_T(R, X0, X1, Y0, Y1, Y2, Y3)                                                  \
  acc[R][1] = __builtin_amdgcn_mfma_f32_16x16x32_bf16(X0, Y1, acc[R][1], 0, 0, 0);         \
  acc[R][2] = __builtin_amdgcn_mfma_f32_16x16x32_bf16(X0, Y2, acc[R][2], 0, 0, 0);         \
  acc[R][3] = __builtin_amdgcn_mfma_f32_16x16x32_bf16(X0, Y3, acc[R][3], 0, 0, 0);         \
  acc[R + 1][0] = __builtin_amdgcn_mfma_f32_16x16x32_bf16(X1, Y0, acc[R + 1][0], 0, 0, 0); \
  acc[R + 1][1] = __builtin_amdgcn_mfma_f32_16x16x32_bf16(X1, Y1, acc[R + 1][1], 0, 0, 0); \
  acc[R + 1][2] = __builtin_amdgcn_mfma_f32_16x16x32_bf16(X1, Y2, acc[R + 1][2], 0, 0, 0); \
  acc[R + 1][3] = __builtin_amdgcn_mfma_f32_16x16x32_bf16(X1, Y3, acc[R + 1][3], 0, 0, 0);
      {
        bf16x8 b0 = LDB(0, 0), b1 = LDB(1, 0), b2 = LDB(2, 0), b3 = LDB(3, 0);
        bf16x8 a0 = LDA(0, 0), a1 = LDA(1, 0);
        bf16x8 n0, n1, c0, c1, c2, c3;
        SB; MFMA_H(0, a0, b0) SB; n0 = LDA(2, 0); n1 = LDA(3, 0); SB; MFMA_T(0, a0, a1, b0, b1, b2, b3) SB;
        MFMA_H(2, n0, b0) SB; a0 = LDA(4, 0); a1 = LDA(5, 0); SB; MFMA_T(2, n0, n1, b0, b1, b2, b3) SB;
        MFMA_H(4, a0, b0) SB; n0 = LDA(6, 0); n1 = LDA(7, 0); SB; MFMA_T(4, a0, a1, b0, b1, b2, b3) SB;
        MFMA_H(6, n0, b0) SB;
        c0 = LDB(0, 1); c1 = LDB(1, 1); c2 = LDB(2, 1); c3 = LDB(3, 1); a0 = LDA(0, 1); a1 = LDA(1, 1);
        SB; MFMA_T(6, n0, n1, b0, b1, b2, b3) SB;
        MFMA_H(0, a0, c0) SB; n0 = LDA(2, 1); n1 = LDA(3, 1); SB; MFMA_T(0, a0, a1, c0, c1, c2, c3) SB;
        MFMA_H(2, n0, c0) SB; a0 = LDA(4, 1); a1 = LDA(5, 1); SB; MFMA_T(2, n0, n1, c0, c1, c2, c3) SB;
        MFMA_H(4, a0, c0) SB; n0 = LDA(6, 1); n1 = LDA(7, 1); SB; MFMA_T(4, a0, a1, c0, c1, c2, c3) SB;
        MFMA_H(6, n0, c0) MFMA_T(6, n0, n1, c0, c1, c2, c3) SB;
      }
#undef LDA
#undef LDB
#undef SB
#undef MFMA_H
#undef MFMA_T
    }
    const int cm0 = m0, cn0 = n0;
    primed = false;
    if (it + (int)gridDim.x < tiles) {
      G_COORDS(it + (int)gridDim.x, m0, n0)
      ag = A + (size_t)(m0 + drow) * lda + dchunk * 8;
      bg = Bt + (size_t)(n0 + drow) * K + dchunk * 8;
      G_ISSUE(0, 0)
      primed = true;
    }
    u16* Cs = (u16*)(smem + 65536);
#pragma unroll 1
    for (int hp = 0; hp < 2; ++hp) {
      asm volatile("s_waitcnt lgkmcnt(0)" ::: "memory");
      __builtin_amdgcn_s_barrier();
      asm volatile("" ::: "memory");
      if (wm == hp) {
#pragma unroll
        for (int i = 0; i < 8; ++i)
#pragma unroll
          for (int j = 0; j < 4; ++j)
#pragma unroll
            for (int e = 0; e < 4; ++e) {
              float v = acc[i][j][e];
              if (EPI == 1) { v = fmaxf(v, 0.f); v = v * v; }
              Cs[(i * 16 + fq * 4 + e) * 264 + wn * 64 + j * 16 + fr] = f2bf(v);
            }
      }
      asm volatile("s_waitcnt lgkmcnt(0)" ::: "memory");
      __builtin_amdgcn_s_barrier();
      asm volatile("" ::: "memory");
#pragma unroll 2
      for (int q = 0; q < 8; ++q) {
        const int chunk = tid + q * 512;
        const int row = chunk >> 5, cc = chunk & 31;
        uint4 cv = *(const uint4*)(Cs + row * 264 + cc * 8);
        const int grow = cm0 + hp * 128 + row;
        u16* dst = C + (size_t)grow * ldc + cn0 + cc * 8;
        if (EPI == 2) {
          float a[8], xo[8], y[8];
          unpack8(cv, a);
          unpack8(*(const uint4*)dst, xo);
          const float* gr = gate + (size_t)modrow(grow) * 6144 + cn0 + cc * 8;
          float4 g0 = *(const float4*)gr, g1 = *(const float4*)(gr + 4);
          float gg[8] = {g0.x, g0.y, g0.z, g0.w, g1.x, g1.y, g1.z, g1.w};
#pragma unroll
          for (int j = 0; j < 8; ++j) y[j] = ALPHA * xo[j] + gg[j] * a[j];
          cv = pack8(y);
        }
        *(uint4*)dst = cv;
      }
    }
    asm volatile("s_waitcnt lgkmcnt(0)" ::: "memory");
    __builtin_amdgcn_s_barrier();
    asm volatile("" ::: "memory");
  }
#undef G_ISSUE
#undef G_COORDS
}

template <bool FINAL>
DEV void ln_phase(const Params& p, int M, const float* __restrict__ g, const float* __restrict__ b,
                         const float* __restrict__ modl  , int shi, int sci) {
  u16* X = (u16*)(p.ws + OFF_X);
  u16* HM = (u16*)(p.ws + OFF_HY);
  const int lane = VTID & 63;
  const int gw = VBID * 4 + (VTID >> 6), nw = VNB * 4;
  uint4 nx0 = make_uint4(0u, 0u, 0u, 0u), nx1 = nx0;
  if (gw < M) {
    nx0 = *(const uint4*)(X + (size_t)gw * 1024 + lane * 8);
    nx1 = *(const uint4*)(X + (size_t)gw * 1024 + 512 + lane * 8);
  }
  for (int row = gw; row < M; row += nw) {
    u16* xr = X + (size_t)row * 1024;
    float f[16];
    unpack8(nx0, f);
    unpack8(nx1, f + 8);
    if (row + nw < M) {
      nx0 = *(const uint4*)(xr + (size_t)nw * 1024 + lane * 8);
      nx1 = *(const uint4*)(xr + (size_t)nw * 1024 + 512 + lane * 8);
    }
    float s = 0.f, q = 0.f;
#pragma unroll
    for (int j = 0; j < 16; ++j) { s += f[j]; q += f[j] * f[j]; }
#pragma unroll
    for (int o = 32; o > 0; o >>= 1) { s += __shfl_xor(s, o, 64); q += __shfl_xor(q, o, 64); }
    const float mu = s * (1.f / 1024.f);
    const float rs = rsqrtf(fmaxf(q * (1.f / 1024.f) - mu * mu, 0.f) + 1e-5f);
#pragma unroll
    for (int j = 0; j < 16; ++j) f[j] -= mu;
#pragma unroll
    for (int hh = 0; hh < 2; ++hh) {
      const int c0 = hh * 512 + lane * 8;
      float y[8];
#pragma unroll
      for (int j = 0; j < 8; ++j) y[j] = f[hh * 8 + j] * rs * g[c0 + j] + b[c0 + j];
      if (FINAL) {
        float* o = p.out + (size_t)row * 1024 + c0;
        *(float4*)o = make_float4(y[0], y[1], y[2], y[3]);
        *(float4*)(o + 4) = make_float4(y[4], y[5], y[6], y[7]);
      } else {
        *(uint4*)(xr + c0) = pack8(y);
        const float* m = modl + (size_t)modrow(row) * 6144;
        float h[8];
#pragma unroll
        for (int j = 0; j < 8; ++j) h[j] = y[j] * (1.f + m[sci * 1024 + c0 + j]) + m[shi * 1024 + c0 + j];
        *(uint4*)(HM + (size_t)row * 1024 + c0) = pack8(h);
      }
    }
  }
}

DEV void hyprep_item(const Params& p, int it, char* smem) {
  u16* su = (u16*)smem;
  u16* sx = su + 64 * 66;
  const u16* P = (const u16*)(p.ws + OFF_BIG);
  const int tid = VTID;
  const int ct = it & 7, st = it >> 3;
  int b, t0, L, rowbase;
  u16 *U, *X0;
  if (st < 1024) { b = st >> 5; t0 = (st & 31) * 64; L = 2048; rowbase = b * 2048;
    U = (u16*)((char*)p.out + SO_U); X0 = (u16*)((char*)p.out + SO_X0); }
  else { int s2 = st - 1024; b = s2 >> 2; t0 = (s2 & 3) * 64; L = 256; rowbase = NLAT + b * 256;
    U = (u16*)((char*)p.out + SO_UC); X0 = (u16*)((char*)p.out + SO_X0C); }
  const int c0 = ct * 64;
  {
    const int t = tid >> 2, cq = tid & 3;
    float z[3][16];
#pragma unroll
    for (int g = 0; g < 3; ++g)
#pragma unroll
      for (int j = 0; j < 16; ++j) z[g][j] = 0.f;
#pragma unroll
    for (int tap = 0; tap < 3; ++tap) {
      const int tt = t0 + t + tap - 1;
      if (tt >= 0 && tt < L) {
#pragma unroll
        for (int g = 0; g < 3; ++g) {
          const int col = g * 512 + c0 + cq * 16;
          const u16* src = P + (size_t)(rowbase + tt) * PS0 + col;
          float f[16];
          unpack8(*(const uint4*)src, f);
          unpack8(*(const uint4*)(src + 8), f + 8);
          const float* w = p.hy_conv + tap * 1536 + col;
#pragma unroll
          for (int j = 0; j < 16; ++j) z[g][j] += f[j] * w[j];
        }
      }
    }
#pragma unroll
    for (int j = 0; j < 16; ++j) {
      su[t * 66 + cq * 16 + j] = f2bf(z[1][j] * z[2][j]);
      sx[t * 66 + cq * 16 + j] = f2bf(z[0][j]);
    }
  }
  HSYNC();
  {
    const int c = tid >> 2, tq = tid & 3;
    unsigned wu[8], wx[8];
#pragma unroll
    for (int j = 0; j < 8; ++j) {
      wu[j] = (unsigned)su[(tq * 16 + 2 * j) * 66 + c] | ((unsigned)su[(tq * 16 + 2 * j + 1) * 66 + c] << 16);
      wx[j] = (unsigned)sx[(tq * 16 + 2 * j) * 66 + c] | ((unsigned)sx[(tq * 16 + 2 * j + 1) * 66 + c] << 16);
    }
    const size_t o = ((size_t)(c0 + c) * 32 + b) * L + t0 + tq * 16;
    *(uint4*)(U + o) = make_uint4(wu[0], wu[1], wu[2], wu[3]);
    *(uint4*)(U + o + 8) = make_uint4(wu[4], wu[5], wu[6], wu[7]);
    *(uint4*)(X0 + o) = make_uint4(wx[0], wx[1], wx[2], wx[3]);
    *(uint4*)(X0 + o + 8) = make_uint4(wx[4], wx[5], wx[6], wx[7]);
  }
  HSYNC();
}

DEV void rope_item(const Params& p, int it) {
  u16* P = (u16*)(p.ws + OFF_BIG);
  const float2* tab = (const float2*)(p.ws + OFF_ROPE);
  const int task = it * 256 + VTID;
  const int row = task / 40, rem = task - row * 40;
  const int head = rem >> 2, pr = rem & 3;
  const int d0 = (pr >> 1) * 32 + (pr & 1) * 8;
  const int t = row & 2047;
  const int posc = (pr >> 1) ? (t & 63) : (t >> 6);
  const int fi0 = (pr & 1) * 8;
  u16* ptr = P + (size_t)row * PS0 + 1536 + head * 64 + d0;
  float u1[8], u2[8], o1[8], o2[8];
  unpack8(*(const uint4*)ptr, u1);
  unpack8(*(const uint4*)(ptr + 16), u2);
#pragma unroll
  for (int j = 0; j < 8; ++j) {
    float2 cs = tab[posc * 16 + fi0 + j];
    o1[j] = u1[j] * cs.x - u2[j] * cs.y;
    o2[j] = u1[j] * cs.y + u2[j] * cs.x;
  }
  *(uint4*)ptr = pack8(o1);
  *(uint4*)(ptr + 16) = pack8(o2);
}

DEV void phase_hyprep_rope(const Params& p, char* smem) {
  constexpr int NH = 9216, NR = 10240;
  for (int it = VBID; it < NH + NR; it += VNB) {
    if (it < NH) hyprep_item(p, it, smem);
    else rope_item(p, it - NH);
  }
}

template <int L, int NT>
DEV void conv_item(const Params& p, int c, int th, char* smem) {
  const u16* R = (const u16*)(p.ws + (L == 2048 ? OFF_KR2048 : OFF_KR256)) + (size_t)c * 2 * L;
  const u16* U = (const u16*)((const char*)p.out + (L == 2048 ? SO_U : SO_UC));
  const u16* X0 = (const u16*)((const char*)p.out + (L == 2048 ? SO_X0 : SO_X0C));
  u16* Y = (u16*)(p.ws + OFF_HY);
  u16* Rs0 = (u16*)smem;
  u16* Rs1 = Rs0 + 2 * L + 8;
  const int tid = VTID, lane = tid & 63, wave = tid >> 6;
  for (int i = tid; i < 2 * L; i += 256) {
    Rs0[i] = R[i];
    Rs1[i] = (i + 1 < 2 * L) ? R[i + 1] : (u16)0;
  }
  HSYNC();
  const int r = lane & 31, h = lane >> 5;
  const char* lanebase = (r & 1) ? (const char*)Rs1 + 2 * (8 * h - r + L - 1) : (const char*)Rs0 + 2 * (8 * h - r + L);
  const u16* Ub = U + ((size_t)c * 32 + r) * L + 8 * h;
  const int tw0 = th * 1024 + wave * NT * 32;
  f32x16 acc[NT];
#pragma unroll
  for (int i = 0; i < NT; ++i)
#pragma unroll
    for (int e = 0; e < 16; ++e) acc[i][e] = 0.f;
  uint4 nb = *(const uint4*)Ub;
  for (int st = 0; st < L / 16; ++st) {
    uint4 cur = nb;
    if (st + 1 < L / 16) nb = *(const uint4*)(Ub + (st + 1) * 16);
    bf16x8 bfrag = *(bf16x8*)&cur;
#pragma unroll
    for (int i = 0; i < NT; ++i) {
      const unsigned* ap = (const unsigned*)(lanebase + 2 * (st * 16 - (tw0 + i * 32)));
      uint4 av = make_uint4(ap[0], ap[1], ap[2], ap[3]);
      acc[i] = __builtin_amdgcn_mfma_f32_32x32x16_bf16(*(bf16x8*)&av, bfrag, acc[i], 0, 0, 0);
    }
  }
  const int rowbase = (L == 2048) ? r * 2048 : NLAT + r * 256;
#pragma unroll
  for (int i = 0; i < NT; ++i) {
#pragma unroll
    for (int g4 = 0; g4 < 4; ++g4) {
      const int tt = tw0 + i * 32 + 8 * g4 + 4 * h;
      uint2 xv = *(const uint2*)(X0 + ((size_t)c * 32 + r) * L + tt);
      float x0[4] = {bflo(xv.x), bfhi(xv.x), bflo(xv.y), bfhi(xv.y)};
#pragma unroll
      for (int e = 0; e < 4; ++e) Y[(size_t)(rowbase + tt + e) * 1024 + c] = f2bf(acc[i][g4 * 4 + e] * x0[e]);
    }
  }
  HSYNC();
}

DEV void attn_item(const Params& p, int b, int hq, int qb, bool isctx, char* smem) {
  const u16* P = (const u16*)(p.ws + OFF_BIG);
  u16* Y = (u16*)(p.ws + OFF_HY);
  u16* Ks = (u16*)smem;
  u16* Vt = Ks + 64 * 72;
  const int tid = VTID, lane = tid & 63, wave = tid >> 6;
  const int nq = lane & 15, quad = lane >> 4;
  const int qrow = (isctx ? NLAT + b * 256 : b * 2048) + qb * 64 + wave * 16 + nq;
  const int qpos = qb * 64 + wave * 16 + nq;
  const int hkv = hq >> 2;
  const int kcol = 2048 + hkv * 64, vcol = 2176 + hkv * 64;
  bf16x8 qf[2];
#pragma unroll
  for (int ks = 0; ks < 2; ++ks)
    qf[ks] = *(const bf16x8*)(P + (size_t)qrow * PS0 + 1536 + hq * 64 + ks * 32 + quad * 8);
  float m = p.attn_sink[hq];
  float lsum = (quad == 0) ? 1.f : 0.f;
  f32x4 oacc[4];
#pragma unroll
  for (int n = 0; n < 4; ++n) oacc[n] = (f32x4){0.f, 0.f, 0.f, 0.f};
  const int nloc = isctx ? 0 : 5;
  for (int ti = 0; ti < nloc + 4; ++ti) {
    int krow0, k0 = 0;
    bool masked;
    if (ti < nloc) {
      k0 = qb * 64 - 128 + ti * 64;
      if (k0 < 0 || k0 >= 2048) continue;
      krow0 = b * 2048 + k0; masked = true;
    } else { krow0 = NLAT + b * 256 + (ti - nloc) * 64; masked = false; }
    HSYNC();
    {
      const int key = tid >> 2, part = tid & 3;
      const u16* kp = P + (size_t)(krow0 + key) * PS0 + kcol + part * 16;
      const u16* vp = P + (size_t)(krow0 + key) * PS0 + vcol + part * 16;
      uint4 k0v = *(const uint4*)kp, k1v = *(const uint4*)(kp + 8);
      uint4 v0v = *(const uint4*)vp, v1v = *(const uint4*)(vp + 8);
      *(uint4*)(Ks + key * 72 + part * 16) = k0v;
      *(uint4*)(Ks + key * 72 + part * 16 + 8) = k1v;
      unsigned vw[8] = {v0v.x, v0v.y, v0v.z, v0v.w, v1v.x, v1v.y, v1v.z, v1v.w};
#pragma unroll
      for (int j = 0; j < 8; ++j) {
        Vt[(part * 16 + 2 * j) * 72 + key] = (u16)(vw[j] & 0xffffu);
        Vt[(part * 16 + 2 * j + 1) * 72 + key] = (u16)(vw[j] >> 16);
      }
    }
    HSYNC();
    f32x4 s[4];
#pragma unroll
    for (int n = 0; n < 4; ++n) {
      s[n] = (f32x4){0.f, 0.f, 0.f, 0.f};
#pragma unroll
      for (int ks = 0; ks < 2; ++ks) {
        bf16x8 kf = *(const bf16x8*)(Ks + (n * 16 + nq) * 72 + ks * 32 + quad * 8);
        s[n] = __builtin_amdgcn_mfma_f32_16x16x32_bf16(kf, qf[ks], s[n], 0, 0, 0);
      }
    }
    float mx = -1e30f;
#pragma unroll
    for (int n = 0; n < 4; ++n)
#pragma unroll
      for (int e = 0; e < 4; ++e) {
        float v = s[n][e] * 0.125f;
        if (masked) {
          int kpos = k0 + n * 16 + quad * 4 + e;
          int d = qpos - kpos;
          if (d > 128 || d < -128) v = -1e30f;
        }
        s[n][e] = v;
        mx = fmaxf(mx, v);
      }
    mx = fmaxf(mx, __shfl_xor(mx, 16, 64));
    mx = fmaxf(mx, __shfl_xor(mx, 32, 64));
    const float mn = fmaxf(m, mx);
    const float al = __expf(m - mn);
    m = mn;
    float ps = 0.f;
#pragma unroll
    for (int n = 0; n < 4; ++n)
#pragma unroll
      for (int e = 0; e < 4; ++e) { float pv = __expf(s[n][e] - mn); s[n][e] = pv; ps += pv; }
    lsum = lsum * al + ps;
#pragma unroll
    for (int n = 0; n < 4; ++n)
#pragma unroll
      for (int e = 0; e < 4; ++e) oacc[n][e] *= al;
#pragma unroll
    for (int hh = 0; hh < 2; ++hh) {
      uint4 pw;
      pw.x = pack2(s[2 * hh][0], s[2 * hh][1]); pw.y = pack2(s[2 * hh][2], s[2 * hh][3]);
      pw.z = pack2(s[2 * hh + 1][0], s[2 * hh + 1][1]); pw.w = pack2(s[2 * hh + 1][2], s[2 * hh + 1][3]);
      bf16x8 pb = *(bf16x8*)&pw;
#pragma unroll
      for (int n = 0; n < 4; ++n) {
        const u16* vr = Vt + (n * 16 + nq) * 72 + quad * 4;
        uint2 va = *(const uint2*)(vr + (2 * hh) * 16);
        uint2 vb = *(const uint2*)(vr + (2 * hh + 1) * 16);
        uint4 vv = make_uint4(va.x, va.y, vb.x, vb.y);
        oacc[n] = __builtin_amdgcn_mfma_f32_16x16x32_bf16(*(bf16x8*)&vv, pb, oacc[n], 0, 0, 0);
      }
    }
  }
  lsum += __shfl_xor(lsum, 16, 64);
  lsum += __shfl_xor(lsum, 32, 64);
  const float inv = 1.f / lsum;
  u16* yo = Y + (size_t)qrow * 1024 + 512 + hq * 64 + quad * 4;
#pragma unroll
  for (int n = 0; n < 4; ++n) {
    uint2 w;
    w.x = pack2(oacc[n][0] * inv, oacc[n][1] * inv);
    w.y = pack2(oacc[n][2] * inv, oacc[n][3] * inv);
    *(uint2*)(yo + n * 16) = w;
  }
  HSYNC();
}

DEV void phase_conv_attn(const Params& p, char* smem) {
  constexpr int N0 = 1024, N1 = N0 + 512, N2 = N1 + 8192, N3 = N2 + 1024;
#pragma unroll 1
  for (int it = VBID; it < N0; it += VNB) conv_item<2048, 8>(p, it >> 1, it & 1, smem);
  __builtin_amdgcn_sched_barrier(0);
#pragma unroll 1
  for (int it = VBID; it < N3; it += VNB) {
    if (it < N0) continue;
    if (it < N1) conv_item<256, 2>(p, it - N0, 0, smem);
  }
  __builtin_amdgcn_sched_barrier(0);
#pragma unroll 1
  for (int it = VBID; it < N3; it += VNB) {
    if (it < N1) continue;
    if (it < N2) { int a = it - N1; attn_item(p, a >> 8, (a >> 5) & 7, a & 31, false, smem); }
    else { int a = it - N2; attn_item(p, a >> 5, (a >> 2) & 7, a & 3, true, smem); }
  }
}

DEV void lds_wave_sync() {
  asm volatile("s_waitcnt lgkmcnt(0)" ::: "memory");
  __builtin_amdgcn_wave_barrier();
}

DEV void rwkv_item(const Params& p, int ri, char* smem) {
  const u16* P = (const u16*)(p.ws + OFF_BIG);
  u16* O4 = (u16*)p.out;
  float* BS = (float*)(p.ws + OFF_BSUM);
  const int tid0 = VTID;
  const int wp0 = tid0 >> 7;
  const int cid = ri * 2 + wp0;
  const int b = cid >> 4, d = (cid >> 3) & 1, h = cid & 7;
  f32x4 S[4][2];
#pragma unroll
  for (int i = 0; i < 4; ++i)
#pragma unroll
    for (int j = 0; j < 2; ++j) S[i][j] = (f32x4){0.f, 0.f, 0.f, 0.f};
  uint4 bw[2][4];
  float l0[4];
  {
    const int lane = tid0 & 63, wi = (tid0 >> 6) & 1, fr = lane & 15, fq = lane >> 4;
    const float* wsrc = (wi == 0 ? p.rw_w2 : p.rw_a2) + (size_t)d * 64 * 512 + h * 64;
    const float* bsrc = (wi == 0 ? p.rw_w0 : p.rw_a0) + d * 512 + h * 64;
#pragma unroll
    for (int nt = 0; nt < 4; ++nt) {
      l0[nt] = bsrc[nt * 16 + fr];
#pragma unroll
      for (int ks = 0; ks < 2; ++ks) {
        __builtin_amdgcn_sched_barrier(0);
        float f[8];
        const float* wp_ = wsrc + (size_t)(ks * 32 + fq * 8) * 512 + nt * 16 + fr;
#pragma unroll
        for (int j = 0; j < 8; ++j) f[j] = wp_[j * 512];
        bw[ks][nt] = pack8(f);
      }
    }
  }
  uint4 pre[5][3];
#define RW_LOAD(CI)                                                                                 \
  {                                                                                                 \
    const int seg_ = (CI) < 16 ? 0 : 1;                                                             \
    const int ch_ = seg_ ? (CI)-16 : (CI);                                                          \
    const int Ls_ = seg_ ? 2048 : 256;                                                              \
    const int rb_ = seg_ ? b * 2048 : NLAT + b * 256;                                               \
    const int sidx_ = ch_ * 16 + stt;                                                               \
    const int t_ = d == 0 ? sidx_ : Ls_ - 1 - sidx_;                                                \
    const u16* prow_ = P + (size_t)(rb_ + t_) * PS1 + spart * 8;                                    \
    _Pragma("unroll") for (int g = 0; g < 5; ++g) {                                                 \
      const int col_ = g < 3 ? g * 512 + h * 64 : (g == 3 ? 1536 + d * 64 : 1664 + d * 64);         \
      _Pragma("unroll") for (int tap = 0; tap < 3; ++tap) {                                         \
        const int tt_ = t_ + tap - 1;                                                               \
        if (tt_ >= 0 && tt_ < Ls_) pre[g][tap] = *(const uint4*)(prow_ + (ptrdiff_t)(tap - 1) * PS1 + col_); \
        else pre[g][tap] = make_uint4(0u, 0u, 0u, 0u);                                              \
      }                                                                                             \
    }                                                                                               \
  }
  {
    const int pt = tid0 & 127, stt = pt >> 3, spart = pt & 7;
    RW_LOAD(0)
  }
  for (int cidx = 0; cidx < 144; ++cidx) {
    asm volatile("" ::: "memory");
    int tid = tid0;
    asm volatile("" : "+v"(tid));
    const int lane = tid & 63, wave = tid >> 6, wp = wave >> 1, wi = wave & 1, pt = tid & 127;
    const int fr = lane & 15, fq = lane >> 4, stt = pt >> 3, spart = pt & 7;
    const int seg = cidx < 16 ? 0 : 1;
    const int ch = seg ? cidx - 16 : cidx;
    const int Ls = seg ? 2048 : 256;
    char* base = smem + wp * 32768;
    u16* RK = (u16*)base;
    u16* KD = RK + 1152;
    u16* KK = KD + 1152;
    u16* AB = KK + 1152;
    u16* VT = AB + 1152;
    float* LW = (float*)(base + 11264);
    u16* TW = (u16*)(base + 15360);
    u16* AD = TW + 1152;
    u16* BgCT = (u16*)(base + 19968);
    u16* KgCT = BgCT + 1024;
    float* gC = (float*)(base + 24064);
    float* Amat = (float*)(base + 24320) + wi * 256;
    u16* Tinv = (u16*)(base + 26368) + wi * 256;
    u16* BG = (u16*)(base + 27392);
    {
      const int o = stt * 72 + spart * 8;
#pragma unroll
      for (int g = 0; g < 5; ++g) {
        __builtin_amdgcn_sched_barrier(0);
        const int col = g < 3 ? g * 512 + h * 64 : (g == 3 ? 1536 + d * 64 : 1664 + d * 64);
        float pc[8], pp[8], pn[8], v[8];
        unpack8(pre[g][1], pc); unpack8(pre[g][0], pp); unpack8(pre[g][2], pn);
        const float* mu = p.rw_mu + col + spart * 8;
        float4 m0 = *(const float4*)mu, m1 = *(const float4*)(mu + 4);
        const float mm[8] = {m0.x, m0.y, m0.z, m0.w, m1.x, m1.y, m1.z, m1.w};
#pragma unroll
        for (int j = 0; j < 8; ++j) v[j] = pc[j] + mm[j] * (0.5f * (pp[j] + pn[j]) - pc[j]);
        if (g == 0) *(uint4*)(RK + o) = pack8(v);
        else if (g == 1) {
          *(uint4*)(KD + o) = pack8(v);
          const float* kkw = p.rw_kk + h * 64 + spart * 8;
          float kkv[8];
          float ss = 0.f;
#pragma unroll
          for (int j = 0; j < 8; ++j) { kkv[j] = v[j] * kkw[j]; ss += kkv[j] * kkv[j]; }
          ss += __shfl_xor(ss, 1, 64); ss += __shfl_xor(ss, 2, 64); ss += __shfl_xor(ss, 4, 64);
          const float inv = rsqrtf(ss + 1e-6f);
#pragma unroll
          for (int j = 0; j < 8; ++j) kkv[j] *= inv;
          *(uint4*)(KK + o) = pack8(kkv);
        } else if (g == 2) {
#pragma unroll
          for (int j = 0; j < 8; ++j) VT[(spart * 8 + j) * 16 + stt] = f2bf(v[j]);
        } else if (g == 3) {
#pragma unroll
          for (int j = 0; j < 8; ++j) v[j] = fast_tanh(v[j]);
          *(uint4*)(TW + o) = pack8(v);
        } else *(uint4*)(AD + o) = pack8(v);
      }
    }
    HSYNC();
    if (cidx + 1 < 144) RW_LOAD(cidx + 1)
    {
      const u16* IN = wi == 0 ? TW : AD;
      bf16x8 af0 = *(const bf16x8*)(IN + fr * 72 + fq * 8);
      bf16x8 af1 = *(const bf16x8*)(IN + fr * 72 + 32 + fq * 8);
#pragma unroll
      for (int nt = 0; nt < 4; ++nt) {
        f32x4 o4 = (f32x4){0.f, 0.f, 0.f, 0.f};
        o4 = __builtin_amdgcn_mfma_f32_16x16x32_bf16(af0, *(bf16x8*)&bw[0][nt], o4, 0, 0, 0);
        o4 = __builtin_amdgcn_mfma_f32_16x16x32_bf16(af1, *(bf16x8*)&bw[1][nt], o4, 0, 0, 0);
#pragma unroll
        for (int e = 0; e < 4; ++e) {
          const float prev = l0[nt] + o4[e];
          const int t = fq * 4 + e, c = nt * 16 + fr;
          if (wi == 0) LW[t * 64 + c] = -__expf(-softplus(-prev) - 0.5f);
          else AB[t * 72 + c] = f2bf(sigm(prev));
        }
      }
    }
    HSYNC();
    {
      const int c = lane;
      float cum = 0.f;
      if (wi == 0) {
#pragma unroll 4
        for (int t = 0; t < 16; ++t) {
          const float lw = LW[t * 64 + c];
          const float gp = __expf(cum);
          cum += lw;
          const float gi = __expf(-cum);
          const float kk = bf2f(KK[t * 72 + c]);
          const float a = bf2f(AB[t * 72 + c]);
          KK[t * 72 + c] = f2bf(kk * gp);
          BG[t * 72 + c] = f2bf(kk * a * gi);
        }
        const float gCv = __expf(cum);
        gC[c] = gCv;
#pragma unroll 4
        for (int t = 0; t < 16; ++t) BgCT[c * 16 + t] = f2bf(-bf2f(BG[t * 72 + c]) * gCv);
      } else {
        float* PR = (float*)TW;
        const float kac = p.rw_ka[h * 64 + c], rkc = p.rw_rk[h * 64 + c];
#pragma unroll 4
        for (int t = 0; t < 16; ++t) {
          const float lw = LW[t * 64 + c];
          cum += lw;
          const float g = __expf(cum), gi = __expf(-cum);
          const float r = bf2f(RK[t * 72 + c]);
          const float k = bf2f(KD[t * 72 + c]);
          const float a = bf2f(AB[t * 72 + c]);
          const float kd = k * (1.f + (a - 1.f) * kac);
          RK[t * 72 + c] = f2bf(r * g);
          KD[t * 72 + c] = f2bf(kd * gi);
          PR[t * 64 + c] = r * kd * rkc;
        }
        const float gCv = __expf(cum);
#pragma unroll 4
        for (int t = 0; t < 16; ++t) KgCT[c * 16 + t] = f2bf(bf2f(KD[t * 72 + c]) * gCv);
        lds_wave_sync();
        {
          const int t = lane >> 2, sg = lane & 3;
          const float4 q0 = *(const float4*)(PR + t * 64 + sg * 16), q1 = *(const float4*)(PR + t * 64 + sg * 16 + 4);
          const float4 q2 = *(const float4*)(PR + t * 64 + sg * 16 + 8), q3 = *(const float4*)(PR + t * 64 + sg * 16 + 12);
          float bsum = (q0.x + q0.y + q0.z + q0.w) + (q1.x + q1.y + q1.z + q1.w) + (q2.x + q2.y + q2.z + q2.w) + (q3.x + q3.y + q3.z + q3.w);
          bsum += __shfl_xor(bsum, 1, 64);
          bsum += __shfl_xor(bsum, 2, 64);
          if (seg == 1 && sg == 0) {
            const int sidx = ch * 16 + t;
            const int tpos = d == 0 ? sidx : 2047 - sidx;
            BS[(size_t)(b * 2048 + tpos) * 16 + h * 2 + d] = bsum;
          }
        }
      }
    }
    HSYNC();
    __builtin_amdgcn_sched_barrier(0);
    {
      f32x4 XabT = (f32x4){0.f, 0.f, 0.f, 0.f}, XakT = XabT, XrbT = XabT, XrkT = XabT;
#pragma unroll
      for (int ks = 0; ks < 2; ++ks) {
        bf16x8 kkf = *(const bf16x8*)(KK + fr * 72 + ks * 32 + fq * 8);
        bf16x8 rgf = *(const bf16x8*)(RK + fr * 72 + ks * 32 + fq * 8);
        bf16x8 bgf = *(const bf16x8*)(BG + fr * 72 + ks * 32 + fq * 8);
        bf16x8 kgf = *(const bf16x8*)(KD + fr * 72 + ks * 32 + fq * 8);
        XabT = __builtin_amdgcn_mfma_f32_16x16x32_bf16(bgf, kkf, XabT, 0, 0, 0);
        XakT = __builtin_amdgcn_mfma_f32_16x16x32_bf16(kgf, kkf, XakT, 0, 0, 0);
        XrbT = __builtin_amdgcn_mfma_f32_16x16x32_bf16(bgf, rgf, XrbT, 0, 0, 0);
        XrkT = __builtin_amdgcn_mfma_f32_16x16x32_bf16(kgf, rgf, XrkT, 0, 0, 0);
      }
      {
        float am[4];
#pragma unroll
        for (int e = 0; e < 4; ++e) am[e] = (fq * 4 + e < fr) ? XabT[e] : 0.f;
        *(float4*)(Amat + fr * 16 + fq * 4) = make_float4(am[0], am[1], am[2], am[3]);
      }
      lds_wave_sync();
      if (lane < 16) {
        float x[16];
        x[0] = (lane == 0) ? 1.f : 0.f;
        float4 cur[4], nxt[4];
        cur[0] = *(const float4*)(Amat + 16);
        cur[1] = cur[0]; cur[2] = cur[0]; cur[3] = cur[0];
#pragma unroll
        for (int i = 1; i < 16; ++i) {
          __builtin_amdgcn_sched_barrier(0);
          if (i + 1 < 16) {
#pragma unroll
            for (int q = 0; q < (i + 4) / 4; ++q) nxt[q] = *(const float4*)(Amat + (i + 1) * 16 + q * 4);
          }
          float acc = (i == lane) ? 1.f : 0.f;
#pragma unroll
          for (int j = 0; j < i; ++j) {
            const float4 rv = cur[j >> 2];
            const float av = (j & 3) == 0 ? rv.x : ((j & 3) == 1 ? rv.y : ((j & 3) == 2 ? rv.z : rv.w));
            acc -= av * x[j];
          }
          x[i] = acc;
#pragma unroll
          for (int q = 0; q < 4; ++q) cur[q] = nxt[q];
        }
#pragma unroll
        for (int i = 0; i < 16; ++i) Tinv[i * 16 + lane] = f2bf(x[i]);
      }
      lds_wave_sync();
      f32x4 sa0[2], y0[2];
#pragma unroll
      for (int nt = 0; nt < 2; ++nt) { sa0[nt] = (f32x4){0.f, 0.f, 0.f, 0.f}; y0[nt] = (f32x4){0.f, 0.f, 0.f, 0.f}; }
#pragma unroll
      for (int x = 0; x < 2; ++x) {
        __builtin_amdgcn_sched_barrier(0);
        uint2 k0 = *(const uint2*)(KK + fr * 72 + 32 * x + fq * 4);
        uint2 k1 = *(const uint2*)(KK + fr * 72 + 32 * x + 16 + fq * 4);
        uint2 r0 = *(const uint2*)(RK + fr * 72 + 32 * x + fq * 4);
        uint2 r1 = *(const uint2*)(RK + fr * 72 + 32 * x + 16 + fq * 4);
        uint4 kw = make_uint4(k0.x, k0.y, k1.x, k1.y);
        uint4 rw = make_uint4(r0.x, r0.y, r1.x, r1.y);
#pragma unroll
        for (int nt = 0; nt < 2; ++nt) {
          uint4 sw;
          sw.x = pack2(S[2 * x][nt][0], S[2 * x][nt][1]); sw.y = pack2(S[2 * x][nt][2], S[2 * x][nt][3]);
          sw.z = pack2(S[2 * x + 1][nt][0], S[2 * x + 1][nt][1]); sw.w = pack2(S[2 * x + 1][nt][2], S[2 * x + 1][nt][3]);
          sa0[nt] = __builtin_amdgcn_mfma_f32_16x16x32_bf16(*(bf16x8*)&kw, *(bf16x8*)&sw, sa0[nt], 0, 0, 0);
          y0[nt] = __builtin_amdgcn_mfma_f32_16x16x32_bf16(*(bf16x8*)&rw, *(bf16x8*)&sw, y0[nt], 0, 0, 0);
        }
      }
      float ak[4], rb[4], rk[4];
#pragma unroll
      for (int e = 0; e < 4; ++e) {
        const int j = fq * 4 + e;
        ak[e] = (j < fr) ? XakT[e] : 0.f;
        rb[e] = (j <= fr) ? -XrbT[e] : 0.f;
        rk[e] = (j <= fr) ? XrkT[e] : 0.f;
      }
      const uint4 akw = make_uint4(pack2(ak[0], ak[1]), pack2(ak[2], ak[3]), 0u, 0u);
      const uint4 ybw = make_uint4(pack2(rb[0], rb[1]), pack2(rb[2], rb[3]), pack2(rk[0], rk[1]), pack2(rk[2], rk[3]));
      const uint2 tv = *(const uint2*)(Tinv + fr * 16 + fq * 4);
      const uint4 tw = make_uint4(tv.x, tv.y, 0u, 0u);
      uint4 sv[2];
#pragma unroll
      for (int nt = 0; nt < 2; ++nt) {
        const int vc = wi * 32 + nt * 16 + fr;
        const uint2 vt = *(const uint2*)(VT + vc * 16 + fq * 4);
        const uint4 vb = make_uint4(vt.x, vt.y, 0u, 0u);
        f32x4 rhs = __builtin_amdgcn_mfma_f32_16x16x32_bf16(*(bf16x8*)&akw, *(bf16x8*)&vb, sa0[nt], 0, 0, 0);
        const uint4 rw = make_uint4(pack2(rhs[0], rhs[1]), pack2(rhs[2], rhs[3]), 0u, 0u);
        f32x4 sa = __builtin_amdgcn_mfma_f32_16x16x32_bf16(*(bf16x8*)&tw, *(bf16x8*)&rw, (f32x4){0.f, 0.f, 0.f, 0.f}, 0, 0, 0);
        sv[nt] = make_uint4(pack2(sa[0], sa[1]), pack2(sa[2], sa[3]), vt.x, vt.y);
        f32x4 y = __builtin_amdgcn_mfma_f32_16x16x32_bf16(*(bf16x8*)&ybw, *(bf16x8*)&sv[nt], y0[nt], 0, 0, 0);
        if (seg == 1) {
#pragma unroll
          for (int e = 0; e < 4; ++e) {
            const int sidx = ch * 16 + fq * 4 + e;
            const int tpos = d == 0 ? sidx : 2047 - sidx;
            O4[((size_t)d * NLAT + b * 2048 + tpos) * 512 + h * 64 + vc] = f2bf(y[e]);
          }
        }
      }
#pragma unroll
      for (int mt = 0; mt < 4; ++mt) {
        __builtin_amdgcn_sched_barrier(0);
        const float4 g4 = *(const float4*)(gC + mt * 16 + fq * 4);
        const uint2 bv = *(const uint2*)(BgCT + (mt * 16 + fr) * 16 + fq * 4);
        const uint2 kv = *(const uint2*)(KgCT + (mt * 16 + fr) * 16 + fq * 4);
        const uint4 aw = make_uint4(bv.x, bv.y, kv.x, kv.y);
#pragma unroll
        for (int nt = 0; nt < 2; ++nt) {
          S[mt][nt][0] *= g4.x; S[mt][nt][1] *= g4.y; S[mt][nt][2] *= g4.z; S[mt][nt][3] *= g4.w;
          S[mt][nt] = __builtin_amdgcn_mfma_f32_16x16x32_bf16(*(bf16x8*)&aw, *(bf16x8*)&sv[nt], S[mt][nt], 0, 0, 0);
        }
      }
    }
    HSYNC();
  }
#undef RW_LOAD
}

DEV void gdn_item(const Params& p, int gi, char* smem) {
  const u16* P = (const u16*)(p.ws + OFF_BIG);
  u16* O4 = (u16*)p.out;
  const int tid0 = VTID;
  const int b = gi >> 3, d = (gi >> 2) & 1, h = gi & 3;
  constexpr int BUFB = 23424;
  f32x4 S[8][2];
#pragma unroll
  for (int i = 0; i < 8; ++i)
#pragma unroll
    for (int j = 0; j < 2; ++j) S[i][j] = (f32x4){0.f, 0.f, 0.f, 0.f};
  const float negA = -__expf(p.dn_A_log[d * 4 + h]);
  const float dtb = p.dn_dt_bias[d * 4 + h];
  uint4 pre[3][3];
  float gpre0 = 0.f, gpre1 = 0.f;
#define GDN_LOAD(CI)                                                                               \
  {                                                                                                \
    const int seg_ = (CI) < 16 ? 0 : 1;                                                            \
    const int ch_ = seg_ ? (CI)-16 : (CI);                                                         \
    const int Ls_ = seg_ ? 2048 : 256;                                                             \
    const int rb_ = seg_ ? b * 2048 : NLAT + b * 256;                                              \
    const int sidx_ = ch_ * 16 + stt;                                                              \
    const int t_ = d == 0 ? sidx_ : Ls_ - 1 - sidx_;                                               \
    const u16* prow_ = P + (size_t)(rb_ + t_) * PS1 + DNO;                                         \
    _Pragma("unroll") for (int g = 0; g < 3; ++g) {                                                \
      const int col_ = g * 512 + h * 128 + spart * 8;                                              \
      _Pragma("unroll") for (int tap = 0; tap < 3; ++tap) {                                        \
        const int tt_ = t_ + tap - 1;                                                              \
        if (tt_ >= 0 && tt_ < Ls_) pre[g][tap] = *(const uint4*)(prow_ + (ptrdiff_t)(tap - 1) * PS1 + col_); \
        else pre[g][tap] = make_uint4(0u, 0u, 0u, 0u);                                             \
      }                                                                                            \
    }                                                                                              \
    if (wave == 0) {                                                                               \
      const int s2_ = ch_ * 16 + fr;                                                               \
      const int t2_ = d == 0 ? s2_ : Ls_ - 1 - s2_;                                                \
      const u16* gr_ = P + (size_t)(rb_ + t2_) * PS1 + DNO + 2048;                                 \
      gpre0 = bf2f(gr_[d * 4 + h]);                                                                \
      gpre1 = bf2f(gr_[8 + d * 4 + h]);                                                            \
    }                                                                                              \
  }
  {
    const int tid = tid0, lane = tid & 63, wave = tid >> 6, fr = lane & 15, stt = tid >> 4, spart = tid & 15;
    GDN_LOAD(0)
  }
  for (int cidx = 0; cidx < 144; ++cidx) {
    asm volatile("" ::: "memory");
    int tid = tid0;
    asm volatile("" : "+v"(tid));
    const int lane = tid & 63, wave = tid >> 6, fr = lane & 15, fq = lane >> 4, stt = tid >> 4, spart = tid & 15;
    char* buf = smem;
    u16* Kb = (u16*)buf;
    u16* Qb = Kb + 16 * 136;
    float* Vf = (float*)(buf + 8704);
    u16* KdT = (u16*)(buf + 17152);
    u16* Tinv = (u16*)(buf + 21248);
    u16* Pm = (u16*)(buf + 21760);
    float* Amat = (float*)(buf + 22272);
    float* Gs = (float*)(buf + 23296);
    float* Bs = Gs + 16;
#pragma unroll
    for (int g = 0; g < 3; ++g) {
      __builtin_amdgcn_sched_barrier(0);
      const int col = g * 512 + h * 128 + spart * 8;
      float z[8];
#pragma unroll
      for (int j = 0; j < 8; ++j) z[j] = 0.f;
#pragma unroll
      for (int tap = 0; tap < 3; ++tap) {
        __builtin_amdgcn_sched_barrier(0);
        float f[8];
        unpack8(pre[g][tap], f);
        const float* w = p.dn_conv + tap * 1536 + col;
        float4 w0 = *(const float4*)w, w1 = *(const float4*)(w + 4);
        z[0] += f[0] * w0.x; z[1] += f[1] * w0.y; z[2] += f[2] * w0.z; z[3] += f[3] * w0.w;
        z[4] += f[4] * w1.x; z[5] += f[5] * w1.y; z[6] += f[6] * w1.z; z[7] += f[7] * w1.w;
      }
      float ss = 0.f;
#pragma unroll
      for (int j = 0; j < 8; ++j) { z[j] = silu(z[j]); ss += z[j] * z[j]; }
      if (g < 2) {
        ss += __shfl_xor(ss, 1, 64); ss += __shfl_xor(ss, 2, 64); ss += __shfl_xor(ss, 4, 64); ss += __shfl_xor(ss, 8, 64);
        float sc = rsqrtf(ss + 1e-6f);
        if (g == 0) sc *= 0.08838834764831845f;
#pragma unroll
        for (int j = 0; j < 8; ++j) z[j] *= sc;
        *(uint4*)((g == 0 ? Qb : Kb) + stt * 136 + spart * 8) = pack8(z);
      } else {
        float* dst = Vf + stt * 132 + spart * 8;
        *(float4*)dst = make_float4(z[0], z[1], z[2], z[3]);
        *(float4*)(dst + 4) = make_float4(z[4], z[5], z[6], z[7]);
      }
    }
    if (wave == 0) {
      float g = negA * softplus(gpre0 + dtb);
#pragma unroll
      for (int o = 1; o < 16; o <<= 1) { float n = __shfl_up(g, o, 16); if (fr >= o) g += n; }
      if (lane < 16) { Gs[lane] = g; Bs[lane] = sigm(gpre1); }
    }
    HSYNC();
    if (wave == 0) {
      f32x4 kk = (f32x4){0.f, 0.f, 0.f, 0.f};
#pragma unroll
      for (int ks = 0; ks < 4; ++ks) {
        bf16x8 kf = *(const bf16x8*)(Kb + fr * 136 + ks * 32 + fq * 8);
        kk = __builtin_amdgcn_mfma_f32_16x16x32_bf16(kf, kf, kk, 0, 0, 0);
      }
      const float Gj = Gs[fr];
#pragma unroll
      for (int e = 0; e < 4; ++e) {
        const int i = fq * 4 + e;
        const float a = (fr < i) ? Bs[i] * kk[e] * __expf(Gs[i] - Gj) : 0.f;
        Amat[i * 16 + fr] = a;
      }
      lds_wave_sync();
      if (lane < 16) {
        float x[16];
        x[0] = (lane == 0) ? 1.f : 0.f;
        float4 cur[4], nxt[4];
        cur[0] = *(const float4*)(Amat + 16);
        cur[1] = cur[0]; cur[2] = cur[0]; cur[3] = cur[0];
#pragma unroll
        for (int i = 1; i < 16; ++i) {
          __builtin_amdgcn_sched_barrier(0);
          if (i + 1 < 16) {
#pragma unroll
            for (int q = 0; q < (i + 4) / 4; ++q) nxt[q] = *(const float4*)(Amat + (i + 1) * 16 + q * 4);
          }
          float acc = (i == lane) ? 1.f : 0.f;
#pragma unroll
          for (int j = 0; j < i; ++j) {
            const float4 rv = cur[j >> 2];
            const float av = (j & 3) == 0 ? rv.x : ((j & 3) == 1 ? rv.y : ((j & 3) == 2 ? rv.z : rv.w));
            acc -= av * x[j];
          }
          x[i] = acc;
#pragma unroll
          for (int q = 0; q < 4; ++q) cur[q] = nxt[q];
        }
#pragma unroll
        for (int i = 0; i < 16; ++i) Tinv[i * 16 + lane] = f2bf(x[i]);
      }
    } else if (wave == 1) {
      f32x4 qk = (f32x4){0.f, 0.f, 0.f, 0.f};
#pragma unroll
      for (int ks = 0; ks < 4; ++ks) {
        bf16x8 qf = *(const bf16x8*)(Qb + fr * 136 + ks * 32 + fq * 8);
        bf16x8 kf = *(const bf16x8*)(Kb + fr * 136 + ks * 32 + fq * 8);
        qk = __builtin_amdgcn_mfma_f32_16x16x32_bf16(qf, kf, qk, 0, 0, 0);
      }
      const float Gj = Gs[fr];
#pragma unroll
      for (int e = 0; e < 4; ++e) {
        const int t = fq * 4 + e;
        const float v = (fr <= t) ? qk[e] * __expf(Gs[t] - Gj) : 0.f;
        Pm[t * 16 + fr] = f2bf(v);
      }
    } else {
      const int k = tid - 128;
      const float GC = Gs[15];
      unsigned w[8];
#pragma unroll
      for (int j = 0; j < 8; ++j) {
        __builtin_amdgcn_sched_barrier(0);
        float v0 = bf2f(Kb[(2 * j) * 136 + k]) * __expf(GC - Gs[2 * j]);
        float v1 = bf2f(Kb[(2 * j + 1) * 136 + k]) * __expf(GC - Gs[2 * j + 1]);
        w[j] = pack2(v0, v1);
      }
      *(uint4*)(KdT + k * 16) = make_uint4(w[0], w[1], w[2], w[3]);
      *(uint4*)(KdT + k * 16 + 8) = make_uint4(w[4], w[5], w[6], w[7]);
    }
    __builtin_amdgcn_sched_barrier(0);
    f32x4 ksv[2], qsv[2];
#pragma unroll
    for (int nt = 0; nt < 2; ++nt) { ksv[nt] = (f32x4){0.f, 0.f, 0.f, 0.f}; qsv[nt] = (f32x4){0.f, 0.f, 0.f, 0.f}; }
#pragma unroll
    for (int x = 0; x < 4; ++x) {
      __builtin_amdgcn_sched_barrier(0);
      uint2 k0 = *(const uint2*)(Kb + fr * 136 + 32 * x + fq * 4);
      uint2 k1 = *(const uint2*)(Kb + fr * 136 + 32 * x + 16 + fq * 4);
      uint2 q0 = *(const uint2*)(Qb + fr * 136 + 32 * x + fq * 4);
      uint2 q1 = *(const uint2*)(Qb + fr * 136 + 32 * x + 16 + fq * 4);
      uint4 kw = make_uint4(k0.x, k0.y, k1.x, k1.y);
      uint4 qw = make_uint4(q0.x, q0.y, q1.x, q1.y);
#pragma unroll
      for (int nt = 0; nt < 2; ++nt) {
        uint4 sw;
        sw.x = pack2(S[2 * x][nt][0], S[2 * x][nt][1]); sw.y = pack2(S[2 * x][nt][2], S[2 * x][nt][3]);
        sw.z = pack2(S[2 * x + 1][nt][0], S[2 * x + 1][nt][1]); sw.w = pack2(S[2 * x + 1][nt][2], S[2 * x + 1][nt][3]);
        ksv[nt] = __builtin_amdgcn_mfma_f32_16x16x32_bf16(*(bf16x8*)&kw, *(bf16x8*)&sw, ksv[nt], 0, 0, 0);
        qsv[nt] = __builtin_amdgcn_mfma_f32_16x16x32_bf16(*(bf16x8*)&qw, *(bf16x8*)&sw, qsv[nt], 0, 0, 0);
      }
    }
    HSYNC();
    if (cidx + 1 < 144) GDN_LOAD(cidx + 1)
    __builtin_amdgcn_sched_barrier(0);
    {
      const int seg = cidx < 16 ? 0 : 1;
      const int ch = seg ? cidx - 16 : cidx;
      float eG[4], bt[4];
#pragma unroll
      for (int e = 0; e < 4; ++e) { eG[e] = __expf(Gs[fq * 4 + e]); bt[e] = Bs[fq * 4 + e]; }
      const float eGC = __expf(Gs[15]);
      uint2 tv = *(const uint2*)(Tinv + fr * 16 + fq * 4);
      uint2 pv = *(const uint2*)(Pm + fr * 16 + fq * 4);
      uint4 tw = make_uint4(tv.x, tv.y, 0u, 0u);
      uint4 pw = make_uint4(pv.x, pv.y, 0u, 0u);
      uint4 ub[2];
#pragma unroll
      for (int nt = 0; nt < 2; ++nt) {
        const int vc = wave * 32 + nt * 16 + fr;
        float rhs[4];
#pragma unroll
        for (int e = 0; e < 4; ++e) rhs[e] = bt[e] * (Vf[(fq * 4 + e) * 132 + vc] - eG[e] * ksv[nt][e]);
        uint4 rw = make_uint4(pack2(rhs[0], rhs[1]), pack2(rhs[2], rhs[3]), 0u, 0u);
        f32x4 u = __builtin_amdgcn_mfma_f32_16x16x32_bf16(*(bf16x8*)&tw, *(bf16x8*)&rw, (f32x4){0.f, 0.f, 0.f, 0.f}, 0, 0, 0);
        ub[nt] = make_uint4(pack2(u[0], u[1]), pack2(u[2], u[3]), 0u, 0u);
        f32x4 oa;
#pragma unroll
        for (int e = 0; e < 4; ++e) oa[e] = eG[e] * qsv[nt][e];
        oa = __builtin_amdgcn_mfma_f32_16x16x32_bf16(*(bf16x8*)&pw, *(bf16x8*)&ub[nt], oa, 0, 0, 0);
        if (seg == 1) {
#pragma unroll
          for (int e = 0; e < 4; ++e) {
            const int sidx = ch * 16 + fq * 4 + e;
            const int t = d == 0 ? sidx : 2047 - sidx;
            O4[((size_t)(2 + d) * NLAT + b * 2048 + t) * 512 + h * 128 + vc] = f2bf(oa[e]);
          }
        }
      }
#pragma unroll
      for (int mt = 0; mt < 8; ++mt) {
        __builtin_amdgcn_sched_barrier(0);
        uint2 kv = *(const uint2*)(KdT + (mt * 16 + fr) * 16 + fq * 4);
        uint4 kw = make_uint4(kv.x, kv.y, 0u, 0u);
#pragma unroll
        for (int nt = 0; nt < 2; ++nt) {
#pragma unroll
          for (int e = 0; e < 4; ++e) S[mt][nt][e] *= eGC;
          S[mt][nt] = __builtin_amdgcn_mfma_f32_16x16x32_bf16(*(bf16x8*)&kw, *(bf16x8*)&ub[nt], S[mt][nt], 0, 0, 0);
        }
      }
    }
    HSYNC();
  }
#undef GDN_LOAD
}

DEV void phase_scans(const Params& p, char* smem) {
#pragma unroll 1
  for (int it = VBID; it < 512; it += VNB)
    if (it & 1) rwkv_item(p, it >> 1, smem);
  __builtin_amdgcn_sched_barrier(0);
#pragma unroll 1
  for (int it = VBID; it < 512; it += VNB)
    if (!(it & 1)) gdn_item(p, it >> 1, smem);
}

DEV void mixout_item(const Params& p, int it, char* smem) {
  const u16* P = (const u16*)(p.ws + OFF_BIG);
  const u16* O4 = (const u16*)p.out;
  const float* BS = (const float*)(p.ws + OFF_BSUM);
  const u16* G2T = (const u16*)(p.ws + OFF_G2T);
  u16* Y = (u16*)(p.ws + OFF_HY);
  u16* sg = (u16*)smem;
  u16* G = sg + 32 * 136;
  const int tid = VTID, lane = tid & 63, wave = tid >> 6;
  const int fr = lane & 15, fq = lane >> 4;
  const int tok0 = it * 32, tl0 = tok0 & 2047;
  const int tk = tid >> 3, part = tid & 7;
  const int row = tok0 + tk, t = tl0 + tk;
  const bool hasp = t > 0, hasn = t + 1 < 2048;
  const u16* prow = P + (size_t)row * PS1;
  {
#pragma unroll
    for (int q = 0; q < 2; ++q) {
      const int col = 1792 + part * 16 + q * 8;
      float pc[8], pp[8], pn[8], v[8];
      unpack8(*(const uint4*)(prow + col), pc);
      if (hasp) unpack8(*(const uint4*)(prow - PS1 + col), pp);
      else {
#pragma unroll
        for (int j = 0; j < 8; ++j) pp[j] = 0.f;
      }
      if (hasn) unpack8(*(const uint4*)(prow + PS1 + col), pn);
      else {
#pragma unroll
        for (int j = 0; j < 8; ++j) pn[j] = 0.f;
      }
      const float* mu = p.rw_mu + col;
#pragma unroll
      for (int j = 0; j < 8; ++j) v[j] = sigm(pc[j] + mu[j] * (0.5f * (pp[j] + pn[j]) - pc[j]));
      *(uint4*)(sg + tk * 136 + part * 16 + q * 8) = pack8(v);
    }
  }
  HSYNC();
  {
    bf16x8 af[2][4];
#pragma unroll
    for (int mt = 0; mt < 2; ++mt)
#pragma unroll
      for (int ks = 0; ks < 4; ++ks) af[mt][ks] = *(const bf16x8*)(sg + (mt * 16 + fr) * 136 + ks * 32 + fq * 8);
#pragma unroll
    for (int nt = 0; nt < 8; ++nt) {
      const u16* bp = G2T + (size_t)(wave * 128 + nt * 16 + fr) * 128 + fq * 8;
      bf16x8 bf0 = *(const bf16x8*)(bp), bf1 = *(const bf16x8*)(bp + 32), bf2 = *(const bf16x8*)(bp + 64), bf3 = *(const bf16x8*)(bp + 96);
#pragma unroll
      for (int mt = 0; mt < 2; ++mt) {
        f32x4 a = (f32x4){0.f, 0.f, 0.f, 0.f};
        a = __builtin_amdgcn_mfma_f32_16x16x32_bf16(af[mt][0], bf0, a, 0, 0, 0);
        a = __builtin_amdgcn_mfma_f32_16x16x32_bf16(af[mt][1], bf1, a, 0, 0, 0);
        a = __builtin_amdgcn_mfma_f32_16x16x32_bf16(af[mt][2], bf2, a, 0, 0, 0);
        a = __builtin_amdgcn_mfma_f32_16x16x32_bf16(af[mt][3], bf3, a, 0, 0, 0);
#pragma unroll
        for (int e = 0; e < 4; ++e) G[(mt * 16 + fq * 4 + e) * 520 + wave * 128 + nt * 16 + fr] = f2bf(a[e]);
      }
    }
  }
  HSYNC();
  {
    const int hd = part, c0 = hd * 64;
    const u16* of = O4 + (size_t)row * 512 + c0;
    const u16* ob = O4 + ((size_t)NLAT + row) * 512 + c0;
    const float bsum = BS[(size_t)row * 16 + hd * 2] + BS[(size_t)row * 16 + hd * 2 + 1];
    float s1 = 0.f, s2 = 0.f;
#pragma unroll
    for (int q = 0; q < 8; ++q) {
      float a[8], b8[8];
      unpack8(*(const uint4*)(of + q * 8), a);
      unpack8(*(const uint4*)(ob + q * 8), b8);
#pragma unroll
      for (int j = 0; j < 8; ++j) { const float v = a[j] + b8[j]; s1 += v; s2 += v * v; }
    }
    const float mean = s1 * (1.f / 64.f);
    const float var = fmaxf(s2 * (1.f / 64.f) - mean * mean, 0.f);
    const float rs = rsqrtf(var + 64e-5f);
#pragma unroll
    for (int q = 0; q < 8; ++q) {
      const int c = c0 + q * 8;
      float pc[8], pp[8], pn[8], gv[8], o[8], ya[8], yb[8];
      unpack8(*(const uint4*)(of + q * 8), ya);
      unpack8(*(const uint4*)(ob + q * 8), yb);
      unpack8(*(const uint4*)(prow + 1024 + c), pc);
      if (hasp) unpack8(*(const uint4*)(prow - PS1 + 1024 + c), pp);
      else {
#pragma unroll
        for (int j = 0; j < 8; ++j) pp[j] = 0.f;
      }
      if (hasn) unpack8(*(const uint4*)(prow + PS1 + 1024 + c), pn);
      else {
#pragma unroll
        for (int j = 0; j < 8; ++j) pn[j] = 0.f;
      }
      unpack8(*(const uint4*)(G + tk * 520 + c), gv);
      const float* mu = p.rw_mu + 1024 + c;
      const float* gg = p.rw_lnx_g + c;
      const float* gb = p.rw_lnx_b + c;
#pragma unroll
      for (int j = 0; j < 8; ++j) {
        const float vsh = pc[j] + mu[j] * (0.5f * (pp[j] + pn[j]) - pc[j]);
        const float yn = (ya[j] + yb[j] - mean) * rs * gg[j] + gb[j];
        o[j] = (yn + bsum * vsh) * gv[j];
      }
      *(uint4*)(Y + (size_t)row * 1024 + c) = pack8(o);
    }
  }
  {
    const int c0 = part * 64;
    const u16* of = O4 + ((size_t)2 * NLAT + row) * 512 + c0;
    const u16* ob = O4 + ((size_t)3 * NLAT + row) * 512 + c0;
    float s2 = 0.f;
#pragma unroll
    for (int q = 0; q < 8; ++q) {
      float a[8], b8[8];
      unpack8(*(const uint4*)(of + q * 8), a);
      unpack8(*(const uint4*)(ob + q * 8), b8);
#pragma unroll
      for (int j = 0; j < 8; ++j) { const float v = a[j] + b8[j]; s2 += v * v; }
    }
    s2 += __shfl_xor(s2, 1, 64);
    const float rs = rsqrtf(s2 * (1.f / 128.f) + 1e-6f);
    const u16* zr = prow + DNO + 1536 + c0;
    const float* ng = p.dn_norm_g + (part & 1) * 64;
#pragma unroll
    for (int q = 0; q < 8; ++q) {
      float z[8], r8[8], a[8], b8[8];
      unpack8(*(const uint4*)(of + q * 8), a);
      unpack8(*(const uint4*)(ob + q * 8), b8);
      unpack8(*(const uint4*)(zr + q * 8), z);
#pragma unroll
      for (int j = 0; j < 8; ++j) r8[j] = (a[j] + b8[j]) * rs * ng[q * 8 + j] * silu(z[j]);
      *(uint4*)(Y + (size_t)row * 1024 + 512 + c0 + q * 8) = pack8(r8);
    }
  }
  HSYNC();
}

#define XB_TMO      128
#define XB_XCNT(j)  (256  + 64 * (j))
#define XB_XSUB(j)  (1280 + 64 * (j))
#define XB_XGEN(j)  (2304 + 64 * (j))
#define XB_TOP      3328
#define XB_TOPGEN   3392
#define XCD_BAR_WORDS 3456
#define XB_SPIN_CAP (1u << 20)
DEV unsigned xb_ld(unsigned* p) { return __hip_atomic_load(p, __ATOMIC_RELAXED, __HIP_MEMORY_SCOPE_AGENT); }
DEV unsigned xb_add(unsigned* p, unsigned v) { return __hip_atomic_fetch_add(p, v, __ATOMIC_RELAXED, __HIP_MEMORY_SCOPE_AGENT); }
DEV unsigned xb_xcc_id() { return (unsigned)__builtin_amdgcn_s_getreg((3 << 11) | 20) & 0xFu; }
#define XB_SPIN(cond, bar) do { unsigned _sp = 0; while (cond) { __builtin_amdgcn_s_sleep(1); \
    if ((++_sp & 255u) == 0u) { if (xb_ld(&(bar)[XB_TMO])) break; if (_sp > XB_SPIN_CAP) { atomicAdd(&(bar)[XB_TMO], 1u); break; } } } } while (0)
DEV void xcd_barrier_complete(unsigned* bar, unsigned x, unsigned& nloc, unsigned& nx) {
  const unsigned G = gridDim.x;
  unsigned sum, cnt, mine, sp = 0u;
  for (;;) {
    sum = 0u; cnt = 0u; mine = 0u;
#pragma unroll
    for (unsigned j = 0; j < 16; ++j) { const unsigned c = xb_ld(&bar[XB_XCNT(j)]); sum += c; cnt += (c > 0u) ? 1u : 0u; mine = (j == x) ? c : mine; }
    if (sum == G) break;
    __builtin_amdgcn_s_sleep(1);
    if ((++sp & 255u) == 0u) { if (xb_ld(&bar[XB_TMO])) break; if (sp > XB_SPIN_CAP) { atomicAdd(&bar[XB_TMO], 1u); break; } }
  }
  nloc = mine > 0u ? mine : 1u; nx = cnt > 0u ? cnt : 1u;
}
DEV void xcd_barrier(unsigned* bar) {
  asm volatile("s_waitcnt vmcnt(0)" ::: "memory");
  __syncthreads();
  if (threadIdx.x == 0) {
    __builtin_amdgcn_s_waitcnt(0);
    const unsigned x = xb_xcc_id();
    volatile LAS unsigned* st = (volatile LAS unsigned*)(dyn_smem + HS_OFF + 128);
    unsigned nloc = st[0], nx = st[1];
    if (nloc == 0u) { xcd_barrier_complete(bar, x, nloc, nx); st[0] = nloc; st[1] = nx; }
    const unsigned old = xb_add(&bar[XB_XSUB(x)], 1u);
    const unsigned gen = old / nloc;
    if (old + 1u == (gen + 1u) * nloc) {
      __builtin_amdgcn_fence(__ATOMIC_RELEASE, "agent");
      asm volatile("s_waitcnt vmcnt(0)" ::: "memory");
      const unsigned og = xb_add(&bar[XB_TOP], 1u);
      const unsigned tg = og / nx;
      if (og + 1u == (tg + 1u) * nx) xb_add(&bar[XB_TOPGEN], 1u);
      else XB_SPIN(xb_ld(&bar[XB_TOPGEN]) == tg, bar);
      __builtin_amdgcn_fence(__ATOMIC_ACQUIRE, "agent");
      xb_add(&bar[XB_XGEN(x)], 1u);
      asm volatile("s_waitcnt vmcnt(0)" ::: "memory");
    } else {
      XB_SPIN(xb_ld(&bar[XB_XGEN(x)]) == gen, bar);
      __builtin_amdgcn_fence(__ATOMIC_ACQUIRE, "agent");
      asm volatile("s_waitcnt vmcnt(0)" ::: "memory");
    }
  }
  __syncthreads();
}

constexpr int NPHASE = 18;

__global__ void __launch_bounds__(512, 2) mega(Params p, int ph_lo, int ph_hi) {
  char* smem = dyn_smem + VHALF * HALF_LDS;
  if ((threadIdx.x & 255) == 0) *((LAS unsigned*)(dyn_smem + HS_OFF) + (threadIdx.x >> 8) * 16) = 0u;
  __syncthreads();
  cg::grid_group grid = cg::this_grid();
  const float* mv0 = (const float*)(p.ws + OFF_MODV);
  const float* mv1 = mv0 + 33 * 6144;
  u16* X = (u16*)(p.ws + OFF_X);
  u16* HY = (u16*)(p.ws + OFF_HY);
  u16* BIG = (u16*)(p.ws + OFF_BIG);
  unsigned* bar = (unsigned*)(p.ws + OFF_BAR);
  if (threadIdx.x == 0) {
    volatile LAS unsigned* st = (volatile LAS unsigned*)(dyn_smem + HS_OFF + 128);
    st[0] = 0u; st[1] = 0u;
    (void)xb_add(&bar[XB_XCNT(xb_xcc_id())], 1u);
  }
  if (ph_hi < 0) grid.sync();
#define PHASE(n, BODY) if (ph_lo <= (n) && (n) < ph_hi) { BODY; if ((n) + 1 < ph_hi) xcd_barrier(bar); }
  PHASE(0, phase_prep(p, smem))
  PHASE(1, phase_init(p))
  PHASE(2, gemm_phase<0>(HY, 1024, (const u16*)(p.ws + OFF_WIN0), 1024, NTOK, 2304, BIG, PS0, nullptr, dyn_smem))
  PHASE(3, phase_hyprep_rope(p, smem))
  PHASE(4, phase_conv_attn(p, smem))
  PHASE(5, gemm_phase<2>(HY, 1024, (const u16*)(p.ws + OFF_WOUT0), 1024, NTOK, 1024, X, 1024, mv0 + 2 * 1024, dyn_smem))
  PHASE(6, ln_phase<false>(p, NTOK, p.ln_g, p.ln_b, mv0, 3, 4))
  PHASE(7, gemm_phase<1>(HY, 1024, (const u16*)(p.ws + OFF_W1_0), 1024, NTOK, 4096, BIG, 4096, nullptr, dyn_smem))
  PHASE(8, gemm_phase<2>(BIG, 4096, (const u16*)(p.ws + OFF_W2_0), 4096, NTOK, 1024, X, 1024, mv0 + 5 * 1024, dyn_smem))
  PHASE(9, ln_phase<false>(p, NTOK, p.ln_g + 1024, p.ln_b + 1024, mv1, 0, 1))
  PHASE(10, gemm_phase<0>(HY, 1024, (const u16*)(p.ws + OFF_WIN1), 1024, NTOK, 4096, BIG, PS1, nullptr, dyn_smem))
  PHASE(11, phase_scans(p, smem))
  PHASE(12, for (int it = VBID; it < 2048; it += VNB) mixout_item(p, it, smem))
  PHASE(13, gemm_phase<2>(HY, 1024, (const u16*)(p.ws + OFF_WOUT1), 1024, NLAT, 1024, X, 1024, mv1 + 2 * 1024, dyn_smem))
  PHASE(14, ln_phase<false>(p, NLAT, p.ln_g + 2048, p.ln_b + 2048, mv1, 3, 4))
  PHASE(15, gemm_phase<1>(HY, 1024, (const u16*)(p.ws + OFF_W1_1), 1024, NLAT, 4096, BIG, 4096, nullptr, dyn_smem))
  PHASE(16, gemm_phase<2>(BIG, 4096, (const u16*)(p.ws + OFF_W2_1), 4096, NLAT, 1024, X, 1024, mv1 + 5 * 1024, dyn_smem))
  PHASE(17, ln_phase<true>(p, NLAT, p.ln_g + 3072, p.ln_b + 3072, mv1, 0, 1))
}

extern "C" void kernel_launch(void* const* d_in, const int* in_sizes, int n_in, void* d_out, int out_size, void* d_ws,
                              size_t ws_size, hipStream_t stream) {
  static int grid_blocks = 0;
  if (!grid_blocks) {
    int dev = 0, cus = 0, per_cu = 0;
    hipGetDevice(&dev);
    hipDeviceGetAttribute(&cus, hipDeviceAttributeMultiprocessorCount, dev);
    hipFuncSetAttribute((const void*)mega, hipFuncAttributeMaxDynamicSharedMemorySize, LDS_BYTES);
    hipOccupancyMaxActiveBlocksPerMultiprocessor(&per_cu, mega, 512, LDS_BYTES);
    if (per_cu > 1) per_cu = 1;
    if (per_cu < 1) per_cu = 1;
    grid_blocks = cus * per_cu;
  }
  if (ws_size < WS_NEED) fprintf(stderr, "workspace too small: %zu < %zu\n", ws_size, (size_t)WS_NEED);
  Params p{};
  const float** pp = (const float**)&p;
  for (int i = 0; i < 39; ++i) pp[i] = (const float*)d_in[i];
  p.out = (float*)d_out;
  p.ws = (char*)d_ws;
  int lo = 0, hi = NPHASE;
  void* args[] = {&p, &lo, &hi};
  hipMemsetAsync((char*)d_ws + OFF_BAR, 0, XCD_BAR_WORDS * sizeof(unsigned), stream);
  hipError_t e = hipLaunchCooperativeKernel((void*)mega, dim3(grid_blocks), dim3(512), args, LDS_BYTES, stream);
  if (e != hipSuccess) fprintf(stderr, "cooperative launch failed: %s (grid %d)\n", hipGetErrorString(e), grid_blocks);
}
```

```cpp
#include <hip/hip_runtime.h>
#include <hip/hip_cooperative_groups.h>
#include <cstdio>
#include <cstdint>
namespace cg = cooperative_groups;

typedef unsigned short u16;
typedef __attribute__((ext_vector_type(8))) short bf16x8;
typedef __attribute__((ext_vector_type(4))) float f32x4;
typedef __attribute__((ext_vector_type(16))) float f32x16;

#define DEV __device__ __forceinline__

constexpr int NLAT = 65536, NCTX = 8192, NTOK = 73728;
constexpr int PS0 = 2304;
constexpr int PS1 = 4096;
constexpr int DNO = 1920;
constexpr float ALPHA = 1.4142135623730951f;

constexpr size_t OFF_WIN0 = 0;
constexpr size_t OFF_WOUT0 = OFF_WIN0 + (size_t)2304 * 1024 * 2;
constexpr size_t OFF_W1_0 = OFF_WOUT0 + (size_t)1024 * 1024 * 2;
constexpr size_t OFF_W1_1 = OFF_W1_0 + (size_t)4096 * 1024 * 2;
constexpr size_t OFF_W2_0 = OFF_W1_1 + (size_t)4096 * 1024 * 2;
constexpr size_t OFF_W2_1 = OFF_W2_0 + (size_t)4096 * 1024 * 2;
constexpr size_t OFF_WIN1 = OFF_W2_1 + (size_t)4096 * 1024 * 2;
constexpr size_t OFF_WOUT1 = OFF_WIN1 + (size_t)4096 * 1024 * 2;
constexpr size_t OFF_MODV = OFF_WOUT1 + (size_t)1024 * 1024 * 2;
constexpr size_t OFF_KR2048 = OFF_MODV + (size_t)2 * 33 * 6144 * 4;
constexpr size_t OFF_KR256 = OFF_KR2048 + (size_t)512 * 4096 * 2;
constexpr size_t OFF_ROPE = OFF_KR256 + (size_t)512 * 512 * 2;
constexpr size_t OFF_BSUM = OFF_ROPE + 8192;
constexpr size_t OFF_G2T = OFF_BSUM + (size_t)65536 * 16 * 4;
constexpr size_t OFF_BAR = OFF_G2T + (size_t)512 * 128 * 2;
constexpr size_t OFF_X = (size_t)64 << 20;
constexpr size_t OFF_HY = OFF_X + (size_t)NTOK * 1024 * 2;
constexpr size_t OFF_BIG = OFF_HY + (size_t)NTOK * 1024 * 2;
constexpr size_t WS_NEED = OFF_BIG + (size_t)NTOK * 4096 * 2;
static_assert(OFF_BAR + 16384 <= OFF_X, "ws map");
constexpr size_t SO_U = 0;
constexpr size_t SO_X0 = SO_U + (size_t)512 * 32 * 2048 * 2;
constexpr size_t SO_UC = SO_X0 + (size_t)512 * 32 * 2048 * 2;
constexpr size_t SO_X0C = SO_UC + (size_t)512 * 32 * 256 * 2;

struct Params {
  const float *x, *c, *ctx, *c_ctx, *mod_w, *mod_b, *ln_g, *ln_b, *mlp_w1, *mlp_w2, *e_w_in, *e_w_out, *hy_conv,
      *hy_w1, *hy_b1, *hy_w2, *hy_b2, *hy_freq, *hy_w3, *hy_decay, *hy_bias, *attn_sink, *o_w_in, *o_w_out,
      *rw_mu, *rw_w0, *rw_w2, *rw_a0, *rw_a2, *rw_g2, *rw_kk, *rw_ka, *rw_rk, *rw_lnx_g, *rw_lnx_b,
      *dn_conv, *dn_A_log, *dn_dt_bias, *dn_norm_g;
  float* out;
  char* ws;
};

typedef float f32x2_t __attribute__((ext_vector_type(2)));
typedef __bf16 bf16x2_t __attribute__((ext_vector_type(2)));
DEV u16 f2bf(float f) { return __builtin_bit_cast(u16, (__bf16)f); }
DEV float bf2f(u16 h) { return __uint_as_float(((unsigned)h) << 16); }
DEV float bflo(unsigned u) { return __uint_as_float(u << 16); }
DEV float bfhi(unsigned u) { return __uint_as_float(u & 0xffff0000u); }
DEV unsigned pack2(float a, float b) { f32x2_t v = {a, b}; return __builtin_bit_cast(unsigned, __builtin_convertvector(v, bf16x2_t)); }
DEV void unpack8(const uint4& v, float* f) {
  f[0] = bflo(v.x); f[1] = bfhi(v.x); f[2] = bflo(v.y); f[3] = bfhi(v.y);
  f[4] = bflo(v.z); f[5] = bfhi(v.z); f[6] = bflo(v.w); f[7] = bfhi(v.w);
}
DEV uint4 pack8(const float* f) {
  uint4 v; v.x = pack2(f[0], f[1]); v.y = pack2(f[2], f[3]); v.z = pack2(f[4], f[5]); v.w = pack2(f[6], f[7]); return v;
}
DEV int modrow(int r) { return r < NLAT ? (r >> 11) : 32; }
DEV float sigm(float x) { return 1.f / (1.f + __expf(-x)); }
DEV float silu(float x) { return x / (1.f + __expf(-x)); }
DEV float softplus(float x) { return fmaxf(x, 0.f) + __logf(1.f + __expf(-fabsf(x))); }
DEV float fast_tanh(float x) { return 1.f - 2.f / (1.f + __expf(2.f * x)); }
DEV float wave_sum(float v) {
#pragma unroll
  for (int o = 32; o > 0; o >>= 1) v += __shfl_xor(v, o, 64);
  return v;
}

extern __shared__ __attribute__((aligned(16))) char dyn_smem[];
#define LAS __attribute__((address_space(3)))
constexpr int HALF_LDS = 65536;
constexpr int HS_OFF = 2 * HALF_LDS + 2048;
constexpr int LDS_BYTES = HS_OFF + 256;
#define VTID ((int)(threadIdx.x & 255))
#define VHALF ((int)__builtin_amdgcn_readfirstlane((int)(threadIdx.x >> 8)))
#define VBID ((int)(blockIdx.x * 2 + VHALF))
#define VNB ((int)(gridDim.x * 2))
DEV void hsync() {
  LAS unsigned* cnt = (LAS unsigned*)(dyn_smem + HS_OFF) + VHALF * 16;
  asm volatile("s_waitcnt vmcnt(0) lgkmcnt(0)" ::: "memory");
  unsigned tgt = 0u;
  if ((threadIdx.x & 63) == 0) {
    const unsigned old = __hip_atomic_fetch_add(cnt, 1u, __ATOMIC_RELAXED, __HIP_MEMORY_SCOPE_WORKGROUP);
    tgt = (old & ~3u) + 4u;
  }
  tgt = __builtin_amdgcn_readfirstlane(tgt);
  while (__hip_atomic_load(cnt, __ATOMIC_RELAXED, __HIP_MEMORY_SCOPE_WORKGROUP) < tgt) __builtin_amdgcn_s_sleep(0);
  asm volatile("s_waitcnt lgkmcnt(0)" ::: "memory");
}
#define HSYNC() hsync()

DEV void transpose_tile(const float* __restrict__ src, int K, int N, int Npad, u16* __restrict__ dst, int tile,
                               u16* sm) {
  const int tid = VTID;
  const int ntn = Npad >> 6;
  const int tk = tile / ntn, tn = tile - tk * ntn;
  const int n = tid & 63, kq = tid >> 6;
  const int gn = tn * 64 + n;
#pragma unroll 4
  for (int i = 0; i < 16; ++i) {
    int k = kq + 4 * i;
    float v = (gn < N) ? src[(size_t)(tk * 64 + k) * N + gn] : 0.f;
    sm[n * 66 + k] = f2bf(v);
  }
  HSYNC();
  const int n2 = tid >> 2, q = tid & 3;
  const unsigned* s32 = (const unsigned*)sm + (n2 * 66 + q * 16) / 2;
  uint4 a, b;
  a.x = s32[0]; a.y = s32[1]; a.z = s32[2]; a.w = s32[3];
  b.x = s32[4]; b.y = s32[5]; b.z = s32[6]; b.w = s32[7];
  u16* d = dst + (size_t)(tn * 64 + n2) * K + tk * 64 + q * 16;
  *(uint4*)d = a;
  *(uint4*)(d + 8) = b;
  HSYNC();
}

DEV void modv_item(const Params& p, int it, float* sl) {
  const int tid = VTID;
  const int l = it / 288, rem = it % 288, cc = rem / 3, rg = rem % 3;
  for (int idx = tid; idx < 11 * 1024; idx += 256) {
    int r = rg * 11 + (idx >> 10), k = idx & 1023;
    float cv = (r < 32) ? p.c[r * 1024 + k] : p.c_ctx[k];
    sl[idx] = cv / (1.f + expf(-cv));
  }
  HSYNC();
  const int cl = tid & 63, kg = tid >> 6;
  const int col = cc * 64 + cl;
  float acc[11];
#pragma unroll
  for (int r = 0; r < 11; ++r) acc[r] = 0.f;
  const float* w = p.mod_w + (size_t)l * 1024 * 6144 + (size_t)(kg * 256) * 6144 + col;
#pragma unroll 8
  for (int k = 0; k < 256; ++k) {
    float wv = w[(size_t)k * 6144];
#pragma unroll
    for (int r = 0; r < 11; ++r) acc[r] += sl[r * 1024 + kg * 256 + k] * wv;
  }
  HSYNC();
  float* red = sl;
#pragma unroll
  for (int r = 0; r < 11; ++r) red[(kg * 11 + r) * 64 + cl] = acc[r];
  HSYNC();
  for (int idx = tid; idx < 11 * 64; idx += 256) {
    int r = idx >> 6, c2 = idx & 63;
    float v = red[(0 * 11 + r) * 64 + c2] + red[(1 * 11 + r) * 64 + c2] + red[(2 * 11 + r) * 64 + c2] + red[(3 * 11 + r) * 64 + c2];
    int gcol = cc * 64 + c2;
    ((float*)(p.ws + OFF_MODV))[(size_t)(l * 33 + rg * 11 + r) * 6144 + gcol] = v + p.mod_b[l * 6144 + gcol];
  }
  HSYNC();
}

DEV void filter_item(const Params& p, int it, float* sm) {
  const int L = it < 2048 ? 2048 : 256;
  const int t = it < 2048 ? it : it - 2048;
  u16* R = (u16*)(p.ws + (L == 2048 ? OFF_KR2048 : OFF_KR256));
  float* pe = sm; float* h1 = sm + 64; float* h2 = sm + 128;
  const int tid = VTID;
  const float tn = (float)t / (float)(L - 1);
  if (tid < 33) {
    float v;
    if (tid == 0) v = tn;
    else {
      int i = (tid - 1) & 15;
      double band = 1e-4 + (double)i * ((15.0 - 1e-4) / 15.0);
      double ang = 2.0 * 3.14159265358979323846 * (double)t * band / (double)L;
      v = (tid <= 16) ? (float)cos(ang) : (float)(-sin(ang));
    }
    pe[tid] = v;
  }
  HSYNC();
  if (tid < 64) {
    float acc = p.hy_b1[tid];
#pragma unroll 11
    for (int i = 0; i < 33; ++i) acc += pe[i] * p.hy_w1[i * 64 + tid];
    h1[tid] = sinf(p.hy_freq[tid] * acc);
  }
  HSYNC();
  if (tid < 64) {
    float acc = p.hy_b2[tid];
#pragma unroll 16
    for (int i = 0; i < 64; ++i) acc += h1[i] * p.hy_w2[i * 64 + tid];
    h2[tid] = sinf(p.hy_freq[tid] * acc);
  }
  HSYNC();
#pragma unroll 1
  for (int q = 0; q < 4; ++q) {
    int o = tid + 256 * q;
    float acc = 0.f;
#pragma unroll 16
    for (int i = 0; i < 64; ++i) acc += h2[i] * p.hy_w3[i * 1024 + o];
    float val = acc * expf(-tn * fabsf(p.hy_decay[o]));
    if (o < 512) {
      if (t == 0) val += p.hy_bias[o];
      R[(size_t)o * 2 * L + L - t] = f2bf(val);
    } else {
      int c = o - 512;
      if (t >= 1) R[(size_t)c * 2 * L + L + t] = f2bf(val);
      else R[(size_t)c * 2 * L] = 0;
    }
  }
  HSYNC();
}

DEV void phase_prep(const Params& p, char* smem) {
  constexpr int T_IN0 = 16 * 36, T_OUT = 16 * 16, T_W = 16 * 64;
  constexpr int E0 = T_IN0, E1 = E0 + T_OUT, E2 = E1 + T_W, E3 = E2 + T_W, E4 = E3 + T_W, E5 = E4 + T_W,
                E6 = E5 + T_W, E7 = E6 + T_OUT, E8 = E7 + 576, E9 = E8 + 2304, E10 = E9 + 1, E11 = E10 + 16;
  for (int it = VBID; it < E11; it += VNB) {
    if (it >= E10) transpose_tile(p.rw_g2, 128, 512, 512, (u16*)(p.ws + OFF_G2T), it - E10, (u16*)smem);
    else if (it < E0) transpose_tile(p.e_w_in, 1024, 2304, 2304, (u16*)(p.ws + OFF_WIN0), it, (u16*)smem);
    else if (it < E1) transpose_tile(p.e_w_out, 1024, 1024, 1024, (u16*)(p.ws + OFF_WOUT0), it - E0, (u16*)smem);
    else if (it < E2) transpose_tile(p.mlp_w1, 1024, 4096, 4096, (u16*)(p.ws + OFF_W1_0), it - E1, (u16*)smem);
    else if (it < E3) transpose_tile(p.mlp_w1 + (size_t)1024 * 4096, 1024, 4096, 4096, (u16*)(p.ws + OFF_W1_1), it - E2, (u16*)smem);
    else if (it < E4) transpose_tile(p.mlp_w2, 4096, 1024, 1024, (u16*)(p.ws + OFF_W2_0), it - E3, (u16*)smem);
    else if (it < E5) transpose_tile(p.mlp_w2 + (size_t)1024 * 4096, 4096, 1024, 1024, (u16*)(p.ws + OFF_W2_1), it - E4, (u16*)smem);
    else if (it < E6) transpose_tile(p.o_w_in, 1024, 3984, 4096, (u16*)(p.ws + OFF_WIN1), it - E5, (u16*)smem);
    else if (it < E7) transpose_tile(p.o_w_out, 1024, 1024, 1024, (u16*)(p.ws + OFF_WOUT1), it - E6, (u16*)smem);
    else if (it < E8) modv_item(p, it - E7, (float*)smem);
    else if (it < E9) filter_item(p, it - E8, (float*)smem);
    else {
      float2* tab = (float2*)(p.ws + OFF_ROPE);
      for (int q = 0; q < 4; ++q) {
        int e = VTID * 4 + q;
        int pos = e >> 4, i = e & 15;
        float inv = powf(10000.f, -(float)i / 16.f);
        float ang = (float)pos * inv;
        tab[e] = make_float2(cosf(ang), sinf(ang));
      }
    }
  }
}

DEV void phase_init(const Params& p) {
  const float* mv = (const float*)(p.ws + OFF_MODV);
  u16* X = (u16*)(p.ws + OFF_X);
  u16* HM = (u16*)(p.ws + OFF_HY);
  const size_t total = (size_t)NTOK * 128;
  for (size_t i = (size_t)VBID * 256 + VTID; i < total; i += (size_t)VNB * 256) {
    int r = (int)(i >> 7), c8 = (int)(i & 127) * 8;
    const float* src = r < NLAT ? p.x + (size_t)r * 1024 + c8 : p.ctx + (size_t)(r - NLAT) * 1024 + c8;
    float4 v0 = *(const float4*)src, v1 = *(const float4*)(src + 4);
    const float* m = mv + (size_t)modrow(r) * 6144 + c8;
    float4 h0 = *(const float4*)m, h1 = *(const float4*)(m + 4);
    float4 s0 = *(const float4*)(m + 1024), s1 = *(const float4*)(m + 1028);
    float f[8] = {v0.x, v0.y, v0.z, v0.w, v1.x, v1.y, v1.z, v1.w};
    float sh[8] = {h0.x, h0.y, h0.z, h0.w, h1.x, h1.y, h1.z, h1.w};
    float sc[8] = {s0.x, s0.y, s0.z, s0.w, s1.x, s1.y, s1.z, s1.w};
    float g[8];
#pragma unroll
    for (int j = 0; j < 8; ++j) g[j] = f[j] * (1.f + sc[j]) + sh[j];
    *(uint4*)(X + (size_t)r * 1024 + c8) = pack8(f);
    *(uint4*)(HM + (size_t)r * 1024 + c8) = pack8(g);
  }
}

template <int EPI>
DEV void gemm_phase(const u16* __restrict__ A, int lda, const u16* __restrict__ Bt, int K, int M, int N,
                    u16* __restrict__ C, int ldc, const float* __restrict__ gate, char* smem) {
  const int tid = threadIdx.x, lane = tid & 63, wave = tid >> 6;
  const int wm = wave >> 2, wn = wave & 3;
  const int fr = lane & 15, fq = lane >> 4;
  const int tn = N >> 8, tm = M >> 8, tiles = tm * tn;
  const int nk = K >> 6;
  const int drow = wave * 8 + (lane >> 3);
  const int dchunk = (lane & 7) ^ ((drow >> 1) & 7);
  const size_t lda64 = (size_t)lda * 64, ldb64 = (size_t)K * 64;
  const int sw = fr >> 1;
  const bool xcd_order = (gridDim.x & 7) == 0 && (tm & 31) == 0;
  const int mx = tm >> 3;
#define G_COORDS(IT, M0, N0)                                                   \
  {                                                                            \
    int tm_i, tn_i;                                                            \
    if (xcd_order) {                                                           \
      const int x = (IT) & 7, local = (IT) >> 3;                               \
      const int mg = local / (4 * tn), r = local - mg * 4 * tn;                \
      tn_i = r >> 2;                                                           \
      tm_i = x * mx + mg * 4 + (r & 3);                                        \
    } else { tm_i = (IT) / tn; tn_i = (IT) - tm_i * tn; }                      \
    M0 = tm_i << 8; N0 = tn_i << 8;                                            \
  }
  int m0 = 0, n0 = 0;
  const u16* ag = A;
  const u16* bg = Bt;
  bool primed = false;
  for (int it = blockIdx.x; it < tiles; it += gridDim.x) {
    if (!primed) {
      G_COORDS(it, m0, n0)
      ag = A + (size_t)(m0 + drow) * lda + dchunk * 8;
      bg = Bt + (size_t)(n0 + drow) * K + dchunk * 8;
    }
    f32x4 acc[8][4];
#pragma unroll
    for (int i = 0; i < 8; ++i)
#pragma unroll
      for (int j = 0; j < 4; ++j) acc[i][j] = (f32x4){0.f, 0.f, 0.f, 0.f};
#define G_ISSUE(KT, ST)                                                                                  \
  {                                                                                                      \
    const u16* a2 = ag + (KT)*64;                                                                        \
    const u16* b2 = bg + (KT)*64;                                                                        \
    char* la = smem + (ST)*65536 + wave * 1024;                                                          \
    _Pragma("unroll") for (int j = 0; j < 4; ++j) {                                                      \
      __builtin_amdgcn_global_load_lds((const unsigned*)(a2 + j * lda64), (unsigned*)(la + j * 8192), 16, 0, 0);          \
      __builtin_amdgcn_global_load_lds((const unsigned*)(b2 + j * ldb64), (unsigned*)(la + 32768 + j * 8192), 16, 0, 0);  \
    }                                                                                                    \
  }
    if (!primed) G_ISSUE(0, 0)
    for (int kt = 0; kt < nk; ++kt) {
      asm volatile("s_waitcnt vmcnt(0)" ::: "memory");
      __syncthreads();
      if (kt + 1 < nk) G_ISSUE(kt + 1, (kt + 1) & 1)
      const u16* As = (const u16*)(smem + (kt & 1) * 65536);
      const u16* Bs = As + 16384;
#define LDA(i, ks) (*(const bf16x8*)(As + (wm * 128 + (i) * 16 + fr) * 64 + ((((ks) * 4 + fq) ^ sw) * 8)))
#define LDB(j, ks) (*(const bf16x8*)(Bs + (wn * 64 + (j) * 16 + fr) * 64 + ((((ks) * 4 + fq) ^ sw) * 8)))
#define SB __builtin_amdgcn_sched_barrier(0)
#define MFMA_H(R, X0, Y0) acc[R][0] = __builtin_amdgcn_mfma_f32_16x16x32_bf16(X0, Y0, acc[R][0], 0, 0, 0);
#define MFMA_T(R, X0, X1, Y0, Y1, Y2, Y3)                                                  \
  acc[R][1] = __builtin_amdgcn_mfma_f32_16x16x32_bf16(X0, Y1, acc[R][1], 0, 0, 0);         \
  acc[R][2] = __builtin_amdgcn_mfma_f32_16x16x32_bf16(X0, Y2, acc[R][2], 0, 0, 0);         \
  acc[R][3] = __builtin_amdgcn_mfma_f32_16x16x32_bf16(X0, Y3, acc[R][3], 0, 0, 0);         \
  acc[R + 1][0] = __builtin_amdgcn_mfma_f32_16x16x32_bf16(X1, Y0, acc[R + 1][0], 0, 0, 0); \
  acc[R + 1][1] = __builtin_amdgcn_mfma_f32_16x16x32_bf16(X1, Y1, acc[R + 1][1], 0, 0, 0); \
  acc[R + 1][2] = __builtin_amdgcn_mfma_f32_16x16x32_bf16(X1, Y2, acc[R + 1][2], 0, 0, 0); \
  acc[R + 1][3] = __builtin_amdgcn_mfma_f32_16x16x32_bf16(X1, Y3, acc[R + 1][3], 0, 0, 0);
      {
        bf16x8 b0 = LDB(0, 0), b1 = LDB(1, 0), b2 = LDB(2, 0), b3 = LDB(3, 0);
        bf16x8 a0 = LDA(0, 0), a1 = LDA(1, 0);
        bf16x8 n0, n1, c0, c1, c2, c3;
        SB; MFMA_H(0, a0, b0) SB; n0 = LDA(2, 0); n1 = LDA(3, 0); SB; MFMA_T(0, a0, a1, b0, b1, b2, b3) SB;
        MFMA_H(2, n0, b0) SB; a0 = LDA(4, 0); a1 = LDA(5, 0); SB; MFMA_T(2, n0, n1, b0, b1, b2, b3) SB;
        MFMA_H(4, a0, b0) SB; n0 = LDA(6, 0); n1 = LDA(7, 0); SB; MFMA_T(4, a0, a1, b0, b1, b2, b3) SB;
        MFMA_H(6, n0, b0) SB;
        c0 = LDB(0, 1); c1 = LDB(1, 1); c2 = LDB(2, 1); c3 = LDB(3, 1); a0 = LDA(0, 1); a1 = LDA(1, 1);
        SB; MFMA_T(6, n0, n1, b0, b1, b2, b3) SB;
        MFMA_H(0, a0, c0) SB; n0 = LDA(2, 1); n1 = LDA(3, 1); SB; MFMA_T(0, a0, a1, c0, c1, c2, c3) SB;
        MFMA_H(2, n0, c0) SB; a0 = LDA(4, 1); a1 = LDA(5, 1); SB; MFMA_T(2, n0, n1, c0, c1, c2, c3) SB;
        MFMA_H(4, a0, c0) SB; n0 = LDA(6, 1); n1 = LDA(7, 1); SB; MFMA_T(4, a0, a1, c0, c1, c2, c3) SB;
        MFMA_H(6, n0, c0) MFMA_T(6, n0, n1, c0, c1, c2, c3) SB;
      }
#undef LDA
#undef LDB
#undef SB
#undef MFMA_H
#undef MFMA_T
    }
    const int cm0 = m0, cn0 = n0;
    primed = false;
    if (it + (int)gridDim.x < tiles) {
      G_COORDS(it + (int)gridDim.x, m0, n0)
      ag = A + (size_t)(m0 + drow) * lda + dchunk * 8;
      bg = Bt + (size_t)(n0 + drow) * K + dchunk * 8;
      G_ISSUE(0, 0)
      primed = true;
    }
    u16* Cs = (u16*)(smem + 65536);
#pragma unroll 1
    for (int hp = 0; hp < 2; ++hp) {
      asm volatile("s_waitcnt lgkmcnt(0)" ::: "memory");
      __builtin_amdgcn_s_barrier();
      asm volatile("" ::: "memory");
      if (wm == hp) {
#pragma unroll
        for (int i = 0; i < 8; ++i)
#pragma unroll
          for (int j = 0; j < 4; ++j)
#pragma unroll
            for (int e = 0; e < 4; ++e) {
              float v = acc[i][j][e];
              if (EPI == 1) { v = fmaxf(v, 0.f); v = v * v; }
              Cs[(i * 16 + fq * 4 + e) * 264 + wn * 64 + j * 16 + fr] = f2bf(v);
            }
      }
      asm volatile("s_waitcnt lgkmcnt(0)" ::: "memory");
      __builtin_amdgcn_s_barrier();
      asm volatile("" ::: "memory");
#pragma unroll 2
      for (int q = 0; q < 8; ++q) {
        const int chunk = tid + q * 512;
        const int row = chunk >> 5, cc = chunk & 31;
        uint4 cv = *(const uint4*)(Cs + row * 264 + cc * 8);
        const int grow = cm0 + hp * 128 + row;
        u16* dst = C + (size_t)grow * ldc + cn0 + cc * 8;
        if (EPI == 2) {
          float a[8], xo[8], y[8];
          unpack8(cv, a);
          unpack8(*(const uint4*)dst, xo);
          const float* gr = gate + (size_t)modrow(grow) * 6144 + cn0 + cc * 8;
          float4 g0 = *(const float4*)gr, g1 = *(const float4*)(gr + 4);
          float gg[8] = {g0.x, g0.y, g0.z, g0.w, g1.x, g1.y, g1.z, g1.w};
#pragma unroll
          for (int j = 0; j < 8; ++j) y[j] = ALPHA * xo[j] + gg[j] * a[j];
          cv = pack8(y);
        }
        *(uint4*)dst = cv;
      }
    }
    asm volatile("s_waitcnt lgkmcnt(0)" ::: "memory");
    __builtin_amdgcn_s_barrier();
    asm volatile("" ::: "memory");
  }
#undef G_ISSUE
#undef G_COORDS
}

template <bool FINAL>
DEV void ln_phase(const Params& p, int M, const float* __restrict__ g, const float* __restrict__ b,
                         const float* __restrict__ modl  , int shi, int sci) {
  u16* X = (u16*)(p.ws + OFF_X);
  u16* HM = (u16*)(p.ws + OFF_HY);
  const int lane = VTID & 63;
  const int gw = VBID * 4 + (VTID >> 6), nw = VNB * 4;
  uint4 nx0 = make_uint4(0u, 0u, 0u, 0u), nx1 = nx0;
  if (gw < M) {
    nx0 = *(const uint4*)(X + (size_t)gw * 1024 + lane * 8);
    nx1 = *(const uint4*)(X + (size_t)gw * 1024 + 512 + lane * 8);
  }
  for (int row = gw; row < M; row += nw) {
    u16* xr = X + (size_t)row * 1024;
    float f[16];
    unpack8(nx0, f);
    unpack8(nx1, f + 8);
    if (row + nw < M) {
      nx0 = *(const uint4*)(xr + (size_t)nw * 1024 + lane * 8);
      nx1 = *(const uint4*)(xr + (size_t)nw * 1024 + 512 + lane * 8);
    }
    float s = 0.f, q = 0.f;
#pragma unroll
    for (int j = 0; j < 16; ++j) { s += f[j]; q += f[j] * f[j]; }
#pragma unroll
    for (int o = 32; o > 0; o >>= 1) { s += __shfl_xor(s, o, 64); q += __shfl_xor(q, o, 64); }
    const float mu = s * (1.f / 1024.f);
    const float rs = rsqrtf(fmaxf(q * (1.f / 1024.f) - mu * mu, 0.f) + 1e-5f);
#pragma unroll
    for (int j = 0; j < 16; ++j) f[j] -= mu;
#pragma unroll
    for (int hh = 0; hh < 2; ++hh) {
      const int c0 = hh * 512 + lane * 8;
      float y[8];
#pragma unroll
      for (int j = 0; j < 8; ++j) y[j] = f[hh * 8 + j] * rs * g[c0 + j] + b[c0 + j];
      if (FINAL) {
        float* o = p.out + (size_t)row * 1024 + c0;
        *(float4*)o = make_float4(y[0], y[1], y[2], y[3]);
        *(float4*)(o + 4) = make_float4(y[4], y[5], y[6], y[7]);
      } else {
        *(uint4*)(xr + c0) = pack8(y);
        const float* m = modl + (size_t)modrow(row) * 6144;
        float h[8];
#pragma unroll
        for (int j = 0; j < 8; ++j) h[j] = y[j] * (1.f + m[sci * 1024 + c0 + j]) + m[shi * 1024 + c0 + j];
        *(uint4*)(HM + (size_t)row * 1024 + c0) = pack8(h);
      }
    }
  }
}

DEV void hyprep_item(const Params& p, int it, char* smem) {
  u16* su = (u16*)smem;
  u16* sx = su + 64 * 66;
  const u16* P = (const u16*)(p.ws + OFF_BIG);
  const int tid = VTID;
  const int ct = it & 7, st = it >> 3;
  int b, t0, L, rowbase;
  u16 *U, *X0;
  if (st < 1024) { b = st >> 5; t0 = (st & 31) * 64; L = 2048; rowbase = b * 2048;
    U = (u16*)((char*)p.out + SO_U); X0 = (u16*)((char*)p.out + SO_X0); }
  else { int s2 = st - 1024; b = s2 >> 2; t0 = (s2 & 3) * 64; L = 256; rowbase = NLAT + b * 256;
    U = (u16*)((char*)p.out + SO_UC); X0 = (u16*)((char*)p.out + SO_X0C); }
  const int c0 = ct * 64;
  {
    const int t = tid >> 2, cq = tid & 3;
    float z[3][16];
#pragma unroll
    for (int g = 0; g < 3; ++g)
#pragma unroll
      for (int j = 0; j < 16; ++j) z[g][j] = 0.f;
#pragma unroll
    for (int tap = 0; tap < 3; ++tap) {
      const int tt = t0 + t + tap - 1;
      if (tt >= 0 && tt < L) {
#pragma unroll
        for (int g = 0; g < 3; ++g) {
          const int col = g * 512 + c0 + cq * 16;
          const u16* src = P + (size_t)(rowbase + tt) * PS0 + col;
          float f[16];
          unpack8(*(const uint4*)src, f);
          unpack8(*(const uint4*)(src + 8), f + 8);
          const float* w = p.hy_conv + tap * 1536 + col;
#pragma unroll
          for (int j = 0; j < 16; ++j) z[g][j] += f[j] * w[j];
        }
      }
    }
#pragma unroll
    for (int j = 0; j < 16; ++j) {
      su[t * 66 + cq * 16 + j] = f2bf(z[1][j] * z[2][j]);
      sx[t * 66 + cq * 16 + j] = f2bf(z[0][j]);
    }
  }
  HSYNC();
  {
    const int c = tid >> 2, tq = tid & 3;
    unsigned wu[8], wx[8];
#pragma unroll
    for (int j = 0; j < 8; ++j) {
      wu[j] = (unsigned)su[(tq * 16 + 2 * j) * 66 + c] | ((unsigned)su[(tq * 16 + 2 * j + 1) * 66 + c] << 16);
      wx[j] = (unsigned)sx[(tq * 16 + 2 * j) * 66 + c] | ((unsigned)sx[(tq * 16 + 2 * j + 1) * 66 + c] << 16);
    }
    const size_t o = ((size_t)(c0 + c) * 32 + b) * L + t0 + tq * 16;
    *(uint4*)(U + o) = make_uint4(wu[0], wu[1], wu[2], wu[3]);
    *(uint4*)(U + o + 8) = make_uint4(wu[4], wu[5], wu[6], wu[7]);
    *(uint4*)(X0 + o) = make_uint4(wx[0], wx[1], wx[2], wx[3]);
    *(uint4*)(X0 + o + 8) = make_uint4(wx[4], wx[5], wx[6], wx[7]);
  }
  HSYNC();
}

DEV void rope_item(const Params& p, int it) {
  u16* P = (u16*)(p.ws + OFF_BIG);
  const float2* tab = (const float2*)(p.ws + OFF_ROPE);
  const int task = it * 256 + VTID;
  const int row = task / 40, rem = task - row * 40;
  const int head = rem >> 2, pr = rem & 3;
  const int d0 = (pr >> 1) * 32 + (pr & 1) * 8;
  const int t = row & 2047;
  const int posc = (pr >> 1) ? (t & 63) : (t >> 6);
  const int fi0 = (pr & 1) * 8;
  u16* ptr = P + (size_t)row * PS0 + 1536 + head * 64 + d0;
  float u1[8], u2[8], o1[8], o2[8];
  unpack8(*(const uint4*)ptr, u1);
  unpack8(*(const uint4*)(ptr + 16), u2);
#pragma unroll
  for (int j = 0; j < 8; ++j) {
    float2 cs = tab[posc * 16 + fi0 + j];
    o1[j] = u1[j] * cs.x - u2[j] * cs.y;
    o2[j] = u1[j] * cs.y + u2[j] * cs.x;
  }
  *(uint4*)ptr = pack8(o1);
  *(uint4*)(ptr + 16) = pack8(o2);
}

DEV void phase_hyprep_rope(const Params& p, char* smem) {
  constexpr int NH = 9216, NR = 10240;
  for (int it = VBID; it < NH + NR; it += VNB) {
    if (it < NH) hyprep_item(p, it, smem);
    else rope_item(p, it - NH);
  }
}

template <int L, int NT>
DEV void conv_item(const Params& p, int c, int th, char* smem) {
  const u16* R = (const u16*)(p.ws + (L == 2048 ? OFF_KR2048 : OFF_KR256)) + (size_t)c * 2 * L;
  const u16* U = (const u16*)((const char*)p.out + (L == 2048 ? SO_U : SO_UC));
  const u16* X0 = (const u16*)((const char*)p.out + (L == 2048 ? SO_X0 : SO_X0C));
  u16* Y = (u16*)(p.ws + OFF_HY);
  u16* Rs0 = (u16*)smem;
  u16* Rs1 = Rs0 + 2 * L + 8;
  const int tid = VTID, lane = tid & 63, wave = tid >> 6;
  for (int i = tid; i < 2 * L; i += 256) {
    Rs0[i] = R[i];
    Rs1[i] = (i + 1 < 2 * L) ? R[i + 1] : (u16)0;
  }
  HSYNC();
  const int r = lane & 31, h = lane >> 5;
  const char* lanebase = (r & 1) ? (const char*)Rs1 + 2 * (8 * h - r + L - 1) : (const char*)Rs0 + 2 * (8 * h - r + L);
  const u16* Ub = U + ((size_t)c * 32 + r) * L + 8 * h;
  const int tw0 = th * 1024 + wave * NT * 32;
  f32x16 acc[NT];
#pragma unroll
  for (int i = 0; i < NT; ++i)
#pragma unroll
    for (int e = 0; e < 16; ++e) acc[i][e] = 0.f;
  uint4 nb = *(const uint4*)Ub;
  for (int st = 0; st < L / 16; ++st) {
    uint4 cur = nb;
    if (st + 1 < L / 16) nb = *(const uint4*)(Ub + (st + 1) * 16);
    bf16x8 bfrag = *(bf16x8*)&cur;
#pragma unroll
    for (int i = 0; i < NT; ++i) {
      const unsigned* ap = (const unsigned*)(lanebase + 2 * (st * 16 - (tw0 + i * 32)));
      uint4 av = make_uint4(ap[0], ap[1], ap[2], ap[3]);
      acc[i] = __builtin_amdgcn_mfma_f32_32x32x16_bf16(*(bf16x8*)&av, bfrag, acc[i], 0, 0, 0);
    }
  }
  const int rowbase = (L == 2048) ? r * 2048 : NLAT + r * 256;
#pragma unroll
  for (int i = 0; i < NT; ++i) {
#pragma unroll
    for (int g4 = 0; g4 < 4; ++g4) {
      const int tt = tw0 + i * 32 + 8 * g4 + 4 * h;
      uint2 xv = *(const uint2*)(X0 + ((size_t)c * 32 + r) * L + tt);
      float x0[4] = {bflo(xv.x), bfhi(xv.x), bflo(xv.y), bfhi(xv.y)};
#pragma unroll
      for (int e = 0; e < 4; ++e) Y[(size_t)(rowbase + tt + e) * 1024 + c] = f2bf(acc[i][g4 * 4 + e] * x0[e]);
    }
  }
  HSYNC();
}

DEV void attn_item(const Params& p, int b, int hq, int qb, bool isctx, char* smem) {
  const u16* P = (const u16*)(p.ws + OFF_BIG);
  u16* Y = (u16*)(p.ws + OFF_HY);
  u16* Ks = (u16*)smem;
  u16* Vt = Ks + 64 * 72;
  const int tid = VTID, lane = tid & 63, wave = tid >> 6;
  const int nq = lane & 15, quad = lane >> 4;
  const int qrow = (isctx ? NLAT + b * 256 : b * 2048) + qb * 64 + wave * 16 + nq;
  const int qpos = qb * 64 + wave * 16 + nq;
  const int hkv = hq >> 2;
  const int kcol = 2048 + hkv * 64, vcol = 2176 + hkv * 64;
  bf16x8 qf[2];
#pragma unroll
  for (int ks = 0; ks < 2; ++ks)
    qf[ks] = *(const bf16x8*)(P + (size_t)qrow * PS0 + 1536 + hq * 64 + ks * 32 + quad * 8);
  float m = p.attn_sink[hq];
  float lsum = (quad == 0) ? 1.f : 0.f;
  f32x4 oacc[4];
#pragma unroll
  for (int n = 0; n < 4; ++n) oacc[n] = (f32x4){0.f, 0.f, 0.f, 0.f};
  const int nloc = isctx ? 0 : 5;
  for (int ti = 0; ti < nloc + 4; ++ti) {
    int krow0, k0 = 0;
    bool masked;
    if (ti < nloc) {
      k0 = qb * 64 - 128 + ti * 64;
      if (k0 < 0 || k0 >= 2048) continue;
      krow0 = b * 2048 + k0; masked = true;
    } else { krow0 = NLAT + b * 256 + (ti - nloc) * 64; masked = false; }
    HSYNC();
    {
      const int key = tid >> 2, part = tid & 3;
      const u16* kp = P + (size_t)(krow0 + key) * PS0 + kcol + part * 16;
      const u16* vp = P + (size_t)(krow0 + key) * PS0 + vcol + part * 16;
      uint4 k0v = *(const uint4*)kp, k1v = *(const uint4*)(kp + 8);
      uint4 v0v = *(const uint4*)vp, v1v = *(const uint4*)(vp + 8);
      *(uint4*)(Ks + key * 72 + part * 16) = k0v;
      *(uint4*)(Ks + key * 72 + part * 16 + 8) = k1v;
      unsigned vw[8] = {v0v.x, v0v.y, v0v.z, v0v.w, v1v.x, v1v.y, v1v.z, v1v.w};
#pragma unroll
      for (int j = 0; j < 8; ++j) {
        Vt[(part * 16 + 2 * j) * 72 + key] = (u16)(vw[j] & 0xffffu);
        Vt[(part * 16 + 2 * j + 1) * 72 + key] = (u16)(vw[j] >> 16);
      }
    }
    HSYNC();
    f32x4 s[4];
#pragma unroll
    for (int n = 0; n < 4; ++n) {
      s[n] = (f32x4){0.f, 0.f, 0.f, 0.f};
#pragma unroll
      for (int ks = 0; ks < 2; ++ks) {
        bf16x8 kf = *(const bf16x8*)(Ks + (n * 16 + nq) * 72 + ks * 32 + quad * 8);
        s[n] = __builtin_amdgcn_mfma_f32_16x16x32_bf16(kf, qf[ks], s[n], 0, 0, 0);
      }
    }
    float mx = -1e30f;
#pragma unroll
    for (int n = 0; n < 4; ++n)
#pragma unroll
      for (int e = 0; e < 4; ++e) {
        float v = s[n][e] * 0.125f;
        if (masked) {
          int kpos = k0 + n * 16 + quad * 4 + e;
          int d = qpos - kpos;
          if (d > 128 || d < -128) v = -1e30f;
        }
        s[n][e] = v;
        mx = fmaxf(mx, v);
      }
    mx = fmaxf(mx, __shfl_xor(mx, 16, 64));
    mx = fmaxf(mx, __shfl_xor(mx, 32, 64));
    const float mn = fmaxf(m, mx);
    const float al = __expf(m - mn);
    m = mn;
    float ps = 0.f;
#pragma unroll
    for (int n = 0; n < 4; ++n)
#pragma unroll
      for (int e = 0; e < 4; ++e) { float pv = __expf(s[n][e] - mn); s[n][e] = pv; ps += pv; }
    lsum = lsum * al + ps;
#pragma unroll
    for (int n = 0; n < 4; ++n)
#pragma unroll
      for (int e = 0; e < 4; ++e) oacc[n][e] *= al;
#pragma unroll
    for (int hh = 0; hh < 2; ++hh) {
      uint4 pw;
      pw.x = pack2(s[2 * hh][0], s[2 * hh][1]); pw.y = pack2(s[2 * hh][2], s[2 * hh][3]);
      pw.z = pack2(s[2 * hh + 1][0], s[2 * hh + 1][1]); pw.w = pack2(s[2 * hh + 1][2], s[2 * hh + 1][3]);
      bf16x8 pb = *(bf16x8*)&pw;
#pragma unroll
      for (int n = 0; n < 4; ++n) {
        const u16* vr = Vt + (n * 16 + nq) * 72 + quad * 4;
        uint2 va = *(const uint2*)(vr + (2 * hh) * 16);
        uint2 vb = *(const uint2*)(vr + (2 * hh + 1) * 16);
        uint4 vv = make_uint4(va.x, va.y, vb.x, vb.y);
        oacc[n] = __builtin_amdgcn_mfma_f32_16x16x32_bf16(*(bf16x8*)&vv, pb, oacc[n], 0, 0, 0);
      }
    }
  }
  lsum += __shfl_xor(lsum, 16, 64);
  lsum += __shfl_xor(lsum, 32, 64);
  const float inv = 1.f / lsum;
  u16* yo = Y + (size_t)qrow * 1024 + 512 + hq * 64 + quad * 4;
#pragma unroll
  for (int n = 0; n < 4; ++n) {
    uint2 w;
    w.x = pack2(oacc[n][0] * inv, oacc[n][1] * inv);
    w.y = pack2(oacc[n][2] * inv, oacc[n][3] * inv);
    *(uint2*)(yo + n * 16) = w;
  }
  HSYNC();
}

DEV void phase_conv_attn(const Params& p, char* smem) {
  constexpr int N0 = 1024, N1 = N0 + 512, N2 = N1 + 8192, N3 = N2 + 1024;
#pragma unroll 1
  for (int it = VBID; it < N0; it += VNB) conv_item<2048, 8>(p, it >> 1, it & 1, smem);
  __builtin_amdgcn_sched_barrier(0);
#pragma unroll 1
  for (int it = VBID; it < N3; it += VNB) {
    if (it < N0) continue;
    if (it < N1) conv_item<256, 2>(p, it - N0, 0, smem);
  }
  __builtin_amdgcn_sched_barrier(0);
#pragma unroll 1
  for (int it = VBID; it < N3; it += VNB) {
    if (it < N1) continue;
    if (it < N2) { int a = it - N1; attn_item(p, a >> 8, (a >> 5) & 7, a & 31, false, smem); }
    else { int a = it - N2; attn_item(p, a >> 5, (a >> 2) & 7, a & 3, true, smem); }
  }
}

DEV void lds_wave_sync() {
  asm volatile("s_waitcnt lgkmcnt(0)" ::: "memory");
  __builtin_amdgcn_wave_barrier();
}

DEV void rwkv_item(const Params& p, int ri, char* smem) {
  const u16* P = (const u16*)(p.ws + OFF_BIG);
  u16* O4 = (u16*)p.out;
  float* BS = (float*)(p.ws + OFF_BSUM);
  const int tid0 = VTID;
  const int wp0 = tid0 >> 7;
  const int cid = ri * 2 + wp0;
  const int b = cid >> 4, d = (cid >> 3) & 1, h = cid & 7;
  f32x4 S[4][2];
#pragma unroll
  for (int i = 0; i < 4; ++i)
#pragma unroll
    for (int j = 0; j < 2; ++j) S[i][j] = (f32x4){0.f, 0.f, 0.f, 0.f};
  uint4 bw[2][4];
  float l0[4];
  {
    const int lane = tid0 & 63, wi = (tid0 >> 6) & 1, fr = lane & 15, fq = lane >> 4;
    const float* wsrc = (wi == 0 ? p.rw_w2 : p.rw_a2) + (size_t)d * 64 * 512 + h * 64;
    const float* bsrc = (wi == 0 ? p.rw_w0 : p.rw_a0) + d * 512 + h * 64;
#pragma unroll
    for (int nt = 0; nt < 4; ++nt) {
      l0[nt] = bsrc[nt * 16 + fr];
#pragma unroll
      for (int ks = 0; ks < 2; ++ks) {
        __builtin_amdgcn_sched_barrier(0);
        float f[8];
        const float* wp_ = wsrc + (size_t)(ks * 32 + fq * 8) * 512 + nt * 16 + fr;
#pragma unroll
        for (int j = 0; j < 8; ++j) f[j] = wp_[j * 512];
        bw[ks][nt] = pack8(f);
      }
    }
  }
  uint4 pre[5][3];
#define RW_LOAD(CI)                                                                                 \
  {                                                                                                 \
    const int seg_ = (CI) < 16 ? 0 : 1;                                                             \
    const int ch_ = seg_ ? (CI)-16 : (CI);                                                          \
    const int Ls_ = seg_ ? 2048 : 256;                                                              \
    const int rb_ = seg_ ? b * 2048 : NLAT + b * 256;                                               \
    const int sidx_ = ch_ * 16 + stt;                                                               \
    const int t_ = d == 0 ? sidx_ : Ls_ - 1 - sidx_;                                                \
    const u16* prow_ = P + (size_t)(rb_ + t_) * PS1 + spart * 8;                                    \
    _Pragma("unroll") for (int g = 0; g < 5; ++g) {                                                 \
      const int col_ = g < 3 ? g * 512 + h * 64 : (g == 3 ? 1536 + d * 64 : 1664 + d * 64);         \
      _Pragma("unroll") for (int tap = 0; tap < 3; ++tap) {                                         \
        const int tt_ = t_ + tap - 1;                                                               \
        if (tt_ >= 0 && tt_ < Ls_) pre[g][tap] = *(const uint4*)(prow_ + (ptrdiff_t)(tap - 1) * PS1 + col_); \
        else pre[g][tap] = make_uint4(0u, 0u, 0u, 0u);                                              \
      }                                                                                             \
    }                                                                                               \
  }
  {
    const int pt = tid0 & 127, stt = pt >> 3, spart = pt & 7;
    RW_LOAD(0)
  }
  for (int cidx = 0; cidx < 144; ++cidx) {
    asm volatile("" ::: "memory");
    int tid = tid0;
    asm volatile("" : "+v"(tid));
    const int lane = tid & 63, wave = tid >> 6, wp = wave >> 1, wi = wave & 1, pt = tid & 127;
    const int fr = lane & 15, fq = lane >> 4, stt = pt >> 3, spart = pt & 7;
    const int seg = cidx < 16 ? 0 : 1;
    const int ch = seg ? cidx - 16 : cidx;
    const int Ls = seg ? 2048 : 256;
    char* base = smem + wp * 32768;
    u16* RK = (u16*)base;
    u16* KD = RK + 1152;
    u16* KK = KD + 1152;
    u16* AB = KK + 1152;
    u16* VT = AB + 1152;
    float* LW = (float*)(base + 11264);
    u16* TW = (u16*)(base + 15360);
    u16* AD = TW + 1152;
    u16* BgCT = (u16*)(base + 19968);
    u16* KgCT = BgCT + 1024;
    float* gC = (float*)(base + 24064);
    float* Amat = (float*)(base + 24320) + wi * 256;
    u16* Tinv = (u16*)(base + 26368) + wi * 256;
    u16* BG = (u16*)(base + 27392);
    {
      const int o = stt * 72 + spart * 8;
#pragma unroll
      for (int g = 0; g < 5; ++g) {
        __builtin_amdgcn_sched_barrier(0);
        const int col = g < 3 ? g * 512 + h * 64 : (g == 3 ? 1536 + d * 64 : 1664 + d * 64);
        float pc[8], pp[8], pn[8], v[8];
        unpack8(pre[g][1], pc); unpack8(pre[g][0], pp); unpack8(pre[g][2], pn);
        const float* mu = p.rw_mu + col + spart * 8;
        float4 m0 = *(const float4*)mu, m1 = *(const float4*)(mu + 4);
        const float mm[8] = {m0.x, m0.y, m0.z, m0.w, m1.x, m1.y, m1.z, m1.w};
#pragma unroll
        for (int j = 0; j < 8; ++j) v[j] = pc[j] + mm[j] * (0.5f * (pp[j] + pn[j]) - pc[j]);
        if (g == 0) *(uint4*)(RK + o) = pack8(v);
        else if (g == 1) {
          *(uint4*)(KD + o) = pack8(v);
          const float* kkw = p.rw_kk + h * 64 + spart * 8;
          float kkv[8];
          float ss = 0.f;
#pragma unroll
          for (int j = 0; j < 8; ++j) { kkv[j] = v[j] * kkw[j]; ss += kkv[j] * kkv[j]; }
          ss += __shfl_xor(ss, 1, 64); ss += __shfl_xor(ss, 2, 64); ss += __shfl_xor(ss, 4, 64);
          const float inv = rsqrtf(ss + 1e-6f);
#pragma unroll
          for (int j = 0; j < 8; ++j) kkv[j] *= inv;
          *(uint4*)(KK + o) = pack8(kkv);
        } else if (g == 2) {
#pragma unroll
          for (int j = 0; j < 8; ++j) VT[(spart * 8 + j) * 16 + stt] = f2bf(v[j]);
        } else if (g == 3) {
#pragma unroll
          for (int j = 0; j < 8; ++j) v[j] = fast_tanh(v[j]);
          *(uint4*)(TW + o) = pack8(v);
        } else *(uint4*)(AD + o) = pack8(v);
      }
    }
    HSYNC();
    if (cidx + 1 < 144) RW_LOAD(cidx + 1)
    {
      const u16* IN = wi == 0 ? TW : AD;
      bf16x8 af0 = *(const bf16x8*)(IN + fr * 72 + fq * 8);
      bf16x8 af1 = *(const bf16x8*)(IN + fr * 72 + 32 + fq * 8);
#pragma unroll
      for (int nt = 0; nt < 4; ++nt) {
        f32x4 o4 = (f32x4){0.f, 0.f, 0.f, 0.f};
        o4 = __builtin_amdgcn_mfma_f32_16x16x32_bf16(af0, *(bf16x8*)&bw[0][nt], o4, 0, 0, 0);
        o4 = __builtin_amdgcn_mfma_f32_16x16x32_bf16(af1, *(bf16x8*)&bw[1][nt], o4, 0, 0, 0);
#pragma unroll
        for (int e = 0; e < 4; ++e) {
          const float prev = l0[nt] + o4[e];
          const int t = fq * 4 + e, c = nt * 16 + fr;
          if (wi == 0) LW[t * 64 + c] = -__expf(-softplus(-prev) - 0.5f);
          else AB[t * 72 + c] = f2bf(sigm(prev));
        }
      }
    }
    HSYNC();
    {
      const int c = lane;
      float cum = 0.f;
      if (wi == 0) {
#pragma unroll 4
        for (int t = 0; t < 16; ++t) {
          const float lw = LW[t * 64 + c];
          const float gp = __expf(cum);
          cum += lw;
          const float gi = __expf(-cum);
          const float kk = bf2f(KK[t * 72 + c]);
          const float a = bf2f(AB[t * 72 + c]);
          KK[t * 72 + c] = f2bf(kk * gp);
          BG[t * 72 + c] = f2bf(kk * a * gi);
        }
        const float gCv = __expf(cum);
        gC[c] = gCv;
#pragma unroll 4
        for (int t = 0; t < 16; ++t) BgCT[c * 16 + t] = f2bf(-bf2f(BG[t * 72 + c]) * gCv);
      } else {
        float* PR = (float*)TW;
        const float kac = p.rw_ka[h * 64 + c], rkc = p.rw_rk[h * 64 + c];
#pragma unroll 4
        for (int t = 0; t < 16; ++t) {
          const float lw = LW[t * 64 + c];
          cum += lw;
          const float g = __expf(cum), gi = __expf(-cum);
          const float r = bf2f(RK[t * 72 + c]);
          const float k = bf2f(KD[t * 72 + c]);
          const float a = bf2f(AB[t * 72 + c]);
          const float kd = k * (1.f + (a - 1.f) * kac);
          RK[t * 72 + c] = f2bf(r * g);
          KD[t * 72 + c] = f2bf(kd * gi);
          PR[t * 64 + c] = r * kd * rkc;
        }
        const float gCv = __expf(cum);
#pragma unroll 4
        for (int t = 0; t < 16; ++t) KgCT[c * 16 + t] = f2bf(bf2f(KD[t * 72 + c]) * gCv);
        lds_wave_sync();
        {
          const int t = lane >> 2, sg = lane & 3;
          const float4 q0 = *(const float4*)(PR + t * 64 + sg * 16), q1 = *(const float4*)(PR + t * 64 + sg * 16 + 4);
          const float4 q2 = *(const float4*)(PR + t * 64 + sg * 16 + 8), q3 = *(const float4*)(PR + t * 64 + sg * 16 + 12);
          float bsum = (q0.x + q0.y + q0.z + q0.w) + (q1.x + q1.y + q1.z + q1.w) + (q2.x + q2.y + q2.z + q2.w) + (q3.x + q3.y + q3.z + q3.w);
          bsum += __shfl_xor(bsum, 1, 64);
          bsum += __shfl_xor(bsum, 2, 64);
          if (seg == 1 && sg == 0) {
            const int sidx = ch * 16 + t;
            const int tpos = d == 0 ? sidx : 2047 - sidx;
            BS[(size_t)(b * 2048 + tpos) * 16 + h * 2 + d] = bsum;
          }
        }
      }
    }
    HSYNC();
    __builtin_amdgcn_sched_barrier(0);
    {
      f32x4 XabT = (f32x4){0.f, 0.f, 0.f, 0.f}, XakT = XabT, XrbT = XabT, XrkT = XabT;
#pragma unroll
      for (int ks = 0; ks < 2; ++ks) {
        bf16x8 kkf = *(const bf16x8*)(KK + fr * 72 + ks * 32 + fq * 8);
        bf16x8 rgf = *(const bf16x8*)(RK + fr * 72 + ks * 32 + fq * 8);
        bf16x8 bgf = *(const bf16x8*)(BG + fr * 72 + ks * 32 + fq * 8);
        bf16x8 kgf = *(const bf16x8*)(KD + fr * 72 + ks * 32 + fq * 8);
        XabT = __builtin_amdgcn_mfma_f32_16x16x32_bf16(bgf, kkf, XabT, 0, 0, 0);
        XakT = __builtin_amdgcn_mfma_f32_16x16x32_bf16(kgf, kkf, XakT, 0, 0, 0);
        XrbT = __builtin_amdgcn_mfma_f32_16x16x32_bf16(bgf, rgf, XrbT, 0, 0, 0);
        XrkT = __builtin_amdgcn_mfma_f32_16x16x32_bf16(kgf, rgf, XrkT, 0, 0, 0);
      }
      {
        float am[4];
#pragma unroll
        for (int e = 0; e < 4; ++e) am[e] = (fq * 4 + e < fr) ? XabT[e] : 0.f;
        *(float4*)(Amat + fr * 16 + fq * 4) = make_float4(am[0], am[1], am[2], am[3]);
      }
      lds_wave_sync();
      if (lane < 16) {
        float x[16];
        x[0] = (lane == 0) ? 1.f : 0.f;
        float4 cur[4], nxt[4];
        cur[0] = *(const float4*)(Amat + 16);
        cur[1] = cur[0]; cur[2] = cur[0]; cur[3] = cur[0];
#pragma unroll
        for (int i = 1; i < 16; ++i) {
          __builtin_amdgcn_sched_barrier(0);
          if (i + 1 < 16) {
#pragma unroll
            for (int q = 0; q < (i + 4) / 4; ++q) nxt[q] = *(const float4*)(Amat + (i + 1) * 16 + q * 4);
          }
          float acc = (i == lane) ? 1.f : 0.f;
#pragma unroll
          for (int j = 0; j < i; ++j) {
            const float4 rv = cur[j >> 2];
            const float av = (j & 3) == 0 ? rv.x : ((j & 3) == 1 ? rv.y : ((j & 3) == 2 ? rv.z : rv.w));
            acc -= av * x[j];
          }
          x[i] = acc;
#pragma unroll
          for (int q = 0; q < 4; ++q) cur[q] = nxt[q];
        }
#pragma unroll
        for (int i = 0; i < 16; ++i) Tinv[i * 16 + lane] = f2bf(x[i]);
      }
      lds_wave_sync();
      f32x4 sa0[2], y0[2];
#pragma unroll
      for (int nt = 0; nt < 2; ++nt) { sa0[nt] = (f32x4){0.f, 0.f, 0.f, 0.f}; y0[nt] = (f32x4){0.f, 0.f, 0.f, 0.f}; }
#pragma unroll
      for (int x = 0; x < 2; ++x) {
        __builtin_amdgcn_sched_barrier(0);
        uint2 k0 = *(const uint2*)(KK + fr * 72 + 32 * x + fq * 4);
        uint2 k1 = *(const uint2*)(KK + fr * 72 + 32 * x + 16 + fq * 4);
        uint2 r0 = *(const uint2*)(RK + fr * 72 + 32 * x + fq * 4);
        uint2 r1 = *(const uint2*)(RK + fr * 72 + 32 * x + 16 + fq * 4);
        uint4 kw = make_uint4(k0.x, k0.y, k1.x, k1.y);
        uint4 rw = make_uint4(r0.x, r0.y, r1.x, r1.y);
#pragma unroll
        for (int nt = 0; nt < 2; ++nt) {
          uint4 sw;
          sw.x = pack2(S[2 * x][nt][0], S[2 * x][nt][1]); sw.y = pack2(S[2 * x][nt][2], S[2 * x][nt][3]);
          sw.z = pack2(S[2 * x + 1][nt][0], S[2 * x + 1][nt][1]); sw.w = pack2(S[2 * x + 1][nt][2], S[2 * x + 1][nt][3]);
          sa0[nt] = __builtin_amdgcn_mfma_f32_16x16x32_bf16(*(bf16x8*)&kw, *(bf16x8*)&sw, sa0[nt], 0, 0, 0);
          y0[nt] = __builtin_amdgcn_mfma_f32_16x16x32_bf16(*(bf16x8*)&rw, *(bf16x8*)&sw, y0[nt], 0, 0, 0);
        }
      }
      float ak[4], rb[4], rk[4];
#pragma unroll
      for (int e = 0; e < 4; ++e) {
        const int j = fq * 4 + e;
        ak[e] = (j < fr) ? XakT[e] : 0.f;
        rb[e] = (j <= fr) ? -XrbT[e] : 0.f;
        rk[e] = (j <= fr) ? XrkT[e] : 0.f;
      }
      const uint4 akw = make_uint4(pack2(ak[0], ak[1]), pack2(ak[2], ak[3]), 0u, 0u);
      const uint4 ybw = make_uint4(pack2(rb[0], rb[1]), pack2(rb[2], rb[3]), pack2(rk[0], rk[1]), pack2(rk[2], rk[3]));
      const uint2 tv = *(const uint2*)(Tinv + fr * 16 + fq * 4);
      const uint4 tw = make_uint4(tv.x, tv.y, 0u, 0u);
      uint4 sv[2];
#pragma unroll
      for (int nt = 0; nt < 2; ++nt) {
        const int vc = wi * 32 + nt * 16 + fr;
        const uint2 vt = *(const uint2*)(VT + vc * 16 + fq * 4);
        const uint4 vb = make_uint4(vt.x, vt.y, 0u, 0u);
        f32x4 rhs = __builtin_amdgcn_mfma_f32_16x16x32_bf16(*(bf16x8*)&akw, *(bf16x8*)&vb, sa0[nt], 0, 0, 0);
        const uint4 rw = make_uint4(pack2(rhs[0], rhs[1]), pack2(rhs[2], rhs[3]), 0u, 0u);
        f32x4 sa = __builtin_amdgcn_mfma_f32_16x16x32_bf16(*(bf16x8*)&tw, *(bf16x8*)&rw, (f32x4){0.f, 0.f, 0.f, 0.f}, 0, 0, 0);
        sv[nt] = make_uint4(pack2(sa[0], sa[1]), pack2(sa[2], sa[3]), vt.x, vt.y);
        f32x4 y = __builtin_amdgcn_mfma_f32_16x16x32_bf16(*(bf16x8*)&ybw, *(bf16x8*)&sv[nt], y0[nt], 0, 0, 0);
        if (seg == 1) {
#pragma unroll
          for (int e = 0; e < 4; ++e) {
            const int sidx = ch * 16 + fq * 4 + e;
            const int tpos = d == 0 ? sidx : 2047 - sidx;
            O4[((size_t)d * NLAT + b * 2048 + tpos) * 512 + h * 64 + vc] = f2bf(y[e]);
          }
        }
      }
#pragma unroll
      for (int mt = 0; mt < 4; ++mt) {
        __builtin_amdgcn_sched_barrier(0);
        const float4 g4 = *(const float4*)(gC + mt * 16 + fq * 4);
        const uint2 bv = *(const uint2*)(BgCT + (mt * 16 + fr) * 16 + fq * 4);
        const uint2 kv = *(const uint2*)(KgCT + (mt * 16 + fr) * 16 + fq * 4);
        const uint4 aw = make_uint4(bv.x, bv.y, kv.x, kv.y);
#pragma unroll
        for (int nt = 0; nt < 2; ++nt) {
          S[mt][nt][0] *= g4.x; S[mt][nt][1] *= g4.y; S[mt][nt][2] *= g4.z; S[mt][nt][3] *= g4.w;
          S[mt][nt] = __builtin_amdgcn_mfma_f32_16x16x32_bf16(*(bf16x8*)&aw, *(bf16x8*)&sv[nt], S[mt][nt], 0, 0, 0);
        }
      }
    }
    HSYNC();
  }
#undef RW_LOAD
}

DEV void gdn_item(const Params& p, int gi, char* smem) {
  const u16* P = (const u16*)(p.ws + OFF_BIG);
  u16* O4 = (u16*)p.out;
  const int tid0 = VTID;
  const int b = gi >> 3, d = (gi >> 2) & 1, h = gi & 3;
  constexpr int BUFB = 23424;
  f32x4 S[8][2];
#pragma unroll
  for (int i = 0; i < 8; ++i)
#pragma unroll
    for (int j = 0; j < 2; ++j) S[i][j] = (f32x4){0.f, 0.f, 0.f, 0.f};
  const float negA = -__expf(p.dn_A_log[d * 4 + h]);
  const float dtb = p.dn_dt_bias[d * 4 + h];
  uint4 pre[3][3];
  float gpre0 = 0.f, gpre1 = 0.f;
#define GDN_LOAD(CI)                                                                               \
  {                                                                                                \
    const int seg_ = (CI) < 16 ? 0 : 1;                                                            \
    const int ch_ = seg_ ? (CI)-16 : (CI);                                                         \
    const int Ls_ = seg_ ? 2048 : 256;                                                             \
    const int rb_ = seg_ ? b * 2048 : NLAT + b * 256;                                              \
    const int sidx_ = ch_ * 16 + stt;                                                              \
    const int t_ = d == 0 ? sidx_ : Ls_ - 1 - sidx_;                                               \
    const u16* prow_ = P + (size_t)(rb_ + t_) * PS1 + DNO;                                         \
    _Pragma("unroll") for (int g = 0; g < 3; ++g) {                                                \
      const int col_ = g * 512 + h * 128 + spart * 8;                                              \
      _Pragma("unroll") for (int tap = 0; tap < 3; ++tap) {                                        \
        const int tt_ = t_ + tap - 1;                                                              \
        if (tt_ >= 0 && tt_ < Ls_) pre[g][tap] = *(const uint4*)(prow_ + (ptrdiff_t)(tap - 1) * PS1 + col_); \
        else pre[g][tap] = make_uint4(0u, 0u, 0u, 0u);                                             \
      }                                                                                            \
    }                                                                                              \
    if (wave == 0) {                                                                               \
      const int s2_ = ch_ * 16 + fr;                                                               \
      const int t2_ = d == 0 ? s2_ : Ls_ - 1 - s2_;                                                \
      const u16* gr_ = P + (size_t)(rb_ + t2_) * PS1 + DNO + 2048;                                 \
      gpre0 = bf2f(gr_[d * 4 + h]);                                                                \
      gpre1 = bf2f(gr_[8 + d * 4 + h]);                                                            \
    }                                                                                              \
  }
  {
    const int tid = tid0, lane = tid & 63, wave = tid >> 6, fr = lane & 15, stt = tid >> 4, spart = tid & 15;
    GDN_LOAD(0)
  }
  for (int cidx = 0; cidx < 144; ++cidx) {
    asm volatile("" ::: "memory");
    int tid = tid0;
    asm volatile("" : "+v"(tid));
    const int lane = tid & 63, wave = tid >> 6, fr = lane & 15, fq = lane >> 4, stt = tid >> 4, spart = tid & 15;
    char* buf = smem;
    u16* Kb = (u16*)buf;
    u16* Qb = Kb + 16 * 136;
    float* Vf = (float*)(buf + 8704);
    u16* KdT = (u16*)(buf + 17152);
    u16* Tinv = (u16*)(buf + 21248);
    u16* Pm = (u16*)(buf + 21760);
    float* Amat = (float*)(buf + 22272);
    float* Gs = (float*)(buf + 23296);
    float* Bs = Gs + 16;
#pragma unroll
    for (int g = 0; g < 3; ++g) {
      __builtin_amdgcn_sched_barrier(0);
      const int col = g * 512 + h * 128 + spart * 8;
      float z[8];
#pragma unroll
      for (int j = 0; j < 8; ++j) z[j] = 0.f;
#pragma unroll
      for (int tap = 0; tap < 3; ++tap) {
        __builtin_amdgcn_sched_barrier(0);
        float f[8];
        unpack8(pre[g][tap], f);
        const float* w = p.dn_conv + tap * 1536 + col;
        float4 w0 = *(const float4*)w, w1 = *(const float4*)(w + 4);
        z[0] += f[0] * w0.x; z[1] += f[1] * w0.y; z[2] += f[2] * w0.z; z[3] += f[3] * w0.w;
        z[4] += f[4] * w1.x; z[5] += f[5] * w1.y; z[6] += f[6] * w1.z; z[7] += f[7] * w1.w;
      }
      float ss = 0.f;
#pragma unroll
      for (int j = 0; j < 8; ++j) { z[j] = silu(z[j]); ss += z[j] * z[j]; }
      if (g < 2) {
        ss += __shfl_xor(ss, 1, 64); ss += __shfl_xor(ss, 2, 64); ss += __shfl_xor(ss, 4, 64); ss += __shfl_xor(ss, 8, 64);
        float sc = rsqrtf(ss + 1e-6f);
        if (g == 0) sc *= 0.08838834764831845f;
#pragma unroll
        for (int j = 0; j < 8; ++j) z[j] *= sc;
        *(uint4*)((g == 0 ? Qb : Kb) + stt * 136 + spart * 8) = pack8(z);
      } else {
        float* dst = Vf + stt * 132 + spart * 8;
        *(float4*)dst = make_float4(z[0], z[1], z[2], z[3]);
        *(float4*)(dst + 4) = make_float4(z[4], z[5], z[6], z[7]);
      }
    }
    if (wave == 0) {
      float g = negA * softplus(gpre0 + dtb);
#pragma unroll
      for (int o = 1; o < 16; o <<= 1) { float n = __shfl_up(g, o, 16); if (fr >= o) g += n; }
      if (lane < 16) { Gs[lane] = g; Bs[lane] = sigm(gpre1); }
    }
    HSYNC();
    if (wave == 0) {
      f32x4 kk = (f32x4){0.f, 0.f, 0.f, 0.f};
#pragma unroll
      for (int ks = 0; ks < 4; ++ks) {
        bf16x8 kf = *(const bf16x8*)(Kb + fr * 136 + ks * 32 + fq * 8);
        kk = __builtin_amdgcn_mfma_f32_16x16x32_bf16(kf, kf, kk, 0, 0, 0);
      }
      const float Gj = Gs[fr];
#pragma unroll
      for (int e = 0; e < 4; ++e) {
        const int i = fq * 4 + e;
        const float a = (fr < i) ? Bs[i] * kk[e] * __expf(Gs[i] - Gj) : 0.f;
        Amat[i * 16 + fr] = a;
      }
      lds_wave_sync();
      if (lane < 16) {
        float x[16];
        x[0] = (lane == 0) ? 1.f : 0.f;
        float4 cur[4], nxt[4];
        cur[0] = *(const float4*)(Amat + 16);
        cur[1] = cur[0]; cur[2] = cur[0]; cur[3] = cur[0];
#pragma unroll
        for (int i = 1; i < 16; ++i) {
          __builtin_amdgcn_sched_barrier(0);
          if (i + 1 < 16) {
#pragma unroll
            for (int q = 0; q < (i + 4) / 4; ++q) nxt[q] = *(const float4*)(Amat + (i + 1) * 16 + q * 4);
          }
          float acc = (i == lane) ? 1.f : 0.f;
#pragma unroll
          for (int j = 0; j < i; ++j) {
            const float4 rv = cur[j >> 2];
            const float av = (j & 3) == 0 ? rv.x : ((j & 3) == 1 ? rv.y : ((j & 3) == 2 ? rv.z : rv.w));
            acc -= av * x[j];
          }
          x[i] = acc;
#pragma unroll
          for (int q = 0; q < 4; ++q) cur[q] = nxt[q];
        }
#pragma unroll
        for (int i = 0; i < 16; ++i) Tinv[i * 16 + lane] = f2bf(x[i]);
      }
    } else if (wave == 1) {
      f32x4 qk = (f32x4){0.f, 0.f, 0.f, 0.f};
#pragma unroll
      for (int ks = 0; ks < 4; ++ks) {
        bf16x8 qf = *(const bf16x8*)(Qb + fr * 136 + ks * 32 + fq * 8);
        bf16x8 kf = *(const bf16x8*)(Kb + fr * 136 + ks * 32 + fq * 8);
        qk = __builtin_amdgcn_mfma_f32_16x16x32_bf16(qf, kf, qk, 0, 0, 0);
      }
      const float Gj = Gs[fr];
#pragma unroll
      for (int e = 0; e < 4; ++e) {
        const int t = fq * 4 + e;
        const float v = (fr <= t) ? qk[e] * __expf(Gs[t] - Gj) : 0.f;
        Pm[t * 16 + fr] = f2bf(v);
      }
    } else {
      const int k = tid - 128;
      const float GC = Gs[15];
      unsigned w[8];
#pragma unroll
      for (int j = 0; j < 8; ++j) {
        __builtin_amdgcn_sched_barrier(0);
        float v0 = bf2f(Kb[(2 * j) * 136 + k]) * __expf(GC - Gs[2 * j]);
        float v1 = bf2f(Kb[(2 * j + 1) * 136 + k]) * __expf(GC - Gs[2 * j + 1]);
        w[j] = pack2(v0, v1);
      }
      *(uint4*)(KdT + k * 16) = make_uint4(w[0], w[1], w[2], w[3]);
      *(uint4*)(KdT + k * 16 + 8) = make_uint4(w[4], w[5], w[6], w[7]);
    }
    __builtin_amdgcn_sched_barrier(0);
    f32x4 ksv[2], qsv[2];
#pragma unroll
    for (int nt = 0; nt < 2; ++nt) { ksv[nt] = (f32x4){0.f, 0.f, 0.f, 0.f}; qsv[nt] = (f32x4){0.f, 0.f, 0.f, 0.f}; }
#pragma unroll
    for (int x = 0; x < 4; ++x) {
      __builtin_amdgcn_sched_barrier(0);
      uint2 k0 = *(const uint2*)(Kb + fr * 136 + 32 * x + fq * 4);
      uint2 k1 = *(const uint2*)(Kb + fr * 136 + 32 * x + 16 + fq * 4);
      uint2 q0 = *(const uint2*)(Qb + fr * 136 + 32 * x + fq * 4);
      uint2 q1 = *(const uint2*)(Qb + fr * 136 + 32 * x + 16 + fq * 4);
      uint4 kw = make_uint4(k0.x, k0.y, k1.x, k1.y);
      uint4 qw = make_uint4(q0.x, q0.y, q1.x, q1.y);
#pragma unroll
      for (int nt = 0; nt < 2; ++nt) {
        uint4 sw;
        sw.x = pack2(S[2 * x][nt][0], S[2 * x][nt][1]); sw.y = pack2(S[2 * x][nt][2], S[2 * x][nt][3]);
        sw.z = pack2(S[2 * x + 1][nt][0], S[2 * x + 1][nt][1]); sw.w = pack2(S[2 * x + 1][nt][2], S[2 * x + 1][nt][3]);
        ksv[nt] = __builtin_amdgcn_mfma_f32_16x16x32_bf16(*(bf16x8*)&kw, *(bf16x8*)&sw, ksv[nt], 0, 0, 0);
        qsv[nt] = __builtin_amdgcn_mfma_f32_16x16x32_bf16(*(bf16x8*)&qw, *(bf16x8*)&sw, qsv[nt], 0, 0, 0);
      }
    }
    HSYNC();
    if (cidx + 1 < 144) GDN_LOAD(cidx + 1)
    __builtin_amdgcn_sched_barrier(0);
    {
      const int seg = cidx < 16 ? 0 : 1;
      const int ch = seg ? cidx - 16 : cidx;
      float eG[4], bt[4];
#pragma unroll
      for (int e = 0; e < 4; ++e) { eG[e] = __expf(Gs[fq * 4 + e]); bt[e] = Bs[fq * 4 + e]; }
      const float eGC = __expf(Gs[15]);
      uint2 tv = *(const uint2*)(Tinv + fr * 16 + fq * 4);
      uint2 pv = *(const uint2*)(Pm + fr * 16 + fq * 4);
      uint4 tw = make_uint4(tv.x, tv.y, 0u, 0u);
      uint4 pw = make_uint4(pv.x, pv.y, 0u, 0u);
      uint4 ub[2];
#pragma unroll
      for (int nt = 0; nt < 2; ++nt) {
        const int vc = wave * 32 + nt * 16 + fr;
        float rhs[4];
#pragma unroll
        for (int e = 0; e < 4; ++e) rhs[e] = bt[e] * (Vf[(fq * 4 + e) * 132 + vc] - eG[e] * ksv[nt][e]);
        uint4 rw = make_uint4(pack2(rhs[0], rhs[1]), pack2(rhs[2], rhs[3]), 0u, 0u);
        f32x4 u = __builtin_amdgcn_mfma_f32_16x16x32_bf16(*(bf16x8*)&tw, *(bf16x8*)&rw, (f32x4){0.f, 0.f, 0.f, 0.f}, 0, 0, 0);
        ub[nt] = make_uint4(pack2(u[0], u[1]), pack2(u[2], u[3]), 0u, 0u);
        f32x4 oa;
#pragma unroll
        for (int e = 0; e < 4; ++e) oa[e] = eG[e] * qsv[nt][e];
        oa = __builtin_amdgcn_mfma_f32_16x16x32_bf16(*(bf16x8*)&pw, *(bf16x8*)&ub[nt], oa, 0, 0, 0);
        if (seg == 1) {
#pragma unroll
          for (int e = 0; e < 4; ++e) {
            const int sidx = ch * 16 + fq * 4 + e;
            const int t = d == 0 ? sidx : 2047 - sidx;
            O4[((size_t)(2 + d) * NLAT + b * 2048 + t) * 512 + h * 128 + vc] = f2bf(oa[e]);
          }
        }
      }
#pragma unroll
      for (int mt = 0; mt < 8; ++mt) {
        __builtin_amdgcn_sched_barrier(0);
        uint2 kv = *(const uint2*)(KdT + (mt * 16 + fr) * 16 + fq * 4);
        uint4 kw = make_uint4(kv.x, kv.y, 0u, 0u);
#pragma unroll
        for (int nt = 0; nt < 2; ++nt) {
#pragma unroll
          for (int e = 0; e < 4; ++e) S[mt][nt][e] *= eGC;
          S[mt][nt] = __builtin_amdgcn_mfma_f32_16x16x32_bf16(*(bf16x8*)&kw, *(bf16x8*)&ub[nt], S[mt][nt], 0, 0, 0);
        }
      }
    }
    HSYNC();
  }
#undef GDN_LOAD
}

DEV void phase_scans(const Params& p, char* smem) {
#pragma unroll 1
  for (int it = VBID; it < 512; it += VNB)
    if (it & 1) rwkv_item(p, it >> 1, smem);
  __builtin_amdgcn_sched_barrier(0);
#pragma unroll 1
  for (int it = VBID; it < 512; it += VNB)
    if (!(it & 1)) gdn_item(p, it >> 1, smem);
}

DEV void mixout_item(const Params& p, int it, char* smem) {
  const u16* P = (const u16*)(p.ws + OFF_BIG);
  const u16* O4 = (const u16*)p.out;
  const float* BS = (const float*)(p.ws + OFF_BSUM);
  const u16* G2T = (const u16*)(p.ws + OFF_G2T);
  u16* Y = (u16*)(p.ws + OFF_HY);
  u16* sg = (u16*)smem;
  u16* G = sg + 32 * 136;
  const int tid = VTID, lane = tid & 63, wave = tid >> 6;
  const int fr = lane & 15, fq = lane >> 4;
  const int tok0 = it * 32, tl0 = tok0 & 2047;
  const int tk = tid >> 3, part = tid & 7;
  const int row = tok0 + tk, t = tl0 + tk;
  const bool hasp = t > 0, hasn = t + 1 < 2048;
  const u16* prow = P + (size_t)row * PS1;
  {
#pragma unroll
    for (int q = 0; q < 2; ++q) {
      const int col = 1792 + part * 16 + q * 8;
      float pc[8], pp[8], pn[8], v[8];
      unpack8(*(const uint4*)(prow + col), pc);
      if (hasp) unpack8(*(const uint4*)(prow - PS1 + col), pp);
      else {
#pragma unroll
        for (int j = 0; j < 8; ++j) pp[j] = 0.f;
      }
      if (hasn) unpack8(*(const uint4*)(prow + PS1 + col), pn);
      else {
#pragma unroll
        for (int j = 0; j < 8; ++j) pn[j] = 0.f;
      }
      const float* mu = p.rw_mu + col;
#pragma unroll
      for (int j = 0; j < 8; ++j) v[j] = sigm(pc[j] + mu[j] * (0.5f * (pp[j] + pn[j]) - pc[j]));
      *(uint4*)(sg + tk * 136 + part * 16 + q * 8) = pack8(v);
    }
  }
  HSYNC();
  {
    bf16x8 af[2][4];
#pragma unroll
    for (int mt = 0; mt < 2; ++mt)
#pragma unroll
      for (int ks = 0; ks < 4; ++ks) af[mt][ks] = *(const bf16x8*)(sg + (mt * 16 + fr) * 136 + ks * 32 + fq * 8);
#pragma unroll
    for (int nt = 0; nt < 8; ++nt) {
      const u16* bp = G2T + (size_t)(wave * 128 + nt * 16 + fr) * 128 + fq * 8;
      bf16x8 bf0 = *(const bf16x8*)(bp), bf1 = *(const bf16x8*)(bp + 32), bf2 = *(const bf16x8*)(bp + 64), bf3 = *(const bf16x8*)(bp + 96);
#pragma unroll
      for (int mt = 0; mt < 2; ++mt) {
        f32x4 a = (f32x4){0.f, 0.f, 0.f, 0.f};
        a = __builtin_amdgcn_mfma_f32_16x16x32_bf16(af[mt][0], bf0, a, 0, 0, 0);
        a = __builtin_amdgcn_mfma_f32_16x16x32_bf16(af[mt][1], bf1, a, 0, 0, 0);
        a = __builtin_amdgcn_mfma_f32_16x16x32_bf16(af[mt][2], bf2, a, 0, 0, 0);
        a = __builtin_amdgcn_mfma_f32_16x16x32_bf16(af[mt][3], bf3, a, 0, 0, 0);
#pragma unroll
        for (int e = 0; e < 4; ++e) G[(mt * 16 + fq * 4 + e) * 520 + wave * 128 + nt * 16 + fr] = f2bf(a[e]);
      }
    }
  }
  HSYNC();
  {
    const int hd = part, c0 = hd * 64;
    const u16* of = O4 + (size_t)row * 512 + c0;
    const u16* ob = O4 + ((size_t)NLAT + row) * 512 + c0;
    const float bsum = BS[(size_t)row * 16 + hd * 2] + BS[(size_t)row * 16 + hd * 2 + 1];
    float s1 = 0.f, s2 = 0.f;
#pragma unroll
    for (int q = 0; q < 8; ++q) {
      float a[8], b8[8];
      unpack8(*(const uint4*)(of + q * 8), a);
      unpack8(*(const uint4*)(ob + q * 8), b8);
#pragma unroll
      for (int j = 0; j < 8; ++j) { const float v = a[j] + b8[j]; s1 += v; s2 += v * v; }
    }
    const float mean = s1 * (1.f / 64.f);
    const float var = fmaxf(s2 * (1.f / 64.f) - mean * mean, 0.f);
    const float rs = rsqrtf(var + 64e-5f);
#pragma unroll
    for (int q = 0; q < 8; ++q) {
      const int c = c0 + q * 8;
      float pc[8], pp[8], pn[8], gv[8], o[8], ya[8], yb[8];
      unpack8(*(const uint4*)(of + q * 8), ya);
      unpack8(*(const uint4*)(ob + q * 8), yb);
      unpack8(*(const uint4*)(prow + 1024 + c), pc);
      if (hasp) unpack8(*(const uint4*)(prow - PS1 + 1024 + c), pp);
      else {
#pragma unroll
        for (int j = 0; j < 8; ++j) pp[j] = 0.f;
      }
      if (hasn) unpack8(*(const uint4*)(prow + PS1 + 1024 + c), pn);
      else {
#pragma unroll
        for (int j = 0; j < 8; ++j) pn[j] = 0.f;
      }
      unpack8(*(const uint4*)(G + tk * 520 + c), gv);
      const float* mu = p.rw_mu + 1024 + c;
      const float* gg = p.rw_lnx_g + c;
      const float* gb = p.rw_lnx_b + c;
#pragma unroll
      for (int j = 0; j < 8; ++j) {
        const float vsh = pc[j] + mu[j] * (0.5f * (pp[j] + pn[j]) - pc[j]);
        const float yn = (ya[j] + yb[j] - mean) * rs * gg[j] + gb[j];
        o[j] = (yn + bsum * vsh) * gv[j];
      }
      *(uint4*)(Y + (size_t)row * 1024 + c) = pack8(o);
    }
  }
  {
    const int c0 = part * 64;
    const u16* of = O4 + ((size_t)2 * NLAT + row) * 512 + c0;
    const u16* ob = O4 + ((size_t)3 * NLAT + row) * 512 + c0;
    float s2 = 0.f;
#pragma unroll
    for (int q = 0; q < 8; ++q) {
      float a[8], b8[8];
      unpack8(*(const uint4*)(of + q * 8), a);
      unpack8(*(const uint4*)(ob + q * 8), b8);
#pragma unroll
      for (int j = 0; j < 8; ++j) { const float v = a[j] + b8[j]; s2 += v * v; }
    }
    s2 += __shfl_xor(s2, 1, 64);
    const float rs = rsqrtf(s2 * (1.f / 128.f) + 1e-6f);
    const u16* zr = prow + DNO + 1536 + c0;
    const float* ng = p.dn_norm_g + (part & 1) * 64;
#pragma unroll
    for (int q = 0; q < 8; ++q) {
      float z[8], r8[8], a[8], b8[8];
      unpack8(*(const uint4*)(of + q * 8), a);
      unpack8(*(const uint4*)(ob + q * 8), b8);
      unpack8(*(const uint4*)(zr + q * 8), z);
#pragma unroll
      for (int j = 0; j < 8; ++j) r8[j] = (a[j] + b8[j]) * rs * ng[q * 8 + j] * silu(z[j]);
      *(uint4*)(Y + (size_t)row * 1024 + 512 + c0 + q * 8) = pack8(r8);
    }
  }
  HSYNC();
}

#define XB_TMO      128
#define XB_XCNT(j)  (256  + 64 * (j))
#define XB_XSUB(j)  (1280 + 64 * (j))
#define XB_XGEN(j)  (2304 + 64 * (j))
#define XB_TOP      3328
#define XB_TOPGEN   3392
#define XCD_BAR_WORDS 3456
#define XB_SPIN_CAP (1u << 20)
DEV unsigned xb_ld(unsigned* p) { return __hip_atomic_load(p, __ATOMIC_RELAXED, __HIP_MEMORY_SCOPE_AGENT); }
DEV unsigned xb_add(unsigned* p, unsigned v) { return __hip_atomic_fetch_add(p, v, __ATOMIC_RELAXED, __HIP_MEMORY_SCOPE_AGENT); }
DEV unsigned xb_xcc_id() { return (unsigned)__builtin_amdgcn_s_getreg((3 << 11) | 20) & 0xFu; }
#define XB_SPIN(cond, bar) do { unsigned _sp = 0; while (cond) { __builtin_amdgcn_s_sleep(1); \
    if ((++_sp & 255u) == 0u) { if (xb_ld(&(bar)[XB_TMO])) break; if (_sp > XB_SPIN_CAP) { atomicAdd(&(bar)[XB_TMO], 1u); break; } } } } while (0)
DEV void xcd_barrier_complete(unsigned* bar, unsigned x, unsigned& nloc, unsigned& nx) {
  const unsigned G = gridDim.x;
  unsigned sum, cnt, mine, sp = 0u;
  for (;;) {
    sum = 0u; cnt = 0u; mine = 0u;
#pragma unroll
    for (unsigned j = 0; j < 16; ++j) { const unsigned c = xb_ld(&bar[XB_XCNT(j)]); sum += c; cnt += (c > 0u) ? 1u : 0u; mine = (j == x) ? c : mine; }
    if (sum == G) break;
    __builtin_amdgcn_s_sleep(1);
    if ((++sp & 255u) == 0u) { if (xb_ld(&bar[XB_TMO])) break; if (sp > XB_SPIN_CAP) { atomicAdd(&bar[XB_TMO], 1u); break; } }
  }
  nloc = mine > 0u ? mine : 1u; nx = cnt > 0u ? cnt : 1u;
}
DEV void xcd_barrier(unsigned* bar) {
  asm volatile("s_waitcnt vmcnt(0)" ::: "memory");
  __syncthreads();
  if (threadIdx.x == 0) {
    __builtin_amdgcn_s_waitcnt(0);
    const unsigned x = xb_xcc_id();
    volatile LAS unsigned* st = (volatile LAS unsigned*)(dyn_smem + HS_OFF + 128);
    unsigned nloc = st[0], nx = st[1];
    if (nloc == 0u) { xcd_barrier_complete(bar, x, nloc, nx); st[0] = nloc; st[1] = nx; }
    const unsigned old = xb_add(&bar[XB_XSUB(x)], 1u);
    const unsigned gen = old / nloc;
    if (old + 1u == (gen + 1u) * nloc) {
      __builtin_amdgcn_fence(__ATOMIC_RELEASE, "agent");
      asm volatile("s_waitcnt vmcnt(0)" ::: "memory");
      const unsigned og = xb_add(&bar[XB_TOP], 1u);
      const unsigned tg = og / nx;
      if (og + 1u == (tg + 1u) * nx) xb_add(&bar[XB_TOPGEN], 1u);
      else XB_SPIN(xb_ld(&bar[XB_TOPGEN]) == tg, bar);
      __builtin_amdgcn_fence(__ATOMIC_ACQUIRE, "agent");
      xb_add(&bar[XB_XGEN(x)], 1u);
      asm volatile("s_waitcnt vmcnt(0)" ::: "memory");
    } else {
      XB_SPIN(xb_ld(&bar[XB_XGEN(x)]) == gen, bar);
      __builtin_amdgcn_fence(__ATOMIC_ACQUIRE, "agent");
      asm volatile("s_waitcnt vmcnt(0)" ::: "memory");
    }
  }
  __syncthreads();
}

constexpr int NPHASE = 18;

__global__ void __launch_bounds__(512, 2) mega(Params p, int ph_lo, int ph_hi) {
  char* smem = dyn_smem + VHALF * HALF_LDS;
  if ((threadIdx.x & 255) == 0) *((LAS unsigned*)(dyn_smem + HS_OFF) + (threadIdx.x >> 8) * 16) = 0u;
  __syncthreads();
  cg::grid_group grid = cg::this_grid();
  const float* mv0 = (const float*)(p.ws + OFF_MODV);
  const float* mv1 = mv0 + 33 * 6144;
  u16* X = (u16*)(p.ws + OFF_X);
  u16* HY = (u16*)(p.ws + OFF_HY);
  u16* BIG = (u16*)(p.ws + OFF_BIG);
  unsigned* bar = (unsigned*)(p.ws + OFF_BAR);
  if (threadIdx.x == 0) {
    volatile LAS unsigned* st = (volatile LAS unsigned*)(dyn_smem + HS_OFF + 128);
    st[0] = 0u; st[1] = 0u;
    (void)xb_add(&bar[XB_XCNT(xb_xcc_id())], 1u);
  }
  if (ph_hi < 0) grid.sync();
#define PHASE(n, BODY) if (ph_lo <= (n) && (n) < ph_hi) { BODY; if ((n) + 1 < ph_hi) xcd_barrier(bar); }
  PHASE(0, phase_prep(p, smem))
  PHASE(1, phase_init(p))
  PHASE(2, gemm_phase<0>(HY, 1024, (const u16*)(p.ws + OFF_WIN0), 1024, NTOK, 2304, BIG, PS0, nullptr, dyn_smem))
  PHASE(3, phase_hyprep_rope(p, smem))
  PHASE(4, phase_conv_attn(p, smem))
  PHASE(5, gemm_phase<2>(HY, 1024, (const u16*)(p.ws + OFF_WOUT0), 1024, NTOK, 1024, X, 1024, mv0 + 2 * 1024, dyn_smem))
  PHASE(6, ln_phase<false>(p, NTOK, p.ln_g, p.ln_b, mv0, 3, 4))
  PHASE(7, gemm_phase<1>(HY, 1024, (const u16*)(p.ws + OFF_W1_0), 1024, NTOK, 4096, BIG, 4096, nullptr, dyn_smem))
  PHASE(8, gemm_phase<2>(BIG, 4096, (const u16*)(p.ws + OFF_W2_0), 4096, NTOK, 1024, X, 1024, mv0 + 5 * 1024, dyn_smem))
  PHASE(9, ln_phase<false>(p, NTOK, p.ln_g + 1024, p.ln_b + 1024, mv1, 0, 1))
  PHASE(10, gemm_phase<0>(HY, 1024, (const u16*)(p.ws + OFF_WIN1), 1024, NTOK, 4096, BIG, PS1, nullptr, dyn_smem))
  PHASE(11, phase_scans(p, smem))
  PHASE(12, for (int it = VBID; it < 2048; it += VNB) mixout_item(p, it, smem))
  PHASE(13, gemm_phase<2>(HY, 1024, (const u16*)(p.ws + OFF_WOUT1), 1024, NLAT, 1024, X, 1024, mv1 + 2 * 1024, dyn_smem))
  PHASE(14, ln_phase<false>(p, NLAT, p.ln_g + 2048, p.ln_b + 2048, mv1, 3, 4))
  PHASE(15, gemm_phase<1>(HY, 1024, (const u16*)(p.ws + OFF_W1_1), 1024, NLAT, 4096, BIG, 4096, nullptr, dyn_smem))
  PHASE(16, gemm_phase<2>(BIG, 4096, (const u16*)(p.ws + OFF_W2_1), 4096, NLAT, 1024, X, 1024, mv1 + 5 * 1024, dyn_smem))
  PHASE(17, ln_phase<true>(p, NLAT, p.ln_g + 3072, p.ln_b + 3072, mv1, 0, 1))
}

extern "C" void kernel_launch(void* const* d_in, const int* in_sizes, int n_in, void* d_out, int out_size, void* d_ws,
                              size_t ws_size, hipStream_t stream) {
  static int grid_blocks = 0;
  if (!grid_blocks) {
    int dev = 0, cus = 0, per_cu = 0;
    hipGetDevice(&dev);
    hipDeviceGetAttribute(&cus, hipDeviceAttributeMultiprocessorCount, dev);
    hipFuncSetAttribute((const void*)mega, hipFuncAttributeMaxDynamicSharedMemorySize, LDS_BYTES);
    hipOccupancyMaxActiveBlocksPerMultiprocessor(&per_cu, mega, 512, LDS_BYTES);
    if (per_cu > 1) per_cu = 1;
    if (per_cu < 1) per_cu = 1;
    grid_blocks = cus * per_cu;
  }
  if (ws_size < WS_NEED) fprintf(stderr, "workspace too small: %zu < %zu\n", ws_size, (size_t)WS_NEED);
  Params p{};
  const float** pp = (const float**)&p;
  for (int i = 0; i < 39; ++i) pp[i] = (const float*)d_in[i];
  p.out = (float*)d_out;
  p.ws = (char*)d_ws;
  int lo = 0, hi = NPHASE;
  void* args[] = {&p, &lo, &hi};
  hipMemsetAsync((char*)d_ws + OFF_BAR, 0, XCD_BAR_WORDS * sizeof(unsigned), stream);
  hipError_t e = hipLaunchCooperativeKernel((void*)mega, dim3(grid_blocks), dim3(512), args, LDS_BYTES, stream);
  if (e != hipSuccess) fprintf(stderr, "cooperative launch failed: %s (grid %d)\n", hipGetErrorString(e), grid_blocks);
}
```

```cpp
#include <hip/hip_runtime.h>
#include <hip/hip_cooperative_groups.h>
#include <cstdio>
#include <cstdint>
namespace cg = cooperative_groups;

typedef unsigned short u16;
typedef __attribute__((ext_vector_type(8))) short bf16x8;
typedef __attribute__((ext_vector_type(4))) float f32x4;
typedef __attribute__((ext_vector_type(16))) float f32x16;

#define DEV __device__ __forceinline__

constexpr int NLAT = 65536, NCTX = 8192, NTOK = 73728;
constexpr int PS0 = 2304;
constexpr int PS1 = 4096;
constexpr int DNO = 1920;
constexpr float ALPHA = 1.4142135623730951f;

constexpr size_t OFF_WIN0 = 0;
constexpr size_t OFF_WOUT0 = OFF_WIN0 + (size_t)2304 * 1024 * 2;
constexpr size_t OFF_W1_0 = OFF_WOUT0 + (size_t)1024 * 1024 * 2;
constexpr size_t OFF_W1_1 = OFF_W1_0 + (size_t)4096 * 1024 * 2;
constexpr size_t OFF_W2_0 = OFF_W1_1 + (size_t)4096 * 1024 * 2;
constexpr size_t OFF_W2_1 = OFF_W2_0 + (size_t)4096 * 1024 * 2;
constexpr size_t OFF_WIN1 = OFF_W2_1 + (size_t)4096 * 1024 * 2;
constexpr size_t OFF_WOUT1 = OFF_WIN1 + (size_t)4096 * 1024 * 2;
constexpr size_t OFF_MODV = OFF_WOUT1 + (size_t)1024 * 1024 * 2;
constexpr size_t OFF_KR2048 = OFF_MODV + (size_t)2 * 33 * 6144 * 4;
constexpr size_t OFF_KR256 = OFF_KR2048 + (size_t)512 * 4096 * 2;
constexpr size_t OFF_ROPE = OFF_KR256 + (size_t)512 * 512 * 2;
constexpr size_t OFF_BSUM = OFF_ROPE + 8192;
constexpr size_t OFF_G2T = OFF_BSUM + (size_t)65536 * 16 * 4;
constexpr size_t OFF_BAR = OFF_G2T + (size_t)512 * 128 * 2;
constexpr size_t OFF_X = (size_t)64 << 20;
constexpr size_t OFF_HY = OFF_X + (size_t)NTOK * 1024 * 2;
constexpr size_t OFF_BIG = OFF_HY + (size_t)NTOK * 1024 * 2;
constexpr size_t WS_NEED = OFF_BIG + (size_t)NTOK * 4096 * 2;
static_assert(OFF_BAR + 16384 <= OFF_X, "ws map");
constexpr size_t SO_U = 0;
constexpr size_t SO_X0 = SO_U + (size_t)512 * 32 * 2048 * 2;
constexpr size_t SO_UC = SO_X0 + (size_t)512 * 32 * 2048 * 2;
constexpr size_t SO_X0C = SO_UC + (size_t)512 * 32 * 256 * 2;

struct Params {
  const float *x, *c, *ctx, *c_ctx, *mod_w, *mod_b, *ln_g, *ln_b, *mlp_w1, *mlp_w2, *e_w_in, *e_w_out, *hy_conv,
      *hy_w1, *hy_b1, *hy_w2, *hy_b2, *hy_freq, *hy_w3, *hy_decay, *hy_bias, *attn_sink, *o_w_in, *o_w_out,
      *rw_mu, *rw_w0, *rw_w2, *rw_a0, *rw_a2, *rw_g2, *rw_kk, *rw_ka, *rw_rk, *rw_lnx_g, *rw_lnx_b,
      *dn_conv, *dn_A_log, *dn_dt_bias, *dn_norm_g;
  float* out;
  char* ws;
};

typedef float f32x2_t __attribute__((ext_vector_type(2)));
typedef __bf16 bf16x2_t __attribute__((ext_vector_type(2)));
DEV u16 f2bf(float f) { return __builtin_bit_cast(u16, (__bf16)f); }
DEV float bf2f(u16 h) { return __uint_as_float(((unsigned)h) << 16); }
DEV float bflo(unsigned u) { return __uint_as_float(u << 16); }
DEV float bfhi(unsigned u) { return __uint_as_float(u & 0xffff0000u); }
DEV unsigned pack2(float a, float b) { f32x2_t v = {a, b}; return __builtin_bit_cast(unsigned, __builtin_convertvector(v, bf16x2_t)); }
DEV void unpack8(const uint4& v, float* f) {
  f[0] = bflo(v.x); f[1] = bfhi(v.x); f[2] = bflo(v.y); f[3] = bfhi(v.y);
  f[4] = bflo(v.z); f[5] = bfhi(v.z); f[6] = bflo(v.w); f[7] = bfhi(v.w);
}
DEV uint4 pack8(const float* f) {
  uint4 v; v.x = pack2(f[0], f[1]); v.y = pack2(f[2], f[3]); v.z = pack2(f[4], f[5]); v.w = pack2(f[6], f[7]); return v;
}
DEV int modrow(int r) { return r < NLAT ? (r >> 11) : 32; }
DEV float sigm(float x) { return __builtin_amdgcn_rcpf(1.f + __expf(-x)); }
DEV float silu(float x) { return x * __builtin_amdgcn_rcpf(1.f + __expf(-x)); }
DEV float softplus(float x) { return fmaxf(x, 0.f) + __logf(1.f + __expf(-fabsf(x))); }
DEV float fast_tanh(float x) { return 1.f - 2.f * __builtin_amdgcn_rcpf(1.f + __expf(2.f * x)); }
DEV float wave_sum(float v) {
#pragma unroll
  for (int o = 32; o > 0; o >>= 1) v += __shfl_xor(v, o, 64);
  return v;
}

extern __shared__ __attribute__((aligned(16))) char dyn_smem[];
#define LAS __attribute__((address_space(3)))
constexpr int HALF_LDS = 65536;
constexpr int HS_OFF = 2 * HALF_LDS + 2048;
constexpr int LDS_BYTES = HS_OFF + 256;
#define VTID ((int)(threadIdx.x & 255))
#define VHALF ((int)__builtin_amdgcn_readfirstlane((int)(threadIdx.x >> 8)))
#define VBID ((int)(blockIdx.x * 2 + VHALF))
#define VNB ((int)(gridDim.x * 2))
DEV void hsync() {
  LAS unsigned* cnt = (LAS unsigned*)(dyn_smem + HS_OFF) + VHALF * 16;
  asm volatile("s_waitcnt vmcnt(0) lgkmcnt(0)" ::: "memory");
  unsigned tgt = 0u;
  if ((threadIdx.x & 63) == 0) {
    const unsigned old = __hip_atomic_fetch_add(cnt, 1u, __ATOMIC_RELAXED, __HIP_MEMORY_SCOPE_WORKGROUP);
    tgt = (old & ~3u) + 4u;
  }
  tgt = __builtin_amdgcn_readfirstlane(tgt);
  while (__hip_atomic_load(cnt, __ATOMIC_RELAXED, __HIP_MEMORY_SCOPE_WORKGROUP) < tgt) __builtin_amdgcn_s_sleep(0);
  asm volatile("s_waitcnt lgkmcnt(0)" ::: "memory");
}
#define HSYNC() hsync()

DEV void transpose_tile(const float* __restrict__ src, int K, int N, int Npad, u16* __restrict__ dst, int tile,
                               u16* sm) {
  const int tid = VTID;
  const int ntn = Npad >> 6;
  const int tk = tile / ntn, tn = tile - tk * ntn;
  const int n = tid & 63, kq = tid >> 6;
  const int gn = tn * 64 + n;
#pragma unroll 4
  for (int i = 0; i < 16; ++i) {
    int k = kq + 4 * i;
    float v = (gn < N) ? src[(size_t)(tk * 64 + k) * N + gn] : 0.f;
    sm[n * 66 + k] = f2bf(v);
  }
  HSYNC();
  const int n2 = tid >> 2, q = tid & 3;
  const unsigned* s32 = (const unsigned*)sm + (n2 * 66 + q * 16) / 2;
  uint4 a, b;
  a.x = s32[0]; a.y = s32[1]; a.z = s32[2]; a.w = s32[3];
  b.x = s32[4]; b.y = s32[5]; b.z = s32[6]; b.w = s32[7];
  u16* d = dst + (size_t)(tn * 64 + n2) * K + tk * 64 + q * 16;
  *(uint4*)d = a;
  *(uint4*)(d + 8) = b;
  HSYNC();
}

DEV void modv_item(const Params& p, int it, float* sl) {
  const int tid = VTID;
  const int l = it / 288, rem = it % 288, cc = rem / 3, rg = rem % 3;
  for (int idx = tid; idx < 11 * 1024; idx += 256) {
    int r = rg * 11 + (idx >> 10), k = idx & 1023;
    float cv = (r < 32) ? p.c[r * 1024 + k] : p.c_ctx[k];
    sl[idx] = cv / (1.f + expf(-cv));
  }
  HSYNC();
  const int cl = tid & 63, kg = tid >> 6;
  const int col = cc * 64 + cl;
  float acc[11];
#pragma unroll
  for (int r = 0; r < 11; ++r) acc[r] = 0.f;
  const float* w = p.mod_w + (size_t)l * 1024 * 6144 + (size_t)(kg * 256) * 6144 + col;
#pragma unroll 8
  for (int k = 0; k < 256; ++k) {
    float wv = w[(size_t)k * 6144];
#pragma unroll
    for (int r = 0; r < 11; ++r) acc[r] += sl[r * 1024 + kg * 256 + k] * wv;
  }
  HSYNC();
  float* red = sl;
#pragma unroll
  for (int r = 0; r < 11; ++r) red[(kg * 11 + r) * 64 + cl] = acc[r];
  HSYNC();
  for (int idx = tid; idx < 11 * 64; idx += 256) {
    int r = idx >> 6, c2 = idx & 63;
    float v = red[(0 * 11 + r) * 64 + c2] + red[(1 * 11 + r) * 64 + c2] + red[(2 * 11 + r) * 64 + c2] + red[(3 * 11 + r) * 64 + c2];
    int gcol = cc * 64 + c2;
    ((float*)(p.ws + OFF_MODV))[(size_t)(l * 33 + rg * 11 + r) * 6144 + gcol] = v + p.mod_b[l * 6144 + gcol];
  }
  HSYNC();
}

DEV void filter_item(const Params& p, int it, float* sm) {
  const int L = it < 2048 ? 2048 : 256;
  const int t = it < 2048 ? it : it - 2048;
  u16* R = (u16*)(p.ws + (L == 2048 ? OFF_KR2048 : OFF_KR256));
  float* pe = sm; float* h1 = sm + 64; float* h2 = sm + 128;
  const int tid = VTID;
  const float tn = (float)t / (float)(L - 1);
  if (tid < 33) {
    float v;
    if (tid == 0) v = tn;
    else {
      int i = (tid - 1) & 15;
      double band = 1e-4 + (double)i * ((15.0 - 1e-4) / 15.0);
      double ang = 2.0 * 3.14159265358979323846 * (double)t * band / (double)L;
      v = (tid <= 16) ? (float)cos(ang) : (float)(-sin(ang));
    }
    pe[tid] = v;
  }
  HSYNC();
  if (tid < 64) {
    float acc = p.hy_b1[tid];
#pragma unroll 11
    for (int i = 0; i < 33; ++i) acc += pe[i] * p.hy_w1[i * 64 + tid];
    h1[tid] = sinf(p.hy_freq[tid] * acc);
  }
  HSYNC();
  if (tid < 64) {
    float acc = p.hy_b2[tid];
#pragma unroll 16
    for (int i = 0; i < 64; ++i) acc += h1[i] * p.hy_w2[i * 64 + tid];
    h2[tid] = sinf(p.hy_freq[tid] * acc);
  }
  HSYNC();
#pragma unroll 1
  for (int q = 0; q < 4; ++q) {
    int o = tid + 256 * q;
    float acc = 0.f;
#pragma unroll 16
    for (int i = 0; i < 64; ++i) acc += h2[i] * p.hy_w3[i * 1024 + o];
    float val = acc * expf(-tn * fabsf(p.hy_decay[o]));
    if (o < 512) {
      if (t == 0) val += p.hy_bias[o];
      R[(size_t)o * 2 * L + L - t] = f2bf(val);
    } else {
      int c = o - 512;
      if (t >= 1) R[(size_t)c * 2 * L + L + t] = f2bf(val);
      else R[(size_t)c * 2 * L] = 0;
    }
  }
  HSYNC();
}

DEV void phase_prep(const Params& p, char* smem) {
  constexpr int T_IN0 = 16 * 36, T_OUT = 16 * 16, T_W = 16 * 64;
  constexpr int E0 = T_IN0, E1 = E0 + T_OUT, E2 = E1 + T_W, E3 = E2 + T_W, E4 = E3 + T_W, E5 = E4 + T_W,
                E6 = E5 + T_W, E7 = E6 + T_OUT, E8 = E7 + 576, E9 = E8 + 2304, E10 = E9 + 1, E11 = E10 + 16;
  for (int it = VBID; it < E11; it += VNB) {
    if (it >= E10) transpose_tile(p.rw_g2, 128, 512, 512, (u16*)(p.ws + OFF_G2T), it - E10, (u16*)smem);
    else if (it < E0) transpose_tile(p.e_w_in, 1024, 2304, 2304, (u16*)(p.ws + OFF_WIN0), it, (u16*)smem);
    else if (it < E1) transpose_tile(p.e_w_out, 1024, 1024, 1024, (u16*)(p.ws + OFF_WOUT0), it - E0, (u16*)smem);
    else if (it < E2) transpose_tile(p.mlp_w1, 1024, 4096, 4096, (u16*)(p.ws + OFF_W1_0), it - E1, (u16*)smem);
    else if (it < E3) transpose_tile(p.mlp_w1 + (size_t)1024 * 4096, 1024, 4096, 4096, (u16*)(p.ws + OFF_W1_1), it - E2, (u16*)smem);
    else if (it < E4) transpose_tile(p.mlp_w2, 4096, 1024, 1024, (u16*)(p.ws + OFF_W2_0), it - E3, (u16*)smem);
    else if (it < E5) transpose_tile(p.mlp_w2 + (size_t)1024 * 4096, 4096, 1024, 1024, (u16*)(p.ws + OFF_W2_1), it - E4, (u16*)smem);
    else if (it < E6) transpose_tile(p.o_w_in, 1024, 3984, 4096, (u16*)(p.ws + OFF_WIN1), it - E5, (u16*)smem);
    else if (it < E7) transpose_tile(p.o_w_out, 1024, 1024, 1024, (u16*)(p.ws + OFF_WOUT1), it - E6, (u16*)smem);
    else if (it < E8) modv_item(p, it - E7, (float*)smem);
    else if (it < E9) filter_item(p, it - E8, (float*)smem);
    else {
      float2* tab = (float2*)(p.ws + OFF_ROPE);
      for (int q = 0; q < 4; ++q) {
        int e = VTID * 4 + q;
        int pos = e >> 4, i = e & 15;
        float inv = powf(10000.f, -(float)i / 16.f);
        float ang = (float)pos * inv;
        tab[e] = make_float2(cosf(ang), sinf(ang));
      }
    }
  }
}

DEV void phase_init(const Params& p) {
  const float* mv = (const float*)(p.ws + OFF_MODV);
  u16* X = (u16*)(p.ws + OFF_X);
  u16* HM = (u16*)(p.ws + OFF_HY);
  const size_t total = (size_t)NTOK * 128;
  for (size_t i = (size_t)VBID * 256 + VTID; i < total; i += (size_t)VNB * 256) {
    int r = (int)(i >> 7), c8 = (int)(i & 127) * 8;
    const float* src = r < NLAT ? p.x + (size_t)r * 1024 + c8 : p.ctx + (size_t)(r - NLAT) * 1024 + c8;
    float4 v0 = *(const float4*)src, v1 = *(const float4*)(src + 4);
    const float* m = mv + (size_t)modrow(r) * 6144 + c8;
    float4 h0 = *(const float4*)m, h1 = *(const float4*)(m + 4);
    float4 s0 = *(const float4*)(m + 1024), s1 = *(const float4*)(m + 1028);
    float f[8] = {v0.x, v0.y, v0.z, v0.w, v1.x, v1.y, v1.z, v1.w};
    float sh[8] = {h0.x, h0.y, h0.z, h0.w, h1.x, h1.y, h1.z, h1.w};
    float sc[8] = {s0.x, s0.y, s0.z, s0.w, s1.x, s1.y, s1.z, s1.w};
    float g[8];
#pragma unroll
    for (int j = 0; j < 8; ++j) g[j] = f[j] * (1.f + sc[j]) + sh[j];
    *(uint4*)(X + (size_t)r * 1024 + c8) = pack8(f);
    *(uint4*)(HM + (size_t)r * 1024 + c8) = pack8(g);
  }
}

template <int EPI>
DEV void gemm_phase(const u16* __restrict__ A, int lda, const u16* __restrict__ Bt, int K, int M, int N,
                    u16* __restrict__ C, int ldc, const float* __restrict__ gate, char* smem) {
  const int tid = threadIdx.x, lane = tid & 63, wave = tid >> 6;
  const int wm = wave >> 2, wn = wave & 3;
  const int fr = lane & 15, fq = lane >> 4;
  const int tn = N >> 8, tm = M >> 8, tiles = tm * tn;
  const int nk = K >> 6;
  const int drow = wave * 8 + (lane >> 3);
  const int dchunk = (lane & 7) ^ ((drow >> 1) & 7);
  const size_t lda64 = (size_t)lda * 64, ldb64 = (size_t)K * 64;
  const int sw = fr >> 1;
  const bool xcd_order = (gridDim.x & 7) == 0 && (tm & 31) == 0;
  const int mx = tm >> 3;
#define G_COORDS(IT, M0, N0)                                                   \
  {                                                                            \
    int tm_i, tn_i;                                                            \
    if (xcd_order) {                                                           \
      const int x = (IT) & 7, local = (IT) >> 3;                               \
      const int mg = local / (4 * tn), r = local - mg * 4 * tn;                \
      tn_i = r >> 2;                                                           \
      tm_i = x * mx + mg * 4 + (r & 3);                                        \
    } else { tm_i = (IT) / tn; tn_i = (IT) - tm_i * tn; }                      \
    M0 = tm_i << 8; N0 = tn_i << 8;                                            \
  }
  int m0 = 0, n0 = 0;
  const u16* ag = A;
  const u16* bg = Bt;
  bool primed = false;
  for (int it = blockIdx.x; it < tiles; it += gridDim.x) {
    if (!primed) {
      G_COORDS(it, m0, n0)
      ag = A + (size_t)(m0 + drow) * lda + dchunk * 8;
      bg = Bt + (size_t)(n0 + drow) * K + dchunk * 8;
    }
    f32x4 acc[8][4];
#pragma unroll
    for (int i = 0; i < 8; ++i)
#pragma unroll
      for (int j = 0; j < 4; ++j) acc[i][j] = (f32x4){0.f, 0.f, 0.f, 0.f};
#define G_ISSUE(KT, ST)                                                                                  \
  {                                                                                                      \
    const u16* a2 = ag + (KT)*64;                                                                        \
    const u16* b2 = bg + (KT)*64;                                                                        \
    char* la = smem + (ST)*65536 + wave * 1024;                                                          \
    _Pragma("unroll") for (int j = 0; j < 4; ++j) {                                                      \
      __builtin_amdgcn_global_load_lds((const unsigned*)(a2 + j * lda64), (unsigned*)(la + j * 8192), 16, 0, 0);          \
      __builtin_amdgcn_global_load_lds((const unsigned*)(b2 + j * ldb64), (unsigned*)(la + 32768 + j * 8192), 16, 0, 0);  \
    }                                                                                                    \
  }
    if (!primed) G_ISSUE(0, 0)
    for (int kt = 0; kt < nk; ++kt) {
      asm volatile("s_waitcnt vmcnt(0)" ::: "memory");
      __syncthreads();
      if (kt + 1 < nk) G_ISSUE(kt + 1, (kt + 1) & 1)
      const u16* As = (const u16*)(smem + (kt & 1) * 65536);
      const u16* Bs = As + 16384;
#define LDA(i, ks) (*(const bf16x8*)(As + (wm * 128 + (i) * 16 + fr) * 64 + ((((ks) * 4 + fq) ^ sw) * 8)))
#define LDB(j, ks) (*(const bf16x8*)(Bs + (wn * 64 + (j) * 16 + fr) * 64 + ((((ks) * 4 + fq) ^ sw) * 8)))
#define SB __builtin_amdgcn_sched_barrier(0)
#define MFMA_H(R, X0, Y0) acc[R][0] = __builtin_amdgcn_mfma_f32_16x16x32_bf16(X0, Y0, acc[R][0], 0, 0, 0);
#define MFMA_T(R, X0, X1, Y0, Y1, Y2, Y3)                                                  \
  acc[R][1] = __builtin_amdgcn_mfma_f32_16x16x32_bf16(X0, Y1, acc[R][1], 0, 0, 0);         \
  acc[R][2] = __builtin_amdgcn_mfma_f32_16x16x32_bf16(X0, Y2, acc[R][2], 0, 0, 0);         \
  acc[R][3] = __builtin_amdgcn_mfma_f32_16x16x32_bf16(X0, Y3, acc[R][3], 0, 0, 0);         \
  acc[R + 1][0] = __builtin_amdgcn_mfma_f32_16x16x32_bf16(X1, Y0, acc[R + 1][0], 0, 0, 0); \
  acc[R + 1][1] = __builtin_amdgcn_mfma_f32_16x16x32_bf16(X1, Y1, acc[R + 1][1], 0, 0, 0); \
  acc[R + 1][2] = __builtin_amdgcn_mfma_f32_16x16x32_bf16(X1, Y2, acc[R + 1][2], 0, 0, 0); \
  acc[R + 1][3] = __builtin_amdgcn_mfma_f32_16x16x32_bf16(X1, Y3, acc[R + 1][3], 0, 0, 0);
      {
        bf16x8 b0 = LDB(0, 0), b1 = LDB(1, 0), b2 = LDB(2, 0), b3 = LDB(3, 0);
        bf16x8 a0 = LDA(0, 0), a1 = LDA(1, 0);
        bf16x8 n0, n1, c0, c1, c2, c3;
        SB; MFMA_H(0, a0, b0) SB; n0 = LDA(2, 0); n1 = LDA(3, 0); SB; MFMA_T(0, a0, a1, b0, b1, b2, b3) SB;
        MFMA_H(2, n0, b0) SB; a0 = LDA(4, 0); a1 = LDA(5, 0); SB; MFMA_T(2, n0, n1, b0, b1, b2, b3) SB;
        MFMA_H(4, a0, b0) SB; n0 = LDA(6, 0); n1 = LDA(7, 0); SB; MFMA_T(4, a0, a1, b0, b1, b2, b3) SB;
        MFMA_H(6, n0, b0) SB;
        c0 = LDB(0, 1); c1 = LDB(1, 1); c2 = LDB(2, 1); c3 = LDB(3, 1); a0 = LDA(0, 1); a1 = LDA(1, 1);
        SB; MFMA_T(6, n0, n1, b0, b1, b2, b3) SB;
        MFMA_H(0, a0, c0) SB; n0 = LDA(2, 1); n1 = LDA(3, 1); SB; MFMA_T(0, a0, a1, c0, c1, c2, c3) SB;
        MFMA_H(2, n0, c0) SB; a0 = LDA(4, 1); a1 = LDA(5, 1); SB; MFMA_T(2, n0, n1, c0, c1, c2, c3) SB;
        MFMA_H(4, a0, c0) SB; n0 = LDA(6, 1); n1 = LDA(7, 1); SB; MFMA_T(4, a0, a1, c0, c1, c2, c3) SB;
        MFMA_H(6, n0, c0) MFMA_T(6, n0, n1, c0, c1, c2, c3) SB;
      }
#undef LDA
#undef LDB
#undef SB
#undef MFMA_H
#undef MFMA_T
    }
    const int cm0 = m0, cn0 = n0;
    primed = false;
    if (it + (int)gridDim.x < tiles) {
      G_COORDS(it + (int)gridDim.x, m0, n0)
      ag = A + (size_t)(m0 + drow) * lda + dchunk * 8;
      bg = Bt + (size_t)(n0 + drow) * K + dchunk * 8;
      G_ISSUE(0, 0)
      primed = true;
    }
    u16* Cs = (u16*)(smem + 65536);
#pragma unroll 1
    for (int hp = 0; hp < 2; ++hp) {
      asm volatile("s_waitcnt lgkmcnt(0)" ::: "memory");
      __builtin_amdgcn_s_barrier();
      asm volatile("" ::: "memory");
      if (wm == hp) {
#pragma unroll
        for (int i = 0; i < 8; ++i)
#pragma unroll
          for (int j = 0; j < 4; ++j)
#pragma unroll
            for (int e = 0; e < 4; ++e) {
              float v = acc[i][j][e];
              if (EPI == 1) { v = fmaxf(v, 0.f); v = v * v; }
              Cs[(i * 16 + fq * 4 + e) * 264 + wn * 64 + j * 16 + fr] = f2bf(v);
            }
      }
      asm volatile("s_waitcnt lgkmcnt(0)" ::: "memory");
      __builtin_amdgcn_s_barrier();
      asm volatile("" ::: "memory");
#pragma unroll 2
      for (int q = 0; q < 8; ++q) {
        const int chunk = tid + q * 512;
        const int row = chunk >> 5, cc = chunk & 31;
        uint4 cv = *(const uint4*)(Cs + row * 264 + cc * 8);
        const int grow = cm0 + hp * 128 + row;
        u16* dst = C + (size_t)grow * ldc + cn0 + cc * 8;
        if (EPI == 2) {
          float a[8], xo[8], y[8];
          unpack8(cv, a);
          unpack8(*(const uint4*)dst, xo);
          const float* gr = gate + (size_t)modrow(grow) * 6144 + cn0 + cc * 8;
          float4 g0 = *(const float4*)gr, g1 = *(const float4*)(gr + 4);
          float gg[8] = {g0.x, g0.y, g0.z, g0.w, g1.x, g1.y, g1.z, g1.w};
#pragma unroll
          for (int j = 0; j < 8; ++j) y[j] = ALPHA * xo[j] + gg[j] * a[j];
          cv = pack8(y);
        }
        *(uint4*)dst = cv;
      }
    }
    asm volatile("s_waitcnt lgkmcnt(0)" ::: "memory");
    __builtin_amdgcn_s_barrier();
    asm volatile("" ::: "memory");
  }
#undef G_ISSUE
#undef G_COORDS
}

template <bool FINAL>
DEV void ln_phase(const Params& p, int M, const float* __restrict__ g, const float* __restrict__ b,
                         const float* __restrict__ modl  , int shi, int sci) {
  u16* X = (u16*)(p.ws + OFF_X);
  u16* HM = (u16*)(p.ws + OFF_HY);
  const int lane = VTID & 63;
  const int gw = VBID * 4 + (VTID >> 6), nw = VNB * 4;
  uint4 nx0 = make_uint4(0u, 0u, 0u, 0u), nx1 = nx0;
  if (gw < M) {
    nx0 = *(const uint4*)(X + (size_t)gw * 1024 + lane * 8);
    nx1 = *(const uint4*)(X + (size_t)gw * 1024 + 512 + lane * 8);
  }
  for (int row = gw; row < M; row += nw) {
    u16* xr = X + (size_t)row * 1024;
    float f[16];
    unpack8(nx0, f);
    unpack8(nx1, f + 8);
    if (row + nw < M) {
      nx0 = *(const uint4*)(xr + (size_t)nw * 1024 + lane * 8);
      nx1 = *(const uint4*)(xr + (size_t)nw * 1024 + 512 + lane * 8);
    }
    float s = 0.f, q = 0.f;
#pragma unroll
    for (int j = 0; j < 16; ++j) { s += f[j]; q += f[j] * f[j]; }
#pragma unroll
    for (int o = 32; o > 0; o >>= 1) { s += __shfl_xor(s, o, 64); q += __shfl_xor(q, o, 64); }
    const float mu = s * (1.f / 1024.f);
    const float rs = rsqrtf(fmaxf(q * (1.f / 1024.f) - mu * mu, 0.f) + 1e-5f);
#pragma unroll
    for (int j = 0; j < 16; ++j) f[j] -= mu;
#pragma unroll
    for (int hh = 0; hh < 2; ++hh) {
      const int c0 = hh * 512 + lane * 8;
      float y[8];
#pragma unroll
      for (int j = 0; j < 8; ++j) y[j] = f[hh * 8 + j] * rs * g[c0 + j] + b[c0 + j];
      if (FINAL) {
        float* o = p.out + (size_t)row * 1024 + c0;
        *(float4*)o = make_float4(y[0], y[1], y[2], y[3]);
        *(float4*)(o + 4) = make_float4(y[4], y[5], y[6], y[7]);
      } else {
        *(uint4*)(xr + c0) = pack8(y);
        const float* m = modl + (size_t)modrow(row) * 6144;
        float h[8];
#pragma unroll
        for (int j = 0; j < 8; ++j) h[j] = y[j] * (1.f + m[sci * 1024 + c0 + j]) + m[shi * 1024 + c0 + j];
        *(uint4*)(HM + (size_t)row * 1024 + c0) = pack8(h);
      }
    }
  }
}

DEV void hyprep_item(const Params& p, int it, char* smem) {
  u16* su = (u16*)smem;
  u16* sx = su + 64 * 66;
  const u16* P = (const u16*)(p.ws + OFF_BIG);
  const int tid = VTID;
  const int ct = it & 7, st = it >> 3;
  int b, t0, L, rowbase;
  u16 *U, *X0;
  if (st < 1024) { b = st >> 5; t0 = (st & 31) * 64; L = 2048; rowbase = b * 2048;
    U = (u16*)((char*)p.out + SO_U); X0 = (u16*)((char*)p.out + SO_X0); }
  else { int s2 = st - 1024; b = s2 >> 2; t0 = (s2 & 3) * 64; L = 256; rowbase = NLAT + b * 256;
    U = (u16*)((char*)p.out + SO_UC); X0 = (u16*)((char*)p.out + SO_X0C); }
  const int c0 = ct * 64;
  {
    const int t = tid >> 2, cq = tid & 3;
    float z[3][16];
#pragma unroll
    for (int g = 0; g < 3; ++g)
#pragma unroll
      for (int j = 0; j < 16; ++j) z[g][j] = 0.f;
#pragma unroll
    for (int tap = 0; tap < 3; ++tap) {
      const int tt = t0 + t + tap - 1;
      if (tt >= 0 && tt < L) {
#pragma unroll
        for (int g = 0; g < 3; ++g) {
          const int col = g * 512 + c0 + cq * 16;
          const u16* src = P + (size_t)(rowbase + tt) * PS0 + col;
          float f[16];
          unpack8(*(const uint4*)src, f);
          unpack8(*(const uint4*)(src + 8), f + 8);
          const float* w = p.hy_conv + tap * 1536 + col;
#pragma unroll
          for (int j = 0; j < 16; ++j) z[g][j] += f[j] * w[j];
        }
      }
    }
#pragma unroll
    for (int j = 0; j < 16; ++j) {
      su[t * 66 + cq * 16 + j] = f2bf(z[1][j] * z[2][j]);
      sx[t * 66 + cq * 16 + j] = f2bf(z[0][j]);
    }
  }
  HSYNC();
  {
    const int c = tid >> 2, tq = tid & 3;
    unsigned wu[8], wx[8];
#pragma unroll
    for (int j = 0; j < 8; ++j) {
      wu[j] = (unsigned)su[(tq * 16 + 2 * j) * 66 + c] | ((unsigned)su[(tq * 16 + 2 * j + 1) * 66 + c] << 16);
      wx[j] = (unsigned)sx[(tq * 16 + 2 * j) * 66 + c] | ((unsigned)sx[(tq * 16 + 2 * j + 1) * 66 + c] << 16);
    }
    const size_t o = ((size_t)(c0 + c) * 32 + b) * L + t0 + tq * 16;
    *(uint4*)(U + o) = make_uint4(wu[0], wu[1], wu[2], wu[3]);
    *(uint4*)(U + o + 8) = make_uint4(wu[4], wu[5], wu[6], wu[7]);
    *(uint4*)(X0 + o) = make_uint4(wx[0], wx[1], wx[2], wx[3]);
    *(uint4*)(X0 + o + 8) = make_uint4(wx[4], wx[5], wx[6], wx[7]);
  }
  HSYNC();
}

DEV void rope_item(const Params& p, int it) {
  u16* P = (u16*)(p.ws + OFF_BIG);
  const float2* tab = (const float2*)(p.ws + OFF_ROPE);
  const int task = it * 256 + VTID;
  const int row = task / 40, rem = task - row * 40;
  const int head = rem >> 2, pr = rem & 3;
  const int d0 = (pr >> 1) * 32 + (pr & 1) * 8;
  const int t = row & 2047;
  const int posc = (pr >> 1) ? (t & 63) : (t >> 6);
  const int fi0 = (pr & 1) * 8;
  u16* ptr = P + (size_t)row * PS0 + 1536 + head * 64 + d0;
  float u1[8], u2[8], o1[8], o2[8];
  unpack8(*(const uint4*)ptr, u1);
  unpack8(*(const uint4*)(ptr + 16), u2);
#pragma unroll
  for (int j = 0; j < 8; ++j) {
    float2 cs = tab[posc * 16 + fi0 + j];
    o1[j] = u1[j] * cs.x - u2[j] * cs.y;
    o2[j] = u1[j] * cs.y + u2[j] * cs.x;
  }
  *(uint4*)ptr = pack8(o1);
  *(uint4*)(ptr + 16) = pack8(o2);
}

DEV void phase_hyprep_rope(const Params& p, char* smem) {
  constexpr int NH = 9216, NR = 10240;
  for (int it = VBID; it < NH + NR; it += VNB) {
    if (it < NH) hyprep_item(p, it, smem);
    else rope_item(p, it - NH);
  }
}

template <int L, int NT>
DEV void conv_item(const Params& p, int c, int th, char* smem) {
  const u16* R = (const u16*)(p.ws + (L == 2048 ? OFF_KR2048 : OFF_KR256)) + (size_t)c * 2 * L;
  const u16* U = (const u16*)((const char*)p.out + (L == 2048 ? SO_U : SO_UC));
  const u16* X0 = (const u16*)((const char*)p.out + (L == 2048 ? SO_X0 : SO_X0C));
  u16* Y = (u16*)(p.ws + OFF_HY);
  u16* Rs0 = (u16*)smem;
  u16* Rs1 = Rs0 + 2 * L + 8;
  const int tid = VTID, lane = tid & 63, wave = tid >> 6;
  for (int i = tid; i < 2 * L; i += 256) {
    Rs0[i] = R[i];
    Rs1[i] = (i + 1 < 2 * L) ? R[i + 1] : (u16)0;
  }
  HSYNC();
  const int r = lane & 31, h = lane >> 5;
  const char* lanebase = (r & 1) ? (const char*)Rs1 + 2 * (8 * h - r + L - 1) : (const char*)Rs0 + 2 * (8 * h - r + L);
  const int tw0 = th * 1024 + wave * NT * 32;
  f32x16 acc[NT];
#pragma unroll
  for (int i = 0; i < NT; ++i)
#pragma unroll
    for (int e = 0; e < 16; ++e) acc[i][e] = 0.f;
  u16* UC = Rs1 + 2 * L + 8;
  const u16* Ug = U + (size_t)c * 32 * L;
  const u16* ug0 = Ug + (size_t)(tid >> 5) * L + (tid & 31) * 8;
  u16* uc0 = UC + (tid >> 5) * 264 + (tid & 31) * 8;
  uint4 stg0 = *(const uint4*)(ug0), stg1 = *(const uint4*)(ug0 + (size_t)8 * L);
  uint4 stg2 = *(const uint4*)(ug0 + (size_t)16 * L), stg3 = *(const uint4*)(ug0 + (size_t)24 * L);
  for (int chk = 0; chk < L / 256; ++chk) {
    HSYNC();
    *(uint4*)(uc0) = stg0; *(uint4*)(uc0 + 8 * 264) = stg1; *(uint4*)(uc0 + 16 * 264) = stg2; *(uint4*)(uc0 + 24 * 264) = stg3;
    HSYNC();
    if (chk + 1 < L / 256) {
      const u16* un = ug0 + (chk + 1) * 256;
      stg0 = *(const uint4*)(un); stg1 = *(const uint4*)(un + (size_t)8 * L);
      stg2 = *(const uint4*)(un + (size_t)16 * L); stg3 = *(const uint4*)(un + (size_t)24 * L);
    }
#pragma unroll 4
    for (int s2 = 0; s2 < 16; ++s2) {
      const int st = chk * 16 + s2;
      bf16x8 bfrag = *(const bf16x8*)(UC + r * 264 + s2 * 16 + 8 * h);
#pragma unroll
      for (int i = 0; i < NT; ++i) {
        const unsigned* ap = (const unsigned*)(lanebase + 2 * (st * 16 - (tw0 + i * 32)));
        uint4 av = make_uint4(ap[0], ap[1], ap[2], ap[3]);
        acc[i] = __builtin_amdgcn_mfma_f32_32x32x16_bf16(*(bf16x8*)&av, bfrag, acc[i], 0, 0, 0);
      }
    }
  }
  const int rowbase = (L == 2048) ? r * 2048 : NLAT + r * 256;
#pragma unroll
  for (int i = 0; i < NT; ++i) {
#pragma unroll
    for (int g4 = 0; g4 < 4; ++g4) {
      const int tt = tw0 + i * 32 + 8 * g4 + 4 * h;
      uint2 xv = *(const uint2*)(X0 + ((size_t)c * 32 + r) * L + tt);
      float x0[4] = {bflo(xv.x), bfhi(xv.x), bflo(xv.y), bfhi(xv.y)};
#pragma unroll
      for (int e = 0; e < 4; ++e) Y[(size_t)(rowbase + tt + e) * 1024 + c] = f2bf(acc[i][g4 * 4 + e] * x0[e]);
    }
  }
  HSYNC();
}

DEV void attn_item(const Params& p, int b, int hq, int qb, bool isctx, char* smem) {
  const u16* P = (const u16*)(p.ws + OFF_BIG);
  u16* Y = (u16*)(p.ws + OFF_HY);
  u16* Ks = (u16*)smem;
  u16* Vt = Ks + 64 * 72;
  const int tid = VTID, lane = tid & 63, wave = tid >> 6;
  const int nq = lane & 15, quad = lane >> 4;
  const int qrow = (isctx ? NLAT + b * 256 : b * 2048) + qb * 64 + wave * 16 + nq;
  const int qpos = qb * 64 + wave * 16 + nq;
  const int hkv = hq >> 2;
  const int kcol = 2048 + hkv * 64, vcol = 2176 + hkv * 64;
  bf16x8 qf[2];
#pragma unroll
  for (int ks = 0; ks < 2; ++ks)
    qf[ks] = *(const bf16x8*)(P + (size_t)qrow * PS0 + 1536 + hq * 64 + ks * 32 + quad * 8);
  float m = p.attn_sink[hq];
  float lsum = (quad == 0) ? 1.f : 0.f;
  f32x4 oacc[4];
#pragma unroll
  for (int n = 0; n < 4; ++n) oacc[n] = (f32x4){0.f, 0.f, 0.f, 0.f};
  const int nloc = isctx ? 0 : 5;
  for (int ti = 0; ti < nloc + 4; ++ti) {
    int krow0, k0 = 0;
    bool masked;
    if (ti < nloc) {
      k0 = qb * 64 - 128 + ti * 64;
      if (k0 < 0 || k0 >= 2048) continue;
      krow0 = b * 2048 + k0; masked = true;
    } else { krow0 = NLAT + b * 256 + (ti - nloc) * 64; masked = false; }
    HSYNC();
    {
      const int key = tid >> 2, part = tid & 3;
      const u16* kp = P + (size_t)(krow0 + key) * PS0 + kcol + part * 16;
      const u16* vp = P + (size_t)(krow0 + key) * PS0 + vcol + part * 16;
      uint4 k0v = *(const uint4*)kp, k1v = *(const uint4*)(kp + 8);
      uint4 v0v = *(const uint4*)vp, v1v = *(const uint4*)(vp + 8);
      *(uint4*)(Ks + key * 72 + part * 16) = k0v;
      *(uint4*)(Ks + key * 72 + part * 16 + 8) = k1v;
      unsigned vw[8] = {v0v.x, v0v.y, v0v.z, v0v.w, v1v.x, v1v.y, v1v.z, v1v.w};
#pragma unroll
      for (int j = 0; j < 8; ++j) {
        Vt[(part * 16 + 2 * j) * 72 + key] = (u16)(vw[j] & 0xffffu);
        Vt[(part * 16 + 2 * j + 1) * 72 + key] = (u16)(vw[j] >> 16);
      }
    }
    HSYNC();
    f32x4 s[4];
#pragma unroll
    for (int n = 0; n < 4; ++n) {
      s[n] = (f32x4){0.f, 0.f, 0.f, 0.f};
#pragma unroll
      for (int ks = 0; ks < 2; ++ks) {
        bf16x8 kf = *(const bf16x8*)(Ks + (n * 16 + nq) * 72 + ks * 32 + quad * 8);
        s[n] = __builtin_amdgcn_mfma_f32_16x16x32_bf16(kf, qf[ks], s[n], 0, 0, 0);
      }
    }
    float mx = -1e30f;
#pragma unroll
    for (int n = 0; n < 4; ++n)
#pragma unroll
      for (int e = 0; e < 4; ++e) {
        float v = s[n][e] * 0.125f;
        if (masked) {
          int kpos = k0 + n * 16 + quad * 4 + e;
          int d = qpos - kpos;
          if (d > 128 || d < -128) v = -1e30f;
        }
        s[n][e] = v;
        mx = fmaxf(mx, v);
      }
    mx = fmaxf(mx, __shfl_xor(mx, 16, 64));
    mx = fmaxf(mx, __shfl_xor(mx, 32, 64));
    const float mn = fmaxf(m, mx);
    const float al = __expf(m - mn);
    m = mn;
    float ps = 0.f;
#pragma unroll
    for (int n = 0; n < 4; ++n)
#pragma unroll
      for (int e = 0; e < 4; ++e) { float pv = __expf(s[n][e] - mn); s[n][e] = pv; ps += pv; }
    lsum = lsum * al + ps;
#pragma unroll
    for (int n = 0; n < 4; ++n)
#pragma unroll
      for (int e = 0; e < 4; ++e) oacc[n][e] *= al;
#pragma unroll
    for (int hh = 0; hh < 2; ++hh) {
      uint4 pw;
      pw.x = pack2(s[2 * hh][0], s[2 * hh][1]); pw.y = pack2(s[2 * hh][2], s[2 * hh][3]);
      pw.z = pack2(s[2 * hh + 1][0], s[2 * hh + 1][1]); pw.w = pack2(s[2 * hh + 1][2], s[2 * hh + 1][3]);
      bf16x8 pb = *(bf16x8*)&pw;
#pragma unroll
      for (int n = 0; n < 4; ++n) {
        const u16* vr = Vt + (n * 16 + nq) * 72 + quad * 4;
        uint2 va = *(const uint2*)(vr + (2 * hh) * 16);
        uint2 vb = *(const uint2*)(vr + (2 * hh + 1) * 16);
        uint4 vv = make_uint4(va.x, va.y, vb.x, vb.y);
        oacc[n] = __builtin_amdgcn_mfma_f32_16x16x32_bf16(*(bf16x8*)&vv, pb, oacc[n], 0, 0, 0);
      }
    }
  }
  lsum += __shfl_xor(lsum, 16, 64);
  lsum += __shfl_xor(lsum, 32, 64);
  const float inv = 1.f / lsum;
  u16* yo = Y + (size_t)qrow * 1024 + 512 + hq * 64 + quad * 4;
#pragma unroll
  for (int n = 0; n < 4; ++n) {
    uint2 w;
    w.x = pack2(oacc[n][0] * inv, oacc[n][1] * inv);
    w.y = pack2(oacc[n][2] * inv, oacc[n][3] * inv);
    *(uint2*)(yo + n * 16) = w;
  }
  HSYNC();
}

DEV void phase_conv_attn(const Params& p, char* smem) {
  constexpr int N0 = 1024, N1 = N0 + 512, N2 = N1 + 8192, N3 = N2 + 1024;
#pragma unroll 1
  for (int it = VBID; it < N0; it += VNB) conv_item<2048, 8>(p, it >> 1, it & 1, smem);
  __builtin_amdgcn_sched_barrier(0);
#pragma unroll 1
  for (int it = VBID; it < N3; it += VNB) {
    if (it < N0) continue;
    if (it < N1) conv_item<256, 2>(p, it - N0, 0, smem);
  }
  __builtin_amdgcn_sched_barrier(0);
#pragma unroll 1
  for (int it = VBID; it < N3; it += VNB) {
    if (it < N1) continue;
    if (it < N2) { int a = it - N1; attn_item(p, a >> 8, (a >> 5) & 7, a & 31, false, smem); }
    else { int a = it - N2; attn_item(p, a >> 5, (a >> 2) & 7, a & 3, true, smem); }
  }
}

DEV void lds_wave_sync() {
  asm volatile("s_waitcnt lgkmcnt(0)" ::: "memory");
  __builtin_amdgcn_wave_barrier();
}

DEV void rwkv_item(const Params& p, int ri, char* smem) {
  const u16* P = (const u16*)(p.ws + OFF_BIG);
  u16* O4 = (u16*)p.out;
  float* BS = (float*)(p.ws + OFF_BSUM);
  const int tid0 = VTID;
  const int wp0 = tid0 >> 7;
  const int cid = ri * 2 + wp0;
  const int b = cid >> 4, d = (cid >> 3) & 1, h = cid & 7;
  f32x4 S[4][2];
#pragma unroll
  for (int i = 0; i < 4; ++i)
#pragma unroll
    for (int j = 0; j < 2; ++j) S[i][j] = (f32x4){0.f, 0.f, 0.f, 0.f};
  uint4 bw[2][4];
  float l0[4];
  {
    const int lane = tid0 & 63, wi = (tid0 >> 6) & 1, fr = lane & 15, fq = lane >> 4;
    const float* wsrc = (wi == 0 ? p.rw_w2 : p.rw_a2) + (size_t)d * 64 * 512 + h * 64;
    const float* bsrc = (wi == 0 ? p.rw_w0 : p.rw_a0) + d * 512 + h * 64;
#pragma unroll
    for (int nt = 0; nt < 4; ++nt) {
      l0[nt] = bsrc[nt * 16 + fr];
#pragma unroll
      for (int ks = 0; ks < 2; ++ks) {
        __builtin_amdgcn_sched_barrier(0);
        float f[8];
        const float* wp_ = wsrc + (size_t)(ks * 32 + fq * 8) * 512 + nt * 16 + fr;
#pragma unroll
        for (int j = 0; j < 8; ++j) f[j] = wp_[j * 512];
        bw[ks][nt] = pack8(f);
      }
    }
  }
  uint4 pre[5][3];
#define RW_LOAD(CI)                                                                                 \
  {                                                                                                 \
    const int seg_ = (CI) < 16 ? 0 : 1;                                                             \
    const int ch_ = seg_ ? (CI)-16 : (CI);                                                          \
    const int Ls_ = seg_ ? 2048 : 256;                                                              \
    const int rb_ = seg_ ? b * 2048 : NLAT + b * 256;                                               \
    const int sidx_ = ch_ * 16 + stt;                                                               \
    const int t_ = d == 0 ? sidx_ : Ls_ - 1 - sidx_;                                                \
    const u16* prow_ = P + (size_t)(rb_ + t_) * PS1 + spart * 8;                                    \
    _Pragma("unroll") for (int g = 0; g < 5; ++g) {                                                 \
      const int col_ = g < 3 ? g * 512 + h * 64 : (g == 3 ? 1536 + d * 64 : 1664 + d * 64);         \
      _Pragma("unroll") for (int tap = 0; tap < 3; ++tap) {                                         \
        const int tt_ = t_ + tap - 1;                                                               \
        if (tt_ >= 0 && tt_ < Ls_) pre[g][tap] = *(const uint4*)(prow_ + (ptrdiff_t)(tap - 1) * PS1 + col_); \
        else pre[g][tap] = make_uint4(0u, 0u, 0u, 0u);                                              \
      }                                                                                             \
    }                                                                                               \
  }
  {
    const int pt = tid0 & 127, stt = pt >> 3, spart = pt & 7;
    RW_LOAD(0)
  }
  for (int cidx = 0; cidx < 144; ++cidx) {
    asm volatile("" ::: "memory");
    int tid = tid0;
    asm volatile("" : "+v"(tid));
    const int lane = tid & 63, wave = tid >> 6, wp = wave >> 1, wi = wave & 1, pt = tid & 127;
    const int fr = lane & 15, fq = lane >> 4, stt = pt >> 3, spart = pt & 7;
    const int seg = cidx < 16 ? 0 : 1;
    const int ch = seg ? cidx - 16 : cidx;
    const int Ls = seg ? 2048 : 256;
    char* base = smem + wp * 32768;
    u16* RK = (u16*)base;
    u16* KD = RK + 1152;
    u16* KK = KD + 1152;
    u16* AB = KK + 1152;
    u16* VT = AB + 1152;
    float* LW = (float*)(base + 11264);
    u16* TW = (u16*)(base + 15360);
    u16* AD = TW + 1152;
    u16* BgCT = (u16*)(base + 19968);
    u16* KgCT = BgCT + 1024;
    float* gC = (float*)(base + 24064);
    float* Amat = (float*)(base + 24320) + wi * 256;
    u16* Tinv = (u16*)(base + 26368) + wi * 256;
    u16* BG = (u16*)(base + 27392);
    {
      const int o = stt * 72 + spart * 8;
#pragma unroll
      for (int g = 0; g < 5; ++g) {
        __builtin_amdgcn_sched_barrier(0);
        const int col = g < 3 ? g * 512 + h * 64 : (g == 3 ? 1536 + d * 64 : 1664 + d * 64);
        float pc[8], pp[8], pn[8], v[8];
        unpack8(pre[g][1], pc); unpack8(pre[g][0], pp); unpack8(pre[g][2], pn);
        const float* mu = p.rw_mu + col + spart * 8;
        float4 m0 = *(const float4*)mu, m1 = *(const float4*)(mu + 4);
        const float mm[8] = {m0.x, m0.y, m0.z, m0.w, m1.x, m1.y, m1.z, m1.w};
#pragma unroll
        for (int j = 0; j < 8; ++j) v[j] = pc[j] + mm[j] * (0.5f * (pp[j] + pn[j]) - pc[j]);
        if (g == 0) *(uint4*)(RK + o) = pack8(v);
        else if (g == 1) {
          *(uint4*)(KD + o) = pack8(v);
          const float* kkw = p.rw_kk + h * 64 + spart * 8;
          float kkv[8];
          float ss = 0.f;
#pragma unroll
          for (int j = 0; j < 8; ++j) { kkv[j] = v[j] * kkw[j]; ss += kkv[j] * kkv[j]; }
          ss += __shfl_xor(ss, 1, 64); ss += __shfl_xor(ss, 2, 64); ss += __shfl_xor(ss, 4, 64);
          const float inv = rsqrtf(ss + 1e-6f);
#pragma unroll
          for (int j = 0; j < 8; ++j) kkv[j] *= inv;
          *(uint4*)(KK + o) = pack8(kkv);
        } else if (g == 2) {
#pragma unroll
          for (int j = 0; j < 8; ++j) VT[(spart * 8 + j) * 16 + stt] = f2bf(v[j]);
        } else if (g == 3) {
#pragma unroll
          for (int j = 0; j < 8; ++j) v[j] = fast_tanh(v[j]);
          *(uint4*)(TW + o) = pack8(v);
        } else *(uint4*)(AD + o) = pack8(v);
      }
    }
    HSYNC();
    if (cidx + 1 < 144) RW_LOAD(cidx + 1)
    {
      const u16* IN = wi == 0 ? TW : AD;
      bf16x8 af0 = *(const bf16x8*)(IN + fr * 72 + fq * 8);
      bf16x8 af1 = *(const bf16x8*)(IN + fr * 72 + 32 + fq * 8);
#pragma unroll
      for (int nt = 0; nt < 4; ++nt) {
        f32x4 o4 = (f32x4){0.f, 0.f, 0.f, 0.f};
        o4 = __builtin_amdgcn_mfma_f32_16x16x32_bf16(af0, *(bf16x8*)&bw[0][nt], o4, 0, 0, 0);
        o4 = __builtin_amdgcn_mfma_f32_16x16x32_bf16(af1, *(bf16x8*)&bw[1][nt], o4, 0, 0, 0);
#pragma unroll
        for (int e = 0; e < 4; ++e) {
          const float prev = l0[nt] + o4[e];
          const int t = fq * 4 + e, c = nt * 16 + fr;
          if (wi == 0) LW[t * 64 + c] = -__expf(-softplus(-prev) - 0.5f);
          else AB[t * 72 + c] = f2bf(sigm(prev));
        }
      }
    }
    HSYNC();
    {
      const int c = lane;
      float cum = 0.f;
      if (wi == 0) {
#pragma unroll 4
        for (int t = 0; t < 16; ++t) {
          const float lw = LW[t * 64 + c];
          const float gp = __expf(cum);
          cum += lw;
          const float gi = __expf(-cum);
          const float kk = bf2f(KK[t * 72 + c]);
          const float a = bf2f(AB[t * 72 + c]);
          KK[t * 72 + c] = f2bf(kk * gp);
          BG[t * 72 + c] = f2bf(kk * a * gi);
        }
        const float gCv = __expf(cum);
        gC[c] = gCv;
#pragma unroll 4
        for (int t = 0; t < 16; ++t) BgCT[c * 16 + t] = f2bf(-bf2f(BG[t * 72 + c]) * gCv);
      } else {
        float* PR = (float*)TW;
        const float kac = p.rw_ka[h * 64 + c], rkc = p.rw_rk[h * 64 + c];
#pragma unroll 4
        for (int t = 0; t < 16; ++t) {
          const float lw = LW[t * 64 + c];
          cum += lw;
          const float g = __expf(cum), gi = __expf(-cum);
          const float r = bf2f(RK[t * 72 + c]);
          const float k = bf2f(KD[t * 72 + c]);
          const float a = bf2f(AB[t * 72 + c]);
          const float kd = k * (1.f + (a - 1.f) * kac);
          RK[t * 72 + c] = f2bf(r * g);
          KD[t * 72 + c] = f2bf(kd * gi);
          PR[t * 64 + c] = r * kd * rkc;
        }
        const float gCv = __expf(cum);
#pragma unroll 4
        for (int t = 0; t < 16; ++t) KgCT[c * 16 + t] = f2bf(bf2f(KD[t * 72 + c]) * gCv);
        lds_wave_sync();
        {
          const int t = lane >> 2, sg = lane & 3;
          const float4 q0 = *(const float4*)(PR + t * 64 + sg * 16), q1 = *(const float4*)(PR + t * 64 + sg * 16 + 4);
          const float4 q2 = *(const float4*)(PR + t * 64 + sg * 16 + 8), q3 = *(const float4*)(PR + t * 64 + sg * 16 + 12);
          float bsum = (q0.x + q0.y + q0.z + q0.w) + (q1.x + q1.y + q1.z + q1.w) + (q2.x + q2.y + q2.z + q2.w) + (q3.x + q3.y + q3.z + q3.w);
          bsum += __shfl_xor(bsum, 1, 64);
          bsum += __shfl_xor(bsum, 2, 64);
          if (seg == 1 && sg == 0) {
            const int sidx = ch * 16 + t;
            const int tpos = d == 0 ? sidx : 2047 - sidx;
            BS[(size_t)(b * 2048 + tpos) * 16 + h * 2 + d] = bsum;
          }
        }
      }
    }
    HSYNC();
    __builtin_amdgcn_sched_barrier(0);
    {
      f32x4 XabT = (f32x4){0.f, 0.f, 0.f, 0.f}, XakT = XabT, XrbT = XabT, XrkT = XabT;
#pragma unroll
      for (int ks = 0; ks < 2; ++ks) {
        bf16x8 kkf = *(const bf16x8*)(KK + fr * 72 + ks * 32 + fq * 8);
        bf16x8 rgf = *(const bf16x8*)(RK + fr * 72 + ks * 32 + fq * 8);
        bf16x8 bgf = *(const bf16x8*)(BG + fr * 72 + ks * 32 + fq * 8);
        bf16x8 kgf = *(const bf16x8*)(KD + fr * 72 + ks * 32 + fq * 8);
        XabT = __builtin_amdgcn_mfma_f32_16x16x32_bf16(bgf, kkf, XabT, 0, 0, 0);
        XakT = __builtin_amdgcn_mfma_f32_16x16x32_bf16(kgf, kkf, XakT, 0, 0, 0);
        XrbT = __builtin_amdgcn_mfma_f32_16x16x32_bf16(bgf, rgf, XrbT, 0, 0, 0);
        XrkT = __builtin_amdgcn_mfma_f32_16x16x32_bf16(kgf, rgf, XrkT, 0, 0, 0);
      }
      {
        float am[4];
#pragma unroll
        for (int e = 0; e < 4; ++e) am[e] = (fq * 4 + e < fr) ? XabT[e] : 0.f;
        *(float4*)(Amat + fr * 16 + fq * 4) = make_float4(am[0], am[1], am[2], am[3]);
      }
      lds_wave_sync();
      if (lane < 16) {
        float x[16];
        x[0] = (lane == 0) ? 1.f : 0.f;
        float4 cur[4], nxt[4];
        cur[0] = *(const float4*)(Amat + 16);
        cur[1] = cur[0]; cur[2] = cur[0]; cur[3] = cur[0];
#pragma unroll
        for (int i = 1; i < 16; ++i) {
          __builtin_amdgcn_sched_barrier(0);
          if (i + 1 < 16) {
#pragma unroll
            for (int q = 0; q < (i + 4) / 4; ++q) nxt[q] = *(const float4*)(Amat + (i + 1) * 16 + q * 4);
          }
          float acc = (i == lane) ? 1.f : 0.f;
#pragma unroll
          for (int j = 0; j < i; ++j) {
            const float4 rv = cur[j >> 2];
            const float av = (j & 3) == 0 ? rv.x : ((j & 3) == 1 ? rv.y : ((j & 3) == 2 ? rv.z : rv.w));
            acc -= av * x[j];
          }
          x[i] = acc;
#pragma unroll
          for (int q = 0; q < 4; ++q) cur[q] = nxt[q];
        }
#pragma unroll
        for (int i = 0; i < 16; ++i) Tinv[i * 16 + lane] = f2bf(x[i]);
      }
      lds_wave_sync();
      f32x4 sa0[2], y0[2];
#pragma unroll
      for (int nt = 0; nt < 2; ++nt) { sa0[nt] = (f32x4){0.f, 0.f, 0.f, 0.f}; y0[nt] = (f32x4){0.f, 0.f, 0.f, 0.f}; }
#pragma unroll
      for (int x = 0; x < 2; ++x) {
        __builtin_amdgcn_sched_barrier(0);
        uint2 k0 = *(const uint2*)(KK + fr * 72 + 32 * x + fq * 4);
        uint2 k1 = *(const uint2*)(KK + fr * 72 + 32 * x + 16 + fq * 4);
        uint2 r0 = *(const uint2*)(RK + fr * 72 + 32 * x + fq * 4);
        uint2 r1 = *(const uint2*)(RK + fr * 72 + 32 * x + 16 + fq * 4);
        uint4 kw = make_uint4(k0.x, k0.y, k1.x, k1.y);
        uint4 rw = make_uint4(r0.x, r0.y, r1.x, r1.y);
#pragma unroll
        for (int nt = 0; nt < 2; ++nt) {
          uint4 sw;
          sw.x = pack2(S[2 * x][nt][0], S[2 * x][nt][1]); sw.y = pack2(S[2 * x][nt][2], S[2 * x][nt][3]);
          sw.z = pack2(S[2 * x + 1][nt][0], S[2 * x + 1][nt][1]); sw.w = pack2(S[2 * x + 1][nt][2], S[2 * x + 1][nt][3]);
          sa0[nt] = __builtin_amdgcn_mfma_f32_16x16x32_bf16(*(bf16x8*)&kw, *(bf16x8*)&sw, sa0[nt], 0, 0, 0);
          y0[nt] = __builtin_amdgcn_mfma_f32_16x16x32_bf16(*(bf16x8*)&rw, *(bf16x8*)&sw, y0[nt], 0, 0, 0);
        }
      }
      float ak[4], rb[4], rk[4];
#pragma unroll
      for (int e = 0; e < 4; ++e) {
        const int j = fq * 4 + e;
        ak[e] = (j < fr) ? XakT[e] : 0.f;
        rb[e] = (j <= fr) ? -XrbT[e] : 0.f;
        rk[e] = (j <= fr) ? XrkT[e] : 0.f;
      }
      const uint4 akw = make_uint4(pack2(ak[0], ak[1]), pack2(ak[2], ak[3]), 0u, 0u);
      const uint4 ybw = make_uint4(pack2(rb[0], rb[1]), pack2(rb[2], rb[3]), pack2(rk[0], rk[1]), pack2(rk[2], rk[3]));
      const uint2 tv = *(const uint2*)(Tinv + fr * 16 + fq * 4);
      const uint4 tw = make_uint4(tv.x, tv.y, 0u, 0u);
      uint4 sv[2];
#pragma unroll
      for (int nt = 0; nt < 2; ++nt) {
        const int vc = wi * 32 + nt * 16 + fr;
        const uint2 vt = *(const uint2*)(VT + vc * 16 + fq * 4);
        const uint4 vb = make_uint4(vt.x, vt.y, 0u, 0u);
        f32x4 rhs = __builtin_amdgcn_mfma_f32_16x16x32_bf16(*(bf16x8*)&akw, *(bf16x8*)&vb, sa0[nt], 0, 0, 0);
        const uint4 rw = make_uint4(pack2(rhs[0], rhs[1]), pack2(rhs[2], rhs[3]), 0u, 0u);
        f32x4 sa = __builtin_amdgcn_mfma_f32_16x16x32_bf16(*(bf16x8*)&tw, *(bf16x8*)&rw, (f32x4){0.f, 0.f, 0.f, 0.f}, 0, 0, 0);
        sv[nt] = make_uint4(pack2(sa[0], sa[1]), pack2(sa[2], sa[3]), vt.x, vt.y);
        f32x4 y = __builtin_amdgcn_mfma_f32_16x16x32_bf16(*(bf16x8*)&ybw, *(bf16x8*)&sv[nt], y0[nt], 0, 0, 0);
        if (seg == 1) {
#pragma unroll
          for (int e = 0; e < 4; ++e) {
            const int sidx = ch * 16 + fq * 4 + e;
            const int tpos = d == 0 ? sidx : 2047 - sidx;
            O4[((size_t)d * NLAT + b * 2048 + tpos) * 512 + h * 64 + vc] = f2bf(y[e]);
          }
        }
      }
#pragma unroll
      for (int mt = 0; mt < 4; ++mt) {
        __builtin_amdgcn_sched_barrier(0);
        const float4 g4 = *(const float4*)(gC + mt * 16 + fq * 4);
        const uint2 bv = *(const uint2*)(BgCT + (mt * 16 + fr) * 16 + fq * 4);
        const uint2 kv = *(const uint2*)(KgCT + (mt * 16 + fr) * 16 + fq * 4);
        const uint4 aw = make_uint4(bv.x, bv.y, kv.x, kv.y);
#pragma unroll
        for (int nt = 0; nt < 2; ++nt) {
          S[mt][nt][0] *= g4.x; S[mt][nt][1] *= g4.y; S[mt][nt][2] *= g4.z; S[mt][nt][3] *= g4.w;
          S[mt][nt] = __builtin_amdgcn_mfma_f32_16x16x32_bf16(*(bf16x8*)&aw, *(bf16x8*)&sv[nt], S[mt][nt], 0, 0, 0);
        }
      }
    }
    HSYNC();
  }
#undef RW_LOAD
}

DEV void gdn_item(const Params& p, int gi, char* smem) {
  const u16* P = (const u16*)(p.ws + OFF_BIG);
  u16* O4 = (u16*)p.out;
  const int tid0 = VTID;
  const int b = gi >> 3, d = (gi >> 2) & 1, h = gi & 3;
  constexpr int BUFB = 23424;
  f32x4 S[8][2];
#pragma unroll
  for (int i = 0; i < 8; ++i)
#pragma unroll
    for (int j = 0; j < 2; ++j) S[i][j] = (f32x4){0.f, 0.f, 0.f, 0.f};
  const float negA = -__expf(p.dn_A_log[d * 4 + h]);
  const float dtb = p.dn_dt_bias[d * 4 + h];
  uint4 pre[3][3];
  float gpre0 = 0.f, gpre1 = 0.f;
#define GDN_LOAD(CI)                                                                               \
  {                                                                                                \
    const int seg_ = (CI) < 16 ? 0 : 1;                                                            \
    const int ch_ = seg_ ? (CI)-16 : (CI);                                                         \
    const int Ls_ = seg_ ? 2048 : 256;                                                             \
    const int rb_ = seg_ ? b * 2048 : NLAT + b * 256;                                              \
    const int sidx_ = ch_ * 16 + stt;                                                              \
    const int t_ = d == 0 ? sidx_ : Ls_ - 1 - sidx_;                                               \
    const u16* prow_ = P + (size_t)(rb_ + t_) * PS1 + DNO;                                         \
    _Pragma("unroll") for (int g = 0; g < 3; ++g) {                                                \
      const int col_ = g * 512 + h * 128 + spart * 8;                                              \
      _Pragma("unroll") for (int tap = 0; tap < 3; ++tap) {                                        \
        const int tt_ = t_ + tap - 1;                                                              \
        if (tt_ >= 0 && tt_ < Ls_) pre[g][tap] = *(const uint4*)(prow_ + (ptrdiff_t)(tap - 1) * PS1 + col_); \
        else pre[g][tap] = make_uint4(0u, 0u, 0u, 0u);                                             \
      }                                                                                            \
    }                                                                                              \
    if (wave == 0) {                                                                               \
      const int s2_ = ch_ * 16 + fr;                                                               \
      const int t2_ = d == 0 ? s2_ : Ls_ - 1 - s2_;                                                \
      const u16* gr_ = P + (size_t)(rb_ + t2_) * PS1 + DNO + 2048;                                 \
      gpre0 = bf2f(gr_[d * 4 + h]);                                                                \
      gpre1 = bf2f(gr_[8 + d * 4 + h]);                                                            \
    }                                                                                              \
  }
  {
    const int tid = tid0, lane = tid & 63, wave = tid >> 6, fr = lane & 15, stt = tid >> 4, spart = tid & 15;
    GDN_LOAD(0)
  }
  for (int cidx = 0; cidx < 144; ++cidx) {
    asm volatile("" ::: "memory");
    int tid = tid0;
    asm volatile("" : "+v"(tid));
    const int lane = tid & 63, wave = tid >> 6, fr = lane & 15, fq = lane >> 4, stt = tid >> 4, spart = tid & 15;
    char* buf = smem;
    u16* Kb = (u16*)buf;
    u16* Qb = Kb + 16 * 136;
    float* Vf = (float*)(buf + 8704);
    u16* KdT = (u16*)(buf + 17152);
    u16* Tinv = (u16*)(buf + 21248);
    u16* Pm = (u16*)(buf + 21760);
    float* Amat = (float*)(buf + 22272);
    float* Gs = (float*)(buf + 23296);
    float* Bs = Gs + 16;
#pragma unroll
    for (int g = 0; g < 3; ++g) {
      __builtin_amdgcn_sched_barrier(0);
      const int col = g * 512 + h * 128 + spart * 8;
      float z[8];
#pragma unroll
      for (int j = 0; j < 8; ++j) z[j] = 0.f;
#pragma unroll
      for (int tap = 0; tap < 3; ++tap) {
        __builtin_amdgcn_sched_barrier(0);
        float f[8];
        unpack8(pre[g][tap], f);
        const float* w = p.dn_conv + tap * 1536 + col;
        float4 w0 = *(const float4*)w, w1 = *(const float4*)(w + 4);
        z[0] += f[0] * w0.x; z[1] += f[1] * w0.y; z[2] += f[2] * w0.z; z[3] += f[3] * w0.w;
        z[4] += f[4] * w1.x; z[5] += f[5] * w1.y; z[6] += f[6] * w1.z; z[7] += f[7] * w1.w;
      }
      float ss = 0.f;
#pragma unroll
      for (int j = 0; j < 8; ++j) { z[j] = silu(z[j]); ss += z[j] * z[j]; }
      if (g < 2) {
        ss += __shfl_xor(ss, 1, 64); ss += __shfl_xor(ss, 2, 64); ss += __shfl_xor(ss, 4, 64); ss += __shfl_xor(ss, 8, 64);
        float sc = rsqrtf(ss + 1e-6f);
        if (g == 0) sc *= 0.08838834764831845f;
#pragma unroll
        for (int j = 0; j < 8; ++j) z[j] *= sc;
        *(uint4*)((g == 0 ? Qb : Kb) + stt * 136 + spart * 8) = pack8(z);
      } else {
        float* dst = Vf + stt * 132 + spart * 8;
        *(float4*)dst = make_float4(z[0], z[1], z[2], z[3]);
        *(float4*)(dst + 4) = make_float4(z[4], z[5], z[6], z[7]);
      }
    }
    if (wave == 0) {
      float g = negA * softplus(gpre0 + dtb);
#pragma unroll
      for (int o = 1; o < 16; o <<= 1) { float n = __shfl_up(g, o, 16); if (fr >= o) g += n; }
      if (lane < 16) { Gs[lane] = g; Bs[lane] = sigm(gpre1); }
    }
    HSYNC();
    if (wave == 0) {
      f32x4 kk = (f32x4){0.f, 0.f, 0.f, 0.f};
#pragma unroll
      for (int ks = 0; ks < 4; ++ks) {
        bf16x8 kf = *(const bf16x8*)(Kb + fr * 136 + ks * 32 + fq * 8);
        kk = __builtin_amdgcn_mfma_f32_16x16x32_bf16(kf, kf, kk, 0, 0, 0);
      }
      const float Gj = Gs[fr];
#pragma unroll
      for (int e = 0; e < 4; ++e) {
        const int i = fq * 4 + e;
        const float a = (fr < i) ? Bs[i] * kk[e] * __expf(Gs[i] - Gj) : 0.f;
        Amat[i * 16 + fr] = a;
      }
      lds_wave_sync();
      if (lane < 16) {
        float x[16];
        x[0] = (lane == 0) ? 1.f : 0.f;
        float4 cur[4], nxt[4];
        cur[0] = *(const float4*)(Amat + 16);
        cur[1] = cur[0]; cur[2] = cur[0]; cur[3] = cur[0];
#pragma unroll
        for (int i = 1; i < 16; ++i) {
          __builtin_amdgcn_sched_barrier(0);
          if (i + 1 < 16) {
#pragma unroll
            for (int q = 0; q < (i + 4) / 4; ++q) nxt[q] = *(const float4*)(Amat + (i + 1) * 16 + q * 4);
          }
          float acc = (i == lane) ? 1.f : 0.f;
#pragma unroll
          for (int j = 0; j < i; ++j) {
            const float4 rv = cur[j >> 2];
            const float av = (j & 3) == 0 ? rv.x : ((j & 3) == 1 ? rv.y : ((j & 3) == 2 ? rv.z : rv.w));
            acc -= av * x[j];
          }
          x[i] = acc;
#pragma unroll
          for (int q = 0; q < 4; ++q) cur[q] = nxt[q];
        }
#pragma unroll
        for (int i = 0; i < 16; ++i) Tinv[i * 16 + lane] = f2bf(x[i]);
      }
    } else if (wave == 1) {
      f32x4 qk = (f32x4){0.f, 0.f, 0.f, 0.f};
#pragma unroll
      for (int ks = 0; ks < 4; ++ks) {
        bf16x8 qf = *(const bf16x8*)(Qb + fr * 136 + ks * 32 + fq * 8);
        bf16x8 kf = *(const bf16x8*)(Kb + fr * 136 + ks * 32 + fq * 8);
        qk = __builtin_amdgcn_mfma_f32_16x16x32_bf16(qf, kf, qk, 0, 0, 0);
      }
      const float Gj = Gs[fr];
#pragma unroll
      for (int e = 0; e < 4; ++e) {
        const int t = fq * 4 + e;
        const float v = (fr <= t) ? qk[e] * __expf(Gs[t] - Gj) : 0.f;
        Pm[t * 16 + fr] = f2bf(v);
      }
    } else {
      const int k = tid - 128;
      const float GC = Gs[15];
      unsigned w[8];
#pragma unroll
      for (int j = 0; j < 8; ++j) {
        __builtin_amdgcn_sched_barrier(0);
        float v0 = bf2f(Kb[(2 * j) * 136 + k]) * __expf(GC - Gs[2 * j]);
        float v1 = bf2f(Kb[(2 * j + 1) * 136 + k]) * __expf(GC - Gs[2 * j + 1]);
        w[j] = pack2(v0, v1);
      }
      *(uint4*)(KdT + k * 16) = make_uint4(w[0], w[1], w[2], w[3]);
      *(uint4*)(KdT + k * 16 + 8) = make_uint4(w[4], w[5], w[6], w[7]);
    }
    __builtin_amdgcn_sched_barrier(0);
    f32x4 ksv[2], qsv[2];
#pragma unroll
    for (int nt = 0; nt < 2; ++nt) { ksv[nt] = (f32x4){0.f, 0.f, 0.f, 0.f}; qsv[nt] = (f32x4){0.f, 0.f, 0.f, 0.f}; }
#pragma unroll
    for (int x = 0; x < 4; ++x) {
      __builtin_amdgcn_sched_barrier(0);
      uint2 k0 = *(const uint2*)(Kb + fr * 136 + 32 * x + fq * 4);
      uint2 k1 = *(const uint2*)(Kb + fr * 136 + 32 * x + 16 + fq * 4);
      uint2 q0 = *(const uint2*)(Qb + fr * 136 + 32 * x + fq * 4);
      uint2 q1 = *(const uint2*)(Qb + fr * 136 + 32 * x + 16 + fq * 4);
      uint4 kw = make_uint4(k0.x, k0.y, k1.x, k1.y);
      uint4 qw = make_uint4(q0.x, q0.y, q1.x, q1.y);
#pragma unroll
      for (int nt = 0; nt < 2; ++nt) {
        uint4 sw;
        sw.x = pack2(S[2 * x][nt][0], S[2 * x][nt][1]); sw.y = pack2(S[2 * x][nt][2], S[2 * x][nt][3]);
        sw.z = pack2(S[2 * x + 1][nt][0], S[2 * x + 1][nt][1]); sw.w = pack2(S[2 * x + 1][nt][2], S[2 * x + 1][nt][3]);
        ksv[nt] = __builtin_amdgcn_mfma_f32_16x16x32_bf16(*(bf16x8*)&kw, *(bf16x8*)&sw, ksv[nt], 0, 0, 0);
        qsv[nt] = __builtin_amdgcn_mfma_f32_16x16x32_bf16(*(bf16x8*)&qw, *(bf16x8*)&sw, qsv[nt], 0, 0, 0);
      }
    }
    HSYNC();
    if (cidx + 1 < 144) GDN_LOAD(cidx + 1)
    __builtin_amdgcn_sched_barrier(0);
    {
      const int seg = cidx < 16 ? 0 : 1;
      const int ch = seg ? cidx - 16 : cidx;
      float eG[4], bt[4];
#pragma unroll
      for (int e = 0; e < 4; ++e) { eG[e] = __expf(Gs[fq * 4 + e]); bt[e] = Bs[fq * 4 + e]; }
      const float eGC = __expf(Gs[15]);
      uint2 tv = *(const uint2*)(Tinv + fr * 16 + fq * 4);
      uint2 pv = *(const uint2*)(Pm + fr * 16 + fq * 4);
      uint4 tw = make_uint4(tv.x, tv.y, 0u, 0u);
      uint4 pw = make_uint4(pv.x, pv.y, 0u, 0u);
      uint4 ub[2];
#pragma unroll
      for (int nt = 0; nt < 2; ++nt) {
        const int vc = wave * 32 + nt * 16 + fr;
        float rhs[4];
#pragma unroll
        for (int e = 0; e < 4; ++e) rhs[e] = bt[e] * (Vf[(fq * 4 + e) * 132 + vc] - eG[e] * ksv[nt][e]);
        uint4 rw = make_uint4(pack2(rhs[0], rhs[1]), pack2(rhs[2], rhs[3]), 0u, 0u);
        f32x4 u = __builtin_amdgcn_mfma_f32_16x16x32_bf16(*(bf16x8*)&tw, *(bf16x8*)&rw, (f32x4){0.f, 0.f, 0.f, 0.f}, 0, 0, 0);
        ub[nt] = make_uint4(pack2(u[0], u[1]), pack2(u[2], u[3]), 0u, 0u);
        f32x4 oa;
#pragma unroll
        for (int e = 0; e < 4; ++e) oa[e] = eG[e] * qsv[nt][e];
        oa = __builtin_amdgcn_mfma_f32_16x16x32_bf16(*(bf16x8*)&pw, *(bf16x8*)&ub[nt], oa, 0, 0, 0);
        if (seg == 1) {
#pragma unroll
          for (int e = 0; e < 4; ++e) {
            const int sidx = ch * 16 + fq * 4 + e;
            const int t = d == 0 ? sidx : 2047 - sidx;
            O4[((size_t)(2 + d) * NLAT + b * 2048 + t) * 512 + h * 128 + vc] = f2bf(oa[e]);
          }
        }
      }
#pragma unroll
      for (int mt = 0; mt < 8; ++mt) {
        __builtin_amdgcn_sched_barrier(0);
        uint2 kv = *(const uint2*)(KdT + (mt * 16 + fr) * 16 + fq * 4);
        uint4 kw = make_uint4(kv.x, kv.y, 0u, 0u);
#pragma unroll
        for (int nt = 0; nt < 2; ++nt) {
#pragma unroll
          for (int e = 0; e < 4; ++e) S[mt][nt][e] *= eGC;
          S[mt][nt] = __builtin_amdgcn_mfma_f32_16x16x32_bf16(*(bf16x8*)&kw, *(bf16x8*)&ub[nt], S[mt][nt], 0, 0, 0);
        }
      }
    }
    HSYNC();
  }
#undef GDN_LOAD
}

DEV void phase_scans(const Params& p, char* smem) {
#pragma unroll 1
  for (int it = VBID; it < 512; it += VNB)
    if (it & 1) rwkv_item(p, it >> 1, smem);
  __builtin_amdgcn_sched_barrier(0);
#pragma unroll 1
  for (int it = VBID; it < 512; it += VNB)
    if (!(it & 1)) gdn_item(p, it >> 1, smem);
}

DEV void mixout_item(const Params& p, int it, char* smem) {
  const u16* P = (const u16*)(p.ws + OFF_BIG);
  const u16* O4 = (const u16*)p.out;
  const float* BS = (const float*)(p.ws + OFF_BSUM);
  const u16* G2T = (const u16*)(p.ws + OFF_G2T);
  u16* Y = (u16*)(p.ws + OFF_HY);
  u16* sg = (u16*)smem;
  u16* G = sg + 32 * 136;
  const int tid = VTID, lane = tid & 63, wave = tid >> 6;
  const int fr = lane & 15, fq = lane >> 4;
  const int tok0 = it * 32, tl0 = tok0 & 2047;
  const int tk = tid >> 3, part = tid & 7;
  const int row = tok0 + tk, t = tl0 + tk;
  const bool hasp = t > 0, hasn = t + 1 < 2048;
  const u16* prow = P + (size_t)row * PS1;
  {
#pragma unroll
    for (int q = 0; q < 2; ++q) {
      const int col = 1792 + part * 16 + q * 8;
      float pc[8], pp[8], pn[8], v[8];
      unpack8(*(const uint4*)(prow + col), pc);
      if (hasp) unpack8(*(const uint4*)(prow - PS1 + col), pp);
      else {
#pragma unroll
        for (int j = 0; j < 8; ++j) pp[j] = 0.f;
      }
      if (hasn) unpack8(*(const uint4*)(prow + PS1 + col), pn);
      else {
#pragma unroll
        for (int j = 0; j < 8; ++j) pn[j] = 0.f;
      }
      const float* mu = p.rw_mu + col;
#pragma unroll
      for (int j = 0; j < 8; ++j) v[j] = sigm(pc[j] + mu[j] * (0.5f * (pp[j] + pn[j]) - pc[j]));
      *(uint4*)(sg + tk * 136 + part * 16 + q * 8) = pack8(v);
    }
  }
  HSYNC();
  {
    bf16x8 af[2][4];
#pragma unroll
    for (int mt = 0; mt < 2; ++mt)
#pragma unroll
      for (int ks = 0; ks < 4; ++ks) af[mt][ks] = *(const bf16x8*)(sg + (mt * 16 + fr) * 136 + ks * 32 + fq * 8);
#pragma unroll
    for (int nt = 0; nt < 8; ++nt) {
      const u16* bp = G2T + (size_t)(wave * 128 + nt * 16 + fr) * 128 + fq * 8;
      bf16x8 bf0 = *(const bf16x8*)(bp), bf1 = *(const bf16x8*)(bp + 32), bf2 = *(const bf16x8*)(bp + 64), bf3 = *(const bf16x8*)(bp + 96);
#pragma unroll
      for (int mt = 0; mt < 2; ++mt) {
        f32x4 a = (f32x4){0.f, 0.f, 0.f, 0.f};
        a = __builtin_amdgcn_mfma_f32_16x16x32_bf16(af[mt][0], bf0, a, 0, 0, 0);
        a = __builtin_amdgcn_mfma_f32_16x16x32_bf16(af[mt][1], bf1, a, 0, 0, 0);
        a = __builtin_amdgcn_mfma_f32_16x16x32_bf16(af[mt][2], bf2, a, 0, 0, 0);
        a = __builtin_amdgcn_mfma_f32_16x16x32_bf16(af[mt][3], bf3, a, 0, 0, 0);
#pragma unroll
        for (int e = 0; e < 4; ++e) G[(mt * 16 + fq * 4 + e) * 520 + wave * 128 + nt * 16 + fr] = f2bf(a[e]);
      }
    }
  }
  HSYNC();
  {
    const int hd = part, c0 = hd * 64;
    const u16* of = O4 + (size_t)row * 512 + c0;
    const u16* ob = O4 + ((size_t)NLAT + row) * 512 + c0;
    const float bsum = BS[(size_t)row * 16 + hd * 2] + BS[(size_t)row * 16 + hd * 2 + 1];
    float s1 = 0.f, s2 = 0.f;
#pragma unroll
    for (int q = 0; q < 8; ++q) {
      float a[8], b8[8];
      unpack8(*(const uint4*)(of + q * 8), a);
      unpack8(*(const uint4*)(ob + q * 8), b8);
#pragma unroll
      for (int j = 0; j < 8; ++j) { const float v = a[j] + b8[j]; s1 += v; s2 += v * v; }
    }
    const float mean = s1 * (1.f / 64.f);
    const float var = fmaxf(s2 * (1.f / 64.f) - mean * mean, 0.f);
    const float rs = rsqrtf(var + 64e-5f);
#pragma unroll
    for (int q = 0; q < 8; ++q) {
      const int c = c0 + q * 8;
      float pc[8], pp[8], pn[8], gv[8], o[8], ya[8], yb[8];
      unpack8(*(const uint4*)(of + q * 8), ya);
      unpack8(*(const uint4*)(ob + q * 8), yb);
      unpack8(*(const uint4*)(prow + 1024 + c), pc);
      if (hasp) unpack8(*(const uint4*)(prow - PS1 + 1024 + c), pp);
      else {
#pragma unroll
        for (int j = 0; j < 8; ++j) pp[j] = 0.f;
      }
      if (hasn) unpack8(*(const uint4*)(prow + PS1 + 1024 + c), pn);
      else {
#pragma unroll
        for (int j = 0; j < 8; ++j) pn[j] = 0.f;
      }
      unpack8(*(const uint4*)(G + tk * 520 + c), gv);
      const float* mu = p.rw_mu + 1024 + c;
      const float* gg = p.rw_lnx_g + c;
      const float* gb = p.rw_lnx_b + c;
#pragma unroll
      for (int j = 0; j < 8; ++j) {
        const float vsh = pc[j] + mu[j] * (0.5f * (pp[j] + pn[j]) - pc[j]);
        const float yn = (ya[j] + yb[j] - mean) * rs * gg[j] + gb[j];
        o[j] = (yn + bsum * vsh) * gv[j];
      }
      *(uint4*)(Y + (size_t)row * 1024 + c) = pack8(o);
    }
  }
  {
    const int c0 = part * 64;
    const u16* of = O4 + ((size_t)2 * NLAT + row) * 512 + c0;
    const u16* ob = O4 + ((size_t)3 * NLAT + row) * 512 + c0;
    float s2 = 0.f;
#pragma unroll
    for (int q = 0; q < 8; ++q) {
      float a[8], b8[8];
      unpack8(*(const uint4*)(of + q * 8), a);
      unpack8(*(const uint4*)(ob + q * 8), b8);
#pragma unroll
      for (int j = 0; j < 8; ++j) { const float v = a[j] + b8[j]; s2 += v * v; }
    }
    s2 += __shfl_xor(s2, 1, 64);
    const float rs = rsqrtf(s2 * (1.f / 128.f) + 1e-6f);
    const u16* zr = prow + DNO + 1536 + c0;
    const float* ng = p.dn_norm_g + (part & 1) * 64;
#pragma unroll
    for (int q = 0; q < 8; ++q) {
      float z[8], r8[8], a[8], b8[8];
      unpack8(*(const uint4*)(of + q * 8), a);
      unpack8(*(const uint4*)(ob + q * 8), b8);
      unpack8(*(const uint4*)(zr + q * 8), z);
#pragma unroll
      for (int j = 0; j < 8; ++j) r8[j] = (a[j] + b8[j]) * rs * ng[q * 8 + j] * silu(z[j]);
      *(uint4*)(Y + (size_t)row * 1024 + 512 + c0 + q * 8) = pack8(r8);
    }
  }
  HSYNC();
}

#define XB_TMO      128
#define XB_XCNT(j)  (256  + 64 * (j))
#define XB_XSUB(j)  (1280 + 64 * (j))
#define XB_XGEN(j)  (2304 + 64 * (j))
#define XB_TOP      3328
#define XB_TOPGEN   3392
#define XCD_BAR_WORDS 3456
#define XB_SPIN_CAP (1u << 20)
DEV unsigned xb_ld(unsigned* p) { return __hip_atomic_load(p, __ATOMIC_RELAXED, __HIP_MEMORY_SCOPE_AGENT); }
DEV unsigned xb_add(unsigned* p, unsigned v) { return __hip_atomic_fetch_add(p, v, __ATOMIC_RELAXED, __HIP_MEMORY_SCOPE_AGENT); }
DEV unsigned xb_xcc_id() { return (unsigned)__builtin_amdgcn_s_getreg((3 << 11) | 20) & 0xFu; }
#define XB_SPIN(cond, bar) do { unsigned _sp = 0; while (cond) { __builtin_amdgcn_s_sleep(1); \
    if ((++_sp & 255u) == 0u) { if (xb_ld(&(bar)[XB_TMO])) break; if (_sp > XB_SPIN_CAP) { atomicAdd(&(bar)[XB_TMO], 1u); break; } } } } while (0)
DEV void xcd_barrier_complete(unsigned* bar, unsigned x, unsigned& nloc, unsigned& nx) {
  const unsigned G = gridDim.x;
  unsigned sum, cnt, mine, sp = 0u;
  for (;;) {
    sum = 0u; cnt = 0u; mine = 0u;
#pragma unroll
    for (unsigned j = 0; j < 16; ++j) { const unsigned c = xb_ld(&bar[XB_XCNT(j)]); sum += c; cnt += (c > 0u) ? 1u : 0u; mine = (j == x) ? c : mine; }
    if (sum == G) break;
    __builtin_amdgcn_s_sleep(1);
    if ((++sp & 255u) == 0u) { if (xb_ld(&bar[XB_TMO])) break; if (sp > XB_SPIN_CAP) { atomicAdd(&bar[XB_TMO], 1u); break; } }
  }
  nloc = mine > 0u ? mine : 1u; nx = cnt > 0u ? cnt : 1u;
}
DEV void xcd_barrier(unsigned* bar) {
  asm volatile("s_waitcnt vmcnt(0)" ::: "memory");
  __syncthreads();
  if (threadIdx.x == 0) {
    __builtin_amdgcn_s_waitcnt(0);
    const unsigned x = xb_xcc_id();
    volatile LAS unsigned* st = (volatile LAS unsigned*)(dyn_smem + HS_OFF + 128);
    unsigned nloc = st[0], nx = st[1];
    if (nloc == 0u) { xcd_barrier_complete(bar, x, nloc, nx); st[0] = nloc; st[1] = nx; }
    const unsigned old = xb_add(&bar[XB_XSUB(x)], 1u);
    const unsigned gen = old / nloc;
    if (old + 1u == (gen + 1u) * nloc) {
      __builtin_amdgcn_fence(__ATOMIC_RELEASE, "agent");
      asm volatile("s_waitcnt vmcnt(0)" ::: "memory");
      const unsigned og = xb_add(&bar[XB_TOP], 1u);
      const unsigned tg = og / nx;
      if (og + 1u == (tg + 1u) * nx) xb_add(&bar[XB_TOPGEN], 1u);
      else XB_SPIN(xb_ld(&bar[XB_TOPGEN]) == tg, bar);
      __builtin_amdgcn_fence(__ATOMIC_ACQUIRE, "agent");
      xb_add(&bar[XB_XGEN(x)], 1u);
      asm volatile("s_waitcnt vmcnt(0)" ::: "memory");
    } else {
      XB_SPIN(xb_ld(&bar[XB_XGEN(x)]) == gen, bar);
      __builtin_amdgcn_fence(__ATOMIC_ACQUIRE, "agent");
      asm volatile("s_waitcnt vmcnt(0)" ::: "memory");
    }
  }
  __syncthreads();
}

constexpr int NPHASE = 18;

__global__ void __launch_bounds__(512, 2) mega(Params p, int ph_lo, int ph_hi) {
  char* smem = dyn_smem + VHALF * HALF_LDS;
  if ((threadIdx.x & 255) == 0) *((LAS unsigned*)(dyn_smem + HS_OFF) + (threadIdx.x >> 8) * 16) = 0u;
  __syncthreads();
  cg::grid_group grid = cg::this_grid();
  const float* mv0 = (const float*)(p.ws + OFF_MODV);
  const float* mv1 = mv0 + 33 * 6144;
  u16* X = (u16*)(p.ws + OFF_X);
  u16* HY = (u16*)(p.ws + OFF_HY);
  u16* BIG = (u16*)(p.ws + OFF_BIG);
  unsigned* bar = (unsigned*)(p.ws + OFF_BAR);
  if (threadIdx.x == 0) {
    volatile LAS unsigned* st = (volatile LAS unsigned*)(dyn_smem + HS_OFF + 128);
    st[0] = 0u; st[1] = 0u;
    (void)xb_add(&bar[XB_XCNT(xb_xcc_id())], 1u);
  }
  if (ph_hi < 0) grid.sync();
#define PHASE(n, BODY) if (ph_lo <= (n) && (n) < ph_hi) { BODY; if ((n) + 1 < ph_hi) xcd_barrier(bar); }
  PHASE(0, phase_prep(p, smem))
  PHASE(1, phase_init(p))
  PHASE(2, gemm_phase<0>(HY, 1024, (const u16*)(p.ws + OFF_WIN0), 1024, NTOK, 2304, BIG, PS0, nullptr, dyn_smem))
  PHASE(3, phase_hyprep_rope(p, smem))
  PHASE(4, phase_conv_attn(p, smem))
  PHASE(5, gemm_phase<2>(HY, 1024, (const u16*)(p.ws + OFF_WOUT0), 1024, NTOK, 1024, X, 1024, mv0 + 2 * 1024, dyn_smem))
  PHASE(6, ln_phase<false>(p, NTOK, p.ln_g, p.ln_b, mv0, 3, 4))
  PHASE(7, gemm_phase<1>(HY, 1024, (const u16*)(p.ws + OFF_W1_0), 1024, NTOK, 4096, BIG, 4096, nullptr, dyn_smem))
  PHASE(8, gemm_phase<2>(BIG, 4096, (const u16*)(p.ws + OFF_W2_0), 4096, NTOK, 1024, X, 1024, mv0 + 5 * 1024, dyn_smem))
  PHASE(9, ln_phase<false>(p, NTOK, p.ln_g + 1024, p.ln_b + 1024, mv1, 0, 1))
  PHASE(10, gemm_phase<0>(HY, 1024, (const u16*)(p.ws + OFF_WIN1), 1024, NTOK, 4096, BIG, PS1, nullptr, dyn_smem))
  PHASE(11, phase_scans(p, smem))
  PHASE(12, for (int it = VBID; it < 2048; it += VNB) mixout_item(p, it, smem))
  PHASE(13, gemm_phase<2>(HY, 1024, (const u16*)(p.ws + OFF_WOUT1), 1024, NLAT, 1024, X, 1024, mv1 + 2 * 1024, dyn_smem))
  PHASE(14, ln_phase<false>(p, NLAT, p.ln_g + 2048, p.ln_b + 2048, mv1, 3, 4))
  PHASE(15, gemm_phase<1>(HY, 1024, (const u16*)(p.ws + OFF_W1_1), 1024, NLAT, 4096, BIG, 4096, nullptr, dyn_smem))
  PHASE(16, gemm_phase<2>(BIG, 4096, (const u16*)(p.ws + OFF_W2_1), 4096, NLAT, 1024, X, 1024, mv1 + 5 * 1024, dyn_smem))
  PHASE(17, ln_phase<true>(p, NLAT, p.ln_g + 3072, p.ln_b + 3072, mv1, 0, 1))
}

extern "C" void kernel_launch(void* const* d_in, const int* in_sizes, int n_in, void* d_out, int out_size, void* d_ws,
                              size_t ws_size, hipStream_t stream) {
  static int grid_blocks = 0;
  if (!grid_blocks) {
    int dev = 0, cus = 0, per_cu = 0;
    hipGetDevice(&dev);
    hipDeviceGetAttribute(&cus, hipDeviceAttributeMultiprocessorCount, dev);
    hipFuncSetAttribute((const void*)mega, hipFuncAttributeMaxDynamicSharedMemorySize, LDS_BYTES);
    hipOccupancyMaxActiveBlocksPerMultiprocessor(&per_cu, mega, 512, LDS_BYTES);
    if (per_cu > 1) per_cu = 1;
    if (per_cu < 1) per_cu = 1;
    grid_blocks = cus * per_cu;
  }
  if (ws_size < WS_NEED) fprintf(stderr, "workspace too small: %zu < %zu\n", ws_size, (size_t)WS_NEED);
  Params p{};
  const float** pp = (const float**)&p;
  for (int i = 0; i < 39; ++i) pp[i] = (const float*)d_in[i];
  p.out = (float*)d_out;
  p.ws = (char*)d_ws;
  int lo = 0, hi = NPHASE;
  void* args[] = {&p, &lo, &hi};
  hipMemsetAsync((char*)d_ws + OFF_BAR, 0, XCD_BAR_WORDS * sizeof(unsigned), stream);
  hipError_t e = hipLaunchCooperativeKernel((void*)mega, dim3(grid_blocks), dim3(512), args, LDS_BYTES, stream);
  if (e != hipSuccess) fprintf(stderr, "cooperative launch failed: %s (grid %d)\n", hipGetErrorString(e), grid_blocks);
}
```

```cpp
#include <hip/hip_runtime.h>
#include <hip/hip_cooperative_groups.h>
#include <cstdio>
#include <cstdint>
namespace cg = cooperative_groups;

typedef unsigned short u16;
typedef __attribute__((ext_vector_type(8))) short bf16x8;
typedef __attribute__((ext_vector_type(4))) float f32x4;
typedef __attribute__((ext_vector_type(16))) float f32x16;

#define DEV __device__ __forceinline__

constexpr int NLAT = 65536, NCTX = 8192, NTOK = 73728;
constexpr int PS0 = 2304;
constexpr int PS1 = 4096;
constexpr int DNO = 1920;
constexpr float ALPHA = 1.4142135623730951f;

constexpr size_t OFF_WIN0 = 0;
constexpr size_t OFF_WOUT0 = OFF_WIN0 + (size_t)2304 * 1024 * 2;
constexpr size_t OFF_W1_0 = OFF_WOUT0 + (size_t)1024 * 1024 * 2;
constexpr size_t OFF_W1_1 = OFF_W1_0 + (size_t)4096 * 1024 * 2;
constexpr size_t OFF_W2_0 = OFF_W1_1 + (size_t)4096 * 1024 * 2;
constexpr size_t OFF_W2_1 = OFF_W2_0 + (size_t)4096 * 1024 * 2;
constexpr size_t OFF_WIN1 = OFF_W2_1 + (size_t)4096 * 1024 * 2;
constexpr size_t OFF_WOUT1 = OFF_WIN1 + (size_t)4096 * 1024 * 2;
constexpr size_t OFF_MODV = OFF_WOUT1 + (size_t)1024 * 1024 * 2;
constexpr size_t OFF_KR2048 = OFF_MODV + (size_t)2 * 33 * 6144 * 4;
constexpr size_t OFF_KR256 = OFF_KR2048 + (size_t)512 * 4096 * 2;
constexpr size_t OFF_ROPE = OFF_KR256 + (size_t)512 * 512 * 2;
constexpr size_t OFF_BSUM = OFF_ROPE + 8192;
constexpr size_t OFF_G2T = OFF_BSUM + (size_t)65536 * 16 * 4;
constexpr size_t OFF_BAR = OFF_G2T + (size_t)512 * 128 * 2;
constexpr size_t OFF_X = (size_t)64 << 20;
constexpr size_t OFF_HY = OFF_X + (size_t)NTOK * 1024 * 2;
constexpr size_t OFF_BIG = OFF_HY + (size_t)NTOK * 1024 * 2;
constexpr size_t WS_NEED = OFF_BIG + (size_t)NTOK * 4096 * 2;
static_assert(OFF_BAR + 16384 <= OFF_X, "ws map");
constexpr size_t SO_U = 0;
constexpr size_t SO_X0 = SO_U + (size_t)512 * 32 * 2048 * 2;
constexpr size_t SO_UC = SO_X0 + (size_t)512 * 32 * 2048 * 2;
constexpr size_t SO_X0C = SO_UC + (size_t)512 * 32 * 256 * 2;

struct Params {
  const float *x, *c, *ctx, *c_ctx, *mod_w, *mod_b, *ln_g, *ln_b, *mlp_w1, *mlp_w2, *e_w_in, *e_w_out, *hy_conv,
      *hy_w1, *hy_b1, *hy_w2, *hy_b2, *hy_freq, *hy_w3, *hy_decay, *hy_bias, *attn_sink, *o_w_in, *o_w_out,
      *rw_mu, *rw_w0, *rw_w2, *rw_a0, *rw_a2, *rw_g2, *rw_kk, *rw_ka, *rw_rk, *rw_lnx_g, *rw_lnx_b,
      *dn_conv, *dn_A_log, *dn_dt_bias, *dn_norm_g;
  float* out;
  char* ws;
};

typedef float f32x2_t __attribute__((ext_vector_type(2)));
typedef __bf16 bf16x2_t __attribute__((ext_vector_type(2)));
DEV u16 f2bf(float f) { return __builtin_bit_cast(u16, (__bf16)f); }
DEV float bf2f(u16 h) { return __uint_as_float(((unsigned)h) << 16); }
DEV float bflo(unsigned u) { return __uint_as_float(u << 16); }
DEV float bfhi(unsigned u) { return __uint_as_float(u & 0xffff0000u); }
DEV unsigned pack2(float a, float b) { f32x2_t v = {a, b}; return __builtin_bit_cast(unsigned, __builtin_convertvector(v, bf16x2_t)); }
DEV void unpack8(const uint4& v, float* f) {
  f[0] = bflo(v.x); f[1] = bfhi(v.x); f[2] = bflo(v.y); f[3] = bfhi(v.y);
  f[4] = bflo(v.z); f[5] = bfhi(v.z); f[6] = bflo(v.w); f[7] = bfhi(v.w);
}
DEV uint4 pack8(const float* f) {
  uint4 v; v.x = pack2(f[0], f[1]); v.y = pack2(f[2], f[3]); v.z = pack2(f[4], f[5]); v.w = pack2(f[6], f[7]); return v;
}
DEV int modrow(int r) { return r < NLAT ? (r >> 11) : 32; }
DEV float sigm(float x) { return __builtin_amdgcn_rcpf(1.f + __expf(-x)); }
DEV float silu(float x) { return x * __builtin_amdgcn_rcpf(1.f + __expf(-x)); }
DEV float softplus(float x) { return fmaxf(x, 0.f) + __logf(1.f + __expf(-fabsf(x))); }
DEV float fast_tanh(float x) { return 1.f - 2.f * __builtin_amdgcn_rcpf(1.f + __expf(2.f * x)); }
DEV float wave_sum(float v) {
#pragma unroll
  for (int o = 32; o > 0; o >>= 1) v += __shfl_xor(v, o, 64);
  return v;
}

extern __shared__ __attribute__((aligned(16))) char dyn_smem[];
#define LAS __attribute__((address_space(3)))
constexpr int HALF_LDS = 65536;
constexpr int HS_OFF = 2 * HALF_LDS + 2048;
constexpr int LDS_BYTES = HS_OFF + 256;
#define VTID ((int)(threadIdx.x & 255))
#define VHALF ((int)__builtin_amdgcn_readfirstlane((int)(threadIdx.x >> 8)))
#define VBID ((int)(blockIdx.x * 2 + VHALF))
#define VNB ((int)(gridDim.x * 2))
DEV void hsync() {
  LAS unsigned* cnt = (LAS unsigned*)(dyn_smem + HS_OFF) + VHALF * 16;
  asm volatile("s_waitcnt vmcnt(0) lgkmcnt(0)" ::: "memory");
  unsigned tgt = 0u;
  if ((threadIdx.x & 63) == 0) {
    const unsigned old = __hip_atomic_fetch_add(cnt, 1u, __ATOMIC_RELAXED, __HIP_MEMORY_SCOPE_WORKGROUP);
    tgt = (old & ~3u) + 4u;
  }
  tgt = __builtin_amdgcn_readfirstlane(tgt);
  while (__hip_atomic_load(cnt, __ATOMIC_RELAXED, __HIP_MEMORY_SCOPE_WORKGROUP) < tgt) __builtin_amdgcn_s_sleep(0);
  asm volatile("s_waitcnt lgkmcnt(0)" ::: "memory");
}
#define HSYNC() hsync()

DEV void transpose_tile(const float* __restrict__ src, int K, int N, int Npad, u16* __restrict__ dst, int tile,
                               u16* sm) {
  const int tid = VTID;
  const int ntn = Npad >> 6;
  const int tk = tile / ntn, tn = tile - tk * ntn;
  const int n = tid & 63, kq = tid >> 6;
  const int gn = tn * 64 + n;
#pragma unroll 4
  for (int i = 0; i < 16; ++i) {
    int k = kq + 4 * i;
    float v = (gn < N) ? src[(size_t)(tk * 64 + k) * N + gn] : 0.f;
    sm[n * 66 + k] = f2bf(v);
  }
  HSYNC();
  const int n2 = tid >> 2, q = tid & 3;
  const unsigned* s32 = (const unsigned*)sm + (n2 * 66 + q * 16) / 2;
  uint4 a, b;
  a.x = s32[0]; a.y = s32[1]; a.z = s32[2]; a.w = s32[3];
  b.x = s32[4]; b.y = s32[5]; b.z = s32[6]; b.w = s32[7];
  u16* d = dst + (size_t)(tn * 64 + n2) * K + tk * 64 + q * 16;
  *(uint4*)d = a;
  *(uint4*)(d + 8) = b;
  HSYNC();
}

DEV void modv_item(const Params& p, int it, float* sl) {
  const int tid = VTID;
  const int l = it / 288, rem = it % 288, cc = rem / 3, rg = rem % 3;
  for (int idx = tid; idx < 11 * 1024; idx += 256) {
    int r = rg * 11 + (idx >> 10), k = idx & 1023;
    float cv = (r < 32) ? p.c[r * 1024 + k] : p.c_ctx[k];
    sl[idx] = cv / (1.f + expf(-cv));
  }
  HSYNC();
  const int cl = tid & 63, kg = tid >> 6;
  const int col = cc * 64 + cl;
  float acc[11];
#pragma unroll
  for (int r = 0; r < 11; ++r) acc[r] = 0.f;
  const float* w = p.mod_w + (size_t)l * 1024 * 6144 + (size_t)(kg * 256) * 6144 + col;
#pragma unroll 8
  for (int k = 0; k < 256; ++k) {
    float wv = w[(size_t)k * 6144];
#pragma unroll
    for (int r = 0; r < 11; ++r) acc[r] += sl[r * 1024 + kg * 256 + k] * wv;
  }
  HSYNC();
  float* red = sl;
#pragma unroll
  for (int r = 0; r < 11; ++r) red[(kg * 11 + r) * 64 + cl] = acc[r];
  HSYNC();
  for (int idx = tid; idx < 11 * 64; idx += 256) {
    int r = idx >> 6, c2 = idx & 63;
    float v = red[(0 * 11 + r) * 64 + c2] + red[(1 * 11 + r) * 64 + c2] + red[(2 * 11 + r) * 64 + c2] + red[(3 * 11 + r) * 64 + c2];
    int gcol = cc * 64 + c2;
    ((float*)(p.ws + OFF_MODV))[(size_t)(l * 33 + rg * 11 + r) * 6144 + gcol] = v + p.mod_b[l * 6144 + gcol];
  }
  HSYNC();
}

DEV void filter_item(const Params& p, int it, float* sm) {
  const int L = it < 2048 ? 2048 : 256;
  const int t = it < 2048 ? it : it - 2048;
  u16* R = (u16*)(p.ws + (L == 2048 ? OFF_KR2048 : OFF_KR256));
  float* pe = sm; float* h1 = sm + 64; float* h2 = sm + 128;
  const int tid = VTID;
  const float tn = (float)t / (float)(L - 1);
  if (tid < 33) {
    float v;
    if (tid == 0) v = tn;
    else {
      int i = (tid - 1) & 15;
      double band = 1e-4 + (double)i * ((15.0 - 1e-4) / 15.0);
      double ang = 2.0 * 3.14159265358979323846 * (double)t * band / (double)L;
      v = (tid <= 16) ? (float)cos(ang) : (float)(-sin(ang));
    }
    pe[tid] = v;
  }
  HSYNC();
  if (tid < 64) {
    float acc = p.hy_b1[tid];
#pragma unroll 11
    for (int i = 0; i < 33; ++i) acc += pe[i] * p.hy_w1[i * 64 + tid];
    h1[tid] = sinf(p.hy_freq[tid] * acc);
  }
  HSYNC();
  if (tid < 64) {
    float acc = p.hy_b2[tid];
#pragma unroll 16
    for (int i = 0; i < 64; ++i) acc += h1[i] * p.hy_w2[i * 64 + tid];
    h2[tid] = sinf(p.hy_freq[tid] * acc);
  }
  HSYNC();
#pragma unroll 1
  for (int q = 0; q < 4; ++q) {
    int o = tid + 256 * q;
    float acc = 0.f;
#pragma unroll 16
    for (int i = 0; i < 64; ++i) acc += h2[i] * p.hy_w3[i * 1024 + o];
    float val = acc * expf(-tn * fabsf(p.hy_decay[o]));
    if (o < 512) {
      if (t == 0) val += p.hy_bias[o];
      R[(size_t)o * 2 * L + L - t] = f2bf(val);
    } else {
      int c = o - 512;
      if (t >= 1) R[(size_t)c * 2 * L + L + t] = f2bf(val);
      else R[(size_t)c * 2 * L] = 0;
    }
  }
  HSYNC();
}

DEV void phase_prep(const Params& p, char* smem) {
  constexpr int T_IN0 = 16 * 36, T_OUT = 16 * 16, T_W = 16 * 64;
  constexpr int E0 = T_IN0, E1 = E0 + T_OUT, E2 = E1 + T_W, E3 = E2 + T_W, E4 = E3 + T_W, E5 = E4 + T_W,
                E6 = E5 + T_W, E7 = E6 + T_OUT, E8 = E7 + 576, E9 = E8 + 2304, E10 = E9 + 1, E11 = E10 + 16;
  for (int it = VBID; it < E11; it += VNB) {
    if (it >= E10) transpose_tile(p.rw_g2, 128, 512, 512, (u16*)(p.ws + OFF_G2T), it - E10, (u16*)smem);
    else if (it < E0) transpose_tile(p.e_w_in, 1024, 2304, 2304, (u16*)(p.ws + OFF_WIN0), it, (u16*)smem);
    else if (it < E1) transpose_tile(p.e_w_out, 1024, 1024, 1024, (u16*)(p.ws + OFF_WOUT0), it - E0, (u16*)smem);
    else if (it < E2) transpose_tile(p.mlp_w1, 1024, 4096, 4096, (u16*)(p.ws + OFF_W1_0), it - E1, (u16*)smem);
    else if (it < E3) transpose_tile(p.mlp_w1 + (size_t)1024 * 4096, 1024, 4096, 4096, (u16*)(p.ws + OFF_W1_1), it - E2, (u16*)smem);
    else if (it < E4) transpose_tile(p.mlp_w2, 4096, 1024, 1024, (u16*)(p.ws + OFF_W2_0), it - E3, (u16*)smem);
    else if (it < E5) transpose_tile(p.mlp_w2 + (size_t)1024 * 4096, 4096, 1024, 1024, (u16*)(p.ws + OFF_W2_1), it - E4, (u16*)smem);
    else if (it < E6) transpose_tile(p.o_w_in, 1024, 3984, 4096, (u16*)(p.ws + OFF_WIN1), it - E5, (u16*)smem);
    else if (it < E7) transpose_tile(p.o_w_out, 1024, 1024, 1024, (u16*)(p.ws + OFF_WOUT1), it - E6, (u16*)smem);
    else if (it < E8) modv_item(p, it - E7, (float*)smem);
    else if (it < E9) filter_item(p, it - E8, (float*)smem);
    else {
      float2* tab = (float2*)(p.ws + OFF_ROPE);
      for (int q = 0; q < 4; ++q) {
        int e = VTID * 4 + q;
        int pos = e >> 4, i = e & 15;
        float inv = powf(10000.f, -(float)i / 16.f);
        float ang = (float)pos * inv;
        tab[e] = make_float2(cosf(ang), sinf(ang));
      }
    }
  }
}

DEV void phase_init(const Params& p) {
  const float* mv = (const float*)(p.ws + OFF_MODV);
  u16* X = (u16*)(p.ws + OFF_X);
  u16* HM = (u16*)(p.ws + OFF_HY);
  const size_t total = (size_t)NTOK * 128;
  for (size_t i = (size_t)VBID * 256 + VTID; i < total; i += (size_t)VNB * 256) {
    int r = (int)(i >> 7), c8 = (int)(i & 127) * 8;
    const float* src = r < NLAT ? p.x + (size_t)r * 1024 + c8 : p.ctx + (size_t)(r - NLAT) * 1024 + c8;
    float4 v0 = *(const float4*)src, v1 = *(const float4*)(src + 4);
    const float* m = mv + (size_t)modrow(r) * 6144 + c8;
    float4 h0 = *(const float4*)m, h1 = *(const float4*)(m + 4);
    float4 s0 = *(const float4*)(m + 1024), s1 = *(const float4*)(m + 1028);
    float f[8] = {v0.x, v0.y, v0.z, v0.w, v1.x, v1.y, v1.z, v1.w};
    float sh[8] = {h0.x, h0.y, h0.z, h0.w, h1.x, h1.y, h1.z, h1.w};
    float sc[8] = {s0.x, s0.y, s0.z, s0.w, s1.x, s1.y, s1.z, s1.w};
    float g[8];
#pragma unroll
    for (int j = 0; j < 8; ++j) g[j] = f[j] * (1.f + sc[j]) + sh[j];
    *(uint4*)(X + (size_t)r * 1024 + c8) = pack8(f);
    *(uint4*)(HM + (size_t)r * 1024 + c8) = pack8(g);
  }
}

template <int EPI>
DEV void gemm_phase(const u16* __restrict__ A, int lda, const u16* __restrict__ Bt, int K, int M, int N,
                    u16* __restrict__ C, int ldc, const float* __restrict__ gate, char* smem) {
  const int tid = threadIdx.x, lane = tid & 63, wave = tid >> 6;
  const int wm = wave >> 2, wn = wave & 3;
  const int fr = lane & 15, fq = lane >> 4;
  const int tn = N >> 8, tm = M >> 8, tiles = tm * tn;
  const int nk = K >> 6;
  const int drow = wave * 8 + (lane >> 3);
  const int dchunk = (lane & 7) ^ ((drow >> 1) & 7);
  const size_t lda64 = (size_t)lda * 64, ldb64 = (size_t)K * 64;
  const int sw = fr >> 1;
  const bool xcd_order = (gridDim.x & 7) == 0 && (tm & 31) == 0;
  const int mx = tm >> 3;
#define G_COORDS(IT, M0, N0)                                                   \
  {                                                                            \
    int tm_i, tn_i;                                                            \
    if (xcd_order) {                                                           \
      const int x = (IT) & 7, local = (IT) >> 3;                               \
      const int mg = local / (4 * tn), r = local - mg * 4 * tn;                \
      tn_i = r >> 2;                                                           \
      tm_i = x * mx + mg * 4 + (r & 3);                                        \
    } else { tm_i = (IT) / tn; tn_i = (IT) - tm_i * tn; }                      \
    M0 = tm_i << 8; N0 = tn_i << 8;                                            \
  }
  int m0 = 0, n0 = 0;
  const u16* ag = A;
  const u16* bg = Bt;
  bool primed = false;
  for (int it = blockIdx.x; it < tiles; it += gridDim.x) {
    if (!primed) {
      G_COORDS(it, m0, n0)
      ag = A + (size_t)(m0 + drow) * lda + dchunk * 8;
      bg = Bt + (size_t)(n0 + drow) * K + dchunk * 8;
    }
    f32x4 acc[8][4];
#pragma unroll
    for (int i = 0; i < 8; ++i)
#pragma unroll
      for (int j = 0; j < 4; ++j) acc[i][j] = (f32x4){0.f, 0.f, 0.f, 0.f};
#define G_ISSUE(KT, ST)                                                                                  \
  {                                                                                                      \
    const u16* a2 = ag + (KT)*64;                                                                        \
    const u16* b2 = bg + (KT)*64;                                                                        \
    char* la = smem + (ST)*65536 + wave * 1024;                                                          \
    _Pragma("unroll") for (int j = 0; j < 4; ++j) {                                                      \
      __builtin_amdgcn_global_load_lds((const unsigned*)(a2 + j * lda64), (unsigned*)(la + j * 8192), 16, 0, 0);          \
      __builtin_amdgcn_global_load_lds((const unsigned*)(b2 + j * ldb64), (unsigned*)(la + 32768 + j * 8192), 16, 0, 0);  \
    }                                                                                                    \
  }
    if (!primed) G_ISSUE(0, 0)
    for (int kt = 0; kt < nk; ++kt) {
      asm volatile("s_waitcnt vmcnt(0)" ::: "memory");
      __syncthreads();
      if (kt + 1 < nk) G_ISSUE(kt + 1, (kt + 1) & 1)
      const u16* As = (const u16*)(smem + (kt & 1) * 65536);
      const u16* Bs = As + 16384;
#define LDA(i, ks) (*(const bf16x8*)(As + (wm * 128 + (i) * 16 + fr) * 64 + ((((ks) * 4 + fq) ^ sw) * 8)))
#define LDB(j, ks) (*(const bf16x8*)(Bs + (wn * 64 + (j) * 16 + fr) * 64 + ((((ks) * 4 + fq) ^ sw) * 8)))
#define SB __builtin_amdgcn_sched_barrier(0)
#define MFMA_H(R, X0, Y0) acc[R][0] = __builtin_amdgcn_mfma_f32_16x16x32_bf16(Y0, X0, acc[R][0], 0, 0, 0);
#define MFMA_T(R, X0, X1, Y0, Y1, Y2, Y3)                                                  \
  acc[R][1] = __builtin_amdgcn_mfma_f32_16x16x32_bf16(Y1, X0, acc[R][1], 0, 0, 0);         \
  acc[R][2] = __builtin_amdgcn_mfma_f32_16x16x32_bf16(Y2, X0, acc[R][2], 0, 0, 0);         \
  acc[R][3] = __builtin_amdgcn_mfma_f32_16x16x32_bf16(Y3, X0, acc[R][3], 0, 0, 0);         \
  acc[R + 1][0] = __builtin_amdgcn_mfma_f32_16x16x32_bf16(Y0, X1, acc[R + 1][0], 0, 0, 0); \
  acc[R + 1][1] = __builtin_amdgcn_mfma_f32_16x16x32_bf16(Y1, X1, acc[R + 1][1], 0, 0, 0); \
  acc[R + 1][2] = __builtin_amdgcn_mfma_f32_16x16x32_bf16(Y2, X1, acc[R + 1][2], 0, 0, 0); \
  acc[R + 1][3] = __builtin_amdgcn_mfma_f32_16x16x32_bf16(Y3, X1, acc[R + 1][3], 0, 0, 0);
      {
        bf16x8 b0 = LDB(0, 0), b1 = LDB(1, 0), b2 = LDB(2, 0), b3 = LDB(3, 0);
        bf16x8 a0 = LDA(0, 0), a1 = LDA(1, 0);
        bf16x8 n0, n1, c0, c1, c2, c3;
        SB; MFMA_H(0, a0, b0) SB; n0 = LDA(2, 0); n1 = LDA(3, 0); SB; MFMA_T(0, a0, a1, b0, b1, b2, b3) SB;
        MFMA_H(2, n0, b0) SB; a0 = LDA(4, 0); a1 = LDA(5, 0); SB; MFMA_T(2, n0, n1, b0, b1, b2, b3) SB;
        MFMA_H(4, a0, b0) SB; n0 = LDA(6, 0); n1 = LDA(7, 0); SB; MFMA_T(4, a0, a1, b0, b1, b2, b3) SB;
        MFMA_H(6, n0, b0) SB;
        c0 = LDB(0, 1); c1 = LDB(1, 1); c2 = LDB(2, 1); c3 = LDB(3, 1); a0 = LDA(0, 1); a1 = LDA(1, 1);
        SB; MFMA_T(6, n0, n1, b0, b1, b2, b3) SB;
        MFMA_H(0, a0, c0) SB; n0 = LDA(2, 1); n1 = LDA(3, 1); SB; MFMA_T(0, a0, a1, c0, c1, c2, c3) SB;
        MFMA_H(2, n0, c0) SB; a0 = LDA(4, 1); a1 = LDA(5, 1); SB; MFMA_T(2, n0, n1, c0, c1, c2, c3) SB;
        MFMA_H(4, a0, c0) SB; n0 = LDA(6, 1); n1 = LDA(7, 1); SB; MFMA_T(4, a0, a1, c0, c1, c2, c3) SB;
        MFMA_H(6, n0, c0) MFMA_T(6, n0, n1, c0, c1, c2, c3) SB;
      }
#undef LDA
#undef LDB
#undef SB
#undef MFMA_H
#undef MFMA_T
    }
    const int cm0 = m0, cn0 = n0;
    primed = false;
    if (it + (int)gridDim.x < tiles) {
      G_COORDS(it + (int)gridDim.x, m0, n0)
      ag = A + (size_t)(m0 + drow) * lda + dchunk * 8;
      bg = Bt + (size_t)(n0 + drow) * K + dchunk * 8;
      G_ISSUE(0, 0)
      primed = true;
    }
    u16* Cs = (u16*)(smem + 65536);
#pragma unroll 1
    for (int hp = 0; hp < 2; ++hp) {
      asm volatile("s_waitcnt lgkmcnt(0)" ::: "memory");
      __builtin_amdgcn_s_barrier();
      asm volatile("" ::: "memory");
      if (wm == hp) {
#pragma unroll
        for (int i = 0; i < 8; ++i)
#pragma unroll
          for (int j = 0; j < 4; ++j) {
            float v0 = acc[i][j][0], v1 = acc[i][j][1], v2 = acc[i][j][2], v3 = acc[i][j][3];
            if (EPI == 1) {
              v0 = fmaxf(v0, 0.f); v1 = fmaxf(v1, 0.f); v2 = fmaxf(v2, 0.f); v3 = fmaxf(v3, 0.f);
              v0 *= v0; v1 *= v1; v2 *= v2; v3 *= v3;
            }
            *(uint2*)(Cs + (i * 16 + fr) * 264 + wn * 64 + j * 16 + fq * 4) = make_uint2(pack2(v0, v1), pack2(v2, v3));
          }
      }
      asm volatile("s_waitcnt lgkmcnt(0)" ::: "memory");
      __builtin_amdgcn_s_barrier();
      asm volatile("" ::: "memory");
#pragma unroll 2
      for (int q = 0; q < 8; ++q) {
        const int chunk = tid + q * 512;
        const int row = chunk >> 5, cc = chunk & 31;
        uint4 cv = *(const uint4*)(Cs + row * 264 + cc * 8);
        const int grow = cm0 + hp * 128 + row;
        u16* dst = C + (size_t)grow * ldc + cn0 + cc * 8;
        if (EPI == 2) {
          float a[8], xo[8], y[8];
          unpack8(cv, a);
          unpack8(*(const uint4*)dst, xo);
          const float* gr = gate + (size_t)modrow(grow) * 6144 + cn0 + cc * 8;
          float4 g0 = *(const float4*)gr, g1 = *(const float4*)(gr + 4);
          float gg[8] = {g0.x, g0.y, g0.z, g0.w, g1.x, g1.y, g1.z, g1.w};
#pragma unroll
          for (int j = 0; j < 8; ++j) y[j] = ALPHA * xo[j] + gg[j] * a[j];
          cv = pack8(y);
        }
        *(uint4*)dst = cv;
      }
    }
    asm volatile("s_waitcnt lgkmcnt(0)" ::: "memory");
    __builtin_amdgcn_s_barrier();
    asm volatile("" ::: "memory");
  }
#undef G_ISSUE
#undef G_COORDS
}

template <bool FINAL>
DEV void ln_phase(const Params& p, int M, const float* __restrict__ g, const float* __restrict__ b,
                         const float* __restrict__ modl  , int shi, int sci) {
  u16* X = (u16*)(p.ws + OFF_X);
  u16* HM = (u16*)(p.ws + OFF_HY);
  const int lane = VTID & 63;
  const int gw = VBID * 4 + (VTID >> 6), nw = VNB * 4;
  uint4 nx0 = make_uint4(0u, 0u, 0u, 0u), nx1 = nx0;
  if (gw < M) {
    nx0 = *(const uint4*)(X + (size_t)gw * 1024 + lane * 8);
    nx1 = *(const uint4*)(X + (size_t)gw * 1024 + 512 + lane * 8);
  }
  for (int row = gw; row < M; row += nw) {
    u16* xr = X + (size_t)row * 1024;
    float f[16];
    unpack8(nx0, f);
    unpack8(nx1, f + 8);
    if (row + nw < M) {
      nx0 = *(const uint4*)(xr + (size_t)nw * 1024 + lane * 8);
      nx1 = *(const uint4*)(xr + (size_t)nw * 1024 + 512 + lane * 8);
    }
    float s = 0.f, q = 0.f;
#pragma unroll
    for (int j = 0; j < 16; ++j) { s += f[j]; q += f[j] * f[j]; }
#pragma unroll
    for (int o = 32; o > 0; o >>= 1) { s += __shfl_xor(s, o, 64); q += __shfl_xor(q, o, 64); }
    const float mu = s * (1.f / 1024.f);
    const float rs = rsqrtf(fmaxf(q * (1.f / 1024.f) - mu * mu, 0.f) + 1e-5f);
#pragma unroll
    for (int j = 0; j < 16; ++j) f[j] -= mu;
#pragma unroll
    for (int hh = 0; hh < 2; ++hh) {
      const int c0 = hh * 512 + lane * 8;
      float y[8];
#pragma unroll
      for (int j = 0; j < 8; ++j) y[j] = f[hh * 8 + j] * rs * g[c0 + j] + b[c0 + j];
      if (FINAL) {
        float* o = p.out + (size_t)row * 1024 + c0;
        *(float4*)o = make_float4(y[0], y[1], y[2], y[3]);
        *(float4*)(o + 4) = make_float4(y[4], y[5], y[6], y[7]);
      } else {
        *(uint4*)(xr + c0) = pack8(y);
        const float* m = modl + (size_t)modrow(row) * 6144;
        float h[8];
#pragma unroll
        for (int j = 0; j < 8; ++j) h[j] = y[j] * (1.f + m[sci * 1024 + c0 + j]) + m[shi * 1024 + c0 + j];
        *(uint4*)(HM + (size_t)row * 1024 + c0) = pack8(h);
      }
    }
  }
}

DEV void hyprep_item(const Params& p, int it, char* smem) {
  u16* su = (u16*)smem;
  u16* sx = su + 64 * 66;
  const u16* P = (const u16*)(p.ws + OFF_BIG);
  const int tid = VTID;
  const int ct = it & 7, st = it >> 3;
  int b, t0, L, rowbase;
  u16 *U, *X0;
  if (st < 1024) { b = st >> 5; t0 = (st & 31) * 64; L = 2048; rowbase = b * 2048;
    U = (u16*)((char*)p.out + SO_U); X0 = (u16*)((char*)p.out + SO_X0); }
  else { int s2 = st - 1024; b = s2 >> 2; t0 = (s2 & 3) * 64; L = 256; rowbase = NLAT + b * 256;
    U = (u16*)((char*)p.out + SO_UC); X0 = (u16*)((char*)p.out + SO_X0C); }
  const int c0 = ct * 64;
  {
    const int t = tid >> 2, cq = tid & 3;
    float z[3][16];
#pragma unroll
    for (int g = 0; g < 3; ++g)
#pragma unroll
      for (int j = 0; j < 16; ++j) z[g][j] = 0.f;
#pragma unroll
    for (int tap = 0; tap < 3; ++tap) {
      const int tt = t0 + t + tap - 1;
      if (tt >= 0 && tt < L) {
#pragma unroll
        for (int g = 0; g < 3; ++g) {
          const int col = g * 512 + c0 + cq * 16;
          const u16* src = P + (size_t)(rowbase + tt) * PS0 + col;
          float f[16];
          unpack8(*(const uint4*)src, f);
          unpack8(*(const uint4*)(src + 8), f + 8);
          const float* w = p.hy_conv + tap * 1536 + col;
#pragma unroll
          for (int j = 0; j < 16; ++j) z[g][j] += f[j] * w[j];
        }
      }
    }
#pragma unroll
    for (int j = 0; j < 16; ++j) {
      su[t * 66 + cq * 16 + j] = f2bf(z[1][j] * z[2][j]);
      sx[t * 66 + cq * 16 + j] = f2bf(z[0][j]);
    }
  }
  HSYNC();
  {
    const int c = tid >> 2, tq = tid & 3;
    unsigned wu[8], wx[8];
#pragma unroll
    for (int j = 0; j < 8; ++j) {
      wu[j] = (unsigned)su[(tq * 16 + 2 * j) * 66 + c] | ((unsigned)su[(tq * 16 + 2 * j + 1) * 66 + c] << 16);
      wx[j] = (unsigned)sx[(tq * 16 + 2 * j) * 66 + c] | ((unsigned)sx[(tq * 16 + 2 * j + 1) * 66 + c] << 16);
    }
    const size_t o = ((size_t)(c0 + c) * 32 + b) * L + t0 + tq * 16;
    *(uint4*)(U + o) = make_uint4(wu[0], wu[1], wu[2], wu[3]);
    *(uint4*)(U + o + 8) = make_uint4(wu[4], wu[5], wu[6], wu[7]);
    *(uint4*)(X0 + o) = make_uint4(wx[0], wx[1], wx[2], wx[3]);
    *(uint4*)(X0 + o + 8) = make_uint4(wx[4], wx[5], wx[6], wx[7]);
  }
  HSYNC();
}

DEV void rope_item(const Params& p, int it) {
  u16* P = (u16*)(p.ws + OFF_BIG);
  const float2* tab = (const float2*)(p.ws + OFF_ROPE);
  const int task = it * 256 + VTID;
  const int row = task / 40, rem = task - row * 40;
  const int head = rem >> 2, pr = rem & 3;
  const int d0 = (pr >> 1) * 32 + (pr & 1) * 8;
  const int t = row & 2047;
  const int posc = (pr >> 1) ? (t & 63) : (t >> 6);
  const int fi0 = (pr & 1) * 8;
  u16* ptr = P + (size_t)row * PS0 + 1536 + head * 64 + d0;
  float u1[8], u2[8], o1[8], o2[8];
  unpack8(*(const uint4*)ptr, u1);
  unpack8(*(const uint4*)(ptr + 16), u2);
#pragma unroll
  for (int j = 0; j < 8; ++j) {
    float2 cs = tab[posc * 16 + fi0 + j];
    o1[j] = u1[j] * cs.x - u2[j] * cs.y;
    o2[j] = u1[j] * cs.y + u2[j] * cs.x;
  }
  *(uint4*)ptr = pack8(o1);
  *(uint4*)(ptr + 16) = pack8(o2);
}

DEV void phase_hyprep_rope(const Params& p, char* smem) {
  constexpr int NH = 9216, NR = 10240;
  for (int it = VBID; it < NH + NR; it += VNB) {
    if (it < NH) hyprep_item(p, it, smem);
    else rope_item(p, it - NH);
  }
}

template <int L, int NT>
DEV void conv_item(const Params& p, int c, int th, char* smem) {
  const u16* R = (const u16*)(p.ws + (L == 2048 ? OFF_KR2048 : OFF_KR256)) + (size_t)c * 2 * L;
  const u16* U = (const u16*)((const char*)p.out + (L == 2048 ? SO_U : SO_UC));
  const u16* X0 = (const u16*)((const char*)p.out + (L == 2048 ? SO_X0 : SO_X0C));
  u16* Y = (u16*)(p.ws + OFF_HY);
  u16* Rs0 = (u16*)smem;
  u16* Rs1 = Rs0 + 2 * L + 8;
  const int tid = VTID, lane = tid & 63, wave = tid >> 6;
  for (int i = tid; i < 2 * L; i += 256) {
    Rs0[i] = R[i];
    Rs1[i] = (i + 1 < 2 * L) ? R[i + 1] : (u16)0;
  }
  HSYNC();
  const int r = lane & 31, h = lane >> 5;
  const char* lanebase = (r & 1) ? (const char*)Rs1 + 2 * (8 * h - r + L - 1) : (const char*)Rs0 + 2 * (8 * h - r + L);
  const int tw0 = th * 1024 + wave * NT * 32;
  f32x16 acc[NT];
#pragma unroll
  for (int i = 0; i < NT; ++i)
#pragma unroll
    for (int e = 0; e < 16; ++e) acc[i][e] = 0.f;
  u16* UC = Rs1 + 2 * L + 8;
  const u16* Ug = U + (size_t)c * 32 * L;
  const u16* ug0 = Ug + (size_t)(tid >> 5) * L + (tid & 31) * 8;
  u16* uc0 = UC + (tid >> 5) * 264 + (tid & 31) * 8;
  uint4 stg0 = *(const uint4*)(ug0), stg1 = *(const uint4*)(ug0 + (size_t)8 * L);
  uint4 stg2 = *(const uint4*)(ug0 + (size_t)16 * L), stg3 = *(const uint4*)(ug0 + (size_t)24 * L);
  for (int chk = 0; chk < L / 256; ++chk) {
    HSYNC();
    *(uint4*)(uc0) = stg0; *(uint4*)(uc0 + 8 * 264) = stg1; *(uint4*)(uc0 + 16 * 264) = stg2; *(uint4*)(uc0 + 24 * 264) = stg3;
    HSYNC();
    if (chk + 1 < L / 256) {
      const u16* un = ug0 + (chk + 1) * 256;
      stg0 = *(const uint4*)(un); stg1 = *(const uint4*)(un + (size_t)8 * L);
      stg2 = *(const uint4*)(un + (size_t)16 * L); stg3 = *(const uint4*)(un + (size_t)24 * L);
    }
#pragma unroll 4
    for (int s2 = 0; s2 < 16; ++s2) {
      const int st = chk * 16 + s2;
      bf16x8 bfrag = *(const bf16x8*)(UC + r * 264 + s2 * 16 + 8 * h);
#pragma unroll
      for (int i = 0; i < NT; ++i) {
        const unsigned* ap = (const unsigned*)(lanebase + 2 * (st * 16 - (tw0 + i * 32)));
        uint4 av = make_uint4(ap[0], ap[1], ap[2], ap[3]);
        acc[i] = __builtin_amdgcn_mfma_f32_32x32x16_bf16(*(bf16x8*)&av, bfrag, acc[i], 0, 0, 0);
      }
    }
  }
  const int rowbase = (L == 2048) ? r * 2048 : NLAT + r * 256;
#pragma unroll
  for (int i = 0; i < NT; ++i) {
#pragma unroll
    for (int g4 = 0; g4 < 4; ++g4) {
      const int tt = tw0 + i * 32 + 8 * g4 + 4 * h;
      uint2 xv = *(const uint2*)(X0 + ((size_t)c * 32 + r) * L + tt);
      float x0[4] = {bflo(xv.x), bfhi(xv.x), bflo(xv.y), bfhi(xv.y)};
#pragma unroll
      for (int e = 0; e < 4; ++e) Y[(size_t)(rowbase + tt + e) * 1024 + c] = f2bf(acc[i][g4 * 4 + e] * x0[e]);
    }
  }
  HSYNC();
}

DEV void attn_item(const Params& p, int b, int hq, int qb, bool isctx, char* smem) {
  const u16* P = (const u16*)(p.ws + OFF_BIG);
  u16* Y = (u16*)(p.ws + OFF_HY);
  u16* Ks = (u16*)smem;
  u16* Vt = Ks + 64 * 72;
  const int tid = VTID, lane = tid & 63, wave = tid >> 6;
  const int nq = lane & 15, quad = lane >> 4;
  const int qrow = (isctx ? NLAT + b * 256 : b * 2048) + qb * 64 + wave * 16 + nq;
  const int qpos = qb * 64 + wave * 16 + nq;
  const int hkv = hq >> 2;
  const int kcol = 2048 + hkv * 64, vcol = 2176 + hkv * 64;
  bf16x8 qf[2];
#pragma unroll
  for (int ks = 0; ks < 2; ++ks)
    qf[ks] = *(const bf16x8*)(P + (size_t)qrow * PS0 + 1536 + hq * 64 + ks * 32 + quad * 8);
  float m = p.attn_sink[hq];
  float lsum = (quad == 0) ? 1.f : 0.f;
  f32x4 oacc[4];
#pragma unroll
  for (int n = 0; n < 4; ++n) oacc[n] = (f32x4){0.f, 0.f, 0.f, 0.f};
  const int nloc = isctx ? 0 : 5;
  for (int ti = 0; ti < nloc + 4; ++ti) {
    int krow0, k0 = 0;
    bool masked;
    if (ti < nloc) {
      k0 = qb * 64 - 128 + ti * 64;
      if (k0 < 0 || k0 >= 2048) continue;
      krow0 = b * 2048 + k0; masked = true;
    } else { krow0 = NLAT + b * 256 + (ti - nloc) * 64; masked = false; }
    HSYNC();
    {
      const int key = tid >> 2, part = tid & 3;
      const u16* kp = P + (size_t)(krow0 + key) * PS0 + kcol + part * 16;
      const u16* vp = P + (size_t)(krow0 + key) * PS0 + vcol + part * 16;
      uint4 k0v = *(const uint4*)kp, k1v = *(const uint4*)(kp + 8);
      uint4 v0v = *(const uint4*)vp, v1v = *(const uint4*)(vp + 8);
      *(uint4*)(Ks + key * 72 + part * 16) = k0v;
      *(uint4*)(Ks + key * 72 + part * 16 + 8) = k1v;
      unsigned vw[8] = {v0v.x, v0v.y, v0v.z, v0v.w, v1v.x, v1v.y, v1v.z, v1v.w};
#pragma unroll
      for (int j = 0; j < 8; ++j) {
        Vt[(part * 16 + 2 * j) * 72 + key] = (u16)(vw[j] & 0xffffu);
        Vt[(part * 16 + 2 * j + 1) * 72 + key] = (u16)(vw[j] >> 16);
      }
    }
    HSYNC();
    f32x4 s[4];
#pragma unroll
    for (int n = 0; n < 4; ++n) {
      s[n] = (f32x4){0.f, 0.f, 0.f, 0.f};
#pragma unroll
      for (int ks = 0; ks < 2; ++ks) {
        bf16x8 kf = *(const bf16x8*)(Ks + (n * 16 + nq) * 72 + ks * 32 + quad * 8);
        s[n] = __builtin_amdgcn_mfma_f32_16x16x32_bf16(kf, qf[ks], s[n], 0, 0, 0);
      }
    }
    float mx = -1e30f;
#pragma unroll
    for (int n = 0; n < 4; ++n)
#pragma unroll
      for (int e = 0; e < 4; ++e) {
        float v = s[n][e] * 0.125f;
        if (masked) {
          int kpos = k0 + n * 16 + quad * 4 + e;
          int d = qpos - kpos;
          if (d > 128 || d < -128) v = -1e30f;
        }
        s[n][e] = v;
        mx = fmaxf(mx, v);
      }
    mx = fmaxf(mx, __shfl_xor(mx, 16, 64));
    mx = fmaxf(mx, __shfl_xor(mx, 32, 64));
    const float mn = fmaxf(m, mx);
    const float al = __expf(m - mn);
    m = mn;
    float ps = 0.f;
#pragma unroll
    for (int n = 0; n < 4; ++n)
#pragma unroll
      for (int e = 0; e < 4; ++e) { float pv = __expf(s[n][e] - mn); s[n][e] = pv; ps += pv; }
    lsum = lsum * al + ps;
#pragma unroll
    for (int n = 0; n < 4; ++n)
#pragma unroll
      for (int e = 0; e < 4; ++e) oacc[n][e] *= al;
#pragma unroll
    for (int hh = 0; hh < 2; ++hh) {
      uint4 pw;
      pw.x = pack2(s[2 * hh][0], s[2 * hh][1]); pw.y = pack2(s[2 * hh][2], s[2 * hh][3]);
      pw.z = pack2(s[2 * hh + 1][0], s[2 * hh + 1][1]); pw.w = pack2(s[2 * hh + 1][2], s[2 * hh + 1][3]);
      bf16x8 pb = *(bf16x8*)&pw;
#pragma unroll
      for (int n = 0; n < 4; ++n) {
        const u16* vr = Vt + (n * 16 + nq) * 72 + quad * 4;
        uint2 va = *(const uint2*)(vr + (2 * hh) * 16);
        uint2 vb = *(const uint2*)(vr + (2 * hh + 1) * 16);
        uint4 vv = make_uint4(va.x, va.y, vb.x, vb.y);
        oacc[n] = __builtin_amdgcn_mfma_f32_16x16x32_bf16(*(bf16x8*)&vv, pb, oacc[n], 0, 0, 0);
      }
    }
  }
  lsum += __shfl_xor(lsum, 16, 64);
  lsum += __shfl_xor(lsum, 32, 64);
  const float inv = 1.f / lsum;
  u16* yo = Y + (size_t)qrow * 1024 + 512 + hq * 64 + quad * 4;
#pragma unroll
  for (int n = 0; n < 4; ++n) {
    uint2 w;
    w.x = pack2(oacc[n][0] * inv, oacc[n][1] * inv);
    w.y = pack2(oacc[n][2] * inv, oacc[n][3] * inv);
    *(uint2*)(yo + n * 16) = w;
  }
  HSYNC();
}

DEV void phase_conv_attn(const Params& p, char* smem) {
  constexpr int N0 = 1024, N1 = N0 + 512, N2 = N1 + 8192, N3 = N2 + 1024;
#pragma unroll 1
  for (int it = VBID; it < N0; it += VNB) conv_item<2048, 8>(p, it >> 1, it & 1, smem);
  __builtin_amdgcn_sched_barrier(0);
#pragma unroll 1
  for (int it = VBID; it < N3; it += VNB) {
    if (it < N0) continue;
    if (it < N1) conv_item<256, 2>(p, it - N0, 0, smem);
  }
  __builtin_amdgcn_sched_barrier(0);
#pragma unroll 1
  for (int it = VBID; it < N3; it += VNB) {
    if (it < N1) continue;
    if (it < N2) { int a = it - N1; attn_item(p, a >> 8, (a >> 5) & 7, a & 31, false, smem); }
    else { int a = it - N2; attn_item(p, a >> 5, (a >> 2) & 7, a & 3, true, smem); }
  }
}

DEV void lds_wave_sync() {
  asm volatile("s_waitcnt lgkmcnt(0)" ::: "memory");
  __builtin_amdgcn_wave_barrier();
}

DEV void rwkv_item(const Params& p, int ri, char* smem) {
  const u16* P = (const u16*)(p.ws + OFF_BIG);
  u16* O4 = (u16*)p.out;
  float* BS = (float*)(p.ws + OFF_BSUM);
  const int tid0 = VTID;
  const int wp0 = tid0 >> 7;
  const int cid = ri * 2 + wp0;
  const int b = cid >> 4, d = (cid >> 3) & 1, h = cid & 7;
  f32x4 S[4][2];
#pragma unroll
  for (int i = 0; i < 4; ++i)
#pragma unroll
    for (int j = 0; j < 2; ++j) S[i][j] = (f32x4){0.f, 0.f, 0.f, 0.f};
  uint4 bw[2][4];
  float l0[4];
  {
    const int lane = tid0 & 63, wi = (tid0 >> 6) & 1, fr = lane & 15, fq = lane >> 4;
    const float* wsrc = (wi == 0 ? p.rw_w2 : p.rw_a2) + (size_t)d * 64 * 512 + h * 64;
    const float* bsrc = (wi == 0 ? p.rw_w0 : p.rw_a0) + d * 512 + h * 64;
#pragma unroll
    for (int nt = 0; nt < 4; ++nt) {
      l0[nt] = bsrc[nt * 16 + fr];
#pragma unroll
      for (int ks = 0; ks < 2; ++ks) {
        __builtin_amdgcn_sched_barrier(0);
        float f[8];
        const float* wp_ = wsrc + (size_t)(ks * 32 + fq * 8) * 512 + nt * 16 + fr;
#pragma unroll
        for (int j = 0; j < 8; ++j) f[j] = wp_[j * 512];
        bw[ks][nt] = pack8(f);
      }
    }
  }
  uint4 pre[5][3];
#define RW_LOAD(CI)                                                                                 \
  {                                                                                                 \
    const int seg_ = (CI) < 16 ? 0 : 1;                                                             \
    const int ch_ = seg_ ? (CI)-16 : (CI);                                                          \
    const int Ls_ = seg_ ? 2048 : 256;                                                              \
    const int rb_ = seg_ ? b * 2048 : NLAT + b * 256;                                               \
    const int sidx_ = ch_ * 16 + stt;                                                               \
    const int t_ = d == 0 ? sidx_ : Ls_ - 1 - sidx_;                                                \
    const u16* prow_ = P + (size_t)(rb_ + t_) * PS1 + spart * 8;                                    \
    _Pragma("unroll") for (int g = 0; g < 5; ++g) {                                                 \
      const int col_ = g < 3 ? g * 512 + h * 64 : (g == 3 ? 1536 + d * 64 : 1664 + d * 64);         \
      _Pragma("unroll") for (int tap = 0; tap < 3; ++tap) {                                         \
        const int tt_ = t_ + tap - 1;                                                               \
        if (tt_ >= 0 && tt_ < Ls_) pre[g][tap] = *(const uint4*)(prow_ + (ptrdiff_t)(tap - 1) * PS1 + col_); \
        else pre[g][tap] = make_uint4(0u, 0u, 0u, 0u);                                              \
      }                                                                                             \
    }                                                                                               \
  }
  {
    const int pt = tid0 & 127, stt = pt >> 3, spart = pt & 7;
    RW_LOAD(0)
  }
  for (int cidx = 0; cidx < 144; ++cidx) {
    asm volatile("" ::: "memory");
    int tid = tid0;
    asm volatile("" : "+v"(tid));
    const int lane = tid & 63, wave = tid >> 6, wp = wave >> 1, wi = wave & 1, pt = tid & 127;
    const int fr = lane & 15, fq = lane >> 4, stt = pt >> 3, spart = pt & 7;
    const int seg = cidx < 16 ? 0 : 1;
    const int ch = seg ? cidx - 16 : cidx;
    const int Ls = seg ? 2048 : 256;
    char* base = smem + wp * 32768;
    u16* RK = (u16*)base;
    u16* KD = RK + 1152;
    u16* KK = KD + 1152;
    u16* AB = KK + 1152;
    u16* VT = AB + 1152;
    float* LW = (float*)(base + 11264);
    u16* TW = (u16*)(base + 15360);
    u16* AD = TW + 1152;
    u16* BgCT = (u16*)(base + 19968);
    u16* KgCT = BgCT + 1024;
    float* gC = (float*)(base + 24064);
    float* Amat = (float*)(base + 24320) + wi * 256;
    u16* Tinv = (u16*)(base + 26368) + wi * 256;
    u16* BG = (u16*)(base + 27392);
    {
      const int o = stt * 72 + spart * 8;
#pragma unroll
      for (int g = 0; g < 5; ++g) {
        __builtin_amdgcn_sched_barrier(0);
        const int col = g < 3 ? g * 512 + h * 64 : (g == 3 ? 1536 + d * 64 : 1664 + d * 64);
        float pc[8], pp[8], pn[8], v[8];
        unpack8(pre[g][1], pc); unpack8(pre[g][0], pp); unpack8(pre[g][2], pn);
        const float* mu = p.rw_mu + col + spart * 8;
        float4 m0 = *(const float4*)mu, m1 = *(const float4*)(mu + 4);
        const float mm[8] = {m0.x, m0.y, m0.z, m0.w, m1.x, m1.y, m1.z, m1.w};
#pragma unroll
        for (int j = 0; j < 8; ++j) v[j] = pc[j] + mm[j] * (0.5f * (pp[j] + pn[j]) - pc[j]);
        if (g == 0) *(uint4*)(RK + o) = pack8(v);
        else if (g == 1) {
          *(uint4*)(KD + o) = pack8(v);
          const float* kkw = p.rw_kk + h * 64 + spart * 8;
          float kkv[8];
          float ss = 0.f;
#pragma unroll
          for (int j = 0; j < 8; ++j) { kkv[j] = v[j] * kkw[j]; ss += kkv[j] * kkv[j]; }
          ss += __shfl_xor(ss, 1, 64); ss += __shfl_xor(ss, 2, 64); ss += __shfl_xor(ss, 4, 64);
          const float inv = rsqrtf(ss + 1e-6f);
#pragma unroll
          for (int j = 0; j < 8; ++j) kkv[j] *= inv;
          *(uint4*)(KK + o) = pack8(kkv);
        } else if (g == 2) {
#pragma unroll
          for (int j = 0; j < 8; ++j) VT[(spart * 8 + j) * 16 + stt] = f2bf(v[j]);
        } else if (g == 3) {
#pragma unroll
          for (int j = 0; j < 8; ++j) v[j] = fast_tanh(v[j]);
          *(uint4*)(TW + o) = pack8(v);
        } else *(uint4*)(AD + o) = pack8(v);
      }
    }
    HSYNC();
    if (cidx + 1 < 144) RW_LOAD(cidx + 1)
    {
      const u16* IN = wi == 0 ? TW : AD;
      bf16x8 af0 = *(const bf16x8*)(IN + fr * 72 + fq * 8);
      bf16x8 af1 = *(const bf16x8*)(IN + fr * 72 + 32 + fq * 8);
#pragma unroll
      for (int nt = 0; nt < 4; ++nt) {
        f32x4 o4 = (f32x4){0.f, 0.f, 0.f, 0.f};
        o4 = __builtin_amdgcn_mfma_f32_16x16x32_bf16(af0, *(bf16x8*)&bw[0][nt], o4, 0, 0, 0);
        o4 = __builtin_amdgcn_mfma_f32_16x16x32_bf16(af1, *(bf16x8*)&bw[1][nt], o4, 0, 0, 0);
#pragma unroll
        for (int e = 0; e < 4; ++e) {
          const float prev = l0[nt] + o4[e];
          const int t = fq * 4 + e, c = nt * 16 + fr;
          if (wi == 0) LW[t * 64 + c] = -__expf(-softplus(-prev) - 0.5f);
          else AB[t * 72 + c] = f2bf(sigm(prev));
        }
      }
    }
    HSYNC();
    {
      const int c = lane;
      float cum = 0.f;
      if (wi == 0) {
#pragma unroll 4
        for (int t = 0; t < 16; ++t) {
          const float lw = LW[t * 64 + c];
          const float gp = __expf(cum);
          cum += lw;
          const float gi = __expf(-cum);
          const float kk = bf2f(KK[t * 72 + c]);
          const float a = bf2f(AB[t * 72 + c]);
          KK[t * 72 + c] = f2bf(kk * gp);
          BG[t * 72 + c] = f2bf(kk * a * gi);
        }
        const float gCv = __expf(cum);
        gC[c] = gCv;
#pragma unroll 4
        for (int t = 0; t < 16; ++t) BgCT[c * 16 + t] = f2bf(-bf2f(BG[t * 72 + c]) * gCv);
      } else {
        float* PR = (float*)TW;
        const float kac = p.rw_ka[h * 64 + c], rkc = p.rw_rk[h * 64 + c];
#pragma unroll 4
        for (int t = 0; t < 16; ++t) {
          const float lw = LW[t * 64 + c];
          cum += lw;
          const float g = __expf(cum), gi = __expf(-cum);
          const float r = bf2f(RK[t * 72 + c]);
          const float k = bf2f(KD[t * 72 + c]);
          const float a = bf2f(AB[t * 72 + c]);
          const float kd = k * (1.f + (a - 1.f) * kac);
          RK[t * 72 + c] = f2bf(r * g);
          KD[t * 72 + c] = f2bf(kd * gi);
          PR[t * 64 + c] = r * kd * rkc;
        }
        const float gCv = __expf(cum);
#pragma unroll 4
        for (int t = 0; t < 16; ++t) KgCT[c * 16 + t] = f2bf(bf2f(KD[t * 72 + c]) * gCv);
        lds_wave_sync();
        {
          const int t = lane >> 2, sg = lane & 3;
          const float4 q0 = *(const float4*)(PR + t * 64 + sg * 16), q1 = *(const float4*)(PR + t * 64 + sg * 16 + 4);
          const float4 q2 = *(const float4*)(PR + t * 64 + sg * 16 + 8), q3 = *(const float4*)(PR + t * 64 + sg * 16 + 12);
          float bsum = (q0.x + q0.y + q0.z + q0.w) + (q1.x + q1.y + q1.z + q1.w) + (q2.x + q2.y + q2.z + q2.w) + (q3.x + q3.y + q3.z + q3.w);
          bsum += __shfl_xor(bsum, 1, 64);
          bsum += __shfl_xor(bsum, 2, 64);
          if (seg == 1 && sg == 0) {
            const int sidx = ch * 16 + t;
            const int tpos = d == 0 ? sidx : 2047 - sidx;
            BS[(size_t)(b * 2048 + tpos) * 16 + h * 2 + d] = bsum;
          }
        }
      }
    }
    HSYNC();
    __builtin_amdgcn_sched_barrier(0);
    {
      f32x4 XabT = (f32x4){0.f, 0.f, 0.f, 0.f}, XakT = XabT, XrbT = XabT, XrkT = XabT;
#pragma unroll
      for (int ks = 0; ks < 2; ++ks) {
        bf16x8 kkf = *(const bf16x8*)(KK + fr * 72 + ks * 32 + fq * 8);
        bf16x8 rgf = *(const bf16x8*)(RK + fr * 72 + ks * 32 + fq * 8);
        bf16x8 bgf = *(const bf16x8*)(BG + fr * 72 + ks * 32 + fq * 8);
        bf16x8 kgf = *(const bf16x8*)(KD + fr * 72 + ks * 32 + fq * 8);
        XabT = __builtin_amdgcn_mfma_f32_16x16x32_bf16(bgf, kkf, XabT, 0, 0, 0);
        XakT = __builtin_amdgcn_mfma_f32_16x16x32_bf16(kgf, kkf, XakT, 0, 0, 0);
        XrbT = __builtin_amdgcn_mfma_f32_16x16x32_bf16(bgf, rgf, XrbT, 0, 0, 0);
        XrkT = __builtin_amdgcn_mfma_f32_16x16x32_bf16(kgf, rgf, XrkT, 0, 0, 0);
      }
      {
        float am[4];
#pragma unroll
        for (int e = 0; e < 4; ++e) am[e] = (fq * 4 + e < fr) ? XabT[e] : 0.f;
        *(float4*)(Amat + fr * 16 + fq * 4) = make_float4(am[0], am[1], am[2], am[3]);
      }
      lds_wave_sync();
      if (lane < 16) {
        float x[16];
        x[0] = (lane == 0) ? 1.f : 0.f;
        float4 cur[4], nxt[4];
        cur[0] = *(const float4*)(Amat + 16);
        cur[1] = cur[0]; cur[2] = cur[0]; cur[3] = cur[0];
#pragma unroll
        for (int i = 1; i < 16; ++i) {
          __builtin_amdgcn_sched_barrier(0);
          if (i + 1 < 16) {
#pragma unroll
            for (int q = 0; q < (i + 4) / 4; ++q) nxt[q] = *(const float4*)(Amat + (i + 1) * 16 + q * 4);
          }
          float acc = (i == lane) ? 1.f : 0.f;
#pragma unroll
          for (int j = 0; j < i; ++j) {
            const float4 rv = cur[j >> 2];
            const float av = (j & 3) == 0 ? rv.x : ((j & 3) == 1 ? rv.y : ((j & 3) == 2 ? rv.z : rv.w));
            acc -= av * x[j];
          }
          x[i] = acc;
#pragma unroll
          for (int q = 0; q < 4; ++q) cur[q] = nxt[q];
        }
#pragma unroll
        for (int i = 0; i < 16; ++i) Tinv[i * 16 + lane] = f2bf(x[i]);
      }
      lds_wave_sync();
      f32x4 sa0[2], y0[2];
#pragma unroll
      for (int nt = 0; nt < 2; ++nt) { sa0[nt] = (f32x4){0.f, 0.f, 0.f, 0.f}; y0[nt] = (f32x4){0.f, 0.f, 0.f, 0.f}; }
#pragma unroll
      for (int x = 0; x < 2; ++x) {
        __builtin_amdgcn_sched_barrier(0);
        uint2 k0 = *(const uint2*)(KK + fr * 72 + 32 * x + fq * 4);
        uint2 k1 = *(const uint2*)(KK + fr * 72 + 32 * x + 16 + fq * 4);
        uint2 r0 = *(const uint2*)(RK + fr * 72 + 32 * x + fq * 4);
        uint2 r1 = *(const uint2*)(RK + fr * 72 + 32 * x + 16 + fq * 4);
        uint4 kw = make_uint4(k0.x, k0.y, k1.x, k1.y);
        uint4 rw = make_uint4(r0.x, r0.y, r1.x, r1.y);
#pragma unroll
        for (int nt = 0; nt < 2; ++nt) {
          uint4 sw;
          sw.x = pack2(S[2 * x][nt][0], S[2 * x][nt][1]); sw.y = pack2(S[2 * x][nt][2], S[2 * x][nt][3]);
          sw.z = pack2(S[2 * x + 1][nt][0], S[2 * x + 1][nt][1]); sw.w = pack2(S[2 * x + 1][nt][2], S[2 * x + 1][nt][3]);
          sa0[nt] = __builtin_amdgcn_mfma_f32_16x16x32_bf16(*(bf16x8*)&kw, *(bf16x8*)&sw, sa0[nt], 0, 0, 0);
          y0[nt] = __builtin_amdgcn_mfma_f32_16x16x32_bf16(*(bf16x8*)&rw, *(bf16x8*)&sw, y0[nt], 0, 0, 0);
        }
      }
      float ak[4], rb[4], rk[4];
#pragma unroll
      for (int e = 0; e < 4; ++e) {
        const int j = fq * 4 + e;
        ak[e] = (j < fr) ? XakT[e] : 0.f;
        rb[e] = (j <= fr) ? -XrbT[e] : 0.f;
        rk[e] = (j <= fr) ? XrkT[e] : 0.f;
      }
      const uint4 akw = make_uint4(pack2(ak[0], ak[1]), pack2(ak[2], ak[3]), 0u, 0u);
      const uint4 ybw = make_uint4(pack2(rb[0], rb[1]), pack2(rb[2], rb[3]), pack2(rk[0], rk[1]), pack2(rk[2], rk[3]));
      const uint2 tv = *(const uint2*)(Tinv + fr * 16 + fq * 4);
      const uint4 tw = make_uint4(tv.x, tv.y, 0u, 0u);
      uint4 sv[2];
#pragma unroll
      for (int nt = 0; nt < 2; ++nt) {
        const int vc = wi * 32 + nt * 16 + fr;
        const uint2 vt = *(const uint2*)(VT + vc * 16 + fq * 4);
        const uint4 vb = make_uint4(vt.x, vt.y, 0u, 0u);
        f32x4 rhs = __builtin_amdgcn_mfma_f32_16x16x32_bf16(*(bf16x8*)&akw, *(bf16x8*)&vb, sa0[nt], 0, 0, 0);
        const uint4 rw = make_uint4(pack2(rhs[0], rhs[1]), pack2(rhs[2], rhs[3]), 0u, 0u);
        f32x4 sa = __builtin_amdgcn_mfma_f32_16x16x32_bf16(*(bf16x8*)&tw, *(bf16x8*)&rw, (f32x4){0.f, 0.f, 0.f, 0.f}, 0, 0, 0);
        sv[nt] = make_uint4(pack2(sa[0], sa[1]), pack2(sa[2], sa[3]), vt.x, vt.y);
        f32x4 y = __builtin_amdgcn_mfma_f32_16x16x32_bf16(*(bf16x8*)&ybw, *(bf16x8*)&sv[nt], y0[nt], 0, 0, 0);
        if (seg == 1) {
#pragma unroll
          for (int e = 0; e < 4; ++e) {
            const int sidx = ch * 16 + fq * 4 + e;
            const int tpos = d == 0 ? sidx : 2047 - sidx;
            O4[((size_t)d * NLAT + b * 2048 + tpos) * 512 + h * 64 + vc] = f2bf(y[e]);
          }
        }
      }
#pragma unroll
      for (int mt = 0; mt < 4; ++mt) {
        __builtin_amdgcn_sched_barrier(0);
        const float4 g4 = *(const float4*)(gC + mt * 16 + fq * 4);
        const uint2 bv = *(const uint2*)(BgCT + (mt * 16 + fr) * 16 + fq * 4);
        const uint2 kv = *(const uint2*)(KgCT + (mt * 16 + fr) * 16 + fq * 4);
        const uint4 aw = make_uint4(bv.x, bv.y, kv.x, kv.y);
#pragma unroll
        for (int nt = 0; nt < 2; ++nt) {
          S[mt][nt][0] *= g4.x; S[mt][nt][1] *= g4.y; S[mt][nt][2] *= g4.z; S[mt][nt][3] *= g4.w;
          S[mt][nt] = __builtin_amdgcn_mfma_f32_16x16x32_bf16(*(bf16x8*)&aw, *(bf16x8*)&sv[nt], S[mt][nt], 0, 0, 0);
        }
      }
    }
    HSYNC();
  }
#undef RW_LOAD
}

DEV void gdn_item(const Params& p, int gi, char* smem) {
  const u16* P = (const u16*)(p.ws + OFF_BIG);
  u16* O4 = (u16*)p.out;
  const int tid0 = VTID;
  const int b = gi >> 3, d = (gi >> 2) & 1, h = gi & 3;
  constexpr int BUFB = 23424;
  f32x4 S[8][2];
#pragma unroll
  for (int i = 0; i < 8; ++i)
#pragma unroll
    for (int j = 0; j < 2; ++j) S[i][j] = (f32x4){0.f, 0.f, 0.f, 0.f};
  const float negA = -__expf(p.dn_A_log[d * 4 + h]);
  const float dtb = p.dn_dt_bias[d * 4 + h];
  uint4 pre[3][3];
  float gpre0 = 0.f, gpre1 = 0.f;
#define GDN_LOAD(CI)                                                                               \
  {                                                                                                \
    const int seg_ = (CI) < 16 ? 0 : 1;                                                            \
    const int ch_ = seg_ ? (CI)-16 : (CI);                                                         \
    const int Ls_ = seg_ ? 2048 : 256;                                                             \
    const int rb_ = seg_ ? b * 2048 : NLAT + b * 256;                                              \
    const int sidx_ = ch_ * 16 + stt;                                                              \
    const int t_ = d == 0 ? sidx_ : Ls_ - 1 - sidx_;                                               \
    const u16* prow_ = P + (size_t)(rb_ + t_) * PS1 + DNO;                                         \
    _Pragma("unroll") for (int g = 0; g < 3; ++g) {                                                \
      const int col_ = g * 512 + h * 128 + spart * 8;                                              \
      _Pragma("unroll") for (int tap = 0; tap < 3; ++tap) {                                        \
        const int tt_ = t_ + tap - 1;                                                              \
        if (tt_ >= 0 && tt_ < Ls_) pre[g][tap] = *(const uint4*)(prow_ + (ptrdiff_t)(tap - 1) * PS1 + col_); \
        else pre[g][tap] = make_uint4(0u, 0u, 0u, 0u);                                             \
      }                                                                                            \
    }                                                                                              \
    if (wave == 0) {                                                                               \
      const int s2_ = ch_ * 16 + fr;                                                               \
      const int t2_ = d == 0 ? s2_ : Ls_ - 1 - s2_;                                                \
      const u16* gr_ = P + (size_t)(rb_ + t2_) * PS1 + DNO + 2048;                                 \
      gpre0 = bf2f(gr_[d * 4 + h]);                                                                \
      gpre1 = bf2f(gr_[8 + d * 4 + h]);                                                            \
    }                                                                                              \
  }
  {
    const int tid = tid0, lane = tid & 63, wave = tid >> 6, fr = lane & 15, stt = tid >> 4, spart = tid & 15;
    GDN_LOAD(0)
  }
  for (int cidx = 0; cidx < 144; ++cidx) {
    asm volatile("" ::: "memory");
    int tid = tid0;
    asm volatile("" : "+v"(tid));
    const int lane = tid & 63, wave = tid >> 6, fr = lane & 15, fq = lane >> 4, stt = tid >> 4, spart = tid & 15;
    char* buf = smem;
    u16* Kb = (u16*)buf;
    u16* Qb = Kb + 16 * 136;
    float* Vf = (float*)(buf + 8704);
    u16* KdT = (u16*)(buf + 17152);
    u16* Tinv = (u16*)(buf + 21248);
    u16* Pm = (u16*)(buf + 21760);
    float* Amat = (float*)(buf + 22272);
    float* Gs = (float*)(buf + 23296);
    float* Bs = Gs + 16;
#pragma unroll
    for (int g = 0; g < 3; ++g) {
      __builtin_amdgcn_sched_barrier(0);
      const int col = g * 512 + h * 128 + spart * 8;
      float z[8];
#pragma unroll
      for (int j = 0; j < 8; ++j) z[j] = 0.f;
#pragma unroll
      for (int tap = 0; tap < 3; ++tap) {
        __builtin_amdgcn_sched_barrier(0);
        float f[8];
        unpack8(pre[g][tap], f);
        const float* w = p.dn_conv + tap * 1536 + col;
        float4 w0 = *(const float4*)w, w1 = *(const float4*)(w + 4);
        z[0] += f[0] * w0.x; z[1] += f[1] * w0.y; z[2] += f[2] * w0.z; z[3] += f[3] * w0.w;
        z[4] += f[4] * w1.x; z[5] += f[5] * w1.y; z[6] += f[6] * w1.z; z[7] += f[7] * w1.w;
      }
      float ss = 0.f;
#pragma unroll
      for (int j = 0; j < 8; ++j) { z[j] = silu(z[j]); ss += z[j] * z[j]; }
      if (g < 2) {
        ss += __shfl_xor(ss, 1, 64); ss += __shfl_xor(ss, 2, 64); ss += __shfl_xor(ss, 4, 64); ss += __shfl_xor(ss, 8, 64);
        float sc = rsqrtf(ss + 1e-6f);
        if (g == 0) sc *= 0.08838834764831845f;
#pragma unroll
        for (int j = 0; j < 8; ++j) z[j] *= sc;
        *(uint4*)((g == 0 ? Qb : Kb) + stt * 136 + spart * 8) = pack8(z);
      } else {
        float* dst = Vf + stt * 132 + spart * 8;
        *(float4*)dst = make_float4(z[0], z[1], z[2], z[3]);
        *(float4*)(dst + 4) = make_float4(z[4], z[5], z[6], z[7]);
      }
    }
    if (wave == 0) {
      float g = negA * softplus(gpre0 + dtb);
#pragma unroll
      for (int o = 1; o < 16; o <<= 1) { float n = __shfl_up(g, o, 16); if (fr >= o) g += n; }
      if (lane < 16) { Gs[lane] = g; Bs[lane] = sigm(gpre1); }
    }
    HSYNC();
    if (wave == 0) {
      f32x4 kk = (f32x4){0.f, 0.f, 0.f, 0.f};
#pragma unroll
      for (int ks = 0; ks < 4; ++ks) {
        bf16x8 kf = *(const bf16x8*)(Kb + fr * 136 + ks * 32 + fq * 8);
        kk = __builtin_amdgcn_mfma_f32_16x16x32_bf16(kf, kf, kk, 0, 0, 0);
      }
      const float Gj = Gs[fr];
#pragma unroll
      for (int e = 0; e < 4; ++e) {
        const int i = fq * 4 + e;
        const float a = (fr < i) ? Bs[i] * kk[e] * __expf(Gs[i] - Gj) : 0.f;
        Amat[i * 16 + fr] = a;
      }
      lds_wave_sync();
      if (lane < 16) {
        float x[16];
        x[0] = (lane == 0) ? 1.f : 0.f;
        float4 cur[4], nxt[4];
        cur[0] = *(const float4*)(Amat + 16);
        cur[1] = cur[0]; cur[2] = cur[0]; cur[3] = cur[0];
#pragma unroll
        for (int i = 1; i < 16; ++i) {
          __builtin_amdgcn_sched_barrier(0);
          if (i + 1 < 16) {
#pragma unroll
            for (int q = 0; q < (i + 4) / 4; ++q) nxt[q] = *(const float4*)(Amat + (i + 1) * 16 + q * 4);
          }
          float acc = (i == lane) ? 1.f : 0.f;
#pragma unroll
          for (int j = 0; j < i; ++j) {
            const float4 rv = cur[j >> 2];
            const float av = (j & 3) == 0 ? rv.x : ((j & 3) == 1 ? rv.y : ((j & 3) == 2 ? rv.z : rv.w));
            acc -= av * x[j];
          }
          x[i] = acc;
#pragma unroll
          for (int q = 0; q < 4; ++q) cur[q] = nxt[q];
        }
#pragma unroll
        for (int i = 0; i < 16; ++i) Tinv[i * 16 + lane] = f2bf(x[i]);
      }
    } else if (wave == 1) {
      f32x4 qk = (f32x4){0.f, 0.f, 0.f, 0.f};
#pragma unroll
      for (int ks = 0; ks < 4; ++ks) {
        bf16x8 qf = *(const bf16x8*)(Qb + fr * 136 + ks * 32 + fq * 8);
        bf16x8 kf = *(const bf16x8*)(Kb + fr * 136 + ks * 32 + fq * 8);
        qk = __builtin_amdgcn_mfma_f32_16x16x32_bf16(qf, kf, qk, 0, 0, 0);
      }
      const float Gj = Gs[fr];
#pragma unroll
      for (int e = 0; e < 4; ++e) {
        const int t = fq * 4 + e;
        const float v = (fr <= t) ? qk[e] * __expf(Gs[t] - Gj) : 0.f;
        Pm[t * 16 + fr] = f2bf(v);
      }
    } else {
      const int k = tid - 128;
      const float GC = Gs[15];
      unsigned w[8];
#pragma unroll
      for (int j = 0; j < 8; ++j) {
        __builtin_amdgcn_sched_barrier(0);
        float v0 = bf2f(Kb[(2 * j) * 136 + k]) * __expf(GC - Gs[2 * j]);
        float v1 = bf2f(Kb[(2 * j + 1) * 136 + k]) * __expf(GC - Gs[2 * j + 1]);
        w[j] = pack2(v0, v1);
      }
      *(uint4*)(KdT + k * 16) = make_uint4(w[0], w[1], w[2], w[3]);
      *(uint4*)(KdT + k * 16 + 8) = make_uint4(w[4], w[5], w[6], w[7]);
    }
    __builtin_amdgcn_sched_barrier(0);
    f32x4 ksv[2], qsv[2];
#pragma unroll
    for (int nt = 0; nt < 2; ++nt) { ksv[nt] = (f32x4){0.f, 0.f, 0.f, 0.f}; qsv[nt] = (f32x4){0.f, 0.f, 0.f, 0.f}; }
#pragma unroll
    for (int x = 0; x < 4; ++x) {
      __builtin_amdgcn_sched_barrier(0);
      uint2 k0 = *(const uint2*)(Kb + fr * 136 + 32 * x + fq * 4);
      uint2 k1 = *(const uint2*)(Kb + fr * 136 + 32 * x + 16 + fq * 4);
      uint2 q0 = *(const uint2*)(Qb + fr * 136 + 32 * x + fq * 4);
      uint2 q1 = *(const uint2*)(Qb + fr * 136 + 32 * x + 16 + fq * 4);
      uint4 kw = make_uint4(k0.x, k0.y, k1.x, k1.y);
      uint4 qw = make_uint4(q0.x, q0.y, q1.x, q1.y);
#pragma unroll
      for (int nt = 0; nt < 2; ++nt) {
        uint4 sw;
        sw.x = pack2(S[2 * x][nt][0], S[2 * x][nt][1]); sw.y = pack2(S[2 * x][nt][2], S[2 * x][nt][3]);
        sw.z = pack2(S[2 * x + 1][nt][0], S[2 * x + 1][nt][1]); sw.w = pack2(S[2 * x + 1][nt][2], S[2 * x + 1][nt][3]);
        ksv[nt] = __builtin_amdgcn_mfma_f32_16x16x32_bf16(*(bf16x8*)&kw, *(bf16x8*)&sw, ksv[nt], 0, 0, 0);
        qsv[nt] = __builtin_amdgcn_mfma_f32_16x16x32_bf16(*(bf16x8*)&qw, *(bf16x8*)&sw, qsv[nt], 0, 0, 0);
      }
    }
    HSYNC();
    if (cidx + 1 < 144) GDN_LOAD(cidx + 1)
    __builtin_amdgcn_sched_barrier(0);
    {
      const int seg = cidx < 16 ? 0 : 1;
      const int ch = seg ? cidx - 16 : cidx;
      float eG[4], bt[4];
#pragma unroll
      for (int e = 0; e < 4; ++e) { eG[e] = __expf(Gs[fq * 4 + e]); bt[e] = Bs[fq * 4 + e]; }
      const float eGC = __expf(Gs[15]);
      uint2 tv = *(const uint2*)(Tinv + fr * 16 + fq * 4);
      uint2 pv = *(const uint2*)(Pm + fr * 16 + fq * 4);
      uint4 tw = make_uint4(tv.x, tv.y, 0u, 0u);
      uint4 pw = make_uint4(pv.x, pv.y, 0u, 0u);
      uint4 ub[2];
#pragma unroll
      for (int nt = 0; nt < 2; ++nt) {
        const int vc = wave * 32 + nt * 16 + fr;
        float rhs[4];
#pragma unroll
        for (int e = 0; e < 4; ++e) rhs[e] = bt[e] * (Vf[(fq * 4 + e) * 132 + vc] - eG[e] * ksv[nt][e]);
        uint4 rw = make_uint4(pack2(rhs[0], rhs[1]), pack2(rhs[2], rhs[3]), 0u, 0u);
        f32x4 u = __builtin_amdgcn_mfma_f32_16x16x32_bf16(*(bf16x8*)&tw, *(bf16x8*)&rw, (f32x4){0.f, 0.f, 0.f, 0.f}, 0, 0, 0);
        ub[nt] = make_uint4(pack2(u[0], u[1]), pack2(u[2], u[3]), 0u, 0u);
        f32x4 oa;
#pragma unroll
        for (int e = 0; e < 4; ++e) oa[e] = eG[e] * qsv[nt][e];
        oa = __builtin_amdgcn_mfma_f32_16x16x32_bf16(*(bf16x8*)&pw, *(bf16x8*)&ub[nt], oa, 0, 0, 0);
        if (seg == 1) {
#pragma unroll
          for (int e = 0; e < 4; ++e) {
            const int sidx = ch * 16 + fq * 4 + e;
            const int t = d == 0 ? sidx : 2047 - sidx;
            O4[((size_t)(2 + d) * NLAT + b * 2048 + t) * 512 + h * 128 + vc] = f2bf(oa[e]);
          }
        }
      }
#pragma unroll
      for (int mt = 0; mt < 8; ++mt) {
        __builtin_amdgcn_sched_barrier(0);
        uint2 kv = *(const uint2*)(KdT + (mt * 16 + fr) * 16 + fq * 4);
        uint4 kw = make_uint4(kv.x, kv.y, 0u, 0u);
#pragma unroll
        for (int nt = 0; nt < 2; ++nt) {
#pragma unroll
          for (int e = 0; e < 4; ++e) S[mt][nt][e] *= eGC;
          S[mt][nt] = __builtin_amdgcn_mfma_f32_16x16x32_bf16(*(bf16x8*)&kw, *(bf16x8*)&ub[nt], S[mt][nt], 0, 0, 0);
        }
      }
    }
    HSYNC();
  }
#undef GDN_LOAD
}

DEV void phase_scans(const Params& p, char* smem) {
#pragma unroll 1
  for (int it = VBID; it < 512; it += VNB)
    if (it & 1) rwkv_item(p, it >> 1, smem);
  __builtin_amdgcn_sched_barrier(0);
#pragma unroll 1
  for (int it = VBID; it < 512; it += VNB)
    if (!(it & 1)) gdn_item(p, it >> 1, smem);
}

DEV void mixout_item(const Params& p, int it, char* smem) {
  const u16* P = (const u16*)(p.ws + OFF_BIG);
  const u16* O4 = (const u16*)p.out;
  const float* BS = (const float*)(p.ws + OFF_BSUM);
  const u16* G2T = (const u16*)(p.ws + OFF_G2T);
  u16* Y = (u16*)(p.ws + OFF_HY);
  u16* sg = (u16*)smem;
  u16* G = sg + 32 * 136;
  const int tid = VTID, lane = tid & 63, wave = tid >> 6;
  const int fr = lane & 15, fq = lane >> 4;
  const int tok0 = it * 32, tl0 = tok0 & 2047;
  const int tk = tid >> 3, part = tid & 7;
  const int row = tok0 + tk, t = tl0 + tk;
  const bool hasp = t > 0, hasn = t + 1 < 2048;
  const u16* prow = P + (size_t)row * PS1;
  {
#pragma unroll
    for (int q = 0; q < 2; ++q) {
      const int col = 1792 + part * 16 + q * 8;
      float pc[8], pp[8], pn[8], v[8];
      unpack8(*(const uint4*)(prow + col), pc);
      if (hasp) unpack8(*(const uint4*)(prow - PS1 + col), pp);
      else {
#pragma unroll
        for (int j = 0; j < 8; ++j) pp[j] = 0.f;
      }
      if (hasn) unpack8(*(const uint4*)(prow + PS1 + col), pn);
      else {
#pragma unroll
        for (int j = 0; j < 8; ++j) pn[j] = 0.f;
      }
      const float* mu = p.rw_mu + col;
#pragma unroll
      for (int j = 0; j < 8; ++j) v[j] = sigm(pc[j] + mu[j] * (0.5f * (pp[j] + pn[j]) - pc[j]));
      *(uint4*)(sg + tk * 136 + part * 16 + q * 8) = pack8(v);
    }
  }
  HSYNC();
  {
    bf16x8 af[2][4];
#pragma unroll
    for (int mt = 0; mt < 2; ++mt)
#pragma unroll
      for (int ks = 0; ks < 4; ++ks) af[mt][ks] = *(const bf16x8*)(sg + (mt * 16 + fr) * 136 + ks * 32 + fq * 8);
#pragma unroll
    for (int nt = 0; nt < 8; ++nt) {
      const u16* bp = G2T + (size_t)(wave * 128 + nt * 16 + fr) * 128 + fq * 8;
      bf16x8 bf0 = *(const bf16x8*)(bp), bf1 = *(const bf16x8*)(bp + 32), bf2 = *(const bf16x8*)(bp + 64), bf3 = *(const bf16x8*)(bp + 96);
#pragma unroll
      for (int mt = 0; mt < 2; ++mt) {
        f32x4 a = (f32x4){0.f, 0.f, 0.f, 0.f};
        a = __builtin_amdgcn_mfma_f32_16x16x32_bf16(af[mt][0], bf0, a, 0, 0, 0);
        a = __builtin_amdgcn_mfma_f32_16x16x32_bf16(af[mt][1], bf1, a, 0, 0, 0);
        a = __builtin_amdgcn_mfma_f32_16x16x32_bf16(af[mt][2], bf2, a, 0, 0, 0);
        a = __builtin_amdgcn_mfma_f32_16x16x32_bf16(af[mt][3], bf3, a, 0, 0, 0);
#pragma unroll
        for (int e = 0; e < 4; ++e) G[(mt * 16 + fq * 4 + e) * 520 + wave * 128 + nt * 16 + fr] = f2bf(a[e]);
      }
    }
  }
  HSYNC();
  {
    const int hd = part, c0 = hd * 64;
    const u16* of = O4 + (size_t)row * 512 + c0;
    const u16* ob = O4 + ((size_t)NLAT + row) * 512 + c0;
    const float bsum = BS[(size_t)row * 16 + hd * 2] + BS[(size_t)row * 16 + hd * 2 + 1];
    float s1 = 0.f, s2 = 0.f;
#pragma unroll
    for (int q = 0; q < 8; ++q) {
      float a[8], b8[8];
      unpack8(*(const uint4*)(of + q * 8), a);
      unpack8(*(const uint4*)(ob + q * 8), b8);
#pragma unroll
      for (int j = 0; j < 8; ++j) { const float v = a[j] + b8[j]; s1 += v; s2 += v * v; }
    }
    const float mean = s1 * (1.f / 64.f);
    const float var = fmaxf(s2 * (1.f / 64.f) - mean * mean, 0.f);
    const float rs = rsqrtf(var + 64e-5f);
#pragma unroll
    for (int q = 0; q < 8; ++q) {
      const int c = c0 + q * 8;
      float pc[8], pp[8], pn[8], gv[8], o[8], ya[8], yb[8];
      unpack8(*(const uint4*)(of + q * 8), ya);
      unpack8(*(const uint4*)(ob + q * 8), yb);
      unpack8(*(const uint4*)(prow + 1024 + c), pc);
      if (hasp) unpack8(*(const uint4*)(prow - PS1 + 1024 + c), pp);
      else {
#pragma unroll
        for (int j = 0; j < 8; ++j) pp[j] = 0.f;
      }
      if (hasn) unpack8(*(const uint4*)(prow + PS1 + 1024 + c), pn);
      else {
#pragma unroll
        for (int j = 0; j < 8; ++j) pn[j] = 0.f;
      }
      unpack8(*(const uint4*)(G + tk * 520 + c), gv);
      const float* mu = p.rw_mu + 1024 + c;
      const float* gg = p.rw_lnx_g + c;
      const float* gb = p.rw_lnx_b + c;
#pragma unroll
      for (int j = 0; j < 8; ++j) {
        const float vsh = pc[j] + mu[j] * (0.5f * (pp[j] + pn[j]) - pc[j]);
        const float yn = (ya[j] + yb[j] - mean) * rs * gg[j] + gb[j];
        o[j] = (yn + bsum * vsh) * gv[j];
      }
      *(uint4*)(Y + (size_t)row * 1024 + c) = pack8(o);
    }
  }
  {
    const int c0 = part * 64;
    const u16* of = O4 + ((size_t)2 * NLAT + row) * 512 + c0;
    const u16* ob = O4 + ((size_t)3 * NLAT + row) * 512 + c0;
    float s2 = 0.f;
#pragma unroll
    for (int q = 0; q < 8; ++q) {
      float a[8], b8[8];
      unpack8(*(const uint4*)(of + q * 8), a);
      unpack8(*(const uint4*)(ob + q * 8), b8);
#pragma unroll
      for (int j = 0; j < 8; ++j) { const float v = a[j] + b8[j]; s2 += v * v; }
    }
    s2 += __shfl_xor(s2, 1, 64);
    const float rs = rsqrtf(s2 * (1.f / 128.f) + 1e-6f);
    const u16* zr = prow + DNO + 1536 + c0;
    const float* ng = p.dn_norm_g + (part & 1) * 64;
#pragma unroll
    for (int q = 0; q < 8; ++q) {
      float z[8], r8[8], a[8], b8[8];
      unpack8(*(const uint4*)(of + q * 8), a);
      unpack8(*(const uint4*)(ob + q * 8), b8);
      unpack8(*(const uint4*)(zr + q * 8), z);
#pragma unroll
      for (int j = 0; j < 8; ++j) r8[j] = (a[j] + b8[j]) * rs * ng[q * 8 + j] * silu(z[j]);
      *(uint4*)(Y + (size_t)row * 1024 + 512 + c0 + q * 8) = pack8(r8);
    }
  }
  HSYNC();
}

#define XB_TMO      128
#define XB_XCNT(j)  (256  + 64 * (j))
#define XB_XSUB(j)  (1280 + 64 * (j))
#define XB_XGEN(j)  (2304 + 64 * (j))
#define XB_TOP      3328
#define XB_TOPGEN   3392
#define XCD_BAR_WORDS 3456
#define XB_SPIN_CAP (1u << 20)
DEV unsigned xb_ld(unsigned* p) { return __hip_atomic_load(p, __ATOMIC_RELAXED, __HIP_MEMORY_SCOPE_AGENT); }
DEV unsigned xb_add(unsigned* p, unsigned v) { return __hip_atomic_fetch_add(p, v, __ATOMIC_RELAXED, __HIP_MEMORY_SCOPE_AGENT); }
DEV unsigned xb_xcc_id() { return (unsigned)__builtin_amdgcn_s_getreg((3 << 11) | 20) & 0xFu; }
#define XB_SPIN(cond, bar) do { unsigned _sp = 0; while (cond) { __builtin_amdgcn_s_sleep(1); \
    if ((++_sp & 255u) == 0u) { if (xb_ld(&(bar)[XB_TMO])) break; if (_sp > XB_SPIN_CAP) { atomicAdd(&(bar)[XB_TMO], 1u); break; } } } } while (0)
DEV void xcd_barrier_complete(unsigned* bar, unsigned x, unsigned& nloc, unsigned& nx) {
  const unsigned G = gridDim.x;
  unsigned sum, cnt, mine, sp = 0u;
  for (;;) {
    sum = 0u; cnt = 0u; mine = 0u;
#pragma unroll
    for (unsigned j = 0; j < 16; ++j) { const unsigned c = xb_ld(&bar[XB_XCNT(j)]); sum += c; cnt += (c > 0u) ? 1u : 0u; mine = (j == x) ? c : mine; }
    if (sum == G) break;
    __builtin_amdgcn_s_sleep(1);
    if ((++sp & 255u) == 0u) { if (xb_ld(&bar[XB_TMO])) break; if (sp > XB_SPIN_CAP) { atomicAdd(&bar[XB_TMO], 1u); break; } }
  }
  nloc = mine > 0u ? mine : 1u; nx = cnt > 0u ? cnt : 1u;
}
DEV void xcd_barrier(unsigned* bar) {
  asm volatile("s_waitcnt vmcnt(0)" ::: "memory");
  __syncthreads();
  if (threadIdx.x == 0) {
    __builtin_amdgcn_s_waitcnt(0);
    const unsigned x = xb_xcc_id();
    volatile LAS unsigned* st = (volatile LAS unsigned*)(dyn_smem + HS_OFF + 128);
    unsigned nloc = st[0], nx = st[1];
    if (nloc == 0u) { xcd_barrier_complete(bar, x, nloc, nx); st[0] = nloc; st[1] = nx; }
    const unsigned old = xb_add(&bar[XB_XSUB(x)], 1u);
    const unsigned gen = old / nloc;
    if (old + 1u == (gen + 1u) * nloc) {
      __builtin_amdgcn_fence(__ATOMIC_RELEASE, "agent");
      asm volatile("s_waitcnt vmcnt(0)" ::: "memory");
      const unsigned og = xb_add(&bar[XB_TOP], 1u);
      const unsigned tg = og / nx;
      if (og + 1u == (tg + 1u) * nx) xb_add(&bar[XB_TOPGEN], 1u);
      else XB_SPIN(xb_ld(&bar[XB_TOPGEN]) == tg, bar);
      __builtin_amdgcn_fence(__ATOMIC_ACQUIRE, "agent");
      xb_add(&bar[XB_XGEN(x)], 1u);
      asm volatile("s_waitcnt vmcnt(0)" ::: "memory");
    } else {
      XB_SPIN(xb_ld(&bar[XB_XGEN(x)]) == gen, bar);
      __builtin_amdgcn_fence(__ATOMIC_ACQUIRE, "agent");
      asm volatile("s_waitcnt vmcnt(0)" ::: "memory");
    }
  }
  __syncthreads();
}

constexpr int NPHASE = 18;

__global__ void __launch_bounds__(512, 2) mega(Params p, int ph_lo, int ph_hi) {
  char* smem = dyn_smem + VHALF * HALF_LDS;
  if ((threadIdx.x & 255) == 0) *((LAS unsigned*)(dyn_smem + HS_OFF) + (threadIdx.x >> 8) * 16) = 0u;
  __syncthreads();
  cg::grid_group grid = cg::this_grid();
  const float* mv0 = (const float*)(p.ws + OFF_MODV);
  const float* mv1 = mv0 + 33 * 6144;
  u16* X = (u16*)(p.ws + OFF_X);
  u16* HY = (u16*)(p.ws + OFF_HY);
  u16* BIG = (u16*)(p.ws + OFF_BIG);
  unsigned* bar = (unsigned*)(p.ws + OFF_BAR);
  if (threadIdx.x == 0) {
    volatile LAS unsigned* st = (volatile LAS unsigned*)(dyn_smem + HS_OFF + 128);
    st[0] = 0u; st[1] = 0u;
    (void)xb_add(&bar[XB_XCNT(xb_xcc_id())], 1u);
  }
  if (ph_hi < 0) grid.sync();
#define PHASE(n, BODY) if (ph_lo <= (n) && (n) < ph_hi) { BODY; if ((n) + 1 < ph_hi) xcd_barrier(bar); }
  PHASE(0, phase_prep(p, smem))
  PHASE(1, phase_init(p))
  PHASE(2, gemm_phase<0>(HY, 1024, (const u16*)(p.ws + OFF_WIN0), 1024, NTOK, 2304, BIG, PS0, nullptr, dyn_smem))
  PHASE(3, phase_hyprep_rope(p, smem))
  PHASE(4, phase_conv_attn(p, smem))
  PHASE(5, gemm_phase<2>(HY, 1024, (const u16*)(p.ws + OFF_WOUT0), 1024, NTOK, 1024, X, 1024, mv0 + 2 * 1024, dyn_smem))
  PHASE(6, ln_phase<false>(p, NTOK, p.ln_g, p.ln_b, mv0, 3, 4))
  PHASE(7, gemm_phase<1>(HY, 1024, (const u16*)(p.ws + OFF_W1_0), 1024, NTOK, 4096, BIG, 4096, nullptr, dyn_smem))
  PHASE(8, gemm_phase<2>(BIG, 4096, (const u16*)(p.ws + OFF_W2_0), 4096, NTOK, 1024, X, 1024, mv0 + 5 * 1024, dyn_smem))
  PHASE(9, ln_phase<false>(p, NTOK, p.ln_g + 1024, p.ln_b + 1024, mv1, 0, 1))
  PHASE(10, gemm_phase<0>(HY, 1024, (const u16*)(p.ws + OFF_WIN1), 1024, NTOK, 4096, BIG, PS1, nullptr, dyn_smem))
  PHASE(11, phase_scans(p, smem))
  PHASE(12, for (int it = VBID; it < 2048; it += VNB) mixout_item(p, it, smem))
  PHASE(13, gemm_phase<2>(HY, 1024, (const u16*)(p.ws + OFF_WOUT1), 1024, NLAT, 1024, X, 1024, mv1 + 2 * 1024, dyn_smem))
  PHASE(14, ln_phase<false>(p, NLAT, p.ln_g + 2048, p.ln_b + 2048, mv1, 3, 4))
  PHASE(15, gemm_phase<1>(HY, 1024, (const u16*)(p.ws + OFF_W1_1), 1024, NLAT, 4096, BIG, 4096, nullptr, dyn_smem))
  PHASE(16, gemm_phase<2>(BIG, 4096, (const u16*)(p.ws + OFF_W2_1), 4096, NLAT, 1024, X, 1024, mv1 + 5 * 1024, dyn_smem))
  PHASE(17, ln_phase<true>(p, NLAT, p.ln_g + 3072, p.ln_b + 3072, mv1, 0, 1))
}

extern "C" void kernel_launch(void* const* d_in, const int* in_sizes, int n_in, void* d_out, int out_size, void* d_ws,
                              size_t ws_size, hipStream_t stream) {
  static int grid_blocks = 0;
  if (!grid_blocks) {
    int dev = 0, cus = 0, per_cu = 0;
    hipGetDevice(&dev);
    hipDeviceGetAttribute(&cus, hipDeviceAttributeMultiprocessorCount, dev);
    hipFuncSetAttribute((const void*)mega, hipFuncAttributeMaxDynamicSharedMemorySize, LDS_BYTES);
    hipOccupancyMaxActiveBlocksPerMultiprocessor(&per_cu, mega, 512, LDS_BYTES);
    if (per_cu > 1) per_cu = 1;
    if (per_cu < 1) per_cu = 1;
    grid_blocks = cus * per_cu;
  }
  if (ws_size < WS_NEED) fprintf(stderr, "workspace too small: %zu < %zu\n", ws_size, (size_t)WS_NEED);
  Params p{};
  const float** pp = (const float**)&p;
  for (int i = 0; i < 39; ++i) pp[i] = (const float*)d_in[i];
  p.out = (float*)d_out;
  p.ws = (char*)d_ws;
  int lo = 0, hi = NPHASE;
  void* args[] = {&p, &lo, &hi};
  hipMemsetAsync((char*)d_ws + OFF_BAR, 0, XCD_BAR_WORDS * sizeof(unsigned), stream);
  hipError_t e = hipLaunchCooperativeKernel((void*)mega, dim3(grid_blocks), dim3(512), args, LDS_BYTES, stream);
  if (e != hipSuccess) fprintf(stderr, "cooperative launch failed: %s (grid %d)\n", hipGetErrorString(e), grid_blocks);
}
```

```cpp
#include <hip/hip_runtime.h>
#include <hip/hip_cooperative_groups.h>
#include <cstdio>
#include <cstdint>
namespace cg = cooperative_groups;

typedef unsigned short u16;
typedef __attribute__((ext_vector_type(8))) short bf16x8;
typedef __attribute__((ext_vector_type(4))) float f32x4;
typedef __attribute__((ext_vector_type(16))) float f32x16;

#define DEV __device__ __forceinline__

constexpr int NLAT = 65536, NCTX = 8192, NTOK = 73728;
constexpr int PS0 = 2304;
constexpr int PS1 = 4096;
constexpr int DNO = 1920;
constexpr float ALPHA = 1.4142135623730951f;

constexpr size_t OFF_WIN0 = 0;
constexpr size_t OFF_WOUT0 = OFF_WIN0 + (size_t)2304 * 1024 * 2;
constexpr size_t OFF_W1_0 = OFF_WOUT0 + (size_t)1024 * 1024 * 2;
constexpr size_t OFF_W1_1 = OFF_W1_0 + (size_t)4096 * 1024 * 2;
constexpr size_t OFF_W2_0 = OFF_W1_1 + (size_t)4096 * 1024 * 2;
constexpr size_t OFF_W2_1 = OFF_W2_0 + (size_t)4096 * 1024 * 2;
constexpr size_t OFF_WIN1 = OFF_W2_1 + (size_t)4096 * 1024 * 2;
constexpr size_t OFF_WOUT1 = OFF_WIN1 + (size_t)4096 * 1024 * 2;
constexpr size_t OFF_MODV = OFF_WOUT1 + (size_t)1024 * 1024 * 2;
constexpr size_t OFF_KR2048 = OFF_MODV + (size_t)2 * 33 * 6144 * 4;
constexpr size_t OFF_KR256 = OFF_KR2048 + (size_t)512 * 4096 * 2;
constexpr size_t OFF_ROPE = OFF_KR256 + (size_t)512 * 512 * 2;
constexpr size_t OFF_BSUM = OFF_ROPE + 8192;
constexpr size_t OFF_G2T = OFF_BSUM + (size_t)65536 * 16 * 4;
constexpr size_t OFF_BAR = OFF_G2T + (size_t)512 * 128 * 2;
constexpr size_t OFF_X = (size_t)64 << 20;
constexpr size_t OFF_HY = OFF_X + (size_t)NTOK * 1024 * 2;
constexpr size_t OFF_BIG = OFF_HY + (size_t)NTOK * 1024 * 2;
constexpr size_t WS_NEED = OFF_BIG + (size_t)NTOK * 4096 * 2;
static_assert(OFF_BAR + 16384 <= OFF_X, "ws map");
constexpr size_t SO_U = 0;
constexpr size_t SO_X0 = SO_U + (size_t)512 * 32 * 2048 * 2;
constexpr size_t SO_UC = SO_X0 + (size_t)512 * 32 * 2048 * 2;
constexpr size_t SO_X0C = SO_UC + (size_t)512 * 32 * 256 * 2;

struct Params {
  const float *x, *c, *ctx, *c_ctx, *mod_w, *mod_b, *ln_g, *ln_b, *mlp_w1, *mlp_w2, *e_w_in, *e_w_out, *hy_conv,
      *hy_w1, *hy_b1, *hy_w2, *hy_b2, *hy_freq, *hy_w3, *hy_decay, *hy_bias, *attn_sink, *o_w_in, *o_w_out,
      *rw_mu, *rw_w0, *rw_w2, *rw_a0, *rw_a2, *rw_g2, *rw_kk, *rw_ka, *rw_rk, *rw_lnx_g, *rw_lnx_b,
      *dn_conv, *dn_A_log, *dn_dt_bias, *dn_norm_g;
  float* out;
  char* ws;
};

typedef float f32x2_t __attribute__((ext_vector_type(2)));
typedef __bf16 bf16x2_t __attribute__((ext_vector_type(2)));
DEV u16 f2bf(float f) { return __builtin_bit_cast(u16, (__bf16)f); }
DEV float bf2f(u16 h) { return __uint_as_float(((unsigned)h) << 16); }
DEV float bflo(unsigned u) { return __uint_as_float(u << 16); }
DEV float bfhi(unsigned u) { return __uint_as_float(u & 0xffff0000u); }
DEV unsigned pack2(float a, float b) { f32x2_t v = {a, b}; return __builtin_bit_cast(unsigned, __builtin_convertvector(v, bf16x2_t)); }
DEV void unpack8(const uint4& v, float* f) {
  f[0] = bflo(v.x); f[1] = bfhi(v.x); f[2] = bflo(v.y); f[3] = bfhi(v.y);
  f[4] = bflo(v.z); f[5] = bfhi(v.z); f[6] = bflo(v.w); f[7] = bfhi(v.w);
}
DEV uint4 pack8(const float* f) {
  uint4 v; v.x = pack2(f[0], f[1]); v.y = pack2(f[2], f[3]); v.z = pack2(f[4], f[5]); v.w = pack2(f[6], f[7]); return v;
}
DEV int modrow(int r) { return r < NLAT ? (r >> 11) : 32; }
DEV float sigm(float x) { return __builtin_amdgcn_rcpf(1.f + __expf(-x)); }
DEV float silu(float x) { return x * __builtin_amdgcn_rcpf(1.f + __expf(-x)); }
DEV float softplus(float x) { return fmaxf(x, 0.f) + __logf(1.f + __expf(-fabsf(x))); }
DEV float fast_tanh(float x) { return 1.f - 2.f * __builtin_amdgcn_rcpf(1.f + __expf(2.f * x)); }
DEV float wave_sum(float v) {
#pragma unroll
  for (int o = 32; o > 0; o >>= 1) v += __shfl_xor(v, o, 64);
  return v;
}

extern __shared__ __attribute__((aligned(16))) char dyn_smem[];
#define LAS __attribute__((address_space(3)))
constexpr int HALF_LDS = 65536;
constexpr int HS_OFF = 2 * HALF_LDS + 2048;
constexpr int LDS_BYTES = HS_OFF + 256;
#define VTID ((int)(threadIdx.x & 255))
#define VHALF ((int)__builtin_amdgcn_readfirstlane((int)(threadIdx.x >> 8)))
#define VBID ((int)(blockIdx.x * 2 + VHALF))
#define VNB ((int)(gridDim.x * 2))
DEV void hsync() {
  LAS unsigned* cnt = (LAS unsigned*)(dyn_smem + HS_OFF) + VHALF * 16;
  asm volatile("s_waitcnt vmcnt(0) lgkmcnt(0)" ::: "memory");
  unsigned tgt = 0u;
  if ((threadIdx.x & 63) == 0) {
    const unsigned old = __hip_atomic_fetch_add(cnt, 1u, __ATOMIC_RELAXED, __HIP_MEMORY_SCOPE_WORKGROUP);
    tgt = (old & ~3u) + 4u;
  }
  tgt = __builtin_amdgcn_readfirstlane(tgt);
  while (__hip_atomic_load(cnt, __ATOMIC_RELAXED, __HIP_MEMORY_SCOPE_WORKGROUP) < tgt) __builtin_amdgcn_s_sleep(0);
  asm volatile("s_waitcnt lgkmcnt(0)" ::: "memory");
}
#define HSYNC() hsync()

DEV void transpose_tile(const float* __restrict__ src, int K, int N, int Npad, u16* __restrict__ dst, int tile,
                               u16* sm) {
  const int tid = VTID;
  const int ntn = Npad >> 6;
  const int tk = tile / ntn, tn = tile - tk * ntn;
  const int n = tid & 63, kq = tid >> 6;
  const int gn = tn * 64 + n;
#pragma unroll 4
  for (int i = 0; i < 16; ++i) {
    int k = kq + 4 * i;
    float v = (gn < N) ? src[(size_t)(tk * 64 + k) * N + gn] : 0.f;
    sm[n * 66 + k] = f2bf(v);
  }
  HSYNC();
  const int n2 = tid >> 2, q = tid & 3;
  const unsigned* s32 = (const unsigned*)sm + (n2 * 66 + q * 16) / 2;
  uint4 a, b;
  a.x = s32[0]; a.y = s32[1]; a.z = s32[2]; a.w = s32[3];
  b.x = s32[4]; b.y = s32[5]; b.z = s32[6]; b.w = s32[7];
  u16* d = dst + (size_t)(tn * 64 + n2) * K + tk * 64 + q * 16;
  *(uint4*)d = a;
  *(uint4*)(d + 8) = b;
  HSYNC();
}

DEV void modv_item(const Params& p, int it, float* sl) {
  const int tid = VTID;
  const int l = it / 288, rem = it % 288, cc = rem / 3, rg = rem % 3;
  for (int idx = tid; idx < 11 * 1024; idx += 256) {
    int r = rg * 11 + (idx >> 10), k = idx & 1023;
    float cv = (r < 32) ? p.c[r * 1024 + k] : p.c_ctx[k];
    sl[idx] = cv / (1.f + expf(-cv));
  }
  HSYNC();
  const int cl = tid & 63, kg = tid >> 6;
  const int col = cc * 64 + cl;
  float acc[11];
#pragma unroll
  for (int r = 0; r < 11; ++r) acc[r] = 0.f;
  const float* w = p.mod_w + (size_t)l * 1024 * 6144 + (size_t)(kg * 256) * 6144 + col;
#pragma unroll 8
  for (int k = 0; k < 256; ++k) {
    float wv = w[(size_t)k * 6144];
#pragma unroll
    for (int r = 0; r < 11; ++r) acc[r] += sl[r * 1024 + kg * 256 + k] * wv;
  }
  HSYNC();
  float* red = sl;
#pragma unroll
  for (int r = 0; r < 11; ++r) red[(kg * 11 + r) * 64 + cl] = acc[r];
  HSYNC();
  for (int idx = tid; idx < 11 * 64; idx += 256) {
    int r = idx >> 6, c2 = idx & 63;
    float v = red[(0 * 11 + r) * 64 + c2] + red[(1 * 11 + r) * 64 + c2] + red[(2 * 11 + r) * 64 + c2] + red[(3 * 11 + r) * 64 + c2];
    int gcol = cc * 64 + c2;
    ((float*)(p.ws + OFF_MODV))[(size_t)(l * 33 + rg * 11 + r) * 6144 + gcol] = v + p.mod_b[l * 6144 + gcol];
  }
  HSYNC();
}

DEV void filter_item(const Params& p, int it, float* sm) {
  const int L = it < 2048 ? 2048 : 256;
  const int t = it < 2048 ? it : it - 2048;
  u16* R = (u16*)(p.ws + (L == 2048 ? OFF_KR2048 : OFF_KR256));
  float* pe = sm; float* h1 = sm + 64; float* h2 = sm + 128;
  const int tid = VTID;
  const float tn = (float)t / (float)(L - 1);
  if (tid < 33) {
    float v;
    if (tid == 0) v = tn;
    else {
      int i = (tid - 1) & 15;
      double band = 1e-4 + (double)i * ((15.0 - 1e-4) / 15.0);
      double ang = 2.0 * 3.14159265358979323846 * (double)t * band / (double)L;
      v = (tid <= 16) ? (float)cos(ang) : (float)(-sin(ang));
    }
    pe[tid] = v;
  }
  HSYNC();
  if (tid < 64) {
    float acc = p.hy_b1[tid];
#pragma unroll 11
    for (int i = 0; i < 33; ++i) acc += pe[i] * p.hy_w1[i * 64 + tid];
    h1[tid] = sinf(p.hy_freq[tid] * acc);
  }
  HSYNC();
  if (tid < 64) {
    float acc = p.hy_b2[tid];
#pragma unroll 16
    for (int i = 0; i < 64; ++i) acc += h1[i] * p.hy_w2[i * 64 + tid];
    h2[tid] = sinf(p.hy_freq[tid] * acc);
  }
  HSYNC();
#pragma unroll 1
  for (int q = 0; q < 4; ++q) {
    int o = tid + 256 * q;
    float acc = 0.f;
#pragma unroll 16
    for (int i = 0; i < 64; ++i) acc += h2[i] * p.hy_w3[i * 1024 + o];
    float val = acc * expf(-tn * fabsf(p.hy_decay[o]));
    if (o < 512) {
      if (t == 0) val += p.hy_bias[o];
      R[(size_t)o * 2 * L + L - t] = f2bf(val);
    } else {
      int c = o - 512;
      if (t >= 1) R[(size_t)c * 2 * L + L + t] = f2bf(val);
      else R[(size_t)c * 2 * L] = 0;
    }
  }
  HSYNC();
}

DEV void phase_prep(const Params& p, char* smem) {
  constexpr int T_IN0 = 16 * 36, T_OUT = 16 * 16, T_W = 16 * 64;
  constexpr int E0 = T_IN0, E1 = E0 + T_OUT, E2 = E1 + T_W, E3 = E2 + T_W, E4 = E3 + T_W, E5 = E4 + T_W,
                E6 = E5 + T_W, E7 = E6 + T_OUT, E8 = E7 + 576, E9 = E8 + 2304, E10 = E9 + 1, E11 = E10 + 16;
  for (int it = VBID; it < E11; it += VNB) {
    if (it >= E10) transpose_tile(p.rw_g2, 128, 512, 512, (u16*)(p.ws + OFF_G2T), it - E10, (u16*)smem);
    else if (it < E0) transpose_tile(p.e_w_in, 1024, 2304, 2304, (u16*)(p.ws + OFF_WIN0), it, (u16*)smem);
    else if (it < E1) transpose_tile(p.e_w_out, 1024, 1024, 1024, (u16*)(p.ws + OFF_WOUT0), it - E0, (u16*)smem);
    else if (it < E2) transpose_tile(p.mlp_w1, 1024, 4096, 4096, (u16*)(p.ws + OFF_W1_0), it - E1, (u16*)smem);
    else if (it < E3) transpose_tile(p.mlp_w1 + (size_t)1024 * 4096, 1024, 4096, 4096, (u16*)(p.ws + OFF_W1_1), it - E2, (u16*)smem);
    else if (it < E4) transpose_tile(p.mlp_w2, 4096, 1024, 1024, (u16*)(p.ws + OFF_W2_0), it - E3, (u16*)smem);
    else if (it < E5) transpose_tile(p.mlp_w2 + (size_t)1024 * 4096, 4096, 1024, 1024, (u16*)(p.ws + OFF_W2_1), it - E4, (u16*)smem);
    else if (it < E6) transpose_tile(p.o_w_in, 1024, 3984, 4096, (u16*)(p.ws + OFF_WIN1), it - E5, (u16*)smem);
    else if (it < E7) transpose_tile(p.o_w_out, 1024, 1024, 1024, (u16*)(p.ws + OFF_WOUT1), it - E6, (u16*)smem);
    else if (it < E8) modv_item(p, it - E7, (float*)smem);
    else if (it < E9) filter_item(p, it - E8, (float*)smem);
    else {
      float2* tab = (float2*)(p.ws + OFF_ROPE);
      for (int q = 0; q < 4; ++q) {
        int e = VTID * 4 + q;
        int pos = e >> 4, i = e & 15;
        float inv = powf(10000.f, -(float)i / 16.f);
        float ang = (float)pos * inv;
        tab[e] = make_float2(cosf(ang), sinf(ang));
      }
    }
  }
}

DEV void phase_init(const Params& p) {
  const float* mv = (const float*)(p.ws + OFF_MODV);
  u16* X = (u16*)(p.ws + OFF_X);
  u16* HM = (u16*)(p.ws + OFF_HY);
  const size_t total = (size_t)NTOK * 128;
  for (size_t i = (size_t)VBID * 256 + VTID; i < total; i += (size_t)VNB * 256) {
    int r = (int)(i >> 7), c8 = (int)(i & 127) * 8;
    const float* src = r < NLAT ? p.x + (size_t)r * 1024 + c8 : p.ctx + (size_t)(r - NLAT) * 1024 + c8;
    float4 v0 = *(const float4*)src, v1 = *(const float4*)(src + 4);
    const float* m = mv + (size_t)modrow(r) * 6144 + c8;
    float4 h0 = *(const float4*)m, h1 = *(const float4*)(m + 4);
    float4 s0 = *(const float4*)(m + 1024), s1 = *(const float4*)(m + 1028);
    float f[8] = {v0.x, v0.y, v0.z, v0.w, v1.x, v1.y, v1.z, v1.w};
    float sh[8] = {h0.x, h0.y, h0.z, h0.w, h1.x, h1.y, h1.z, h1.w};
    float sc[8] = {s0.x, s0.y, s0.z, s0.w, s1.x, s1.y, s1.z, s1.w};
    float g[8];
#pragma unroll
    for (int j = 0; j < 8; ++j) g[j] = f[j] * (1.f + sc[j]) + sh[j];
    *(uint4*)(X + (size_t)r * 1024 + c8) = pack8(f);
    *(uint4*)(HM + (size_t)r * 1024 + c8) = pack8(g);
  }
}

template <int EPI>
DEV void gemm_phase(const u16* __restrict__ A, int lda, const u16* __restrict__ Bt, int K, int M, int N,
                    u16* __restrict__ C, int ldc, const float* __restrict__ gate, char* smem) {
  const int tid = threadIdx.x, lane = tid & 63, wave = tid >> 6;
  const int wm = wave >> 2, wn = wave & 3;
  const int fr = lane & 15, fq = lane >> 4;
  const int tn = N >> 8, tm = M >> 8, tiles = tm * tn;
  const int nk = K >> 6;
  const int drow = wave * 8 + (lane >> 3);
  const int dchunk = (lane & 7) ^ ((drow >> 1) & 7);
  const size_t lda64 = (size_t)lda * 64, ldb64 = (size_t)K * 64;
  const int sw = fr >> 1;
  const bool xcd_order = (gridDim.x & 7) == 0 && (tm & 31) == 0;
  const int mx = tm >> 3;
#define G_COORDS(IT, M0, N0)                                                   \
  {                                                                            \
    int tm_i, tn_i;                                                            \
    if (xcd_order) {                                                           \
      const int x = (IT) & 7, local = (IT) >> 3;                               \
      const int mg = local / (4 * tn), r = local - mg * 4 * tn;                \
      tn_i = r >> 2;                                                           \
      tm_i = x * mx + mg * 4 + (r & 3);                                        \
    } else { tm_i = (IT) / tn; tn_i = (IT) - tm_i * tn; }                      \
    M0 = tm_i << 8; N0 = tn_i << 8;                                            \
  }
  int m0 = 0, n0 = 0;
  const u16* ag = A;
  const u16* bg = Bt;
  bool primed = false;
  for (int it = blockIdx.x; it < tiles; it += gridDim.x) {
    if (!primed) {
      G_COORDS(it, m0, n0)
      ag = A + (size_t)(m0 + drow) * lda + dchunk * 8;
      bg = Bt + (size_t)(n0 + drow) * K + dchunk * 8;
    }
    f32x4 acc[8][4];
#pragma unroll
    for (int i = 0; i < 8; ++i)
#pragma unroll
      for (int j = 0; j < 4; ++j) acc[i][j] = (f32x4){0.f, 0.f, 0.f, 0.f};
#define G_ISSUE(KT, ST)                                                                                  \
  {                                                                                                      \
    const u16* a2 = ag + (KT)*64;                                                                        \
    const u16* b2 = bg + (KT)*64;                                                                        \
    char* la = smem + (ST)*65536 + wave * 1024;                                                          \
    _Pragma("unroll") for (int j = 0; j < 4; ++j) {                                                      \
      __builtin_amdgcn_global_load_lds((const unsigned*)(a2 + j * lda64), (unsigned*)(la + j * 8192), 16, 0, 0);          \
      __builtin_amdgcn_global_load_lds((const unsigned*)(b2 + j * ldb64), (unsigned*)(la + 32768 + j * 8192), 16, 0, 0);  \
    }                                                                                                    \
  }
    if (!primed) G_ISSUE(0, 0)
    for (int kt = 0; kt < nk; ++kt) {
      asm volatile("s_waitcnt vmcnt(0)" ::: "memory");
      __syncthreads();
      if (kt + 1 < nk) G_ISSUE(kt + 1, (kt + 1) & 1)
      const u16* As = (const u16*)(smem + (kt & 1) * 65536);
      const u16* Bs = As + 16384;
#define LDA(i, ks) (*(const bf16x8*)(As + (wm * 128 + (i) * 16 + fr) * 64 + ((((ks) * 4 + fq) ^ sw) * 8)))
#define LDB(j, ks) (*(const bf16x8*)(Bs + (wn * 64 + (j) * 16 + fr) * 64 + ((((ks) * 4 + fq) ^ sw) * 8)))
#define SB __builtin_amdgcn_sched_barrier(0)
#define MFMA_H(R, X0, Y0) acc[R][0] = __builtin_amdgcn_mfma_f32_16x16x32_bf16(Y0, X0, acc[R][0], 0, 0, 0);
#define MFMA_T(R, X0, X1, Y0, Y1, Y2, Y3)                                                  \
  acc[R][1] = __builtin_amdgcn_mfma_f32_16x16x32_bf16(Y1, X0, acc[R][1], 0, 0, 0);         \
  acc[R][2] = __builtin_amdgcn_mfma_f32_16x16x32_bf16(Y2, X0, acc[R][2], 0, 0, 0);         \
  acc[R][3] = __builtin_amdgcn_mfma_f32_16x16x32_bf16(Y3, X0, acc[R][3], 0, 0, 0);         \
  acc[R + 1][0] = __builtin_amdgcn_mfma_f32_16x16x32_bf16(Y0, X1, acc[R + 1][0], 0, 0, 0); \
  acc[R + 1][1] = __builtin_amdgcn_mfma_f32_16x16x32_bf16(Y1, X1, acc[R + 1][1], 0, 0, 0); \
  acc[R + 1][2] = __builtin_amdgcn_mfma_f32_16x16x32_bf16(Y2, X1, acc[R + 1][2], 0, 0, 0); \
  acc[R + 1][3] = __builtin_amdgcn_mfma_f32_16x16x32_bf16(Y3, X1, acc[R + 1][3], 0, 0, 0);
      {
        bf16x8 b0 = LDB(0, 0), b1 = LDB(1, 0), b2 = LDB(2, 0), b3 = LDB(3, 0);
        bf16x8 a0 = LDA(0, 0), a1 = LDA(1, 0);
        bf16x8 n0, n1, c0, c1, c2, c3;
        SB; MFMA_H(0, a0, b0) SB; n0 = LDA(2, 0); n1 = LDA(3, 0); SB; MFMA_T(0, a0, a1, b0, b1, b2, b3) SB;
        MFMA_H(2, n0, b0) SB; a0 = LDA(4, 0); a1 = LDA(5, 0); SB; MFMA_T(2, n0, n1, b0, b1, b2, b3) SB;
        MFMA_H(4, a0, b0) SB; n0 = LDA(6, 0); n1 = LDA(7, 0); SB; MFMA_T(4, a0, a1, b0, b1, b2, b3) SB;
        MFMA_H(6, n0, b0) SB;
        c0 = LDB(0, 1); c1 = LDB(1, 1); c2 = LDB(2, 1); c3 = LDB(3, 1); a0 = LDA(0, 1); a1 = LDA(1, 1);
        SB; MFMA_T(6, n0, n1, b0, b1, b2, b3) SB;
        MFMA_H(0, a0, c0) SB; n0 = LDA(2, 1); n1 = LDA(3, 1); SB; MFMA_T(0, a0, a1, c0, c1, c2, c3) SB;
        MFMA_H(2, n0, c0) SB; a0 = LDA(4, 1); a1 = LDA(5, 1); SB; MFMA_T(2, n0, n1, c0, c1, c2, c3) SB;
        MFMA_H(4, a0, c0) SB; n0 = LDA(6, 1); n1 = LDA(7, 1); SB; MFMA_T(4, a0, a1, c0, c1, c2, c3) SB;
        MFMA_H(6, n0, c0) MFMA_T(6, n0, n1, c0, c1, c2, c3) SB;
      }
#undef LDA
#undef LDB
#undef SB
#undef MFMA_H
#undef MFMA_T
    }
    const int cm0 = m0, cn0 = n0;
    primed = false;
    if (it + (int)gridDim.x < tiles) {
      G_COORDS(it + (int)gridDim.x, m0, n0)
      ag = A + (size_t)(m0 + drow) * lda + dchunk * 8;
      bg = Bt + (size_t)(n0 + drow) * K + dchunk * 8;
      G_ISSUE(0, 0)
      primed = true;
    }
    u16* Cs = (u16*)(smem + 65536);
#pragma unroll 1
    for (int hp = 0; hp < 2; ++hp) {
      asm volatile("s_waitcnt lgkmcnt(0)" ::: "memory");
      __builtin_amdgcn_s_barrier();
      asm volatile("" ::: "memory");
      if (wm == hp) {
#pragma unroll
        for (int i = 0; i < 8; ++i)
#pragma unroll
          for (int j = 0; j < 4; ++j) {
            float v0 = acc[i][j][0], v1 = acc[i][j][1], v2 = acc[i][j][2], v3 = acc[i][j][3];
            if (EPI == 1) {
              v0 = fmaxf(v0, 0.f); v1 = fmaxf(v1, 0.f); v2 = fmaxf(v2, 0.f); v3 = fmaxf(v3, 0.f);
              v0 *= v0; v1 *= v1; v2 *= v2; v3 *= v3;
            }
            *(uint2*)(Cs + (i * 16 + fr) * 264 + wn * 64 + j * 16 + fq * 4) = make_uint2(pack2(v0, v1), pack2(v2, v3));
          }
      }
      asm volatile("s_waitcnt lgkmcnt(0)" ::: "memory");
      __builtin_amdgcn_s_barrier();
      asm volatile("" ::: "memory");
#pragma unroll 2
      for (int q = 0; q < 8; ++q) {
        const int chunk = tid + q * 512;
        const int row = chunk >> 5, cc = chunk & 31;
        uint4 cv = *(const uint4*)(Cs + row * 264 + cc * 8);
        const int grow = cm0 + hp * 128 + row;
        u16* dst = C + (size_t)grow * ldc + cn0 + cc * 8;
        if (EPI == 2) {
          float a[8], xo[8], y[8];
          unpack8(cv, a);
          unpack8(*(const uint4*)dst, xo);
          const float* gr = gate + (size_t)modrow(grow) * 6144 + cn0 + cc * 8;
          float4 g0 = *(const float4*)gr, g1 = *(const float4*)(gr + 4);
          float gg[8] = {g0.x, g0.y, g0.z, g0.w, g1.x, g1.y, g1.z, g1.w};
#pragma unroll
          for (int j = 0; j < 8; ++j) y[j] = ALPHA * xo[j] + gg[j] * a[j];
          cv = pack8(y);
        }
        *(uint4*)dst = cv;
      }
    }
    asm volatile("s_waitcnt lgkmcnt(0)" ::: "memory");
    __builtin_amdgcn_s_barrier();
    asm volatile("" ::: "memory");
  }
#undef G_ISSUE
#undef G_COORDS
}

template <bool FINAL>
DEV void ln_phase(const Params& p, int M, const float* __restrict__ g, const float* __restrict__ b,
                         const float* __restrict__ modl  , int shi, int sci) {
  u16* X = (u16*)(p.ws + OFF_X);
  u16* HM = (u16*)(p.ws + OFF_HY);
  const int lane = VTID & 63;
  const int gw = VBID * 4 + (VTID >> 6), nw = VNB * 4;
  uint4 nx0 = make_uint4(0u, 0u, 0u, 0u), nx1 = nx0;
  if (gw < M) {
    nx0 = *(const uint4*)(X + (size_t)gw * 1024 + lane * 8);
    nx1 = *(const uint4*)(X + (size_t)gw * 1024 + 512 + lane * 8);
  }
  for (int row = gw; row < M; row += nw) {
    u16* xr = X + (size_t)row * 1024;
    float f[16];
    unpack8(nx0, f);
    unpack8(nx1, f + 8);
    if (row + nw < M) {
      nx0 = *(const uint4*)(xr + (size_t)nw * 1024 + lane * 8);
      nx1 = *(const uint4*)(xr + (size_t)nw * 1024 + 512 + lane * 8);
    }
    float s = 0.f, q = 0.f;
#pragma unroll
    for (int j = 0; j < 16; ++j) { s += f[j]; q += f[j] * f[j]; }
#pragma unroll
    for (int o = 32; o > 0; o >>= 1) { s += __shfl_xor(s, o, 64); q += __shfl_xor(q, o, 64); }
    const float mu = s * (1.f / 1024.f);
    const float rs = rsqrtf(fmaxf(q * (1.f / 1024.f) - mu * mu, 0.f) + 1e-5f);
#pragma unroll
    for (int j = 0; j < 16; ++j) f[j] -= mu;
#pragma unroll
    for (int hh = 0; hh < 2; ++hh) {
      const int c0 = hh * 512 + lane * 8;
      float y[8];
#pragma unroll
      for (int j = 0; j < 8; ++j) y[j] = f[hh * 8 + j] * rs * g[c0 + j] + b[c0 + j];
      if (FINAL) {
        float* o = p.out + (size_t)row * 1024 + c0;
        *(float4*)o = make_float4(y[0], y[1], y[2], y[3]);
        *(float4*)(o + 4) = make_float4(y[4], y[5], y[6], y[7]);
      } else {
        *(uint4*)(xr + c0) = pack8(y);
        const float* m = modl + (size_t)modrow(row) * 6144;
        float h[8];
#pragma unroll
        for (int j = 0; j < 8; ++j) h[j] = y[j] * (1.f + m[sci * 1024 + c0 + j]) + m[shi * 1024 + c0 + j];
        *(uint4*)(HM + (size_t)row * 1024 + c0) = pack8(h);
      }
    }
  }
}

DEV void hyprep_item(const Params& p, int it, char* smem) {
  u16* su = (u16*)smem;
  u16* sx = su + 64 * 66;
  const u16* P = (const u16*)(p.ws + OFF_BIG);
  const int tid = VTID;
  const int ct = it & 7, st = it >> 3;
  int b, t0, L, rowbase;
  u16 *U, *X0;
  if (st < 1024) { b = st >> 5; t0 = (st & 31) * 64; L = 2048; rowbase = b * 2048;
    U = (u16*)((char*)p.out + SO_U); X0 = (u16*)((char*)p.out + SO_X0); }
  else { int s2 = st - 1024; b = s2 >> 2; t0 = (s2 & 3) * 64; L = 256; rowbase = NLAT + b * 256;
    U = (u16*)((char*)p.out + SO_UC); X0 = (u16*)((char*)p.out + SO_X0C); }
  const int c0 = ct * 64;
  {
    const int t = tid >> 2, cq = tid & 3;
    float z[3][16];
#pragma unroll
    for (int g = 0; g < 3; ++g)
#pragma unroll
      for (int j = 0; j < 16; ++j) z[g][j] = 0.f;
#pragma unroll
    for (int tap = 0; tap < 3; ++tap) {
      const int tt = t0 + t + tap - 1;
      if (tt >= 0 && tt < L) {
#pragma unroll
        for (int g = 0; g < 3; ++g) {
          const int col = g * 512 + c0 + cq * 16;
          const u16* src = P + (size_t)(rowbase + tt) * PS0 + col;
          float f[16];
          unpack8(*(const uint4*)src, f);
          unpack8(*(const uint4*)(src + 8), f + 8);
          const float* w = p.hy_conv + tap * 1536 + col;
#pragma unroll
          for (int j = 0; j < 16; ++j) z[g][j] += f[j] * w[j];
        }
      }
    }
#pragma unroll
    for (int j = 0; j < 16; ++j) {
      su[t * 66 + cq * 16 + j] = f2bf(z[1][j] * z[2][j]);
      sx[t * 66 + cq * 16 + j] = f2bf(z[0][j]);
    }
  }
  HSYNC();
  {
    const int c = tid >> 2, tq = tid & 3;
    unsigned wu[8], wx[8];
#pragma unroll
    for (int j = 0; j < 8; ++j) {
      wu[j] = (unsigned)su[(tq * 16 + 2 * j) * 66 + c] | ((unsigned)su[(tq * 16 + 2 * j + 1) * 66 + c] << 16);
      wx[j] = (unsigned)sx[(tq * 16 + 2 * j) * 66 + c] | ((unsigned)sx[(tq * 16 + 2 * j + 1) * 66 + c] << 16);
    }
    const size_t o = ((size_t)(c0 + c) * 32 + b) * L + t0 + tq * 16;
    *(uint4*)(U + o) = make_uint4(wu[0], wu[1], wu[2], wu[3]);
    *(uint4*)(U + o + 8) = make_uint4(wu[4], wu[5], wu[6], wu[7]);
    *(uint4*)(X0 + o) = make_uint4(wx[0], wx[1], wx[2], wx[3]);
    *(uint4*)(X0 + o + 8) = make_uint4(wx[4], wx[5], wx[6], wx[7]);
  }
  HSYNC();
}

DEV void rope_item(const Params& p, int it) {
  u16* P = (u16*)(p.ws + OFF_BIG);
  const float2* tab = (const float2*)(p.ws + OFF_ROPE);
  const int task = it * 256 + VTID;
  const int row = task / 40, rem = task - row * 40;
  const int head = rem >> 2, pr = rem & 3;
  const int d0 = (pr >> 1) * 32 + (pr & 1) * 8;
  const int t = row & 2047;
  const int posc = (pr >> 1) ? (t & 63) : (t >> 6);
  const int fi0 = (pr & 1) * 8;
  u16* ptr = P + (size_t)row * PS0 + 1536 + head * 64 + d0;
  float u1[8], u2[8], o1[8], o2[8];
  unpack8(*(const uint4*)ptr, u1);
  unpack8(*(const uint4*)(ptr + 16), u2);
#pragma unroll
  for (int j = 0; j < 8; ++j) {
    float2 cs = tab[posc * 16 + fi0 + j];
    o1[j] = u1[j] * cs.x - u2[j] * cs.y;
    o2[j] = u1[j] * cs.y + u2[j] * cs.x;
  }
  *(uint4*)ptr = pack8(o1);
  *(uint4*)(ptr + 16) = pack8(o2);
}

DEV void phase_hyprep_rope(const Params& p, char* smem) {
  constexpr int NH = 9216, NR = 10240;
  for (int it = VBID; it < NH + NR; it += VNB) {
    if (it < NH) hyprep_item(p, it, smem);
    else rope_item(p, it - NH);
  }
}

template <int L, int NT>
DEV void conv_item(const Params& p, int c, int th, char* smem) {
  const u16* R = (const u16*)(p.ws + (L == 2048 ? OFF_KR2048 : OFF_KR256)) + (size_t)c * 2 * L;
  const u16* U = (const u16*)((const char*)p.out + (L == 2048 ? SO_U : SO_UC));
  const u16* X0 = (const u16*)((const char*)p.out + (L == 2048 ? SO_X0 : SO_X0C));
  u16* Y = (u16*)(p.ws + OFF_HY);
  u16* Rs0 = (u16*)smem;
  u16* Rs1 = Rs0 + 2 * L + 8;
  const int tid = VTID, lane = tid & 63, wave = tid >> 6;
  for (int i = tid; i < 2 * L; i += 256) {
    Rs0[i] = R[i];
    Rs1[i] = (i + 1 < 2 * L) ? R[i + 1] : (u16)0;
  }
  HSYNC();
  const int r = lane & 31, h = lane >> 5;
  const char* lanebase = (r & 1) ? (const char*)Rs1 + 2 * (8 * h - r + L - 1) : (const char*)Rs0 + 2 * (8 * h - r + L);
  const int tw0 = th * 1024 + wave * NT * 32;
  f32x16 acc[NT];
#pragma unroll
  for (int i = 0; i < NT; ++i)
#pragma unroll
    for (int e = 0; e < 16; ++e) acc[i][e] = 0.f;
  u16* UC = Rs1 + 2 * L + 8;
  const u16* Ug = U + (size_t)c * 32 * L;
  const u16* ug0 = Ug + (size_t)(tid >> 5) * L + (tid & 31) * 8;
  u16* uc0 = UC + (tid >> 5) * 264 + (tid & 31) * 8;
  uint4 stg0 = *(const uint4*)(ug0), stg1 = *(const uint4*)(ug0 + (size_t)8 * L);
  uint4 stg2 = *(const uint4*)(ug0 + (size_t)16 * L), stg3 = *(const uint4*)(ug0 + (size_t)24 * L);
  for (int chk = 0; chk < L / 256; ++chk) {
    HSYNC();
    *(uint4*)(uc0) = stg0; *(uint4*)(uc0 + 8 * 264) = stg1; *(uint4*)(uc0 + 16 * 264) = stg2; *(uint4*)(uc0 + 24 * 264) = stg3;
    HSYNC();
    if (chk + 1 < L / 256) {
      const u16* un = ug0 + (chk + 1) * 256;
      stg0 = *(const uint4*)(un); stg1 = *(const uint4*)(un + (size_t)8 * L);
      stg2 = *(const uint4*)(un + (size_t)16 * L); stg3 = *(const uint4*)(un + (size_t)24 * L);
    }
#pragma unroll 4
    for (int s2 = 0; s2 < 16; ++s2) {
      const int st = chk * 16 + s2;
      bf16x8 bfrag = *(const bf16x8*)(UC + r * 264 + s2 * 16 + 8 * h);
#pragma unroll
      for (int i = 0; i < NT; ++i) {
        const unsigned* ap = (const unsigned*)(lanebase + 2 * (st * 16 - (tw0 + i * 32)));
        uint4 av = make_uint4(ap[0], ap[1], ap[2], ap[3]);
        acc[i] = __builtin_amdgcn_mfma_f32_32x32x16_bf16(*(bf16x8*)&av, bfrag, acc[i], 0, 0, 0);
      }
    }
  }
  const int rowbase = (L == 2048) ? r * 2048 : NLAT + r * 256;
#pragma unroll
  for (int i = 0; i < NT; ++i) {
#pragma unroll
    for (int g4 = 0; g4 < 4; ++g4) {
      const int tt = tw0 + i * 32 + 8 * g4 + 4 * h;
      uint2 xv = *(const uint2*)(X0 + ((size_t)c * 32 + r) * L + tt);
      float x0[4] = {bflo(xv.x), bfhi(xv.x), bflo(xv.y), bfhi(xv.y)};
#pragma unroll
      for (int e = 0; e < 4; ++e) Y[(size_t)(rowbase + tt + e) * 1024 + c] = f2bf(acc[i][g4 * 4 + e] * x0[e]);
    }
  }
  HSYNC();
}

DEV void attn_item(const Params& p, int b, int hq, int qb, bool isctx, char* smem) {
  const u16* P = (const u16*)(p.ws + OFF_BIG);
  u16* Y = (u16*)(p.ws + OFF_HY);
  u16* Ks = (u16*)smem;
  u16* Vt = Ks + 64 * 72;
  const int tid = VTID, lane = tid & 63, wave = tid >> 6;
  const int nq = lane & 15, quad = lane >> 4;
  const int qrow = (isctx ? NLAT + b * 256 : b * 2048) + qb * 64 + wave * 16 + nq;
  const int qpos = qb * 64 + wave * 16 + nq;
  const int hkv = hq >> 2;
  const int kcol = 2048 + hkv * 64, vcol = 2176 + hkv * 64;
  bf16x8 qf[2];
#pragma unroll
  for (int ks = 0; ks < 2; ++ks)
    qf[ks] = *(const bf16x8*)(P + (size_t)qrow * PS0 + 1536 + hq * 64 + ks * 32 + quad * 8);
  float m = p.attn_sink[hq];
  float lsum = (quad == 0) ? 1.f : 0.f;
  f32x4 oacc[4];
#pragma unroll
  for (int n = 0; n < 4; ++n) oacc[n] = (f32x4){0.f, 0.f, 0.f, 0.f};
  const int nloc = isctx ? 0 : 5;
  for (int ti = 0; ti < nloc + 4; ++ti) {
    int krow0, k0 = 0;
    bool masked;
    if (ti < nloc) {
      k0 = qb * 64 - 128 + ti * 64;
      if (k0 < 0 || k0 >= 2048) continue;
      krow0 = b * 2048 + k0; masked = true;
    } else { krow0 = NLAT + b * 256 + (ti - nloc) * 64; masked = false; }
    HSYNC();
    {
      const int key = tid >> 2, part = tid & 3;
      const u16* kp = P + (size_t)(krow0 + key) * PS0 + kcol + part * 16;
      const u16* vp = P + (size_t)(krow0 + key) * PS0 + vcol + part * 16;
      uint4 k0v = *(const uint4*)kp, k1v = *(const uint4*)(kp + 8);
      uint4 v0v = *(const uint4*)vp, v1v = *(const uint4*)(vp + 8);
      *(uint4*)(Ks + key * 72 + part * 16) = k0v;
      *(uint4*)(Ks + key * 72 + part * 16 + 8) = k1v;
      unsigned vw[8] = {v0v.x, v0v.y, v0v.z, v0v.w, v1v.x, v1v.y, v1v.z, v1v.w};
#pragma unroll
      for (int j = 0; j < 8; ++j) {
        Vt[(part * 16 + 2 * j) * 72 + key] = (u16)(vw[j] & 0xffffu);
        Vt[(part * 16 + 2 * j + 1) * 72 + key] = (u16)(vw[j] >> 16);
      }
    }
    HSYNC();
    f32x4 s[4];
#pragma unroll
    for (int n = 0; n < 4; ++n) {
      s[n] = (f32x4){0.f, 0.f, 0.f, 0.f};
#pragma unroll
      for (int ks = 0; ks < 2; ++ks) {
        bf16x8 kf = *(const bf16x8*)(Ks + (n * 16 + nq) * 72 + ks * 32 + quad * 8);
        s[n] = __builtin_amdgcn_mfma_f32_16x16x32_bf16(kf, qf[ks], s[n], 0, 0, 0);
      }
    }
    float mx = -1e30f;
#pragma unroll
    for (int n = 0; n < 4; ++n)
#pragma unroll
      for (int e = 0; e < 4; ++e) {
        float v = s[n][e] * 0.125f;
        if (masked) {
          int kpos = k0 + n * 16 + quad * 4 + e;
          int d = qpos - kpos;
          if (d > 128 || d < -128) v = -1e30f;
        }
        s[n][e] = v;
        mx = fmaxf(mx, v);
      }
    mx = fmaxf(mx, __shfl_xor(mx, 16, 64));
    mx = fmaxf(mx, __shfl_xor(mx, 32, 64));
    const float mn = fmaxf(m, mx);
    const float al = __expf(m - mn);
    m = mn;
    float ps = 0.f;
#pragma unroll
    for (int n = 0; n < 4; ++n)
#pragma unroll
      for (int e = 0; e < 4; ++e) { float pv = __expf(s[n][e] - mn); s[n][e] = pv; ps += pv; }
    lsum = lsum * al + ps;
#pragma unroll
    for (int n = 0; n < 4; ++n)
#pragma unroll
      for (int e = 0; e < 4; ++e) oacc[n][e] *= al;
#pragma unroll
    for (int hh = 0; hh < 2; ++hh) {
      uint4 pw;
      pw.x = pack2(s[2 * hh][0], s[2 * hh][1]); pw.y = pack2(s[2 * hh][2], s[2 * hh][3]);
      pw.z = pack2(s[2 * hh + 1][0], s[2 * hh + 1][1]); pw.w = pack2(s[2 * hh + 1][2], s[2 * hh + 1][3]);
      bf16x8 pb = *(bf16x8*)&pw;
#pragma unroll
      for (int n = 0; n < 4; ++n) {
        const u16* vr = Vt + (n * 16 + nq) * 72 + quad * 4;
        uint2 va = *(const uint2*)(vr + (2 * hh) * 16);
        uint2 vb = *(const uint2*)(vr + (2 * hh + 1) * 16);
        uint4 vv = make_uint4(va.x, va.y, vb.x, vb.y);
        oacc[n] = __builtin_amdgcn_mfma_f32_16x16x32_bf16(*(bf16x8*)&vv, pb, oacc[n], 0, 0, 0);
      }
    }
  }
  lsum += __shfl_xor(lsum, 16, 64);
  lsum += __shfl_xor(lsum, 32, 64);
  const float inv = 1.f / lsum;
  u16* yo = Y + (size_t)qrow * 1024 + 512 + hq * 64 + quad * 4;
#pragma unroll
  for (int n = 0; n < 4; ++n) {
    uint2 w;
    w.x = pack2(oacc[n][0] * inv, oacc[n][1] * inv);
    w.y = pack2(oacc[n][2] * inv, oacc[n][3] * inv);
    *(uint2*)(yo + n * 16) = w;
  }
  HSYNC();
}

DEV void phase_conv_attn(const Params& p, char* smem) {
  constexpr int N0 = 1024, N1 = N0 + 512, N2 = N1 + 8192, N3 = N2 + 1024;
#pragma unroll 1
  for (int it = VBID; it < N0; it += VNB) conv_item<2048, 8>(p, it >> 1, it & 1, smem);
  __builtin_amdgcn_sched_barrier(0);
#pragma unroll 1
  for (int it = VBID; it < N3; it += VNB) {
    if (it < N0) continue;
    if (it < N1) conv_item<256, 2>(p, it - N0, 0, smem);
  }
  __builtin_amdgcn_sched_barrier(0);
#pragma unroll 1
  for (int it = VBID; it < N3; it += VNB) {
    if (it < N1) continue;
    if (it < N2) { int a = it - N1; attn_item(p, a >> 8, (a >> 5) & 7, a & 31, false, smem); }
    else { int a = it - N2; attn_item(p, a >> 5, (a >> 2) & 7, a & 3, true, smem); }
  }
}

DEV void lds_wave_sync() {
  asm volatile("s_waitcnt lgkmcnt(0)" ::: "memory");
  __builtin_amdgcn_wave_barrier();
}

#define SCAN_SYNC() do { if (HW) __syncthreads(); else hsync(); } while (0)
template <bool HW>
DEV void rwkv_item(const Params& p, int ri, char* smem) {
  const u16* P = (const u16*)(p.ws + OFF_BIG);
  u16* O4 = (u16*)p.out;
  float* BS = (float*)(p.ws + OFF_BSUM);
  const int tid0 = VTID;
  const int wp0 = tid0 >> 7;
  const int cid = ri * 2 + wp0;
  const int b = cid >> 4, d = (cid >> 3) & 1, h = cid & 7;
  f32x4 S[4][2];
#pragma unroll
  for (int i = 0; i < 4; ++i)
#pragma unroll
    for (int j = 0; j < 2; ++j) S[i][j] = (f32x4){0.f, 0.f, 0.f, 0.f};
  uint4 bw[2][4];
  float l0[4];
  {
    const int lane = tid0 & 63, wi = (tid0 >> 6) & 1, fr = lane & 15, fq = lane >> 4;
    const float* wsrc = (wi == 0 ? p.rw_w2 : p.rw_a2) + (size_t)d * 64 * 512 + h * 64;
    const float* bsrc = (wi == 0 ? p.rw_w0 : p.rw_a0) + d * 512 + h * 64;
#pragma unroll
    for (int nt = 0; nt < 4; ++nt) {
      l0[nt] = bsrc[nt * 16 + fr];
#pragma unroll
      for (int ks = 0; ks < 2; ++ks) {
        __builtin_amdgcn_sched_barrier(0);
        float f[8];
        const float* wp_ = wsrc + (size_t)(ks * 32 + fq * 8) * 512 + nt * 16 + fr;
#pragma unroll
        for (int j = 0; j < 8; ++j) f[j] = wp_[j * 512];
        bw[ks][nt] = pack8(f);
      }
    }
  }
  uint4 pre[5][3];
#define RW_LOAD(CI)                                                                                 \
  {                                                                                                 \
    const int seg_ = (CI) < 16 ? 0 : 1;                                                             \
    const int ch_ = seg_ ? (CI)-16 : (CI);                                                          \
    const int Ls_ = seg_ ? 2048 : 256;                                                              \
    const int rb_ = seg_ ? b * 2048 : NLAT + b * 256;                                               \
    const int sidx_ = ch_ * 16 + stt;                                                               \
    const int t_ = d == 0 ? sidx_ : Ls_ - 1 - sidx_;                                                \
    const u16* prow_ = P + (size_t)(rb_ + t_) * PS1 + spart * 8;                                    \
    _Pragma("unroll") for (int g = 0; g < 5; ++g) {                                                 \
      const int col_ = g < 3 ? g * 512 + h * 64 : (g == 3 ? 1536 + d * 64 : 1664 + d * 64);         \
      _Pragma("unroll") for (int tap = 0; tap < 3; ++tap) {                                         \
        const int tt_ = t_ + tap - 1;                                                               \
        if (tt_ >= 0 && tt_ < Ls_) pre[g][tap] = *(const uint4*)(prow_ + (ptrdiff_t)(tap - 1) * PS1 + col_); \
        else pre[g][tap] = make_uint4(0u, 0u, 0u, 0u);                                              \
      }                                                                                             \
    }                                                                                               \
  }
  {
    const int pt = tid0 & 127, stt = pt >> 3, spart = pt & 7;
    RW_LOAD(0)
  }
  for (int cidx = 0; cidx < 144; ++cidx) {
    asm volatile("" ::: "memory");
    int tid = tid0;
    asm volatile("" : "+v"(tid));
    const int lane = tid & 63, wave = tid >> 6, wp = wave >> 1, wi = wave & 1, pt = tid & 127;
    const int fr = lane & 15, fq = lane >> 4, stt = pt >> 3, spart = pt & 7;
    const int seg = cidx < 16 ? 0 : 1;
    const int ch = seg ? cidx - 16 : cidx;
    const int Ls = seg ? 2048 : 256;
    char* base = smem + wp * 32768;
    u16* RK = (u16*)base;
    u16* KD = RK + 1152;
    u16* KK = KD + 1152;
    u16* AB = KK + 1152;
    u16* VT = AB + 1152;
    float* LW = (float*)(base + 11264);
    u16* TW = (u16*)(base + 15360);
    u16* AD = TW + 1152;
    u16* BgCT = (u16*)(base + 19968);
    u16* KgCT = BgCT + 1024;
    float* gC = (float*)(base + 24064);
    float* Amat = (float*)(base + 24320) + wi * 256;
    u16* Tinv = (u16*)(base + 26368) + wi * 256;
    u16* BG = (u16*)(base + 27392);
    {
      const int o = stt * 72 + spart * 8;
#pragma unroll
      for (int g = 0; g < 5; ++g) {
        __builtin_amdgcn_sched_barrier(0);
        const int col = g < 3 ? g * 512 + h * 64 : (g == 3 ? 1536 + d * 64 : 1664 + d * 64);
        float pc[8], pp[8], pn[8], v[8];
        unpack8(pre[g][1], pc); unpack8(pre[g][0], pp); unpack8(pre[g][2], pn);
        const float* mu = p.rw_mu + col + spart * 8;
        float4 m0 = *(const float4*)mu, m1 = *(const float4*)(mu + 4);
        const float mm[8] = {m0.x, m0.y, m0.z, m0.w, m1.x, m1.y, m1.z, m1.w};
#pragma unroll
        for (int j = 0; j < 8; ++j) v[j] = pc[j] + mm[j] * (0.5f * (pp[j] + pn[j]) - pc[j]);
        if (g == 0) *(uint4*)(RK + o) = pack8(v);
        else if (g == 1) {
          *(uint4*)(KD + o) = pack8(v);
          const float* kkw = p.rw_kk + h * 64 + spart * 8;
          float kkv[8];
          float ss = 0.f;
#pragma unroll
          for (int j = 0; j < 8; ++j) { kkv[j] = v[j] * kkw[j]; ss += kkv[j] * kkv[j]; }
          ss += __shfl_xor(ss, 1, 64); ss += __shfl_xor(ss, 2, 64); ss += __shfl_xor(ss, 4, 64);
          const float inv = rsqrtf(ss + 1e-6f);
#pragma unroll
          for (int j = 0; j < 8; ++j) kkv[j] *= inv;
          *(uint4*)(KK + o) = pack8(kkv);
        } else if (g == 2) {
#pragma unroll
          for (int j = 0; j < 8; ++j) VT[(spart * 8 + j) * 16 + stt] = f2bf(v[j]);
        } else if (g == 3) {
#pragma unroll
          for (int j = 0; j < 8; ++j) v[j] = fast_tanh(v[j]);
          *(uint4*)(TW + o) = pack8(v);
        } else *(uint4*)(AD + o) = pack8(v);
      }
    }
    SCAN_SYNC();
    if (cidx + 1 < 144) RW_LOAD(cidx + 1)
    {
      const u16* IN = wi == 0 ? TW : AD;
      bf16x8 af0 = *(const bf16x8*)(IN + fr * 72 + fq * 8);
      bf16x8 af1 = *(const bf16x8*)(IN + fr * 72 + 32 + fq * 8);
#pragma unroll
      for (int nt = 0; nt < 4; ++nt) {
        f32x4 o4 = (f32x4){0.f, 0.f, 0.f, 0.f};
        o4 = __builtin_amdgcn_mfma_f32_16x16x32_bf16(af0, *(bf16x8*)&bw[0][nt], o4, 0, 0, 0);
        o4 = __builtin_amdgcn_mfma_f32_16x16x32_bf16(af1, *(bf16x8*)&bw[1][nt], o4, 0, 0, 0);
#pragma unroll
        for (int e = 0; e < 4; ++e) {
          const float prev = l0[nt] + o4[e];
          const int t = fq * 4 + e, c = nt * 16 + fr;
          if (wi == 0) LW[t * 64 + c] = -__expf(-softplus(-prev) - 0.5f);
          else AB[t * 72 + c] = f2bf(sigm(prev));
        }
      }
    }
    SCAN_SYNC();
    {
      const int c = lane;
      float cum = 0.f;
      if (wi == 0) {
#pragma unroll 4
        for (int t = 0; t < 16; ++t) {
          const float lw = LW[t * 64 + c];
          const float gp = __expf(cum);
          cum += lw;
          const float gi = __expf(-cum);
          const float kk = bf2f(KK[t * 72 + c]);
          const float a = bf2f(AB[t * 72 + c]);
          KK[t * 72 + c] = f2bf(kk * gp);
          BG[t * 72 + c] = f2bf(kk * a * gi);
        }
        const float gCv = __expf(cum);
        gC[c] = gCv;
#pragma unroll 4
        for (int t = 0; t < 16; ++t) BgCT[c * 16 + t] = f2bf(-bf2f(BG[t * 72 + c]) * gCv);
      } else {
        float* PR = (float*)TW;
        const float kac = p.rw_ka[h * 64 + c], rkc = p.rw_rk[h * 64 + c];
#pragma unroll 4
        for (int t = 0; t < 16; ++t) {
          const float lw = LW[t * 64 + c];
          cum += lw;
          const float g = __expf(cum), gi = __expf(-cum);
          const float r = bf2f(RK[t * 72 + c]);
          const float k = bf2f(KD[t * 72 + c]);
          const float a = bf2f(AB[t * 72 + c]);
          const float kd = k * (1.f + (a - 1.f) * kac);
          RK[t * 72 + c] = f2bf(r * g);
          KD[t * 72 + c] = f2bf(kd * gi);
          PR[t * 64 + c] = r * kd * rkc;
        }
        const float gCv = __expf(cum);
#pragma unroll 4
        for (int t = 0; t < 16; ++t) KgCT[c * 16 + t] = f2bf(bf2f(KD[t * 72 + c]) * gCv);
        lds_wave_sync();
        {
          const int t = lane >> 2, sg = lane & 3;
          const float4 q0 = *(const float4*)(PR + t * 64 + sg * 16), q1 = *(const float4*)(PR + t * 64 + sg * 16 + 4);
          const float4 q2 = *(const float4*)(PR + t * 64 + sg * 16 + 8), q3 = *(const float4*)(PR + t * 64 + sg * 16 + 12);
          float bsum = (q0.x + q0.y + q0.z + q0.w) + (q1.x + q1.y + q1.z + q1.w) + (q2.x + q2.y + q2.z + q2.w) + (q3.x + q3.y + q3.z + q3.w);
          bsum += __shfl_xor(bsum, 1, 64);
          bsum += __shfl_xor(bsum, 2, 64);
          if (seg == 1 && sg == 0) {
            const int sidx = ch * 16 + t;
            const int tpos = d == 0 ? sidx : 2047 - sidx;
            BS[(size_t)(b * 2048 + tpos) * 16 + h * 2 + d] = bsum;
          }
        }
      }
    }
    SCAN_SYNC();
    __builtin_amdgcn_sched_barrier(0);
    {
      f32x4 XabT = (f32x4){0.f, 0.f, 0.f, 0.f}, XakT = XabT, XrbT = XabT, XrkT = XabT;
#pragma unroll
      for (int ks = 0; ks < 2; ++ks) {
        bf16x8 kkf = *(const bf16x8*)(KK + fr * 72 + ks * 32 + fq * 8);
        bf16x8 rgf = *(const bf16x8*)(RK + fr * 72 + ks * 32 + fq * 8);
        bf16x8 bgf = *(const bf16x8*)(BG + fr * 72 + ks * 32 + fq * 8);
        bf16x8 kgf = *(const bf16x8*)(KD + fr * 72 + ks * 32 + fq * 8);
        XabT = __builtin_amdgcn_mfma_f32_16x16x32_bf16(bgf, kkf, XabT, 0, 0, 0);
        XakT = __builtin_amdgcn_mfma_f32_16x16x32_bf16(kgf, kkf, XakT, 0, 0, 0);
        XrbT = __builtin_amdgcn_mfma_f32_16x16x32_bf16(bgf, rgf, XrbT, 0, 0, 0);
        XrkT = __builtin_amdgcn_mfma_f32_16x16x32_bf16(kgf, rgf, XrkT, 0, 0, 0);
      }
      {
        float am[4];
#pragma unroll
        for (int e = 0; e < 4; ++e) am[e] = (fq * 4 + e < fr) ? XabT[e] : 0.f;
        *(float4*)(Amat + fr * 16 + fq * 4) = make_float4(am[0], am[1], am[2], am[3]);
      }
      lds_wave_sync();
      if (lane < 16) {
        float x[16];
        x[0] = (lane == 0) ? 1.f : 0.f;
        float4 cur[4], nxt[4];
        cur[0] = *(const float4*)(Amat + 16);
        cur[1] = cur[0]; cur[2] = cur[0]; cur[3] = cur[0];
#pragma unroll
        for (int i = 1; i < 16; ++i) {
          __builtin_amdgcn_sched_barrier(0);
          if (i + 1 < 16) {
#pragma unroll
            for (int q = 0; q < (i + 4) / 4; ++q) nxt[q] = *(const float4*)(Amat + (i + 1) * 16 + q * 4);
          }
          float acc = (i == lane) ? 1.f : 0.f;
#pragma unroll
          for (int j = 0; j < i; ++j) {
            const float4 rv = cur[j >> 2];
            const float av = (j & 3) == 0 ? rv.x : ((j & 3) == 1 ? rv.y : ((j & 3) == 2 ? rv.z : rv.w));
            acc -= av * x[j];
          }
          x[i] = acc;
#pragma unroll
          for (int q = 0; q < 4; ++q) cur[q] = nxt[q];
        }
#pragma unroll
        for (int i = 0; i < 16; ++i) Tinv[i * 16 + lane] = f2bf(x[i]);
      }
      lds_wave_sync();
      f32x4 sa0[2], y0[2];
#pragma unroll
      for (int nt = 0; nt < 2; ++nt) { sa0[nt] = (f32x4){0.f, 0.f, 0.f, 0.f}; y0[nt] = (f32x4){0.f, 0.f, 0.f, 0.f}; }
#pragma unroll
      for (int x = 0; x < 2; ++x) {
        __builtin_amdgcn_sched_barrier(0);
        uint2 k0 = *(const uint2*)(KK + fr * 72 + 32 * x + fq * 4);
        uint2 k1 = *(const uint2*)(KK + fr * 72 + 32 * x + 16 + fq * 4);
        uint2 r0 = *(const uint2*)(RK + fr * 72 + 32 * x + fq * 4);
        uint2 r1 = *(const uint2*)(RK + fr * 72 + 32 * x + 16 + fq * 4);
        uint4 kw = make_uint4(k0.x, k0.y, k1.x, k1.y);
        uint4 rw = make_uint4(r0.x, r0.y, r1.x, r1.y);
#pragma unroll
        for (int nt = 0; nt < 2; ++nt) {
          uint4 sw;
          sw.x = pack2(S[2 * x][nt][0], S[2 * x][nt][1]); sw.y = pack2(S[2 * x][nt][2], S[2 * x][nt][3]);
          sw.z = pack2(S[2 * x + 1][nt][0], S[2 * x + 1][nt][1]); sw.w = pack2(S[2 * x + 1][nt][2], S[2 * x + 1][nt][3]);
          sa0[nt] = __builtin_amdgcn_mfma_f32_16x16x32_bf16(*(bf16x8*)&kw, *(bf16x8*)&sw, sa0[nt], 0, 0, 0);
          y0[nt] = __builtin_amdgcn_mfma_f32_16x16x32_bf16(*(bf16x8*)&rw, *(bf16x8*)&sw, y0[nt], 0, 0, 0);
        }
      }
      float ak[4], rb[4], rk[4];
#pragma unroll
      for (int e = 0; e < 4; ++e) {
        const int j = fq * 4 + e;
        ak[e] = (j < fr) ? XakT[e] : 0.f;
        rb[e] = (j <= fr) ? -XrbT[e] : 0.f;
        rk[e] = (j <= fr) ? XrkT[e] : 0.f;
      }
      const uint4 akw = make_uint4(pack2(ak[0], ak[1]), pack2(ak[2], ak[3]), 0u, 0u);
      const uint4 ybw = make_uint4(pack2(rb[0], rb[1]), pack2(rb[2], rb[3]), pack2(rk[0], rk[1]), pack2(rk[2], rk[3]));
      const uint2 tv = *(const uint2*)(Tinv + fr * 16 + fq * 4);
      const uint4 tw = make_uint4(tv.x, tv.y, 0u, 0u);
      uint4 sv[2];
#pragma unroll
      for (int nt = 0; nt < 2; ++nt) {
        const int vc = wi * 32 + nt * 16 + fr;
        const uint2 vt = *(const uint2*)(VT + vc * 16 + fq * 4);
        const uint4 vb = make_uint4(vt.x, vt.y, 0u, 0u);
        f32x4 rhs = __builtin_amdgcn_mfma_f32_16x16x32_bf16(*(bf16x8*)&akw, *(bf16x8*)&vb, sa0[nt], 0, 0, 0);
        const uint4 rw = make_uint4(pack2(rhs[0], rhs[1]), pack2(rhs[2], rhs[3]), 0u, 0u);
        f32x4 sa = __builtin_amdgcn_mfma_f32_16x16x32_bf16(*(bf16x8*)&tw, *(bf16x8*)&rw, (f32x4){0.f, 0.f, 0.f, 0.f}, 0, 0, 0);
        sv[nt] = make_uint4(pack2(sa[0], sa[1]), pack2(sa[2], sa[3]), vt.x, vt.y);
        f32x4 y = __builtin_amdgcn_mfma_f32_16x16x32_bf16(*(bf16x8*)&ybw, *(bf16x8*)&sv[nt], y0[nt], 0, 0, 0);
        if (seg == 1) {
#pragma unroll
          for (int e = 0; e < 4; ++e) {
            const int sidx = ch * 16 + fq * 4 + e;
            const int tpos = d == 0 ? sidx : 2047 - sidx;
            O4[((size_t)d * NLAT + b * 2048 + tpos) * 512 + h * 64 + vc] = f2bf(y[e]);
          }
        }
      }
#pragma unroll
      for (int mt = 0; mt < 4; ++mt) {
        __builtin_amdgcn_sched_barrier(0);
        const float4 g4 = *(const float4*)(gC + mt * 16 + fq * 4);
        const uint2 bv = *(const uint2*)(BgCT + (mt * 16 + fr) * 16 + fq * 4);
        const uint2 kv = *(const uint2*)(KgCT + (mt * 16 + fr) * 16 + fq * 4);
        const uint4 aw = make_uint4(bv.x, bv.y, kv.x, kv.y);
#pragma unroll
        for (int nt = 0; nt < 2; ++nt) {
          S[mt][nt][0] *= g4.x; S[mt][nt][1] *= g4.y; S[mt][nt][2] *= g4.z; S[mt][nt][3] *= g4.w;
          S[mt][nt] = __builtin_amdgcn_mfma_f32_16x16x32_bf16(*(bf16x8*)&aw, *(bf16x8*)&sv[nt], S[mt][nt], 0, 0, 0);
        }
      }
    }
    SCAN_SYNC();
  }
#undef RW_LOAD
}

template <bool HW>
DEV void gdn_item(const Params& p, int gi, char* smem) {
  const u16* P = (const u16*)(p.ws + OFF_BIG);
  u16* O4 = (u16*)p.out;
  const int tid0 = VTID;
  const int b = gi >> 3, d = (gi >> 2) & 1, h = gi & 3;
  constexpr int BUFB = 23424;
  f32x4 S[8][2];
#pragma unroll
  for (int i = 0; i < 8; ++i)
#pragma unroll
    for (int j = 0; j < 2; ++j) S[i][j] = (f32x4){0.f, 0.f, 0.f, 0.f};
  const float negA = -__expf(p.dn_A_log[d * 4 + h]);
  const float dtb = p.dn_dt_bias[d * 4 + h];
  uint4 pre[3][3];
  float gpre0 = 0.f, gpre1 = 0.f;
#define GDN_LOAD(CI)                                                                               \
  {                                                                                                \
    const int seg_ = (CI) < 16 ? 0 : 1;                                                            \
    const int ch_ = seg_ ? (CI)-16 : (CI);                                                         \
    const int Ls_ = seg_ ? 2048 : 256;                                                             \
    const int rb_ = seg_ ? b * 2048 : NLAT + b * 256;                                              \
    const int sidx_ = ch_ * 16 + stt;                                                              \
    const int t_ = d == 0 ? sidx_ : Ls_ - 1 - sidx_;                                               \
    const u16* prow_ = P + (size_t)(rb_ + t_) * PS1 + DNO;                                         \
    _Pragma("unroll") for (int g = 0; g < 3; ++g) {                                                \
      const int col_ = g * 512 + h * 128 + spart * 8;                                              \
      _Pragma("unroll") for (int tap = 0; tap < 3; ++tap) {                                        \
        const int tt_ = t_ + tap - 1;                                                              \
        if (tt_ >= 0 && tt_ < Ls_) pre[g][tap] = *(const uint4*)(prow_ + (ptrdiff_t)(tap - 1) * PS1 + col_); \
        else pre[g][tap] = make_uint4(0u, 0u, 0u, 0u);                                             \
      }                                                                                            \
    }                                                                                              \
    if (wave == 0) {                                                                               \
      const int s2_ = ch_ * 16 + fr;                                                               \
      const int t2_ = d == 0 ? s2_ : Ls_ - 1 - s2_;                                                \
      const u16* gr_ = P + (size_t)(rb_ + t2_) * PS1 + DNO + 2048;                                 \
      gpre0 = bf2f(gr_[d * 4 + h]);                                                                \
      gpre1 = bf2f(gr_[8 + d * 4 + h]);                                                            \
    }                                                                                              \
  }
  {
    const int tid = tid0, lane = tid & 63, wave = tid >> 6, fr = lane & 15, stt = tid >> 4, spart = tid & 15;
    GDN_LOAD(0)
  }
  for (int cidx = 0; cidx < 144; ++cidx) {
    asm volatile("" ::: "memory");
    int tid = tid0;
    asm volatile("" : "+v"(tid));
    const int lane = tid & 63, wave = tid >> 6, fr = lane & 15, fq = lane >> 4, stt = tid >> 4, spart = tid & 15;
    char* buf = smem;
    u16* Kb = (u16*)buf;
    u16* Qb = Kb + 16 * 136;
    float* Vf = (float*)(buf + 8704);
    u16* KdT = (u16*)(buf + 17152);
    u16* Tinv = (u16*)(buf + 21248);
    u16* Pm = (u16*)(buf + 21760);
    float* Amat = (float*)(buf + 22272);
    float* Gs = (float*)(buf + 23296);
    float* Bs = Gs + 16;
#pragma unroll
    for (int g = 0; g < 3; ++g) {
      __builtin_amdgcn_sched_barrier(0);
      const int col = g * 512 + h * 128 + spart * 8;
      float z[8];
#pragma unroll
      for (int j = 0; j < 8; ++j) z[j] = 0.f;
#pragma unroll
      for (int tap = 0; tap < 3; ++tap) {
        __builtin_amdgcn_sched_barrier(0);
        float f[8];
        unpack8(pre[g][tap], f);
        const float* w = p.dn_conv + tap * 1536 + col;
        float4 w0 = *(const float4*)w, w1 = *(const float4*)(w + 4);
        z[0] += f[0] * w0.x; z[1] += f[1] * w0.y; z[2] += f[2] * w0.z; z[3] += f[3] * w0.w;
        z[4] += f[4] * w1.x; z[5] += f[5] * w1.y; z[6] += f[6] * w1.z; z[7] += f[7] * w1.w;
      }
      float ss = 0.f;
#pragma unroll
      for (int j = 0; j < 8; ++j) { z[j] = silu(z[j]); ss += z[j] * z[j]; }
      if (g < 2) {
        ss += __shfl_xor(ss, 1, 64); ss += __shfl_xor(ss, 2, 64); ss += __shfl_xor(ss, 4, 64); ss += __shfl_xor(ss, 8, 64);
        float sc = rsqrtf(ss + 1e-6f);
        if (g == 0) sc *= 0.08838834764831845f;
#pragma unroll
        for (int j = 0; j < 8; ++j) z[j] *= sc;
        *(uint4*)((g == 0 ? Qb : Kb) + stt * 136 + spart * 8) = pack8(z);
      } else {
        float* dst = Vf + stt * 132 + spart * 8;
        *(float4*)dst = make_float4(z[0], z[1], z[2], z[3]);
        *(float4*)(dst + 4) = make_float4(z[4], z[5], z[6], z[7]);
      }
    }
    if (wave == 0) {
      float g = negA * softplus(gpre0 + dtb);
#pragma unroll
      for (int o = 1; o < 16; o <<= 1) { float n = __shfl_up(g, o, 16); if (fr >= o) g += n; }
      if (lane < 16) { Gs[lane] = g; Bs[lane] = sigm(gpre1); }
    }
    SCAN_SYNC();
    if (wave == 0) {
      f32x4 kk = (f32x4){0.f, 0.f, 0.f, 0.f};
#pragma unroll
      for (int ks = 0; ks < 4; ++ks) {
        bf16x8 kf = *(const bf16x8*)(Kb + fr * 136 + ks * 32 + fq * 8);
        kk = __builtin_amdgcn_mfma_f32_16x16x32_bf16(kf, kf, kk, 0, 0, 0);
      }
      const float Gj = Gs[fr];
#pragma unroll
      for (int e = 0; e < 4; ++e) {
        const int i = fq * 4 + e;
        const float a = (fr < i) ? Bs[i] * kk[e] * __expf(Gs[i] - Gj) : 0.f;
        Amat[i * 16 + fr] = a;
      }
      lds_wave_sync();
      if (lane < 16) {
        float x[16];
        x[0] = (lane == 0) ? 1.f : 0.f;
        float4 cur[4], nxt[4];
        cur[0] = *(const float4*)(Amat + 16);
        cur[1] = cur[0]; cur[2] = cur[0]; cur[3] = cur[0];
#pragma unroll
        for (int i = 1; i < 16; ++i) {
          __builtin_amdgcn_sched_barrier(0);
          if (i + 1 < 16) {
#pragma unroll
            for (int q = 0; q < (i + 4) / 4; ++q) nxt[q] = *(const float4*)(Amat + (i + 1) * 16 + q * 4);
          }
          float acc = (i == lane) ? 1.f : 0.f;
#pragma unroll
          for (int j = 0; j < i; ++j) {
            const float4 rv = cur[j >> 2];
            const float av = (j & 3) == 0 ? rv.x : ((j & 3) == 1 ? rv.y : ((j & 3) == 2 ? rv.z : rv.w));
            acc -= av * x[j];
          }
          x[i] = acc;
#pragma unroll
          for (int q = 0; q < 4; ++q) cur[q] = nxt[q];
        }
#pragma unroll
        for (int i = 0; i < 16; ++i) Tinv[i * 16 + lane] = f2bf(x[i]);
      }
    } else if (wave == 1) {
      f32x4 qk = (f32x4){0.f, 0.f, 0.f, 0.f};
#pragma unroll
      for (int ks = 0; ks < 4; ++ks) {
        bf16x8 qf = *(const bf16x8*)(Qb + fr * 136 + ks * 32 + fq * 8);
        bf16x8 kf = *(const bf16x8*)(Kb + fr * 136 + ks * 32 + fq * 8);
        qk = __builtin_amdgcn_mfma_f32_16x16x32_bf16(qf, kf, qk, 0, 0, 0);
      }
      const float Gj = Gs[fr];
#pragma unroll
      for (int e = 0; e < 4; ++e) {
        const int t = fq * 4 + e;
        const float v = (fr <= t) ? qk[e] * __expf(Gs[t] - Gj) : 0.f;
        Pm[t * 16 + fr] = f2bf(v);
      }
    } else {
      const int k = tid - 128;
      const float GC = Gs[15];
      unsigned w[8];
#pragma unroll
      for (int j = 0; j < 8; ++j) {
        __builtin_amdgcn_sched_barrier(0);
        float v0 = bf2f(Kb[(2 * j) * 136 + k]) * __expf(GC - Gs[2 * j]);
        float v1 = bf2f(Kb[(2 * j + 1) * 136 + k]) * __expf(GC - Gs[2 * j + 1]);
        w[j] = pack2(v0, v1);
      }
      *(uint4*)(KdT + k * 16) = make_uint4(w[0], w[1], w[2], w[3]);
      *(uint4*)(KdT + k * 16 + 8) = make_uint4(w[4], w[5], w[6], w[7]);
    }
    __builtin_amdgcn_sched_barrier(0);
    f32x4 ksv[2], qsv[2];
#pragma unroll
    for (int nt = 0; nt < 2; ++nt) { ksv[nt] = (f32x4){0.f, 0.f, 0.f, 0.f}; qsv[nt] = (f32x4){0.f, 0.f, 0.f, 0.f}; }
#pragma unroll
    for (int x = 0; x < 4; ++x) {
      __builtin_amdgcn_sched_barrier(0);
      uint2 k0 = *(const uint2*)(Kb + fr * 136 + 32 * x + fq * 4);
      uint2 k1 = *(const uint2*)(Kb + fr * 136 + 32 * x + 16 + fq * 4);
      uint2 q0 = *(const uint2*)(Qb + fr * 136 + 32 * x + fq * 4);
      uint2 q1 = *(const uint2*)(Qb + fr * 136 + 32 * x + 16 + fq * 4);
      uint4 kw = make_uint4(k0.x, k0.y, k1.x, k1.y);
      uint4 qw = make_uint4(q0.x, q0.y, q1.x, q1.y);
#pragma unroll
      for (int nt = 0; nt < 2; ++nt) {
        uint4 sw;
        sw.x = pack2(S[2 * x][nt][0], S[2 * x][nt][1]); sw.y = pack2(S[2 * x][nt][2], S[2 * x][nt][3]);
        sw.z = pack2(S[2 * x + 1][nt][0], S[2 * x + 1][nt][1]); sw.w = pack2(S[2 * x + 1][nt][2], S[2 * x + 1][nt][3]);
        ksv[nt] = __builtin_amdgcn_mfma_f32_16x16x32_bf16(*(bf16x8*)&kw, *(bf16x8*)&sw, ksv[nt], 0, 0, 0);
        qsv[nt] = __builtin_amdgcn_mfma_f32_16x16x32_bf16(*(bf16x8*)&qw, *(bf16x8*)&sw, qsv[nt], 0, 0, 0);
      }
    }
    SCAN_SYNC();
    if (cidx + 1 < 144) GDN_LOAD(cidx + 1)
    __builtin_amdgcn_sched_barrier(0);
    {
      const int seg = cidx < 16 ? 0 : 1;
      const int ch = seg ? cidx - 16 : cidx;
      float eG[4], bt[4];
#pragma unroll
      for (int e = 0; e < 4; ++e) { eG[e] = __expf(Gs[fq * 4 + e]); bt[e] = Bs[fq * 4 + e]; }
      const float eGC = __expf(Gs[15]);
      uint2 tv = *(const uint2*)(Tinv + fr * 16 + fq * 4);
      uint2 pv = *(const uint2*)(Pm + fr * 16 + fq * 4);
      uint4 tw = make_uint4(tv.x, tv.y, 0u, 0u);
      uint4 pw = make_uint4(pv.x, pv.y, 0u, 0u);
      uint4 ub[2];
#pragma unroll
      for (int nt = 0; nt < 2; ++nt) {
        const int vc = wave * 32 + nt * 16 + fr;
        float rhs[4];
#pragma unroll
        for (int e = 0; e < 4; ++e) rhs[e] = bt[e] * (Vf[(fq * 4 + e) * 132 + vc] - eG[e] * ksv[nt][e]);
        uint4 rw = make_uint4(pack2(rhs[0], rhs[1]), pack2(rhs[2], rhs[3]), 0u, 0u);
        f32x4 u = __builtin_amdgcn_mfma_f32_16x16x32_bf16(*(bf16x8*)&tw, *(bf16x8*)&rw, (f32x4){0.f, 0.f, 0.f, 0.f}, 0, 0, 0);
        ub[nt] = make_uint4(pack2(u[0], u[1]), pack2(u[2], u[3]), 0u, 0u);
        f32x4 oa;
#pragma unroll
        for (int e = 0; e < 4; ++e) oa[e] = eG[e] * qsv[nt][e];
        oa = __builtin_amdgcn_mfma_f32_16x16x32_bf16(*(bf16x8*)&pw, *(bf16x8*)&ub[nt], oa, 0, 0, 0);
        if (seg == 1) {
#pragma unroll
          for (int e = 0; e < 4; ++e) {
            const int sidx = ch * 16 + fq * 4 + e;
            const int t = d == 0 ? sidx : 2047 - sidx;
            O4[((size_t)(2 + d) * NLAT + b * 2048 + t) * 512 + h * 128 + vc] = f2bf(oa[e]);
          }
        }
      }
#pragma unroll
      for (int mt = 0; mt < 8; ++mt) {
        __builtin_amdgcn_sched_barrier(0);
        uint2 kv = *(const uint2*)(KdT + (mt * 16 + fr) * 16 + fq * 4);
        uint4 kw = make_uint4(kv.x, kv.y, 0u, 0u);
#pragma unroll
        for (int nt = 0; nt < 2; ++nt) {
#pragma unroll
          for (int e = 0; e < 4; ++e) S[mt][nt][e] *= eGC;
          S[mt][nt] = __builtin_amdgcn_mfma_f32_16x16x32_bf16(*(bf16x8*)&kw, *(bf16x8*)&ub[nt], S[mt][nt], 0, 0, 0);
        }
      }
    }
    SCAN_SYNC();
    if (HW) SCAN_SYNC();
  }
#undef GDN_LOAD
}

#undef SCAN_SYNC
DEV void phase_scans(const Params& p, char* smem) {
  if (VNB == 512) {
    if (VHALF == 1) rwkv_item<true>(p, VBID >> 1, smem);
    else gdn_item<true>(p, VBID >> 1, smem);
  } else {
#pragma unroll 1
    for (int it = VBID; it < 512; it += VNB)
      if (it & 1) rwkv_item<false>(p, it >> 1, smem);
    __builtin_amdgcn_sched_barrier(0);
#pragma unroll 1
    for (int it = VBID; it < 512; it += VNB)
      if (!(it & 1)) gdn_item<false>(p, it >> 1, smem);
  }
}

DEV void mixout_item(const Params& p, int it, char* smem) {
  const u16* P = (const u16*)(p.ws + OFF_BIG);
  const u16* O4 = (const u16*)p.out;
  const float* BS = (const float*)(p.ws + OFF_BSUM);
  const u16* G2T = (const u16*)(p.ws + OFF_G2T);
  u16* Y = (u16*)(p.ws + OFF_HY);
  u16* sg = (u16*)smem;
  u16* G = sg + 32 * 136;
  const int tid = VTID, lane = tid & 63, wave = tid >> 6;
  const int fr = lane & 15, fq = lane >> 4;
  const int tok0 = it * 32, tl0 = tok0 & 2047;
  const int tk = tid >> 3, part = tid & 7;
  const int row = tok0 + tk, t = tl0 + tk;
  const bool hasp = t > 0, hasn = t + 1 < 2048;
  const u16* prow = P + (size_t)row * PS1;
  {
#pragma unroll
    for (int q = 0; q < 2; ++q) {
      const int col = 1792 + part * 16 + q * 8;
      float pc[8], pp[8], pn[8], v[8];
      unpack8(*(const uint4*)(prow + col), pc);
      if (hasp) unpack8(*(const uint4*)(prow - PS1 + col), pp);
      else {
#pragma unroll
        for (int j = 0; j < 8; ++j) pp[j] = 0.f;
      }
      if (hasn) unpack8(*(const uint4*)(prow + PS1 + col), pn);
      else {
#pragma unroll
        for (int j = 0; j < 8; ++j) pn[j] = 0.f;
      }
      const float* mu = p.rw_mu + col;
#pragma unroll
      for (int j = 0; j < 8; ++j) v[j] = sigm(pc[j] + mu[j] * (0.5f * (pp[j] + pn[j]) - pc[j]));
      *(uint4*)(sg + tk * 136 + part * 16 + q * 8) = pack8(v);
    }
  }
  HSYNC();
  {
    bf16x8 af[2][4];
#pragma unroll
    for (int mt = 0; mt < 2; ++mt)
#pragma unroll
      for (int ks = 0; ks < 4; ++ks) af[mt][ks] = *(const bf16x8*)(sg + (mt * 16 + fr) * 136 + ks * 32 + fq * 8);
#pragma unroll
    for (int nt = 0; nt < 8; ++nt) {
      const u16* bp = G2T + (size_t)(wave * 128 + nt * 16 + fr) * 128 + fq * 8;
      bf16x8 bf0 = *(const bf16x8*)(bp), bf1 = *(const bf16x8*)(bp + 32), bf2 = *(const bf16x8*)(bp + 64), bf3 = *(const bf16x8*)(bp + 96);
#pragma unroll
      for (int mt = 0; mt < 2; ++mt) {
        f32x4 a = (f32x4){0.f, 0.f, 0.f, 0.f};
        a = __builtin_amdgcn_mfma_f32_16x16x32_bf16(af[mt][0], bf0, a, 0, 0, 0);
        a = __builtin_amdgcn_mfma_f32_16x16x32_bf16(af[mt][1], bf1, a, 0, 0, 0);
        a = __builtin_amdgcn_mfma_f32_16x16x32_bf16(af[mt][2], bf2, a, 0, 0, 0);
        a = __builtin_amdgcn_mfma_f32_16x16x32_bf16(af[mt][3], bf3, a, 0, 0, 0);
#pragma unroll
        for (int e = 0; e < 4; ++e) G[(mt * 16 + fq * 4 + e) * 520 + wave * 128 + nt * 16 + fr] = f2bf(a[e]);
      }
    }
  }
  HSYNC();
  {
    const int hd = part, c0 = hd * 64;
    const u16* of = O4 + (size_t)row * 512 + c0;
    const u16* ob = O4 + ((size_t)NLAT + row) * 512 + c0;
    const float bsum = BS[(size_t)row * 16 + hd * 2] + BS[(size_t)row * 16 + hd * 2 + 1];
    float s1 = 0.f, s2 = 0.f;
#pragma unroll
    for (int q = 0; q < 8; ++q) {
      float a[8], b8[8];
      unpack8(*(const uint4*)(of + q * 8), a);
      unpack8(*(const uint4*)(ob + q * 8), b8);
#pragma unroll
      for (int j = 0; j < 8; ++j) { const float v = a[j] + b8[j]; s1 += v; s2 += v * v; }
    }
    const float mean = s1 * (1.f / 64.f);
    const float var = fmaxf(s2 * (1.f / 64.f) - mean * mean, 0.f);
    const float rs = rsqrtf(var + 64e-5f);
#pragma unroll
    for (int q = 0; q < 8; ++q) {
      const int c = c0 + q * 8;
      float pc[8], pp[8], pn[8], gv[8], o[8], ya[8], yb[8];
      unpack8(*(const uint4*)(of + q * 8), ya);
      unpack8(*(const uint4*)(ob + q * 8), yb);
      unpack8(*(const uint4*)(prow + 1024 + c), pc);
      if (hasp) unpack8(*(const uint4*)(prow - PS1 + 1024 + c), pp);
      else {
#pragma unroll
        for (int j = 0; j < 8; ++j) pp[j] = 0.f;
      }
      if (hasn) unpack8(*(const uint4*)(prow + PS1 + 1024 + c), pn);
      else {
#pragma unroll
        for (int j = 0; j < 8; ++j) pn[j] = 0.f;
      }
      unpack8(*(const uint4*)(G + tk * 520 + c), gv);
      const float* mu = p.rw_mu + 1024 + c;
      const float* gg = p.rw_lnx_g + c;
      const float* gb = p.rw_lnx_b + c;
#pragma unroll
      for (int j = 0; j < 8; ++j) {
        const float vsh = pc[j] + mu[j] * (0.5f * (pp[j] + pn[j]) - pc[j]);
        const float yn = (ya[j] + yb[j] - mean) * rs * gg[j] + gb[j];
        o[j] = (yn + bsum * vsh) * gv[j];
      }
      *(uint4*)(Y + (size_t)row * 1024 + c) = pack8(o);
    }
  }
  {
    const int c0 = part * 64;
    const u16* of = O4 + ((size_t)2 * NLAT + row) * 512 + c0;
    const u16* ob = O4 + ((size_t)3 * NLAT + row) * 512 + c0;
    float s2 = 0.f;
#pragma unroll
    for (int q = 0; q < 8; ++q) {
      float a[8], b8[8];
      unpack8(*(const uint4*)(of + q * 8), a);
      unpack8(*(const uint4*)(ob + q * 8), b8);
#pragma unroll
      for (int j = 0; j < 8; ++j) { const float v = a[j] + b8[j]; s2 += v * v; }
    }
    s2 += __shfl_xor(s2, 1, 64);
    const float rs = rsqrtf(s2 * (1.f / 128.f) + 1e-6f);
    const u16* zr = prow + DNO + 1536 + c0;
    const float* ng = p.dn_norm_g + (part & 1) * 64;
#pragma unroll
    for (int q = 0; q < 8; ++q) {
      float z[8], r8[8], a[8], b8[8];
      unpack8(*(const uint4*)(of + q * 8), a);
      unpack8(*(const uint4*)(ob + q * 8), b8);
      unpack8(*(const uint4*)(zr + q * 8), z);
#pragma unroll
      for (int j = 0; j < 8; ++j) r8[j] = (a[j] + b8[j]) * rs * ng[q * 8 + j] * silu(z[j]);
      *(uint4*)(Y + (size_t)row * 1024 + 512 + c0 + q * 8) = pack8(r8);
    }
  }
  HSYNC();
}

#define XB_TMO      128
#define XB_XCNT(j)  (256  + 64 * (j))
#define XB_XSUB(j)  (1280 + 64 * (j))
#define XB_XGEN(j)  (2304 + 64 * (j))
#define XB_TOP      3328
#define XB_TOPGEN   3392
#define XCD_BAR_WORDS 3456
#define XB_SPIN_CAP (1u << 20)
DEV unsigned xb_ld(unsigned* p) { return __hip_atomic_load(p, __ATOMIC_RELAXED, __HIP_MEMORY_SCOPE_AGENT); }
DEV unsigned xb_add(unsigned* p, unsigned v) { return __hip_atomic_fetch_add(p, v, __ATOMIC_RELAXED, __HIP_MEMORY_SCOPE_AGENT); }
DEV unsigned xb_xcc_id() { return (unsigned)__builtin_amdgcn_s_getreg((3 << 11) | 20) & 0xFu; }
#define XB_SPIN(cond, bar) do { unsigned _sp = 0; while (cond) { __builtin_amdgcn_s_sleep(1); \
    if ((++_sp & 255u) == 0u) { if (xb_ld(&(bar)[XB_TMO])) break; if (_sp > XB_SPIN_CAP) { atomicAdd(&(bar)[XB_TMO], 1u); break; } } } } while (0)
DEV void xcd_barrier_complete(unsigned* bar, unsigned x, unsigned& nloc, unsigned& nx) {
  const unsigned G = gridDim.x;
  unsigned sum, cnt, mine, sp = 0u;
  for (;;) {
    sum = 0u; cnt = 0u; mine = 0u;
#pragma unroll
    for (unsigned j = 0; j < 16; ++j) { const unsigned c = xb_ld(&bar[XB_XCNT(j)]); sum += c; cnt += (c > 0u) ? 1u : 0u; mine = (j == x) ? c : mine; }
    if (sum == G) break;
    __builtin_amdgcn_s_sleep(1);
    if ((++sp & 255u) == 0u) { if (xb_ld(&bar[XB_TMO])) break; if (sp > XB_SPIN_CAP) { atomicAdd(&bar[XB_TMO], 1u); break; } }
  }
  nloc = mine > 0u ? mine : 1u; nx = cnt > 0u ? cnt : 1u;
}
DEV void xcd_barrier(unsigned* bar) {
  asm volatile("s_waitcnt vmcnt(0)" ::: "memory");
  __syncthreads();
  if (threadIdx.x == 0) {
    __builtin_amdgcn_s_waitcnt(0);
    const unsigned x = xb_xcc_id();
    volatile LAS unsigned* st = (volatile LAS unsigned*)(dyn_smem + HS_OFF + 128);
    unsigned nloc = st[0], nx = st[1];
    if (nloc == 0u) { xcd_barrier_complete(bar, x, nloc, nx); st[0] = nloc; st[1] = nx; }
    const unsigned old = xb_add(&bar[XB_XSUB(x)], 1u);
    const unsigned gen = old / nloc;
    if (old + 1u == (gen + 1u) * nloc) {
      __builtin_amdgcn_fence(__ATOMIC_RELEASE, "agent");
      asm volatile("s_waitcnt vmcnt(0)" ::: "memory");
      const unsigned og = xb_add(&bar[XB_TOP], 1u);
      const unsigned tg = og / nx;
      if (og + 1u == (tg + 1u) * nx) xb_add(&bar[XB_TOPGEN], 1u);
      else XB_SPIN(xb_ld(&bar[XB_TOPGEN]) == tg, bar);
      __builtin_amdgcn_fence(__ATOMIC_ACQUIRE, "agent");
      xb_add(&bar[XB_XGEN(x)], 1u);
      asm volatile("s_waitcnt vmcnt(0)" ::: "memory");
    } else {
      XB_SPIN(xb_ld(&bar[XB_XGEN(x)]) == gen, bar);
      __builtin_amdgcn_fence(__ATOMIC_ACQUIRE, "agent");
      asm volatile("s_waitcnt vmcnt(0)" ::: "memory");
    }
  }
  __syncthreads();
}

constexpr int NPHASE = 18;

__global__ void __launch_bounds__(512, 2) mega(Params p, int ph_lo, int ph_hi) {
  char* smem = dyn_smem + VHALF * HALF_LDS;
  if ((threadIdx.x & 255) == 0) *((LAS unsigned*)(dyn_smem + HS_OFF) + (threadIdx.x >> 8) * 16) = 0u;
  __syncthreads();
  cg::grid_group grid = cg::this_grid();
  const float* mv0 = (const float*)(p.ws + OFF_MODV);
  const float* mv1 = mv0 + 33 * 6144;
  u16* X = (u16*)(p.ws + OFF_X);
  u16* HY = (u16*)(p.ws + OFF_HY);
  u16* BIG = (u16*)(p.ws + OFF_BIG);
  unsigned* bar = (unsigned*)(p.ws + OFF_BAR);
  if (threadIdx.x == 0) {
    volatile LAS unsigned* st = (volatile LAS unsigned*)(dyn_smem + HS_OFF + 128);
    st[0] = 0u; st[1] = 0u;
    (void)xb_add(&bar[XB_XCNT(xb_xcc_id())], 1u);
  }
  if (ph_hi < 0) grid.sync();
#define PHASE(n, BODY) if (ph_lo <= (n) && (n) < ph_hi) { BODY; if ((n) + 1 < ph_hi) xcd_barrier(bar); }
  PHASE(0, phase_prep(p, smem))
  PHASE(1, phase_init(p))
  PHASE(2, gemm_phase<0>(HY, 1024, (const u16*)(p.ws + OFF_WIN0), 1024, NTOK, 2304, BIG, PS0, nullptr, dyn_smem))
  PHASE(3, phase_hyprep_rope(p, smem))
  PHASE(4, phase_conv_attn(p, smem))
  PHASE(5, gemm_phase<2>(HY, 1024, (const u16*)(p.ws + OFF_WOUT0), 1024, NTOK, 1024, X, 1024, mv0 + 2 * 1024, dyn_smem))
  PHASE(6, ln_phase<false>(p, NTOK, p.ln_g, p.ln_b, mv0, 3, 4))
  PHASE(7, gemm_phase<1>(HY, 1024, (const u16*)(p.ws + OFF_W1_0), 1024, NTOK, 4096, BIG, 4096, nullptr, dyn_smem))
  PHASE(8, gemm_phase<2>(BIG, 4096, (const u16*)(p.ws + OFF_W2_0), 4096, NTOK, 1024, X, 1024, mv0 + 5 * 1024, dyn_smem))
  PHASE(9, ln_phase<false>(p, NTOK, p.ln_g + 1024, p.ln_b + 1024, mv1, 0, 1))
  PHASE(10, gemm_phase<0>(HY, 1024, (const u16*)(p.ws + OFF_WIN1), 1024, NTOK, 4096, BIG, PS1, nullptr, dyn_smem))
  PHASE(11, phase_scans(p, smem))
  PHASE(12, for (int it = VBID; it < 2048; it += VNB) mixout_item(p, it, smem))
  PHASE(13, gemm_phase<2>(HY, 1024, (const u16*)(p.ws + OFF_WOUT1), 1024, NLAT, 1024, X, 1024, mv1 + 2 * 1024, dyn_smem))
  PHASE(14, ln_phase<false>(p, NLAT, p.ln_g + 2048, p.ln_b + 2048, mv1, 3, 4))
  PHASE(15, gemm_phase<1>(HY, 1024, (const u16*)(p.ws + OFF_W1_1), 1024, NLAT, 4096, BIG, 4096, nullptr, dyn_smem))
  PHASE(16, gemm_phase<2>(BIG, 4096, (const u16*)(p.ws + OFF_W2_1), 4096, NLAT, 1024, X, 1024, mv1 + 5 * 1024, dyn_smem))
  PHASE(17, ln_phase<true>(p, NLAT, p.ln_g + 3072, p.ln_b + 3072, mv1, 0, 1))
}

extern "C" void kernel_launch(void* const* d_in, const int* in_sizes, int n_in, void* d_out, int out_size, void* d_ws,
                              size_t ws_size, hipStream_t stream) {
  static int grid_blocks = 0;
  if (!grid_blocks) {
    int dev = 0, cus = 0, per_cu = 0;
    hipGetDevice(&dev);
    hipDeviceGetAttribute(&cus, hipDeviceAttributeMultiprocessorCount, dev);
    hipFuncSetAttribute((const void*)mega, hipFuncAttributeMaxDynamicSharedMemorySize, LDS_BYTES);
    hipOccupancyMaxActiveBlocksPerMultiprocessor(&per_cu, mega, 512, LDS_BYTES);
    if (per_cu > 1) per_cu = 1;
    if (per_cu < 1) per_cu = 1;
    grid_blocks = cus * per_cu;
  }
  if (ws_size < WS_NEED) fprintf(stderr, "workspace too small: %zu < %zu\n", ws_size, (size_t)WS_NEED);
  Params p{};
  const float** pp = (const float**)&p;
  for (int i = 0; i < 39; ++i) pp[i] = (const float*)d_in[i];
  p.out = (float*)d_out;
  p.ws = (char*)d_ws;
  int lo = 0, hi = NPHASE;
  void* args[] = {&p, &lo, &hi};
  hipMemsetAsync((char*)d_ws + OFF_BAR, 0, XCD_BAR_WORDS * sizeof(unsigned), stream);
  hipError_t e = hipLaunchCooperativeKernel((void*)mega, dim3(grid_blocks), dim3(512), args, LDS_BYTES, stream);
  if (e != hipSuccess) fprintf(stderr, "cooperative launch failed: %s (grid %d)\n", hipGetErrorString(e), grid_blocks);
}
```

```cpp
#include <hip/hip_runtime.h>
#include <hip/hip_cooperative_groups.h>
#include <cstdio>
#include <cstdint>
namespace cg = cooperative_groups;

typedef unsigned short u16;
typedef __attribute__((ext_vector_type(8))) short bf16x8;
typedef __attribute__((ext_vector_type(4))) float f32x4;
typedef __attribute__((ext_vector_type(16))) float f32x16;

#define DEV __device__ __forceinline__

constexpr int NLAT = 65536, NCTX = 8192, NTOK = 73728;
constexpr int PS0 = 2304;
constexpr int PS1 = 4096;
constexpr int DNO = 1920;
constexpr float ALPHA = 1.4142135623730951f;

constexpr size_t OFF_WIN0 = 0;
constexpr size_t OFF_WOUT0 = OFF_WIN0 + (size_t)2304 * 1024 * 2;
constexpr size_t OFF_W1_0 = OFF_WOUT0 + (size_t)1024 * 1024 * 2;
constexpr size_t OFF_W1_1 = OFF_W1_0 + (size_t)4096 * 1024 * 2;
constexpr size_t OFF_W2_0 = OFF_W1_1 + (size_t)4096 * 1024 * 2;
constexpr size_t OFF_W2_1 = OFF_W2_0 + (size_t)4096 * 1024 * 2;
constexpr size_t OFF_WIN1 = OFF_W2_1 + (size_t)4096 * 1024 * 2;
constexpr size_t OFF_WOUT1 = OFF_WIN1 + (size_t)4096 * 1024 * 2;
constexpr size_t OFF_MODV = OFF_WOUT1 + (size_t)1024 * 1024 * 2;
constexpr size_t OFF_KR2048 = OFF_MODV + (size_t)2 * 33 * 6144 * 4;
constexpr size_t OFF_KR256 = OFF_KR2048 + (size_t)512 * 4096 * 2;
constexpr size_t OFF_ROPE = OFF_KR256 + (size_t)512 * 512 * 2;
constexpr size_t OFF_BSUM = OFF_ROPE + 8192;
constexpr size_t OFF_G2T = OFF_BSUM + (size_t)65536 * 16 * 4;
constexpr size_t OFF_BAR = OFF_G2T + (size_t)512 * 128 * 2;
constexpr size_t OFF_X = (size_t)64 << 20;
constexpr size_t OFF_HY = OFF_X + (size_t)NTOK * 1024 * 2;
constexpr size_t OFF_BIG = OFF_HY + (size_t)NTOK * 1024 * 2;
constexpr size_t WS_NEED = OFF_BIG + (size_t)NTOK * 4096 * 2;
static_assert(OFF_BAR + 16384 <= OFF_X, "ws map");
constexpr size_t SO_U = 0;
constexpr size_t SO_X0 = SO_U + (size_t)512 * 32 * 2048 * 2;
constexpr size_t SO_UC = SO_X0 + (size_t)512 * 32 * 2048 * 2;
constexpr size_t SO_X0C = SO_UC + (size_t)512 * 32 * 256 * 2;

struct Params {
  const float *x, *c, *ctx, *c_ctx, *mod_w, *mod_b, *ln_g, *ln_b, *mlp_w1, *mlp_w2, *e_w_in, *e_w_out, *hy_conv,
      *hy_w1, *hy_b1, *hy_w2, *hy_b2, *hy_freq, *hy_w3, *hy_decay, *hy_bias, *attn_sink, *o_w_in, *o_w_out,
      *rw_mu, *rw_w0, *rw_w2, *rw_a0, *rw_a2, *rw_g2, *rw_kk, *rw_ka, *rw_rk, *rw_lnx_g, *rw_lnx_b,
      *dn_conv, *dn_A_log, *dn_dt_bias, *dn_norm_g;
  float* out;
  char* ws;
};

typedef float f32x2_t __attribute__((ext_vector_type(2)));
typedef __bf16 bf16x2_t __attribute__((ext_vector_type(2)));
DEV u16 f2bf(float f) { return __builtin_bit_cast(u16, (__bf16)f); }
DEV float bf2f(u16 h) { return __uint_as_float(((unsigned)h) << 16); }
DEV float bflo(unsigned u) { return __uint_as_float(u << 16); }
DEV float bfhi(unsigned u) { return __uint_as_float(u & 0xffff0000u); }
DEV unsigned pack2(float a, float b) { f32x2_t v = {a, b}; return __builtin_bit_cast(unsigned, __builtin_convertvector(v, bf16x2_t)); }
DEV void unpack8(const uint4& v, float* f) {
  f[0] = bflo(v.x); f[1] = bfhi(v.x); f[2] = bflo(v.y); f[3] = bfhi(v.y);
  f[4] = bflo(v.z); f[5] = bfhi(v.z); f[6] = bflo(v.w); f[7] = bfhi(v.w);
}
DEV uint4 pack8(const float* f) {
  uint4 v; v.x = pack2(f[0], f[1]); v.y = pack2(f[2], f[3]); v.z = pack2(f[4], f[5]); v.w = pack2(f[6], f[7]); return v;
}
DEV int modrow(int r) { return r < NLAT ? (r >> 11) : 32; }
DEV float sigm(float x) { return __builtin_amdgcn_rcpf(1.f + __expf(-x)); }
DEV float silu(float x) { return x * __builtin_amdgcn_rcpf(1.f + __expf(-x)); }
DEV float softplus(float x) { return fmaxf(x, 0.f) + __logf(1.f + __expf(-fabsf(x))); }
DEV float fast_tanh(float x) { return 1.f - 2.f * __builtin_amdgcn_rcpf(1.f + __expf(2.f * x)); }
DEV float wave_sum(float v) {
#pragma unroll
  for (int o = 32; o > 0; o >>= 1) v += __shfl_xor(v, o, 64);
  return v;
}

extern __shared__ __attribute__((aligned(16))) char dyn_smem[];
#define LAS __attribute__((address_space(3)))
constexpr int HALF_LDS = 65536;
constexpr int HS_OFF = 2 * HALF_LDS + 2048;
constexpr int LDS_BYTES = HS_OFF + 256;
#define VTID ((int)(threadIdx.x & 255))
#define VHALF ((int)__builtin_amdgcn_readfirstlane((int)(threadIdx.x >> 8)))
#define VBID ((int)(blockIdx.x * 2 + VHALF))
#define VNB ((int)(gridDim.x * 2))
DEV void hsync() {
  LAS unsigned* cnt = (LAS unsigned*)(dyn_smem + HS_OFF) + VHALF * 16;
  asm volatile("s_waitcnt vmcnt(0) lgkmcnt(0)" ::: "memory");
  unsigned tgt = 0u;
  if ((threadIdx.x & 63) == 0) {
    const unsigned old = __hip_atomic_fetch_add(cnt, 1u, __ATOMIC_RELAXED, __HIP_MEMORY_SCOPE_WORKGROUP);
    tgt = (old & ~3u) + 4u;
  }
  tgt = __builtin_amdgcn_readfirstlane(tgt);
  while (__hip_atomic_load(cnt, __ATOMIC_RELAXED, __HIP_MEMORY_SCOPE_WORKGROUP) < tgt) __builtin_amdgcn_s_sleep(0);
  asm volatile("s_waitcnt lgkmcnt(0)" ::: "memory");
}
#define HSYNC() hsync()

DEV void transpose_tile(const float* __restrict__ src, int K, int N, int Npad, u16* __restrict__ dst, int tile,
                               u16* sm) {
  const int tid = VTID;
  const int ntn = Npad >> 6;
  const int tk = tile / ntn, tn = tile - tk * ntn;
  const int n = tid & 63, kq = tid >> 6;
  const int gn = tn * 64 + n;
#pragma unroll 4
  for (int i = 0; i < 16; ++i) {
    int k = kq + 4 * i;
    float v = (gn < N) ? src[(size_t)(tk * 64 + k) * N + gn] : 0.f;
    sm[n * 66 + k] = f2bf(v);
  }
  HSYNC();
  const int n2 = tid >> 2, q = tid & 3;
  const unsigned* s32 = (const unsigned*)sm + (n2 * 66 + q * 16) / 2;
  uint4 a, b;
  a.x = s32[0]; a.y = s32[1]; a.z = s32[2]; a.w = s32[3];
  b.x = s32[4]; b.y = s32[5]; b.z = s32[6]; b.w = s32[7];
  u16* d = dst + (size_t)(tn * 64 + n2) * K + tk * 64 + q * 16;
  *(uint4*)d = a;
  *(uint4*)(d + 8) = b;
  HSYNC();
}

DEV void modv_item(const Params& p, int it, float* sl) {
  const int tid = VTID;
  const int l = it / 288, rem = it % 288, cc = rem / 3, rg = rem % 3;
  for (int idx = tid; idx < 11 * 1024; idx += 256) {
    int r = rg * 11 + (idx >> 10), k = idx & 1023;
    float cv = (r < 32) ? p.c[r * 1024 + k] : p.c_ctx[k];
    sl[idx] = cv / (1.f + expf(-cv));
  }
  HSYNC();
  const int cl = tid & 63, kg = tid >> 6;
  const int col = cc * 64 + cl;
  float acc[11];
#pragma unroll
  for (int r = 0; r < 11; ++r) acc[r] = 0.f;
  const float* w = p.mod_w + (size_t)l * 1024 * 6144 + (size_t)(kg * 256) * 6144 + col;
#pragma unroll 8
  for (int k = 0; k < 256; ++k) {
    float wv = w[(size_t)k * 6144];
#pragma unroll
    for (int r = 0; r < 11; ++r) acc[r] += sl[r * 1024 + kg * 256 + k] * wv;
  }
  HSYNC();
  float* red = sl;
#pragma unroll
  for (int r = 0; r < 11; ++r) red[(kg * 11 + r) * 64 + cl] = acc[r];
  HSYNC();
  for (int idx = tid; idx < 11 * 64; idx += 256) {
    int r = idx >> 6, c2 = idx & 63;
    float v = red[(0 * 11 + r) * 64 + c2] + red[(1 * 11 + r) * 64 + c2] + red[(2 * 11 + r) * 64 + c2] + red[(3 * 11 + r) * 64 + c2];
    int gcol = cc * 64 + c2;
    ((float*)(p.ws + OFF_MODV))[(size_t)(l * 33 + rg * 11 + r) * 6144 + gcol] = v + p.mod_b[l * 6144 + gcol];
  }
  HSYNC();
}

DEV void filter_item(const Params& p, int it, float* sm) {
  const int L = it < 2048 ? 2048 : 256;
  const int t = it < 2048 ? it : it - 2048;
  u16* R = (u16*)(p.ws + (L == 2048 ? OFF_KR2048 : OFF_KR256));
  float* pe = sm; float* h1 = sm + 64; float* h2 = sm + 128;
  const int tid = VTID;
  const float tn = (float)t / (float)(L - 1);
  if (tid < 33) {
    float v;
    if (tid == 0) v = tn;
    else {
      int i = (tid - 1) & 15;
      double band = 1e-4 + (double)i * ((15.0 - 1e-4) / 15.0);
      double ang = 2.0 * 3.14159265358979323846 * (double)t * band / (double)L;
      v = (tid <= 16) ? (float)cos(ang) : (float)(-sin(ang));
    }
    pe[tid] = v;
  }
  HSYNC();
  if (tid < 64) {
    float acc = p.hy_b1[tid];
#pragma unroll 11
    for (int i = 0; i < 33; ++i) acc += pe[i] * p.hy_w1[i * 64 + tid];
    h1[tid] = sinf(p.hy_freq[tid] * acc);
  }
  HSYNC();
  if (tid < 64) {
    float acc = p.hy_b2[tid];
#pragma unroll 16
    for (int i = 0; i < 64; ++i) acc += h1[i] * p.hy_w2[i * 64 + tid];
    h2[tid] = sinf(p.hy_freq[tid] * acc);
  }
  HSYNC();
#pragma unroll 1
  for (int q = 0; q < 4; ++q) {
    int o = tid + 256 * q;
    float acc = 0.f;
#pragma unroll 16
    for (int i = 0; i < 64; ++i) acc += h2[i] * p.hy_w3[i * 1024 + o];
    float val = acc * expf(-tn * fabsf(p.hy_decay[o]));
    if (o < 512) {
      if (t == 0) val += p.hy_bias[o];
      R[(size_t)o * 2 * L + L - t] = f2bf(val);
    } else {
      int c = o - 512;
      if (t >= 1) R[(size_t)c * 2 * L + L + t] = f2bf(val);
      else R[(size_t)c * 2 * L] = 0;
    }
  }
  HSYNC();
}

DEV void phase_prep(const Params& p, char* smem) {
  constexpr int T_IN0 = 16 * 36, T_OUT = 16 * 16, T_W = 16 * 64;
  constexpr int E0 = T_IN0, E1 = E0 + T_OUT, E2 = E1 + T_W, E3 = E2 + T_W, E4 = E3 + T_W, E5 = E4 + T_W,
                E6 = E5 + T_W, E7 = E6 + T_OUT, E8 = E7 + 576, E9 = E8 + 2304, E10 = E9 + 1, E11 = E10 + 16;
  for (int it = VBID; it < E11; it += VNB) {
    if (it >= E10) transpose_tile(p.rw_g2, 128, 512, 512, (u16*)(p.ws + OFF_G2T), it - E10, (u16*)smem);
    else if (it < E0) transpose_tile(p.e_w_in, 1024, 2304, 2304, (u16*)(p.ws + OFF_WIN0), it, (u16*)smem);
    else if (it < E1) transpose_tile(p.e_w_out, 1024, 1024, 1024, (u16*)(p.ws + OFF_WOUT0), it - E0, (u16*)smem);
    else if (it < E2) transpose_tile(p.mlp_w1, 1024, 4096, 4096, (u16*)(p.ws + OFF_W1_0), it - E1, (u16*)smem);
    else if (it < E3) transpose_tile(p.mlp_w1 + (size_t)1024 * 4096, 1024, 4096, 4096, (u16*)(p.ws + OFF_W1_1), it - E2, (u16*)smem);
    else if (it < E4) transpose_tile(p.mlp_w2, 4096, 1024, 1024, (u16*)(p.ws + OFF_W2_0), it - E3, (u16*)smem);
    else if (it < E5) transpose_tile(p.mlp_w2 + (size_t)1024 * 4096, 4096, 1024, 1024, (u16*)(p.ws + OFF_W2_1), it - E4, (u16*)smem);
    else if (it < E6) transpose_tile(p.o_w_in, 1024, 3984, 4096, (u16*)(p.ws + OFF_WIN1), it - E5, (u16*)smem);
    else if (it < E7) transpose_tile(p.o_w_out, 1024, 1024, 1024, (u16*)(p.ws + OFF_WOUT1), it - E6, (u16*)smem);
    else if (it < E8) modv_item(p, it - E7, (float*)smem);
    else if (it < E9) filter_item(p, it - E8, (float*)smem);
    else {
      float2* tab = (float2*)(p.ws + OFF_ROPE);
      for (int q = 0; q < 4; ++q) {
        int e = VTID * 4 + q;
        int pos = e >> 4, i = e & 15;
        float inv = powf(10000.f, -(float)i / 16.f);
        float ang = (float)pos * inv;
        tab[e] = make_float2(cosf(ang), sinf(ang));
      }
    }
  }
}

DEV void phase_init(const Params& p) {
  const float* mv = (const float*)(p.ws + OFF_MODV);
  u16* X = (u16*)(p.ws + OFF_X);
  u16* HM = (u16*)(p.ws + OFF_HY);
  const size_t total = (size_t)NTOK * 128;
  for (size_t i = (size_t)VBID * 256 + VTID; i < total; i += (size_t)VNB * 256) {
    int r = (int)(i >> 7), c8 = (int)(i & 127) * 8;
    const float* src = r < NLAT ? p.x + (size_t)r * 1024 + c8 : p.ctx + (size_t)(r - NLAT) * 1024 + c8;
    float4 v0 = *(const float4*)src, v1 = *(const float4*)(src + 4);
    const float* m = mv + (size_t)modrow(r) * 6144 + c8;
    float4 h0 = *(const float4*)m, h1 = *(const float4*)(m + 4);
    float4 s0 = *(const float4*)(m + 1024), s1 = *(const float4*)(m + 1028);
    float f[8] = {v0.x, v0.y, v0.z, v0.w, v1.x, v1.y, v1.z, v1.w};
    float sh[8] = {h0.x, h0.y, h0.z, h0.w, h1.x, h1.y, h1.z, h1.w};
    float sc[8] = {s0.x, s0.y, s0.z, s0.w, s1.x, s1.y, s1.z, s1.w};
    float g[8];
#pragma unroll
    for (int j = 0; j < 8; ++j) g[j] = f[j] * (1.f + sc[j]) + sh[j];
    *(uint4*)(X + (size_t)r * 1024 + c8) = pack8(f);
    *(uint4*)(HM + (size_t)r * 1024 + c8) = pack8(g);
  }
}

template <int EPI>
DEV void gemm_phase(const u16* __restrict__ A, int lda, const u16* __restrict__ Bt, int K, int M, int N,
                    u16* __restrict__ C, int ldc, const float* __restrict__ gate, char* smem) {
  const int tid = threadIdx.x, lane = tid & 63, wave = tid >> 6;
  const int wm = wave >> 2, wn = wave & 3;
  const int fr = lane & 15, fq = lane >> 4;
  const int tn = N >> 8, tm = M >> 8, tiles = tm * tn;
  const int nk = K >> 6;
  const int drow = wave * 8 + (lane >> 3);
  const int dchunk = (lane & 7) ^ ((drow >> 1) & 7);
  const size_t lda64 = (size_t)lda * 64, ldb64 = (size_t)K * 64;
  const int sw = fr >> 1;
  const bool xcd_order = (gridDim.x & 7) == 0 && (tm & 31) == 0;
  const int mx = tm >> 3;
#define G_COORDS(IT, M0, N0)                                                   \
  {                                                                            \
    int tm_i, tn_i;                                                            \
    if (xcd_order) {                                                           \
      const int x = (IT) & 7, local = (IT) >> 3;                               \
      const int mg = local / (4 * tn), r = local - mg * 4 * tn;                \
      tn_i = r >> 2;                                                           \
      tm_i = x * mx + mg * 4 + (r & 3);                                        \
    } else { tm_i = (IT) / tn; tn_i = (IT) - tm_i * tn; }                      \
    M0 = tm_i << 8; N0 = tn_i << 8;                                            \
  }
  int m0 = 0, n0 = 0;
  const u16* ag = A;
  const u16* bg = Bt;
  bool primed = false;
  for (int it = blockIdx.x; it < tiles; it += gridDim.x) {
    if (!primed) {
      G_COORDS(it, m0, n0)
      ag = A + (size_t)(m0 + drow) * lda + dchunk * 8;
      bg = Bt + (size_t)(n0 + drow) * K + dchunk * 8;
    }
    f32x4 acc[8][4];
#pragma unroll
    for (int i = 0; i < 8; ++i)
#pragma unroll
      for (int j = 0; j < 4; ++j) acc[i][j] = (f32x4){0.f, 0.f, 0.f, 0.f};
#define G_ISSUE(KT, ST)                                                                                  \
  {                                                                                                      \
    const u16* a2 = ag + (KT)*64;                                                                        \
    const u16* b2 = bg + (KT)*64;                                                                        \
    char* la = smem + (ST)*65536 + wave * 1024;                                                          \
    _Pragma("unroll") for (int j = 0; j < 4; ++j) {                                                      \
      __builtin_amdgcn_global_load_lds((const unsigned*)(a2 + j * lda64), (unsigned*)(la + j * 8192), 16, 0, 0);          \
      __builtin_amdgcn_global_load_lds((const unsigned*)(b2 + j * ldb64), (unsigned*)(la + 32768 + j * 8192), 16, 0, 0);  \
    }                                                                                                    \
  }
    if (!primed) G_ISSUE(0, 0)
#define LDA(i, ks) (*(const bf16x8*)(As + (wm * 128 + (i) * 16 + fr) * 64 + ((((ks) * 4 + fq) ^ sw) * 8)))
#define LDB(j, ks) (*(const bf16x8*)(Bs + (wn * 64 + (j) * 16 + fr) * 64 + ((((ks) * 4 + fq) ^ sw) * 8)))
#define SB __builtin_amdgcn_sched_barrier(0)
#define MFMA_H(R, X0, Y0) acc[R][0] = __builtin_amdgcn_mfma_f32_16x16x32_bf16(Y0, X0, acc[R][0], 0, 0, 0);
#define MFMA_T(R, X0, X1, Y0, Y1, Y2, Y3)                                                  \
  acc[R][1] = __builtin_amdgcn_mfma_f32_16x16x32_bf16(Y1, X0, acc[R][1], 0, 0, 0);         \
  acc[R][2] = __builtin_amdgcn_mfma_f32_16x16x32_bf16(Y2, X0, acc[R][2], 0, 0, 0);         \
  acc[R][3] = __builtin_amdgcn_mfma_f32_16x16x32_bf16(Y3, X0, acc[R][3], 0, 0, 0);         \
  acc[R + 1][0] = __builtin_amdgcn_mfma_f32_16x16x32_bf16(Y0, X1, acc[R + 1][0], 0, 0, 0); \
  acc[R + 1][1] = __builtin_amdgcn_mfma_f32_16x16x32_bf16(Y1, X1, acc[R + 1][1], 0, 0, 0); \
  acc[R + 1][2] = __builtin_amdgcn_mfma_f32_16x16x32_bf16(Y2, X1, acc[R + 1][2], 0, 0, 0); \
  acc[R + 1][3] = __builtin_amdgcn_mfma_f32_16x16x32_bf16(Y3, X1, acc[R + 1][3], 0, 0, 0);
#define G_KLOOP(STAG)                                                                                              \
  {                                                                                                                \
    const bf16x8 zf = {0, 0, 0, 0, 0, 0, 0, 0};                                                                    \
    bf16x8 c0 = zf, c1 = zf, c2 = zf, c3 = zf, h0 = zf, h1 = zf;                                                   \
    for (int kt = 0; kt < nk; ++kt) {                                                                              \
      asm volatile("s_waitcnt vmcnt(0)" ::: "memory");                                                             \
      __syncthreads();                                                                                             \
      if (STAG && kt > 0) { SB; MFMA_H(6, h0, c0) MFMA_T(6, h0, h1, c0, c1, c2, c3) SB; }                          \
      if (kt + 1 < nk) G_ISSUE(kt + 1, (kt + 1) & 1)                                                               \
      const u16* As = (const u16*)(smem + (kt & 1) * 65536);                                                       \
      const u16* Bs = As + 16384;                                                                                  \
      bf16x8 b0 = LDB(0, 0), b1 = LDB(1, 0), b2 = LDB(2, 0), b3 = LDB(3, 0);                                       \
      bf16x8 a0 = LDA(0, 0), a1 = LDA(1, 0);                                                                       \
      bf16x8 n0, n1;                                                                                               \
      SB; MFMA_H(0, a0, b0) SB; n0 = LDA(2, 0); n1 = LDA(3, 0); SB; MFMA_T(0, a0, a1, b0, b1, b2, b3) SB;          \
      MFMA_H(2, n0, b0) SB; a0 = LDA(4, 0); a1 = LDA(5, 0); SB; MFMA_T(2, n0, n1, b0, b1, b2, b3) SB;              \
      MFMA_H(4, a0, b0) SB; n0 = LDA(6, 0); n1 = LDA(7, 0); SB; MFMA_T(4, a0, a1, b0, b1, b2, b3) SB;              \
      MFMA_H(6, n0, b0) SB;                                                                                        \
      c0 = LDB(0, 1); c1 = LDB(1, 1); c2 = LDB(2, 1); c3 = LDB(3, 1); a0 = LDA(0, 1); a1 = LDA(1, 1);              \
      SB; MFMA_T(6, n0, n1, b0, b1, b2, b3) SB;                                                                    \
      MFMA_H(0, a0, c0) SB; n0 = LDA(2, 1); n1 = LDA(3, 1); SB; MFMA_T(0, a0, a1, c0, c1, c2, c3) SB;              \
      MFMA_H(2, n0, c0) SB; a0 = LDA(4, 1); a1 = LDA(5, 1); SB; MFMA_T(2, n0, n1, c0, c1, c2, c3) SB;              \
      if (STAG) {                                                                                                  \
        MFMA_H(4, a0, c0) SB; h0 = LDA(6, 1); h1 = LDA(7, 1); SB; MFMA_T(4, a0, a1, c0, c1, c2, c3) SB;            \
      } else {                                                                                                     \
        MFMA_H(4, a0, c0) SB; n0 = LDA(6, 1); n1 = LDA(7, 1); SB; MFMA_T(4, a0, a1, c0, c1, c2, c3) SB;            \
        MFMA_H(6, n0, c0) MFMA_T(6, n0, n1, c0, c1, c2, c3) SB;                                                    \
      }                                                                                                            \
    }                                                                                                              \
    if (STAG) { SB; MFMA_H(6, h0, c0) MFMA_T(6, h0, h1, c0, c1, c2, c3) SB; }                                      \
  }
    if (__builtin_amdgcn_readfirstlane(wave >> 2) != 0) G_KLOOP(true)
    else G_KLOOP(false)
#undef G_KLOOP
#undef LDA
#undef LDB
#undef SB
#undef MFMA_H
#undef MFMA_T
    const int cm0 = m0, cn0 = n0;
    primed = false;
    if (it + (int)gridDim.x < tiles) {
      G_COORDS(it + (int)gridDim.x, m0, n0)
      ag = A + (size_t)(m0 + drow) * lda + dchunk * 8;
      bg = Bt + (size_t)(n0 + drow) * K + dchunk * 8;
      G_ISSUE(0, 0)
      primed = true;
    }
    u16* Cs = (u16*)(smem + 65536);
#pragma unroll 1
    for (int hp = 0; hp < 2; ++hp) {
      asm volatile("s_waitcnt lgkmcnt(0)" ::: "memory");
      __builtin_amdgcn_s_barrier();
      asm volatile("" ::: "memory");
      if (wm == hp) {
#pragma unroll
        for (int i = 0; i < 8; ++i)
#pragma unroll
          for (int j = 0; j < 4; ++j) {
            float v0 = acc[i][j][0], v1 = acc[i][j][1], v2 = acc[i][j][2], v3 = acc[i][j][3];
            if (EPI == 1) {
              v0 = fmaxf(v0, 0.f); v1 = fmaxf(v1, 0.f); v2 = fmaxf(v2, 0.f); v3 = fmaxf(v3, 0.f);
              v0 *= v0; v1 *= v1; v2 *= v2; v3 *= v3;
            }
            *(uint2*)(Cs + (i * 16 + fr) * 264 + wn * 64 + j * 16 + fq * 4) = make_uint2(pack2(v0, v1), pack2(v2, v3));
          }
      }
      asm volatile("s_waitcnt lgkmcnt(0)" ::: "memory");
      __builtin_amdgcn_s_barrier();
      asm volatile("" ::: "memory");
#pragma unroll 2
      for (int q = 0; q < 8; ++q) {
        const int chunk = tid + q * 512;
        const int row = chunk >> 5, cc = chunk & 31;
        uint4 cv = *(const uint4*)(Cs + row * 264 + cc * 8);
        const int grow = cm0 + hp * 128 + row;
        u16* dst = C + (size_t)grow * ldc + cn0 + cc * 8;
        if (EPI == 2) {
          float a[8], xo[8], y[8];
          unpack8(cv, a);
          unpack8(*(const uint4*)dst, xo);
          const float* gr = gate + (size_t)modrow(grow) * 6144 + cn0 + cc * 8;
          float4 g0 = *(const float4*)gr, g1 = *(const float4*)(gr + 4);
          float gg[8] = {g0.x, g0.y, g0.z, g0.w, g1.x, g1.y, g1.z, g1.w};
#pragma unroll
          for (int j = 0; j < 8; ++j) y[j] = ALPHA * xo[j] + gg[j] * a[j];
          cv = pack8(y);
        }
        *(uint4*)dst = cv;
      }
    }
    asm volatile("s_waitcnt lgkmcnt(0)" ::: "memory");
    __builtin_amdgcn_s_barrier();
    asm volatile("" ::: "memory");
  }
#undef G_ISSUE
#undef G_COORDS
}

template <bool FINAL>
DEV void ln_phase(const Params& p, int M, const float* __restrict__ g, const float* __restrict__ b,
                         const float* __restrict__ modl  , int shi, int sci) {
  u16* X = (u16*)(p.ws + OFF_X);
  u16* HM = (u16*)(p.ws + OFF_HY);
  const int lane = VTID & 63;
  const int gw = VBID * 4 + (VTID >> 6), nw = VNB * 4;
  uint4 nx0 = make_uint4(0u, 0u, 0u, 0u), nx1 = nx0;
  if (gw < M) {
    nx0 = *(const uint4*)(X + (size_t)gw * 1024 + lane * 8);
    nx1 = *(const uint4*)(X + (size_t)gw * 1024 + 512 + lane * 8);
  }
  for (int row = gw; row < M; row += nw) {
    u16* xr = X + (size_t)row * 1024;
    float f[16];
    unpack8(nx0, f);
    unpack8(nx1, f + 8);
    if (row + nw < M) {
      nx0 = *(const uint4*)(xr + (size_t)nw * 1024 + lane * 8);
      nx1 = *(const uint4*)(xr + (size_t)nw * 1024 + 512 + lane * 8);
    }
    float s = 0.f, q = 0.f;
#pragma unroll
    for (int j = 0; j < 16; ++j) { s += f[j]; q += f[j] * f[j]; }
#pragma unroll
    for (int o = 32; o > 0; o >>= 1) { s += __shfl_xor(s, o, 64); q += __shfl_xor(q, o, 64); }
    const float mu = s * (1.f / 1024.f);
    const float rs = rsqrtf(fmaxf(q * (1.f / 1024.f) - mu * mu, 0.f) + 1e-5f);
#pragma unroll
    for (int j = 0; j < 16; ++j) f[j] -= mu;
#pragma unroll
    for (int hh = 0; hh < 2; ++hh) {
      const int c0 = hh * 512 + lane * 8;
      float y[8];
#pragma unroll
      for (int j = 0; j < 8; ++j) y[j] = f[hh * 8 + j] * rs * g[c0 + j] + b[c0 + j];
      if (FINAL) {
        float* o = p.out + (size_t)row * 1024 + c0;
        *(float4*)o = make_float4(y[0], y[1], y[2], y[3]);
        *(float4*)(o + 4) = make_float4(y[4], y[5], y[6], y[7]);
      } else {
        *(uint4*)(xr + c0) = pack8(y);
        const float* m = modl + (size_t)modrow(row) * 6144;
        float h[8];
#pragma unroll
        for (int j = 0; j < 8; ++j) h[j] = y[j] * (1.f + m[sci * 1024 + c0 + j]) + m[shi * 1024 + c0 + j];
        *(uint4*)(HM + (size_t)row * 1024 + c0) = pack8(h);
      }
    }
  }
}

DEV void hyprep_item(const Params& p, int it, char* smem) {
  u16* su = (u16*)smem;
  u16* sx = su + 64 * 66;
  const u16* P = (const u16*)(p.ws + OFF_BIG);
  const int tid = VTID;
  const int ct = it & 7, st = it >> 3;
  int b, t0, L, rowbase;
  u16 *U, *X0;
  if (st < 1024) { b = st >> 5; t0 = (st & 31) * 64; L = 2048; rowbase = b * 2048;
    U = (u16*)((char*)p.out + SO_U); X0 = (u16*)((char*)p.out + SO_X0); }
  else { int s2 = st - 1024; b = s2 >> 2; t0 = (s2 & 3) * 64; L = 256; rowbase = NLAT + b * 256;
    U = (u16*)((char*)p.out + SO_UC); X0 = (u16*)((char*)p.out + SO_X0C); }
  const int c0 = ct * 64;
  {
    const int t = tid >> 2, cq = tid & 3;
    float z[3][16];
#pragma unroll
    for (int g = 0; g < 3; ++g)
#pragma unroll
      for (int j = 0; j < 16; ++j) z[g][j] = 0.f;
#pragma unroll
    for (int tap = 0; tap < 3; ++tap) {
      const int tt = t0 + t + tap - 1;
      if (tt >= 0 && tt < L) {
#pragma unroll
        for (int g = 0; g < 3; ++g) {
          const int col = g * 512 + c0 + cq * 16;
          const u16* src = P + (size_t)(rowbase + tt) * PS0 + col;
          float f[16];
          unpack8(*(const uint4*)src, f);
          unpack8(*(const uint4*)(src + 8), f + 8);
          const float* w = p.hy_conv + tap * 1536 + col;
#pragma unroll
          for (int j = 0; j < 16; ++j) z[g][j] += f[j] * w[j];
        }
      }
    }
#pragma unroll
    for (int j = 0; j < 16; ++j) {
      su[t * 66 + cq * 16 + j] = f2bf(z[1][j] * z[2][j]);
      sx[t * 66 + cq * 16 + j] = f2bf(z[0][j]);
    }
  }
  HSYNC();
  {
    const int c = tid >> 2, tq = tid & 3;
    unsigned wu[8], wx[8];
#pragma unroll
    for (int j = 0; j < 8; ++j) {
      wu[j] = (unsigned)su[(tq * 16 + 2 * j) * 66 + c] | ((unsigned)su[(tq * 16 + 2 * j + 1) * 66 + c] << 16);
      wx[j] = (unsigned)sx[(tq * 16 + 2 * j) * 66 + c] | ((unsigned)sx[(tq * 16 + 2 * j + 1) * 66 + c] << 16);
    }
    const size_t o = ((size_t)(c0 + c) * 32 + b) * L + t0 + tq * 16;
    *(uint4*)(U + o) = make_uint4(wu[0], wu[1], wu[2], wu[3]);
    *(uint4*)(U + o + 8) = make_uint4(wu[4], wu[5], wu[6], wu[7]);
    *(uint4*)(X0 + o) = make_uint4(wx[0], wx[1], wx[2], wx[3]);
    *(uint4*)(X0 + o + 8) = make_uint4(wx[4], wx[5], wx[6], wx[7]);
  }
  HSYNC();
}

DEV void rope_item(const Params& p, int it) {
  u16* P = (u16*)(p.ws + OFF_BIG);
  const float2* tab = (const float2*)(p.ws + OFF_ROPE);
  const int task = it * 256 + VTID;
  const int row = task / 40, rem = task - row * 40;
  const int head = rem >> 2, pr = rem & 3;
  const int d0 = (pr >> 1) * 32 + (pr & 1) * 8;
  const int t = row & 2047;
  const int posc = (pr >> 1) ? (t & 63) : (t >> 6);
  const int fi0 = (pr & 1) * 8;
  u16* ptr = P + (size_t)row * PS0 + 1536 + head * 64 + d0;
  float u1[8], u2[8], o1[8], o2[8];
  unpack8(*(const uint4*)ptr, u1);
  unpack8(*(const uint4*)(ptr + 16), u2);
#pragma unroll
  for (int j = 0; j < 8; ++j) {
    float2 cs = tab[posc * 16 + fi0 + j];
    o1[j] = u1[j] * cs.x - u2[j] * cs.y;
    o2[j] = u1[j] * cs.y + u2[j] * cs.x;
  }
  *(uint4*)ptr = pack8(o1);
  *(uint4*)(ptr + 16) = pack8(o2);
}

DEV void phase_hyprep_rope(const Params& p, char* smem) {
  constexpr int NH = 9216, NR = 10240;
  for (int it = VBID; it < NH + NR; it += VNB) {
    if (it < NH) hyprep_item(p, it, smem);
    else rope_item(p, it - NH);
  }
}

template <int L, int NT>
DEV void conv_item(const Params& p, int c, int th, char* smem) {
  const u16* R = (const u16*)(p.ws + (L == 2048 ? OFF_KR2048 : OFF_KR256)) + (size_t)c * 2 * L;
  const u16* U = (const u16*)((const char*)p.out + (L == 2048 ? SO_U : SO_UC));
  const u16* X0 = (const u16*)((const char*)p.out + (L == 2048 ? SO_X0 : SO_X0C));
  u16* Y = (u16*)(p.ws + OFF_HY);
  u16* Rs0 = (u16*)smem;
  u16* Rs1 = Rs0 + 2 * L + 8;
  const int tid = VTID, lane = tid & 63, wave = tid >> 6;
  for (int i = tid; i < 2 * L; i += 256) {
    Rs0[i] = R[i];
    Rs1[i] = (i + 1 < 2 * L) ? R[i + 1] : (u16)0;
  }
  HSYNC();
  const int r = lane & 31, h = lane >> 5;
  const char* lanebase = (r & 1) ? (const char*)Rs1 + 2 * (8 * h - r + L - 1) : (const char*)Rs0 + 2 * (8 * h - r + L);
  const int tw0 = th * 1024 + wave * NT * 32;
  f32x16 acc[NT];
#pragma unroll
  for (int i = 0; i < NT; ++i)
#pragma unroll
    for (int e = 0; e < 16; ++e) acc[i][e] = 0.f;
  u16* UC = Rs1 + 2 * L + 8;
  const u16* Ug = U + (size_t)c * 32 * L;
  const u16* ug0 = Ug + (size_t)(tid >> 5) * L + (tid & 31) * 8;
  u16* uc0 = UC + (tid >> 5) * 264 + (tid & 31) * 8;
  uint4 stg0 = *(const uint4*)(ug0), stg1 = *(const uint4*)(ug0 + (size_t)8 * L);
  uint4 stg2 = *(const uint4*)(ug0 + (size_t)16 * L), stg3 = *(const uint4*)(ug0 + (size_t)24 * L);
  for (int chk = 0; chk < L / 256; ++chk) {
    HSYNC();
    *(uint4*)(uc0) = stg0; *(uint4*)(uc0 + 8 * 264) = stg1; *(uint4*)(uc0 + 16 * 264) = stg2; *(uint4*)(uc0 + 24 * 264) = stg3;
    HSYNC();
    if (chk + 1 < L / 256) {
      const u16* un = ug0 + (chk + 1) * 256;
      stg0 = *(const uint4*)(un); stg1 = *(const uint4*)(un + (size_t)8 * L);
      stg2 = *(const uint4*)(un + (size_t)16 * L); stg3 = *(const uint4*)(un + (size_t)24 * L);
    }
#pragma unroll 4
    for (int s2 = 0; s2 < 16; ++s2) {
      const int st = chk * 16 + s2;
      bf16x8 bfrag = *(const bf16x8*)(UC + r * 264 + s2 * 16 + 8 * h);
#pragma unroll
      for (int i = 0; i < NT; ++i) {
        const unsigned* ap = (const unsigned*)(lanebase + 2 * (st * 16 - (tw0 + i * 32)));
        uint4 av = make_uint4(ap[0], ap[1], ap[2], ap[3]);
        acc[i] = __builtin_amdgcn_mfma_f32_32x32x16_bf16(*(bf16x8*)&av, bfrag, acc[i], 0, 0, 0);
      }
    }
  }
  const int rowbase = (L == 2048) ? r * 2048 : NLAT + r * 256;
#pragma unroll
  for (int i = 0; i < NT; ++i) {
#pragma unroll
    for (int g4 = 0; g4 < 4; ++g4) {
      const int tt = tw0 + i * 32 + 8 * g4 + 4 * h;
      uint2 xv = *(const uint2*)(X0 + ((size_t)c * 32 + r) * L + tt);
      float x0[4] = {bflo(xv.x), bfhi(xv.x), bflo(xv.y), bfhi(xv.y)};
#pragma unroll
      for (int e = 0; e < 4; ++e) Y[(size_t)(rowbase + tt + e) * 1024 + c] = f2bf(acc[i][g4 * 4 + e] * x0[e]);
    }
  }
  HSYNC();
}

DEV void attn_item(const Params& p, int b, int hq, int qb, bool isctx, char* smem) {
  const u16* P = (const u16*)(p.ws + OFF_BIG);
  u16* Y = (u16*)(p.ws + OFF_HY);
  u16* Ks = (u16*)smem;
  u16* Vt = Ks + 64 * 72;
  const int tid = VTID, lane = tid & 63, wave = tid >> 6;
  const int nq = lane & 15, quad = lane >> 4;
  const int qrow = (isctx ? NLAT + b * 256 : b * 2048) + qb * 64 + wave * 16 + nq;
  const int qpos = qb * 64 + wave * 16 + nq;
  const int hkv = hq >> 2;
  const int kcol = 2048 + hkv * 64, vcol = 2176 + hkv * 64;
  bf16x8 qf[2];
#pragma unroll
  for (int ks = 0; ks < 2; ++ks)
    qf[ks] = *(const bf16x8*)(P + (size_t)qrow * PS0 + 1536 + hq * 64 + ks * 32 + quad * 8);
  float m = p.attn_sink[hq];
  float lsum = (quad == 0) ? 1.f : 0.f;
  f32x4 oacc[4];
#pragma unroll
  for (int n = 0; n < 4; ++n) oacc[n] = (f32x4){0.f, 0.f, 0.f, 0.f};
  const int nloc = isctx ? 0 : 5;
  for (int ti = 0; ti < nloc + 4; ++ti) {
    int krow0, k0 = 0;
    bool masked;
    if (ti < nloc) {
      k0 = qb * 64 - 128 + ti * 64;
      if (k0 < 0 || k0 >= 2048) continue;
      krow0 = b * 2048 + k0; masked = true;
    } else { krow0 = NLAT + b * 256 + (ti - nloc) * 64; masked = false; }
    HSYNC();
    {
      const int key = tid >> 2, part = tid & 3;
      const u16* kp = P + (size_t)(krow0 + key) * PS0 + kcol + part * 16;
      const u16* vp = P + (size_t)(krow0 + key) * PS0 + vcol + part * 16;
      uint4 k0v = *(const uint4*)kp, k1v = *(const uint4*)(kp + 8);
      uint4 v0v = *(const uint4*)vp, v1v = *(const uint4*)(vp + 8);
      *(uint4*)(Ks + key * 72 + part * 16) = k0v;
      *(uint4*)(Ks + key * 72 + part * 16 + 8) = k1v;
      unsigned vw[8] = {v0v.x, v0v.y, v0v.z, v0v.w, v1v.x, v1v.y, v1v.z, v1v.w};
#pragma unroll
      for (int j = 0; j < 8; ++j) {
        Vt[(part * 16 + 2 * j) * 72 + key] = (u16)(vw[j] & 0xffffu);
        Vt[(part * 16 + 2 * j + 1) * 72 + key] = (u16)(vw[j] >> 16);
      }
    }
    HSYNC();
    f32x4 s[4];
#pragma unroll
    for (int n = 0; n < 4; ++n) {
      s[n] = (f32x4){0.f, 0.f, 0.f, 0.f};
#pragma unroll
      for (int ks = 0; ks < 2; ++ks) {
        bf16x8 kf = *(const bf16x8*)(Ks + (n * 16 + nq) * 72 + ks * 32 + quad * 8);
        s[n] = __builtin_amdgcn_mfma_f32_16x16x32_bf16(kf, qf[ks], s[n], 0, 0, 0);
      }
    }
    float mx = -1e30f;
#pragma unroll
    for (int n = 0; n < 4; ++n)
#pragma unroll
      for (int e = 0; e < 4; ++e) {
        float v = s[n][e] * 0.125f;
        if (masked) {
          int kpos = k0 + n * 16 + quad * 4 + e;
          int d = qpos - kpos;
          if (d > 128 || d < -128) v = -1e30f;
        }
        s[n][e] = v;
        mx = fmaxf(mx, v);
      }
    mx = fmaxf(mx, __shfl_xor(mx, 16, 64));
    mx = fmaxf(mx, __shfl_xor(mx, 32, 64));
    const float mn = fmaxf(m, mx);
    const float al = __expf(m - mn);
    m = mn;
    float ps = 0.f;
#pragma unroll
    for (int n = 0; n < 4; ++n)
#pragma unroll
      for (int e = 0; e < 4; ++e) { float pv = __expf(s[n][e] - mn); s[n][e] = pv; ps += pv; }
    lsum = lsum * al + ps;
#pragma unroll
    for (int n = 0; n < 4; ++n)
#pragma unroll
      for (int e = 0; e < 4; ++e) oacc[n][e] *= al;
#pragma unroll
    for (int hh = 0; hh < 2; ++hh) {
      uint4 pw;
      pw.x = pack2(s[2 * hh][0], s[2 * hh][1]); pw.y = pack2(s[2 * hh][2], s[2 * hh][3]);
      pw.z = pack2(s[2 * hh + 1][0], s[2 * hh + 1][1]); pw.w = pack2(s[2 * hh + 1][2], s[2 * hh + 1][3]);
      bf16x8 pb = *(bf16x8*)&pw;
#pragma unroll
      for (int n = 0; n < 4; ++n) {
        const u16* vr = Vt + (n * 16 + nq) * 72 + quad * 4;
        uint2 va = *(const uint2*)(vr + (2 * hh) * 16);
        uint2 vb = *(const uint2*)(vr + (2 * hh + 1) * 16);
        uint4 vv = make_uint4(va.x, va.y, vb.x, vb.y);
        oacc[n] = __builtin_amdgcn_mfma_f32_16x16x32_bf16(*(bf16x8*)&vv, pb, oacc[n], 0, 0, 0);
      }
    }
  }
  lsum += __shfl_xor(lsum, 16, 64);
  lsum += __shfl_xor(lsum, 32, 64);
  const float inv = 1.f / lsum;
  u16* yo = Y + (size_t)qrow * 1024 + 512 + hq * 64 + quad * 4;
#pragma unroll
  for (int n = 0; n < 4; ++n) {
    uint2 w;
    w.x = pack2(oacc[n][0] * inv, oacc[n][1] * inv);
    w.y = pack2(oacc[n][2] * inv, oacc[n][3] * inv);
    *(uint2*)(yo + n * 16) = w;
  }
  HSYNC();
}

DEV void phase_conv_attn(const Params& p, char* smem) {
  constexpr int N0 = 1024, N1 = N0 + 512, N2 = N1 + 8192, N3 = N2 + 1024;
#pragma unroll 1
  for (int it = VBID; it < N0; it += VNB) conv_item<2048, 8>(p, it >> 1, it & 1, smem);
  __builtin_amdgcn_sched_barrier(0);
#pragma unroll 1
  for (int it = VBID; it < N3; it += VNB) {
    if (it < N0) continue;
    if (it < N1) conv_item<256, 2>(p, it - N0, 0, smem);
  }
  __builtin_amdgcn_sched_barrier(0);
#pragma unroll 1
  for (int it = VBID; it < N3; it += VNB) {
    if (it < N1) continue;
    if (it < N2) { int a = it - N1; attn_item(p, a >> 8, (a >> 5) & 7, a & 31, false, smem); }
    else { int a = it - N2; attn_item(p, a >> 5, (a >> 2) & 7, a & 3, true, smem); }
  }
}

DEV void lds_wave_sync() {
  asm volatile("s_waitcnt lgkmcnt(0)" ::: "memory");
  __builtin_amdgcn_wave_barrier();
}

#define SCAN_SYNC() do { if (HW) __syncthreads(); else hsync(); } while (0)
template <bool HW>
DEV void rwkv_item(const Params& p, int ri, char* smem) {
  const u16* P = (const u16*)(p.ws + OFF_BIG);
  u16* O4 = (u16*)p.out;
  float* BS = (float*)(p.ws + OFF_BSUM);
  const int tid0 = VTID;
  const int wp0 = tid0 >> 7;
  const int cid = ri * 2 + wp0;
  const int b = cid >> 4, d = (cid >> 3) & 1, h = cid & 7;
  f32x4 S[4][2];
#pragma unroll
  for (int i = 0; i < 4; ++i)
#pragma unroll
    for (int j = 0; j < 2; ++j) S[i][j] = (f32x4){0.f, 0.f, 0.f, 0.f};
  uint4 bw[2][4];
  float l0[4];
  {
    const int lane = tid0 & 63, wi = (tid0 >> 6) & 1, fr = lane & 15, fq = lane >> 4;
    const float* wsrc = (wi == 0 ? p.rw_w2 : p.rw_a2) + (size_t)d * 64 * 512 + h * 64;
    const float* bsrc = (wi == 0 ? p.rw_w0 : p.rw_a0) + d * 512 + h * 64;
#pragma unroll
    for (int nt = 0; nt < 4; ++nt) {
      l0[nt] = bsrc[nt * 16 + fr];
#pragma unroll
      for (int ks = 0; ks < 2; ++ks) {
        __builtin_amdgcn_sched_barrier(0);
        float f[8];
        const float* wp_ = wsrc + (size_t)(ks * 32 + fq * 8) * 512 + nt * 16 + fr;
#pragma unroll
        for (int j = 0; j < 8; ++j) f[j] = wp_[j * 512];
        bw[ks][nt] = pack8(f);
      }
    }
  }
  uint4 pre[5][3];
#define RW_LOAD(CI)                                                                                 \
  {                                                                                                 \
    const int seg_ = (CI) < 16 ? 0 : 1;                                                             \
    const int ch_ = seg_ ? (CI)-16 : (CI);                                                          \
    const int Ls_ = seg_ ? 2048 : 256;                                                              \
    const int rb_ = seg_ ? b * 2048 : NLAT + b * 256;                                               \
    const int sidx_ = ch_ * 16 + stt;                                                               \
    const int t_ = d == 0 ? sidx_ : Ls_ - 1 - sidx_;                                                \
    const u16* prow_ = P + (size_t)(rb_ + t_) * PS1 + spart * 8;                                    \
    _Pragma("unroll") for (int g = 0; g < 5; ++g) {                                                 \
      const int col_ = g < 3 ? g * 512 + h * 64 : (g == 3 ? 1536 + d * 64 : 1664 + d * 64);         \
      _Pragma("unroll") for (int tap = 0; tap < 3; ++tap) {                                         \
        const int tt_ = t_ + tap - 1;                                                               \
        if (tt_ >= 0 && tt_ < Ls_) pre[g][tap] = *(const uint4*)(prow_ + (ptrdiff_t)(tap - 1) * PS1 + col_); \
        else pre[g][tap] = make_uint4(0u, 0u, 0u, 0u);                                              \
      }                                                                                             \
    }                                                                                               \
  }
  {
    const int pt = tid0 & 127, stt = pt >> 3, spart = pt & 7;
    RW_LOAD(0)
  }
  for (int cidx = 0; cidx < 144; ++cidx) {
    asm volatile("" ::: "memory");
    int tid = tid0;
    asm volatile("" : "+v"(tid));
    const int lane = tid & 63, wave = tid >> 6, wp = wave >> 1, wi = wave & 1, pt = tid & 127;
    const int fr = lane & 15, fq = lane >> 4, stt = pt >> 3, spart = pt & 7;
    const int seg = cidx < 16 ? 0 : 1;
    const int ch = seg ? cidx - 16 : cidx;
    const int Ls = seg ? 2048 : 256;
    char* base = smem + wp * 32768;
    u16* RK = (u16*)base;
    u16* KD = RK + 1152;
    u16* KK = KD + 1152;
    u16* AB = KK + 1152;
    u16* VT = AB + 1152;
    float* LW = (float*)(base + 11264);
    u16* TW = (u16*)(base + 15360);
    u16* AD = TW + 1152;
    u16* BgCT = (u16*)(base + 19968);
    u16* KgCT = BgCT + 1024;
    float* gC = (float*)(base + 24064);
    float* Amat = (float*)(base + 24320) + wi * 256;
    u16* Tinv = (u16*)(base + 26368) + wi * 256;
    u16* BG = (u16*)(base + 27392);
    {
      const int o = stt * 72 + spart * 8;
#pragma unroll
      for (int g = 0; g < 5; ++g) {
        __builtin_amdgcn_sched_barrier(0);
        const int col = g < 3 ? g * 512 + h * 64 : (g == 3 ? 1536 + d * 64 : 1664 + d * 64);
        float pc[8], pp[8], pn[8], v[8];
        unpack8(pre[g][1], pc); unpack8(pre[g][0], pp); unpack8(pre[g][2], pn);
        const float* mu = p.rw_mu + col + spart * 8;
        float4 m0 = *(const float4*)mu, m1 = *(const float4*)(mu + 4);
        const float mm[8] = {m0.x, m0.y, m0.z, m0.w, m1.x, m1.y, m1.z, m1.w};
#pragma unroll
        for (int j = 0; j < 8; ++j) v[j] = pc[j] + mm[j] * (0.5f * (pp[j] + pn[j]) - pc[j]);
        if (g == 0) *(uint4*)(RK + o) = pack8(v);
        else if (g == 1) {
          *(uint4*)(KD + o) = pack8(v);
          const float* kkw = p.rw_kk + h * 64 + spart * 8;
          float kkv[8];
          float ss = 0.f;
#pragma unroll
          for (int j = 0; j < 8; ++j) { kkv[j] = v[j] * kkw[j]; ss += kkv[j] * kkv[j]; }
          ss += __shfl_xor(ss, 1, 64); ss += __shfl_xor(ss, 2, 64); ss += __shfl_xor(ss, 4, 64);
          const float inv = rsqrtf(ss + 1e-6f);
#pragma unroll
          for (int j = 0; j < 8; ++j) kkv[j] *= inv;
          *(uint4*)(KK + o) = pack8(kkv);
        } else if (g == 2) {
#pragma unroll
          for (int j = 0; j < 8; ++j) VT[(spart * 8 + j) * 16 + stt] = f2bf(v[j]);
        } else if (g == 3) {
#pragma unroll
          for (int j = 0; j < 8; ++j) v[j] = fast_tanh(v[j]);
          *(uint4*)(TW + o) = pack8(v);
        } else *(uint4*)(AD + o) = pack8(v);
      }
    }
    SCAN_SYNC();
    if (cidx + 1 < 144) RW_LOAD(cidx + 1)
    {
      const u16* IN = wi == 0 ? TW : AD;
      bf16x8 af0 = *(const bf16x8*)(IN + fr * 72 + fq * 8);
      bf16x8 af1 = *(const bf16x8*)(IN + fr * 72 + 32 + fq * 8);
#pragma unroll
      for (int nt = 0; nt < 4; ++nt) {
        f32x4 o4 = (f32x4){0.f, 0.f, 0.f, 0.f};
        o4 = __builtin_amdgcn_mfma_f32_16x16x32_bf16(af0, *(bf16x8*)&bw[0][nt], o4, 0, 0, 0);
        o4 = __builtin_amdgcn_mfma_f32_16x16x32_bf16(af1, *(bf16x8*)&bw[1][nt], o4, 0, 0, 0);
#pragma unroll
        for (int e = 0; e < 4; ++e) {
          const float prev = l0[nt] + o4[e];
          const int t = fq * 4 + e, c = nt * 16 + fr;
          if (wi == 0) LW[t * 64 + c] = -__expf(-softplus(-prev) - 0.5f);
          else AB[t * 72 + c] = f2bf(sigm(prev));
        }
      }
    }
    SCAN_SYNC();
    {
      const int c = lane;
      float cum = 0.f;
      if (wi == 0) {
#pragma unroll 4
        for (int t = 0; t < 16; ++t) {
          const float lw = LW[t * 64 + c];
          const float gp = __expf(cum);
          cum += lw;
          const float gi = __expf(-cum);
          const float kk = bf2f(KK[t * 72 + c]);
          const float a = bf2f(AB[t * 72 + c]);
          KK[t * 72 + c] = f2bf(kk * gp);
          BG[t * 72 + c] = f2bf(kk * a * gi);
        }
        const float gCv = __expf(cum);
        gC[c] = gCv;
#pragma unroll 4
        for (int t = 0; t < 16; ++t) BgCT[c * 16 + t] = f2bf(-bf2f(BG[t * 72 + c]) * gCv);
      } else {
        float* PR = (float*)TW;
        const float kac = p.rw_ka[h * 64 + c], rkc = p.rw_rk[h * 64 + c];
#pragma unroll 4
        for (int t = 0; t < 16; ++t) {
          const float lw = LW[t * 64 + c];
          cum += lw;
          const float g = __expf(cum), gi = __expf(-cum);
          const float r = bf2f(RK[t * 72 + c]);
          const float k = bf2f(KD[t * 72 + c]);
          const float a = bf2f(AB[t * 72 + c]);
          const float kd = k * (1.f + (a - 1.f) * kac);
          RK[t * 72 + c] = f2bf(r * g);
          KD[t * 72 + c] = f2bf(kd * gi);
          PR[t * 64 + c] = r * kd * rkc;
        }
        const float gCv = __expf(cum);
#pragma unroll 4
        for (int t = 0; t < 16; ++t) KgCT[c * 16 + t] = f2bf(bf2f(KD[t * 72 + c]) * gCv);
        lds_wave_sync();
        {
          const int t = lane >> 2, sg = lane & 3;
          const float4 q0 = *(const float4*)(PR + t * 64 + sg * 16), q1 = *(const float4*)(PR + t * 64 + sg * 16 + 4);
          const float4 q2 = *(const float4*)(PR + t * 64 + sg * 16 + 8), q3 = *(const float4*)(PR + t * 64 + sg * 16 + 12);
          float bsum = (q0.x + q0.y + q0.z + q0.w) + (q1.x + q1.y + q1.z + q1.w) + (q2.x + q2.y + q2.z + q2.w) + (q3.x + q3.y + q3.z + q3.w);
          bsum += __shfl_xor(bsum, 1, 64);
          bsum += __shfl_xor(bsum, 2, 64);
          if (seg == 1 && sg == 0) {
            const int sidx = ch * 16 + t;
            const int tpos = d == 0 ? sidx : 2047 - sidx;
            BS[(size_t)(b * 2048 + tpos) * 16 + h * 2 + d] = bsum;
          }
        }
      }
    }
    SCAN_SYNC();
    __builtin_amdgcn_sched_barrier(0);
    {
      f32x4 XabT = (f32x4){0.f, 0.f, 0.f, 0.f}, XakT = XabT, XrbT = XabT, XrkT = XabT;
#pragma unroll
      for (int ks = 0; ks < 2; ++ks) {
        bf16x8 kkf = *(const bf16x8*)(KK + fr * 72 + ks * 32 + fq * 8);
        bf16x8 rgf = *(const bf16x8*)(RK + fr * 72 + ks * 32 + fq * 8);
        bf16x8 bgf = *(const bf16x8*)(BG + fr * 72 + ks * 32 + fq * 8);
        bf16x8 kgf = *(const bf16x8*)(KD + fr * 72 + ks * 32 + fq * 8);
        XabT = __builtin_amdgcn_mfma_f32_16x16x32_bf16(bgf, kkf, XabT, 0, 0, 0);
        XakT = __builtin_amdgcn_mfma_f32_16x16x32_bf16(kgf, kkf, XakT, 0, 0, 0);
        XrbT = __builtin_amdgcn_mfma_f32_16x16x32_bf16(bgf, rgf, XrbT, 0, 0, 0);
        XrkT = __builtin_amdgcn_mfma_f32_16x16x32_bf16(kgf, rgf, XrkT, 0, 0, 0);
      }
      {
        float am[4];
#pragma unroll
        for (int e = 0; e < 4; ++e) am[e] = (fq * 4 + e < fr) ? XabT[e] : 0.f;
        *(float4*)(Amat + fr * 16 + fq * 4) = make_float4(am[0], am[1], am[2], am[3]);
      }
      lds_wave_sync();
      if (lane < 16) {
        float x[16];
        x[0] = (lane == 0) ? 1.f : 0.f;
        float4 cur[4], nxt[4];
        cur[0] = *(const float4*)(Amat + 16);
        cur[1] = cur[0]; cur[2] = cur[0]; cur[3] = cur[0];
#pragma unroll
        for (int i = 1; i < 16; ++i) {
          __builtin_amdgcn_sched_barrier(0);
          if (i + 1 < 16) {
#pragma unroll
            for (int q = 0; q < (i + 4) / 4; ++q) nxt[q] = *(const float4*)(Amat + (i + 1) * 16 + q * 4);
          }
          float acc = (i == lane) ? 1.f : 0.f;
#pragma unroll
          for (int j = 0; j < i; ++j) {
            const float4 rv = cur[j >> 2];
            const float av = (j & 3) == 0 ? rv.x : ((j & 3) == 1 ? rv.y : ((j & 3) == 2 ? rv.z : rv.w));
            acc -= av * x[j];
          }
          x[i] = acc;
#pragma unroll
          for (int q = 0; q < 4; ++q) cur[q] = nxt[q];
        }
#pragma unroll
        for (int i = 0; i < 16; ++i) Tinv[i * 16 + lane] = f2bf(x[i]);
      }
      lds_wave_sync();
      f32x4 sa0[2], y0[2];
#pragma unroll
      for (int nt = 0; nt < 2; ++nt) { sa0[nt] = (f32x4){0.f, 0.f, 0.f, 0.f}; y0[nt] = (f32x4){0.f, 0.f, 0.f, 0.f}; }
#pragma unroll
      for (int x = 0; x < 2; ++x) {
        __builtin_amdgcn_sched_barrier(0);
        uint2 k0 = *(const uint2*)(KK + fr * 72 + 32 * x + fq * 4);
        uint2 k1 = *(const uint2*)(KK + fr * 72 + 32 * x + 16 + fq * 4);
        uint2 r0 = *(const uint2*)(RK + fr * 72 + 32 * x + fq * 4);
        uint2 r1 = *(const uint2*)(RK + fr * 72 + 32 * x + 16 + fq * 4);
        uint4 kw = make_uint4(k0.x, k0.y, k1.x, k1.y);
        uint4 rw = make_uint4(r0.x, r0.y, r1.x, r1.y);
#pragma unroll
        for (int nt = 0; nt < 2; ++nt) {
          uint4 sw;
          sw.x = pack2(S[2 * x][nt][0], S[2 * x][nt][1]); sw.y = pack2(S[2 * x][nt][2], S[2 * x][nt][3]);
          sw.z = pack2(S[2 * x + 1][nt][0], S[2 * x + 1][nt][1]); sw.w = pack2(S[2 * x + 1][nt][2], S[2 * x + 1][nt][3]);
          sa0[nt] = __builtin_amdgcn_mfma_f32_16x16x32_bf16(*(bf16x8*)&kw, *(bf16x8*)&sw, sa0[nt], 0, 0, 0);
          y0[nt] = __builtin_amdgcn_mfma_f32_16x16x32_bf16(*(bf16x8*)&rw, *(bf16x8*)&sw, y0[nt], 0, 0, 0);
        }
      }
      float ak[4], rb[4], rk[4];
#pragma unroll
      for (int e = 0; e < 4; ++e) {
        const int j = fq * 4 + e;
        ak[e] = (j < fr) ? XakT[e] : 0.f;
        rb[e] = (j <= fr) ? -XrbT[e] : 0.f;
        rk[e] = (j <= fr) ? XrkT[e] : 0.f;
      }
      const uint4 akw = make_uint4(pack2(ak[0], ak[1]), pack2(ak[2], ak[3]), 0u, 0u);
      const uint4 ybw = make_uint4(pack2(rb[0], rb[1]), pack2(rb[2], rb[3]), pack2(rk[0], rk[1]), pack2(rk[2], rk[3]));
      const uint2 tv = *(const uint2*)(Tinv + fr * 16 + fq * 4);
      const uint4 tw = make_uint4(tv.x, tv.y, 0u, 0u);
      uint4 sv[2];
#pragma unroll
      for (int nt = 0; nt < 2; ++nt) {
        const int vc = wi * 32 + nt * 16 + fr;
        const uint2 vt = *(const uint2*)(VT + vc * 16 + fq * 4);
        const uint4 vb = make_uint4(vt.x, vt.y, 0u, 0u);
        f32x4 rhs = __builtin_amdgcn_mfma_f32_16x16x32_bf16(*(bf16x8*)&akw, *(bf16x8*)&vb, sa0[nt], 0, 0, 0);
        const uint4 rw = make_uint4(pack2(rhs[0], rhs[1]), pack2(rhs[2], rhs[3]), 0u, 0u);
        f32x4 sa = __builtin_amdgcn_mfma_f32_16x16x32_bf16(*(bf16x8*)&tw, *(bf16x8*)&rw, (f32x4){0.f, 0.f, 0.f, 0.f}, 0, 0, 0);
        sv[nt] = make_uint4(pack2(sa[0], sa[1]), pack2(sa[2], sa[3]), vt.x, vt.y);
        f32x4 y = __builtin_amdgcn_mfma_f32_16x16x32_bf16(*(bf16x8*)&ybw, *(bf16x8*)&sv[nt], y0[nt], 0, 0, 0);
        if (seg == 1) {
#pragma unroll
          for (int e = 0; e < 4; ++e) {
            const int sidx = ch * 16 + fq * 4 + e;
            const int tpos = d == 0 ? sidx : 2047 - sidx;
            O4[((size_t)d * NLAT + b * 2048 + tpos) * 512 + h * 64 + vc] = f2bf(y[e]);
          }
        }
      }
#pragma unroll
      for (int mt = 0; mt < 4; ++mt) {
        __builtin_amdgcn_sched_barrier(0);
        const float4 g4 = *(const float4*)(gC + mt * 16 + fq * 4);
        const uint2 bv = *(const uint2*)(BgCT + (mt * 16 + fr) * 16 + fq * 4);
        const uint2 kv = *(const uint2*)(KgCT + (mt * 16 + fr) * 16 + fq * 4);
        const uint4 aw = make_uint4(bv.x, bv.y, kv.x, kv.y);
#pragma unroll
        for (int nt = 0; nt < 2; ++nt) {
          S[mt][nt][0] *= g4.x; S[mt][nt][1] *= g4.y; S[mt][nt][2] *= g4.z; S[mt][nt][3] *= g4.w;
          S[mt][nt] = __builtin_amdgcn_mfma_f32_16x16x32_bf16(*(bf16x8*)&aw, *(bf16x8*)&sv[nt], S[mt][nt], 0, 0, 0);
        }
      }
    }
    SCAN_SYNC();
  }
#undef RW_LOAD
}

template <bool HW>
DEV void gdn_item(const Params& p, int gi, char* smem) {
  const u16* P = (const u16*)(p.ws + OFF_BIG);
  u16* O4 = (u16*)p.out;
  const int tid0 = VTID;
  const int b = gi >> 3, d = (gi >> 2) & 1, h = gi & 3;
  constexpr int BUFB = 23424;
  f32x4 S[8][2];
#pragma unroll
  for (int i = 0; i < 8; ++i)
#pragma unroll
    for (int j = 0; j < 2; ++j) S[i][j] = (f32x4){0.f, 0.f, 0.f, 0.f};
  const float negA = -__expf(p.dn_A_log[d * 4 + h]);
  const float dtb = p.dn_dt_bias[d * 4 + h];
  uint4 pre[3][3];
  float gpre0 = 0.f, gpre1 = 0.f;
#define GDN_LOAD(CI)                                                                               \
  {                                                                                                \
    const int seg_ = (CI) < 16 ? 0 : 1;                                                            \
    const int ch_ = seg_ ? (CI)-16 : (CI);                                                         \
    const int Ls_ = seg_ ? 2048 : 256;                                                             \
    const int rb_ = seg_ ? b * 2048 : NLAT + b * 256;                                              \
    const int sidx_ = ch_ * 16 + stt;                                                              \
    const int t_ = d == 0 ? sidx_ : Ls_ - 1 - sidx_;                                               \
    const u16* prow_ = P + (size_t)(rb_ + t_) * PS1 + DNO;                                         \
    _Pragma("unroll") for (int g = 0; g < 3; ++g) {                                                \
      const int col_ = g * 512 + h * 128 + spart * 8;                                              \
      _Pragma("unroll") for (int tap = 0; tap < 3; ++tap) {                                        \
        const int tt_ = t_ + tap - 1;                                                              \
        if (tt_ >= 0 && tt_ < Ls_) pre[g][tap] = *(const uint4*)(prow_ + (ptrdiff_t)(tap - 1) * PS1 + col_); \
        else pre[g][tap] = make_uint4(0u, 0u, 0u, 0u);                                             \
      }                                                                                            \
    }                                                                                              \
    if (wave == 0) {                                                                               \
      const int s2_ = ch_ * 16 + fr;                                                               \
      const int t2_ = d == 0 ? s2_ : Ls_ - 1 - s2_;                                                \
      const u16* gr_ = P + (size_t)(rb_ + t2_) * PS1 + DNO + 2048;                                 \
      gpre0 = bf2f(gr_[d * 4 + h]);                                                                \
      gpre1 = bf2f(gr_[8 + d * 4 + h]);                                                            \
    }                                                                                              \
  }
  {
    const int tid = tid0, lane = tid & 63, wave = tid >> 6, fr = lane & 15, stt = tid >> 4, spart = tid & 15;
    GDN_LOAD(0)
  }
  for (int cidx = 0; cidx < 144; ++cidx) {
    asm volatile("" ::: "memory");
    int tid = tid0;
    asm volatile("" : "+v"(tid));
    const int lane = tid & 63, wave = tid >> 6, fr = lane & 15, fq = lane >> 4, stt = tid >> 4, spart = tid & 15;
    char* buf = smem;
    u16* Kb = (u16*)buf;
    u16* Qb = Kb + 16 * 136;
    float* Vf = (float*)(buf + 8704);
    u16* KdT = (u16*)(buf + 17152);
    u16* Tinv = (u16*)(buf + 21248);
    u16* Pm = (u16*)(buf + 21760);
    float* Amat = (float*)(buf + 22272);
    float* Gs = (float*)(buf + 23296);
    float* Bs = Gs + 16;
#pragma unroll
    for (int g = 0; g < 3; ++g) {
      __builtin_amdgcn_sched_barrier(0);
      const int col = g * 512 + h * 128 + spart * 8;
      float z[8];
#pragma unroll
      for (int j = 0; j < 8; ++j) z[j] = 0.f;
#pragma unroll
      for (int tap = 0; tap < 3; ++tap) {
        __builtin_amdgcn_sched_barrier(0);
        float f[8];
        unpack8(pre[g][tap], f);
        const float* w = p.dn_conv + tap * 1536 + col;
        float4 w0 = *(const float4*)w, w1 = *(const float4*)(w + 4);
        z[0] += f[0] * w0.x; z[1] += f[1] * w0.y; z[2] += f[2] * w0.z; z[3] += f[3] * w0.w;
        z[4] += f[4] * w1.x; z[5] += f[5] * w1.y; z[6] += f[6] * w1.z; z[7] += f[7] * w1.w;
      }
      float ss = 0.f;
#pragma unroll
      for (int j = 0; j < 8; ++j) { z[j] = silu(z[j]); ss += z[j] * z[j]; }
      if (g < 2) {
        ss += __shfl_xor(ss, 1, 64); ss += __shfl_xor(ss, 2, 64); ss += __shfl_xor(ss, 4, 64); ss += __shfl_xor(ss, 8, 64);
        float sc = rsqrtf(ss + 1e-6f);
        if (g == 0) sc *= 0.08838834764831845f;
#pragma unroll
        for (int j = 0; j < 8; ++j) z[j] *= sc;
        *(uint4*)((g == 0 ? Qb : Kb) + stt * 136 + spart * 8) = pack8(z);
      } else {
        float* dst = Vf + stt * 132 + spart * 8;
        *(float4*)dst = make_float4(z[0], z[1], z[2], z[3]);
        *(float4*)(dst + 4) = make_float4(z[4], z[5], z[6], z[7]);
      }
    }
    if (wave == 0) {
      float g = negA * softplus(gpre0 + dtb);
#pragma unroll
      for (int o = 1; o < 16; o <<= 1) { float n = __shfl_up(g, o, 16); if (fr >= o) g += n; }
      if (lane < 16) { Gs[lane] = g; Bs[lane] = sigm(gpre1); }
    }
    SCAN_SYNC();
    if (wave == 0) {
      f32x4 kk = (f32x4){0.f, 0.f, 0.f, 0.f};
#pragma unroll
      for (int ks = 0; ks < 4; ++ks) {
        bf16x8 kf = *(const bf16x8*)(Kb + fr * 136 + ks * 32 + fq * 8);
        kk = __builtin_amdgcn_mfma_f32_16x16x32_bf16(kf, kf, kk, 0, 0, 0);
      }
      const float Gj = Gs[fr];
#pragma unroll
      for (int e = 0; e < 4; ++e) {
        const int i = fq * 4 + e;
        const float a = (fr < i) ? Bs[i] * kk[e] * __expf(Gs[i] - Gj) : 0.f;
        Amat[i * 16 + fr] = a;
      }
      lds_wave_sync();
      if (lane < 16) {
        float x[16];
        x[0] = (lane == 0) ? 1.f : 0.f;
        float4 cur[4], nxt[4];
        cur[0] = *(const float4*)(Amat + 16);
        cur[1] = cur[0]; cur[2] = cur[0]; cur[3] = cur[0];
#pragma unroll
        for (int i = 1; i < 16; ++i) {
          __builtin_amdgcn_sched_barrier(0);
          if (i + 1 < 16) {
#pragma unroll
            for (int q = 0; q < (i + 4) / 4; ++q) nxt[q] = *(const float4*)(Amat + (i + 1) * 16 + q * 4);
          }
          float acc = (i == lane) ? 1.f : 0.f;
#pragma unroll
          for (int j = 0; j < i; ++j) {
            const float4 rv = cur[j >> 2];
            const float av = (j & 3) == 0 ? rv.x : ((j & 3) == 1 ? rv.y : ((j & 3) == 2 ? rv.z : rv.w));
            acc -= av * x[j];
          }
          x[i] = acc;
#pragma unroll
          for (int q = 0; q < 4; ++q) cur[q] = nxt[q];
        }
#pragma unroll
        for (int i = 0; i < 16; ++i) Tinv[i * 16 + lane] = f2bf(x[i]);
      }
    } else if (wave == 1) {
      f32x4 qk = (f32x4){0.f, 0.f, 0.f, 0.f};
#pragma unroll
      for (int ks = 0; ks < 4; ++ks) {
        bf16x8 qf = *(const bf16x8*)(Qb + fr * 136 + ks * 32 + fq * 8);
        bf16x8 kf = *(const bf16x8*)(Kb + fr * 136 + ks * 32 + fq * 8);
        qk = __builtin_amdgcn_mfma_f32_16x16x32_bf16(qf, kf, qk, 0, 0, 0);
      }
      const float Gj = Gs[fr];
#pragma unroll
      for (int e = 0; e < 4; ++e) {
        const int t = fq * 4 + e;
        const float v = (fr <= t) ? qk[e] * __expf(Gs[t] - Gj) : 0.f;
        Pm[t * 16 + fr] = f2bf(v);
      }
    } else {
      const int k = tid - 128;
      const float GC = Gs[15];
      unsigned w[8];
#pragma unroll
      for (int j = 0; j < 8; ++j) {
        __builtin_amdgcn_sched_barrier(0);
        float v0 = bf2f(Kb[(2 * j) * 136 + k]) * __expf(GC - Gs[2 * j]);
        float v1 = bf2f(Kb[(2 * j + 1) * 136 + k]) * __expf(GC - Gs[2 * j + 1]);
        w[j] = pack2(v0, v1);
      }
      *(uint4*)(KdT + k * 16) = make_uint4(w[0], w[1], w[2], w[3]);
      *(uint4*)(KdT + k * 16 + 8) = make_uint4(w[4], w[5], w[6], w[7]);
    }
    __builtin_amdgcn_sched_barrier(0);
    f32x4 ksv[2], qsv[2];
#pragma unroll
    for (int nt = 0; nt < 2; ++nt) { ksv[nt] = (f32x4){0.f, 0.f, 0.f, 0.f}; qsv[nt] = (f32x4){0.f, 0.f, 0.f, 0.f}; }
#pragma unroll
    for (int x = 0; x < 4; ++x) {
      __builtin_amdgcn_sched_barrier(0);
      uint2 k0 = *(const uint2*)(Kb + fr * 136 + 32 * x + fq * 4);
      uint2 k1 = *(const uint2*)(Kb + fr * 136 + 32 * x + 16 + fq * 4);
      uint2 q0 = *(const uint2*)(Qb + fr * 136 + 32 * x + fq * 4);
      uint2 q1 = *(const uint2*)(Qb + fr * 136 + 32 * x + 16 + fq * 4);
      uint4 kw = make_uint4(k0.x, k0.y, k1.x, k1.y);
      uint4 qw = make_uint4(q0.x, q0.y, q1.x, q1.y);
#pragma unroll
      for (int nt = 0; nt < 2; ++nt) {
        uint4 sw;
        sw.x = pack2(S[2 * x][nt][0], S[2 * x][nt][1]); sw.y = pack2(S[2 * x][nt][2], S[2 * x][nt][3]);
        sw.z = pack2(S[2 * x + 1][nt][0], S[2 * x + 1][nt][1]); sw.w = pack2(S[2 * x + 1][nt][2], S[2 * x + 1][nt][3]);
        ksv[nt] = __builtin_amdgcn_mfma_f32_16x16x32_bf16(*(bf16x8*)&kw, *(bf16x8*)&sw, ksv[nt], 0, 0, 0);
        qsv[nt] = __builtin_amdgcn_mfma_f32_16x16x32_bf16(*(bf16x8*)&qw, *(bf16x8*)&sw, qsv[nt], 0, 0, 0);
      }
    }
    SCAN_SYNC();
    if (cidx + 1 < 144) GDN_LOAD(cidx + 1)
    __builtin_amdgcn_sched_barrier(0);
    {
      const int seg = cidx < 16 ? 0 : 1;
      const int ch = seg ? cidx - 16 : cidx;
      float eG[4], bt[4];
#pragma unroll
      for (int e = 0; e < 4; ++e) { eG[e] = __expf(Gs[fq * 4 + e]); bt[e] = Bs[fq * 4 + e]; }
      const float eGC = __expf(Gs[15]);
      uint2 tv = *(const uint2*)(Tinv + fr * 16 + fq * 4);
      uint2 pv = *(const uint2*)(Pm + fr * 16 + fq * 4);
      uint4 tw = make_uint4(tv.x, tv.y, 0u, 0u);
      uint4 pw = make_uint4(pv.x, pv.y, 0u, 0u);
      uint4 ub[2];
#pragma unroll
      for (int nt = 0; nt < 2; ++nt) {
        const int vc = wave * 32 + nt * 16 + fr;
        float rhs[4];
#pragma unroll
        for (int e = 0; e < 4; ++e) rhs[e] = bt[e] * (Vf[(fq * 4 + e) * 132 + vc] - eG[e] * ksv[nt][e]);
        uint4 rw = make_uint4(pack2(rhs[0], rhs[1]), pack2(rhs[2], rhs[3]), 0u, 0u);
        f32x4 u = __builtin_amdgcn_mfma_f32_16x16x32_bf16(*(bf16x8*)&tw, *(bf16x8*)&rw, (f32x4){0.f, 0.f, 0.f, 0.f}, 0, 0, 0);
        ub[nt] = make_uint4(pack2(u[0], u[1]), pack2(u[2], u[3]), 0u, 0u);
        f32x4 oa;
#pragma unroll
        for (int e = 0; e < 4; ++e) oa[e] = eG[e] * qsv[nt][e];
        oa = __builtin_amdgcn_mfma_f32_16x16x32_bf16(*(bf16x8*)&pw, *(bf16x8*)&ub[nt], oa, 0, 0, 0);
        if (seg == 1) {
#pragma unroll
          for (int e = 0; e < 4; ++e) {
            const int sidx = ch * 16 + fq * 4 + e;
            const int t = d == 0 ? sidx : 2047 - sidx;
            O4[((size_t)(2 + d) * NLAT + b * 2048 + t) * 512 + h * 128 + vc] = f2bf(oa[e]);
          }
        }
      }
#pragma unroll
      for (int mt = 0; mt < 8; ++mt) {
        __builtin_amdgcn_sched_barrier(0);
        uint2 kv = *(const uint2*)(KdT + (mt * 16 + fr) * 16 + fq * 4);
        uint4 kw = make_uint4(kv.x, kv.y, 0u, 0u);
#pragma unroll
        for (int nt = 0; nt < 2; ++nt) {
#pragma unroll
          for (int e = 0; e < 4; ++e) S[mt][nt][e] *= eGC;
          S[mt][nt] = __builtin_amdgcn_mfma_f32_16x16x32_bf16(*(bf16x8*)&kw, *(bf16x8*)&ub[nt], S[mt][nt], 0, 0, 0);
        }
      }
    }
    SCAN_SYNC();
    if (HW) SCAN_SYNC();
  }
#undef GDN_LOAD
}

#undef SCAN_SYNC
DEV void phase_scans(const Params& p, char* smem) {
  if (VNB == 512) {
    if (VHALF == 1) rwkv_item<true>(p, VBID >> 1, smem);
    else gdn_item<true>(p, VBID >> 1, smem);
  } else {
#pragma unroll 1
    for (int it = VBID; it < 512; it += VNB)
      if (it & 1) rwkv_item<false>(p, it >> 1, smem);
    __builtin_amdgcn_sched_barrier(0);
#pragma unroll 1
    for (int it = VBID; it < 512; it += VNB)
      if (!(it & 1)) gdn_item<false>(p, it >> 1, smem);
  }
}

DEV void mixout_item(const Params& p, int it, char* smem) {
  const u16* P = (const u16*)(p.ws + OFF_BIG);
  const u16* O4 = (const u16*)p.out;
  const float* BS = (const float*)(p.ws + OFF_BSUM);
  const u16* G2T = (const u16*)(p.ws + OFF_G2T);
  u16* Y = (u16*)(p.ws + OFF_HY);
  u16* sg = (u16*)smem;
  u16* G = sg + 32 * 136;
  const int tid = VTID, lane = tid & 63, wave = tid >> 6;
  const int fr = lane & 15, fq = lane >> 4;
  const int tok0 = it * 32, tl0 = tok0 & 2047;
  const int tk = tid >> 3, part = tid & 7;
  const int row = tok0 + tk, t = tl0 + tk;
  const bool hasp = t > 0, hasn = t + 1 < 2048;
  const u16* prow = P + (size_t)row * PS1;
  {
#pragma unroll
    for (int q = 0; q < 2; ++q) {
      const int col = 1792 + part * 16 + q * 8;
      float pc[8], pp[8], pn[8], v[8];
      unpack8(*(const uint4*)(prow + col), pc);
      if (hasp) unpack8(*(const uint4*)(prow - PS1 + col), pp);
      else {
#pragma unroll
        for (int j = 0; j < 8; ++j) pp[j] = 0.f;
      }
      if (hasn) unpack8(*(const uint4*)(prow + PS1 + col), pn);
      else {
#pragma unroll
        for (int j = 0; j < 8; ++j) pn[j] = 0.f;
      }
      const float* mu = p.rw_mu + col;
#pragma unroll
      for (int j = 0; j < 8; ++j) v[j] = sigm(pc[j] + mu[j] * (0.5f * (pp[j] + pn[j]) - pc[j]));
      *(uint4*)(sg + tk * 136 + part * 16 + q * 8) = pack8(v);
    }
  }
  HSYNC();
  {
    bf16x8 af[2][4];
#pragma unroll
    for (int mt = 0; mt < 2; ++mt)
#pragma unroll
      for (int ks = 0; ks < 4; ++ks) af[mt][ks] = *(const bf16x8*)(sg + (mt * 16 + fr) * 136 + ks * 32 + fq * 8);
#pragma unroll
    for (int nt = 0; nt < 8; ++nt) {
      const u16* bp = G2T + (size_t)(wave * 128 + nt * 16 + fr) * 128 + fq * 8;
      bf16x8 bf0 = *(const bf16x8*)(bp), bf1 = *(const bf16x8*)(bp + 32), bf2 = *(const bf16x8*)(bp + 64), bf3 = *(const bf16x8*)(bp + 96);
#pragma unroll
      for (int mt = 0; mt < 2; ++mt) {
        f32x4 a = (f32x4){0.f, 0.f, 0.f, 0.f};
        a = __builtin_amdgcn_mfma_f32_16x16x32_bf16(af[mt][0], bf0, a, 0, 0, 0);
        a = __builtin_amdgcn_mfma_f32_16x16x32_bf16(af[mt][1], bf1, a, 0, 0, 0);
        a = __builtin_amdgcn_mfma_f32_16x16x32_bf16(af[mt][2], bf2, a, 0, 0, 0);
        a = __builtin_amdgcn_mfma_f32_16x16x32_bf16(af[mt][3], bf3, a, 0, 0, 0);
#pragma unroll
        for (int e = 0; e < 4; ++e) G[(mt * 16 + fq * 4 + e) * 520 + wave * 128 + nt * 16 + fr] = f2bf(a[e]);
      }
    }
  }
  HSYNC();
  {
    const int hd = part, c0 = hd * 64;
    const u16* of = O4 + (size_t)row * 512 + c0;
    const u16* ob = O4 + ((size_t)NLAT + row) * 512 + c0;
    const float bsum = BS[(size_t)row * 16 + hd * 2] + BS[(size_t)row * 16 + hd * 2 + 1];
    float s1 = 0.f, s2 = 0.f;
#pragma unroll
    for (int q = 0; q < 8; ++q) {
      float a[8], b8[8];
      unpack8(*(const uint4*)(of + q * 8), a);
      unpack8(*(const uint4*)(ob + q * 8), b8);
#pragma unroll
      for (int j = 0; j < 8; ++j) { const float v = a[j] + b8[j]; s1 += v; s2 += v * v; }
    }
    const float mean = s1 * (1.f / 64.f);
    const float var = fmaxf(s2 * (1.f / 64.f) - mean * mean, 0.f);
    const float rs = rsqrtf(var + 64e-5f);
#pragma unroll
    for (int q = 0; q < 8; ++q) {
      const int c = c0 + q * 8;
      float pc[8], pp[8], pn[8], gv[8], o[8], ya[8], yb[8];
      unpack8(*(const uint4*)(of + q * 8), ya);
      unpack8(*(const uint4*)(ob + q * 8), yb);
      unpack8(*(const uint4*)(prow + 1024 + c), pc);
      if (hasp) unpack8(*(const uint4*)(prow - PS1 + 1024 + c), pp);
      else {
#pragma unroll
        for (int j = 0; j < 8; ++j) pp[j] = 0.f;
      }
      if (hasn) unpack8(*(const uint4*)(prow + PS1 + 1024 + c), pn);
      else {
#pragma unroll
        for (int j = 0; j < 8; ++j) pn[j] = 0.f;
      }
      unpack8(*(const uint4*)(G + tk * 520 + c), gv);
      const float* mu = p.rw_mu + 1024 + c;
      const float* gg = p.rw_lnx_g + c;
      const float* gb = p.rw_lnx_b + c;
#pragma unroll
      for (int j = 0; j < 8; ++j) {
        const float vsh = pc[j] + mu[j] * (0.5f * (pp[j] + pn[j]) - pc[j]);
        const float yn = (ya[j] + yb[j] - mean) * rs * gg[j] + gb[j];
        o[j] = (yn + bsum * vsh) * gv[j];
      }
      *(uint4*)(Y + (size_t)row * 1024 + c) = pack8(o);
    }
  }
  {
    const int c0 = part * 64;
    const u16* of = O4 + ((size_t)2 * NLAT + row) * 512 + c0;
    const u16* ob = O4 + ((size_t)3 * NLAT + row) * 512 + c0;
    float s2 = 0.f;
#pragma unroll
    for (int q = 0; q < 8; ++q) {
      float a[8], b8[8];
      unpack8(*(const uint4*)(of + q * 8), a);
      unpack8(*(const uint4*)(ob + q * 8), b8);
#pragma unroll
      for (int j = 0; j < 8; ++j) { const float v = a[j] + b8[j]; s2 += v * v; }
    }
    s2 += __shfl_xor(s2, 1, 64);
    const float rs = rsqrtf(s2 * (1.f / 128.f) + 1e-6f);
    const u16* zr = prow + DNO + 1536 + c0;
    const float* ng = p.dn_norm_g + (part & 1) * 64;
#pragma unroll
    for (int q = 0; q < 8; ++q) {
      float z[8], r8[8], a[8], b8[8];
      unpack8(*(const uint4*)(of + q * 8), a);
      unpack8(*(const uint4*)(ob + q * 8), b8);
      unpack8(*(const uint4*)(zr + q * 8), z);
#pragma unroll
      for (int j = 0; j < 8; ++j) r8[j] = (a[j] + b8[j]) * rs * ng[q * 8 + j] * silu(z[j]);
      *(uint4*)(Y + (size_t)row * 1024 + 512 + c0 + q * 8) = pack8(r8);
    }
  }
  HSYNC();
}

#define XB_TMO      128
#define XB_XCNT(j)  (256  + 64 * (j))
#define XB_XSUB(j)  (1280 + 64 * (j))
#define XB_XGEN(j)  (2304 + 64 * (j))
#define XB_TOP      3328
#define XB_TOPGEN   3392
#define XCD_BAR_WORDS 3456
#define XB_SPIN_CAP (1u << 20)
DEV unsigned xb_ld(unsigned* p) { return __hip_atomic_load(p, __ATOMIC_RELAXED, __HIP_MEMORY_SCOPE_AGENT); }
DEV unsigned xb_add(unsigned* p, unsigned v) { return __hip_atomic_fetch_add(p, v, __ATOMIC_RELAXED, __HIP_MEMORY_SCOPE_AGENT); }
DEV unsigned xb_xcc_id() { return (unsigned)__builtin_amdgcn_s_getreg((3 << 11) | 20) & 0xFu; }
#define XB_SPIN(cond, bar) do { unsigned _sp = 0; while (cond) { __builtin_amdgcn_s_sleep(1); \
    if ((++_sp & 255u) == 0u) { if (xb_ld(&(bar)[XB_TMO])) break; if (_sp > XB_SPIN_CAP) { atomicAdd(&(bar)[XB_TMO], 1u); break; } } } } while (0)
DEV void xcd_barrier_complete(unsigned* bar, unsigned x, unsigned& nloc, unsigned& nx) {
  const unsigned G = gridDim.x;
  unsigned sum, cnt, mine, sp = 0u;
  for (;;) {
    sum = 0u; cnt = 0u; mine = 0u;
#pragma unroll
    for (unsigned j = 0; j < 16; ++j) { const unsigned c = xb_ld(&bar[XB_XCNT(j)]); sum += c; cnt += (c > 0u) ? 1u : 0u; mine = (j == x) ? c : mine; }
    if (sum == G) break;
    __builtin_amdgcn_s_sleep(1);
    if ((++sp & 255u) == 0u) { if (xb_ld(&bar[XB_TMO])) break; if (sp > XB_SPIN_CAP) { atomicAdd(&bar[XB_TMO], 1u); break; } }
  }
  nloc = mine > 0u ? mine : 1u; nx = cnt > 0u ? cnt : 1u;
}
DEV void xcd_barrier(unsigned* bar) {
  asm volatile("s_waitcnt vmcnt(0)" ::: "memory");
  __syncthreads();
  if (threadIdx.x == 0) {
    __builtin_amdgcn_s_waitcnt(0);
    const unsigned x = xb_xcc_id();
    volatile LAS unsigned* st = (volatile LAS unsigned*)(dyn_smem + HS_OFF + 128);
    unsigned nloc = st[0], nx = st[1];
    if (nloc == 0u) { xcd_barrier_complete(bar, x, nloc, nx); st[0] = nloc; st[1] = nx; }
    const unsigned old = xb_add(&bar[XB_XSUB(x)], 1u);
    const unsigned gen = old / nloc;
    if (old + 1u == (gen + 1u) * nloc) {
      __builtin_amdgcn_fence(__ATOMIC_RELEASE, "agent");
      asm volatile("s_waitcnt vmcnt(0)" ::: "memory");
      const unsigned og = xb_add(&bar[XB_TOP], 1u);
      const unsigned tg = og / nx;
      if (og + 1u == (tg + 1u) * nx) xb_add(&bar[XB_TOPGEN], 1u);
      else XB_SPIN(xb_ld(&bar[XB_TOPGEN]) == tg, bar);
      __builtin_amdgcn_fence(__ATOMIC_ACQUIRE, "agent");
      xb_add(&bar[XB_XGEN(x)], 1u);
      asm volatile("s_waitcnt vmcnt(0)" ::: "memory");
    } else {
      XB_SPIN(xb_ld(&bar[XB_XGEN(x)]) == gen, bar);
      __builtin_amdgcn_fence(__ATOMIC_ACQUIRE, "agent");
      asm volatile("s_waitcnt vmcnt(0)" ::: "memory");
    }
  }
  __syncthreads();
}

constexpr int NPHASE = 18;

__global__ void __launch_bounds__(512, 2) mega(Params p, int ph_lo, int ph_hi) {
  char* smem = dyn_smem + VHALF * HALF_LDS;
  if ((threadIdx.x & 255) == 0) *((LAS unsigned*)(dyn_smem + HS_OFF) + (threadIdx.x >> 8) * 16) = 0u;
  __syncthreads();
  cg::grid_group grid = cg::this_grid();
  const float* mv0 = (const float*)(p.ws + OFF_MODV);
  const float* mv1 = mv0 + 33 * 6144;
  u16* X = (u16*)(p.ws + OFF_X);
  u16* HY = (u16*)(p.ws + OFF_HY);
  u16* BIG = (u16*)(p.ws + OFF_BIG);
  unsigned* bar = (unsigned*)(p.ws + OFF_BAR);
  if (threadIdx.x == 0) {
    volatile LAS unsigned* st = (volatile LAS unsigned*)(dyn_smem + HS_OFF + 128);
    st[0] = 0u; st[1] = 0u;
    (void)xb_add(&bar[XB_XCNT(xb_xcc_id())], 1u);
  }
  if (ph_hi < 0) grid.sync();
#define PHASE(n, BODY) if (ph_lo <= (n) && (n) < ph_hi) { BODY; if ((n) + 1 < ph_hi) xcd_barrier(bar); }
  PHASE(0, phase_prep(p, smem))
  PHASE(1, phase_init(p))
  PHASE(2, gemm_phase<0>(HY, 1024, (const u16*)(p.ws + OFF_WIN0), 1024, NTOK, 2304, BIG, PS0, nullptr, dyn_smem))
  PHASE(3, phase_hyprep_rope(p, smem))
  PHASE(4, phase_conv_attn(p, smem))
  PHASE(5, gemm_phase<2>(HY, 1024, (const u16*)(p.ws + OFF_WOUT0), 1024, NTOK, 1024, X, 1024, mv0 + 2 * 1024, dyn_smem))
  PHASE(6, ln_phase<false>(p, NTOK, p.ln_g, p.ln_b, mv0, 3, 4))
  PHASE(7, gemm_phase<1>(HY, 1024, (const u16*)(p.ws + OFF_W1_0), 1024, NTOK, 4096, BIG, 4096, nullptr, dyn_smem))
  PHASE(8, gemm_phase<2>(BIG, 4096, (const u16*)(p.ws + OFF_W2_0), 4096, NTOK, 1024, X, 1024, mv0 + 5 * 1024, dyn_smem))
  PHASE(9, ln_phase<false>(p, NTOK, p.ln_g + 1024, p.ln_b + 1024, mv1, 0, 1))
  PHASE(10, gemm_phase<0>(HY, 1024, (const u16*)(p.ws + OFF_WIN1), 1024, NTOK, 4096, BIG, PS1, nullptr, dyn_smem))
  PHASE(11, phase_scans(p, smem))
  PHASE(12, for (int it = VBID; it < 2048; it += VNB) mixout_item(p, it, smem))
  PHASE(13, gemm_phase<2>(HY, 1024, (const u16*)(p.ws + OFF_WOUT1), 1024, NLAT, 1024, X, 1024, mv1 + 2 * 1024, dyn_smem))
  PHASE(14, ln_phase<false>(p, NLAT, p.ln_g + 2048, p.ln_b + 2048, mv1, 3, 4))
  PHASE(15, gemm_phase<1>(HY, 1024, (const u16*)(p.ws + OFF_W1_1), 1024, NLAT, 4096, BIG, 4096, nullptr, dyn_smem))
  PHASE(16, gemm_phase<2>(BIG, 4096, (const u16*)(p.ws + OFF_W2_1), 4096, NLAT, 1024, X, 1024, mv1 + 5 * 1024, dyn_smem))
  PHASE(17, ln_phase<true>(p, NLAT, p.ln_g + 3072, p.ln_b + 3072, mv1, 0, 1))
}

extern "C" void kernel_launch(void* const* d_in, const int* in_sizes, int n_in, void* d_out, int out_size, void* d_ws,
                              size_t ws_size, hipStream_t stream) {
  static int grid_blocks = 0;
  if (!grid_blocks) {
    int dev = 0, cus = 0, per_cu = 0;
    hipGetDevice(&dev);
    hipDeviceGetAttribute(&cus, hipDeviceAttributeMultiprocessorCount, dev);
    hipFuncSetAttribute((const void*)mega, hipFuncAttributeMaxDynamicSharedMemorySize, LDS_BYTES);
    hipOccupancyMaxActiveBlocksPerMultiprocessor(&per_cu, mega, 512, LDS_BYTES);
    if (per_cu > 1) per_cu = 1;
    if (per_cu < 1) per_cu = 1;
    grid_blocks = cus * per_cu;
  }
  if (ws_size < WS_NEED) fprintf(stderr, "workspace too small: %zu < %zu\n", ws_size, (size_t)WS_NEED);
  Params p{};
  const float** pp = (const float**)&p;
  for (int i = 0; i < 39; ++i) pp[i] = (const float*)d_in[i];
  p.out = (float*)d_out;
  p.ws = (char*)d_ws;
  int lo = 0, hi = NPHASE;
  void* args[] = {&p, &lo, &hi};
  hipMemsetAsync((char*)d_ws + OFF_BAR, 0, XCD_BAR_WORDS * sizeof(unsigned), stream);
  hipError_t e = hipLaunchCooperativeKernel((void*)mega, dim3(grid_blocks), dim3(512), args, LDS_BYTES, stream);
  if (e != hipSuccess) fprintf(stderr, "cooperative launch failed: %s (grid %d)\n", hipGetErrorString(e), grid_blocks);
}
```

```cpp
#include <hip/hip_runtime.h>
#include <hip/hip_cooperative_groups.h>
#include <cstdio>
#include <cstdint>
namespace cg = cooperative_groups;

typedef unsigned short u16;
typedef __attribute__((ext_vector_type(8))) short bf16x8;
typedef __attribute__((ext_vector_type(4))) float f32x4;
typedef __attribute__((ext_vector_type(16))) float f32x16;

#define DEV __device__ __forceinline__

constexpr int NLAT = 65536, NCTX = 8192, NTOK = 73728;
constexpr int PS0 = 2304;
constexpr int PS1 = 4096;
constexpr int DNO = 1920;
constexpr float ALPHA = 1.4142135623730951f;

constexpr size_t OFF_WIN0 = 0;
constexpr size_t OFF_WOUT0 = OFF_WIN0 + (size_t)2304 * 1024 * 2;
constexpr size_t OFF_W1_0 = OFF_WOUT0 + (size_t)1024 * 1024 * 2;
constexpr size_t OFF_W1_1 = OFF_W1_0 + (size_t)4096 * 1024 * 2;
constexpr size_t OFF_W2_0 = OFF_W1_1 + (size_t)4096 * 1024 * 2;
constexpr size_t OFF_W2_1 = OFF_W2_0 + (size_t)4096 * 1024 * 2;
constexpr size_t OFF_WIN1 = OFF_W2_1 + (size_t)4096 * 1024 * 2;
constexpr size_t OFF_WOUT1 = OFF_WIN1 + (size_t)4096 * 1024 * 2;
constexpr size_t OFF_MODV = OFF_WOUT1 + (size_t)1024 * 1024 * 2;
constexpr size_t OFF_KR2048 = OFF_MODV + (size_t)2 * 33 * 6144 * 4;
constexpr size_t OFF_KR256 = OFF_KR2048 + (size_t)512 * 4096 * 2;
constexpr size_t OFF_ROPE = OFF_KR256 + (size_t)512 * 512 * 2;
constexpr size_t OFF_BSUM = OFF_ROPE + 8192;
constexpr size_t OFF_G2T = OFF_BSUM + (size_t)65536 * 16 * 4;
constexpr size_t OFF_BAR = OFF_G2T + (size_t)512 * 128 * 2;
constexpr size_t OFF_X = (size_t)64 << 20;
constexpr size_t OFF_HY = OFF_X + (size_t)NTOK * 1024 * 2;
constexpr size_t OFF_BIG = OFF_HY + (size_t)NTOK * 1024 * 2;
constexpr size_t WS_NEED = OFF_BIG + (size_t)NTOK * 4096 * 2;
static_assert(OFF_BAR + 16384 <= OFF_X, "ws map");
constexpr size_t SO_U = 0;
constexpr size_t SO_X0 = SO_U + (size_t)512 * 32 * 2048 * 2;
constexpr size_t SO_UC = SO_X0 + (size_t)512 * 32 * 2048 * 2;
constexpr size_t SO_X0C = SO_UC + (size_t)512 * 32 * 256 * 2;

struct Params {
  const float *x, *c, *ctx, *c_ctx, *mod_w, *mod_b, *ln_g, *ln_b, *mlp_w1, *mlp_w2, *e_w_in, *e_w_out, *hy_conv,
      *hy_w1, *hy_b1, *hy_w2, *hy_b2, *hy_freq, *hy_w3, *hy_decay, *hy_bias, *attn_sink, *o_w_in, *o_w_out,
      *rw_mu, *rw_w0, *rw_w2, *rw_a0, *rw_a2, *rw_g2, *rw_kk, *rw_ka, *rw_rk, *rw_lnx_g, *rw_lnx_b,
      *dn_conv, *dn_A_log, *dn_dt_bias, *dn_norm_g;
  float* out;
  char* ws;
};

typedef float f32x2_t __attribute__((ext_vector_type(2)));
typedef __bf16 bf16x2_t __attribute__((ext_vector_type(2)));
DEV u16 f2bf(float f) { return __builtin_bit_cast(u16, (__bf16)f); }
DEV float bf2f(u16 h) { return __uint_as_float(((unsigned)h) << 16); }
DEV float bflo(unsigned u) { return __uint_as_float(u << 16); }
DEV float bfhi(unsigned u) { return __uint_as_float(u & 0xffff0000u); }
DEV unsigned pack2(float a, float b) { f32x2_t v = {a, b}; return __builtin_bit_cast(unsigned, __builtin_convertvector(v, bf16x2_t)); }
DEV void unpack8(const uint4& v, float* f) {
  f[0] = bflo(v.x); f[1] = bfhi(v.x); f[2] = bflo(v.y); f[3] = bfhi(v.y);
  f[4] = bflo(v.z); f[5] = bfhi(v.z); f[6] = bflo(v.w); f[7] = bfhi(v.w);
}
DEV uint4 pack8(const float* f) {
  uint4 v; v.x = pack2(f[0], f[1]); v.y = pack2(f[2], f[3]); v.z = pack2(f[4], f[5]); v.w = pack2(f[6], f[7]); return v;
}
DEV int modrow(int r) { return r < NLAT ? (r >> 11) : 32; }
DEV float sigm(float x) { return __builtin_amdgcn_rcpf(1.f + __expf(-x)); }
DEV float silu(float x) { return x * __builtin_amdgcn_rcpf(1.f + __expf(-x)); }
DEV float softplus(float x) { return fmaxf(x, 0.f) + __logf(1.f + __expf(-fabsf(x))); }
DEV float fast_tanh(float x) { return 1.f - 2.f * __builtin_amdgcn_rcpf(1.f + __expf(2.f * x)); }
DEV float wave_sum(float v) {
#pragma unroll
  for (int o = 32; o > 0; o >>= 1) v += __shfl_xor(v, o, 64);
  return v;
}

extern __shared__ __attribute__((aligned(16))) char dyn_smem[];
#define LAS __attribute__((address_space(3)))
constexpr int HALF_LDS = 65536;
constexpr int HS_OFF = 2 * HALF_LDS + 2048;
constexpr int LDS_BYTES = HS_OFF + 256;
#define VTID ((int)(threadIdx.x & 255))
#define VHALF ((int)__builtin_amdgcn_readfirstlane((int)(threadIdx.x >> 8)))
#define VBID ((int)(blockIdx.x * 2 + VHALF))
#define VNB ((int)(gridDim.x * 2))
DEV void hsync() {
  LAS unsigned* cnt = (LAS unsigned*)(dyn_smem + HS_OFF) + VHALF * 16;
  asm volatile("s_waitcnt lgkmcnt(0)" ::: "memory");
  unsigned tgt = 0u;
  if ((threadIdx.x & 63) == 0) {
    const unsigned old = __hip_atomic_fetch_add(cnt, 1u, __ATOMIC_RELAXED, __HIP_MEMORY_SCOPE_WORKGROUP);
    tgt = (old & ~3u) + 4u;
  }
  tgt = __builtin_amdgcn_readfirstlane(tgt);
  while (__hip_atomic_load(cnt, __ATOMIC_RELAXED, __HIP_MEMORY_SCOPE_WORKGROUP) < tgt) __builtin_amdgcn_s_sleep(0);
  asm volatile("s_waitcnt lgkmcnt(0)" ::: "memory");
}
#define HSYNC() hsync()

DEV void transpose_tile(const float* __restrict__ src, int K, int N, int Npad, u16* __restrict__ dst, int tile,
                               u16* sm) {
  const int tid = VTID;
  const int ntn = Npad >> 6;
  const int tk = tile / ntn, tn = tile - tk * ntn;
  const int n = tid & 63, kq = tid >> 6;
  const int gn = tn * 64 + n;
#pragma unroll 4
  for (int i = 0; i < 16; ++i) {
    int k = kq + 4 * i;
    float v = (gn < N) ? src[(size_t)(tk * 64 + k) * N + gn] : 0.f;
    sm[n * 66 + k] = f2bf(v);
  }
  HSYNC();
  const int n2 = tid >> 2, q = tid & 3;
  const unsigned* s32 = (const unsigned*)sm + (n2 * 66 + q * 16) / 2;
  uint4 a, b;
  a.x = s32[0]; a.y = s32[1]; a.z = s32[2]; a.w = s32[3];
  b.x = s32[4]; b.y = s32[5]; b.z = s32[6]; b.w = s32[7];
  u16* d = dst + (size_t)(tn * 64 + n2) * K + tk * 64 + q * 16;
  *(uint4*)d = a;
  *(uint4*)(d + 8) = b;
  HSYNC();
}

DEV void modv_item(const Params& p, int it, float* sl) {
  const int tid = VTID;
  const int l = it / 288, rem = it % 288, cc = rem / 3, rg = rem % 3;
  for (int idx = tid; idx < 11 * 1024; idx += 256) {
    int r = rg * 11 + (idx >> 10), k = idx & 1023;
    float cv = (r < 32) ? p.c[r * 1024 + k] : p.c_ctx[k];
    sl[idx] = cv / (1.f + expf(-cv));
  }
  HSYNC();
  const int cl = tid & 63, kg = tid >> 6;
  const int col = cc * 64 + cl;
  float acc[11];
#pragma unroll
  for (int r = 0; r < 11; ++r) acc[r] = 0.f;
  const float* w = p.mod_w + (size_t)l * 1024 * 6144 + (size_t)(kg * 256) * 6144 + col;
#pragma unroll 8
  for (int k = 0; k < 256; ++k) {
    float wv = w[(size_t)k * 6144];
#pragma unroll
    for (int r = 0; r < 11; ++r) acc[r] += sl[r * 1024 + kg * 256 + k] * wv;
  }
  HSYNC();
  float* red = sl;
#pragma unroll
  for (int r = 0; r < 11; ++r) red[(kg * 11 + r) * 64 + cl] = acc[r];
  HSYNC();
  for (int idx = tid; idx < 11 * 64; idx += 256) {
    int r = idx >> 6, c2 = idx & 63;
    float v = red[(0 * 11 + r) * 64 + c2] + red[(1 * 11 + r) * 64 + c2] + red[(2 * 11 + r) * 64 + c2] + red[(3 * 11 + r) * 64 + c2];
    int gcol = cc * 64 + c2;
    ((float*)(p.ws + OFF_MODV))[(size_t)(l * 33 + rg * 11 + r) * 6144 + gcol] = v + p.mod_b[l * 6144 + gcol];
  }
  HSYNC();
}

DEV void filter_item(const Params& p, int it, float* sm) {
  const int L = it < 2048 ? 2048 : 256;
  const int t = it < 2048 ? it : it - 2048;
  u16* R = (u16*)(p.ws + (L == 2048 ? OFF_KR2048 : OFF_KR256));
  float* pe = sm; float* h1 = sm + 64; float* h2 = sm + 128;
  const int tid = VTID;
  const float tn = (float)t / (float)(L - 1);
  if (tid < 33) {
    float v;
    if (tid == 0) v = tn;
    else {
      int i = (tid - 1) & 15;
      double band = 1e-4 + (double)i * ((15.0 - 1e-4) / 15.0);
      double ang = 2.0 * 3.14159265358979323846 * (double)t * band / (double)L;
      v = (tid <= 16) ? (float)cos(ang) : (float)(-sin(ang));
    }
    pe[tid] = v;
  }
  HSYNC();
  if (tid < 64) {
    float acc = p.hy_b1[tid];
#pragma unroll 11
    for (int i = 0; i < 33; ++i) acc += pe[i] * p.hy_w1[i * 64 + tid];
    h1[tid] = sinf(p.hy_freq[tid] * acc);
  }
  HSYNC();
  if (tid < 64) {
    float acc = p.hy_b2[tid];
#pragma unroll 16
    for (int i = 0; i < 64; ++i) acc += h1[i] * p.hy_w2[i * 64 + tid];
    h2[tid] = sinf(p.hy_freq[tid] * acc);
  }
  HSYNC();
#pragma unroll 1
  for (int q = 0; q < 4; ++q) {
    int o = tid + 256 * q;
    float acc = 0.f;
#pragma unroll 16
    for (int i = 0; i < 64; ++i) acc += h2[i] * p.hy_w3[i * 1024 + o];
    float val = acc * expf(-tn * fabsf(p.hy_decay[o]));
    if (o < 512) {
      if (t == 0) val += p.hy_bias[o];
      R[(size_t)o * 2 * L + L - t] = f2bf(val);
    } else {
      int c = o - 512;
      if (t >= 1) R[(size_t)c * 2 * L + L + t] = f2bf(val);
      else R[(size_t)c * 2 * L] = 0;
    }
  }
  HSYNC();
}

DEV void phase_prep(const Params& p, char* smem) {
  constexpr int T_IN0 = 16 * 36, T_OUT = 16 * 16, T_W = 16 * 64;
  constexpr int E0 = T_IN0, E1 = E0 + T_OUT, E2 = E1 + T_W, E3 = E2 + T_W, E4 = E3 + T_W, E5 = E4 + T_W,
                E6 = E5 + T_W, E7 = E6 + T_OUT, E8 = E7 + 576, E9 = E8 + 2304, E10 = E9 + 1, E11 = E10 + 16;
  for (int it = VBID; it < E11; it += VNB) {
    if (it >= E10) transpose_tile(p.rw_g2, 128, 512, 512, (u16*)(p.ws + OFF_G2T), it - E10, (u16*)smem);
    else if (it < E0) transpose_tile(p.e_w_in, 1024, 2304, 2304, (u16*)(p.ws + OFF_WIN0), it, (u16*)smem);
    else if (it < E1) transpose_tile(p.e_w_out, 1024, 1024, 1024, (u16*)(p.ws + OFF_WOUT0), it - E0, (u16*)smem);
    else if (it < E2) transpose_tile(p.mlp_w1, 1024, 4096, 4096, (u16*)(p.ws + OFF_W1_0), it - E1, (u16*)smem);
    else if (it < E3) transpose_tile(p.mlp_w1 + (size_t)1024 * 4096, 1024, 4096, 4096, (u16*)(p.ws + OFF_W1_1), it - E2, (u16*)smem);
    else if (it < E4) transpose_tile(p.mlp_w2, 4096, 1024, 1024, (u16*)(p.ws + OFF_W2_0), it - E3, (u16*)smem);
    else if (it < E5) transpose_tile(p.mlp_w2 + (size_t)1024 * 4096, 4096, 1024, 1024, (u16*)(p.ws + OFF_W2_1), it - E4, (u16*)smem);
    else if (it < E6) transpose_tile(p.o_w_in, 1024, 3984, 4096, (u16*)(p.ws + OFF_WIN1), it - E5, (u16*)smem);
    else if (it < E7) transpose_tile(p.o_w_out, 1024, 1024, 1024, (u16*)(p.ws + OFF_WOUT1), it - E6, (u16*)smem);
    else if (it < E8) modv_item(p, it - E7, (float*)smem);
    else if (it < E9) filter_item(p, it - E8, (float*)smem);
    else {
      float2* tab = (float2*)(p.ws + OFF_ROPE);
      for (int q = 0; q < 4; ++q) {
        int e = VTID * 4 + q;
        int pos = e >> 4, i = e & 15;
        float inv = powf(10000.f, -(float)i / 16.f);
        float ang = (float)pos * inv;
        tab[e] = make_float2(cosf(ang), sinf(ang));
      }
    }
  }
}

DEV void phase_init(const Params& p) {
  const float* mv = (const float*)(p.ws + OFF_MODV);
  u16* X = (u16*)(p.ws + OFF_X);
  u16* HM = (u16*)(p.ws + OFF_HY);
  const size_t total = (size_t)NTOK * 128;
  for (size_t i = (size_t)VBID * 256 + VTID; i < total; i += (size_t)VNB * 256) {
    int r = (int)(i >> 7), c8 = (int)(i & 127) * 8;
    const float* src = r < NLAT ? p.x + (size_t)r * 1024 + c8 : p.ctx + (size_t)(r - NLAT) * 1024 + c8;
    float4 v0 = *(const float4*)src, v1 = *(const float4*)(src + 4);
    const float* m = mv + (size_t)modrow(r) * 6144 + c8;
    float4 h0 = *(const float4*)m, h1 = *(const float4*)(m + 4);
    float4 s0 = *(const float4*)(m + 1024), s1 = *(const float4*)(m + 1028);
    float f[8] = {v0.x, v0.y, v0.z, v0.w, v1.x, v1.y, v1.z, v1.w};
    float sh[8] = {h0.x, h0.y, h0.z, h0.w, h1.x, h1.y, h1.z, h1.w};
    float sc[8] = {s0.x, s0.y, s0.z, s0.w, s1.x, s1.y, s1.z, s1.w};
    float g[8];
#pragma unroll
    for (int j = 0; j < 8; ++j) g[j] = f[j] * (1.f + sc[j]) + sh[j];
    *(uint4*)(X + (size_t)r * 1024 + c8) = pack8(f);
    *(uint4*)(HM + (size_t)r * 1024 + c8) = pack8(g);
  }
}

template <int EPI>
DEV void gemm_phase(const u16* __restrict__ A, int lda, const u16* __restrict__ Bt, int K, int M, int N,
                    u16* __restrict__ C, int ldc, const float* __restrict__ gate, char* smem) {
  const int tid = threadIdx.x, lane = tid & 63, wave = tid >> 6;
  const int wm = wave >> 2, wn = wave & 3;
  const int fr = lane & 15, fq = lane >> 4;
  const int tn = N >> 8, tm = M >> 8, tiles = tm * tn;
  const int nk = K >> 6;
  const int drow = wave * 8 + (lane >> 3);
  const int dchunk = (lane & 7) ^ ((drow >> 1) & 7);
  const size_t lda64 = (size_t)lda * 64, ldb64 = (size_t)K * 64;
  const int sw = fr >> 1;
  const bool xcd_order = (gridDim.x & 7) == 0 && (tm & 31) == 0;
  const int mx = tm >> 3;
#define G_COORDS(IT, M0, N0)                                                   \
  {                                                                            \
    int tm_i, tn_i;                                                            \
    if (xcd_order) {                                                           \
      const int x = (IT) & 7, local = (IT) >> 3;                               \
      const int mg = local / (4 * tn), r = local - mg * 4 * tn;                \
      tn_i = r >> 2;                                                           \
      tm_i = x * mx + mg * 4 + (r & 3);                                        \
    } else { tm_i = (IT) / tn; tn_i = (IT) - tm_i * tn; }                      \
    M0 = tm_i << 8; N0 = tn_i << 8;                                            \
  }
  int m0 = 0, n0 = 0;
  const u16* ag = A;
  const u16* bg = Bt;
  bool primed = false;
  for (int it = blockIdx.x; it < tiles; it += gridDim.x) {
    if (!primed) {
      G_COORDS(it, m0, n0)
      ag = A + (size_t)(m0 + drow) * lda + dchunk * 8;
      bg = Bt + (size_t)(n0 + drow) * K + dchunk * 8;
    }
    f32x4 acc[8][4];
#pragma unroll
    for (int i = 0; i < 8; ++i)
#pragma unroll
      for (int j = 0; j < 4; ++j) acc[i][j] = (f32x4){0.f, 0.f, 0.f, 0.f};
#define G_ISSUE(KT, ST)                                                                                  \
  {                                                                                                      \
    const u16* a2 = ag + (KT)*64;                                                                        \
    const u16* b2 = bg + (KT)*64;                                                                        \
    char* la = smem + (ST)*65536 + wave * 1024;                                                          \
    _Pragma("unroll") for (int j = 0; j < 4; ++j) {                                                      \
      __builtin_amdgcn_global_load_lds((const unsigned*)(a2 + j * lda64), (unsigned*)(la + j * 8192), 16, 0, 0);          \
      __builtin_amdgcn_global_load_lds((const unsigned*)(b2 + j * ldb64), (unsigned*)(la + 32768 + j * 8192), 16, 0, 0);  \
    }                                                                                                    \
  }
    if (!primed) G_ISSUE(0, 0)
#define LDA(i, ks) (*(const bf16x8*)(As + (wm * 128 + (i) * 16 + fr) * 64 + ((((ks) * 4 + fq) ^ sw) * 8)))
#define LDB(j, ks) (*(const bf16x8*)(Bs + (wn * 64 + (j) * 16 + fr) * 64 + ((((ks) * 4 + fq) ^ sw) * 8)))
#define SB __builtin_amdgcn_sched_barrier(0)
#define MFMA_H(R, X0, Y0) acc[R][0] = __builtin_amdgcn_mfma_f32_16x16x32_bf16(Y0, X0, acc[R][0], 0, 0, 0);
#define MFMA_T(R, X0, X1, Y0, Y1, Y2, Y3)                                                  \
  acc[R][1] = __builtin_amdgcn_mfma_f32_16x16x32_bf16(Y1, X0, acc[R][1], 0, 0, 0);         \
  acc[R][2] = __builtin_amdgcn_mfma_f32_16x16x32_bf16(Y2, X0, acc[R][2], 0, 0, 0);         \
  acc[R][3] = __builtin_amdgcn_mfma_f32_16x16x32_bf16(Y3, X0, acc[R][3], 0, 0, 0);         \
  acc[R + 1][0] = __builtin_amdgcn_mfma_f32_16x16x32_bf16(Y0, X1, acc[R + 1][0], 0, 0, 0); \
  acc[R + 1][1] = __builtin_amdgcn_mfma_f32_16x16x32_bf16(Y1, X1, acc[R + 1][1], 0, 0, 0); \
  acc[R + 1][2] = __builtin_amdgcn_mfma_f32_16x16x32_bf16(Y2, X1, acc[R + 1][2], 0, 0, 0); \
  acc[R + 1][3] = __builtin_amdgcn_mfma_f32_16x16x32_bf16(Y3, X1, acc[R + 1][3], 0, 0, 0);
#define G_KLOOP(STAG)                                                                                              \
  {                                                                                                                \
    const bf16x8 zf = {0, 0, 0, 0, 0, 0, 0, 0};                                                                    \
    bf16x8 c0 = zf, c1 = zf, c2 = zf, c3 = zf, h0 = zf, h1 = zf;                                                   \
    for (int kt = 0; kt < nk; ++kt) {                                                                              \
      asm volatile("s_waitcnt vmcnt(0)" ::: "memory");                                                             \
      __syncthreads();                                                                                             \
      if (STAG && kt > 0) { SB; MFMA_H(6, h0, c0) MFMA_T(6, h0, h1, c0, c1, c2, c3) SB; }                          \
      if (kt + 1 < nk) G_ISSUE(kt + 1, (kt + 1) & 1)                                                               \
      const u16* As = (const u16*)(smem + (kt & 1) * 65536);                                                       \
      const u16* Bs = As + 16384;                                                                                  \
      bf16x8 b0 = LDB(0, 0), b1 = LDB(1, 0), b2 = LDB(2, 0), b3 = LDB(3, 0);                                       \
      bf16x8 a0 = LDA(0, 0), a1 = LDA(1, 0);                                                                       \
      bf16x8 n0, n1;                                                                                               \
      SB; MFMA_H(0, a0, b0) SB; n0 = LDA(2, 0); n1 = LDA(3, 0); SB; MFMA_T(0, a0, a1, b0, b1, b2, b3) SB;          \
      MFMA_H(2, n0, b0) SB; a0 = LDA(4, 0); a1 = LDA(5, 0); SB; MFMA_T(2, n0, n1, b0, b1, b2, b3) SB;              \
      MFMA_H(4, a0, b0) SB; n0 = LDA(6, 0); n1 = LDA(7, 0); SB; MFMA_T(4, a0, a1, b0, b1, b2, b3) SB;              \
      MFMA_H(6, n0, b0) SB;                                                                                        \
      c0 = LDB(0, 1); c1 = LDB(1, 1); c2 = LDB(2, 1); c3 = LDB(3, 1); a0 = LDA(0, 1); a1 = LDA(1, 1);              \
      SB; MFMA_T(6, n0, n1, b0, b1, b2, b3) SB;                                                                    \
      MFMA_H(0, a0, c0) SB; n0 = LDA(2, 1); n1 = LDA(3, 1); SB; MFMA_T(0, a0, a1, c0, c1, c2, c3) SB;              \
      MFMA_H(2, n0, c0) SB; a0 = LDA(4, 1); a1 = LDA(5, 1); SB; MFMA_T(2, n0, n1, c0, c1, c2, c3) SB;              \
      if (STAG) {                                                                                                  \
        MFMA_H(4, a0, c0) SB; h0 = LDA(6, 1); h1 = LDA(7, 1); SB; MFMA_T(4, a0, a1, c0, c1, c2, c3) SB;            \
      } else {                                                                                                     \
        MFMA_H(4, a0, c0) SB; n0 = LDA(6, 1); n1 = LDA(7, 1); SB; MFMA_T(4, a0, a1, c0, c1, c2, c3) SB;            \
        MFMA_H(6, n0, c0) MFMA_T(6, n0, n1, c0, c1, c2, c3) SB;                                                    \
      }                                                                                                            \
    }                                                                                                              \
    if (STAG) { SB; MFMA_H(6, h0, c0) MFMA_T(6, h0, h1, c0, c1, c2, c3) SB; }                                      \
  }
    if (__builtin_amdgcn_readfirstlane(wave >> 2) != 0) G_KLOOP(true)
    else G_KLOOP(false)
#undef G_KLOOP
#undef LDA
#undef LDB
#undef SB
#undef MFMA_H
#undef MFMA_T
    const int cm0 = m0, cn0 = n0;
    primed = false;
    if (it + (int)gridDim.x < tiles) {
      G_COORDS(it + (int)gridDim.x, m0, n0)
      ag = A + (size_t)(m0 + drow) * lda + dchunk * 8;
      bg = Bt + (size_t)(n0 + drow) * K + dchunk * 8;
      G_ISSUE(0, 0)
      primed = true;
    }
    u16* Cs = (u16*)(smem + 65536);
#pragma unroll 1
    for (int hp = 0; hp < 2; ++hp) {
      asm volatile("s_waitcnt lgkmcnt(0)" ::: "memory");
      __builtin_amdgcn_s_barrier();
      asm volatile("" ::: "memory");
      if (wm == hp) {
#pragma unroll
        for (int i = 0; i < 8; ++i)
#pragma unroll
          for (int j = 0; j < 4; ++j) {
            float v0 = acc[i][j][0], v1 = acc[i][j][1], v2 = acc[i][j][2], v3 = acc[i][j][3];
            if (EPI == 1) {
              v0 = fmaxf(v0, 0.f); v1 = fmaxf(v1, 0.f); v2 = fmaxf(v2, 0.f); v3 = fmaxf(v3, 0.f);
              v0 *= v0; v1 *= v1; v2 *= v2; v3 *= v3;
            }
            *(uint2*)(Cs + (i * 16 + fr) * 264 + wn * 64 + j * 16 + fq * 4) = make_uint2(pack2(v0, v1), pack2(v2, v3));
          }
      }
      asm volatile("s_waitcnt lgkmcnt(0)" ::: "memory");
      __builtin_amdgcn_s_barrier();
      asm volatile("" ::: "memory");
#pragma unroll 2
      for (int q = 0; q < 8; ++q) {
        const int chunk = tid + q * 512;
        const int row = chunk >> 5, cc = chunk & 31;
        uint4 cv = *(const uint4*)(Cs + row * 264 + cc * 8);
        const int grow = cm0 + hp * 128 + row;
        u16* dst = C + (size_t)grow * ldc + cn0 + cc * 8;
        if (EPI == 2) {
          float a[8], xo[8], y[8];
          unpack8(cv, a);
          unpack8(*(const uint4*)dst, xo);
          const float* gr = gate + (size_t)modrow(grow) * 6144 + cn0 + cc * 8;
          float4 g0 = *(const float4*)gr, g1 = *(const float4*)(gr + 4);
          float gg[8] = {g0.x, g0.y, g0.z, g0.w, g1.x, g1.y, g1.z, g1.w};
#pragma unroll
          for (int j = 0; j < 8; ++j) y[j] = ALPHA * xo[j] + gg[j] * a[j];
          cv = pack8(y);
        }
        *(uint4*)dst = cv;
      }
    }
    asm volatile("s_waitcnt lgkmcnt(0)" ::: "memory");
    __builtin_amdgcn_s_barrier();
    asm volatile("" ::: "memory");
  }
#undef G_ISSUE
#undef G_COORDS
}

template <bool FINAL>
DEV void ln_phase(const Params& p, int M, const float* __restrict__ g, const float* __restrict__ b,
                         const float* __restrict__ modl  , int shi, int sci) {
  u16* X = (u16*)(p.ws + OFF_X);
  u16* HM = (u16*)(p.ws + OFF_HY);
  const int lane = VTID & 63;
  const int gw = VBID * 4 + (VTID >> 6), nw = VNB * 4;
  uint4 nx0 = make_uint4(0u, 0u, 0u, 0u), nx1 = nx0;
  if (gw < M) {
    nx0 = *(const uint4*)(X + (size_t)gw * 1024 + lane * 8);
    nx1 = *(const uint4*)(X + (size_t)gw * 1024 + 512 + lane * 8);
  }
  for (int row = gw; row < M; row += nw) {
    u16* xr = X + (size_t)row * 1024;
    float f[16];
    unpack8(nx0, f);
    unpack8(nx1, f + 8);
    if (row + nw < M) {
      nx0 = *(const uint4*)(xr + (size_t)nw * 1024 + lane * 8);
      nx1 = *(const uint4*)(xr + (size_t)nw * 1024 + 512 + lane * 8);
    }
    float s = 0.f, q = 0.f;
#pragma unroll
    for (int j = 0; j < 16; ++j) { s += f[j]; q += f[j] * f[j]; }
#pragma unroll
    for (int o = 32; o > 0; o >>= 1) { s += __shfl_xor(s, o, 64); q += __shfl_xor(q, o, 64); }
    const float mu = s * (1.f / 1024.f);
    const float rs = rsqrtf(fmaxf(q * (1.f / 1024.f) - mu * mu, 0.f) + 1e-5f);
#pragma unroll
    for (int j = 0; j < 16; ++j) f[j] -= mu;
#pragma unroll
    for (int hh = 0; hh < 2; ++hh) {
      const int c0 = hh * 512 + lane * 8;
      float y[8];
#pragma unroll
      for (int j = 0; j < 8; ++j) y[j] = f[hh * 8 + j] * rs * g[c0 + j] + b[c0 + j];
      if (FINAL) {
        float* o = p.out + (size_t)row * 1024 + c0;
        *(float4*)o = make_float4(y[0], y[1], y[2], y[3]);
        *(float4*)(o + 4) = make_float4(y[4], y[5], y[6], y[7]);
      } else {
        *(uint4*)(xr + c0) = pack8(y);
        const float* m = modl + (size_t)modrow(row) * 6144;
        float h[8];
#pragma unroll
        for (int j = 0; j < 8; ++j) h[j] = y[j] * (1.f + m[sci * 1024 + c0 + j]) + m[shi * 1024 + c0 + j];
        *(uint4*)(HM + (size_t)row * 1024 + c0) = pack8(h);
      }
    }
  }
}

DEV void hyprep_item(const Params& p, int it, char* smem) {
  u16* su = (u16*)smem;
  u16* sx = su + 64 * 66;
  const u16* P = (const u16*)(p.ws + OFF_BIG);
  const int tid = VTID;
  const int ct = it & 7, st = it >> 3;
  int b, t0, L, rowbase;
  u16 *U, *X0;
  if (st < 1024) { b = st >> 5; t0 = (st & 31) * 64; L = 2048; rowbase = b * 2048;
    U = (u16*)((char*)p.out + SO_U); X0 = (u16*)((char*)p.out + SO_X0); }
  else { int s2 = st - 1024; b = s2 >> 2; t0 = (s2 & 3) * 64; L = 256; rowbase = NLAT + b * 256;
    U = (u16*)((char*)p.out + SO_UC); X0 = (u16*)((char*)p.out + SO_X0C); }
  const int c0 = ct * 64;
  {
    const int t = tid >> 2, cq = tid & 3;
    float z[3][16];
#pragma unroll
    for (int g = 0; g < 3; ++g)
#pragma unroll
      for (int j = 0; j < 16; ++j) z[g][j] = 0.f;
#pragma unroll
    for (int tap = 0; tap < 3; ++tap) {
      const int tt = t0 + t + tap - 1;
      if (tt >= 0 && tt < L) {
#pragma unroll
        for (int g = 0; g < 3; ++g) {
          const int col = g * 512 + c0 + cq * 16;
          const u16* src = P + (size_t)(rowbase + tt) * PS0 + col;
          float f[16];
          unpack8(*(const uint4*)src, f);
          unpack8(*(const uint4*)(src + 8), f + 8);
          const float* w = p.hy_conv + tap * 1536 + col;
#pragma unroll
          for (int j = 0; j < 16; ++j) z[g][j] += f[j] * w[j];
        }
      }
    }
#pragma unroll
    for (int j = 0; j < 16; ++j) {
      su[t * 66 + cq * 16 + j] = f2bf(z[1][j] * z[2][j]);
      sx[t * 66 + cq * 16 + j] = f2bf(z[0][j]);
    }
  }
  HSYNC();
  {
    const int c = tid >> 2, tq = tid & 3;
    unsigned wu[8], wx[8];
#pragma unroll
    for (int j = 0; j < 8; ++j) {
      wu[j] = (unsigned)su[(tq * 16 + 2 * j) * 66 + c] | ((unsigned)su[(tq * 16 + 2 * j + 1) * 66 + c] << 16);
      wx[j] = (unsigned)sx[(tq * 16 + 2 * j) * 66 + c] | ((unsigned)sx[(tq * 16 + 2 * j + 1) * 66 + c] << 16);
    }
    const size_t o = ((size_t)(c0 + c) * 32 + b) * L + t0 + tq * 16;
    *(uint4*)(U + o) = make_uint4(wu[0], wu[1], wu[2], wu[3]);
    *(uint4*)(U + o + 8) = make_uint4(wu[4], wu[5], wu[6], wu[7]);
    *(uint4*)(X0 + o) = make_uint4(wx[0], wx[1], wx[2], wx[3]);
    *(uint4*)(X0 + o + 8) = make_uint4(wx[4], wx[5], wx[6], wx[7]);
  }
  HSYNC();
}

DEV void rope_item(const Params& p, int it) {
  u16* P = (u16*)(p.ws + OFF_BIG);
  const float2* tab = (const float2*)(p.ws + OFF_ROPE);
  const int task = it * 256 + VTID;
  const int row = task / 40, rem = task - row * 40;
  const int head = rem >> 2, pr = rem & 3;
  const int d0 = (pr >> 1) * 32 + (pr & 1) * 8;
  const int t = row & 2047;
  const int posc = (pr >> 1) ? (t & 63) : (t >> 6);
  const int fi0 = (pr & 1) * 8;
  u16* ptr = P + (size_t)row * PS0 + 1536 + head * 64 + d0;
  float u1[8], u2[8], o1[8], o2[8];
  unpack8(*(const uint4*)ptr, u1);
  unpack8(*(const uint4*)(ptr + 16), u2);
#pragma unroll
  for (int j = 0; j < 8; ++j) {
    float2 cs = tab[posc * 16 + fi0 + j];
    o1[j] = u1[j] * cs.x - u2[j] * cs.y;
    o2[j] = u1[j] * cs.y + u2[j] * cs.x;
  }
  *(uint4*)ptr = pack8(o1);
  *(uint4*)(ptr + 16) = pack8(o2);
}

DEV void phase_hyprep_rope(const Params& p, char* smem) {
  constexpr int NH = 9216, NR = 10240;
  for (int it = VBID; it < NH + NR; it += VNB) {
    if (it < NH) hyprep_item(p, it, smem);
    else rope_item(p, it - NH);
  }
}

template <int L, int NT>
DEV void conv_item(const Params& p, int c, int th, char* smem) {
  const u16* R = (const u16*)(p.ws + (L == 2048 ? OFF_KR2048 : OFF_KR256)) + (size_t)c * 2 * L;
  const u16* U = (const u16*)((const char*)p.out + (L == 2048 ? SO_U : SO_UC));
  const u16* X0 = (const u16*)((const char*)p.out + (L == 2048 ? SO_X0 : SO_X0C));
  u16* Y = (u16*)(p.ws + OFF_HY);
  u16* Rs0 = (u16*)smem;
  u16* Rs1 = Rs0 + 2 * L + 8;
  const int tid = VTID, lane = tid & 63, wave = tid >> 6;
  for (int i = tid; i < (2 * L) / 8; i += 256) *(uint4*)(Rs0 + i * 8) = *(const uint4*)(R + i * 8);
  HSYNC();
  for (int i = tid; i < 2 * L; i += 256) Rs1[i] = (i + 1 < 2 * L) ? Rs0[i + 1] : (u16)0;
  HSYNC();
  const int r = lane & 31, h = lane >> 5;
  const char* lanebase = (r & 1) ? (const char*)Rs1 + 2 * (8 * h - r + L - 1) : (const char*)Rs0 + 2 * (8 * h - r + L);
  const int tw0 = th * 1024 + wave * NT * 32;
  f32x16 acc[NT];
#pragma unroll
  for (int i = 0; i < NT; ++i)
#pragma unroll
    for (int e = 0; e < 16; ++e) acc[i][e] = 0.f;
  u16* UC = Rs1 + 2 * L + 8;
  const u16* Ug = U + (size_t)c * 32 * L;
  const u16* ug0 = Ug + (size_t)(tid >> 5) * L + (tid & 31) * 8;
  u16* uc0 = UC + (tid >> 5) * 264 + (tid & 31) * 8;
  uint4 stg0 = *(const uint4*)(ug0), stg1 = *(const uint4*)(ug0 + (size_t)8 * L);
  uint4 stg2 = *(const uint4*)(ug0 + (size_t)16 * L), stg3 = *(const uint4*)(ug0 + (size_t)24 * L);
  for (int chk = 0; chk < L / 256; ++chk) {
    HSYNC();
    *(uint4*)(uc0) = stg0; *(uint4*)(uc0 + 8 * 264) = stg1; *(uint4*)(uc0 + 16 * 264) = stg2; *(uint4*)(uc0 + 24 * 264) = stg3;
    HSYNC();
    if (chk + 1 < L / 256) {
      const u16* un = ug0 + (chk + 1) * 256;
      stg0 = *(const uint4*)(un); stg1 = *(const uint4*)(un + (size_t)8 * L);
      stg2 = *(const uint4*)(un + (size_t)16 * L); stg3 = *(const uint4*)(un + (size_t)24 * L);
    }
#pragma unroll 4
    for (int s2 = 0; s2 < 16; ++s2) {
      const int st = chk * 16 + s2;
      bf16x8 bfrag = *(const bf16x8*)(UC + r * 264 + s2 * 16 + 8 * h);
#pragma unroll
      for (int i = 0; i < NT; ++i) {
        const unsigned* ap = (const unsigned*)(lanebase + 2 * (st * 16 - (tw0 + i * 32)));
        uint4 av = make_uint4(ap[0], ap[1], ap[2], ap[3]);
        acc[i] = __builtin_amdgcn_mfma_f32_32x32x16_bf16(*(bf16x8*)&av, bfrag, acc[i], 0, 0, 0);
      }
    }
  }
  const int rowbase = (L == 2048) ? r * 2048 : NLAT + r * 256;
#pragma unroll
  for (int i = 0; i < NT; ++i) {
#pragma unroll
    for (int g4 = 0; g4 < 4; ++g4) {
      const int tt = tw0 + i * 32 + 8 * g4 + 4 * h;
      uint2 xv = *(const uint2*)(X0 + ((size_t)c * 32 + r) * L + tt);
      float x0[4] = {bflo(xv.x), bfhi(xv.x), bflo(xv.y), bfhi(xv.y)};
#pragma unroll
      for (int e = 0; e < 4; ++e) Y[(size_t)(rowbase + tt + e) * 1024 + c] = f2bf(acc[i][g4 * 4 + e] * x0[e]);
    }
  }
  HSYNC();
}

DEV void attn_item(const Params& p, int b, int hq, int qb, bool isctx, char* smem) {
  const u16* P = (const u16*)(p.ws + OFF_BIG);
  u16* Y = (u16*)(p.ws + OFF_HY);
  u16* Ks = (u16*)smem;
  u16* Vt = Ks + 64 * 72;
  const int tid = VTID, lane = tid & 63, wave = tid >> 6;
  const int nq = lane & 15, quad = lane >> 4;
  const int qrow = (isctx ? NLAT + b * 256 : b * 2048) + qb * 64 + wave * 16 + nq;
  const int qpos = qb * 64 + wave * 16 + nq;
  const int hkv = hq >> 2;
  const int kcol = 2048 + hkv * 64, vcol = 2176 + hkv * 64;
  bf16x8 qf[2];
#pragma unroll
  for (int ks = 0; ks < 2; ++ks)
    qf[ks] = *(const bf16x8*)(P + (size_t)qrow * PS0 + 1536 + hq * 64 + ks * 32 + quad * 8);
  float m = p.attn_sink[hq];
  float lsum = (quad == 0) ? 1.f : 0.f;
  f32x4 oacc[4];
#pragma unroll
  for (int n = 0; n < 4; ++n) oacc[n] = (f32x4){0.f, 0.f, 0.f, 0.f};
  const int lo = isctx ? 0 : (qb < 2 ? 2 - qb : 0);
  const int hi = isctx ? 0 : (34 - qb < 5 ? 34 - qb : 5);
  const int nl = hi - lo, ntile = nl + 4;
  const int skey = tid >> 2, spart = tid & 3;
  uint4 k0v, k1v, v0v, v1v;
  {
    const int kr = (nl > 0) ? b * 2048 + qb * 64 - 128 + lo * 64 : NLAT + b * 256;
    const u16* kp = P + (size_t)(kr + skey) * PS0 + kcol + spart * 16;
    const u16* vp = P + (size_t)(kr + skey) * PS0 + vcol + spart * 16;
    k0v = *(const uint4*)kp; k1v = *(const uint4*)(kp + 8);
    v0v = *(const uint4*)vp; v1v = *(const uint4*)(vp + 8);
  }
  for (int si = 0; si < ntile; ++si) {
    int k0 = 0;
    const bool masked = si < nl;
    if (masked) k0 = qb * 64 - 128 + (lo + si) * 64;
    HSYNC();
    {
      const int key = skey, part = spart;
      *(uint4*)(Ks + key * 72 + part * 16) = k0v;
      *(uint4*)(Ks + key * 72 + part * 16 + 8) = k1v;
      unsigned vw[8] = {v0v.x, v0v.y, v0v.z, v0v.w, v1v.x, v1v.y, v1v.z, v1v.w};
#pragma unroll
      for (int j = 0; j < 8; ++j) {
        Vt[(part * 16 + 2 * j) * 72 + key] = (u16)(vw[j] & 0xffffu);
        Vt[(part * 16 + 2 * j + 1) * 72 + key] = (u16)(vw[j] >> 16);
      }
    }
    HSYNC();
    if (si + 1 < ntile) {
      const int sn = si + 1;
      const int kr = (sn < nl) ? b * 2048 + qb * 64 - 128 + (lo + sn) * 64 : NLAT + b * 256 + (sn - nl) * 64;
      const u16* kp = P + (size_t)(kr + skey) * PS0 + kcol + spart * 16;
      const u16* vp = P + (size_t)(kr + skey) * PS0 + vcol + spart * 16;
      k0v = *(const uint4*)kp; k1v = *(const uint4*)(kp + 8);
      v0v = *(const uint4*)vp; v1v = *(const uint4*)(vp + 8);
    }
    f32x4 s[4];
#pragma unroll
    for (int n = 0; n < 4; ++n) {
      s[n] = (f32x4){0.f, 0.f, 0.f, 0.f};
#pragma unroll
      for (int ks = 0; ks < 2; ++ks) {
        bf16x8 kf = *(const bf16x8*)(Ks + (n * 16 + nq) * 72 + ks * 32 + quad * 8);
        s[n] = __builtin_amdgcn_mfma_f32_16x16x32_bf16(kf, qf[ks], s[n], 0, 0, 0);
      }
    }
    float mx = -1e30f;
#pragma unroll
    for (int n = 0; n < 4; ++n)
#pragma unroll
      for (int e = 0; e < 4; ++e) {
        float v = s[n][e] * 0.125f;
        if (masked) {
          int kpos = k0 + n * 16 + quad * 4 + e;
          int d = qpos - kpos;
          if (d > 128 || d < -128) v = -1e30f;
        }
        s[n][e] = v;
        mx = fmaxf(mx, v);
      }
    mx = fmaxf(mx, __shfl_xor(mx, 16, 64));
    mx = fmaxf(mx, __shfl_xor(mx, 32, 64));
    const float mn = fmaxf(m, mx);
    const float al = __expf(m - mn);
    m = mn;
    float ps = 0.f;
#pragma unroll
    for (int n = 0; n < 4; ++n)
#pragma unroll
      for (int e = 0; e < 4; ++e) { float pv = __expf(s[n][e] - mn); s[n][e] = pv; ps += pv; }
    lsum = lsum * al + ps;
#pragma unroll
    for (int n = 0; n < 4; ++n)
#pragma unroll
      for (int e = 0; e < 4; ++e) oacc[n][e] *= al;
#pragma unroll
    for (int hh = 0; hh < 2; ++hh) {
      uint4 pw;
      pw.x = pack2(s[2 * hh][0], s[2 * hh][1]); pw.y = pack2(s[2 * hh][2], s[2 * hh][3]);
      pw.z = pack2(s[2 * hh + 1][0], s[2 * hh + 1][1]); pw.w = pack2(s[2 * hh + 1][2], s[2 * hh + 1][3]);
      bf16x8 pb = *(bf16x8*)&pw;
#pragma unroll
      for (int n = 0; n < 4; ++n) {
        const u16* vr = Vt + (n * 16 + nq) * 72 + quad * 4;
        uint2 va = *(const uint2*)(vr + (2 * hh) * 16);
        uint2 vb = *(const uint2*)(vr + (2 * hh + 1) * 16);
        uint4 vv = make_uint4(va.x, va.y, vb.x, vb.y);
        oacc[n] = __builtin_amdgcn_mfma_f32_16x16x32_bf16(*(bf16x8*)&vv, pb, oacc[n], 0, 0, 0);
      }
    }
  }
  lsum += __shfl_xor(lsum, 16, 64);
  lsum += __shfl_xor(lsum, 32, 64);
  const float inv = 1.f / lsum;
  u16* yo = Y + (size_t)qrow * 1024 + 512 + hq * 64 + quad * 4;
#pragma unroll
  for (int n = 0; n < 4; ++n) {
    uint2 w;
    w.x = pack2(oacc[n][0] * inv, oacc[n][1] * inv);
    w.y = pack2(oacc[n][2] * inv, oacc[n][3] * inv);
    *(uint2*)(yo + n * 16) = w;
  }
  HSYNC();
}

DEV void phase_conv_attn(const Params& p, char* smem) {
  constexpr int N0 = 1024, N1 = N0 + 512, N2 = N1 + 8192, N3 = N2 + 1024;
#pragma unroll 1
  for (int it = VBID; it < N0; it += VNB) conv_item<2048, 8>(p, it >> 1, it & 1, smem);
  __builtin_amdgcn_sched_barrier(0);
#pragma unroll 1
  for (int it = VBID; it < N3; it += VNB) {
    if (it < N0) continue;
    if (it < N1) conv_item<256, 2>(p, it - N0, 0, smem);
  }
  __builtin_amdgcn_sched_barrier(0);
#pragma unroll 1
  for (int it = VBID; it < N3; it += VNB) {
    if (it < N1) continue;
    if (it < N2) { int a = it - N1; attn_item(p, a >> 8, (a >> 5) & 7, a & 31, false, smem); }
    else { int a = it - N2; attn_item(p, a >> 5, (a >> 2) & 7, a & 3, true, smem); }
  }
}

DEV void lds_wave_sync() {
  asm volatile("s_waitcnt lgkmcnt(0)" ::: "memory");
  __builtin_amdgcn_wave_barrier();
}

#define SCAN_SYNC() do { if (HW) __syncthreads(); else hsync(); } while (0)
template <bool HW>
DEV void rwkv_item(const Params& p, int ri, char* smem) {
  const u16* P = (const u16*)(p.ws + OFF_BIG);
  u16* O4 = (u16*)p.out;
  float* BS = (float*)(p.ws + OFF_BSUM);
  const int tid0 = VTID;
  const int wp0 = tid0 >> 7;
  const int cid = ri * 2 + wp0;
  const int b = cid >> 4, d = (cid >> 3) & 1, h = cid & 7;
  f32x4 S[4][2];
#pragma unroll
  for (int i = 0; i < 4; ++i)
#pragma unroll
    for (int j = 0; j < 2; ++j) S[i][j] = (f32x4){0.f, 0.f, 0.f, 0.f};
  uint4 bw[2][4];
  float l0[4];
  {
    const int lane = tid0 & 63, wi = (tid0 >> 6) & 1, fr = lane & 15, fq = lane >> 4;
    const float* wsrc = (wi == 0 ? p.rw_w2 : p.rw_a2) + (size_t)d * 64 * 512 + h * 64;
    const float* bsrc = (wi == 0 ? p.rw_w0 : p.rw_a0) + d * 512 + h * 64;
#pragma unroll
    for (int nt = 0; nt < 4; ++nt) {
      l0[nt] = bsrc[nt * 16 + fr];
#pragma unroll
      for (int ks = 0; ks < 2; ++ks) {
        __builtin_amdgcn_sched_barrier(0);
        float f[8];
        const float* wp_ = wsrc + (size_t)(ks * 32 + fq * 8) * 512 + nt * 16 + fr;
#pragma unroll
        for (int j = 0; j < 8; ++j) f[j] = wp_[j * 512];
        bw[ks][nt] = pack8(f);
      }
    }
  }
  uint4 pre[5][3];
#define RW_LOAD(CI)                                                                                 \
  {                                                                                                 \
    const int seg_ = (CI) < 16 ? 0 : 1;                                                             \
    const int ch_ = seg_ ? (CI)-16 : (CI);                                                          \
    const int Ls_ = seg_ ? 2048 : 256;                                                              \
    const int rb_ = seg_ ? b * 2048 : NLAT + b * 256;                                               \
    const int sidx_ = ch_ * 16 + stt;                                                               \
    const int t_ = d == 0 ? sidx_ : Ls_ - 1 - sidx_;                                                \
    const u16* prow_ = P + (size_t)(rb_ + t_) * PS1 + spart * 8;                                    \
    _Pragma("unroll") for (int g = 0; g < 5; ++g) {                                                 \
      const int col_ = g < 3 ? g * 512 + h * 64 : (g == 3 ? 1536 + d * 64 : 1664 + d * 64);         \
      _Pragma("unroll") for (int tap = 0; tap < 3; ++tap) {                                         \
        const int tt_ = t_ + tap - 1;                                                               \
        if (tt_ >= 0 && tt_ < Ls_) pre[g][tap] = *(const uint4*)(prow_ + (ptrdiff_t)(tap - 1) * PS1 + col_); \
        else pre[g][tap] = make_uint4(0u, 0u, 0u, 0u);                                              \
      }                                                                                             \
    }                                                                                               \
  }
  {
    const int pt = tid0 & 127, stt = pt >> 3, spart = pt & 7;
    RW_LOAD(0)
  }
  for (int cidx = 0; cidx < 144; ++cidx) {
    asm volatile("" ::: "memory");
    int tid = tid0;
    asm volatile("" : "+v"(tid));
    const int lane = tid & 63, wave = tid >> 6, wp = wave >> 1, wi = wave & 1, pt = tid & 127;
    const int fr = lane & 15, fq = lane >> 4, stt = pt >> 3, spart = pt & 7;
    const int seg = cidx < 16 ? 0 : 1;
    const int ch = seg ? cidx - 16 : cidx;
    const int Ls = seg ? 2048 : 256;
    char* base = smem + wp * 32768;
    u16* RK = (u16*)base;
    u16* KD = RK + 1152;
    u16* KK = KD + 1152;
    u16* AB = KK + 1152;
    u16* VT = AB + 1152;
    float* LW = (float*)(base + 11264);
    u16* TW = (u16*)(base + 15360);
    u16* AD = TW + 1152;
    u16* BgCT = (u16*)(base + 19968);
    u16* KgCT = BgCT + 1024;
    float* gC = (float*)(base + 24064);
    float* Amat = (float*)(base + 24320) + wi * 256;
    u16* Tinv = (u16*)(base + 26368) + wi * 256;
    u16* BG = (u16*)(base + 27392);
    {
      const int o = stt * 72 + spart * 8;
#pragma unroll
      for (int g = 0; g < 5; ++g) {
        __builtin_amdgcn_sched_barrier(0);
        const int col = g < 3 ? g * 512 + h * 64 : (g == 3 ? 1536 + d * 64 : 1664 + d * 64);
        float pc[8], pp[8], pn[8], v[8];
        unpack8(pre[g][1], pc); unpack8(pre[g][0], pp); unpack8(pre[g][2], pn);
        const float* mu = p.rw_mu + col + spart * 8;
        float4 m0 = *(const float4*)mu, m1 = *(const float4*)(mu + 4);
        const float mm[8] = {m0.x, m0.y, m0.z, m0.w, m1.x, m1.y, m1.z, m1.w};
#pragma unroll
        for (int j = 0; j < 8; ++j) v[j] = pc[j] + mm[j] * (0.5f * (pp[j] + pn[j]) - pc[j]);
        if (g == 0) *(uint4*)(RK + o) = pack8(v);
        else if (g == 1) {
          *(uint4*)(KD + o) = pack8(v);
          const float* kkw = p.rw_kk + h * 64 + spart * 8;
          float kkv[8];
          float ss = 0.f;
#pragma unroll
          for (int j = 0; j < 8; ++j) { kkv[j] = v[j] * kkw[j]; ss += kkv[j] * kkv[j]; }
          ss += __shfl_xor(ss, 1, 64); ss += __shfl_xor(ss, 2, 64); ss += __shfl_xor(ss, 4, 64);
          const float inv = rsqrtf(ss + 1e-6f);
#pragma unroll
          for (int j = 0; j < 8; ++j) kkv[j] *= inv;
          *(uint4*)(KK + o) = pack8(kkv);
        } else if (g == 2) {
#pragma unroll
          for (int j = 0; j < 8; ++j) VT[(spart * 8 + j) * 16 + stt] = f2bf(v[j]);
        } else if (g == 3) {
#pragma unroll
          for (int j = 0; j < 8; ++j) v[j] = fast_tanh(v[j]);
          *(uint4*)(TW + o) = pack8(v);
        } else *(uint4*)(AD + o) = pack8(v);
      }
    }
    SCAN_SYNC();
    if (cidx + 1 < 144) RW_LOAD(cidx + 1)
    {
      const u16* IN = wi == 0 ? TW : AD;
      bf16x8 af0 = *(const bf16x8*)(IN + fr * 72 + fq * 8);
      bf16x8 af1 = *(const bf16x8*)(IN + fr * 72 + 32 + fq * 8);
#pragma unroll
      for (int nt = 0; nt < 4; ++nt) {
        f32x4 o4 = (f32x4){0.f, 0.f, 0.f, 0.f};
        o4 = __builtin_amdgcn_mfma_f32_16x16x32_bf16(af0, *(bf16x8*)&bw[0][nt], o4, 0, 0, 0);
        o4 = __builtin_amdgcn_mfma_f32_16x16x32_bf16(af1, *(bf16x8*)&bw[1][nt], o4, 0, 0, 0);
#pragma unroll
        for (int e = 0; e < 4; ++e) {
          const float prev = l0[nt] + o4[e];
          const int t = fq * 4 + e, c = nt * 16 + fr;
          if (wi == 0) LW[t * 64 + c] = -__expf(-softplus(-prev) - 0.5f);
          else AB[t * 72 + c] = f2bf(sigm(prev));
        }
      }
    }
    SCAN_SYNC();
    {
      const int c = lane;
      float cum = 0.f;
      if (wi == 0) {
#pragma unroll 4
        for (int t = 0; t < 16; ++t) {
          const float lw = LW[t * 64 + c];
          const float gp = __expf(cum);
          cum += lw;
          const float gi = __expf(-cum);
          const float kk = bf2f(KK[t * 72 + c]);
          const float a = bf2f(AB[t * 72 + c]);
          KK[t * 72 + c] = f2bf(kk * gp);
          BG[t * 72 + c] = f2bf(kk * a * gi);
        }
        const float gCv = __expf(cum);
        gC[c] = gCv;
#pragma unroll 4
        for (int t = 0; t < 16; ++t) BgCT[c * 16 + t] = f2bf(-bf2f(BG[t * 72 + c]) * gCv);
      } else {
        float* PR = (float*)TW;
        const float kac = p.rw_ka[h * 64 + c], rkc = p.rw_rk[h * 64 + c];
#pragma unroll 4
        for (int t = 0; t < 16; ++t) {
          const float lw = LW[t * 64 + c];
          cum += lw;
          const float g = __expf(cum), gi = __expf(-cum);
          const float r = bf2f(RK[t * 72 + c]);
          const float k = bf2f(KD[t * 72 + c]);
          const float a = bf2f(AB[t * 72 + c]);
          const float kd = k * (1.f + (a - 1.f) * kac);
          RK[t * 72 + c] = f2bf(r * g);
          KD[t * 72 + c] = f2bf(kd * gi);
          PR[t * 64 + c] = r * kd * rkc;
        }
        const float gCv = __expf(cum);
#pragma unroll 4
        for (int t = 0; t < 16; ++t) KgCT[c * 16 + t] = f2bf(bf2f(KD[t * 72 + c]) * gCv);
        lds_wave_sync();
        {
          const int t = lane >> 2, sg = lane & 3;
          const float4 q0 = *(const float4*)(PR + t * 64 + sg * 16), q1 = *(const float4*)(PR + t * 64 + sg * 16 + 4);
          const float4 q2 = *(const float4*)(PR + t * 64 + sg * 16 + 8), q3 = *(const float4*)(PR + t * 64 + sg * 16 + 12);
          float bsum = (q0.x + q0.y + q0.z + q0.w) + (q1.x + q1.y + q1.z + q1.w) + (q2.x + q2.y + q2.z + q2.w) + (q3.x + q3.y + q3.z + q3.w);
          bsum += __shfl_xor(bsum, 1, 64);
          bsum += __shfl_xor(bsum, 2, 64);
          if (seg == 1 && sg == 0) {
            const int sidx = ch * 16 + t;
            const int tpos = d == 0 ? sidx : 2047 - sidx;
            BS[(size_t)(b * 2048 + tpos) * 16 + h * 2 + d] = bsum;
          }
        }
      }
    }
    SCAN_SYNC();
    __builtin_amdgcn_sched_barrier(0);
    {
      f32x4 XabT = (f32x4){0.f, 0.f, 0.f, 0.f}, XakT = XabT, XrbT = XabT, XrkT = XabT;
#pragma unroll
      for (int ks = 0; ks < 2; ++ks) {
        bf16x8 kkf = *(const bf16x8*)(KK + fr * 72 + ks * 32 + fq * 8);
        bf16x8 rgf = *(const bf16x8*)(RK + fr * 72 + ks * 32 + fq * 8);
        bf16x8 bgf = *(const bf16x8*)(BG + fr * 72 + ks * 32 + fq * 8);
        bf16x8 kgf = *(const bf16x8*)(KD + fr * 72 + ks * 32 + fq * 8);
        XabT = __builtin_amdgcn_mfma_f32_16x16x32_bf16(bgf, kkf, XabT, 0, 0, 0);
        XakT = __builtin_amdgcn_mfma_f32_16x16x32_bf16(kgf, kkf, XakT, 0, 0, 0);
        XrbT = __builtin_amdgcn_mfma_f32_16x16x32_bf16(bgf, rgf, XrbT, 0, 0, 0);
        XrkT = __builtin_amdgcn_mfma_f32_16x16x32_bf16(kgf, rgf, XrkT, 0, 0, 0);
      }
      {
        float am[4];
#pragma unroll
        for (int e = 0; e < 4; ++e) am[e] = (fq * 4 + e < fr) ? XabT[e] : 0.f;
        *(float4*)(Amat + fr * 16 + fq * 4) = make_float4(am[0], am[1], am[2], am[3]);
      }
      lds_wave_sync();
      if (lane < 16) {
        float x[16];
        x[0] = (lane == 0) ? 1.f : 0.f;
        float4 cur[4], nxt[4];
        cur[0] = *(const float4*)(Amat + 16);
        cur[1] = cur[0]; cur[2] = cur[0]; cur[3] = cur[0];
#pragma unroll
        for (int i = 1; i < 16; ++i) {
          __builtin_amdgcn_sched_barrier(0);
          if (i + 1 < 16) {
#pragma unroll
            for (int q = 0; q < (i + 4) / 4; ++q) nxt[q] = *(const float4*)(Amat + (i + 1) * 16 + q * 4);
          }
          float acc = (i == lane) ? 1.f : 0.f;
#pragma unroll
          for (int j = 0; j < i; ++j) {
            const float4 rv = cur[j >> 2];
            const float av = (j & 3) == 0 ? rv.x : ((j & 3) == 1 ? rv.y : ((j & 3) == 2 ? rv.z : rv.w));
            acc -= av * x[j];
          }
          x[i] = acc;
#pragma unroll
          for (int q = 0; q < 4; ++q) cur[q] = nxt[q];
        }
#pragma unroll
        for (int i = 0; i < 16; ++i) Tinv[i * 16 + lane] = f2bf(x[i]);
      }
      lds_wave_sync();
      f32x4 sa0[2], y0[2];
#pragma unroll
      for (int nt = 0; nt < 2; ++nt) { sa0[nt] = (f32x4){0.f, 0.f, 0.f, 0.f}; y0[nt] = (f32x4){0.f, 0.f, 0.f, 0.f}; }
#pragma unroll
      for (int x = 0; x < 2; ++x) {
        __builtin_amdgcn_sched_barrier(0);
        uint2 k0 = *(const uint2*)(KK + fr * 72 + 32 * x + fq * 4);
        uint2 k1 = *(const uint2*)(KK + fr * 72 + 32 * x + 16 + fq * 4);
        uint2 r0 = *(const uint2*)(RK + fr * 72 + 32 * x + fq * 4);
        uint2 r1 = *(const uint2*)(RK + fr * 72 + 32 * x + 16 + fq * 4);
        uint4 kw = make_uint4(k0.x, k0.y, k1.x, k1.y);
        uint4 rw = make_uint4(r0.x, r0.y, r1.x, r1.y);
#pragma unroll
        for (int nt = 0; nt < 2; ++nt) {
          uint4 sw;
          sw.x = pack2(S[2 * x][nt][0], S[2 * x][nt][1]); sw.y = pack2(S[2 * x][nt][2], S[2 * x][nt][3]);
          sw.z = pack2(S[2 * x + 1][nt][0], S[2 * x + 1][nt][1]); sw.w = pack2(S[2 * x + 1][nt][2], S[2 * x + 1][nt][3]);
          sa0[nt] = __builtin_amdgcn_mfma_f32_16x16x32_bf16(*(bf16x8*)&kw, *(bf16x8*)&sw, sa0[nt], 0, 0, 0);
          y0[nt] = __builtin_amdgcn_mfma_f32_16x16x32_bf16(*(bf16x8*)&rw, *(bf16x8*)&sw, y0[nt], 0, 0, 0);
        }
      }
      float ak[4], rb[4], rk[4];
#pragma unroll
      for (int e = 0; e < 4; ++e) {
        const int j = fq * 4 + e;
        ak[e] = (j < fr) ? XakT[e] : 0.f;
        rb[e] = (j <= fr) ? -XrbT[e] : 0.f;
        rk[e] = (j <= fr) ? XrkT[e] : 0.f;
      }
      const uint4 akw = make_uint4(pack2(ak[0], ak[1]), pack2(ak[2], ak[3]), 0u, 0u);
      const uint4 ybw = make_uint4(pack2(rb[0], rb[1]), pack2(rb[2], rb[3]), pack2(rk[0], rk[1]), pack2(rk[2], rk[3]));
      const uint2 tv = *(const uint2*)(Tinv + fr * 16 + fq * 4);
      const uint4 tw = make_uint4(tv.x, tv.y, 0u, 0u);
      uint4 sv[2];
#pragma unroll
      for (int nt = 0; nt < 2; ++nt) {
        const int vc = wi * 32 + nt * 16 + fr;
        const uint2 vt = *(const uint2*)(VT + vc * 16 + fq * 4);
        const uint4 vb = make_uint4(vt.x, vt.y, 0u, 0u);
        f32x4 rhs = __builtin_amdgcn_mfma_f32_16x16x32_bf16(*(bf16x8*)&akw, *(bf16x8*)&vb, sa0[nt], 0, 0, 0);
        const uint4 rw = make_uint4(pack2(rhs[0], rhs[1]), pack2(rhs[2], rhs[3]), 0u, 0u);
        f32x4 sa = __builtin_amdgcn_mfma_f32_16x16x32_bf16(*(bf16x8*)&tw, *(bf16x8*)&rw, (f32x4){0.f, 0.f, 0.f, 0.f}, 0, 0, 0);
        sv[nt] = make_uint4(pack2(sa[0], sa[1]), pack2(sa[2], sa[3]), vt.x, vt.y);
        f32x4 y = __builtin_amdgcn_mfma_f32_16x16x32_bf16(*(bf16x8*)&ybw, *(bf16x8*)&sv[nt], y0[nt], 0, 0, 0);
        if (seg == 1) {
#pragma unroll
          for (int e = 0; e < 4; ++e) {
            const int sidx = ch * 16 + fq * 4 + e;
            const int tpos = d == 0 ? sidx : 2047 - sidx;
            O4[((size_t)d * NLAT + b * 2048 + tpos) * 512 + h * 64 + vc] = f2bf(y[e]);
          }
        }
      }
#pragma unroll
      for (int mt = 0; mt < 4; ++mt) {
        __builtin_amdgcn_sched_barrier(0);
        const float4 g4 = *(const float4*)(gC + mt * 16 + fq * 4);
        const uint2 bv = *(const uint2*)(BgCT + (mt * 16 + fr) * 16 + fq * 4);
        const uint2 kv = *(const uint2*)(KgCT + (mt * 16 + fr) * 16 + fq * 4);
        const uint4 aw = make_uint4(bv.x, bv.y, kv.x, kv.y);
#pragma unroll
        for (int nt = 0; nt < 2; ++nt) {
          S[mt][nt][0] *= g4.x; S[mt][nt][1] *= g4.y; S[mt][nt][2] *= g4.z; S[mt][nt][3] *= g4.w;
          S[mt][nt] = __builtin_amdgcn_mfma_f32_16x16x32_bf16(*(bf16x8*)&aw, *(bf16x8*)&sv[nt], S[mt][nt], 0, 0, 0);
        }
      }
    }
    SCAN_SYNC();
  }
#undef RW_LOAD
}

template <bool HW>
DEV void gdn_item(const Params& p, int gi, char* smem) {
  const u16* P = (const u16*)(p.ws + OFF_BIG);
  u16* O4 = (u16*)p.out;
  const int tid0 = VTID;
  const int b = gi >> 3, d = (gi >> 2) & 1, h = gi & 3;
  constexpr int BUFB = 23424;
  f32x4 S[8][2];
#pragma unroll
  for (int i = 0; i < 8; ++i)
#pragma unroll
    for (int j = 0; j < 2; ++j) S[i][j] = (f32x4){0.f, 0.f, 0.f, 0.f};
  const float negA = -__expf(p.dn_A_log[d * 4 + h]);
  const float dtb = p.dn_dt_bias[d * 4 + h];
  uint4 pre[3][3];
  float gpre0 = 0.f, gpre1 = 0.f;
#define GDN_LOAD(CI)                                                                               \
  {                                                                                                \
    const int seg_ = (CI) < 16 ? 0 : 1;                                                            \
    const int ch_ = seg_ ? (CI)-16 : (CI);                                                         \
    const int Ls_ = seg_ ? 2048 : 256;                                                             \
    const int rb_ = seg_ ? b * 2048 : NLAT + b * 256;                                              \
    const int sidx_ = ch_ * 16 + stt;                                                              \
    const int t_ = d == 0 ? sidx_ : Ls_ - 1 - sidx_;                                               \
    const u16* prow_ = P + (size_t)(rb_ + t_) * PS1 + DNO;                                         \
    _Pragma("unroll") for (int g = 0; g < 3; ++g) {                                                \
      const int col_ = g * 512 + h * 128 + spart * 8;                                              \
      _Pragma("unroll") for (int tap = 0; tap < 3; ++tap) {                                        \
        const int tt_ = t_ + tap - 1;                                                              \
        if (tt_ >= 0 && tt_ < Ls_) pre[g][tap] = *(const uint4*)(prow_ + (ptrdiff_t)(tap - 1) * PS1 + col_); \
        else pre[g][tap] = make_uint4(0u, 0u, 0u, 0u);                                             \
      }                                                                                            \
    }                                                                                              \
    if (wave == 0) {                                                                               \
      const int s2_ = ch_ * 16 + fr;                                                               \
      const int t2_ = d == 0 ? s2_ : Ls_ - 1 - s2_;                                                \
      const u16* gr_ = P + (size_t)(rb_ + t2_) * PS1 + DNO + 2048;                                 \
      gpre0 = bf2f(gr_[d * 4 + h]);                                                                \
      gpre1 = bf2f(gr_[8 + d * 4 + h]);                                                            \
    }                                                                                              \
  }
  {
    const int tid = tid0, lane = tid & 63, wave = tid >> 6, fr = lane & 15, stt = tid >> 4, spart = tid & 15;
    GDN_LOAD(0)
  }
  for (int cidx = 0; cidx < 144; ++cidx) {
    asm volatile("" ::: "memory");
    int tid = tid0;
    asm volatile("" : "+v"(tid));
    const int lane = tid & 63, wave = tid >> 6, fr = lane & 15, fq = lane >> 4, stt = tid >> 4, spart = tid & 15;
    char* buf = smem;
    u16* Kb = (u16*)buf;
    u16* Qb = Kb + 16 * 136;
    float* Vf = (float*)(buf + 8704);
    u16* KdT = (u16*)(buf + 17152);
    u16* Tinv = (u16*)(buf + 21248);
    u16* Pm = (u16*)(buf + 21760);
    float* Amat = (float*)(buf + 22272);
    float* Gs = (float*)(buf + 23296);
    float* Bs = Gs + 16;
#pragma unroll
    for (int g = 0; g < 3; ++g) {
      __builtin_amdgcn_sched_barrier(0);
      const int col = g * 512 + h * 128 + spart * 8;
      float z[8];
#pragma unroll
      for (int j = 0; j < 8; ++j) z[j] = 0.f;
#pragma unroll
      for (int tap = 0; tap < 3; ++tap) {
        __builtin_amdgcn_sched_barrier(0);
        float f[8];
        unpack8(pre[g][tap], f);
        const float* w = p.dn_conv + tap * 1536 + col;
        float4 w0 = *(const float4*)w, w1 = *(const float4*)(w + 4);
        z[0] += f[0] * w0.x; z[1] += f[1] * w0.y; z[2] += f[2] * w0.z; z[3] += f[3] * w0.w;
        z[4] += f[4] * w1.x; z[5] += f[5] * w1.y; z[6] += f[6] * w1.z; z[7] += f[7] * w1.w;
      }
      float ss = 0.f;
#pragma unroll
      for (int j = 0; j < 8; ++j) { z[j] = silu(z[j]); ss += z[j] * z[j]; }
      if (g < 2) {
        ss += __shfl_xor(ss, 1, 64); ss += __shfl_xor(ss, 2, 64); ss += __shfl_xor(ss, 4, 64); ss += __shfl_xor(ss, 8, 64);
        float sc = rsqrtf(ss + 1e-6f);
        if (g == 0) sc *= 0.08838834764831845f;
#pragma unroll
        for (int j = 0; j < 8; ++j) z[j] *= sc;
        *(uint4*)((g == 0 ? Qb : Kb) + stt * 136 + spart * 8) = pack8(z);
      } else {
        float* dst = Vf + stt * 132 + spart * 8;
        *(float4*)dst = make_float4(z[0], z[1], z[2], z[3]);
        *(float4*)(dst + 4) = make_float4(z[4], z[5], z[6], z[7]);
      }
    }
    if (wave == 0) {
      float g = negA * softplus(gpre0 + dtb);
#pragma unroll
      for (int o = 1; o < 16; o <<= 1) { float n = __shfl_up(g, o, 16); if (fr >= o) g += n; }
      if (lane < 16) { Gs[lane] = g; Bs[lane] = sigm(gpre1); }
    }
    SCAN_SYNC();
    if (wave == 0) {
      f32x4 kk = (f32x4){0.f, 0.f, 0.f, 0.f};
#pragma unroll
      for (int ks = 0; ks < 4; ++ks) {
        bf16x8 kf = *(const bf16x8*)(Kb + fr * 136 + ks * 32 + fq * 8);
        kk = __builtin_amdgcn_mfma_f32_16x16x32_bf16(kf, kf, kk, 0, 0, 0);
      }
      const float Gj = Gs[fr];
#pragma unroll
      for (int e = 0; e < 4; ++e) {
        const int i = fq * 4 + e;
        const float a = (fr < i) ? Bs[i] * kk[e] * __expf(Gs[i] - Gj) : 0.f;
        Amat[i * 16 + fr] = a;
      }
      lds_wave_sync();
      if (lane < 16) {
        float x[16];
        x[0] = (lane == 0) ? 1.f : 0.f;
        float4 cur[4], nxt[4];
        cur[0] = *(const float4*)(Amat + 16);
        cur[1] = cur[0]; cur[2] = cur[0]; cur[3] = cur[0];
#pragma unroll
        for (int i = 1; i < 16; ++i) {
          __builtin_amdgcn_sched_barrier(0);
          if (i + 1 < 16) {
#pragma unroll
            for (int q = 0; q < (i + 4) / 4; ++q) nxt[q] = *(const float4*)(Amat + (i + 1) * 16 + q * 4);
          }
          float acc = (i == lane) ? 1.f : 0.f;
#pragma unroll
          for (int j = 0; j < i; ++j) {
            const float4 rv = cur[j >> 2];
            const float av = (j & 3) == 0 ? rv.x : ((j & 3) == 1 ? rv.y : ((j & 3) == 2 ? rv.z : rv.w));
            acc -= av * x[j];
          }
          x[i] = acc;
#pragma unroll
          for (int q = 0; q < 4; ++q) cur[q] = nxt[q];
        }
#pragma unroll
        for (int i = 0; i < 16; ++i) Tinv[i * 16 + lane] = f2bf(x[i]);
      }
    } else if (wave == 1) {
      f32x4 qk = (f32x4){0.f, 0.f, 0.f, 0.f};
#pragma unroll
      for (int ks = 0; ks < 4; ++ks) {
        bf16x8 qf = *(const bf16x8*)(Qb + fr * 136 + ks * 32 + fq * 8);
        bf16x8 kf = *(const bf16x8*)(Kb + fr * 136 + ks * 32 + fq * 8);
        qk = __builtin_amdgcn_mfma_f32_16x16x32_bf16(qf, kf, qk, 0, 0, 0);
      }
      const float Gj = Gs[fr];
#pragma unroll
      for (int e = 0; e < 4; ++e) {
        const int t = fq * 4 + e;
        const float v = (fr <= t) ? qk[e] * __expf(Gs[t] - Gj) : 0.f;
        Pm[t * 16 + fr] = f2bf(v);
      }
    } else {
      const int k = tid - 128;
      const float GC = Gs[15];
      unsigned w[8];
#pragma unroll
      for (int j = 0; j < 8; ++j) {
        __builtin_amdgcn_sched_barrier(0);
        float v0 = bf2f(Kb[(2 * j) * 136 + k]) * __expf(GC - Gs[2 * j]);
        float v1 = bf2f(Kb[(2 * j + 1) * 136 + k]) * __expf(GC - Gs[2 * j + 1]);
        w[j] = pack2(v0, v1);
      }
      *(uint4*)(KdT + k * 16) = make_uint4(w[0], w[1], w[2], w[3]);
      *(uint4*)(KdT + k * 16 + 8) = make_uint4(w[4], w[5], w[6], w[7]);
    }
    __builtin_amdgcn_sched_barrier(0);
    f32x4 ksv[2], qsv[2];
#pragma unroll
    for (int nt = 0; nt < 2; ++nt) { ksv[nt] = (f32x4){0.f, 0.f, 0.f, 0.f}; qsv[nt] = (f32x4){0.f, 0.f, 0.f, 0.f}; }
#pragma unroll
    for (int x = 0; x < 4; ++x) {
      __builtin_amdgcn_sched_barrier(0);
      uint2 k0 = *(const uint2*)(Kb + fr * 136 + 32 * x + fq * 4);
      uint2 k1 = *(const uint2*)(Kb + fr * 136 + 32 * x + 16 + fq * 4);
      uint2 q0 = *(const uint2*)(Qb + fr * 136 + 32 * x + fq * 4);
      uint2 q1 = *(const uint2*)(Qb + fr * 136 + 32 * x + 16 + fq * 4);
      uint4 kw = make_uint4(k0.x, k0.y, k1.x, k1.y);
      uint4 qw = make_uint4(q0.x, q0.y, q1.x, q1.y);
#pragma unroll
      for (int nt = 0; nt < 2; ++nt) {
        uint4 sw;
        sw.x = pack2(S[2 * x][nt][0], S[2 * x][nt][1]); sw.y = pack2(S[2 * x][nt][2], S[2 * x][nt][3]);
        sw.z = pack2(S[2 * x + 1][nt][0], S[2 * x + 1][nt][1]); sw.w = pack2(S[2 * x + 1][nt][2], S[2 * x + 1][nt][3]);
        ksv[nt] = __builtin_amdgcn_mfma_f32_16x16x32_bf16(*(bf16x8*)&kw, *(bf16x8*)&sw, ksv[nt], 0, 0, 0);
        qsv[nt] = __builtin_amdgcn_mfma_f32_16x16x32_bf16(*(bf16x8*)&qw, *(bf16x8*)&sw, qsv[nt], 0, 0, 0);
      }
    }
    SCAN_SYNC();
    if (cidx + 1 < 144) GDN_LOAD(cidx + 1)
    __builtin_amdgcn_sched_barrier(0);
    {
      const int seg = cidx < 16 ? 0 : 1;
      const int ch = seg ? cidx - 16 : cidx;
      float eG[4], bt[4];
#pragma unroll
      for (int e = 0; e < 4; ++e) { eG[e] = __expf(Gs[fq * 4 + e]); bt[e] = Bs[fq * 4 + e]; }
      const float eGC = __expf(Gs[15]);
      uint2 tv = *(const uint2*)(Tinv + fr * 16 + fq * 4);
      uint2 pv = *(const uint2*)(Pm + fr * 16 + fq * 4);
      uint4 tw = make_uint4(tv.x, tv.y, 0u, 0u);
      uint4 pw = make_uint4(pv.x, pv.y, 0u, 0u);
      uint4 ub[2];
#pragma unroll
      for (int nt = 0; nt < 2; ++nt) {
        const int vc = wave * 32 + nt * 16 + fr;
        float rhs[4];
#pragma unroll
        for (int e = 0; e < 4; ++e) rhs[e] = bt[e] * (Vf[(fq * 4 + e) * 132 + vc] - eG[e] * ksv[nt][e]);
        uint4 rw = make_uint4(pack2(rhs[0], rhs[1]), pack2(rhs[2], rhs[3]), 0u, 0u);
        f32x4 u = __builtin_amdgcn_mfma_f32_16x16x32_bf16(*(bf16x8*)&tw, *(bf16x8*)&rw, (f32x4){0.f, 0.f, 0.f, 0.f}, 0, 0, 0);
        ub[nt] = make_uint4(pack2(u[0], u[1]), pack2(u[2], u[3]), 0u, 0u);
        f32x4 oa;
#pragma unroll
        for (int e = 0; e < 4; ++e) oa[e] = eG[e] * qsv[nt][e];
        oa = __builtin_amdgcn_mfma_f32_16x16x32_bf16(*(bf16x8*)&pw, *(bf16x8*)&ub[nt], oa, 0, 0, 0);
        if (seg == 1) {
#pragma unroll
          for (int e = 0; e < 4; ++e) {
            const int sidx = ch * 16 + fq * 4 + e;
            const int t = d == 0 ? sidx : 2047 - sidx;
            O4[((size_t)(2 + d) * NLAT + b * 2048 + t) * 512 + h * 128 + vc] = f2bf(oa[e]);
          }
        }
      }
#pragma unroll
      for (int mt = 0; mt < 8; ++mt) {
        __builtin_amdgcn_sched_barrier(0);
        uint2 kv = *(const uint2*)(KdT + (mt * 16 + fr) * 16 + fq * 4);
        uint4 kw = make_uint4(kv.x, kv.y, 0u, 0u);
#pragma unroll
        for (int nt = 0; nt < 2; ++nt) {
#pragma unroll
          for (int e = 0; e < 4; ++e) S[mt][nt][e] *= eGC;
          S[mt][nt] = __builtin_amdgcn_mfma_f32_16x16x32_bf16(*(bf16x8*)&kw, *(bf16x8*)&ub[nt], S[mt][nt], 0, 0, 0);
        }
      }
    }
    SCAN_SYNC();
    if (HW) SCAN_SYNC();
  }
#undef GDN_LOAD
}

#undef SCAN_SYNC
DEV void phase_scans(const Params& p, char* smem) {
  if (VNB == 512) {
    if (VHALF == 1) rwkv_item<true>(p, VBID >> 1, smem);
    else gdn_item<true>(p, VBID >> 1, smem);
  } else {
#pragma unroll 1
    for (int it = VBID; it < 512; it += VNB)
      if (it & 1) rwkv_item<false>(p, it >> 1, smem);
    __builtin_amdgcn_sched_barrier(0);
#pragma unroll 1
    for (int it = VBID; it < 512; it += VNB)
      if (!(it & 1)) gdn_item<false>(p, it >> 1, smem);
  }
}

DEV void mixout_item(const Params& p, int it, char* smem) {
  const u16* P = (const u16*)(p.ws + OFF_BIG);
  const u16* O4 = (const u16*)p.out;
  const float* BS = (const float*)(p.ws + OFF_BSUM);
  const u16* G2T = (const u16*)(p.ws + OFF_G2T);
  u16* Y = (u16*)(p.ws + OFF_HY);
  u16* sg = (u16*)smem;
  u16* G = sg + 32 * 136;
  const int tid = VTID, lane = tid & 63, wave = tid >> 6;
  const int fr = lane & 15, fq = lane >> 4;
  const int tok0 = it * 32, tl0 = tok0 & 2047;
  const int tk = tid >> 3, part = tid & 7;
  const int row = tok0 + tk, t = tl0 + tk;
  const bool hasp = t > 0, hasn = t + 1 < 2048;
  const u16* prow = P + (size_t)row * PS1;
  {
#pragma unroll
    for (int q = 0; q < 2; ++q) {
      const int col = 1792 + part * 16 + q * 8;
      float pc[8], pp[8], pn[8], v[8];
      unpack8(*(const uint4*)(prow + col), pc);
      if (hasp) unpack8(*(const uint4*)(prow - PS1 + col), pp);
      else {
#pragma unroll
        for (int j = 0; j < 8; ++j) pp[j] = 0.f;
      }
      if (hasn) unpack8(*(const uint4*)(prow + PS1 + col), pn);
      else {
#pragma unroll
        for (int j = 0; j < 8; ++j) pn[j] = 0.f;
      }
      const float* mu = p.rw_mu + col;
#pragma unroll
      for (int j = 0; j < 8; ++j) v[j] = sigm(pc[j] + mu[j] * (0.5f * (pp[j] + pn[j]) - pc[j]));
      *(uint4*)(sg + tk * 136 + part * 16 + q * 8) = pack8(v);
    }
  }
  HSYNC();
  {
    bf16x8 af[2][4];
#pragma unroll
    for (int mt = 0; mt < 2; ++mt)
#pragma unroll
      for (int ks = 0; ks < 4; ++ks) af[mt][ks] = *(const bf16x8*)(sg + (mt * 16 + fr) * 136 + ks * 32 + fq * 8);
#pragma unroll
    for (int nt = 0; nt < 8; ++nt) {
      const u16* bp = G2T + (size_t)(wave * 128 + nt * 16 + fr) * 128 + fq * 8;
      bf16x8 bf0 = *(const bf16x8*)(bp), bf1 = *(const bf16x8*)(bp + 32), bf2 = *(const bf16x8*)(bp + 64), bf3 = *(const bf16x8*)(bp + 96);
#pragma unroll
      for (int mt = 0; mt < 2; ++mt) {
        f32x4 a = (f32x4){0.f, 0.f, 0.f, 0.f};
        a = __builtin_amdgcn_mfma_f32_16x16x32_bf16(af[mt][0], bf0, a, 0, 0, 0);
        a = __builtin_amdgcn_mfma_f32_16x16x32_bf16(af[mt][1], bf1, a, 0, 0, 0);
        a = __builtin_amdgcn_mfma_f32_16x16x32_bf16(af[mt][2], bf2, a, 0, 0, 0);
        a = __builtin_amdgcn_mfma_f32_16x16x32_bf16(af[mt][3], bf3, a, 0, 0, 0);
#pragma unroll
        for (int e = 0; e < 4; ++e) G[(mt * 16 + fq * 4 + e) * 520 + wave * 128 + nt * 16 + fr] = f2bf(a[e]);
      }
    }
  }
  HSYNC();
  {
    const int hd = part, c0 = hd * 64;
    const u16* of = O4 + (size_t)row * 512 + c0;
    const u16* ob = O4 + ((size_t)NLAT + row) * 512 + c0;
    const float bsum = BS[(size_t)row * 16 + hd * 2] + BS[(size_t)row * 16 + hd * 2 + 1];
    float s1 = 0.f, s2 = 0.f;
#pragma unroll
    for (int q = 0; q < 8; ++q) {
      float a[8], b8[8];
      unpack8(*(const uint4*)(of + q * 8), a);
      unpack8(*(const uint4*)(ob + q * 8), b8);
#pragma unroll
      for (int j = 0; j < 8; ++j) { const float v = a[j] + b8[j]; s1 += v; s2 += v * v; }
    }
    const float mean = s1 * (1.f / 64.f);
    const float var = fmaxf(s2 * (1.f / 64.f) - mean * mean, 0.f);
    const float rs = rsqrtf(var + 64e-5f);
#pragma unroll
    for (int q = 0; q < 8; ++q) {
      const int c = c0 + q * 8;
      float pc[8], pp[8], pn[8], gv[8], o[8], ya[8], yb[8];
      unpack8(*(const uint4*)(of + q * 8), ya);
      unpack8(*(const uint4*)(ob + q * 8), yb);
      unpack8(*(const uint4*)(prow + 1024 + c), pc);
      if (hasp) unpack8(*(const uint4*)(prow - PS1 + 1024 + c), pp);
      else {
#pragma unroll
        for (int j = 0; j < 8; ++j) pp[j] = 0.f;
      }
      if (hasn) unpack8(*(const uint4*)(prow + PS1 + 1024 + c), pn);
      else {
#pragma unroll
        for (int j = 0; j < 8; ++j) pn[j] = 0.f;
      }
      unpack8(*(const uint4*)(G + tk * 520 + c), gv);
      const float* mu = p.rw_mu + 1024 + c;
      const float* gg = p.rw_lnx_g + c;
      const float* gb = p.rw_lnx_b + c;
#pragma unroll
      for (int j = 0; j < 8; ++j) {
        const float vsh = pc[j] + mu[j] * (0.5f * (pp[j] + pn[j]) - pc[j]);
        const float yn = (ya[j] + yb[j] - mean) * rs * gg[j] + gb[j];
        o[j] = (yn + bsum * vsh) * gv[j];
      }
      *(uint4*)(Y + (size_t)row * 1024 + c) = pack8(o);
    }
  }
  {
    const int c0 = part * 64;
    const u16* of = O4 + ((size_t)2 * NLAT + row) * 512 + c0;
    const u16* ob = O4 + ((size_t)3 * NLAT + row) * 512 + c0;
    float s2 = 0.f;
#pragma unroll
    for (int q = 0; q < 8; ++q) {
      float a[8], b8[8];
      unpack8(*(const uint4*)(of + q * 8), a);
      unpack8(*(const uint4*)(ob + q * 8), b8);
#pragma unroll
      for (int j = 0; j < 8; ++j) { const float v = a[j] + b8[j]; s2 += v * v; }
    }
    s2 += __shfl_xor(s2, 1, 64);
    const float rs = rsqrtf(s2 * (1.f / 128.f) + 1e-6f);
    const u16* zr = prow + DNO + 1536 + c0;
    const float* ng = p.dn_norm_g + (part & 1) * 64;
#pragma unroll
    for (int q = 0; q < 8; ++q) {
      float z[8], r8[8], a[8], b8[8];
      unpack8(*(const uint4*)(of + q * 8), a);
      unpack8(*(const uint4*)(ob + q * 8), b8);
      unpack8(*(const uint4*)(zr + q * 8), z);
#pragma unroll
      for (int j = 0; j < 8; ++j) r8[j] = (a[j] + b8[j]) * rs * ng[q * 8 + j] * silu(z[j]);
      *(uint4*)(Y + (size_t)row * 1024 + 512 + c0 + q * 8) = pack8(r8);
    }
  }
  HSYNC();
}

#define XB_TMO      128
#define XB_XCNT(j)  (256  + 64 * (j))
#define XB_XSUB(j)  (1280 + 64 * (j))
#define XB_XGEN(j)  (2304 + 64 * (j))
#define XB_TOP      3328
#define XB_TOPGEN   3392
#define XCD_BAR_WORDS 3456
#define XB_SPIN_CAP (1u << 20)
DEV unsigned xb_ld(unsigned* p) { return __hip_atomic_load(p, __ATOMIC_RELAXED, __HIP_MEMORY_SCOPE_AGENT); }
DEV unsigned xb_add(unsigned* p, unsigned v) { return __hip_atomic_fetch_add(p, v, __ATOMIC_RELAXED, __HIP_MEMORY_SCOPE_AGENT); }
DEV unsigned xb_xcc_id() { return (unsigned)__builtin_amdgcn_s_getreg((3 << 11) | 20) & 0xFu; }
#define XB_SPIN(cond, bar) do { unsigned _sp = 0; while (cond) { __builtin_amdgcn_s_sleep(1); \
    if ((++_sp & 255u) == 0u) { if (xb_ld(&(bar)[XB_TMO])) break; if (_sp > XB_SPIN_CAP) { atomicAdd(&(bar)[XB_TMO], 1u); break; } } } } while (0)
DEV void xcd_barrier_complete(unsigned* bar, unsigned x, unsigned& nloc, unsigned& nx) {
  const unsigned G = gridDim.x;
  unsigned sum, cnt, mine, sp = 0u;
  for (;;) {
    sum = 0u; cnt = 0u; mine = 0u;
#pragma unroll
    for (unsigned j = 0; j < 16; ++j) { const unsigned c = xb_ld(&bar[XB_XCNT(j)]); sum += c; cnt += (c > 0u) ? 1u : 0u; mine = (j == x) ? c : mine; }
    if (sum == G) break;
    __builtin_amdgcn_s_sleep(1);
    if ((++sp & 255u) == 0u) { if (xb_ld(&bar[XB_TMO])) break; if (sp > XB_SPIN_CAP) { atomicAdd(&bar[XB_TMO], 1u); break; } }
  }
  nloc = mine > 0u ? mine : 1u; nx = cnt > 0u ? cnt : 1u;
}
DEV void xcd_barrier(unsigned* bar) {
  asm volatile("s_waitcnt vmcnt(0)" ::: "memory");
  __syncthreads();
  if (threadIdx.x == 0) {
    __builtin_amdgcn_s_waitcnt(0);
    const unsigned x = xb_xcc_id();
    volatile LAS unsigned* st = (volatile LAS unsigned*)(dyn_smem + HS_OFF + 128);
    unsigned nloc = st[0], nx = st[1];
    if (nloc == 0u) { xcd_barrier_complete(bar, x, nloc, nx); st[0] = nloc; st[1] = nx; }
    const unsigned old = xb_add(&bar[XB_XSUB(x)], 1u);
    const unsigned gen = old / nloc;
    if (old + 1u == (gen + 1u) * nloc) {
      __builtin_amdgcn_fence(__ATOMIC_RELEASE, "agent");
      asm volatile("s_waitcnt vmcnt(0)" ::: "memory");
      const unsigned og = xb_add(&bar[XB_TOP], 1u);
      const unsigned tg = og / nx;
      if (og + 1u == (tg + 1u) * nx) xb_add(&bar[XB_TOPGEN], 1u);
      else XB_SPIN(xb_ld(&bar[XB_TOPGEN]) == tg, bar);
      __builtin_amdgcn_fence(__ATOMIC_ACQUIRE, "agent");
      xb_add(&bar[XB_XGEN(x)], 1u);
      asm volatile("s_waitcnt vmcnt(0)" ::: "memory");
    } else {
      XB_SPIN(xb_ld(&bar[XB_XGEN(x)]) == gen, bar);
      __builtin_amdgcn_fence(__ATOMIC_ACQUIRE, "agent");
      asm volatile("s_waitcnt vmcnt(0)" ::: "memory");
    }
  }
  __syncthreads();
}

constexpr int NPHASE = 18;

__global__ void __launch_bounds__(512, 2) mega(Params p, int ph_lo, int ph_hi) {
  char* smem = dyn_smem + VHALF * HALF_LDS;
  if ((threadIdx.x & 255) == 0) *((LAS unsigned*)(dyn_smem + HS_OFF) + (threadIdx.x >> 8) * 16) = 0u;
  __syncthreads();
  cg::grid_group grid = cg::this_grid();
  const float* mv0 = (const float*)(p.ws + OFF_MODV);
  const float* mv1 = mv0 + 33 * 6144;
  u16* X = (u16*)(p.ws + OFF_X);
  u16* HY = (u16*)(p.ws + OFF_HY);
  u16* BIG = (u16*)(p.ws + OFF_BIG);
  unsigned* bar = (unsigned*)(p.ws + OFF_BAR);
  if (threadIdx.x == 0) {
    volatile LAS unsigned* st = (volatile LAS unsigned*)(dyn_smem + HS_OFF + 128);
    st[0] = 0u; st[1] = 0u;
    (void)xb_add(&bar[XB_XCNT(xb_xcc_id())], 1u);
  }
  if (ph_hi < 0) grid.sync();
#define PHASE(n, BODY) if (ph_lo <= (n) && (n) < ph_hi) { BODY; if ((n) + 1 < ph_hi) xcd_barrier(bar); }
  PHASE(0, phase_prep(p, smem))
  PHASE(1, phase_init(p))
  PHASE(2, gemm_phase<0>(HY, 1024, (const u16*)(p.ws + OFF_WIN0), 1024, NTOK, 2304, BIG, PS0, nullptr, dyn_smem))
  PHASE(3, phase_hyprep_rope(p, smem))
  PHASE(4, phase_conv_attn(p, smem))
  PHASE(5, gemm_phase<2>(HY, 1024, (const u16*)(p.ws + OFF_WOUT0), 1024, NTOK, 1024, X, 1024, mv0 + 2 * 1024, dyn_smem))
  PHASE(6, ln_phase<false>(p, NTOK, p.ln_g, p.ln_b, mv0, 3, 4))
  PHASE(7, gemm_phase<1>(HY, 1024, (const u16*)(p.ws + OFF_W1_0), 1024, NTOK, 4096, BIG, 4096, nullptr, dyn_smem))
  PHASE(8, gemm_phase<2>(BIG, 4096, (const u16*)(p.ws + OFF_W2_0), 4096, NTOK, 1024, X, 1024, mv0 + 5 * 1024, dyn_smem))
  PHASE(9, ln_phase<false>(p, NTOK, p.ln_g + 1024, p.ln_b + 1024, mv1, 0, 1))
  PHASE(10, gemm_phase<0>(HY, 1024, (const u16*)(p.ws + OFF_WIN1), 1024, NTOK, 4096, BIG, PS1, nullptr, dyn_smem))
  PHASE(11, phase_scans(p, smem))
  PHASE(12, for (int it = VBID; it < 2048; it += VNB) mixout_item(p, it, smem))
  PHASE(13, gemm_phase<2>(HY, 1024, (const u16*)(p.ws + OFF_WOUT1), 1024, NLAT, 1024, X, 1024, mv1 + 2 * 1024, dyn_smem))
  PHASE(14, ln_phase<false>(p, NLAT, p.ln_g + 2048, p.ln_b + 2048, mv1, 3, 4))
  PHASE(15, gemm_phase<1>(HY, 1024, (const u16*)(p.ws + OFF_W1_1), 1024, NLAT, 4096, BIG, 4096, nullptr, dyn_smem))
  PHASE(16, gemm_phase<2>(BIG, 4096, (const u16*)(p.ws + OFF_W2_1), 4096, NLAT, 1024, X, 1024, mv1 + 5 * 1024, dyn_smem))
  PHASE(17, ln_phase<true>(p, NLAT, p.ln_g + 3072, p.ln_b + 3072, mv1, 0, 1))
}

extern "C" void kernel_launch(void* const* d_in, const int* in_sizes, int n_in, void* d_out, int out_size, void* d_ws,
                              size_t ws_size, hipStream_t stream) {
  static int grid_blocks = 0;
  if (!grid_blocks) {
    int dev = 0, cus = 0, per_cu = 0;
    hipGetDevice(&dev);
    hipDeviceGetAttribute(&cus, hipDeviceAttributeMultiprocessorCount, dev);
    hipFuncSetAttribute((const void*)mega, hipFuncAttributeMaxDynamicSharedMemorySize, LDS_BYTES);
    hipOccupancyMaxActiveBlocksPerMultiprocessor(&per_cu, mega, 512, LDS_BYTES);
    if (per_cu > 1) per_cu = 1;
    if (per_cu < 1) per_cu = 1;
    grid_blocks = cus * per_cu;
  }
  if (ws_size < WS_NEED) fprintf(stderr, "workspace too small: %zu < %zu\n", ws_size, (size_t)WS_NEED);
  Params p{};
  const float** pp = (const float**)&p;
  for (int i = 0; i < 39; ++i) pp[i] = (const float*)d_in[i];
  p.out = (float*)d_out;
  p.ws = (char*)d_ws;
  int lo = 0, hi = NPHASE;
  void* args[] = {&p, &lo, &hi};
  hipMemsetAsync((char*)d_ws + OFF_BAR, 0, XCD_BAR_WORDS * sizeof(unsigned), stream);
  hipError_t e = hipLaunchCooperativeKernel((void*)mega, dim3(grid_blocks), dim3(512), args, LDS_BYTES, stream);
  if (e != hipSuccess) fprintf(stderr, "cooperative launch failed: %s (grid %d)\n", hipGetErrorString(e), grid_blocks);
}
```

```cpp
#include <hip/hip_runtime.h>
#include <hip/hip_cooperative_groups.h>
#include <cstdio>
#include <cstdint>
namespace cg = cooperative_groups;

typedef unsigned short u16;
typedef __attribute__((ext_vector_type(8))) short bf16x8;
typedef __attribute__((ext_vector_type(4))) float f32x4;
typedef __attribute__((ext_vector_type(16))) float f32x16;

#define DEV __device__ __forceinline__

constexpr int NLAT = 65536, NCTX = 8192, NTOK = 73728;
constexpr int PS0 = 2304;
constexpr int PS1 = 4096;
constexpr int DNO = 1920;
constexpr float ALPHA = 1.4142135623730951f;

constexpr size_t OFF_WIN0 = 0;
constexpr size_t OFF_WOUT0 = OFF_WIN0 + (size_t)2304 * 1024 * 2;
constexpr size_t OFF_W1_0 = OFF_WOUT0 + (size_t)1024 * 1024 * 2;
constexpr size_t OFF_W1_1 = OFF_W1_0 + (size_t)4096 * 1024 * 2;
constexpr size_t OFF_W2_0 = OFF_W1_1 + (size_t)4096 * 1024 * 2;
constexpr size_t OFF_W2_1 = OFF_W2_0 + (size_t)4096 * 1024 * 2;
constexpr size_t OFF_WIN1 = OFF_W2_1 + (size_t)4096 * 1024 * 2;
constexpr size_t OFF_WOUT1 = OFF_WIN1 + (size_t)4096 * 1024 * 2;
constexpr size_t OFF_MODV = OFF_WOUT1 + (size_t)1024 * 1024 * 2;
constexpr size_t OFF_KR2048 = OFF_MODV + (size_t)2 * 33 * 6144 * 4;
constexpr size_t OFF_KR256 = OFF_KR2048 + (size_t)512 * 4096 * 2;
constexpr size_t OFF_ROPE = OFF_KR256 + (size_t)512 * 512 * 2;
constexpr size_t OFF_BSUM = OFF_ROPE + 8192;
constexpr size_t OFF_G2T = OFF_BSUM + (size_t)65536 * 16 * 4;
constexpr size_t OFF_BAR = OFF_G2T + (size_t)512 * 128 * 2;
constexpr size_t OFF_X = (size_t)64 << 20;
constexpr size_t OFF_HY = OFF_X + (size_t)NTOK * 1024 * 2;
constexpr size_t OFF_BIG = OFF_HY + (size_t)NTOK * 1024 * 2;
constexpr size_t WS_NEED = OFF_BIG + (size_t)NTOK * 4096 * 2;
static_assert(OFF_BAR + 16384 <= OFF_X, "ws map");
constexpr size_t SO_U = 0;
constexpr size_t SO_X0 = SO_U + (size_t)512 * 32 * 2048 * 2;
constexpr size_t SO_UC = SO_X0 + (size_t)512 * 32 * 2048 * 2;
constexpr size_t SO_X0C = SO_UC + (size_t)512 * 32 * 256 * 2;

struct Params {
  const float *x, *c, *ctx, *c_ctx, *mod_w, *mod_b, *ln_g, *ln_b, *mlp_w1, *mlp_w2, *e_w_in, *e_w_out, *hy_conv,
      *hy_w1, *hy_b1, *hy_w2, *hy_b2, *hy_freq, *hy_w3, *hy_decay, *hy_bias, *attn_sink, *o_w_in, *o_w_out,
      *rw_mu, *rw_w0, *rw_w2, *rw_a0, *rw_a2, *rw_g2, *rw_kk, *rw_ka, *rw_rk, *rw_lnx_g, *rw_lnx_b,
      *dn_conv, *dn_A_log, *dn_dt_bias, *dn_norm_g;
  float* out;
  char* ws;
};

typedef float f32x2_t __attribute__((ext_vector_type(2)));
typedef __bf16 bf16x2_t __attribute__((ext_vector_type(2)));
DEV u16 f2bf(float f) { return __builtin_bit_cast(u16, (__bf16)f); }
DEV float bf2f(u16 h) { return __uint_as_float(((unsigned)h) << 16); }
DEV float bflo(unsigned u) { return __uint_as_float(u << 16); }
DEV float bfhi(unsigned u) { return __uint_as_float(u & 0xffff0000u); }
DEV unsigned pack2(float a, float b) { f32x2_t v = {a, b}; return __builtin_bit_cast(unsigned, __builtin_convertvector(v, bf16x2_t)); }
DEV void unpack8(const uint4& v, float* f) {
  f[0] = bflo(v.x); f[1] = bfhi(v.x); f[2] = bflo(v.y); f[3] = bfhi(v.y);
  f[4] = bflo(v.z); f[5] = bfhi(v.z); f[6] = bflo(v.w); f[7] = bfhi(v.w);
}
DEV uint4 pack8(const float* f) {
  uint4 v; v.x = pack2(f[0], f[1]); v.y = pack2(f[2], f[3]); v.z = pack2(f[4], f[5]); v.w = pack2(f[6], f[7]); return v;
}
DEV int modrow(int r) { return r < NLAT ? (r >> 11) : 32; }
DEV float sigm(float x) { return __builtin_amdgcn_rcpf(1.f + __expf(-x)); }
DEV float silu(float x) { return x * __builtin_amdgcn_rcpf(1.f + __expf(-x)); }
DEV float softplus(float x) { return fmaxf(x, 0.f) + __logf(1.f + __expf(-fabsf(x))); }
DEV float fast_tanh(float x) { return 1.f - 2.f * __builtin_amdgcn_rcpf(1.f + __expf(2.f * x)); }
DEV float wave_sum(float v) {
#pragma unroll
  for (int o = 32; o > 0; o >>= 1) v += __shfl_xor(v, o, 64);
  return v;
}

extern __shared__ __attribute__((aligned(16))) char dyn_smem[];
#define LAS __attribute__((address_space(3)))
constexpr int HALF_LDS = 65536;
constexpr int HS_OFF = 2 * HALF_LDS + 2048;
constexpr int LDS_BYTES = HS_OFF + 256;
#define VTID ((int)(threadIdx.x & 255))
#define VHALF ((int)__builtin_amdgcn_readfirstlane((int)(threadIdx.x >> 8)))
#define VBID ((int)(blockIdx.x * 2 + VHALF))
#define VNB ((int)(gridDim.x * 2))
DEV void hsync() {
  LAS unsigned* cnt = (LAS unsigned*)(dyn_smem + HS_OFF) + VHALF * 16;
  asm volatile("s_waitcnt lgkmcnt(0)" ::: "memory");
  unsigned tgt = 0u;
  if ((threadIdx.x & 63) == 0) {
    const unsigned old = __hip_atomic_fetch_add(cnt, 1u, __ATOMIC_RELAXED, __HIP_MEMORY_SCOPE_WORKGROUP);
    tgt = (old & ~3u) + 4u;
  }
  tgt = __builtin_amdgcn_readfirstlane(tgt);
  while (__hip_atomic_load(cnt, __ATOMIC_RELAXED, __HIP_MEMORY_SCOPE_WORKGROUP) < tgt) __builtin_amdgcn_s_sleep(0);
  asm volatile("s_waitcnt lgkmcnt(0)" ::: "memory");
}
#define HSYNC() hsync()

DEV void transpose_tile(const float* __restrict__ src, int K, int N, int Npad, u16* __restrict__ dst, int tile,
                               u16* sm) {
  const int tid = VTID;
  const int ntn = Npad >> 6;
  const int tk = tile / ntn, tn = tile - tk * ntn;
  const int n = tid & 63, kq = tid >> 6;
  const int gn = tn * 64 + n;
#pragma unroll 4
  for (int i = 0; i < 16; ++i) {
    int k = kq + 4 * i;
    float v = (gn < N) ? src[(size_t)(tk * 64 + k) * N + gn] : 0.f;
    sm[n * 66 + k] = f2bf(v);
  }
  HSYNC();
  const int n2 = tid >> 2, q = tid & 3;
  const unsigned* s32 = (const unsigned*)sm + (n2 * 66 + q * 16) / 2;
  uint4 a, b;
  a.x = s32[0]; a.y = s32[1]; a.z = s32[2]; a.w = s32[3];
  b.x = s32[4]; b.y = s32[5]; b.z = s32[6]; b.w = s32[7];
  u16* d = dst + (size_t)(tn * 64 + n2) * K + tk * 64 + q * 16;
  *(uint4*)d = a;
  *(uint4*)(d + 8) = b;
  HSYNC();
}

DEV void modv_item(const Params& p, int it, float* sl) {
  const int tid = VTID;
  const int l = it / 288, rem = it % 288, cc = rem / 3, rg = rem % 3;
  for (int idx = tid; idx < 11 * 1024; idx += 256) {
    int r = rg * 11 + (idx >> 10), k = idx & 1023;
    float cv = (r < 32) ? p.c[r * 1024 + k] : p.c_ctx[k];
    sl[idx] = cv / (1.f + expf(-cv));
  }
  HSYNC();
  const int cl = tid & 63, kg = tid >> 6;
  const int col = cc * 64 + cl;
  float acc[11];
#pragma unroll
  for (int r = 0; r < 11; ++r) acc[r] = 0.f;
  const float* w = p.mod_w + (size_t)l * 1024 * 6144 + (size_t)(kg * 256) * 6144 + col;
#pragma unroll 8
  for (int k = 0; k < 256; ++k) {
    float wv = w[(size_t)k * 6144];
#pragma unroll
    for (int r = 0; r < 11; ++r) acc[r] += sl[r * 1024 + kg * 256 + k] * wv;
  }
  HSYNC();
  float* red = sl;
#pragma unroll
  for (int r = 0; r < 11; ++r) red[(kg * 11 + r) * 64 + cl] = acc[r];
  HSYNC();
  for (int idx = tid; idx < 11 * 64; idx += 256) {
    int r = idx >> 6, c2 = idx & 63;
    float v = red[(0 * 11 + r) * 64 + c2] + red[(1 * 11 + r) * 64 + c2] + red[(2 * 11 + r) * 64 + c2] + red[(3 * 11 + r) * 64 + c2];
    int gcol = cc * 64 + c2;
    ((float*)(p.ws + OFF_MODV))[(size_t)(l * 33 + rg * 11 + r) * 6144 + gcol] = v + p.mod_b[l * 6144 + gcol];
  }
  HSYNC();
}

DEV void filter_item(const Params& p, int it, float* sm) {
  const int L = it < 2048 ? 2048 : 256;
  const int t = it < 2048 ? it : it - 2048;
  u16* R = (u16*)(p.ws + (L == 2048 ? OFF_KR2048 : OFF_KR256));
  float* pe = sm; float* h1 = sm + 64; float* h2 = sm + 128;
  const int tid = VTID;
  const float tn = (float)t / (float)(L - 1);
  if (tid < 33) {
    float v;
    if (tid == 0) v = tn;
    else {
      int i = (tid - 1) & 15;
      double band = 1e-4 + (double)i * ((15.0 - 1e-4) / 15.0);
      double ang = 2.0 * 3.14159265358979323846 * (double)t * band / (double)L;
      v = (tid <= 16) ? (float)cos(ang) : (float)(-sin(ang));
    }
    pe[tid] = v;
  }
  HSYNC();
  if (tid < 64) {
    float acc = p.hy_b1[tid];
#pragma unroll 11
    for (int i = 0; i < 33; ++i) acc += pe[i] * p.hy_w1[i * 64 + tid];
    h1[tid] = sinf(p.hy_freq[tid] * acc);
  }
  HSYNC();
  if (tid < 64) {
    float acc = p.hy_b2[tid];
#pragma unroll 16
    for (int i = 0; i < 64; ++i) acc += h1[i] * p.hy_w2[i * 64 + tid];
    h2[tid] = sinf(p.hy_freq[tid] * acc);
  }
  HSYNC();
#pragma unroll 1
  for (int q = 0; q < 4; ++q) {
    int o = tid + 256 * q;
    float acc = 0.f;
#pragma unroll 16
    for (int i = 0; i < 64; ++i) acc += h2[i] * p.hy_w3[i * 1024 + o];
    float val = acc * expf(-tn * fabsf(p.hy_decay[o]));
    if (o < 512) {
      if (t == 0) val += p.hy_bias[o];
      R[(size_t)o * 2 * L + L - t] = f2bf(val);
    } else {
      int c = o - 512;
      if (t >= 1) R[(size_t)c * 2 * L + L + t] = f2bf(val);
      else R[(size_t)c * 2 * L] = 0;
    }
  }
  HSYNC();
}

DEV void phase_prep(const Params& p, char* smem) {
  constexpr int T_IN0 = 16 * 36, T_OUT = 16 * 16, T_W = 16 * 64;
  constexpr int E0 = T_IN0, E1 = E0 + T_OUT, E2 = E1 + T_W, E3 = E2 + T_W, E4 = E3 + T_W, E5 = E4 + T_W,
                E6 = E5 + T_W, E7 = E6 + T_OUT, E8 = E7 + 576, E9 = E8 + 2304, E10 = E9 + 1, E11 = E10 + 16;
  for (int it = VBID; it < E11; it += VNB) {
    if (it >= E10) transpose_tile(p.rw_g2, 128, 512, 512, (u16*)(p.ws + OFF_G2T), it - E10, (u16*)smem);
    else if (it < E0) transpose_tile(p.e_w_in, 1024, 2304, 2304, (u16*)(p.ws + OFF_WIN0), it, (u16*)smem);
    else if (it < E1) transpose_tile(p.e_w_out, 1024, 1024, 1024, (u16*)(p.ws + OFF_WOUT0), it - E0, (u16*)smem);
    else if (it < E2) transpose_tile(p.mlp_w1, 1024, 4096, 4096, (u16*)(p.ws + OFF_W1_0), it - E1, (u16*)smem);
    else if (it < E3) transpose_tile(p.mlp_w1 + (size_t)1024 * 4096, 1024, 4096, 4096, (u16*)(p.ws + OFF_W1_1), it - E2, (u16*)smem);
    else if (it < E4) transpose_tile(p.mlp_w2, 4096, 1024, 1024, (u16*)(p.ws + OFF_W2_0), it - E3, (u16*)smem);
    else if (it < E5) transpose_tile(p.mlp_w2 + (size_t)1024 * 4096, 4096, 1024, 1024, (u16*)(p.ws + OFF_W2_1), it - E4, (u16*)smem);
    else if (it < E6) transpose_tile(p.o_w_in, 1024, 3984, 4096, (u16*)(p.ws + OFF_WIN1), it - E5, (u16*)smem);
    else if (it < E7) transpose_tile(p.o_w_out, 1024, 1024, 1024, (u16*)(p.ws + OFF_WOUT1), it - E6, (u16*)smem);
    else if (it < E8) modv_item(p, it - E7, (float*)smem);
    else if (it < E9) filter_item(p, it - E8, (float*)smem);
    else {
      float2* tab = (float2*)(p.ws + OFF_ROPE);
      for (int q = 0; q < 4; ++q) {
        int e = VTID * 4 + q;
        int pos = e >> 4, i = e & 15;
        float inv = powf(10000.f, -(float)i / 16.f);
        float ang = (float)pos * inv;
        tab[e] = make_float2(cosf(ang), sinf(ang));
      }
    }
  }
}

DEV void phase_init(const Params& p) {
  const float* mv = (const float*)(p.ws + OFF_MODV);
  u16* X = (u16*)(p.ws + OFF_X);
  u16* HM = (u16*)(p.ws + OFF_HY);
  const size_t total = (size_t)NTOK * 128;
  for (size_t i = (size_t)VBID * 256 + VTID; i < total; i += (size_t)VNB * 256) {
    int r = (int)(i >> 7), c8 = (int)(i & 127) * 8;
    const float* src = r < NLAT ? p.x + (size_t)r * 1024 + c8 : p.ctx + (size_t)(r - NLAT) * 1024 + c8;
    float4 v0 = *(const float4*)src, v1 = *(const float4*)(src + 4);
    const float* m = mv + (size_t)modrow(r) * 6144 + c8;
    float4 h0 = *(const float4*)m, h1 = *(const float4*)(m + 4);
    float4 s0 = *(const float4*)(m + 1024), s1 = *(const float4*)(m + 1028);
    float f[8] = {v0.x, v0.y, v0.z, v0.w, v1.x, v1.y, v1.z, v1.w};
    float sh[8] = {h0.x, h0.y, h0.z, h0.w, h1.x, h1.y, h1.z, h1.w};
    float sc[8] = {s0.x, s0.y, s0.z, s0.w, s1.x, s1.y, s1.z, s1.w};
    float g[8];
#pragma unroll
    for (int j = 0; j < 8; ++j) g[j] = f[j] * (1.f + sc[j]) + sh[j];
    *(uint4*)(X + (size_t)r * 1024 + c8) = pack8(f);
    *(uint4*)(HM + (size_t)r * 1024 + c8) = pack8(g);
  }
}

template <int EPI>
DEV void gemm_phase(const u16* __restrict__ A, int lda, const u16* __restrict__ Bt, int K, int M, int N,
                    u16* __restrict__ C, int ldc, const float* __restrict__ gate, char* smem) {
  const int tid = threadIdx.x, lane = tid & 63, wave = tid >> 6;
  const int wm = wave >> 2, wn = wave & 3;
  const int fr = lane & 15, fq = lane >> 4;
  const int tn = N >> 8, tm = M >> 8, tiles = tm * tn;
  const int nk = K >> 6;
  const int drow = wave * 8 + (lane >> 3);
  const int dchunk = (lane & 7) ^ ((drow >> 1) & 7);
  const size_t lda64 = (size_t)lda * 64, ldb64 = (size_t)K * 64;
  const int sw = fr >> 1;
  const bool xcd_order = (gridDim.x & 7) == 0 && (tm & 31) == 0;
  const int mx = tm >> 3;
#define G_COORDS(IT, M0, N0)                                                   \
  {                                                                            \
    int tm_i, tn_i;                                                            \
    if (xcd_order) {                                                           \
      const int x = (IT) & 7, local = (IT) >> 3;                               \
      const int mg = local / (4 * tn), r = local - mg * 4 * tn;                \
      tn_i = r >> 2;                                                           \
      tm_i = x * mx + mg * 4 + (r & 3);                                        \
    } else { tm_i = (IT) / tn; tn_i = (IT) - tm_i * tn; }                      \
    M0 = tm_i << 8; N0 = tn_i << 8;                                            \
  }
  int m0 = 0, n0 = 0;
  const u16* ag = A;
  const u16* bg = Bt;
  bool primed = false;
  for (int it = blockIdx.x; it < tiles; it += gridDim.x) {
    if (!primed) {
      G_COORDS(it, m0, n0)
      ag = A + (size_t)(m0 + drow) * lda + dchunk * 8;
      bg = Bt + (size_t)(n0 + drow) * K + dchunk * 8;
    }
    f32x4 acc[8][4];
#pragma unroll
    for (int i = 0; i < 8; ++i)
#pragma unroll
      for (int j = 0; j < 4; ++j) acc[i][j] = (f32x4){0.f, 0.f, 0.f, 0.f};
#define G_ISSUE(KT, ST)                                                                                  \
  {                                                                                                      \
    const u16* a2 = ag + (KT)*64;                                                                        \
    const u16* b2 = bg + (KT)*64;                                                                        \
    char* la = smem + (ST)*65536 + wave * 1024;                                                          \
    _Pragma("unroll") for (int j = 0; j < 4; ++j) {                                                      \
      __builtin_amdgcn_global_load_lds((const unsigned*)(a2 + j * lda64), (unsigned*)(la + j * 8192), 16, 0, 0);          \
      __builtin_amdgcn_global_load_lds((const unsigned*)(b2 + j * ldb64), (unsigned*)(la + 32768 + j * 8192), 16, 0, 0);  \
    }                                                                                                    \
  }
    if (!primed) G_ISSUE(0, 0)
#define LDA(i, ks) (*(const bf16x8*)(As + (wm * 128 + (i) * 16 + fr) * 64 + ((((ks) * 4 + fq) ^ sw) * 8)))
#define LDB(j, ks) (*(const bf16x8*)(Bs + (wn * 64 + (j) * 16 + fr) * 64 + ((((ks) * 4 + fq) ^ sw) * 8)))
#define SB __builtin_amdgcn_sched_barrier(0)
#define MFMA_H(R, X0, Y0) acc[R][0] = __builtin_amdgcn_mfma_f32_16x16x32_bf16(Y0, X0, acc[R][0], 0, 0, 0);
#define MFMA_T(R, X0, X1, Y0, Y1, Y2, Y3)                                                  \
  acc[R][1] = __builtin_amdgcn_mfma_f32_16x16x32_bf16(Y1, X0, acc[R][1], 0, 0, 0);         \
  acc[R][2] = __builtin_amdgcn_mfma_f32_16x16x32_bf16(Y2, X0, acc[R][2], 0, 0, 0);         \
  acc[R][3] = __builtin_amdgcn_mfma_f32_16x16x32_bf16(Y3, X0, acc[R][3], 0, 0, 0);         \
  acc[R + 1][0] = __builtin_amdgcn_mfma_f32_16x16x32_bf16(Y0, X1, acc[R + 1][0], 0, 0, 0); \
  acc[R + 1][1] = __builtin_amdgcn_mfma_f32_16x16x32_bf16(Y1, X1, acc[R + 1][1], 0, 0, 0); \
  acc[R + 1][2] = __builtin_amdgcn_mfma_f32_16x16x32_bf16(Y2, X1, acc[R + 1][2], 0, 0, 0); \
  acc[R + 1][3] = __builtin_amdgcn_mfma_f32_16x16x32_bf16(Y3, X1, acc[R + 1][3], 0, 0, 0);
#define G_KLOOP(STAG)                                                                                              \
  {                                                                                                                \
    const bf16x8 zf = {0, 0, 0, 0, 0, 0, 0, 0};                                                                    \
    bf16x8 c0 = zf, c1 = zf, c2 = zf, c3 = zf, h0 = zf, h1 = zf;                                                   \
    for (int kt = 0; kt < nk; ++kt) {                                                                              \
      asm volatile("s_waitcnt vmcnt(0)" ::: "memory");                                                             \
      __syncthreads();                                                                                             \
      if (STAG && kt > 0) { SB; MFMA_H(6, h0, c0) MFMA_T(6, h0, h1, c0, c1, c2, c3) SB; }                          \
      if (kt + 1 < nk) G_ISSUE(kt + 1, (kt + 1) & 1)                                                               \
      const u16* As = (const u16*)(smem + (kt & 1) * 65536);                                                       \
      const u16* Bs = As + 16384;                                                                                  \
      bf16x8 b0 = LDB(0, 0), b1 = LDB(1, 0), b2 = LDB(2, 0), b3 = LDB(3, 0);                                       \
      bf16x8 a0 = LDA(0, 0), a1 = LDA(1, 0);                                                                       \
      bf16x8 n0, n1;                                                                                               \
      SB; MFMA_H(0, a0, b0) SB; n0 = LDA(2, 0); n1 = LDA(3, 0); SB; MFMA_T(0, a0, a1, b0, b1, b2, b3) SB;          \
      MFMA_H(2, n0, b0) SB; a0 = LDA(4, 0); a1 = LDA(5, 0); SB; MFMA_T(2, n0, n1, b0, b1, b2, b3) SB;              \
      MFMA_H(4, a0, b0) SB; n0 = LDA(6, 0); n1 = LDA(7, 0); SB; MFMA_T(4, a0, a1, b0, b1, b2, b3) SB;              \
      MFMA_H(6, n0, b0) SB;                                                                                        \
      c0 = LDB(0, 1); c1 = LDB(1, 1); c2 = LDB(2, 1); c3 = LDB(3, 1); a0 = LDA(0, 1); a1 = LDA(1, 1);              \
      SB; MFMA_T(6, n0, n1, b0, b1, b2, b3) SB;                                                                    \
      MFMA_H(0, a0, c0) SB; n0 = LDA(2, 1); n1 = LDA(3, 1); SB; MFMA_T(0, a0, a1, c0, c1, c2, c3) SB;              \
      MFMA_H(2, n0, c0) SB; a0 = LDA(4, 1); a1 = LDA(5, 1); SB; MFMA_T(2, n0, n1, c0, c1, c2, c3) SB;              \
      if (STAG) {                                                                                                  \
        MFMA_H(4, a0, c0) SB; h0 = LDA(6, 1); h1 = LDA(7, 1); SB; MFMA_T(4, a0, a1, c0, c1, c2, c3) SB;            \
      } else {                                                                                                     \
        MFMA_H(4, a0, c0) SB; n0 = LDA(6, 1); n1 = LDA(7, 1); SB; MFMA_T(4, a0, a1, c0, c1, c2, c3) SB;            \
        MFMA_H(6, n0, c0) MFMA_T(6, n0, n1, c0, c1, c2, c3) SB;                                                    \
      }                                                                                                            \
    }                                                                                                              \
    if (STAG) { SB; MFMA_H(6, h0, c0) MFMA_T(6, h0, h1, c0, c1, c2, c3) SB; }                                      \
  }
    if (__builtin_amdgcn_readfirstlane(wave >> 2) != 0) G_KLOOP(true)
    else G_KLOOP(false)
#undef G_KLOOP
#undef LDA
#undef LDB
#undef SB
#undef MFMA_H
#undef MFMA_T
    const int cm0 = m0, cn0 = n0;
    primed = false;
    if (it + (int)gridDim.x < tiles) {
      G_COORDS(it + (int)gridDim.x, m0, n0)
      ag = A + (size_t)(m0 + drow) * lda + dchunk * 8;
      bg = Bt + (size_t)(n0 + drow) * K + dchunk * 8;
      G_ISSUE(0, 0)
      primed = true;
    }
    u16* Cs = (u16*)(smem + 65536);
#pragma unroll 1
    for (int hp = 0; hp < 2; ++hp) {
      asm volatile("s_waitcnt lgkmcnt(0)" ::: "memory");
      __builtin_amdgcn_s_barrier();
      asm volatile("" ::: "memory");
      if (wm == hp) {
#pragma unroll
        for (int i = 0; i < 8; ++i)
#pragma unroll
          for (int j = 0; j < 4; ++j) {
            float v0 = acc[i][j][0], v1 = acc[i][j][1], v2 = acc[i][j][2], v3 = acc[i][j][3];
            if (EPI == 1) {
              v0 = fmaxf(v0, 0.f); v1 = fmaxf(v1, 0.f); v2 = fmaxf(v2, 0.f); v3 = fmaxf(v3, 0.f);
              v0 *= v0; v1 *= v1; v2 *= v2; v3 *= v3;
            }
            *(uint2*)(Cs + (i * 16 + fr) * 264 + wn * 64 + j * 16 + fq * 4) = make_uint2(pack2(v0, v1), pack2(v2, v3));
          }
      }
      asm volatile("s_waitcnt lgkmcnt(0)" ::: "memory");
      __builtin_amdgcn_s_barrier();
      asm volatile("" ::: "memory");
#pragma unroll 2
      for (int q = 0; q < 8; ++q) {
        const int chunk = tid + q * 512;
        const int row = chunk >> 5, cc = chunk & 31;
        uint4 cv = *(const uint4*)(Cs + row * 264 + cc * 8);
        const int grow = cm0 + hp * 128 + row;
        u16* dst = C + (size_t)grow * ldc + cn0 + cc * 8;
        if (EPI == 2) {
          float a[8], xo[8], y[8];
          unpack8(cv, a);
          unpack8(*(const uint4*)dst, xo);
          const float* gr = gate + (size_t)modrow(grow) * 6144 + cn0 + cc * 8;
          float4 g0 = *(const float4*)gr, g1 = *(const float4*)(gr + 4);
          float gg[8] = {g0.x, g0.y, g0.z, g0.w, g1.x, g1.y, g1.z, g1.w};
#pragma unroll
          for (int j = 0; j < 8; ++j) y[j] = ALPHA * xo[j] + gg[j] * a[j];
          cv = pack8(y);
        }
        *(uint4*)dst = cv;
      }
    }
    asm volatile("s_waitcnt lgkmcnt(0)" ::: "memory");
    __builtin_amdgcn_s_barrier();
    asm volatile("" ::: "memory");
  }
#undef G_ISSUE
#undef G_COORDS
}

template <bool FINAL>
DEV void ln_phase(const Params& p, int M, const float* __restrict__ g, const float* __restrict__ b,
                         const float* __restrict__ modl  , int shi, int sci) {
  u16* X = (u16*)(p.ws + OFF_X);
  u16* HM = (u16*)(p.ws + OFF_HY);
  const int lane = VTID & 63;
  const int gw = VBID * 4 + (VTID >> 6), nw = VNB * 4;
  uint4 nx0 = make_uint4(0u, 0u, 0u, 0u), nx1 = nx0;
  if (gw < M) {
    nx0 = *(const uint4*)(X + (size_t)gw * 1024 + lane * 8);
    nx1 = *(const uint4*)(X + (size_t)gw * 1024 + 512 + lane * 8);
  }
  for (int row = gw; row < M; row += nw) {
    u16* xr = X + (size_t)row * 1024;
    float f[16];
    unpack8(nx0, f);
    unpack8(nx1, f + 8);
    if (row + nw < M) {
      nx0 = *(const uint4*)(xr + (size_t)nw * 1024 + lane * 8);
      nx1 = *(const uint4*)(xr + (size_t)nw * 1024 + 512 + lane * 8);
    }
    float s = 0.f, q = 0.f;
#pragma unroll
    for (int j = 0; j < 16; ++j) { s += f[j]; q += f[j] * f[j]; }
#pragma unroll
    for (int o = 32; o > 0; o >>= 1) { s += __shfl_xor(s, o, 64); q += __shfl_xor(q, o, 64); }
    const float mu = s * (1.f / 1024.f);
    const float rs = rsqrtf(fmaxf(q * (1.f / 1024.f) - mu * mu, 0.f) + 1e-5f);
#pragma unroll
    for (int j = 0; j < 16; ++j) f[j] -= mu;
#pragma unroll
    for (int hh = 0; hh < 2; ++hh) {
      const int c0 = hh * 512 + lane * 8;
      float y[8];
#pragma unroll
      for (int j = 0; j < 8; ++j) y[j] = f[hh * 8 + j] * rs * g[c0 + j] + b[c0 + j];
      if (FINAL) {
        float* o = p.out + (size_t)row * 1024 + c0;
        *(float4*)o = make_float4(y[0], y[1], y[2], y[3]);
        *(float4*)(o + 4) = make_float4(y[4], y[5], y[6], y[7]);
      } else {
        *(uint4*)(xr + c0) = pack8(y);
        const float* m = modl + (size_t)modrow(row) * 6144;
        float h[8];
#pragma unroll
        for (int j = 0; j < 8; ++j) h[j] = y[j] * (1.f + m[sci * 1024 + c0 + j]) + m[shi * 1024 + c0 + j];
        *(uint4*)(HM + (size_t)row * 1024 + c0) = pack8(h);
      }
    }
  }
}

DEV void hyprep_item(const Params& p, int it, char* smem) {
  u16* su = (u16*)smem;
  u16* sx = su + 64 * 66;
  const u16* P = (const u16*)(p.ws + OFF_BIG);
  const int tid = VTID;
  const int ct = it & 7, st = it >> 3;
  int b, t0, L, rowbase;
  u16 *U, *X0;
  if (st < 1024) { b = st >> 5; t0 = (st & 31) * 64; L = 2048; rowbase = b * 2048;
    U = (u16*)((char*)p.out + SO_U); X0 = (u16*)((char*)p.out + SO_X0); }
  else { int s2 = st - 1024; b = s2 >> 2; t0 = (s2 & 3) * 64; L = 256; rowbase = NLAT + b * 256;
    U = (u16*)((char*)p.out + SO_UC); X0 = (u16*)((char*)p.out + SO_X0C); }
  const int c0 = ct * 64;
  {
    const int t = tid >> 2, cq = tid & 3;
    float z[3][16];
#pragma unroll
    for (int g = 0; g < 3; ++g)
#pragma unroll
      for (int j = 0; j < 16; ++j) z[g][j] = 0.f;
#pragma unroll
    for (int tap = 0; tap < 3; ++tap) {
      const int tt = t0 + t + tap - 1;
      if (tt >= 0 && tt < L) {
#pragma unroll
        for (int g = 0; g < 3; ++g) {
          const int col = g * 512 + c0 + cq * 16;
          const u16* src = P + (size_t)(rowbase + tt) * PS0 + col;
          float f[16];
          unpack8(*(const uint4*)src, f);
          unpack8(*(const uint4*)(src + 8), f + 8);
          const float* w = p.hy_conv + tap * 1536 + col;
#pragma unroll
          for (int j = 0; j < 16; ++j) z[g][j] += f[j] * w[j];
        }
      }
    }
#pragma unroll
    for (int j = 0; j < 16; ++j) {
      su[t * 66 + cq * 16 + j] = f2bf(z[1][j] * z[2][j]);
      sx[t * 66 + cq * 16 + j] = f2bf(z[0][j]);
    }
  }
  HSYNC();
  {
    const int c = tid >> 2, tq = tid & 3;
    unsigned wu[8], wx[8];
#pragma unroll
    for (int j = 0; j < 8; ++j) {
      wu[j] = (unsigned)su[(tq * 16 + 2 * j) * 66 + c] | ((unsigned)su[(tq * 16 + 2 * j + 1) * 66 + c] << 16);
      wx[j] = (unsigned)sx[(tq * 16 + 2 * j) * 66 + c] | ((unsigned)sx[(tq * 16 + 2 * j + 1) * 66 + c] << 16);
    }
    const size_t o = ((size_t)(c0 + c) * 32 + b) * L + t0 + tq * 16;
    *(uint4*)(U + o) = make_uint4(wu[0], wu[1], wu[2], wu[3]);
    *(uint4*)(U + o + 8) = make_uint4(wu[4], wu[5], wu[6], wu[7]);
    *(uint4*)(X0 + o) = make_uint4(wx[0], wx[1], wx[2], wx[3]);
    *(uint4*)(X0 + o + 8) = make_uint4(wx[4], wx[5], wx[6], wx[7]);
  }
  HSYNC();
}

DEV void rope_item(const Params& p, int it) {
  u16* P = (u16*)(p.ws + OFF_BIG);
  const float2* tab = (const float2*)(p.ws + OFF_ROPE);
  const int task = it * 256 + VTID;
  const int row = task / 40, rem = task - row * 40;
  const int head = rem >> 2, pr = rem & 3;
  const int d0 = (pr >> 1) * 32 + (pr & 1) * 8;
  const int t = row & 2047;
  const int posc = (pr >> 1) ? (t & 63) : (t >> 6);
  const int fi0 = (pr & 1) * 8;
  u16* ptr = P + (size_t)row * PS0 + 1536 + head * 64 + d0;
  float u1[8], u2[8], o1[8], o2[8];
  unpack8(*(const uint4*)ptr, u1);
  unpack8(*(const uint4*)(ptr + 16), u2);
#pragma unroll
  for (int j = 0; j < 8; ++j) {
    float2 cs = tab[posc * 16 + fi0 + j];
    o1[j] = u1[j] * cs.x - u2[j] * cs.y;
    o2[j] = u1[j] * cs.y + u2[j] * cs.x;
  }
  *(uint4*)ptr = pack8(o1);
  *(uint4*)(ptr + 16) = pack8(o2);
}

DEV void phase_hyprep_rope(const Params& p, char* smem) {
  constexpr int NH = 9216, NR = 10240;
  for (int it = VBID; it < NH + NR; it += VNB) {
    if (it < NH) hyprep_item(p, it, smem);
    else rope_item(p, it - NH);
  }
}

template <int L, int NT>
DEV void conv_item(const Params& p, int c, int th, char* smem) {
  const u16* R = (const u16*)(p.ws + (L == 2048 ? OFF_KR2048 : OFF_KR256)) + (size_t)c * 2 * L;
  const u16* U = (const u16*)((const char*)p.out + (L == 2048 ? SO_U : SO_UC));
  const u16* X0 = (const u16*)((const char*)p.out + (L == 2048 ? SO_X0 : SO_X0C));
  u16* Y = (u16*)(p.ws + OFF_HY);
  u16* Rs0 = (u16*)smem;
  u16* Rs1 = Rs0 + 2 * L + 8;
  const int tid = VTID, lane = tid & 63, wave = tid >> 6;
  for (int i = tid; i < (2 * L) / 8; i += 256) *(uint4*)(Rs0 + i * 8) = *(const uint4*)(R + i * 8);
  HSYNC();
  for (int i = tid; i < 2 * L; i += 256) Rs1[i] = (i + 1 < 2 * L) ? Rs0[i + 1] : (u16)0;
  HSYNC();
  const int r = lane & 31, h = lane >> 5;
  const char* lanebase = (r & 1) ? (const char*)Rs1 + 2 * (8 * h - r + L - 1) : (const char*)Rs0 + 2 * (8 * h - r + L);
  const int tw0 = th * 1024 + wave * NT * 32;
  f32x16 acc[NT];
#pragma unroll
  for (int i = 0; i < NT; ++i)
#pragma unroll
    for (int e = 0; e < 16; ++e) acc[i][e] = 0.f;
  u16* UC = Rs1 + 2 * L + 8;
  const u16* Ug = U + (size_t)c * 32 * L;
  const u16* ug0 = Ug + (size_t)(tid >> 5) * L + (tid & 31) * 8;
  u16* uc0 = UC + (tid >> 5) * 264 + (tid & 31) * 8;
  uint4 stg0 = *(const uint4*)(ug0), stg1 = *(const uint4*)(ug0 + (size_t)8 * L);
  uint4 stg2 = *(const uint4*)(ug0 + (size_t)16 * L), stg3 = *(const uint4*)(ug0 + (size_t)24 * L);
  for (int chk = 0; chk < L / 256; ++chk) {
    HSYNC();
    *(uint4*)(uc0) = stg0; *(uint4*)(uc0 + 8 * 264) = stg1; *(uint4*)(uc0 + 16 * 264) = stg2; *(uint4*)(uc0 + 24 * 264) = stg3;
    HSYNC();
    if (chk + 1 < L / 256) {
      const u16* un = ug0 + (chk + 1) * 256;
      stg0 = *(const uint4*)(un); stg1 = *(const uint4*)(un + (size_t)8 * L);
      stg2 = *(const uint4*)(un + (size_t)16 * L); stg3 = *(const uint4*)(un + (size_t)24 * L);
    }
#pragma unroll 4
    for (int s2 = 0; s2 < 16; ++s2) {
      const int st = chk * 16 + s2;
      bf16x8 bfrag = *(const bf16x8*)(UC + r * 264 + s2 * 16 + 8 * h);
#pragma unroll
      for (int i = 0; i < NT; ++i) {
        const unsigned* ap = (const unsigned*)(lanebase + 2 * (st * 16 - (tw0 + i * 32)));
        uint4 av = make_uint4(ap[0], ap[1], ap[2], ap[3]);
        acc[i] = __builtin_amdgcn_mfma_f32_32x32x16_bf16(*(bf16x8*)&av, bfrag, acc[i], 0, 0, 0);
      }
    }
  }
  const int rowbase = (L == 2048) ? r * 2048 : NLAT + r * 256;
#pragma unroll
  for (int i = 0; i < NT; ++i) {
#pragma unroll
    for (int g4 = 0; g4 < 4; ++g4) {
      const int tt = tw0 + i * 32 + 8 * g4 + 4 * h;
      uint2 xv = *(const uint2*)(X0 + ((size_t)c * 32 + r) * L + tt);
      float x0[4] = {bflo(xv.x), bfhi(xv.x), bflo(xv.y), bfhi(xv.y)};
#pragma unroll
      for (int e = 0; e < 4; ++e) Y[(size_t)(rowbase + tt + e) * 1024 + c] = f2bf(acc[i][g4 * 4 + e] * x0[e]);
    }
  }
  HSYNC();
}

DEV void attn_item(const Params& p, int b, int hq, int qb, bool isctx, char* smem) {
  const u16* P = (const u16*)(p.ws + OFF_BIG);
  u16* Y = (u16*)(p.ws + OFF_HY);
  u16* Ks = (u16*)smem;
  u16* Vt = Ks + 64 * 72;
  const int tid = VTID, lane = tid & 63, wave = tid >> 6;
  const int nq = lane & 15, quad = lane >> 4;
  const int qrow = (isctx ? NLAT + b * 256 : b * 2048) + qb * 64 + wave * 16 + nq;
  const int qpos = qb * 64 + wave * 16 + nq;
  const int hkv = hq >> 2;
  const int kcol = 2048 + hkv * 64, vcol = 2176 + hkv * 64;
  bf16x8 qf[2];
#pragma unroll
  for (int ks = 0; ks < 2; ++ks)
    qf[ks] = *(const bf16x8*)(P + (size_t)qrow * PS0 + 1536 + hq * 64 + ks * 32 + quad * 8);
  float m = p.attn_sink[hq];
  float lsum = (quad == 0) ? 1.f : 0.f;
  f32x4 oacc[4];
#pragma unroll
  for (int n = 0; n < 4; ++n) oacc[n] = (f32x4){0.f, 0.f, 0.f, 0.f};
  const int lo = isctx ? 0 : (qb < 2 ? 2 - qb : 0);
  const int hi = isctx ? 0 : (34 - qb < 5 ? 34 - qb : 5);
  const int nl = hi - lo, ntile = nl + 4;
  const int skey = tid >> 2, spart = tid & 3;
  uint4 k0v, k1v, v0v, v1v;
  {
    const int kr = (nl > 0) ? b * 2048 + qb * 64 - 128 + lo * 64 : NLAT + b * 256;
    const u16* kp = P + (size_t)(kr + skey) * PS0 + kcol + spart * 16;
    const u16* vp = P + (size_t)(kr + skey) * PS0 + vcol + spart * 16;
    k0v = *(const uint4*)kp; k1v = *(const uint4*)(kp + 8);
    v0v = *(const uint4*)vp; v1v = *(const uint4*)(vp + 8);
  }
  for (int si = 0; si < ntile; ++si) {
    int k0 = 0;
    const bool masked = si < nl;
    if (masked) k0 = qb * 64 - 128 + (lo + si) * 64;
    HSYNC();
    {
      const int key = skey, part = spart;
      *(uint4*)(Ks + key * 72 + part * 16) = k0v;
      *(uint4*)(Ks + key * 72 + part * 16 + 8) = k1v;
      unsigned vw[8] = {v0v.x, v0v.y, v0v.z, v0v.w, v1v.x, v1v.y, v1v.z, v1v.w};
#pragma unroll
      for (int j = 0; j < 8; ++j) {
        Vt[(part * 16 + 2 * j) * 72 + key] = (u16)(vw[j] & 0xffffu);
        Vt[(part * 16 + 2 * j + 1) * 72 + key] = (u16)(vw[j] >> 16);
      }
    }
    HSYNC();
    if (si + 1 < ntile) {
      const int sn = si + 1;
      const int kr = (sn < nl) ? b * 2048 + qb * 64 - 128 + (lo + sn) * 64 : NLAT + b * 256 + (sn - nl) * 64;
      const u16* kp = P + (size_t)(kr + skey) * PS0 + kcol + spart * 16;
      const u16* vp = P + (size_t)(kr + skey) * PS0 + vcol + spart * 16;
      k0v = *(const uint4*)kp; k1v = *(const uint4*)(kp + 8);
      v0v = *(const uint4*)vp; v1v = *(const uint4*)(vp + 8);
    }
    f32x4 s[4];
#pragma unroll
    for (int n = 0; n < 4; ++n) {
      s[n] = (f32x4){0.f, 0.f, 0.f, 0.f};
#pragma unroll
      for (int ks = 0; ks < 2; ++ks) {
        bf16x8 kf = *(const bf16x8*)(Ks + (n * 16 + nq) * 72 + ks * 32 + quad * 8);
        s[n] = __builtin_amdgcn_mfma_f32_16x16x32_bf16(kf, qf[ks], s[n], 0, 0, 0);
      }
    }
    float mx = -1e30f;
#pragma unroll
    for (int n = 0; n < 4; ++n)
#pragma unroll
      for (int e = 0; e < 4; ++e) {
        float v = s[n][e] * 0.125f;
        if (masked) {
          int kpos = k0 + n * 16 + quad * 4 + e;
          int d = qpos - kpos;
          if (d > 128 || d < -128) v = -1e30f;
        }
        s[n][e] = v;
        mx = fmaxf(mx, v);
      }
    mx = fmaxf(mx, __shfl_xor(mx, 16, 64));
    mx = fmaxf(mx, __shfl_xor(mx, 32, 64));
    const float mn = fmaxf(m, mx);
    const float al = __expf(m - mn);
    m = mn;
    float ps = 0.f;
#pragma unroll
    for (int n = 0; n < 4; ++n)
#pragma unroll
      for (int e = 0; e < 4; ++e) { float pv = __expf(s[n][e] - mn); s[n][e] = pv; ps += pv; }
    lsum = lsum * al + ps;
#pragma unroll
    for (int n = 0; n < 4; ++n)
#pragma unroll
      for (int e = 0; e < 4; ++e) oacc[n][e] *= al;
#pragma unroll
    for (int hh = 0; hh < 2; ++hh) {
      uint4 pw;
      pw.x = pack2(s[2 * hh][0], s[2 * hh][1]); pw.y = pack2(s[2 * hh][2], s[2 * hh][3]);
      pw.z = pack2(s[2 * hh + 1][0], s[2 * hh + 1][1]); pw.w = pack2(s[2 * hh + 1][2], s[2 * hh + 1][3]);
      bf16x8 pb = *(bf16x8*)&pw;
#pragma unroll
      for (int n = 0; n < 4; ++n) {
        const u16* vr = Vt + (n * 16 + nq) * 72 + quad * 4;
        uint2 va = *(const uint2*)(vr + (2 * hh) * 16);
        uint2 vb = *(const uint2*)(vr + (2 * hh + 1) * 16);
        uint4 vv = make_uint4(va.x, va.y, vb.x, vb.y);
        oacc[n] = __builtin_amdgcn_mfma_f32_16x16x32_bf16(*(bf16x8*)&vv, pb, oacc[n], 0, 0, 0);
      }
    }
  }
  lsum += __shfl_xor(lsum, 16, 64);
  lsum += __shfl_xor(lsum, 32, 64);
  const float inv = 1.f / lsum;
  u16* yo = Y + (size_t)qrow * 1024 + 512 + hq * 64 + quad * 4;
#pragma unroll
  for (int n = 0; n < 4; ++n) {
    uint2 w;
    w.x = pack2(oacc[n][0] * inv, oacc[n][1] * inv);
    w.y = pack2(oacc[n][2] * inv, oacc[n][3] * inv);
    *(uint2*)(yo + n * 16) = w;
  }
  HSYNC();
}

#define PH4_CONV                                                                                     \
  {                                                                                                  \
    _Pragma("unroll 1") for (int it = VBID; it < N0; it += VNB) conv_item<2048, 8>(p, it >> 1, it & 1, smem); \
    __builtin_amdgcn_sched_barrier(0);                                                               \
    _Pragma("unroll 1") for (int it = VBID; it < N1; it += VNB) {                                    \
      if (it < N0) continue;                                                                         \
      conv_item<256, 2>(p, it - N0, 0, smem);                                                        \
    }                                                                                                \
    __builtin_amdgcn_sched_barrier(0);                                                               \
  }
#define PH4_ATTN                                                                                     \
  {                                                                                                  \
    _Pragma("unroll 1") for (int it = VBID; it < N3; it += VNB) {                                    \
      if (it < N1) continue;                                                                         \
      if (it < N2) { int a = it - N1; attn_item(p, a >> 8, (a >> 5) & 7, a & 31, false, smem); }     \
      else { int a = it - N2; attn_item(p, a >> 5, (a >> 2) & 7, a & 3, true, smem); }               \
    }                                                                                                \
    __builtin_amdgcn_sched_barrier(0);                                                               \
  }
DEV void phase_conv_attn(const Params& p, char* smem) {
  constexpr int N0 = 1024, N1 = N0 + 512, N2 = N1 + 8192, N3 = N2 + 1024;
  if (VHALF == 0) { PH4_CONV PH4_ATTN }
  else { PH4_ATTN PH4_CONV }
}
#undef PH4_CONV
#undef PH4_ATTN

DEV void lds_wave_sync() {
  asm volatile("s_waitcnt lgkmcnt(0)" ::: "memory");
  __builtin_amdgcn_wave_barrier();
}

#define SCAN_SYNC() do { if (HW) __syncthreads(); else hsync(); } while (0)
template <bool HW>
DEV void rwkv_item(const Params& p, int ri, char* smem) {
  const u16* P = (const u16*)(p.ws + OFF_BIG);
  u16* O4 = (u16*)p.out;
  float* BS = (float*)(p.ws + OFF_BSUM);
  const int tid0 = VTID;
  const int wp0 = tid0 >> 7;
  const int cid = ri * 2 + wp0;
  const int b = cid >> 4, d = (cid >> 3) & 1, h = cid & 7;
  f32x4 S[4][2];
#pragma unroll
  for (int i = 0; i < 4; ++i)
#pragma unroll
    for (int j = 0; j < 2; ++j) S[i][j] = (f32x4){0.f, 0.f, 0.f, 0.f};
  uint4 bw[2][4];
  float l0[4];
  {
    const int lane = tid0 & 63, wi = (tid0 >> 6) & 1, fr = lane & 15, fq = lane >> 4;
    const float* wsrc = (wi == 0 ? p.rw_w2 : p.rw_a2) + (size_t)d * 64 * 512 + h * 64;
    const float* bsrc = (wi == 0 ? p.rw_w0 : p.rw_a0) + d * 512 + h * 64;
#pragma unroll
    for (int nt = 0; nt < 4; ++nt) {
      l0[nt] = bsrc[nt * 16 + fr];
#pragma unroll
      for (int ks = 0; ks < 2; ++ks) {
        __builtin_amdgcn_sched_barrier(0);
        float f[8];
        const float* wp_ = wsrc + (size_t)(ks * 32 + fq * 8) * 512 + nt * 16 + fr;
#pragma unroll
        for (int j = 0; j < 8; ++j) f[j] = wp_[j * 512];
        bw[ks][nt] = pack8(f);
      }
    }
  }
  uint4 pre[5][3];
#define RW_LOAD(CI)                                                                                 \
  {                                                                                                 \
    const int seg_ = (CI) < 16 ? 0 : 1;                                                             \
    const int ch_ = seg_ ? (CI)-16 : (CI);                                                          \
    const int Ls_ = seg_ ? 2048 : 256;                                                              \
    const int rb_ = seg_ ? b * 2048 : NLAT + b * 256;                                               \
    const int sidx_ = ch_ * 16 + stt;                                                               \
    const int t_ = d == 0 ? sidx_ : Ls_ - 1 - sidx_;                                                \
    const u16* prow_ = P + (size_t)(rb_ + t_) * PS1 + spart * 8;                                    \
    _Pragma("unroll") for (int g = 0; g < 5; ++g) {                                                 \
      const int col_ = g < 3 ? g * 512 + h * 64 : (g == 3 ? 1536 + d * 64 : 1664 + d * 64);         \
      _Pragma("unroll") for (int tap = 0; tap < 3; ++tap) {                                         \
        const int tt_ = t_ + tap - 1;                                                               \
        if (tt_ >= 0 && tt_ < Ls_) pre[g][tap] = *(const uint4*)(prow_ + (ptrdiff_t)(tap - 1) * PS1 + col_); \
        else pre[g][tap] = make_uint4(0u, 0u, 0u, 0u);                                              \
      }                                                                                             \
    }                                                                                               \
  }
  {
    const int pt = tid0 & 127, stt = pt >> 3, spart = pt & 7;
    RW_LOAD(0)
  }
  for (int cidx = 0; cidx < 144; ++cidx) {
    asm volatile("" ::: "memory");
    int tid = tid0;
    asm volatile("" : "+v"(tid));
    const int lane = tid & 63, wave = tid >> 6, wp = wave >> 1, wi = wave & 1, pt = tid & 127;
    const int fr = lane & 15, fq = lane >> 4, stt = pt >> 3, spart = pt & 7;
    const int seg = cidx < 16 ? 0 : 1;
    const int ch = seg ? cidx - 16 : cidx;
    const int Ls = seg ? 2048 : 256;
    char* base = smem + wp * 32768;
    u16* RK = (u16*)base;
    u16* KD = RK + 1152;
    u16* KK = KD + 1152;
    u16* AB = KK + 1152;
    u16* VT = AB + 1152;
    float* LW = (float*)(base + 11264);
    u16* TW = (u16*)(base + 15360);
    u16* AD = TW + 1152;
    u16* BgCT = (u16*)(base + 19968);
    u16* KgCT = BgCT + 1024;
    float* gC = (float*)(base + 24064);
    float* Amat = (float*)(base + 24320) + wi * 256;
    u16* Tinv = (u16*)(base + 26368) + wi * 256;
    u16* BG = (u16*)(base + 27392);
    {
      const int o = stt * 72 + spart * 8;
#pragma unroll
      for (int g = 0; g < 5; ++g) {
        __builtin_amdgcn_sched_barrier(0);
        const int col = g < 3 ? g * 512 + h * 64 : (g == 3 ? 1536 + d * 64 : 1664 + d * 64);
        float pc[8], pp[8], pn[8], v[8];
        unpack8(pre[g][1], pc); unpack8(pre[g][0], pp); unpack8(pre[g][2], pn);
        const float* mu = p.rw_mu + col + spart * 8;
        float4 m0 = *(const float4*)mu, m1 = *(const float4*)(mu + 4);
        const float mm[8] = {m0.x, m0.y, m0.z, m0.w, m1.x, m1.y, m1.z, m1.w};
#pragma unroll
        for (int j = 0; j < 8; ++j) v[j] = pc[j] + mm[j] * (0.5f * (pp[j] + pn[j]) - pc[j]);
        if (g == 0) *(uint4*)(RK + o) = pack8(v);
        else if (g == 1) {
          *(uint4*)(KD + o) = pack8(v);
          const float* kkw = p.rw_kk + h * 64 + spart * 8;
          float kkv[8];
          float ss = 0.f;
#pragma unroll
          for (int j = 0; j < 8; ++j) { kkv[j] = v[j] * kkw[j]; ss += kkv[j] * kkv[j]; }
          ss += __shfl_xor(ss, 1, 64); ss += __shfl_xor(ss, 2, 64); ss += __shfl_xor(ss, 4, 64);
          const float inv = rsqrtf(ss + 1e-6f);
#pragma unroll
          for (int j = 0; j < 8; ++j) kkv[j] *= inv;
          *(uint4*)(KK + o) = pack8(kkv);
        } else if (g == 2) {
#pragma unroll
          for (int j = 0; j < 8; ++j) VT[(spart * 8 + j) * 16 + stt] = f2bf(v[j]);
        } else if (g == 3) {
#pragma unroll
          for (int j = 0; j < 8; ++j) v[j] = fast_tanh(v[j]);
          *(uint4*)(TW + o) = pack8(v);
        } else *(uint4*)(AD + o) = pack8(v);
      }
    }
    SCAN_SYNC();
    if (cidx + 1 < 144) RW_LOAD(cidx + 1)
    {
      const u16* IN = wi == 0 ? TW : AD;
      bf16x8 af0 = *(const bf16x8*)(IN + fr * 72 + fq * 8);
      bf16x8 af1 = *(const bf16x8*)(IN + fr * 72 + 32 + fq * 8);
#pragma unroll
      for (int nt = 0; nt < 4; ++nt) {
        f32x4 o4 = (f32x4){0.f, 0.f, 0.f, 0.f};
        o4 = __builtin_amdgcn_mfma_f32_16x16x32_bf16(af0, *(bf16x8*)&bw[0][nt], o4, 0, 0, 0);
        o4 = __builtin_amdgcn_mfma_f32_16x16x32_bf16(af1, *(bf16x8*)&bw[1][nt], o4, 0, 0, 0);
#pragma unroll
        for (int e = 0; e < 4; ++e) {
          const float prev = l0[nt] + o4[e];
          const int t = fq * 4 + e, c = nt * 16 + fr;
          if (wi == 0) LW[t * 64 + c] = -__expf(-softplus(-prev) - 0.5f);
          else AB[t * 72 + c] = f2bf(sigm(prev));
        }
      }
    }
    SCAN_SYNC();
    {
      const int c = lane;
      float cum = 0.f;
      if (wi == 0) {
#pragma unroll 4
        for (int t = 0; t < 16; ++t) {
          const float lw = LW[t * 64 + c];
          const float gp = __expf(cum);
          cum += lw;
          const float gi = __expf(-cum);
          const float kk = bf2f(KK[t * 72 + c]);
          const float a = bf2f(AB[t * 72 + c]);
          KK[t * 72 + c] = f2bf(kk * gp);
          BG[t * 72 + c] = f2bf(kk * a * gi);
        }
        const float gCv = __expf(cum);
        gC[c] = gCv;
#pragma unroll 4
        for (int t = 0; t < 16; ++t) BgCT[c * 16 + t] = f2bf(-bf2f(BG[t * 72 + c]) * gCv);
      } else {
        float* PR = (float*)TW;
        const float kac = p.rw_ka[h * 64 + c], rkc = p.rw_rk[h * 64 + c];
#pragma unroll 4
        for (int t = 0; t < 16; ++t) {
          const float lw = LW[t * 64 + c];
          cum += lw;
          const float g = __expf(cum), gi = __expf(-cum);
          const float r = bf2f(RK[t * 72 + c]);
          const float k = bf2f(KD[t * 72 + c]);
          const float a = bf2f(AB[t * 72 + c]);
          const float kd = k * (1.f + (a - 1.f) * kac);
          RK[t * 72 + c] = f2bf(r * g);
          KD[t * 72 + c] = f2bf(kd * gi);
          PR[t * 64 + c] = r * kd * rkc;
        }
        const float gCv = __expf(cum);
#pragma unroll 4
        for (int t = 0; t < 16; ++t) KgCT[c * 16 + t] = f2bf(bf2f(KD[t * 72 + c]) * gCv);
        lds_wave_sync();
        {
          const int t = lane >> 2, sg = lane & 3;
          const float4 q0 = *(const float4*)(PR + t * 64 + sg * 16), q1 = *(const float4*)(PR + t * 64 + sg * 16 + 4);
          const float4 q2 = *(const float4*)(PR + t * 64 + sg * 16 + 8), q3 = *(const float4*)(PR + t * 64 + sg * 16 + 12);
          float bsum = (q0.x + q0.y + q0.z + q0.w) + (q1.x + q1.y + q1.z + q1.w) + (q2.x + q2.y + q2.z + q2.w) + (q3.x + q3.y + q3.z + q3.w);
          bsum += __shfl_xor(bsum, 1, 64);
          bsum += __shfl_xor(bsum, 2, 64);
          if (seg == 1 && sg == 0) {
            const int sidx = ch * 16 + t;
            const int tpos = d == 0 ? sidx : 2047 - sidx;
            BS[(size_t)(b * 2048 + tpos) * 16 + h * 2 + d] = bsum;
          }
        }
      }
    }
    SCAN_SYNC();
    __builtin_amdgcn_sched_barrier(0);
    {
      f32x4 XabT = (f32x4){0.f, 0.f, 0.f, 0.f}, XakT = XabT, XrbT = XabT, XrkT = XabT;
#pragma unroll
      for (int ks = 0; ks < 2; ++ks) {
        bf16x8 kkf = *(const bf16x8*)(KK + fr * 72 + ks * 32 + fq * 8);
        bf16x8 rgf = *(const bf16x8*)(RK + fr * 72 + ks * 32 + fq * 8);
        bf16x8 bgf = *(const bf16x8*)(BG + fr * 72 + ks * 32 + fq * 8);
        bf16x8 kgf = *(const bf16x8*)(KD + fr * 72 + ks * 32 + fq * 8);
        XabT = __builtin_amdgcn_mfma_f32_16x16x32_bf16(bgf, kkf, XabT, 0, 0, 0);
        XakT = __builtin_amdgcn_mfma_f32_16x16x32_bf16(kgf, kkf, XakT, 0, 0, 0);
        XrbT = __builtin_amdgcn_mfma_f32_16x16x32_bf16(bgf, rgf, XrbT, 0, 0, 0);
        XrkT = __builtin_amdgcn_mfma_f32_16x16x32_bf16(kgf, rgf, XrkT, 0, 0, 0);
      }
      {
        float am[4];
#pragma unroll
        for (int e = 0; e < 4; ++e) am[e] = (fq * 4 + e < fr) ? XabT[e] : 0.f;
        *(float4*)(Amat + fr * 16 + fq * 4) = make_float4(am[0], am[1], am[2], am[3]);
      }
      lds_wave_sync();
      if (lane < 16) {
        float x[16];
        x[0] = (lane == 0) ? 1.f : 0.f;
        float4 cur[4], nxt[4];
        cur[0] = *(const float4*)(Amat + 16);
        cur[1] = cur[0]; cur[2] = cur[0]; cur[3] = cur[0];
#pragma unroll
        for (int i = 1; i < 16; ++i) {
          __builtin_amdgcn_sched_barrier(0);
          if (i + 1 < 16) {
#pragma unroll
            for (int q = 0; q < (i + 4) / 4; ++q) nxt[q] = *(const float4*)(Amat + (i + 1) * 16 + q * 4);
          }
          float acc = (i == lane) ? 1.f : 0.f;
#pragma unroll
          for (int j = 0; j < i; ++j) {
            const float4 rv = cur[j >> 2];
            const float av = (j & 3) == 0 ? rv.x : ((j & 3) == 1 ? rv.y : ((j & 3) == 2 ? rv.z : rv.w));
            acc -= av * x[j];
          }
          x[i] = acc;
#pragma unroll
          for (int q = 0; q < 4; ++q) cur[q] = nxt[q];
        }
#pragma unroll
        for (int i = 0; i < 16; ++i) Tinv[i * 16 + lane] = f2bf(x[i]);
      }
      lds_wave_sync();
      f32x4 sa0[2], y0[2];
#pragma unroll
      for (int nt = 0; nt < 2; ++nt) { sa0[nt] = (f32x4){0.f, 0.f, 0.f, 0.f}; y0[nt] = (f32x4){0.f, 0.f, 0.f, 0.f}; }
#pragma unroll
      for (int x = 0; x < 2; ++x) {
        __builtin_amdgcn_sched_barrier(0);
        uint2 k0 = *(const uint2*)(KK + fr * 72 + 32 * x + fq * 4);
        uint2 k1 = *(const uint2*)(KK + fr * 72 + 32 * x + 16 + fq * 4);
        uint2 r0 = *(const uint2*)(RK + fr * 72 + 32 * x + fq * 4);
        uint2 r1 = *(const uint2*)(RK + fr * 72 + 32 * x + 16 + fq * 4);
        uint4 kw = make_uint4(k0.x, k0.y, k1.x, k1.y);
        uint4 rw = make_uint4(r0.x, r0.y, r1.x, r1.y);
#pragma unroll
        for (int nt = 0; nt < 2; ++nt) {
          uint4 sw;
          sw.x = pack2(S[2 * x][nt][0], S[2 * x][nt][1]); sw.y = pack2(S[2 * x][nt][2], S[2 * x][nt][3]);
          sw.z = pack2(S[2 * x + 1][nt][0], S[2 * x + 1][nt][1]); sw.w = pack2(S[2 * x + 1][nt][2], S[2 * x + 1][nt][3]);
          sa0[nt] = __builtin_amdgcn_mfma_f32_16x16x32_bf16(*(bf16x8*)&kw, *(bf16x8*)&sw, sa0[nt], 0, 0, 0);
          y0[nt] = __builtin_amdgcn_mfma_f32_16x16x32_bf16(*(bf16x8*)&rw, *(bf16x8*)&sw, y0[nt], 0, 0, 0);
        }
      }
      float ak[4], rb[4], rk[4];
#pragma unroll
      for (int e = 0; e < 4; ++e) {
        const int j = fq * 4 + e;
        ak[e] = (j < fr) ? XakT[e] : 0.f;
        rb[e] = (j <= fr) ? -XrbT[e] : 0.f;
        rk[e] = (j <= fr) ? XrkT[e] : 0.f;
      }
      const uint4 akw = make_uint4(pack2(ak[0], ak[1]), pack2(ak[2], ak[3]), 0u, 0u);
      const uint4 ybw = make_uint4(pack2(rb[0], rb[1]), pack2(rb[2], rb[3]), pack2(rk[0], rk[1]), pack2(rk[2], rk[3]));
      const uint2 tv = *(const uint2*)(Tinv + fr * 16 + fq * 4);
      const uint4 tw = make_uint4(tv.x, tv.y, 0u, 0u);
      uint4 sv[2];
#pragma unroll
      for (int nt = 0; nt < 2; ++nt) {
        const int vc = wi * 32 + nt * 16 + fr;
        const uint2 vt = *(const uint2*)(VT + vc * 16 + fq * 4);
        const uint4 vb = make_uint4(vt.x, vt.y, 0u, 0u);
        f32x4 rhs = __builtin_amdgcn_mfma_f32_16x16x32_bf16(*(bf16x8*)&akw, *(bf16x8*)&vb, sa0[nt], 0, 0, 0);
        const uint4 rw = make_uint4(pack2(rhs[0], rhs[1]), pack2(rhs[2], rhs[3]), 0u, 0u);
        f32x4 sa = __builtin_amdgcn_mfma_f32_16x16x32_bf16(*(bf16x8*)&tw, *(bf16x8*)&rw, (f32x4){0.f, 0.f, 0.f, 0.f}, 0, 0, 0);
        sv[nt] = make_uint4(pack2(sa[0], sa[1]), pack2(sa[2], sa[3]), vt.x, vt.y);
        f32x4 y = __builtin_amdgcn_mfma_f32_16x16x32_bf16(*(bf16x8*)&ybw, *(bf16x8*)&sv[nt], y0[nt], 0, 0, 0);
        if (seg == 1) {
#pragma unroll
          for (int e = 0; e < 4; ++e) {
            const int sidx = ch * 16 + fq * 4 + e;
            const int tpos = d == 0 ? sidx : 2047 - sidx;
            O4[((size_t)d * NLAT + b * 2048 + tpos) * 512 + h * 64 + vc] = f2bf(y[e]);
          }
        }
      }
#pragma unroll
      for (int mt = 0; mt < 4; ++mt) {
        __builtin_amdgcn_sched_barrier(0);
        const float4 g4 = *(const float4*)(gC + mt * 16 + fq * 4);
        const uint2 bv = *(const uint2*)(BgCT + (mt * 16 + fr) * 16 + fq * 4);
        const uint2 kv = *(const uint2*)(KgCT + (mt * 16 + fr) * 16 + fq * 4);
        const uint4 aw = make_uint4(bv.x, bv.y, kv.x, kv.y);
#pragma unroll
        for (int nt = 0; nt < 2; ++nt) {
          S[mt][nt][0] *= g4.x; S[mt][nt][1] *= g4.y; S[mt][nt][2] *= g4.z; S[mt][nt][3] *= g4.w;
          S[mt][nt] = __builtin_amdgcn_mfma_f32_16x16x32_bf16(*(bf16x8*)&aw, *(bf16x8*)&sv[nt], S[mt][nt], 0, 0, 0);
        }
      }
    }
    SCAN_SYNC();
  }
#undef RW_LOAD
}

template <bool HW>
DEV void gdn_item(const Params& p, int gi, char* smem) {
  const u16* P = (const u16*)(p.ws + OFF_BIG);
  u16* O4 = (u16*)p.out;
  const int tid0 = VTID;
  const int b = gi >> 3, d = (gi >> 2) & 1, h = gi & 3;
  constexpr int BUFB = 23424;
  f32x4 S[8][2];
#pragma unroll
  for (int i = 0; i < 8; ++i)
#pragma unroll
    for (int j = 0; j < 2; ++j) S[i][j] = (f32x4){0.f, 0.f, 0.f, 0.f};
  const float negA = -__expf(p.dn_A_log[d * 4 + h]);
  const float dtb = p.dn_dt_bias[d * 4 + h];
  uint4 pre[3][3];
  float gpre0 = 0.f, gpre1 = 0.f;
#define GDN_LOAD(CI)                                                                               \
  {                                                                                                \
    const int seg_ = (CI) < 16 ? 0 : 1;                                                            \
    const int ch_ = seg_ ? (CI)-16 : (CI);                                                         \
    const int Ls_ = seg_ ? 2048 : 256;                                                             \
    const int rb_ = seg_ ? b * 2048 : NLAT + b * 256;                                              \
    const int sidx_ = ch_ * 16 + stt;                                                              \
    const int t_ = d == 0 ? sidx_ : Ls_ - 1 - sidx_;                                               \
    const u16* prow_ = P + (size_t)(rb_ + t_) * PS1 + DNO;                                         \
    _Pragma("unroll") for (int g = 0; g < 3; ++g) {                                                \
      const int col_ = g * 512 + h * 128 + spart * 8;                                              \
      _Pragma("unroll") for (int tap = 0; tap < 3; ++tap) {                                        \
        const int tt_ = t_ + tap - 1;                                                              \
        if (tt_ >= 0 && tt_ < Ls_) pre[g][tap] = *(const uint4*)(prow_ + (ptrdiff_t)(tap - 1) * PS1 + col_); \
        else pre[g][tap] = make_uint4(0u, 0u, 0u, 0u);                                             \
      }                                                                                            \
    }                                                                                              \
    if (wave == 0) {                                                                               \
      const int s2_ = ch_ * 16 + fr;                                                               \
      const int t2_ = d == 0 ? s2_ : Ls_ - 1 - s2_;                                                \
      const u16* gr_ = P + (size_t)(rb_ + t2_) * PS1 + DNO + 2048;                                 \
      gpre0 = bf2f(gr_[d * 4 + h]);                                                                \
      gpre1 = bf2f(gr_[8 + d * 4 + h]);                                                            \
    }                                                                                              \
  }
  {
    const int tid = tid0, lane = tid & 63, wave = tid >> 6, fr = lane & 15, stt = tid >> 4, spart = tid & 15;
    GDN_LOAD(0)
  }
  for (int cidx = 0; cidx < 144; ++cidx) {
    asm volatile("" ::: "memory");
    int tid = tid0;
    asm volatile("" : "+v"(tid));
    const int lane = tid & 63, wave = tid >> 6, fr = lane & 15, fq = lane >> 4, stt = tid >> 4, spart = tid & 15;
    char* buf = smem;
    u16* Kb = (u16*)buf;
    u16* Qb = Kb + 16 * 136;
    float* Vf = (float*)(buf + 8704);
    u16* KdT = (u16*)(buf + 17152);
    u16* Tinv = (u16*)(buf + 21248);
    u16* Pm = (u16*)(buf + 21760);
    float* Amat = (float*)(buf + 22272);
    float* Gs = (float*)(buf + 23296);
    float* Bs = Gs + 16;
#pragma unroll
    for (int g = 0; g < 3; ++g) {
      __builtin_amdgcn_sched_barrier(0);
      const int col = g * 512 + h * 128 + spart * 8;
      float z[8];
#pragma unroll
      for (int j = 0; j < 8; ++j) z[j] = 0.f;
#pragma unroll
      for (int tap = 0; tap < 3; ++tap) {
        __builtin_amdgcn_sched_barrier(0);
        float f[8];
        unpack8(pre[g][tap], f);
        const float* w = p.dn_conv + tap * 1536 + col;
        float4 w0 = *(const float4*)w, w1 = *(const float4*)(w + 4);
        z[0] += f[0] * w0.x; z[1] += f[1] * w0.y; z[2] += f[2] * w0.z; z[3] += f[3] * w0.w;
        z[4] += f[4] * w1.x; z[5] += f[5] * w1.y; z[6] += f[6] * w1.z; z[7] += f[7] * w1.w;
      }
      float ss = 0.f;
#pragma unroll
      for (int j = 0; j < 8; ++j) { z[j] = silu(z[j]); ss += z[j] * z[j]; }
      if (g < 2) {
        ss += __shfl_xor(ss, 1, 64); ss += __shfl_xor(ss, 2, 64); ss += __shfl_xor(ss, 4, 64); ss += __shfl_xor(ss, 8, 64);
        float sc = rsqrtf(ss + 1e-6f);
        if (g == 0) sc *= 0.08838834764831845f;
#pragma unroll
        for (int j = 0; j < 8; ++j) z[j] *= sc;
        *(uint4*)((g == 0 ? Qb : Kb) + stt * 136 + spart * 8) = pack8(z);
      } else {
        float* dst = Vf + stt * 132 + spart * 8;
        *(float4*)dst = make_float4(z[0], z[1], z[2], z[3]);
        *(float4*)(dst + 4) = make_float4(z[4], z[5], z[6], z[7]);
      }
    }
    if (wave == 0) {
      float g = negA * softplus(gpre0 + dtb);
#pragma unroll
      for (int o = 1; o < 16; o <<= 1) { float n = __shfl_up(g, o, 16); if (fr >= o) g += n; }
      if (lane < 16) { Gs[lane] = g; Bs[lane] = sigm(gpre1); }
    }
    SCAN_SYNC();
    if (wave == 0) {
      f32x4 kk = (f32x4){0.f, 0.f, 0.f, 0.f};
#pragma unroll
      for (int ks = 0; ks < 4; ++ks) {
        bf16x8 kf = *(const bf16x8*)(Kb + fr * 136 + ks * 32 + fq * 8);
        kk = __builtin_amdgcn_mfma_f32_16x16x32_bf16(kf, kf, kk, 0, 0, 0);
      }
      const float Gj = Gs[fr];
#pragma unroll
      for (int e = 0; e < 4; ++e) {
        const int i = fq * 4 + e;
        const float a = (fr < i) ? Bs[i] * kk[e] * __expf(Gs[i] - Gj) : 0.f;
        Amat[i * 16 + fr] = a;
      }
      lds_wave_sync();
      if (lane < 16) {
        float x[16];
        x[0] = (lane == 0) ? 1.f : 0.f;
        float4 cur[4], nxt[4];
        cur[0] = *(const float4*)(Amat + 16);
        cur[1] = cur[0]; cur[2] = cur[0]; cur[3] = cur[0];
#pragma unroll
        for (int i = 1; i < 16; ++i) {
          __builtin_amdgcn_sched_barrier(0);
          if (i + 1 < 16) {
#pragma unroll
            for (int q = 0; q < (i + 4) / 4; ++q) nxt[q] = *(const float4*)(Amat + (i + 1) * 16 + q * 4);
          }
          float acc = (i == lane) ? 1.f : 0.f;
#pragma unroll
          for (int j = 0; j < i; ++j) {
            const float4 rv = cur[j >> 2];
            const float av = (j & 3) == 0 ? rv.x : ((j & 3) == 1 ? rv.y : ((j & 3) == 2 ? rv.z : rv.w));
            acc -= av * x[j];
          }
          x[i] = acc;
#pragma unroll
          for (int q = 0; q < 4; ++q) cur[q] = nxt[q];
        }
#pragma unroll
        for (int i = 0; i < 16; ++i) Tinv[i * 16 + lane] = f2bf(x[i]);
      }
    } else if (wave == 1) {
      f32x4 qk = (f32x4){0.f, 0.f, 0.f, 0.f};
#pragma unroll
      for (int ks = 0; ks < 4; ++ks) {
        bf16x8 qf = *(const bf16x8*)(Qb + fr * 136 + ks * 32 + fq * 8);
        bf16x8 kf = *(const bf16x8*)(Kb + fr * 136 + ks * 32 + fq * 8);
        qk = __builtin_amdgcn_mfma_f32_16x16x32_bf16(qf, kf, qk, 0, 0, 0);
      }
      const float Gj = Gs[fr];
#pragma unroll
      for (int e = 0; e < 4; ++e) {
        const int t = fq * 4 + e;
        const float v = (fr <= t) ? qk[e] * __expf(Gs[t] - Gj) : 0.f;
        Pm[t * 16 + fr] = f2bf(v);
      }
    } else {
      const int k = tid - 128;
      const float GC = Gs[15];
      unsigned w[8];
#pragma unroll
      for (int j = 0; j < 8; ++j) {
        __builtin_amdgcn_sched_barrier(0);
        float v0 = bf2f(Kb[(2 * j) * 136 + k]) * __expf(GC - Gs[2 * j]);
        float v1 = bf2f(Kb[(2 * j + 1) * 136 + k]) * __expf(GC - Gs[2 * j + 1]);
        w[j] = pack2(v0, v1);
      }
      *(uint4*)(KdT + k * 16) = make_uint4(w[0], w[1], w[2], w[3]);
      *(uint4*)(KdT + k * 16 + 8) = make_uint4(w[4], w[5], w[6], w[7]);
    }
    __builtin_amdgcn_sched_barrier(0);
    f32x4 ksv[2], qsv[2];
#pragma unroll
    for (int nt = 0; nt < 2; ++nt) { ksv[nt] = (f32x4){0.f, 0.f, 0.f, 0.f}; qsv[nt] = (f32x4){0.f, 0.f, 0.f, 0.f}; }
#pragma unroll
    for (int x = 0; x < 4; ++x) {
      __builtin_amdgcn_sched_barrier(0);
      uint2 k0 = *(const uint2*)(Kb + fr * 136 + 32 * x + fq * 4);
      uint2 k1 = *(const uint2*)(Kb + fr * 136 + 32 * x + 16 + fq * 4);
      uint2 q0 = *(const uint2*)(Qb + fr * 136 + 32 * x + fq * 4);
      uint2 q1 = *(const uint2*)(Qb + fr * 136 + 32 * x + 16 + fq * 4);
      uint4 kw = make_uint4(k0.x, k0.y, k1.x, k1.y);
      uint4 qw = make_uint4(q0.x, q0.y, q1.x, q1.y);
#pragma unroll
      for (int nt = 0; nt < 2; ++nt) {
        uint4 sw;
        sw.x = pack2(S[2 * x][nt][0], S[2 * x][nt][1]); sw.y = pack2(S[2 * x][nt][2], S[2 * x][nt][3]);
        sw.z = pack2(S[2 * x + 1][nt][0], S[2 * x + 1][nt][1]); sw.w = pack2(S[2 * x + 1][nt][2], S[2 * x + 1][nt][3]);
        ksv[nt] = __builtin_amdgcn_mfma_f32_16x16x32_bf16(*(bf16x8*)&kw, *(bf16x8*)&sw, ksv[nt], 0, 0, 0);
        qsv[nt] = __builtin_amdgcn_mfma_f32_16x16x32_bf16(*(bf16x8*)&qw, *(bf16x8*)&sw, qsv[nt], 0, 0, 0);
      }
    }
    SCAN_SYNC();
    if (cidx + 1 < 144) GDN_LOAD(cidx + 1)
    __builtin_amdgcn_sched_barrier(0);
    {
      const int seg = cidx < 16 ? 0 : 1;
      const int ch = seg ? cidx - 16 : cidx;
      float eG[4], bt[4];
#pragma unroll
      for (int e = 0; e < 4; ++e) { eG[e] = __expf(Gs[fq * 4 + e]); bt[e] = Bs[fq * 4 + e]; }
      const float eGC = __expf(Gs[15]);
      uint2 tv = *(const uint2*)(Tinv + fr * 16 + fq * 4);
      uint2 pv = *(const uint2*)(Pm + fr * 16 + fq * 4);
      uint4 tw = make_uint4(tv.x, tv.y, 0u, 0u);
      uint4 pw = make_uint4(pv.x, pv.y, 0u, 0u);
      uint4 ub[2];
#pragma unroll
      for (int nt = 0; nt < 2; ++nt) {
        const int vc = wave * 32 + nt * 16 + fr;
        float rhs[4];
#pragma unroll
        for (int e = 0; e < 4; ++e) rhs[e] = bt[e] * (Vf[(fq * 4 + e) * 132 + vc] - eG[e] * ksv[nt][e]);
        uint4 rw = make_uint4(pack2(rhs[0], rhs[1]), pack2(rhs[2], rhs[3]), 0u, 0u);
        f32x4 u = __builtin_amdgcn_mfma_f32_16x16x32_bf16(*(bf16x8*)&tw, *(bf16x8*)&rw, (f32x4){0.f, 0.f, 0.f, 0.f}, 0, 0, 0);
        ub[nt] = make_uint4(pack2(u[0], u[1]), pack2(u[2], u[3]), 0u, 0u);
        f32x4 oa;
#pragma unroll
        for (int e = 0; e < 4; ++e) oa[e] = eG[e] * qsv[nt][e];
        oa = __builtin_amdgcn_mfma_f32_16x16x32_bf16(*(bf16x8*)&pw, *(bf16x8*)&ub[nt], oa, 0, 0, 0);
        if (seg == 1) {
#pragma unroll
          for (int e = 0; e < 4; ++e) {
            const int sidx = ch * 16 + fq * 4 + e;
            const int t = d == 0 ? sidx : 2047 - sidx;
            O4[((size_t)(2 + d) * NLAT + b * 2048 + t) * 512 + h * 128 + vc] = f2bf(oa[e]);
          }
        }
      }
#pragma unroll
      for (int mt = 0; mt < 8; ++mt) {
        __builtin_amdgcn_sched_barrier(0);
        uint2 kv = *(const uint2*)(KdT + (mt * 16 + fr) * 16 + fq * 4);
        uint4 kw = make_uint4(kv.x, kv.y, 0u, 0u);
#pragma unroll
        for (int nt = 0; nt < 2; ++nt) {
#pragma unroll
          for (int e = 0; e < 4; ++e) S[mt][nt][e] *= eGC;
          S[mt][nt] = __builtin_amdgcn_mfma_f32_16x16x32_bf16(*(bf16x8*)&kw, *(bf16x8*)&ub[nt], S[mt][nt], 0, 0, 0);
        }
      }
    }
    SCAN_SYNC();
    if (HW) SCAN_SYNC();
  }
#undef GDN_LOAD
}

#undef SCAN_SYNC
DEV void phase_scans(const Params& p, char* smem) {
  if (VNB == 512) {
    if (VHALF == 1) rwkv_item<true>(p, VBID >> 1, smem);
    else gdn_item<true>(p, VBID >> 1, smem);
  } else {
#pragma unroll 1
    for (int it = VBID; it < 512; it += VNB)
      if (it & 1) rwkv_item<false>(p, it >> 1, smem);
    __builtin_amdgcn_sched_barrier(0);
#pragma unroll 1
    for (int it = VBID; it < 512; it += VNB)
      if (!(it & 1)) gdn_item<false>(p, it >> 1, smem);
  }
}

DEV void mixout_item(const Params& p, int it, char* smem) {
  const u16* P = (const u16*)(p.ws + OFF_BIG);
  const u16* O4 = (const u16*)p.out;
  const float* BS = (const float*)(p.ws + OFF_BSUM);
  const u16* G2T = (const u16*)(p.ws + OFF_G2T);
  u16* Y = (u16*)(p.ws + OFF_HY);
  u16* sg = (u16*)smem;
  u16* G = sg + 32 * 136;
  const int tid = VTID, lane = tid & 63, wave = tid >> 6;
  const int fr = lane & 15, fq = lane >> 4;
  const int tok0 = it * 32, tl0 = tok0 & 2047;
  const int tk = tid >> 3, part = tid & 7;
  const int row = tok0 + tk, t = tl0 + tk;
  const bool hasp = t > 0, hasn = t + 1 < 2048;
  const u16* prow = P + (size_t)row * PS1;
  {
#pragma unroll
    for (int q = 0; q < 2; ++q) {
      const int col = 1792 + part * 16 + q * 8;
      float pc[8], pp[8], pn[8], v[8];
      unpack8(*(const uint4*)(prow + col), pc);
      if (hasp) unpack8(*(const uint4*)(prow - PS1 + col), pp);
      else {
#pragma unroll
        for (int j = 0; j < 8; ++j) pp[j] = 0.f;
      }
      if (hasn) unpack8(*(const uint4*)(prow + PS1 + col), pn);
      else {
#pragma unroll
        for (int j = 0; j < 8; ++j) pn[j] = 0.f;
      }
      const float* mu = p.rw_mu + col;
#pragma unroll
      for (int j = 0; j < 8; ++j) v[j] = sigm(pc[j] + mu[j] * (0.5f * (pp[j] + pn[j]) - pc[j]));
      *(uint4*)(sg + tk * 136 + part * 16 + q * 8) = pack8(v);
    }
  }
  HSYNC();
  {
    bf16x8 af[2][4];
#pragma unroll
    for (int mt = 0; mt < 2; ++mt)
#pragma unroll
      for (int ks = 0; ks < 4; ++ks) af[mt][ks] = *(const bf16x8*)(sg + (mt * 16 + fr) * 136 + ks * 32 + fq * 8);
#pragma unroll
    for (int nt = 0; nt < 8; ++nt) {
      const u16* bp = G2T + (size_t)(wave * 128 + nt * 16 + fr) * 128 + fq * 8;
      bf16x8 bf0 = *(const bf16x8*)(bp), bf1 = *(const bf16x8*)(bp + 32), bf2 = *(const bf16x8*)(bp + 64), bf3 = *(const bf16x8*)(bp + 96);
#pragma unroll
      for (int mt = 0; mt < 2; ++mt) {
        f32x4 a = (f32x4){0.f, 0.f, 0.f, 0.f};
        a = __builtin_amdgcn_mfma_f32_16x16x32_bf16(af[mt][0], bf0, a, 0, 0, 0);
        a = __builtin_amdgcn_mfma_f32_16x16x32_bf16(af[mt][1], bf1, a, 0, 0, 0);
        a = __builtin_amdgcn_mfma_f32_16x16x32_bf16(af[mt][2], bf2, a, 0, 0, 0);
        a = __builtin_amdgcn_mfma_f32_16x16x32_bf16(af[mt][3], bf3, a, 0, 0, 0);
#pragma unroll
        for (int e = 0; e < 4; ++e) G[(mt * 16 + fq * 4 + e) * 520 + wave * 128 + nt * 16 + fr] = f2bf(a[e]);
      }
    }
  }
  HSYNC();
  {
    const int hd = part, c0 = hd * 64;
    const u16* of = O4 + (size_t)row * 512 + c0;
    const u16* ob = O4 + ((size_t)NLAT + row) * 512 + c0;
    const float bsum = BS[(size_t)row * 16 + hd * 2] + BS[(size_t)row * 16 + hd * 2 + 1];
    float s1 = 0.f, s2 = 0.f;
#pragma unroll
    for (int q = 0; q < 8; ++q) {
      float a[8], b8[8];
      unpack8(*(const uint4*)(of + q * 8), a);
      unpack8(*(const uint4*)(ob + q * 8), b8);
#pragma unroll
      for (int j = 0; j < 8; ++j) { const float v = a[j] + b8[j]; s1 += v; s2 += v * v; }
    }
    const float mean = s1 * (1.f / 64.f);
    const float var = fmaxf(s2 * (1.f / 64.f) - mean * mean, 0.f);
    const float rs = rsqrtf(var + 64e-5f);
#pragma unroll
    for (int q = 0; q < 8; ++q) {
      const int c = c0 + q * 8;
      float pc[8], pp[8], pn[8], gv[8], o[8], ya[8], yb[8];
      unpack8(*(const uint4*)(of + q * 8), ya);
      unpack8(*(const uint4*)(ob + q * 8), yb);
      unpack8(*(const uint4*)(prow + 1024 + c), pc);
      if (hasp) unpack8(*(const uint4*)(prow - PS1 + 1024 + c), pp);
      else {
#pragma unroll
        for (int j = 0; j < 8; ++j) pp[j] = 0.f;
      }
      if (hasn) unpack8(*(const uint4*)(prow + PS1 + 1024 + c), pn);
      else {
#pragma unroll
        for (int j = 0; j < 8; ++j) pn[j] = 0.f;
      }
      unpack8(*(const uint4*)(G + tk * 520 + c), gv);
      const float* mu = p.rw_mu + 1024 + c;
      const float* gg = p.rw_lnx_g + c;
      const float* gb = p.rw_lnx_b + c;
#pragma unroll
      for (int j = 0; j < 8; ++j) {
        const float vsh = pc[j] + mu[j] * (0.5f * (pp[j] + pn[j]) - pc[j]);
        const float yn = (ya[j] + yb[j] - mean) * rs * gg[j] + gb[j];
        o[j] = (yn + bsum * vsh) * gv[j];
      }
      *(uint4*)(Y + (size_t)row * 1024 + c) = pack8(o);
    }
  }
  {
    const int c0 = part * 64;
    const u16* of = O4 + ((size_t)2 * NLAT + row) * 512 + c0;
    const u16* ob = O4 + ((size_t)3 * NLAT + row) * 512 + c0;
    float s2 = 0.f;
#pragma unroll
    for (int q = 0; q < 8; ++q) {
      float a[8], b8[8];
      unpack8(*(const uint4*)(of + q * 8), a);
      unpack8(*(const uint4*)(ob + q * 8), b8);
#pragma unroll
      for (int j = 0; j < 8; ++j) { const float v = a[j] + b8[j]; s2 += v * v; }
    }
    s2 += __shfl_xor(s2, 1, 64);
    const float rs = rsqrtf(s2 * (1.f / 128.f) + 1e-6f);
    const u16* zr = prow + DNO + 1536 + c0;
    const float* ng = p.dn_norm_g + (part & 1) * 64;
#pragma unroll
    for (int q = 0; q < 8; ++q) {
      float z[8], r8[8], a[8], b8[8];
      unpack8(*(const uint4*)(of + q * 8), a);
      unpack8(*(const uint4*)(ob + q * 8), b8);
      unpack8(*(const uint4*)(zr + q * 8), z);
#pragma unroll
      for (int j = 0; j < 8; ++j) r8[j] = (a[j] + b8[j]) * rs * ng[q * 8 + j] * silu(z[j]);
      *(uint4*)(Y + (size_t)row * 1024 + 512 + c0 + q * 8) = pack8(r8);
    }
  }
  HSYNC();
}

#define XB_TMO      128
#define XB_XCNT(j)  (256  + 64 * (j))
#define XB_XSUB(j)  (1280 + 64 * (j))
#define XB_XGEN(j)  (2304 + 64 * (j))
#define XB_TOP      3328
#define XB_TOPGEN   3392
#define XCD_BAR_WORDS 3456
#define XB_SPIN_CAP (1u << 20)
DEV unsigned xb_ld(unsigned* p) { return __hip_atomic_load(p, __ATOMIC_RELAXED, __HIP_MEMORY_SCOPE_AGENT); }
DEV unsigned xb_add(unsigned* p, unsigned v) { return __hip_atomic_fetch_add(p, v, __ATOMIC_RELAXED, __HIP_MEMORY_SCOPE_AGENT); }
DEV unsigned xb_xcc_id() { return (unsigned)__builtin_amdgcn_s_getreg((3 << 11) | 20) & 0xFu; }
#define XB_SPIN(cond, bar) do { unsigned _sp = 0; while (cond) { __builtin_amdgcn_s_sleep(1); \
    if ((++_sp & 255u) == 0u) { if (xb_ld(&(bar)[XB_TMO])) break; if (_sp > XB_SPIN_CAP) { atomicAdd(&(bar)[XB_TMO], 1u); break; } } } } while (0)
DEV void xcd_barrier_complete(unsigned* bar, unsigned x, unsigned& nloc, unsigned& nx) {
  const unsigned G = gridDim.x;
  unsigned sum, cnt, mine, sp = 0u;
  for (;;) {
    sum = 0u; cnt = 0u; mine = 0u;
#pragma unroll
    for (unsigned j = 0; j < 16; ++j) { const unsigned c = xb_ld(&bar[XB_XCNT(j)]); sum += c; cnt += (c > 0u) ? 1u : 0u; mine = (j == x) ? c : mine; }
    if (sum == G) break;
    __builtin_amdgcn_s_sleep(1);
    if ((++sp & 255u) == 0u) { if (xb_ld(&bar[XB_TMO])) break; if (sp > XB_SPIN_CAP) { atomicAdd(&bar[XB_TMO], 1u); break; } }
  }
  nloc = mine > 0u ? mine : 1u; nx = cnt > 0u ? cnt : 1u;
}
DEV void xcd_barrier(unsigned* bar) {
  asm volatile("s_waitcnt vmcnt(0)" ::: "memory");
  __syncthreads();
  if (threadIdx.x == 0) {
    __builtin_amdgcn_s_waitcnt(0);
    const unsigned x = xb_xcc_id();
    volatile LAS unsigned* st = (volatile LAS unsigned*)(dyn_smem + HS_OFF + 128);
    unsigned nloc = st[0], nx = st[1];
    if (nloc == 0u) { xcd_barrier_complete(bar, x, nloc, nx); st[0] = nloc; st[1] = nx; }
    const unsigned old = xb_add(&bar[XB_XSUB(x)], 1u);
    const unsigned gen = old / nloc;
    if (old + 1u == (gen + 1u) * nloc) {
      __builtin_amdgcn_fence(__ATOMIC_RELEASE, "agent");
      asm volatile("s_waitcnt vmcnt(0)" ::: "memory");
      const unsigned og = xb_add(&bar[XB_TOP], 1u);
      const unsigned tg = og / nx;
      if (og + 1u == (tg + 1u) * nx) xb_add(&bar[XB_TOPGEN], 1u);
      else XB_SPIN(xb_ld(&bar[XB_TOPGEN]) == tg, bar);
      __builtin_amdgcn_fence(__ATOMIC_ACQUIRE, "agent");
      xb_add(&bar[XB_XGEN(x)], 1u);
      asm volatile("s_waitcnt vmcnt(0)" ::: "memory");
    } else {
      XB_SPIN(xb_ld(&bar[XB_XGEN(x)]) == gen, bar);
      __builtin_amdgcn_fence(__ATOMIC_ACQUIRE, "agent");
      asm volatile("s_waitcnt vmcnt(0)" ::: "memory");
    }
  }
  __syncthreads();
}

constexpr int NPHASE = 18;

__global__ void __launch_bounds__(512, 2) mega(Params p, int ph_lo, int ph_hi) {
  char* smem = dyn_smem + VHALF * HALF_LDS;
  if ((threadIdx.x & 255) == 0) *((LAS unsigned*)(dyn_smem + HS_OFF) + (threadIdx.x >> 8) * 16) = 0u;
  __syncthreads();
  cg::grid_group grid = cg::this_grid();
  const float* mv0 = (const float*)(p.ws + OFF_MODV);
  const float* mv1 = mv0 + 33 * 6144;
  u16* X = (u16*)(p.ws + OFF_X);
  u16* HY = (u16*)(p.ws + OFF_HY);
  u16* BIG = (u16*)(p.ws + OFF_BIG);
  unsigned* bar = (unsigned*)(p.ws + OFF_BAR);
  if (threadIdx.x == 0) {
    volatile LAS unsigned* st = (volatile LAS unsigned*)(dyn_smem + HS_OFF + 128);
    st[0] = 0u; st[1] = 0u;
    (void)xb_add(&bar[XB_XCNT(xb_xcc_id())], 1u);
  }
  if (ph_hi < 0) grid.sync();
#define PHASE(n, BODY) if (ph_lo <= (n) && (n) < ph_hi) { BODY; if ((n) + 1 < ph_hi) xcd_barrier(bar); }
  PHASE(0, phase_prep(p, smem))
  PHASE(1, phase_init(p))
  PHASE(2, gemm_phase<0>(HY, 1024, (const u16*)(p.ws + OFF_WIN0), 1024, NTOK, 2304, BIG, PS0, nullptr, dyn_smem))
  PHASE(3, phase_hyprep_rope(p, smem))
  PHASE(4, phase_conv_attn(p, smem))
  PHASE(5, gemm_phase<2>(HY, 1024, (const u16*)(p.ws + OFF_WOUT0), 1024, NTOK, 1024, X, 1024, mv0 + 2 * 1024, dyn_smem))
  PHASE(6, ln_phase<false>(p, NTOK, p.ln_g, p.ln_b, mv0, 3, 4))
  PHASE(7, gemm_phase<1>(HY, 1024, (const u16*)(p.ws + OFF_W1_0), 1024, NTOK, 4096, BIG, 4096, nullptr, dyn_smem))
  PHASE(8, gemm_phase<2>(BIG, 4096, (const u16*)(p.ws + OFF_W2_0), 4096, NTOK, 1024, X, 1024, mv0 + 5 * 1024, dyn_smem))
  PHASE(9, ln_phase<false>(p, NTOK, p.ln_g + 1024, p.ln_b + 1024, mv1, 0, 1))
  PHASE(10, gemm_phase<0>(HY, 1024, (const u16*)(p.ws + OFF_WIN1), 1024, NTOK, 4096, BIG, PS1, nullptr, dyn_smem))
  PHASE(11, phase_scans(p, smem))
  PHASE(12, for (int it = VBID; it < 2048; it += VNB) mixout_item(p, it, smem))
  PHASE(13, gemm_phase<2>(HY, 1024, (const u16*)(p.ws + OFF_WOUT1), 1024, NLAT, 1024, X, 1024, mv1 + 2 * 1024, dyn_smem))
  PHASE(14, ln_phase<false>(p, NLAT, p.ln_g + 2048, p.ln_b + 2048, mv1, 3, 4))
  PHASE(15, gemm_phase<1>(HY, 1024, (const u16*)(p.ws + OFF_W1_1), 1024, NLAT, 4096, BIG, 4096, nullptr, dyn_smem))
  PHASE(16, gemm_phase<2>(BIG, 4096, (const u16*)(p.ws + OFF_W2_1), 4096, NLAT, 1024, X, 1024, mv1 + 5 * 1024, dyn_smem))
  PHASE(17, ln_phase<true>(p, NLAT, p.ln_g + 3072, p.ln_b + 3072, mv1, 0, 1))
}

extern "C" void kernel_launch(void* const* d_in, const int* in_sizes, int n_in, void* d_out, int out_size, void* d_ws,
                              size_t ws_size, hipStream_t stream) {
  static int grid_blocks = 0;
  if (!grid_blocks) {
    int dev = 0, cus = 0, per_cu = 0;
    hipGetDevice(&dev);
    hipDeviceGetAttribute(&cus, hipDeviceAttributeMultiprocessorCount, dev);
    hipFuncSetAttribute((const void*)mega, hipFuncAttributeMaxDynamicSharedMemorySize, LDS_BYTES);
    hipOccupancyMaxActiveBlocksPerMultiprocessor(&per_cu, mega, 512, LDS_BYTES);
    if (per_cu > 1) per_cu = 1;
    if (per_cu < 1) per_cu = 1;
    grid_blocks = cus * per_cu;
  }
  if (ws_size < WS_NEED) fprintf(stderr, "workspace too small: %zu < %zu\n", ws_size, (size_t)WS_NEED);
  Params p{};
  const float** pp = (const float**)&p;
  for (int i = 0; i < 39; ++i) pp[i] = (const float*)d_in[i];
  p.out = (float*)d_out;
  p.ws = (char*)d_ws;
  int lo = 0, hi = NPHASE;
  void* args[] = {&p, &lo, &hi};
  hipMemsetAsync((char*)d_ws + OFF_BAR, 0, XCD_BAR_WORDS * sizeof(unsigned), stream);
  hipError_t e = hipLaunchCooperativeKernel((void*)mega, dim3(grid_blocks), dim3(512), args, LDS_BYTES, stream);
  if (e != hipSuccess) fprintf(stderr, "cooperative launch failed: %s (grid %d)\n", hipGetErrorString(e), grid_blocks);
}
```
